# Optimizing an MI355X kernel written in HIP

```python
import jax
import jax.numpy as jnp
from jax import lax
import numpy as np

D_MODEL = 1024
BATCH = 16
SEQ = 4096
DEPTH = 4

GRID_W = 64
CTX_LEN = 256
N_MIXERS = 2
HEAD_SIZE = 64
N_HEADS = D_MODEL // HEAD_SIZE
DECAY_LORA = 64
AAA_LORA = 64
MV_LORA = 32
GATE_LORA = 128
N_DIRS = 2
POOL_WINDOWS = (2, 4, 8, 16)
N_POOL_GROUPS = len(POOL_WINDOWS)
POOL_GROUP = D_MODEL // N_POOL_GROUPS
N_EXPERTS = 16
EXPERT_FF = 2 * D_MODEL
CAPACITY_FACTOR = 2
N_RWKV = (DEPTH + N_MIXERS - 1) // N_MIXERS
N_POOL = DEPTH // N_MIXERS
RMS_EPS = 1e-6
GN_EPS = 64e-5

kernel_name = 'hybrid_rwkv7_pool_ecmoe_dit'


def rmsnorm(x, g):
    xf = x.astype(jnp.float32)
    y = xf * lax.rsqrt(jnp.mean(xf * xf, axis=-1, keepdims=True) + RMS_EPS)
    return (y * g.astype(jnp.float32)).astype(x.dtype)


def ada_mod(cond, w, b):
    m = (jax.nn.silu(cond) @ w + b)[..., None, :]
    return jnp.split(m, 6, axis=-1)


def modulate(h, shift, scale):
    return h * (1 + scale) + shift


def grid_shift(x):
    B, T, D = x.shape
    rows = T // GRID_W
    q = D // 4
    g = x.reshape(B, rows, GRID_W, D)
    left = jnp.pad(g[:, :, :-1, :q], ((0, 0), (0, 0), (1, 0), (0, 0)))
    right = jnp.pad(g[:, :, 1:, q:2 * q], ((0, 0), (0, 0), (0, 1), (0, 0)))
    up = jnp.pad(g[:, :-1, :, 2 * q:3 * q], ((0, 0), (1, 0), (0, 0), (0, 0)))
    down = jnp.pad(g[:, 1:, :, 3 * q:], ((0, 0), (0, 1), (0, 0), (0, 0)))
    return jnp.concatenate([left, right, up, down], axis=-1).reshape(B, T, D)


def seq_shift(x):
    h = x.shape[-1] // 2
    prev = jnp.pad(x[:, :-1, :h], ((0, 0), (1, 0), (0, 0)))
    nxt = jnp.pad(x[:, 1:, h:], ((0, 0), (0, 1), (0, 0)))
    return jnp.concatenate([prev, nxt], axis=-1)


def rwkv_project(h, shifted, p, vres, v_first):
    B, T, D = h.shape
    f32 = jnp.float32

    def heads(t):
        return t.astype(f32).reshape(B, T, N_HEADS, HEAD_SIZE)

    xx = shifted - h
    xr, xw, xk, xv, xa, xg = [h + xx * p['mix'][n] for n in range(6)]
    r = xr @ p['wrkv'][0]
    k = xk @ p['wrkv'][1]
    v = xv @ p['wrkv'][2]
    if vres is not None:
        v0, v1, v2 = vres
        v = v + (v_first - v) * jax.nn.sigmoid(v0 + (xv @ v1) @ v2)
    g = jax.nn.sigmoid(xg @ p['g1']) @ p['g2']
    kh = heads(k)
    kk = heads(k * p['k_k'])
    kk = kk / jnp.maximum(jnp.sqrt(jnp.sum(kk * kk, axis=-1, keepdims=True)), 1e-12)
    k_a = p['k_a'].astype(f32).reshape(N_HEADS, HEAD_SIZE)
    dirs = []
    for d in range(N_DIRS):
        w_pre = (p['w0'][d] + jnp.tanh(xw @ p['w1'][d]) @ p['w2'][d]).astype(f32)
        w_log = -jax.nn.softplus(-w_pre) - 0.5
        decay = heads(jnp.exp(-jnp.exp(w_log)))
        a = heads(jax.nn.sigmoid((p['a0'][d] + (xa @ p['a1'][d]) @ p['a2'][d]).astype(f32)))
        k_d = kh * (1 + (a - 1) * k_a)
        dirs.append((decay, kk * a, k_d))
    return heads(r), heads(v), v, g, kk, dirs


def wkv_scan(S0, r, decay, kk, b, k, v, reverse):
    def step(S, inp):
        r_t, w_t, kk_t, b_t, k_t, v_t = inp
        S = (S * w_t[:, :, None, :]
             + jnp.einsum('bhi,bhj->bhij', jnp.einsum('bhij,bhj->bhi', S, -kk_t), b_t)
             + jnp.einsum('bhi,bhj->bhij', v_t, k_t))
        return S, jnp.einsum('bhij,bhj->bhi', S, r_t)

    xs = tuple(jnp.moveaxis(t, 1, 0) for t in (r, decay, kk, b, k, v))
    S, y = lax.scan(step, S0, xs, reverse=reverse)
    return S, jnp.moveaxis(y, 0, 1)


def rwkv_output(o, r, kb, v, g, p, dtype):
    B, T, H, N = o.shape
    mu = jnp.mean(o, axis=-1, keepdims=True)
    var = jnp.mean(jnp.square(o - mu), axis=-1, keepdims=True)
    on = ((o - mu) * lax.rsqrt(var + GN_EPS)).reshape(B, T, H * N)
    on = on * p['ln_w'].astype(jnp.float32) + p['ln_b'].astype(jnp.float32)
    bonus = (jnp.sum(r * kb * p['r_k'].astype(jnp.float32), axis=-1, keepdims=True) * v).reshape(B, T, H * N)
    y = (on + bonus).astype(dtype) * g
    return y @ p['wo']


def rwkv_time_mix(h_ctx, h_lat, p, vres, v_first):
    vf_ctx = None if v_first is None else v_first[0]
    vf_lat = None if v_first is None else v_first[1]
    r_c, vh_c, v_c, g_c, kk_c, dirs_c = rwkv_project(h_ctx, seq_shift(h_ctx), p, vres, vf_ctx)
    r_l, vh_l, v_l, g_l, kk_l, dirs_l = rwkv_project(h_lat, grid_shift(h_lat), p, vres, vf_lat)
    new_v_first = (v_c, v_l) if v_first is None else v_first
    B = h_lat.shape[0]
    S_zero = jnp.zeros((B, N_HEADS, HEAD_SIZE, HEAD_SIZE), jnp.float32)
    o_c = jnp.zeros_like(r_c)
    o_l = jnp.zeros_like(r_l)
    kb_c = jnp.zeros_like(r_c)
    kb_l = jnp.zeros_like(r_l)
    for d, rev in enumerate((False, True)):
        dec_c, b_c, k_c = dirs_c[d]
        dec_l, b_l, k_l = dirs_l[d]
        S_ctx, y_c = wkv_scan(S_zero, r_c, dec_c, kk_c, b_c, k_c, vh_c, rev)
        _, y_l = wkv_scan(S_ctx, r_l, dec_l, kk_l, b_l, k_l, vh_l, rev)
        o_c = o_c + y_c
        o_l = o_l + y_l
        kb_c = kb_c + 0.5 * k_c
        kb_l = kb_l + 0.5 * k_l
    y_ctx = rwkv_output(o_c, r_c, kb_c, vh_c, g_c, p, h_ctx.dtype)
    y_lat = rwkv_output(o_l, r_l, kb_l, vh_l, g_l, p, h_lat.dtype)
    return y_ctx, y_lat, new_v_first


def pool_mix(h, w, scale):
    B, T, D = h.shape
    t = jnp.arange(T)
    parts = []
    for gi, win in enumerate(POOL_WINDOWS):
        hg = h[..., gi * POOL_GROUP:(gi + 1) * POOL_GROUP].astype(jnp.float32)
        P = jnp.pad(jnp.cumsum(hg, axis=1), ((0, 0), (1, 0), (0, 0)))
        half = win // 2
        hi = jnp.minimum(t + half, T)
        lo = jnp.maximum(t - half, 0)
        cnt = (hi - lo).astype(jnp.float32)[None, :, None]
        mean = (jnp.take(P, hi, axis=1) - jnp.take(P, lo, axis=1)) / cnt
        parts.append(mean - hg)
    dlt = jnp.stack(parts, axis=2).astype(h.dtype)
    y = jnp.einsum('btgc,gce->btge', dlt, w).reshape(B, T, D)
    return y * scale


def ec_moe(h, router, w1, w3, w2):
    B, T, D = h.shape
    cap = CAPACITY_FACTOR * T // N_EXPERTS
    aff = jax.nn.softmax(jnp.einsum('btd,de->bte', h, router).astype(jnp.float32), axis=-1)
    gates, idx = lax.top_k(jnp.swapaxes(aff, 1, 2), cap)
    bi = jnp.arange(B)[:, None, None]
    xin = h[bi, idx]
    hid = jax.nn.silu(jnp.einsum('becd,edf->becf', xin, w1)) * jnp.einsum('becd,edf->becf', xin, w3)
    y = jnp.einsum('becf,efd->becd', hid, w2) * gates[..., None].astype(h.dtype)
    return jnp.zeros_like(h).at[bi, idx].add(y)


def setup_inputs(seed: int = 0) -> dict:
    key = jax.random.key(seed)
    ks = iter(list(jax.random.split(key, 40)))

    def nrm(shape, scale):
        return jax.random.normal(next(ks), shape, jnp.float32) * scale

    def unif(shape, lo, hi):
        return jax.random.uniform(next(ks), shape, jnp.float32, lo, hi)

    D = D_MODEL
    NR = N_RWKV
    NP = N_POOL
    sd = D ** -0.5
    return {
        'x': nrm((BATCH, SEQ, D), 1.0),
        'c': nrm((BATCH, D), 1.0),
        'ctx': nrm((BATCH, CTX_LEN, D), 1.0),
        'c_ctx': nrm((D,), 1.0),
        'ada_w': nrm((DEPTH, D, 6 * D), 0.5 * sd),
        'ada_b': nrm((DEPTH, 6 * D), 0.02),
        'norm1_g': 1.0 + nrm((DEPTH, D), 0.05),
        'norm2_g': 1.0 + nrm((DEPTH, D), 0.05),
        'rwkv_mix': unif((NR, 6, D), 0.0, 1.0),
        'rwkv_wrkv': nrm((NR, 3, D, D), sd),
        'rwkv_w0': unif((NR, N_DIRS, D), -6.0, 1.0),
        'rwkv_w1': nrm((NR, N_DIRS, D, DECAY_LORA), sd),
        'rwkv_w2': nrm((NR, N_DIRS, DECAY_LORA, D), 0.5 * DECAY_LORA ** -0.5),
        'rwkv_a0': nrm((NR, N_DIRS, D), 0.1),
        'rwkv_a1': nrm((NR, N_DIRS, D, AAA_LORA), sd),
        'rwkv_a2': nrm((NR, N_DIRS, AAA_LORA, D), 0.5 * AAA_LORA ** -0.5),
        'rwkv_v0': 1.0 + nrm((NR - 1, D), 0.1),
        'rwkv_v1': nrm((NR - 1, D, MV_LORA), sd),
        'rwkv_v2': nrm((NR - 1, MV_LORA, D), 0.5 * MV_LORA ** -0.5),
        'rwkv_g1': nrm((NR, D, GATE_LORA), sd),
        'rwkv_g2': nrm((NR, GATE_LORA, D), GATE_LORA ** -0.5),
        'rwkv_kk': 0.85 + nrm((NR, D), 0.05),
        'rwkv_ka': 1.0 + nrm((NR, D), 0.05),
        'rwkv_rk': nrm((NR, N_HEADS, HEAD_SIZE), 0.1),
        'rwkv_lnw': 1.0 + nrm((NR, D), 0.05),
        'rwkv_lnb': nrm((NR, D), 0.02),
        'rwkv_wo': nrm((NR, D, D), sd),
        'pool_w': nrm((NP, N_POOL_GROUPS, POOL_GROUP, POOL_GROUP), POOL_GROUP ** -0.5),
        'pool_scale': 1.0 + nrm((NP, D), 0.1),
        'moe_router': nrm((DEPTH, D, N_EXPERTS), sd),
        'moe_w1': nrm((DEPTH, N_EXPERTS, D, EXPERT_FF), sd),
        'moe_w3': nrm((DEPTH, N_EXPERTS, D, EXPERT_FF), sd),
        'moe_w2': nrm((DEPTH, N_EXPERTS, EXPERT_FF, D), EXPERT_FF ** -0.5),
        'final_g': 1.0 + nrm((D,), 0.05),
    }


def reference(x, c, ctx, c_ctx, ada_w, ada_b, norm1_g, norm2_g, rwkv_mix, rwkv_wrkv,
              rwkv_w0, rwkv_w1, rwkv_w2, rwkv_a0, rwkv_a1, rwkv_a2, rwkv_v0, rwkv_v1, rwkv_v2,
              rwkv_g1, rwkv_g2, rwkv_kk, rwkv_ka, rwkv_rk, rwkv_lnw, rwkv_lnb, rwkv_wo,
              pool_w, pool_scale, moe_router, moe_w1, moe_w3, moe_w2, final_g):
    v_first = None
    for i in range(DEPTH):
        last = i == DEPTH - 1
        is_rwkv = i % N_MIXERS == 0
        j = i // N_MIXERS
        m_lat = ada_mod(c, ada_w[i], ada_b[i])
        need_ctx = (not last) or is_rwkv
        m_ctx = ada_mod(c_ctx, ada_w[i], ada_b[i]) if need_ctx else None

        h_lat = modulate(rmsnorm(x, norm1_g[i]), m_lat[0], m_lat[1])
        if is_rwkv:
            h_ctx = modulate(rmsnorm(ctx, norm1_g[i]), m_ctx[0], m_ctx[1])
            p = {'mix': rwkv_mix[j], 'wrkv': rwkv_wrkv[j],
                 'w0': rwkv_w0[j], 'w1': rwkv_w1[j], 'w2': rwkv_w2[j],
                 'a0': rwkv_a0[j], 'a1': rwkv_a1[j], 'a2': rwkv_a2[j],
                 'g1': rwkv_g1[j], 'g2': rwkv_g2[j], 'k_k': rwkv_kk[j], 'k_a': rwkv_ka[j],
                 'r_k': rwkv_rk[j], 'ln_w': rwkv_lnw[j], 'ln_b': rwkv_lnb[j], 'wo': rwkv_wo[j]}
            vres = None if j == 0 else (rwkv_v0[j - 1], rwkv_v1[j - 1], rwkv_v2[j - 1])
            y_ctx, y_lat, v_first = rwkv_time_mix(h_ctx, h_lat, p, vres, v_first)
            x = x + m_lat[2] * y_lat
            if not last:
                ctx = ctx + m_ctx[2] * y_ctx
        else:
            x = x + m_lat[2] * pool_mix(h_lat, pool_w[j], pool_scale[j])
            if not last:
                h_ctx = modulate(rmsnorm(ctx, norm1_g[i]), m_ctx[0], m_ctx[1])
                ctx = ctx + m_ctx[2] * pool_mix(h_ctx, pool_w[j], pool_scale[j])

        h_lat = modulate(rmsnorm(x, norm2_g[i]), m_lat[3], m_lat[4])
        x = x + m_lat[5] * ec_moe(h_lat, moe_router[i], moe_w1[i], moe_w3[i], moe_w2[i])
        if not last:
            h_ctx = modulate(rmsnorm(ctx, norm2_g[i]), m_ctx[3], m_ctx[4])
            ctx = ctx + m_ctx[5] * ec_moe(h_ctx, moe_router[i], moe_w1[i], moe_w3[i], moe_w2[i])
    return rmsnorm(x, final_g)
```

```cpp
#include <hip/hip_runtime.h>
#include <stdint.h>
#include <stdio.h>
#include <string.h>

typedef unsigned short bf16_t;
typedef short bf16x8 __attribute__((ext_vector_type(8)));
typedef float f32x4 __attribute__((ext_vector_type(4)));
typedef unsigned u32x4 __attribute__((ext_vector_type(4)));
typedef unsigned u32x2 __attribute__((ext_vector_type(2)));

constexpr int D = 1024, NB = 16, TL = 4096, TC = 256;
constexpr int NLAT = NB * TL, NCTX = NB * TC, NT = NLAT + NCTX;
constexpr int NE = 16, FF = 2048, CAPL = 512, CAPC = 32;
constexpr int NSLOT_LAT = NB * NE * CAPL, NSLOT_CTX = NB * NE * CAPC, NSLOT = NSLOT_LAT + NSLOT_CTX;
constexpr int MODW = 6 * D;
constexpr int NTHREADS = 512;

constexpr size_t MiB = 1ull << 20;
constexpr size_t U = (size_t)NT * D * 2;
constexpr size_t OFF_BAR = 0;
constexpr size_t OFF_MOD = 64 * 1024;
constexpr size_t OFF_WSM = 2 * MiB;
constexpr size_t OFF_AFF = 26 * MiB;
constexpr size_t OFF_BON = 31 * MiB;
constexpr size_t OFF_IDX = 36 * MiB;
constexpr size_t OFF_GTV = 37 * MiB;
constexpr size_t OFF_SLT = 38 * MiB;
constexpr size_t OFF_BIG = 48 * MiB;
constexpr size_t OFF_X = OFF_BIG;
constexpr size_t OFF_VF = OFF_BIG + 2 * U;
constexpr size_t OFF_H = OFF_BIG + 3 * U;
constexpr size_t OFF_R = OFF_BIG + 4 * U;
constexpr size_t OFF_K = OFF_BIG + 5 * U;
constexpr size_t OFF_LD = OFF_BIG + 6 * U;
constexpr size_t OFF_LW = OFF_BIG + 6 * U + U / 2;
constexpr size_t OFF_AD = OFF_BIG + 8 * U + U / 2;
constexpr size_t OFF_Y = OFF_BIG + 10 * U + U / 2;
constexpr size_t OFF_G = OFF_BIG + 12 * U + U / 2;
constexpr size_t OFF_WM = OFF_BIG + 4 * U;
constexpr size_t OFF_XG = OFF_BIG + 5 * U + U / 2;
constexpr size_t OFF_HID = OFF_BIG + 7 * U + U / 2;
constexpr size_t OFF_YS = OFF_BIG + 11 * U + U / 2;
constexpr size_t OFF_DLT = OFF_BIG + 4 * U;
constexpr size_t WS_NEED = OFF_BIG + 13 * U + U / 2;

constexpr size_t WJ_RKV = 0;
constexpr size_t WJ_WO = 3 * 1048576;
constexpr size_t WJ_W1 = 4 * 1048576;
constexpr size_t WJ_A1 = WJ_W1 + 131072;
constexpr size_t WJ_G1 = WJ_A1 + 131072;
constexpr size_t WJ_W2 = WJ_G1 + 131072;
constexpr size_t WJ_A2 = WJ_W2 + 131072;
constexpr size_t WJ_G2 = WJ_A2 + 131072;
constexpr size_t WJ_POOL = WJ_G2 + 131072;
constexpr size_t WJ_SIZE = WJ_POOL + 262144;
constexpr size_t W_V1 = 2 * WJ_SIZE;
constexpr size_t W_V2 = W_V1 + 131072;
constexpr size_t WM_13 = 0;
constexpr size_t WM_2 = (size_t)16 * 4096 * 1024;

struct CvtJob {
    const float* src; bf16_t* dst;
    long src_bs, dst_bs;
    int K, N, src_ld, dst_ld, n_mul, n_off, Kpad, Npad, nbatch, tiles;
};
constexpr int NJOBS = 32;
struct Params {
    const float* in[34];
    float* out;
    char* ws;
    CvtJob jobs[NJOBS];
};

__device__ __forceinline__ float bf2f(bf16_t v) { return __uint_as_float(((unsigned)v) << 16); }
__device__ __forceinline__ bf16_t f2bf(float f) { unsigned u = __float_as_uint(f); u += 0x7FFFu + ((u >> 16) & 1u); return (bf16_t)(u >> 16); }
__device__ __forceinline__ unsigned pack2(float lo, float hi) { return (unsigned)f2bf(lo) | ((unsigned)f2bf(hi) << 16); }
__device__ __forceinline__ float bflo(unsigned w) { return __uint_as_float(w << 16); }
__device__ __forceinline__ float bfhi(unsigned w) { return __uint_as_float(w & 0xffff0000u); }
__device__ __forceinline__ float wave_sum(float v) {
#pragma unroll
    for (int m = 32; m >= 1; m >>= 1) v += __shfl_xor(v, m, 64);
    return v;
}
__device__ __forceinline__ float sigmoidf_(float x) { return 1.f / (1.f + __expf(-x)); }
__device__ __forceinline__ float siluf_(float x) { return x / (1.f + __expf(-x)); }
__device__ __forceinline__ float rdlane(float v, int l) { return __uint_as_float(__builtin_amdgcn_readlane(__float_as_uint(v), l)); }

__device__ __forceinline__ int mod_row(int row) { return row < NLAT ? (row >> 12) : 16; }

__device__ void phase_cvt(const Params& p, int jlo, int jhi, char* lds) {
    float* tile = (float*)lds;
    const int tid = threadIdx.x;
    int total = 0;
    for (int j = jlo; j < jhi; ++j) total += p.jobs[j].tiles;
    for (int u = blockIdx.x; u < total; u += gridDim.x) {
        int j = jlo, uu = u;
        while (uu >= p.jobs[j].tiles) { uu -= p.jobs[j].tiles; ++j; }
        const CvtJob& J = p.jobs[j];
        const int tk = J.Kpad / 64, tn = J.Npad / 64;
        const int bt = uu / (tk * tn), r = uu % (tk * tn), kt = r / tn, nt = r % tn;
        const float* src = J.src + (size_t)bt * J.src_bs;
        bf16_t* dst = J.dst + (size_t)bt * J.dst_bs;
#pragma unroll
        for (int ps = 0; ps < 2; ++ps) {
            const int kl = ps * 32 + (tid >> 4), k = kt * 64 + kl, n = nt * 64 + (tid & 15) * 4;
            float v0 = 0.f, v1 = 0.f, v2 = 0.f, v3 = 0.f;
            if (k < J.K) {
                const float* s = src + (size_t)k * J.src_ld + n;
                if (n + 3 < J.N) { const float4 t = *(const float4*)s; v0 = t.x; v1 = t.y; v2 = t.z; v3 = t.w; }
                else { if (n < J.N) v0 = s[0]; if (n + 1 < J.N) v1 = s[1]; if (n + 2 < J.N) v2 = s[2]; }
            }
            float* tp = tile + kl * 65 + (tid & 15) * 4;
            tp[0] = v0; tp[1] = v1; tp[2] = v2; tp[3] = v3;
        }
        __syncthreads();
        {
            const int n = tid >> 3, kc = tid & 7;
            u32x4 o;
            o[0] = pack2(tile[(kc * 8 + 0) * 65 + n], tile[(kc * 8 + 1) * 65 + n]);
            o[1] = pack2(tile[(kc * 8 + 2) * 65 + n], tile[(kc * 8 + 3) * 65 + n]);
            o[2] = pack2(tile[(kc * 8 + 4) * 65 + n], tile[(kc * 8 + 5) * 65 + n]);
            o[3] = pack2(tile[(kc * 8 + 6) * 65 + n], tile[(kc * 8 + 7) * 65 + n]);
            *(u32x4*)(dst + ((size_t)(nt * 64 + n) * J.n_mul + J.n_off) * J.dst_ld + kt * 64 + kc * 8) = o;
        }
        __syncthreads();
    }
}

__device__ void phase_ada(const Params& p, char* lds) {
    float* sc = (float*)lds;
    float* red = sc + 17 * 1024;
    const int tid = threadIdx.x;
    const float* c = p.in[1]; const float* cctx = p.in[3];
    for (int i = tid; i < 17 * 1024; i += NTHREADS) {
        const float v = i < 16 * 1024 ? c[i] : cctx[i - 16 * 1024];
        sc[i] = siluf_(v);
    }
    __syncthreads();
    float* MOD = (float*)(p.ws + OFF_MOD);
    const int col = tid & 63, ks = tid >> 6;
    for (int u = blockIdx.x; u < 4 * 96; u += gridDim.x) {
        const int l = u / 96, n = (u % 96) * 64 + col;
        const float* w = p.in[4] + (size_t)l * D * MODW + n;
        float acc[17];
#pragma unroll
        for (int r = 0; r < 17; ++r) acc[r] = 0.f;
        for (int k = ks * 128; k < ks * 128 + 128; ++k) {
            const float wv = w[(size_t)k * MODW];
#pragma unroll
            for (int r = 0; r < 17; ++r) acc[r] += sc[r * 1024 + k] * wv;
        }
#pragma unroll
        for (int r = 0; r < 17; ++r) red[(ks * 17 + r) * 64 + col] = acc[r];
        __syncthreads();
        for (int i = tid; i < 17 * 64; i += NTHREADS) {
            const int r = i >> 6, cc = i & 63;
            float s = 0.f;
#pragma unroll
            for (int q = 0; q < 8; ++q) s += red[(q * 17 + r) * 64 + cc];
            const int nn = (u % 96) * 64 + cc;
            MOD[((size_t)l * 17 + r) * MODW + nn] = s + p.in[5][(size_t)l * MODW + nn];
        }
        __syncthreads();
    }
}

template <bool ROUTER>
__device__ void phase_norm(const Params& p, int l, int which, int nrows, char* lds) {
    const float* X = (const float*)(p.ws + OFF_X);
    bf16_t* H = (bf16_t*)(p.ws + OFF_H);
    const float* MOD = (const float*)(p.ws + OFF_MOD) + (size_t)l * 17 * MODW;
    const float* g = (which == 0 ? p.in[6] : p.in[7]) + (size_t)l * D;
    float* AFF = (float*)(p.ws + OFF_AFF);
    float* rt = (float*)lds;
    const int tid = threadIdx.x, lane = tid & 63, wid = tid >> 6;
    if (ROUTER) {
        const float* rsrc = p.in[29] + (size_t)l * D * NE;
        for (int i = tid; i < D * NE; i += NTHREADS) rt[i] = rsrc[i];
        __syncthreads();
    }
    const int so = which == 0 ? 0 : 3 * D, co = which == 0 ? D : 4 * D;
    for (int row = blockIdx.x * 8 + wid; row < nrows; row += gridDim.x * 8) {
        const float* xr = X + (size_t)row * D;
        const float* mr = MOD + (size_t)mod_row(row) * MODW;
        float ss = 0.f;
#pragma unroll
        for (int i = 0; i < 4; ++i) { const float4 t = *(const float4*)(xr + i * 256 + lane * 4); ss += t.x * t.x + t.y * t.y + t.z * t.z + t.w * t.w; }
        ss = wave_sum(ss);
        const float rs = rsqrtf(ss * (1.f / D) + 1e-6f);
        float lg[16];
        if (ROUTER) {
#pragma unroll
            for (int e = 0; e < 16; ++e) lg[e] = 0.f;
        }
#pragma unroll 1
        for (int i = 0; i < 4; ++i) {
            const int c0 = i * 256 + lane * 4;
            const float4 xv = *(const float4*)(xr + c0);
            const float4 gg = *(const float4*)(g + c0), sh = *(const float4*)(mr + so + c0), sl = *(const float4*)(mr + co + c0);
            float h0 = xv.x * rs * gg.x * (1.f + sl.x) + sh.x;
            float h1 = xv.y * rs * gg.y * (1.f + sl.y) + sh.y;
            float h2 = xv.z * rs * gg.z * (1.f + sl.z) + sh.z;
            float h3 = xv.w * rs * gg.w * (1.f + sl.w) + sh.w;
            u32x2 o; o[0] = pack2(h0, h1); o[1] = pack2(h2, h3);
            *(u32x2*)(H + (size_t)row * D + c0) = o;
            if (ROUTER) {
                const float4* r0 = (const float4*)(rt + c0 * 16);
#pragma unroll
                for (int e4 = 0; e4 < 4; ++e4) {
                    const float4 a = r0[e4], b = r0[4 + e4], c = r0[8 + e4], d = r0[12 + e4];
                    lg[e4 * 4 + 0] += h0 * a.x + h1 * b.x + h2 * c.x + h3 * d.x;
                    lg[e4 * 4 + 1] += h0 * a.y + h1 * b.y + h2 * c.y + h3 * d.y;
                    lg[e4 * 4 + 2] += h0 * a.z + h1 * b.z + h2 * c.z + h3 * d.z;
                    lg[e4 * 4 + 3] += h0 * a.w + h1 * b.w + h2 * c.w + h3 * d.w;
                }
            }
        }
        if (ROUTER) {
            float mx = -1e30f;
#pragma unroll
            for (int e = 0; e < 16; ++e) { lg[e] = wave_sum(lg[e]); mx = fmaxf(mx, lg[e]); }
            float sum = 0.f;
#pragma unroll
            for (int e = 0; e < 16; ++e) { lg[e] = __expf(lg[e] - mx); sum += lg[e]; }
            const float inv = 1.f / sum;
            float mine = 0.f;
#pragma unroll
            for (int e = 0; e < 16; ++e) mine = (lane == e) ? lg[e] * inv : mine;
            if (lane < 16) AFF[(size_t)row * 16 + lane] = mine;
        }
    }
}

constexpr int GS_LD = 72;
template <class AL, class EP>
__device__ __forceinline__ void gemm_tile_small(char* lds, const AL& al, const bf16_t* __restrict__ Bt, int ldb, int K, int row0, int col0, const EP& ep) {
    bf16_t* As = (bf16_t*)lds; bf16_t* Bs = As + 128 * GS_LD;
    const int tid = threadIdx.x, lane = tid & 63, wid = tid >> 6, wr = wid >> 1, wc = wid & 1, fr = lane & 15, fq = lane >> 4;
    const int lr = tid >> 3, kc = tid & 7;
    f32x4 acc[2][4];
#pragma unroll
    for (int m = 0; m < 2; ++m)
#pragma unroll
        for (int n = 0; n < 4; ++n) acc[m][n] = (f32x4){0.f, 0.f, 0.f, 0.f};
    bf16x8 ra0 = al(row0 + lr, kc * 8), ra1 = al(row0 + lr + 64, kc * 8);
    bf16x8 rb0 = *(const bf16x8*)(Bt + (size_t)(col0 + lr) * ldb + kc * 8), rb1 = *(const bf16x8*)(Bt + (size_t)(col0 + lr + 64) * ldb + kc * 8);
    for (int k0 = 0; k0 < K; k0 += 64) {
        __syncthreads();
        *(bf16x8*)(As + lr * GS_LD + kc * 8) = ra0; *(bf16x8*)(As + (lr + 64) * GS_LD + kc * 8) = ra1;
        *(bf16x8*)(Bs + lr * GS_LD + kc * 8) = rb0; *(bf16x8*)(Bs + (lr + 64) * GS_LD + kc * 8) = rb1;
        __syncthreads();
        if (k0 + 64 < K) {
            const int kn = k0 + 64 + kc * 8;
            ra0 = al(row0 + lr, kn); ra1 = al(row0 + lr + 64, kn);
            rb0 = *(const bf16x8*)(Bt + (size_t)(col0 + lr) * ldb + kn); rb1 = *(const bf16x8*)(Bt + (size_t)(col0 + lr + 64) * ldb + kn);
        }
#pragma unroll
        for (int ks = 0; ks < 2; ++ks) {
            bf16x8 a[2], b[4];
#pragma unroll
            for (int m = 0; m < 2; ++m) a[m] = *(const bf16x8*)(As + (wr * 32 + m * 16 + fr) * GS_LD + ks * 32 + fq * 8);
#pragma unroll
            for (int n = 0; n < 4; ++n) b[n] = *(const bf16x8*)(Bs + (wc * 64 + n * 16 + fr) * GS_LD + ks * 32 + fq * 8);
#pragma unroll
            for (int m = 0; m < 2; ++m)
#pragma unroll
                for (int n = 0; n < 4; ++n) acc[m][n] = __builtin_amdgcn_mfma_f32_16x16x32_bf16(b[n], a[m], acc[m][n], 0, 0, 0);
        }
    }
#pragma unroll
    for (int m = 0; m < 2; ++m)
#pragma unroll
        for (int n = 0; n < 4; ++n) ep(row0 + wr * 32 + m * 16 + fr, col0 + wc * 64 + n * 16 + fq * 4, acc[m][n]);
}

struct PlainLoader {
    const bf16_t* A; int lda;
    __device__ __forceinline__ bf16x8 operator()(int row, int k) const { return *(const bf16x8*)(A + (size_t)row * lda + k); }
};
struct MixLoader {
    const bf16_t* H; const float* mix;
    __device__ __forceinline__ bf16x8 operator()(int row, int k) const {
        int nb;
        if (row < NLAT) {
            const int t = row & (TL - 1), gc = t & 63, gr = t >> 6, q = k >> 8;
            if (q == 0) nb = gc > 0 ? row - 1 : -1;
            else if (q == 1) nb = gc < 63 ? row + 1 : -1;
            else if (q == 2) nb = gr > 0 ? row - 64 : -1;
            else nb = gr < 63 ? row + 64 : -1;
        } else {
            const int t = (row - NLAT) & (TC - 1);
            if (k < 512) nb = t > 0 ? row - 1 : -1;
            else nb = t < TC - 1 ? row + 1 : -1;
        }
        const u32x4 h = *(const u32x4*)(H + (size_t)row * D + k);
        u32x4 s = (u32x4){0u, 0u, 0u, 0u};
        if (nb >= 0) s = *(const u32x4*)(H + (size_t)nb * D + k);
        const float4 m0 = *(const float4*)(mix + k), m1 = *(const float4*)(mix + k + 4);
        u32x4 o;
        { float a = bflo(h[0]), b = bfhi(h[0]); o[0] = pack2(a + (bflo(s[0]) - a) * m0.x, b + (bfhi(s[0]) - b) * m0.y); }
        { float a = bflo(h[1]), b = bfhi(h[1]); o[1] = pack2(a + (bflo(s[1]) - a) * m0.z, b + (bfhi(s[1]) - b) * m0.w); }
        { float a = bflo(h[2]), b = bfhi(h[2]); o[2] = pack2(a + (bflo(s[2]) - a) * m1.x, b + (bfhi(s[2]) - b) * m1.y); }
        { float a = bflo(h[3]), b = bfhi(h[3]); o[3] = pack2(a + (bflo(s[3]) - a) * m1.z, b + (bfhi(s[3]) - b) * m1.w); }
        return __builtin_bit_cast(bf16x8, o);
    }
};

struct EpStoreBf16 {
    bf16_t* O; int ldo; int act;
    __device__ __forceinline__ void operator()(int row, int col, f32x4 v) const {
        if (act == 1) { v[0] = tanhf(v[0]); v[1] = tanhf(v[1]); v[2] = tanhf(v[2]); v[3] = tanhf(v[3]); }
        else if (act == 2) { v[0] = sigmoidf_(v[0]); v[1] = sigmoidf_(v[1]); v[2] = sigmoidf_(v[2]); v[3] = sigmoidf_(v[3]); }
        u32x2 o; o[0] = pack2(v[0], v[1]); o[1] = pack2(v[2], v[3]);
        *(u32x2*)(O + (size_t)row * ldo + col) = o;
    }
};
struct EpDecay {
    bf16_t* O; const float* w0;
    __device__ __forceinline__ void operator()(int row, int col, f32x4 v) const {
        const float4 b = *(const float4*)(w0 + col);
        u32x2 o;
        o[0] = pack2(-0.6065306597f * sigmoidf_(v[0] + b.x), -0.6065306597f * sigmoidf_(v[1] + b.y));
        o[1] = pack2(-0.6065306597f * sigmoidf_(v[2] + b.z), -0.6065306597f * sigmoidf_(v[3] + b.w));
        *(u32x2*)(O + (size_t)row * D + col) = o;
    }
};
struct EpSigBias {
    bf16_t* O; const float* b0;
    __device__ __forceinline__ void operator()(int row, int col, f32x4 v) const {
        const float4 b = *(const float4*)(b0 + col);
        u32x2 o;
        o[0] = pack2(sigmoidf_(v[0] + b.x), sigmoidf_(v[1] + b.y));
        o[1] = pack2(sigmoidf_(v[2] + b.z), sigmoidf_(v[3] + b.w));
        *(u32x2*)(O + (size_t)row * D + col) = o;
    }
};
struct EpVres {
    bf16_t* VF; const bf16_t* VRAW; const float* v0;
    __device__ __forceinline__ void operator()(int row, int col, f32x4 a) const {
        const float4 b = *(const float4*)(v0 + col);
        const u32x2 vr = *(const u32x2*)(VRAW + (size_t)row * D + col);
        const u32x2 vf = *(const u32x2*)(VF + (size_t)row * D + col);
        float x0 = bflo(vr[0]), x1 = bfhi(vr[0]), x2 = bflo(vr[1]), x3 = bfhi(vr[1]);
        float f0 = bflo(vf[0]), f1 = bfhi(vf[0]), f2 = bflo(vf[1]), f3 = bfhi(vf[1]);
        u32x2 o;
        o[0] = pack2(x0 + (f0 - x0) * sigmoidf_(a[0] + b.x), x1 + (f1 - x1) * sigmoidf_(a[1] + b.y));
        o[1] = pack2(x2 + (f2 - x2) * sigmoidf_(a[2] + b.z), x3 + (f3 - x3) * sigmoidf_(a[3] + b.w));
        *(u32x2*)(VF + (size_t)row * D + col) = o;
    }
};
struct EpResidual {
    float* X; const float* gate; const float* cscale;
    __device__ __forceinline__ void operator()(int row, int col, f32x4 a) const {
        const float4 gt = *(const float4*)(gate + (size_t)mod_row(row) * MODW + col);
        float4 cs = make_float4(1.f, 1.f, 1.f, 1.f);
        if (cscale) cs = *(const float4*)(cscale + col);
        float4* xp = (float4*)(X + (size_t)row * D + col);
        float4 x = *xp;
        x.x += gt.x * a[0] * cs.x; x.y += gt.y * a[1] * cs.y; x.z += gt.z * a[2] * cs.z; x.w += gt.w * a[3] * cs.w;
        *xp = x;
    }
};
struct EpSwiglu {
    bf16_t* HID;
    __device__ __forceinline__ void operator()(int row, int col, f32x4 a) const {
        *(unsigned*)(HID + (size_t)row * FF + (col >> 1)) = pack2(siluf_(a[0]) * a[1], siluf_(a[2]) * a[3]);
    }
};
struct EpGateRow {
    bf16_t* YS; const float* gatev;
    __device__ __forceinline__ void operator()(int row, int col, f32x4 a) const {
        const float gt = gatev[row];
        u32x2 o; o[0] = pack2(a[0] * gt, a[1] * gt); o[1] = pack2(a[2] * gt, a[3] * gt);
        *(u32x2*)(YS + (size_t)row * D + col) = o;
    }
};

__device__ __forceinline__ const bf16_t* wsm(const Params& p, int j, size_t off) { return (const bf16_t*)(p.ws + OFF_WSM) + (size_t)j * WJ_SIZE + off; }

__device__ void phase_rwkv_proj(const Params& p, int j, char* lds) {
    const bf16_t* H = (const bf16_t*)(p.ws + OFF_H);
    const float* mix = p.in[8] + (size_t)j * 6 * D;
    bf16_t* R = (bf16_t*)(p.ws + OFF_R); bf16_t* Kb = (bf16_t*)(p.ws + OFF_K);
    bf16_t* V = (bf16_t*)(p.ws + (j == 0 ? OFF_VF : OFF_Y));
    bf16_t* LD = (bf16_t*)(p.ws + OFF_LD);
    constexpr int RT = NT / 128;
    const int nbig = 3 * RT * 8, nsmall = (j == 0 ? 3 : 4) * RT;
    for (int u = blockIdx.x; u < nbig + nsmall; u += gridDim.x) {
        if (u < nbig) {
            const int which = u / (RT * 8), r = u % (RT * 8), rt = r / 8, ct = r % 8;
            const int mi = which == 0 ? 0 : (which == 1 ? 2 : 3);
            MixLoader al{H, mix + mi * D};
            EpStoreBf16 ep{which == 0 ? R : (which == 1 ? Kb : V), D, 0};
            gemm_tile_small(lds, al, wsm(p, j, WJ_RKV) + (size_t)which * D * D, D, D, rt * 128, ct * 128, ep);
        } else {
            const int v = u - nbig, which = v / RT, rt = v % RT;
            const int mi = which == 0 ? 1 : (which == 1 ? 4 : (which == 2 ? 5 : 3));
            MixLoader al{H, mix + mi * D};
            const bf16_t* Bt = which == 0 ? wsm(p, j, WJ_W1) : which == 1 ? wsm(p, j, WJ_A1) : which == 2 ? wsm(p, j, WJ_G1) : ((const bf16_t*)(p.ws + OFF_WSM) + W_V1);
            EpStoreBf16 ep{LD + (size_t)which * NT * 128, 128, which == 0 ? 1 : (which == 2 ? 2 : 0)};
            gemm_tile_small(lds, al, Bt, D, D, rt * 128, 0, ep);
        }
    }
}

__device__ void phase_rwkv_up(const Params& p, int j, char* lds) {
    bf16_t* LD = (bf16_t*)(p.ws + OFF_LD);
    bf16_t* LW = (bf16_t*)(p.ws + OFF_LW); bf16_t* AD = (bf16_t*)(p.ws + OFF_AD); bf16_t* G = (bf16_t*)(p.ws + OFF_G);
    constexpr int RT = NT / 128;
    const int per = RT * 8, ntot = (j == 0 ? 5 : 6) * per;
    for (int u = blockIdx.x; u < ntot; u += gridDim.x) {
        const int which = u / per, r = u % per, rt = r / 8, ct = r % 8;
        if (which < 2) {
            const int d = which;
            PlainLoader al{LD + d * 64, 128};
            EpDecay ep{LW + (size_t)d * NT * D, p.in[10] + ((size_t)j * 2 + d) * D};
            gemm_tile_small(lds, al, wsm(p, j, WJ_W2) + (size_t)d * D * 64, 64, 64, rt * 128, ct * 128, ep);
        } else if (which < 4) {
            const int d = which - 2;
            PlainLoader al{LD + (size_t)NT * 128 + d * 64, 128};
            EpSigBias ep{AD + (size_t)d * NT * D, p.in[13] + ((size_t)j * 2 + d) * D};
            gemm_tile_small(lds, al, wsm(p, j, WJ_A2) + (size_t)d * D * 64, 64, 64, rt * 128, ct * 128, ep);
        } else if (which == 4) {
            PlainLoader al{LD + (size_t)2 * NT * 128, 128};
            EpStoreBf16 ep{G, D, 0};
            gemm_tile_small(lds, al, wsm(p, j, WJ_G2), 128, 128, rt * 128, ct * 128, ep);
        } else {
            PlainLoader al{LD + (size_t)3 * NT * 128, 128};
            EpVres ep{(bf16_t*)(p.ws + OFF_VF), (const bf16_t*)(p.ws + OFF_Y), p.in[16]};
            gemm_tile_small(lds, al, (const bf16_t*)(p.ws + OFF_WSM) + W_V2, 64, 64, rt * 128, ct * 128, ep);
        }
    }
}

__device__ void phase_rwkv_prep(const Params& p, int j) {
    const bf16_t* R = (const bf16_t*)(p.ws + OFF_R); const bf16_t* Kb = (const bf16_t*)(p.ws + OFF_K);
    const bf16_t* AD = (const bf16_t*)(p.ws + OFF_AD);
    bf16_t* KK = (bf16_t*)(p.ws + OFF_H); float* BON = (float*)(p.ws + OFF_BON);
    const float* k_k = p.in[21] + (size_t)j * D; const float* k_a = p.in[22] + (size_t)j * D; const float* r_k = p.in[23] + (size_t)j * D;
    const int lane = threadIdx.x & 63, wid = threadIdx.x >> 6, c0 = lane * 16;
    float kkw[16], kaw[16], rkw[16];
#pragma unroll
    for (int i = 0; i < 16; ++i) { kkw[i] = k_k[c0 + i]; kaw[i] = k_a[c0 + i]; rkw[i] = r_k[c0 + i]; }
    for (int row = blockIdx.x * 8 + wid; row < NT; row += gridDim.x * 8) {
        const size_t o = (size_t)row * D + c0;
        u32x4 kv[2], rv[2], a0[2], a1[2];
#pragma unroll
        for (int i = 0; i < 2; ++i) {
            kv[i] = *(const u32x4*)(Kb + o + i * 8); rv[i] = *(const u32x4*)(R + o + i * 8);
            a0[i] = *(const u32x4*)(AD + o + i * 8); a1[i] = *(const u32x4*)(AD + (size_t)NT * D + o + i * 8);
        }
        float kk[16]; float n2 = 0.f, bon = 0.f;
#pragma unroll
        for (int i = 0; i < 16; ++i) {
            const unsigned kw = kv[i >> 3][(i >> 1) & 3], rw = rv[i >> 3][(i >> 1) & 3], aw0 = a0[i >> 3][(i >> 1) & 3], aw1 = a1[i >> 3][(i >> 1) & 3];
            const float k = (i & 1) ? bfhi(kw) : bflo(kw), r = (i & 1) ? bfhi(rw) : bflo(rw);
            const float am = 0.5f * (((i & 1) ? bfhi(aw0) : bflo(aw0)) + ((i & 1) ? bfhi(aw1) : bflo(aw1)));
            kk[i] = k * kkw[i]; n2 += kk[i] * kk[i];
            bon += r * (k * (1.f + (am - 1.f) * kaw[i])) * rkw[i];
        }
        n2 += __shfl_xor(n2, 1, 64); n2 += __shfl_xor(n2, 2, 64);
        bon += __shfl_xor(bon, 1, 64); bon += __shfl_xor(bon, 2, 64);
        const float inv = 1.f / fmaxf(sqrtf(n2), 1e-12f);
        u32x4 ov[2];
#pragma unroll
        for (int i = 0; i < 8; ++i) ov[i >> 2][i & 3] = pack2(kk[2 * i] * inv, kk[2 * i + 1] * inv);
        *(u32x4*)(KK + o) = ov[0]; *(u32x4*)(KK + o + 8) = ov[1];
        if ((lane & 3) == 0) BON[(size_t)row * 16 + (lane >> 2)] = bon;
    }
}

__device__ void phase_rwkv_scan(const Params& p, int j, char* lds) {
    const bf16_t* R = (const bf16_t*)(p.ws + OFF_R); const bf16_t* Kb = (const bf16_t*)(p.ws + OFF_K);
    const bf16_t* V = (const bf16_t*)(p.ws + OFF_VF); const bf16_t* KK = (const bf16_t*)(p.ws + OFF_H);
    const bf16_t* LW = (const bf16_t*)(p.ws + OFF_LW); const bf16_t* AD = (const bf16_t*)(p.ws + OFF_AD);
    bf16_t* Y = (bf16_t*)(p.ws + OFF_Y);
    float* ex = (float*)lds;
    const int tid = threadIdx.x, lane = tid & 63, wid = tid >> 6, cl = wid >> 2, q = wid & 3, jj = lane & 15;
    for (int cp = blockIdx.x; cp < 256; cp += gridDim.x) {
        const int chain = cp * 2 + cl, d = chain & 1, bh = chain >> 1, b = bh >> 4, h = bh & 15;
        const int col = h * 64 + q * 16 + jj, vcol = h * 64 + lane;
        const float ka = p.in[22][(size_t)j * D + col];
        const bf16_t* LWd = LW + (size_t)d * NT * D; const bf16_t* ADd = AD + (size_t)d * NT * D;
        bf16_t* Yd = Y + (size_t)d * NT * D;
        float S[16];
#pragma unroll
        for (int i = 0; i < 16; ++i) S[i] = 0.f;
        float py = 0.f; int prev_row = -1; int buf = 0;
        auto row_of = [&](int s) -> int {
            if (s < TC) { const int t = d ? (TC - 1 - s) : s; return NLAT + b * TC + t; }
            const int tl = s - TC; const int t = d ? (TL - 1 - tl) : tl; return b * TL + t;
        };
        bf16_t nr[4], nkk[4], nk[4], nlw[4], na[4], nv[4];
#pragma unroll
        for (int g = 0; g < 4; ++g) {
            const size_t o = (size_t)row_of(g) * D;
            nr[g] = R[o + col]; nkk[g] = KK[o + col]; nk[g] = Kb[o + col]; nlw[g] = LWd[o + col]; na[g] = ADd[o + col]; nv[g] = V[o + vcol];
        }
        constexpr int NSTEP = TC + TL;
        for (int s0 = 0; s0 < NSTEP; s0 += 4) {
            bf16_t cr[4], ckk[4], ck[4], clw[4], ca[4], cv[4];
#pragma unroll
            for (int g = 0; g < 4; ++g) { cr[g] = nr[g]; ckk[g] = nkk[g]; ck[g] = nk[g]; clw[g] = nlw[g]; ca[g] = na[g]; cv[g] = nv[g]; }
            if (s0 + 4 < NSTEP) {
#pragma unroll
                for (int g = 0; g < 4; ++g) {
                    const size_t o = (size_t)row_of(s0 + 4 + g) * D;
                    nr[g] = R[o + col]; nkk[g] = KK[o + col]; nk[g] = Kb[o + col]; nlw[g] = LWd[o + col]; na[g] = ADd[o + col]; nv[g] = V[o + vcol];
                }
            }
#pragma unroll
            for (int g = 0; g < 4; ++g) {
                const float rr = bf2f(cr[g]), kkv = bf2f(ckk[g]), kv = bf2f(ck[g]), av = bf2f(ca[g]), vv = bf2f(cv[g]);
                const float dec = __expf(bf2f(clw[g])), bb = kkv * av, kd = kv * (1.f + (av - 1.f) * ka);
                float psa = 0.f;
#pragma unroll
                for (int i = 0; i < 16; ++i) psa += S[i] * rdlane(kkv, i);
                float* e = ex + ((buf * 2 + cl) * 4 + q) * 128;
                e[lane] = psa; e[64 + lane] = py;
                __syncthreads();
                const float* eb = ex + (buf * 2 + cl) * 4 * 128;
                const float sa = -(eb[lane] + eb[128 + lane] + eb[256 + lane] + eb[384 + lane]);
                if (q == 0 && prev_row >= 0) {
                    const float yv = eb[64 + lane] + eb[192 + lane] + eb[320 + lane] + eb[448 + lane];
                    Yd[(size_t)prev_row * D + vcol] = f2bf(yv);
                }
                py = 0.f;
#pragma unroll
                for (int i = 0; i < 16; ++i) {
                    const float w = rdlane(dec, i), b_ = rdlane(bb, i), k_ = rdlane(kd, i), r_ = rdlane(rr, i);
                    S[i] = S[i] * w + sa * b_ + vv * k_;
                    py += S[i] * r_;
                }
                prev_row = row_of(s0 + g);
                buf ^= 1;
            }
        }
        {
            float* e = ex + ((buf * 2 + cl) * 4 + q) * 128;
            e[64 + lane] = py;
            __syncthreads();
            const float* eb = ex + (buf * 2 + cl) * 4 * 128;
            if (q == 0) {
                const float yv = eb[64 + lane] + eb[192 + lane] + eb[320 + lane] + eb[448 + lane];
                Yd[(size_t)prev_row * D + vcol] = f2bf(yv);
            }
            __syncthreads();
        }
    }
}

__device__ void phase_rwkv_out(const Params& p, int j) {
    const bf16_t* Y = (const bf16_t*)(p.ws + OFF_Y); const bf16_t* V = (const bf16_t*)(p.ws + OFF_VF); const bf16_t* G = (const bf16_t*)(p.ws + OFF_G);
    const float* BON = (const float*)(p.ws + OFF_BON);
    bf16_t* YO = (bf16_t*)(p.ws + OFF_LW);
    const float* lnw = p.in[24] + (size_t)j * D; const float* lnb = p.in[25] + (size_t)j * D;
    const int lane = threadIdx.x & 63, wid = threadIdx.x >> 6, c0 = lane * 16;
    for (int row = blockIdx.x * 8 + wid; row < NT; row += gridDim.x * 8) {
        const size_t o = (size_t)row * D + c0;
        u32x4 y0[2], y1[2], vv[2], gg[2];
#pragma unroll
        for (int i = 0; i < 2; ++i) {
            y0[i] = *(const u32x4*)(Y + o + i * 8); y1[i] = *(const u32x4*)(Y + (size_t)NT * D + o + i * 8);
            vv[i] = *(const u32x4*)(V + o + i * 8); gg[i] = *(const u32x4*)(G + o + i * 8);
        }
        float ov[16]; float s1 = 0.f;
#pragma unroll
        for (int i = 0; i < 16; ++i) {
            const unsigned w0 = y0[i >> 3][(i >> 1) & 3], w1 = y1[i >> 3][(i >> 1) & 3];
            ov[i] = ((i & 1) ? bfhi(w0) : bflo(w0)) + ((i & 1) ? bfhi(w1) : bflo(w1));
            s1 += ov[i];
        }
        s1 += __shfl_xor(s1, 1, 64); s1 += __shfl_xor(s1, 2, 64);
        const float mu = s1 * (1.f / 64.f);
        float s2 = 0.f;
#pragma unroll
        for (int i = 0; i < 16; ++i) { const float dd = ov[i] - mu; s2 += dd * dd; }
        s2 += __shfl_xor(s2, 1, 64); s2 += __shfl_xor(s2, 2, 64);
        const float rs = rsqrtf(s2 * (1.f / 64.f) + 64e-5f);
        const float bon = BON[(size_t)row * 16 + (lane >> 2)];
        float res[16];
#pragma unroll
        for (int i = 0; i < 16; ++i) {
            const unsigned vw = vv[i >> 3][(i >> 1) & 3], gw = gg[i >> 3][(i >> 1) & 3];
            const float v = (i & 1) ? bfhi(vw) : bflo(vw), g = (i & 1) ? bfhi(gw) : bflo(gw);
            res[i] = ((ov[i] - mu) * rs * lnw[c0 + i] + lnb[c0 + i] + bon * v) * g;
        }
        u32x4 w[2];
#pragma unroll
        for (int i = 0; i < 8; ++i) w[i >> 2][i & 3] = pack2(res[2 * i], res[2 * i + 1]);
        *(u32x4*)(YO + o) = w[0]; *(u32x4*)(YO + o + 8) = w[1];
    }
}

__device__ void phase_rwkv_wo(const Params& p, int l, int j, char* lds) {
    PlainLoader al{(const bf16_t*)(p.ws + OFF_LW), D};
    EpResidual ep{(float*)(p.ws + OFF_X), (const float*)(p.ws + OFF_MOD) + (size_t)l * 17 * MODW + 2 * D, nullptr};
    constexpr int RT = NT / 128;
    for (int u = blockIdx.x; u < RT * 8; u += gridDim.x) gemm_tile_small(lds, al, wsm(p, j, WJ_WO), D, D, (u / 8) * 128, (u % 8) * 128, ep);
}

__device__ void phase_pool_dlt(const Params& p, int nrows) {
    const bf16_t* H = (const bf16_t*)(p.ws + OFF_H); bf16_t* DL = (bf16_t*)(p.ws + OFF_DLT);
    const int lane = threadIdx.x & 63, wid = threadIdx.x >> 6;
    for (int row = blockIdx.x * 8 + wid; row < nrows; row += gridDim.x * 8) {
        int t, T, base;
        if (row < NLAT) { t = row & (TL - 1); T = TL; base = row - t; } else { t = (row - NLAT) & (TC - 1); T = TC; base = row - t; }
#pragma unroll
        for (int g = 0; g < 4; ++g) {
            const int half = 1 << g;
            const int lo = max(t - half, 0), hi = min(t + half, T);
            const int c = g * 256 + lane * 4;
            float s0 = 0.f, s1 = 0.f, s2 = 0.f, s3 = 0.f;
            for (int tt = lo; tt < hi; ++tt) {
                const u32x2 w = *(const u32x2*)(H + (size_t)(base + tt) * D + c);
                s0 += bflo(w[0]); s1 += bfhi(w[0]); s2 += bflo(w[1]); s3 += bfhi(w[1]);
            }
            const float inv = 1.f / (float)(hi - lo);
            const u32x2 hw = *(const u32x2*)(H + (size_t)row * D + c);
            u32x2 o; o[0] = pack2(s0 * inv - bflo(hw[0]), s1 * inv - bfhi(hw[0])); o[1] = pack2(s2 * inv - bflo(hw[1]), s3 * inv - bfhi(hw[1]));
            *(u32x2*)(DL + (size_t)row * D + c) = o;
        }
    }
}
__device__ void phase_pool_gemm(const Params& p, int l, int j, int nrows, char* lds) {
    EpResidual ep{(float*)(p.ws + OFF_X), (const float*)(p.ws + OFF_MOD) + (size_t)l * 17 * MODW + 2 * D, p.in[28] + (size_t)j * D};
    const int RT = nrows / 128;
    for (int u = blockIdx.x; u < RT * 8; u += gridDim.x) {
        const int rt = u / 8, ct = u % 8, g = ct >> 1;
        PlainLoader al{(const bf16_t*)(p.ws + OFF_DLT) + g * 256, D};
        const bf16_t* Bt = wsm(p, j, WJ_POOL) + (size_t)g * 65536 - (size_t)(g * 256) * 256;
        gemm_tile_small(lds, al, Bt, 256, 256, rt * 128, ct * 128, ep);
    }
}

__device__ void phase_topk(const Params& p, bool with_ctx, char* lds) {
    const float* AFF = (const float*)(p.ws + OFF_AFF);
    int* IDX = (int*)(p.ws + OFF_IDX); float* GTV = (float*)(p.ws + OFF_GTV); short* SLT = (short*)(p.ws + OFF_SLT);
    unsigned* keys = (unsigned*)lds;
    unsigned* hist = keys + 4096;
    unsigned* scan = hist + 256;
    unsigned* bc = scan + 512;
    const int tid = threadIdx.x;
    const int nunits = with_ctx ? 512 : 256;
    for (int u = blockIdx.x; u < nunits; u += gridDim.x) {
        const bool lat = u < 256;
        const int uu = lat ? u : u - 256, b = uu >> 4, e = uu & 15;
        const int n = lat ? TL : TC, kq = lat ? CAPL : CAPC, per = lat ? 8 : 1;
        const int rowbase = lat ? b * TL : NLAT + b * TC;
        for (int i = tid; i < n; i += NTHREADS) keys[i] = __float_as_uint(AFF[(size_t)(rowbase + i) * 16 + e]);
        __syncthreads();
        unsigned prefix = 0u, mask = 0u; int kth = kq;
        for (int ps = 0; ps < 4; ++ps) {
            const int shift = 24 - 8 * ps;
            if (tid < 256) hist[tid] = 0u;
            __syncthreads();
            for (int i = tid; i < n; i += NTHREADS) { const unsigned k = keys[i]; if ((k & mask) == prefix) atomicAdd(&hist[(k >> shift) & 255u], 1u); }
            __syncthreads();
            if (tid == 0) {
                int cum = 0, dg = 0, rem = kth;
                for (int bin = 255; bin >= 0; --bin) { const int hc = (int)hist[bin]; if (cum + hc >= kth) { dg = bin; rem = kth - cum; break; } cum += hc; }
                bc[0] = (unsigned)dg; bc[1] = (unsigned)rem;
            }
            __syncthreads();
            prefix |= bc[0] << shift; mask |= 255u << shift; kth = (int)bc[1];
            __syncthreads();
        }
        const unsigned Tk = prefix; const int need_eq = kth;
        const int t0 = tid * per; const bool act = t0 < n;
        int cgt = 0, ceq = 0;
        if (act) for (int i = 0; i < per; ++i) { const unsigned k = keys[t0 + i]; cgt += k > Tk; ceq += k == Tk; }
        scan[tid] = ((unsigned)cgt << 16) | (unsigned)ceq;
        __syncthreads();
        if (tid == 0) { unsigned run = 0; for (int i = 0; i < NTHREADS; ++i) { const unsigned v = scan[i]; scan[i] = run; run += v; } }
        __syncthreads();
        const unsigned ex = scan[tid];
        int gt_before = (int)(ex >> 16), eq_before = (int)(ex & 0xffffu);
        if (act) {
            for (int i = 0; i < per; ++i) {
                const int t = t0 + i; const unsigned k = keys[t];
                int slot = -1;
                if (k > Tk) { slot = gt_before + min(eq_before, need_eq); ++gt_before; }
                else if (k == Tk) { if (eq_before < need_eq) slot = gt_before + eq_before; ++eq_before; }
                SLT[(size_t)(rowbase + t) * 16 + e] = (short)slot;
                if (slot >= 0) {
                    const int srow = lat ? (b * 16 + e) * CAPL + slot : NSLOT_LAT + (e * 16 + b) * CAPC + slot;
                    IDX[srow] = rowbase + t; GTV[srow] = __uint_as_float(k);
                }
            }
        }
        __syncthreads();
    }
}
__device__ void phase_gather(const Params& p, bool with_ctx) {
    const bf16_t* H = (const bf16_t*)(p.ws + OFF_H); bf16_t* XG = (bf16_t*)(p.ws + OFF_XG);
    const int* IDX = (const int*)(p.ws + OFF_IDX);
    const int lane = threadIdx.x & 63, wid = threadIdx.x >> 6;
    const int nrows = with_ctx ? NSLOT : NSLOT_LAT;
    for (int r = blockIdx.x * 8 + wid; r < nrows; r += gridDim.x * 8) {
        const int src = IDX[r];
        const u32x4 a = *(const u32x4*)(H + (size_t)src * D + lane * 8), b = *(const u32x4*)(H + (size_t)src * D + 512 + lane * 8);
        *(u32x4*)(XG + (size_t)r * D + lane * 8) = a; *(u32x4*)(XG + (size_t)r * D + 512 + lane * 8) = b;
    }
}
__device__ __forceinline__ int expert_of_slotrow(int r) { return r < NSLOT_LAT ? ((r >> 9) & 15) : ((r - NSLOT_LAT) >> 9); }
__device__ void phase_moe_up(const Params& p, bool with_ctx, char* lds) {
    PlainLoader al{(const bf16_t*)(p.ws + OFF_XG), D};
    EpSwiglu ep{(bf16_t*)(p.ws + OFF_HID)};
    const bf16_t* W13 = (const bf16_t*)(p.ws + OFF_WM) + WM_13;
    const int RT = (with_ctx ? NSLOT : NSLOT_LAT) / 128;
    for (int u = blockIdx.x; u < RT * 32; u += gridDim.x) {
        const int rt = u / 32, ct = u % 32, e = expert_of_slotrow(rt * 128);
        gemm_tile_small(lds, al, W13 + (size_t)e * 4096 * 1024, D, D, rt * 128, ct * 128, ep);
    }
}
__device__ void phase_moe_down(const Params& p, bool with_ctx, char* lds) {
    PlainLoader al{(const bf16_t*)(p.ws + OFF_HID), FF};
    EpGateRow ep{(bf16_t*)(p.ws + OFF_YS), (const float*)(p.ws + OFF_GTV)};
    const bf16_t* W2 = (const bf16_t*)(p.ws + OFF_WM) + WM_2;
    const int RT = (with_ctx ? NSLOT : NSLOT_LAT) / 128;
    for (int u = blockIdx.x; u < RT * 8; u += gridDim.x) {
        const int rt = u / 8, ct = u % 8, e = expert_of_slotrow(rt * 128);
        gemm_tile_small(lds, al, W2 + (size_t)e * 1024 * 2048, FF, FF, rt * 128, ct * 128, ep);
    }
}
__device__ void phase_moe_combine(const Params& p, int l, int nrows) {
    float* X = (float*)(p.ws + OFF_X); const bf16_t* YS = (const bf16_t*)(p.ws + OFF_YS); const short* SLT = (const short*)(p.ws + OFF_SLT);
    const float* MOD = (const float*)(p.ws + OFF_MOD) + (size_t)l * 17 * MODW + 5 * D;
    const int lane = threadIdx.x & 63, wid = threadIdx.x >> 6;
    for (int row = blockIdx.x * 8 + wid; row < nrows; row += gridDim.x * 8) {
        float acc[16];
#pragma unroll
        for (int i = 0; i < 16; ++i) acc[i] = 0.f;
        const bool lat = row < NLAT;
        const int b = lat ? (row >> 12) : ((row - NLAT) >> 8);
        for (int e = 0; e < 16; ++e) {
            const int s = SLT[(size_t)row * 16 + e];
            if (s >= 0) {
                const int srow = lat ? (b * 16 + e) * CAPL + s : NSLOT_LAT + (e * 16 + b) * CAPC + s;
                const u32x4 a = *(const u32x4*)(YS + (size_t)srow * D + lane * 8), c = *(const u32x4*)(YS + (size_t)srow * D + 512 + lane * 8);
#pragma unroll
                for (int i = 0; i < 4; ++i) { acc[2 * i] += bflo(a[i]); acc[2 * i + 1] += bfhi(a[i]); acc[8 + 2 * i] += bflo(c[i]); acc[8 + 2 * i + 1] += bfhi(c[i]); }
            }
        }
        const float* gt = MOD + (size_t)mod_row(row) * MODW;
#pragma unroll
        for (int hh = 0; hh < 2; ++hh) {
            float* xp = X + (size_t)row * D + hh * 512 + lane * 8;
            const float* gp = gt + hh * 512 + lane * 8;
            float4 x0 = *(float4*)xp, x1 = *(float4*)(xp + 4);
            const float4 g0 = *(const float4*)gp, g1 = *(const float4*)(gp + 4);
            x0.x += g0.x * acc[hh * 8 + 0]; x0.y += g0.y * acc[hh * 8 + 1]; x0.z += g0.z * acc[hh * 8 + 2]; x0.w += g0.w * acc[hh * 8 + 3];
            x1.x += g1.x * acc[hh * 8 + 4]; x1.y += g1.y * acc[hh * 8 + 5]; x1.z += g1.z * acc[hh * 8 + 6]; x1.w += g1.w * acc[hh * 8 + 7];
            *(float4*)xp = x0; *(float4*)(xp + 4) = x1;
        }
    }
}
__device__ void phase_final(const Params& p) {
    const float* X = (const float*)(p.ws + OFF_X); const float* g = p.in[33];
    const int lane = threadIdx.x & 63, wid = threadIdx.x >> 6;
    for (int row = blockIdx.x * 8 + wid; row < NLAT; row += gridDim.x * 8) {
        const float* xr = X + (size_t)row * D;
        float4 v[4]; float ss = 0.f;
#pragma unroll
        for (int i = 0; i < 4; ++i) { v[i] = *(const float4*)(xr + i * 256 + lane * 4); ss += v[i].x * v[i].x + v[i].y * v[i].y + v[i].z * v[i].z + v[i].w * v[i].w; }
        ss = wave_sum(ss);
        const float rs = rsqrtf(ss * (1.f / D) + 1e-6f);
#pragma unroll
        for (int i = 0; i < 4; ++i) {
            const float4 gg = *(const float4*)(g + i * 256 + lane * 4);
            float4 o; o.x = v[i].x * rs * gg.x; o.y = v[i].y * rs * gg.y; o.z = v[i].z * rs * gg.z; o.w = v[i].w * rs * gg.w;
            *(float4*)(p.out + (size_t)row * D + i * 256 + lane * 4) = o;
        }
    }
}

enum { PH_CVT = 0, PH_ADA, PH_NORM1, PH_NORM2, PH_PROJ, PH_UP, PH_PREP, PH_SCAN, PH_OUT, PH_WO, PH_DLT, PH_POOLG, PH_TOPK, PH_GATHER, PH_MUP, PH_MDOWN, PH_COMB, PH_FINAL };
template <int PH>
__global__ void __launch_bounds__(NTHREADS) k_phase(Params p, int a0, int a1, int a2) {
    extern __shared__ __attribute__((aligned(16))) char lds[];
    if (PH == PH_CVT) phase_cvt(p, a0, a1, lds);
    if (PH == PH_ADA) phase_ada(p, lds);
    if (PH == PH_NORM1) phase_norm<false>(p, a0, 0, a1, lds);
    if (PH == PH_NORM2) phase_norm<true>(p, a0, 1, a1, lds);
    if (PH == PH_PROJ) phase_rwkv_proj(p, a0, lds);
    if (PH == PH_UP) phase_rwkv_up(p, a0, lds);
    if (PH == PH_PREP) phase_rwkv_prep(p, a0);
    if (PH == PH_SCAN) phase_rwkv_scan(p, a0, lds);
    if (PH == PH_OUT) phase_rwkv_out(p, a0);
    if (PH == PH_WO) phase_rwkv_wo(p, a0, a1, lds);
    if (PH == PH_DLT) phase_pool_dlt(p, a0);
    if (PH == PH_POOLG) phase_pool_gemm(p, a0, a1, a2, lds);
    if (PH == PH_TOPK) phase_topk(p, a0 != 0, lds);
    if (PH == PH_GATHER) phase_gather(p, a0 != 0);
    if (PH == PH_MUP) phase_moe_up(p, a0 != 0, lds);
    if (PH == PH_MDOWN) phase_moe_down(p, a0 != 0, lds);
    if (PH == PH_COMB) phase_moe_combine(p, a0, a1);
    if (PH == PH_FINAL) phase_final(p);
}

constexpr int LDS_BYTES = 112 * 1024;
template <int PH>
static void launch(const Params& p, int a0, int a1, int a2, hipStream_t s) {
    static bool init = false;
    if (!init) { hipFuncSetAttribute((const void*)k_phase<PH>, hipFuncAttributeMaxDynamicSharedMemorySize, LDS_BYTES); init = true; }
    hipLaunchKernelGGL(k_phase<PH>, dim3(256), dim3(NTHREADS), LDS_BYTES, s, p, a0, a1, a2);
}

static int add_job(Params& p, int n, const float* src, bf16_t* dst, int K, int N, int src_ld, int dst_ld, int n_mul, int n_off, int Kpad, int Npad, int nbatch, long src_bs, long dst_bs) {
    CvtJob& J = p.jobs[n];
    J.src = src; J.dst = dst; J.src_bs = src_bs; J.dst_bs = dst_bs; J.K = K; J.N = N; J.src_ld = src_ld; J.dst_ld = dst_ld; J.n_mul = n_mul; J.n_off = n_off;
    J.Kpad = Kpad; J.Npad = Npad; J.nbatch = nbatch; J.tiles = nbatch * (Kpad / 64) * (Npad / 64);
    return n + 1;
}

extern "C" void kernel_launch(void* const* d_in, const int* in_sizes, int n_in, void* d_out, int out_size, void* d_ws, size_t ws_size, hipStream_t stream) {
    Params p;
    memset(&p, 0, sizeof(p));
    for (int i = 0; i < 34; ++i) p.in[i] = (const float*)d_in[i];
    p.out = (float*)d_out; p.ws = (char*)d_ws;
    if (ws_size < WS_NEED) { fprintf(stderr, "workspace too small: %zu < %zu\n", ws_size, (size_t)WS_NEED); }
    bf16_t* wsm_ = (bf16_t*)(p.ws + OFF_WSM);
    bf16_t* wm_ = (bf16_t*)(p.ws + OFF_WM);
    int nj = 0;
    for (int j = 0; j < 2; ++j) {
        bf16_t* base = wsm_ + (size_t)j * WJ_SIZE;
        nj = add_job(p, nj, p.in[9] + (size_t)j * 3 * D * D, base + WJ_RKV, D, D, D, D, 1, 0, D, D, 3, (long)D * D, (long)D * D);
        nj = add_job(p, nj, p.in[26] + (size_t)j * D * D, base + WJ_WO, D, D, D, D, 1, 0, D, D, 1, 0, 0);
        nj = add_job(p, nj, p.in[11] + (size_t)j * 2 * D * 64, base + WJ_W1, D, 64, 64, D, 1, 0, D, 64, 2, (long)D * 64, (long)64 * D);
        nj = add_job(p, nj, p.in[14] + (size_t)j * 2 * D * 64, base + WJ_A1, D, 64, 64, D, 1, 0, D, 64, 2, (long)D * 64, (long)64 * D);
        nj = add_job(p, nj, p.in[19] + (size_t)j * D * 128, base + WJ_G1, D, 128, 128, D, 1, 0, D, 128, 1, 0, 0);
        nj = add_job(p, nj, p.in[12] + (size_t)j * 2 * 64 * D, base + WJ_W2, 64, D, D, 64, 1, 0, 64, D, 2, (long)64 * D, (long)D * 64);
        nj = add_job(p, nj, p.in[15] + (size_t)j * 2 * 64 * D, base + WJ_A2, 64, D, D, 64, 1, 0, 64, D, 2, (long)64 * D, (long)D * 64);
        nj = add_job(p, nj, p.in[20] + (size_t)j * 128 * D, base + WJ_G2, 128, D, D, 128, 1, 0, 128, D, 1, 0, 0);
        nj = add_job(p, nj, p.in[27] + (size_t)j * 4 * 256 * 256, base + WJ_POOL, 256, 256, 256, 256, 1, 0, 256, 256, 4, 65536, 65536);
    }
    nj = add_job(p, nj, p.in[17], wsm_ + W_V1, D, 32, 32, D, 1, 0, D, 128, 1, 0, 0);
    nj = add_job(p, nj, p.in[18], wsm_ + W_V2, 32, D, D, 64, 1, 0, 64, D, 1, 0, 0);
    const int nsmall = nj;
    for (int l = 0; l < 4; ++l) {
        nj = add_job(p, nj, p.in[30] + (size_t)l * 16 * D * FF, wm_ + WM_13, D, FF, FF, D, 2, 0, D, FF, 16, (long)D * FF, (long)4096 * 1024);
        nj = add_job(p, nj, p.in[31] + (size_t)l * 16 * D * FF, wm_ + WM_13, D, FF, FF, D, 2, 1, D, FF, 16, (long)D * FF, (long)4096 * 1024);
        nj = add_job(p, nj, p.in[32] + (size_t)l * 16 * FF * D, wm_ + WM_2, FF, D, D, FF, 1, 0, FF, D, 16, (long)FF * D, (long)D * FF);
    }
    hipMemcpyAsync(p.ws + OFF_X, d_in[0], (size_t)NLAT * D * 4, hipMemcpyDeviceToDevice, stream);
    hipMemcpyAsync(p.ws + OFF_X + (size_t)NLAT * D * 4, d_in[2], (size_t)NCTX * D * 4, hipMemcpyDeviceToDevice, stream);
    launch<PH_CVT>(p, 0, nsmall, 0, stream);
    launch<PH_ADA>(p, 0, 0, 0, stream);
    for (int l = 0; l < 4; ++l) {
        const bool last = l == 3, rw = (l % 2) == 0; const int j = l / 2;
        const bool need_ctx = !last || rw;
        const int nrows = need_ctx ? NT : NLAT;
        launch<PH_NORM1>(p, l, nrows, 0, stream);
        if (rw) {
            launch<PH_PROJ>(p, j, 0, 0, stream);
            launch<PH_UP>(p, j, 0, 0, stream);
            launch<PH_PREP>(p, j, 0, 0, stream);
            launch<PH_SCAN>(p, j, 0, 0, stream);
            launch<PH_OUT>(p, j, 0, 0, stream);
            launch<PH_WO>(p, l, j, 0, stream);
        } else {
            launch<PH_DLT>(p, nrows, 0, 0, stream);
            launch<PH_POOLG>(p, l, j, nrows, stream);
        }
        const int mrows = last ? NLAT : NT;
        launch<PH_CVT>(p, nsmall + 3 * l, nsmall + 3 * l + 3, 0, stream);
        launch<PH_NORM2>(p, l, mrows, 0, stream);
        launch<PH_TOPK>(p, last ? 0 : 1, 0, 0, stream);
        launch<PH_GATHER>(p, last ? 0 : 1, 0, 0, stream);
        launch<PH_MUP>(p, last ? 0 : 1, 0, 0, stream);
        launch<PH_MDOWN>(p, last ? 0 : 1, 0, 0, stream);
        launch<PH_COMB>(p, l, mrows, 0, stream);
    }
    launch<PH_FINAL>(p, 0, 0, 0, stream);
}
```

```cpp
#include <hip/hip_runtime.h>
#include <stdint.h>
#include <stdio.h>
#include <string.h>
#ifndef MK_MULTI
#define MK_MULTI 0
#endif

typedef unsigned short bf16_t;
typedef short bf16x8 __attribute__((ext_vector_type(8)));
typedef float f32x4 __attribute__((ext_vector_type(4)));
typedef unsigned u32x4 __attribute__((ext_vector_type(4)));
typedef unsigned u32x2 __attribute__((ext_vector_type(2)));

constexpr int D = 1024, NB = 16, TL = 4096, TC = 256;
constexpr int NLAT = NB * TL, NCTX = NB * TC, NT = NLAT + NCTX;
constexpr int NE = 16, FF = 2048, CAPL = 512, CAPC = 32;
constexpr int NSLOT_LAT = NB * NE * CAPL, NSLOT_CTX = NB * NE * CAPC, NSLOT = NSLOT_LAT + NSLOT_CTX;
constexpr int MODW = 6 * D;
constexpr int NTHREADS = 512;

constexpr size_t MiB = 1ull << 20;
constexpr size_t U = (size_t)NT * D * 2;
constexpr size_t OFF_BAR = 0;
constexpr size_t OFF_MOD = 64 * 1024;
constexpr size_t OFF_WSM = 2 * MiB;
constexpr size_t OFF_AFF = 26 * MiB;
constexpr size_t OFF_BON = 31 * MiB;
constexpr size_t OFF_IDX = 36 * MiB;
constexpr size_t OFF_GTV = 37 * MiB;
constexpr size_t OFF_SLT = 38 * MiB;
constexpr size_t OFF_BIG = 48 * MiB;
constexpr size_t OFF_X = OFF_BIG;
constexpr size_t OFF_VF = OFF_BIG + 2 * U;
constexpr size_t OFF_H = OFF_BIG + 3 * U;
constexpr size_t OFF_R = OFF_BIG + 4 * U;
constexpr size_t OFF_K = OFF_BIG + 5 * U;
constexpr size_t OFF_LD = OFF_BIG + 6 * U;
constexpr size_t OFF_LW = OFF_BIG + 6 * U + U / 2;
constexpr size_t OFF_AD = OFF_BIG + 8 * U + U / 2;
constexpr size_t OFF_Y = OFF_BIG + 10 * U + U / 2;
constexpr size_t OFF_G = OFF_BIG + 12 * U + U / 2;
constexpr size_t OFF_WM = OFF_BIG + 4 * U;
constexpr size_t OFF_XG = OFF_BIG + 5 * U + U / 2;
constexpr size_t OFF_HID = OFF_BIG + 7 * U + U / 2;
constexpr size_t OFF_YS = OFF_BIG + 11 * U + U / 2;
constexpr size_t OFF_DLT = OFF_BIG + 4 * U;
constexpr size_t WS_NEED = OFF_BIG + 13 * U + U / 2;

constexpr size_t WJ_RKV = 0;
constexpr size_t WJ_WO = 3 * 1048576;
constexpr size_t WJ_W1 = 4 * 1048576;
constexpr size_t WJ_A1 = WJ_W1 + 131072;
constexpr size_t WJ_G1 = WJ_A1 + 131072;
constexpr size_t WJ_W2 = WJ_G1 + 131072;
constexpr size_t WJ_A2 = WJ_W2 + 131072;
constexpr size_t WJ_G2 = WJ_A2 + 131072;
constexpr size_t WJ_POOL = WJ_G2 + 131072;
constexpr size_t WJ_SIZE = WJ_POOL + 262144;
constexpr size_t W_V1 = 2 * WJ_SIZE;
constexpr size_t W_V2 = W_V1 + 131072;
constexpr size_t WM_13 = 0;
constexpr size_t WM_2 = (size_t)16 * 4096 * 1024;

struct CvtJob {
    const float* src; bf16_t* dst;
    long src_bs, dst_bs;
    int K, N, src_ld, dst_ld, n_mul, n_off, Kpad, Npad, nbatch, tiles;
};
constexpr int NJOBS = 32;
struct Params {
    const float* in[34];
    float* out;
    char* ws;
    CvtJob jobs[NJOBS];
};

__device__ __forceinline__ float bf2f(bf16_t v) { return __uint_as_float(((unsigned)v) << 16); }
__device__ __forceinline__ bf16_t f2bf(float f) { unsigned u = __float_as_uint(f); u += 0x7FFFu + ((u >> 16) & 1u); return (bf16_t)(u >> 16); }
__device__ __forceinline__ unsigned pack2(float lo, float hi) { return (unsigned)f2bf(lo) | ((unsigned)f2bf(hi) << 16); }
__device__ __forceinline__ float bflo(unsigned w) { return __uint_as_float(w << 16); }
__device__ __forceinline__ float bfhi(unsigned w) { return __uint_as_float(w & 0xffff0000u); }
__device__ __forceinline__ float wave_sum(float v) {
#pragma unroll
    for (int m = 32; m >= 1; m >>= 1) v += __shfl_xor(v, m, 64);
    return v;
}
__device__ __forceinline__ float sigmoidf_(float x) { return 1.f / (1.f + __expf(-x)); }
__device__ __forceinline__ float siluf_(float x) { return x / (1.f + __expf(-x)); }
__device__ __forceinline__ float rdlane(float v, int l) { return __uint_as_float(__builtin_amdgcn_readlane(__float_as_uint(v), l)); }

__device__ __forceinline__ int tidx() { int t = threadIdx.x; asm volatile("" : "+v"(t)); return t; }

__device__ __forceinline__ int mod_row(int row) { return row < NLAT ? (row >> 12) : 16; }

__device__ void phase_cvt(const Params& p, int jlo, int jhi, char* lds) {
    float* tile = (float*)lds;
    const int tid = tidx();
    int total = 0;
    for (int j = jlo; j < jhi; ++j) total += p.jobs[j].tiles;
    for (int u = blockIdx.x; u < total; u += gridDim.x) {
        int j = jlo, uu = u;
        while (uu >= p.jobs[j].tiles) { uu -= p.jobs[j].tiles; ++j; }
        const CvtJob& J = p.jobs[j];
        const int tk = J.Kpad / 64, tn = J.Npad / 64;
        const int bt = uu / (tk * tn), r = uu % (tk * tn), kt = r / tn, nt = r % tn;
        const float* src = J.src + (size_t)bt * J.src_bs;
        bf16_t* dst = J.dst + (size_t)bt * J.dst_bs;
#pragma unroll
        for (int ps = 0; ps < 2; ++ps) {
            const int kl = ps * 32 + (tid >> 4), k = kt * 64 + kl, n = nt * 64 + (tid & 15) * 4;
            float v0 = 0.f, v1 = 0.f, v2 = 0.f, v3 = 0.f;
            if (k < J.K) {
                const float* s = src + (size_t)k * J.src_ld + n;
                if (n + 3 < J.N) { const float4 t = *(const float4*)s; v0 = t.x; v1 = t.y; v2 = t.z; v3 = t.w; }
                else { if (n < J.N) v0 = s[0]; if (n + 1 < J.N) v1 = s[1]; if (n + 2 < J.N) v2 = s[2]; }
            }
            float* tp = tile + kl * 65 + (tid & 15) * 4;
            tp[0] = v0; tp[1] = v1; tp[2] = v2; tp[3] = v3;
        }
        __syncthreads();
        {
            const int n = tid >> 3, kc = tid & 7;
            u32x4 o;
            o[0] = pack2(tile[(kc * 8 + 0) * 65 + n], tile[(kc * 8 + 1) * 65 + n]);
            o[1] = pack2(tile[(kc * 8 + 2) * 65 + n], tile[(kc * 8 + 3) * 65 + n]);
            o[2] = pack2(tile[(kc * 8 + 4) * 65 + n], tile[(kc * 8 + 5) * 65 + n]);
            o[3] = pack2(tile[(kc * 8 + 6) * 65 + n], tile[(kc * 8 + 7) * 65 + n]);
            *(u32x4*)(dst + ((size_t)(nt * 64 + n) * J.n_mul + J.n_off) * J.dst_ld + kt * 64 + kc * 8) = o;
        }
        __syncthreads();
    }
}

__device__ void phase_ada(const Params& p, char* lds) {
    float* sc = (float*)lds;
    float* red = sc + 17 * 1024;
    const int tid = tidx();
    const float* c = p.in[1]; const float* cctx = p.in[3];
    for (int i = tid; i < 17 * 1024; i += NTHREADS) {
        const float v = i < 16 * 1024 ? c[i] : cctx[i - 16 * 1024];
        sc[i] = siluf_(v);
    }
    __syncthreads();
    float* MOD = (float*)(p.ws + OFF_MOD);
    const int col = tid & 63, ks = tid >> 6;
    for (int u = blockIdx.x; u < 4 * 96; u += gridDim.x) {
        const int l = u / 96, n = (u % 96) * 64 + col;
        const float* w = p.in[4] + (size_t)l * D * MODW + n;
        float acc[17];
#pragma unroll
        for (int r = 0; r < 17; ++r) acc[r] = 0.f;
        for (int k = ks * 128; k < ks * 128 + 128; ++k) {
            const float wv = w[(size_t)k * MODW];
#pragma unroll
            for (int r = 0; r < 17; ++r) acc[r] += sc[r * 1024 + k] * wv;
        }
#pragma unroll
        for (int r = 0; r < 17; ++r) red[(ks * 17 + r) * 64 + col] = acc[r];
        __syncthreads();
        for (int i = tid; i < 17 * 64; i += NTHREADS) {
            const int r = i >> 6, cc = i & 63;
            float s = 0.f;
#pragma unroll
            for (int q = 0; q < 8; ++q) s += red[(q * 17 + r) * 64 + cc];
            const int nn = (u % 96) * 64 + cc;
            MOD[((size_t)l * 17 + r) * MODW + nn] = s + p.in[5][(size_t)l * MODW + nn];
        }
        __syncthreads();
    }
}

template <bool ROUTER>
__device__ void phase_norm(const Params& p, int l, int which, int nrows, char* lds) {
    const float* X = (const float*)(p.ws + OFF_X);
    bf16_t* H = (bf16_t*)(p.ws + OFF_H);
    const float* MOD = (const float*)(p.ws + OFF_MOD) + (size_t)l * 17 * MODW;
    const float* g = (which == 0 ? p.in[6] : p.in[7]) + (size_t)l * D;
    float* AFF = (float*)(p.ws + OFF_AFF);
    float* rt = (float*)lds;
    const int tid = tidx(), lane = tid & 63, wid = tid >> 6;
    if (ROUTER) {
        const float* rsrc = p.in[29] + (size_t)l * D * NE;
        for (int i = tid; i < D * NE; i += NTHREADS) rt[i] = rsrc[i];
        __syncthreads();
    }
    const int so = which == 0 ? 0 : 3 * D, co = which == 0 ? D : 4 * D;
    for (int row = blockIdx.x * 8 + wid; row < nrows; row += gridDim.x * 8) {
        const float* xr = X + (size_t)row * D;
        const float* mr = MOD + (size_t)mod_row(row) * MODW;
        float ss = 0.f;
#pragma unroll
        for (int i = 0; i < 4; ++i) { const float4 t = *(const float4*)(xr + i * 256 + lane * 4); ss += t.x * t.x + t.y * t.y + t.z * t.z + t.w * t.w; }
        ss = wave_sum(ss);
        const float rs = rsqrtf(ss * (1.f / D) + 1e-6f);
        float lg[16];
        if (ROUTER) {
#pragma unroll
            for (int e = 0; e < 16; ++e) lg[e] = 0.f;
        }
#pragma unroll 1
        for (int i = 0; i < 4; ++i) {
            const int c0 = i * 256 + lane * 4;
            const float4 xv = *(const float4*)(xr + c0);
            const float4 gg = *(const float4*)(g + c0), sh = *(const float4*)(mr + so + c0), sl = *(const float4*)(mr + co + c0);
            float h0 = xv.x * rs * gg.x * (1.f + sl.x) + sh.x;
            float h1 = xv.y * rs * gg.y * (1.f + sl.y) + sh.y;
            float h2 = xv.z * rs * gg.z * (1.f + sl.z) + sh.z;
            float h3 = xv.w * rs * gg.w * (1.f + sl.w) + sh.w;
            u32x2 o; o[0] = pack2(h0, h1); o[1] = pack2(h2, h3);
            *(u32x2*)(H + (size_t)row * D + c0) = o;
            if (ROUTER) {
                const float4* r0 = (const float4*)(rt + c0 * 16);
#pragma unroll
                for (int e4 = 0; e4 < 4; ++e4) {
                    const float4 a = r0[e4], b = r0[4 + e4], c = r0[8 + e4], d = r0[12 + e4];
                    lg[e4 * 4 + 0] += h0 * a.x + h1 * b.x + h2 * c.x + h3 * d.x;
                    lg[e4 * 4 + 1] += h0 * a.y + h1 * b.y + h2 * c.y + h3 * d.y;
                    lg[e4 * 4 + 2] += h0 * a.z + h1 * b.z + h2 * c.z + h3 * d.z;
                    lg[e4 * 4 + 3] += h0 * a.w + h1 * b.w + h2 * c.w + h3 * d.w;
                }
            }
        }
        if (ROUTER) {
            float mx = -1e30f;
#pragma unroll
            for (int e = 0; e < 16; ++e) { lg[e] = wave_sum(lg[e]); mx = fmaxf(mx, lg[e]); }
            float sum = 0.f;
#pragma unroll
            for (int e = 0; e < 16; ++e) { lg[e] = __expf(lg[e] - mx); sum += lg[e]; }
            const float inv = 1.f / sum;
            float mine = 0.f;
#pragma unroll
            for (int e = 0; e < 16; ++e) mine = (lane == e) ? lg[e] * inv : mine;
            if (lane < 16) AFF[(size_t)row * 16 + lane] = mine;
        }
    }
}

constexpr int GS_LD = 72;
template <class AL, class EP>
__device__ __forceinline__ void gemm_tile_small(char* lds, const AL& al, const bf16_t* __restrict__ Bt, int ldb, int K, int row0, int col0, const EP& ep) {
    bf16_t* As = (bf16_t*)lds; bf16_t* Bs = As + 128 * GS_LD;
    const int tid = tidx(), lane = tid & 63, wid = tid >> 6, wr = wid >> 1, wc = wid & 1, fr = lane & 15, fq = lane >> 4;
    const int lr = tid >> 3, kc = tid & 7;
    f32x4 acc[2][4];
#pragma unroll
    for (int m = 0; m < 2; ++m)
#pragma unroll
        for (int n = 0; n < 4; ++n) acc[m][n] = (f32x4){0.f, 0.f, 0.f, 0.f};
    bf16x8 ra0 = al(row0 + lr, kc * 8), ra1 = al(row0 + lr + 64, kc * 8);
    bf16x8 rb0 = *(const bf16x8*)(Bt + (size_t)(col0 + lr) * ldb + kc * 8), rb1 = *(const bf16x8*)(Bt + (size_t)(col0 + lr + 64) * ldb + kc * 8);
    for (int k0 = 0; k0 < K; k0 += 64) {
        __syncthreads();
        *(bf16x8*)(As + lr * GS_LD + kc * 8) = ra0; *(bf16x8*)(As + (lr + 64) * GS_LD + kc * 8) = ra1;
        *(bf16x8*)(Bs + lr * GS_LD + kc * 8) = rb0; *(bf16x8*)(Bs + (lr + 64) * GS_LD + kc * 8) = rb1;
        __syncthreads();
        if (k0 + 64 < K) {
            const int kn = k0 + 64 + kc * 8;
            ra0 = al(row0 + lr, kn); ra1 = al(row0 + lr + 64, kn);
            rb0 = *(const bf16x8*)(Bt + (size_t)(col0 + lr) * ldb + kn); rb1 = *(const bf16x8*)(Bt + (size_t)(col0 + lr + 64) * ldb + kn);
        }
#pragma unroll
        for (int ks = 0; ks < 2; ++ks) {
            bf16x8 a[2], b[4];
#pragma unroll
            for (int m = 0; m < 2; ++m) a[m] = *(const bf16x8*)(As + (wr * 32 + m * 16 + fr) * GS_LD + ks * 32 + fq * 8);
#pragma unroll
            for (int n = 0; n < 4; ++n) b[n] = *(const bf16x8*)(Bs + (wc * 64 + n * 16 + fr) * GS_LD + ks * 32 + fq * 8);
#pragma unroll
            for (int m = 0; m < 2; ++m)
#pragma unroll
                for (int n = 0; n < 4; ++n) acc[m][n] = __builtin_amdgcn_mfma_f32_16x16x32_bf16(b[n], a[m], acc[m][n], 0, 0, 0);
        }
    }
#pragma unroll
    for (int m = 0; m < 2; ++m)
#pragma unroll
        for (int n = 0; n < 4; ++n) ep(row0 + wr * 32 + m * 16 + fr, col0 + wc * 64 + n * 16 + fq * 4, acc[m][n]);
}

struct PlainLoader {
    const bf16_t* A; int lda;
    __device__ __forceinline__ bf16x8 operator()(int row, int k) const { return *(const bf16x8*)(A + (size_t)row * lda + k); }
};
struct MixLoader {
    const bf16_t* H; const float* mix;
    __device__ __forceinline__ bf16x8 operator()(int row, int k) const {
        int nb;
        if (row < NLAT) {
            const int t = row & (TL - 1), gc = t & 63, gr = t >> 6, q = k >> 8;
            if (q == 0) nb = gc > 0 ? row - 1 : -1;
            else if (q == 1) nb = gc < 63 ? row + 1 : -1;
            else if (q == 2) nb = gr > 0 ? row - 64 : -1;
            else nb = gr < 63 ? row + 64 : -1;
        } else {
            const int t = (row - NLAT) & (TC - 1);
            if (k < 512) nb = t > 0 ? row - 1 : -1;
            else nb = t < TC - 1 ? row + 1 : -1;
        }
        const u32x4 h = *(const u32x4*)(H + (size_t)row * D + k);
        u32x4 s = (u32x4){0u, 0u, 0u, 0u};
        if (nb >= 0) s = *(const u32x4*)(H + (size_t)nb * D + k);
        const float4 m0 = *(const float4*)(mix + k), m1 = *(const float4*)(mix + k + 4);
        u32x4 o;
        { float a = bflo(h[0]), b = bfhi(h[0]); o[0] = pack2(a + (bflo(s[0]) - a) * m0.x, b + (bfhi(s[0]) - b) * m0.y); }
        { float a = bflo(h[1]), b = bfhi(h[1]); o[1] = pack2(a + (bflo(s[1]) - a) * m0.z, b + (bfhi(s[1]) - b) * m0.w); }
        { float a = bflo(h[2]), b = bfhi(h[2]); o[2] = pack2(a + (bflo(s[2]) - a) * m1.x, b + (bfhi(s[2]) - b) * m1.y); }
        { float a = bflo(h[3]), b = bfhi(h[3]); o[3] = pack2(a + (bflo(s[3]) - a) * m1.z, b + (bfhi(s[3]) - b) * m1.w); }
        return __builtin_bit_cast(bf16x8, o);
    }
};

struct EpStoreBf16 {
    bf16_t* O; int ldo; int act;
    __device__ __forceinline__ void operator()(int row, int col, f32x4 v) const {
        if (act == 1) { v[0] = tanhf(v[0]); v[1] = tanhf(v[1]); v[2] = tanhf(v[2]); v[3] = tanhf(v[3]); }
        else if (act == 2) { v[0] = sigmoidf_(v[0]); v[1] = sigmoidf_(v[1]); v[2] = sigmoidf_(v[2]); v[3] = sigmoidf_(v[3]); }
        u32x2 o; o[0] = pack2(v[0], v[1]); o[1] = pack2(v[2], v[3]);
        *(u32x2*)(O + (size_t)row * ldo + col) = o;
    }
};
struct EpDecay {
    bf16_t* O; const float* w0;
    __device__ __forceinline__ void operator()(int row, int col, f32x4 v) const {
        const float4 b = *(const float4*)(w0 + col);
        u32x2 o;
        o[0] = pack2(-0.6065306597f * sigmoidf_(v[0] + b.x), -0.6065306597f * sigmoidf_(v[1] + b.y));
        o[1] = pack2(-0.6065306597f * sigmoidf_(v[2] + b.z), -0.6065306597f * sigmoidf_(v[3] + b.w));
        *(u32x2*)(O + (size_t)row * D + col) = o;
    }
};
struct EpSigBias {
    bf16_t* O; const float* b0;
    __device__ __forceinline__ void operator()(int row, int col, f32x4 v) const {
        const float4 b = *(const float4*)(b0 + col);
        u32x2 o;
        o[0] = pack2(sigmoidf_(v[0] + b.x), sigmoidf_(v[1] + b.y));
        o[1] = pack2(sigmoidf_(v[2] + b.z), sigmoidf_(v[3] + b.w));
        *(u32x2*)(O + (size_t)row * D + col) = o;
    }
};
struct EpVres {
    bf16_t* VF; const bf16_t* VRAW; const float* v0;
    __device__ __forceinline__ void operator()(int row, int col, f32x4 a) const {
        const float4 b = *(const float4*)(v0 + col);
        const u32x2 vr = *(const u32x2*)(VRAW + (size_t)row * D + col);
        const u32x2 vf = *(const u32x2*)(VF + (size_t)row * D + col);
        float x0 = bflo(vr[0]), x1 = bfhi(vr[0]), x2 = bflo(vr[1]), x3 = bfhi(vr[1]);
        float f0 = bflo(vf[0]), f1 = bfhi(vf[0]), f2 = bflo(vf[1]), f3 = bfhi(vf[1]);
        u32x2 o;
        o[0] = pack2(x0 + (f0 - x0) * sigmoidf_(a[0] + b.x), x1 + (f1 - x1) * sigmoidf_(a[1] + b.y));
        o[1] = pack2(x2 + (f2 - x2) * sigmoidf_(a[2] + b.z), x3 + (f3 - x3) * sigmoidf_(a[3] + b.w));
        *(u32x2*)(VF + (size_t)row * D + col) = o;
    }
};
struct EpResidual {
    float* X; const float* gate; const float* cscale;
    __device__ __forceinline__ void operator()(int row, int col, f32x4 a) const {
        const float4 gt = *(const float4*)(gate + (size_t)mod_row(row) * MODW + col);
        float4 cs = make_float4(1.f, 1.f, 1.f, 1.f);
        if (cscale) cs = *(const float4*)(cscale + col);
        float4* xp = (float4*)(X + (size_t)row * D + col);
        float4 x = *xp;
        x.x += gt.x * a[0] * cs.x; x.y += gt.y * a[1] * cs.y; x.z += gt.z * a[2] * cs.z; x.w += gt.w * a[3] * cs.w;
        *xp = x;
    }
};
struct EpSwiglu {
    bf16_t* HID;
    __device__ __forceinline__ void operator()(int row, int col, f32x4 a) const {
        *(unsigned*)(HID + (size_t)row * FF + (col >> 1)) = pack2(siluf_(a[0]) * a[1], siluf_(a[2]) * a[3]);
    }
};
struct EpGateRow {
    bf16_t* YS; const float* gatev;
    __device__ __forceinline__ void operator()(int row, int col, f32x4 a) const {
        const float gt = gatev[row];
        u32x2 o; o[0] = pack2(a[0] * gt, a[1] * gt); o[1] = pack2(a[2] * gt, a[3] * gt);
        *(u32x2*)(YS + (size_t)row * D + col) = o;
    }
};

__device__ __forceinline__ const bf16_t* wsm(const Params& p, int j, size_t off) { return (const bf16_t*)(p.ws + OFF_WSM) + (size_t)j * WJ_SIZE + off; }

__device__ void phase_rwkv_proj(const Params& p, int j, char* lds) {
    const bf16_t* H = (const bf16_t*)(p.ws + OFF_H);
    const float* mix = p.in[8] + (size_t)j * 6 * D;
    bf16_t* R = (bf16_t*)(p.ws + OFF_R); bf16_t* Kb = (bf16_t*)(p.ws + OFF_K);
    bf16_t* V = (bf16_t*)(p.ws + (j == 0 ? OFF_VF : OFF_Y));
    bf16_t* LD = (bf16_t*)(p.ws + OFF_LD);
    constexpr int RT = NT / 128;
    const int nbig = 3 * RT * 8, nsmall = (j == 0 ? 3 : 4) * RT;
    for (int u = blockIdx.x; u < nbig + nsmall; u += gridDim.x) {
        if (u < nbig) {
            const int which = u / (RT * 8), r = u % (RT * 8), rt = r / 8, ct = r % 8;
            const int mi = which == 0 ? 0 : (which == 1 ? 2 : 3);
            MixLoader al{H, mix + mi * D};
            EpStoreBf16 ep{which == 0 ? R : (which == 1 ? Kb : V), D, 0};
            gemm_tile_small(lds, al, wsm(p, j, WJ_RKV) + (size_t)which * D * D, D, D, rt * 128, ct * 128, ep);
        } else {
            const int v = u - nbig, which = v / RT, rt = v % RT;
            const int mi = which == 0 ? 1 : (which == 1 ? 4 : (which == 2 ? 5 : 3));
            MixLoader al{H, mix + mi * D};
            const bf16_t* Bt = which == 0 ? wsm(p, j, WJ_W1) : which == 1 ? wsm(p, j, WJ_A1) : which == 2 ? wsm(p, j, WJ_G1) : ((const bf16_t*)(p.ws + OFF_WSM) + W_V1);
            EpStoreBf16 ep{LD + (size_t)which * NT * 128, 128, which == 0 ? 1 : (which == 2 ? 2 : 0)};
            gemm_tile_small(lds, al, Bt, D, D, rt * 128, 0, ep);
        }
    }
}

__device__ void phase_rwkv_up(const Params& p, int j, char* lds) {
    bf16_t* LD = (bf16_t*)(p.ws + OFF_LD);
    bf16_t* LW = (bf16_t*)(p.ws + OFF_LW); bf16_t* AD = (bf16_t*)(p.ws + OFF_AD); bf16_t* G = (bf16_t*)(p.ws + OFF_G);
    constexpr int RT = NT / 128;
    const int per = RT * 8, ntot = (j == 0 ? 5 : 6) * per;
    for (int u = blockIdx.x; u < ntot; u += gridDim.x) {
        const int which = u / per, r = u % per, rt = r / 8, ct = r % 8;
        if (which < 2) {
            const int d = which;
            PlainLoader al{LD + d * 64, 128};
            EpDecay ep{LW + (size_t)d * NT * D, p.in[10] + ((size_t)j * 2 + d) * D};
            gemm_tile_small(lds, al, wsm(p, j, WJ_W2) + (size_t)d * D * 64, 64, 64, rt * 128, ct * 128, ep);
        } else if (which < 4) {
            const int d = which - 2;
            PlainLoader al{LD + (size_t)NT * 128 + d * 64, 128};
            EpSigBias ep{AD + (size_t)d * NT * D, p.in[13] + ((size_t)j * 2 + d) * D};
            gemm_tile_small(lds, al, wsm(p, j, WJ_A2) + (size_t)d * D * 64, 64, 64, rt * 128, ct * 128, ep);
        } else if (which == 4) {
            PlainLoader al{LD + (size_t)2 * NT * 128, 128};
            EpStoreBf16 ep{G, D, 0};
            gemm_tile_small(lds, al, wsm(p, j, WJ_G2), 128, 128, rt * 128, ct * 128, ep);
        } else {
            PlainLoader al{LD + (size_t)3 * NT * 128, 128};
            EpVres ep{(bf16_t*)(p.ws + OFF_VF), (const bf16_t*)(p.ws + OFF_Y), p.in[16]};
            gemm_tile_small(lds, al, (const bf16_t*)(p.ws + OFF_WSM) + W_V2, 64, 64, rt * 128, ct * 128, ep);
        }
    }
}

__device__ void phase_rwkv_prep(const Params& p, int j) {
    const bf16_t* R = (const bf16_t*)(p.ws + OFF_R); const bf16_t* Kb = (const bf16_t*)(p.ws + OFF_K);
    const bf16_t* AD = (const bf16_t*)(p.ws + OFF_AD);
    bf16_t* KK = (bf16_t*)(p.ws + OFF_H); float* BON = (float*)(p.ws + OFF_BON);
    const float* k_k = p.in[21] + (size_t)j * D; const float* k_a = p.in[22] + (size_t)j * D; const float* r_k = p.in[23] + (size_t)j * D;
    const int tid_ = tidx(), lane = tid_ & 63, wid = tid_ >> 6, c0 = lane * 16;
    float kkw[16], kaw[16], rkw[16];
#pragma unroll
    for (int i = 0; i < 16; ++i) { kkw[i] = k_k[c0 + i]; kaw[i] = k_a[c0 + i]; rkw[i] = r_k[c0 + i]; }
    for (int row = blockIdx.x * 8 + wid; row < NT; row += gridDim.x * 8) {
        const size_t o = (size_t)row * D + c0;
        u32x4 kv[2], rv[2], a0[2], a1[2];
#pragma unroll
        for (int i = 0; i < 2; ++i) {
            kv[i] = *(const u32x4*)(Kb + o + i * 8); rv[i] = *(const u32x4*)(R + o + i * 8);
            a0[i] = *(const u32x4*)(AD + o + i * 8); a1[i] = *(const u32x4*)(AD + (size_t)NT * D + o + i * 8);
        }
        float kk[16]; float n2 = 0.f, bon = 0.f;
#pragma unroll
        for (int i = 0; i < 16; ++i) {
            const unsigned kw = kv[i >> 3][(i >> 1) & 3], rw = rv[i >> 3][(i >> 1) & 3], aw0 = a0[i >> 3][(i >> 1) & 3], aw1 = a1[i >> 3][(i >> 1) & 3];
            const float k = (i & 1) ? bfhi(kw) : bflo(kw), r = (i & 1) ? bfhi(rw) : bflo(rw);
            const float am = 0.5f * (((i & 1) ? bfhi(aw0) : bflo(aw0)) + ((i & 1) ? bfhi(aw1) : bflo(aw1)));
            kk[i] = k * kkw[i]; n2 += kk[i] * kk[i];
            bon += r * (k * (1.f + (am - 1.f) * kaw[i])) * rkw[i];
        }
        n2 += __shfl_xor(n2, 1, 64); n2 += __shfl_xor(n2, 2, 64);
        bon += __shfl_xor(bon, 1, 64); bon += __shfl_xor(bon, 2, 64);
        const float inv = 1.f / fmaxf(sqrtf(n2), 1e-12f);
        u32x4 ov[2];
#pragma unroll
        for (int i = 0; i < 8; ++i) ov[i >> 2][i & 3] = pack2(kk[2 * i] * inv, kk[2 * i + 1] * inv);
        *(u32x4*)(KK + o) = ov[0]; *(u32x4*)(KK + o + 8) = ov[1];
        if ((lane & 3) == 0) BON[(size_t)row * 16 + (lane >> 2)] = bon;
    }
}

__device__ void phase_rwkv_scan(const Params& p, int j, char* lds) {
    const bf16_t* R = (const bf16_t*)(p.ws + OFF_R); const bf16_t* Kb = (const bf16_t*)(p.ws + OFF_K);
    const bf16_t* V = (const bf16_t*)(p.ws + OFF_VF); const bf16_t* KK = (const bf16_t*)(p.ws + OFF_H);
    const bf16_t* LW = (const bf16_t*)(p.ws + OFF_LW); const bf16_t* AD = (const bf16_t*)(p.ws + OFF_AD);
    bf16_t* Y = (bf16_t*)(p.ws + OFF_Y);
    float* ex = (float*)lds;
    const int tid = tidx(), lane = tid & 63, wid = tid >> 6, cl = wid >> 2, q = wid & 3, jj = lane & 15;
    for (int cp = blockIdx.x; cp < 256; cp += gridDim.x) {
        const int chain = cp * 2 + cl, d = chain & 1, bh = chain >> 1, b = bh >> 4, h = bh & 15;
        const int col = h * 64 + q * 16 + jj, vcol = h * 64 + lane;
        const float ka = p.in[22][(size_t)j * D + col];
        const bf16_t* LWd = LW + (size_t)d * NT * D; const bf16_t* ADd = AD + (size_t)d * NT * D;
        bf16_t* Yd = Y + (size_t)d * NT * D;
        float S[16];
#pragma unroll
        for (int i = 0; i < 16; ++i) S[i] = 0.f;
        float py = 0.f; int prev_row = -1; int buf = 0;
        auto row_of = [&](int s) -> int {
            if (s < TC) { const int t = d ? (TC - 1 - s) : s; return NLAT + b * TC + t; }
            const int tl = s - TC; const int t = d ? (TL - 1 - tl) : tl; return b * TL + t;
        };
        bf16_t nr[4], nkk[4], nk[4], nlw[4], na[4], nv[4];
#pragma unroll
        for (int g = 0; g < 4; ++g) {
            const size_t o = (size_t)row_of(g) * D;
            nr[g] = R[o + col]; nkk[g] = KK[o + col]; nk[g] = Kb[o + col]; nlw[g] = LWd[o + col]; na[g] = ADd[o + col]; nv[g] = V[o + vcol];
        }
        constexpr int NSTEP = TC + TL;
        for (int s0 = 0; s0 < NSTEP; s0 += 4) {
            bf16_t cr[4], ckk[4], ck[4], clw[4], ca[4], cv[4];
#pragma unroll
            for (int g = 0; g < 4; ++g) { cr[g] = nr[g]; ckk[g] = nkk[g]; ck[g] = nk[g]; clw[g] = nlw[g]; ca[g] = na[g]; cv[g] = nv[g]; }
            if (s0 + 4 < NSTEP) {
#pragma unroll
                for (int g = 0; g < 4; ++g) {
                    const size_t o = (size_t)row_of(s0 + 4 + g) * D;
                    nr[g] = R[o + col]; nkk[g] = KK[o + col]; nk[g] = Kb[o + col]; nlw[g] = LWd[o + col]; na[g] = ADd[o + col]; nv[g] = V[o + vcol];
                }
            }
#pragma unroll
            for (int g = 0; g < 4; ++g) {
                const float rr = bf2f(cr[g]), kkv = bf2f(ckk[g]), kv = bf2f(ck[g]), av = bf2f(ca[g]), vv = bf2f(cv[g]);
                const float dec = __expf(bf2f(clw[g])), bb = kkv * av, kd = kv * (1.f + (av - 1.f) * ka);
                float psa = 0.f;
#pragma unroll
                for (int i = 0; i < 16; ++i) psa += S[i] * rdlane(kkv, i);
                float* e = ex + ((buf * 2 + cl) * 4 + q) * 128;
                e[lane] = psa; e[64 + lane] = py;
                __syncthreads();
                const float* eb = ex + (buf * 2 + cl) * 4 * 128;
                const float sa = -(eb[lane] + eb[128 + lane] + eb[256 + lane] + eb[384 + lane]);
                if (q == 0 && prev_row >= 0) {
                    const float yv = eb[64 + lane] + eb[192 + lane] + eb[320 + lane] + eb[448 + lane];
                    Yd[(size_t)prev_row * D + vcol] = f2bf(yv);
                }
                py = 0.f;
#pragma unroll
                for (int i = 0; i < 16; ++i) {
                    const float w = rdlane(dec, i), b_ = rdlane(bb, i), k_ = rdlane(kd, i), r_ = rdlane(rr, i);
                    S[i] = S[i] * w + sa * b_ + vv * k_;
                    py += S[i] * r_;
                }
                prev_row = row_of(s0 + g);
                buf ^= 1;
            }
        }
        {
            float* e = ex + ((buf * 2 + cl) * 4 + q) * 128;
            e[64 + lane] = py;
            __syncthreads();
            const float* eb = ex + (buf * 2 + cl) * 4 * 128;
            if (q == 0) {
                const float yv = eb[64 + lane] + eb[192 + lane] + eb[320 + lane] + eb[448 + lane];
                Yd[(size_t)prev_row * D + vcol] = f2bf(yv);
            }
            __syncthreads();
        }
    }
}

__device__ void phase_rwkv_out(const Params& p, int j) {
    const bf16_t* Y = (const bf16_t*)(p.ws + OFF_Y); const bf16_t* V = (const bf16_t*)(p.ws + OFF_VF); const bf16_t* G = (const bf16_t*)(p.ws + OFF_G);
    const float* BON = (const float*)(p.ws + OFF_BON);
    bf16_t* YO = (bf16_t*)(p.ws + OFF_LW);
    const float* lnw = p.in[24] + (size_t)j * D; const float* lnb = p.in[25] + (size_t)j * D;
    const int tid_ = tidx(), lane = tid_ & 63, wid = tid_ >> 6, c0 = lane * 16;
    for (int row = blockIdx.x * 8 + wid; row < NT; row += gridDim.x * 8) {
        const size_t o = (size_t)row * D + c0;
        u32x4 y0[2], y1[2], vv[2], gg[2];
#pragma unroll
        for (int i = 0; i < 2; ++i) {
            y0[i] = *(const u32x4*)(Y + o + i * 8); y1[i] = *(const u32x4*)(Y + (size_t)NT * D + o + i * 8);
            vv[i] = *(const u32x4*)(V + o + i * 8); gg[i] = *(const u32x4*)(G + o + i * 8);
        }
        float ov[16]; float s1 = 0.f;
#pragma unroll
        for (int i = 0; i < 16; ++i) {
            const unsigned w0 = y0[i >> 3][(i >> 1) & 3], w1 = y1[i >> 3][(i >> 1) & 3];
            ov[i] = ((i & 1) ? bfhi(w0) : bflo(w0)) + ((i & 1) ? bfhi(w1) : bflo(w1));
            s1 += ov[i];
        }
        s1 += __shfl_xor(s1, 1, 64); s1 += __shfl_xor(s1, 2, 64);
        const float mu = s1 * (1.f / 64.f);
        float s2 = 0.f;
#pragma unroll
        for (int i = 0; i < 16; ++i) { const float dd = ov[i] - mu; s2 += dd * dd; }
        s2 += __shfl_xor(s2, 1, 64); s2 += __shfl_xor(s2, 2, 64);
        const float rs = rsqrtf(s2 * (1.f / 64.f) + 64e-5f);
        const float bon = BON[(size_t)row * 16 + (lane >> 2)];
        float res[16];
#pragma unroll
        for (int i = 0; i < 16; ++i) {
            const unsigned vw = vv[i >> 3][(i >> 1) & 3], gw = gg[i >> 3][(i >> 1) & 3];
            const float v = (i & 1) ? bfhi(vw) : bflo(vw), g = (i & 1) ? bfhi(gw) : bflo(gw);
            res[i] = ((ov[i] - mu) * rs * lnw[c0 + i] + lnb[c0 + i] + bon * v) * g;
        }
        u32x4 w[2];
#pragma unroll
        for (int i = 0; i < 8; ++i) w[i >> 2][i & 3] = pack2(res[2 * i], res[2 * i + 1]);
        *(u32x4*)(YO + o) = w[0]; *(u32x4*)(YO + o + 8) = w[1];
    }
}

__device__ void phase_rwkv_wo(const Params& p, int l, int j, char* lds) {
    PlainLoader al{(const bf16_t*)(p.ws + OFF_LW), D};
    EpResidual ep{(float*)(p.ws + OFF_X), (const float*)(p.ws + OFF_MOD) + (size_t)l * 17 * MODW + 2 * D, nullptr};
    constexpr int RT = NT / 128;
    for (int u = blockIdx.x; u < RT * 8; u += gridDim.x) gemm_tile_small(lds, al, wsm(p, j, WJ_WO), D, D, (u / 8) * 128, (u % 8) * 128, ep);
}

__device__ void phase_pool_dlt(const Params& p, int nrows) {
    const bf16_t* H = (const bf16_t*)(p.ws + OFF_H); bf16_t* DL = (bf16_t*)(p.ws + OFF_DLT);
    const int tid_ = tidx(), lane = tid_ & 63, wid = tid_ >> 6;
    for (int row = blockIdx.x * 8 + wid; row < nrows; row += gridDim.x * 8) {
        int t, T, base;
        if (row < NLAT) { t = row & (TL - 1); T = TL; base = row - t; } else { t = (row - NLAT) & (TC - 1); T = TC; base = row - t; }
#pragma unroll
        for (int g = 0; g < 4; ++g) {
            const int half = 1 << g;
            const int lo = max(t - half, 0), hi = min(t + half, T);
            const int c = g * 256 + lane * 4;
            float s0 = 0.f, s1 = 0.f, s2 = 0.f, s3 = 0.f;
            for (int tt = lo; tt < hi; ++tt) {
                const u32x2 w = *(const u32x2*)(H + (size_t)(base + tt) * D + c);
                s0 += bflo(w[0]); s1 += bfhi(w[0]); s2 += bflo(w[1]); s3 += bfhi(w[1]);
            }
            const float inv = 1.f / (float)(hi - lo);
            const u32x2 hw = *(const u32x2*)(H + (size_t)row * D + c);
            u32x2 o; o[0] = pack2(s0 * inv - bflo(hw[0]), s1 * inv - bfhi(hw[0])); o[1] = pack2(s2 * inv - bflo(hw[1]), s3 * inv - bfhi(hw[1]));
            *(u32x2*)(DL + (size_t)row * D + c) = o;
        }
    }
}
__device__ void phase_pool_gemm(const Params& p, int l, int j, int nrows, char* lds) {
    EpResidual ep{(float*)(p.ws + OFF_X), (const float*)(p.ws + OFF_MOD) + (size_t)l * 17 * MODW + 2 * D, p.in[28] + (size_t)j * D};
    const int RT = nrows / 128;
    for (int u = blockIdx.x; u < RT * 8; u += gridDim.x) {
        const int rt = u / 8, ct = u % 8, g = ct >> 1;
        PlainLoader al{(const bf16_t*)(p.ws + OFF_DLT) + g * 256, D};
        const bf16_t* Bt = wsm(p, j, WJ_POOL) + (size_t)g * 65536 - (size_t)(g * 256) * 256;
        gemm_tile_small(lds, al, Bt, 256, 256, rt * 128, ct * 128, ep);
    }
}

__device__ void phase_topk(const Params& p, bool with_ctx, char* lds) {
    const float* AFF = (const float*)(p.ws + OFF_AFF);
    int* IDX = (int*)(p.ws + OFF_IDX); float* GTV = (float*)(p.ws + OFF_GTV); short* SLT = (short*)(p.ws + OFF_SLT);
    unsigned* keys = (unsigned*)lds;
    unsigned* hist = keys + 4096;
    unsigned* scan = hist + 256;
    unsigned* bc = scan + 512;
    const int tid = tidx();
    const int nunits = with_ctx ? 512 : 256;
    for (int u = blockIdx.x; u < nunits; u += gridDim.x) {
        const bool lat = u < 256;
        const int uu = lat ? u : u - 256, b = uu >> 4, e = uu & 15;
        const int n = lat ? TL : TC, kq = lat ? CAPL : CAPC, per = lat ? 8 : 1;
        const int rowbase = lat ? b * TL : NLAT + b * TC;
        for (int i = tid; i < n; i += NTHREADS) keys[i] = __float_as_uint(AFF[(size_t)(rowbase + i) * 16 + e]);
        __syncthreads();
        unsigned prefix = 0u, mask = 0u; int kth = kq;
        for (int ps = 0; ps < 4; ++ps) {
            const int shift = 24 - 8 * ps;
            if (tid < 256) hist[tid] = 0u;
            __syncthreads();
            for (int i = tid; i < n; i += NTHREADS) { const unsigned k = keys[i]; if ((k & mask) == prefix) atomicAdd(&hist[(k >> shift) & 255u], 1u); }
            __syncthreads();
            if (tid == 0) {
                int cum = 0, dg = 0, rem = kth;
                for (int bin = 255; bin >= 0; --bin) { const int hc = (int)hist[bin]; if (cum + hc >= kth) { dg = bin; rem = kth - cum; break; } cum += hc; }
                bc[0] = (unsigned)dg; bc[1] = (unsigned)rem;
            }
            __syncthreads();
            prefix |= bc[0] << shift; mask |= 255u << shift; kth = (int)bc[1];
            __syncthreads();
        }
        const unsigned Tk = prefix; const int need_eq = kth;
        const int t0 = tid * per; const bool act = t0 < n;
        int cgt = 0, ceq = 0;
        if (act) for (int i = 0; i < per; ++i) { const unsigned k = keys[t0 + i]; cgt += k > Tk; ceq += k == Tk; }
        scan[tid] = ((unsigned)cgt << 16) | (unsigned)ceq;
        __syncthreads();
        if (tid == 0) { unsigned run = 0; for (int i = 0; i < NTHREADS; ++i) { const unsigned v = scan[i]; scan[i] = run; run += v; } }
        __syncthreads();
        const unsigned ex = scan[tid];
        int gt_before = (int)(ex >> 16), eq_before = (int)(ex & 0xffffu);
        if (act) {
            for (int i = 0; i < per; ++i) {
                const int t = t0 + i; const unsigned k = keys[t];
                int slot = -1;
                if (k > Tk) { slot = gt_before + min(eq_before, need_eq); ++gt_before; }
                else if (k == Tk) { if (eq_before < need_eq) slot = gt_before + eq_before; ++eq_before; }
                SLT[(size_t)(rowbase + t) * 16 + e] = (short)slot;
                if (slot >= 0) {
                    const int srow = lat ? (b * 16 + e) * CAPL + slot : NSLOT_LAT + (e * 16 + b) * CAPC + slot;
                    IDX[srow] = rowbase + t; GTV[srow] = __uint_as_float(k);
                }
            }
        }
        __syncthreads();
    }
}
__device__ void phase_gather(const Params& p, bool with_ctx) {
    const bf16_t* H = (const bf16_t*)(p.ws + OFF_H); bf16_t* XG = (bf16_t*)(p.ws + OFF_XG);
    const int* IDX = (const int*)(p.ws + OFF_IDX);
    const int tid_ = tidx(), lane = tid_ & 63, wid = tid_ >> 6;
    const int nrows = with_ctx ? NSLOT : NSLOT_LAT;
    for (int r = blockIdx.x * 8 + wid; r < nrows; r += gridDim.x * 8) {
        const int src = IDX[r];
        const u32x4 a = *(const u32x4*)(H + (size_t)src * D + lane * 8), b = *(const u32x4*)(H + (size_t)src * D + 512 + lane * 8);
        *(u32x4*)(XG + (size_t)r * D + lane * 8) = a; *(u32x4*)(XG + (size_t)r * D + 512 + lane * 8) = b;
    }
}
__device__ __forceinline__ int expert_of_slotrow(int r) { return r < NSLOT_LAT ? ((r >> 9) & 15) : ((r - NSLOT_LAT) >> 9); }
__device__ void phase_moe_up(const Params& p, bool with_ctx, char* lds) {
    PlainLoader al{(const bf16_t*)(p.ws + OFF_XG), D};
    EpSwiglu ep{(bf16_t*)(p.ws + OFF_HID)};
    const bf16_t* W13 = (const bf16_t*)(p.ws + OFF_WM) + WM_13;
    const int RT = (with_ctx ? NSLOT : NSLOT_LAT) / 128;
    for (int u = blockIdx.x; u < RT * 32; u += gridDim.x) {
        const int rt = u / 32, ct = u % 32, e = expert_of_slotrow(rt * 128);
        gemm_tile_small(lds, al, W13 + (size_t)e * 4096 * 1024, D, D, rt * 128, ct * 128, ep);
    }
}
__device__ void phase_moe_down(const Params& p, bool with_ctx, char* lds) {
    PlainLoader al{(const bf16_t*)(p.ws + OFF_HID), FF};
    EpGateRow ep{(bf16_t*)(p.ws + OFF_YS), (const float*)(p.ws + OFF_GTV)};
    const bf16_t* W2 = (const bf16_t*)(p.ws + OFF_WM) + WM_2;
    const int RT = (with_ctx ? NSLOT : NSLOT_LAT) / 128;
    for (int u = blockIdx.x; u < RT * 8; u += gridDim.x) {
        const int rt = u / 8, ct = u % 8, e = expert_of_slotrow(rt * 128);
        gemm_tile_small(lds, al, W2 + (size_t)e * 1024 * 2048, FF, FF, rt * 128, ct * 128, ep);
    }
}
__device__ void phase_moe_combine(const Params& p, int l, int nrows) {
    float* X = (float*)(p.ws + OFF_X); const bf16_t* YS = (const bf16_t*)(p.ws + OFF_YS); const short* SLT = (const short*)(p.ws + OFF_SLT);
    const float* MOD = (const float*)(p.ws + OFF_MOD) + (size_t)l * 17 * MODW + 5 * D;
    const int tid_ = tidx(), lane = tid_ & 63, wid = tid_ >> 6;
    for (int row = blockIdx.x * 8 + wid; row < nrows; row += gridDim.x * 8) {
        float acc[16];
#pragma unroll
        for (int i = 0; i < 16; ++i) acc[i] = 0.f;
        const bool lat = row < NLAT;
        const int b = lat ? (row >> 12) : ((row - NLAT) >> 8);
        for (int e = 0; e < 16; ++e) {
            const int s = SLT[(size_t)row * 16 + e];
            if (s >= 0) {
                const int srow = lat ? (b * 16 + e) * CAPL + s : NSLOT_LAT + (e * 16 + b) * CAPC + s;
                const u32x4 a = *(const u32x4*)(YS + (size_t)srow * D + lane * 8), c = *(const u32x4*)(YS + (size_t)srow * D + 512 + lane * 8);
#pragma unroll
                for (int i = 0; i < 4; ++i) { acc[2 * i] += bflo(a[i]); acc[2 * i + 1] += bfhi(a[i]); acc[8 + 2 * i] += bflo(c[i]); acc[8 + 2 * i + 1] += bfhi(c[i]); }
            }
        }
        const float* gt = MOD + (size_t)mod_row(row) * MODW;
#pragma unroll
        for (int hh = 0; hh < 2; ++hh) {
            float* xp = X + (size_t)row * D + hh * 512 + lane * 8;
            const float* gp = gt + hh * 512 + lane * 8;
            float4 x0 = *(float4*)xp, x1 = *(float4*)(xp + 4);
            const float4 g0 = *(const float4*)gp, g1 = *(const float4*)(gp + 4);
            x0.x += g0.x * acc[hh * 8 + 0]; x0.y += g0.y * acc[hh * 8 + 1]; x0.z += g0.z * acc[hh * 8 + 2]; x0.w += g0.w * acc[hh * 8 + 3];
            x1.x += g1.x * acc[hh * 8 + 4]; x1.y += g1.y * acc[hh * 8 + 5]; x1.z += g1.z * acc[hh * 8 + 6]; x1.w += g1.w * acc[hh * 8 + 7];
            *(float4*)xp = x0; *(float4*)(xp + 4) = x1;
        }
    }
}
__device__ void phase_final(const Params& p) {
    const float* X = (const float*)(p.ws + OFF_X); const float* g = p.in[33];
    const int tid_ = tidx(), lane = tid_ & 63, wid = tid_ >> 6;
    for (int row = blockIdx.x * 8 + wid; row < NLAT; row += gridDim.x * 8) {
        const float* xr = X + (size_t)row * D;
        float4 v[4]; float ss = 0.f;
#pragma unroll
        for (int i = 0; i < 4; ++i) { v[i] = *(const float4*)(xr + i * 256 + lane * 4); ss += v[i].x * v[i].x + v[i].y * v[i].y + v[i].z * v[i].z + v[i].w * v[i].w; }
        ss = wave_sum(ss);
        const float rs = rsqrtf(ss * (1.f / D) + 1e-6f);
#pragma unroll
        for (int i = 0; i < 4; ++i) {
            const float4 gg = *(const float4*)(g + i * 256 + lane * 4);
            float4 o; o.x = v[i].x * rs * gg.x; o.y = v[i].y * rs * gg.y; o.z = v[i].z * rs * gg.z; o.w = v[i].w * rs * gg.w;
            *(float4*)(p.out + (size_t)row * D + i * 256 + lane * 4) = o;
        }
    }
}

#define XB_TMO      128
#define XB_XCNT(j)  (256  + 64 * (j))
#define XB_XSUB(j)  (1280 + 64 * (j))
#define XB_XGEN(j)  (2304 + 64 * (j))
#define XB_TOP      3328
#define XB_TOPGEN   3392
#define XCD_BAR_WORDS 3456
#define XB_SPIN_CAP (1u << 25)
#define LAS __attribute__((address_space(3)))
__device__ __forceinline__ unsigned xb_ld(unsigned* p)              { return __hip_atomic_load(p, __ATOMIC_RELAXED, __HIP_MEMORY_SCOPE_AGENT); }
__device__ __forceinline__ unsigned xb_add(unsigned* p, unsigned v) { return __hip_atomic_fetch_add(p, v, __ATOMIC_RELAXED, __HIP_MEMORY_SCOPE_AGENT); }
__device__ __forceinline__ unsigned xb_xcc_id() { return (unsigned)__builtin_amdgcn_s_getreg((3 << 11) | 20) & 0xFu; }
#define XB_SPIN(cond, bar) do { unsigned _sp = 0; while (cond) { __builtin_amdgcn_s_sleep(1); \
    if ((++_sp & 255u) == 0u) { if (xb_ld(&(bar)[XB_TMO])) break; if (_sp > XB_SPIN_CAP) { atomicAdd(&(bar)[XB_TMO], 1u); break; } } } } while (0)
struct XcdBarrier { unsigned* bar; unsigned x; volatile LAS unsigned* st; };
__device__ __forceinline__ XcdBarrier xcd_barrier_post(unsigned* bar, volatile LAS unsigned* st) {
    XcdBarrier b; b.bar = bar; b.x = xb_xcc_id(); b.st = st;
    if (threadIdx.x == 0) (void)xb_add(&bar[XB_XCNT(b.x)], 1u);
    return b;
}
__device__ __forceinline__ void xcd_barrier_complete(unsigned* bar, unsigned x, unsigned& nloc, unsigned& nx) {
    const unsigned G = gridDim.x * gridDim.y * gridDim.z;
    unsigned sum, cnt, mine, sp = 0u;
    for (;;) {
        sum = 0u; cnt = 0u; mine = 0u;
#pragma unroll
        for (unsigned j = 0; j < 16; ++j) { const unsigned c = xb_ld(&bar[XB_XCNT(j)]); sum += c; cnt += (c > 0u) ? 1u : 0u; mine = (j == x) ? c : mine; }
        if (sum == G) break;
        __builtin_amdgcn_s_sleep(1);
        if ((++sp & 255u) == 0u) { if (xb_ld(&bar[XB_TMO])) break; if (sp > XB_SPIN_CAP) { atomicAdd(&bar[XB_TMO], 1u); break; } }
    }
    nloc = mine > 0u ? mine : 1u; nx = cnt > 0u ? cnt : 1u;
}
__device__ __forceinline__ void xcd_barrier(const XcdBarrier& b) {
    asm volatile("s_waitcnt vmcnt(0)" ::: "memory");
    __syncthreads();
    if (threadIdx.x == 0) {
        unsigned* bar = b.bar;
        __builtin_amdgcn_s_waitcnt(0);
        unsigned nloc = b.st[0], nx = b.st[1];
        if (nloc == 0u) { xcd_barrier_complete(bar, b.x, nloc, nx); b.st[0] = nloc; b.st[1] = nx; }
        const unsigned old = xb_add(&bar[XB_XSUB(b.x)], 1u);
        const unsigned gen = old / nloc;
        if (old + 1u == (gen + 1u) * nloc) {
            __builtin_amdgcn_fence(__ATOMIC_RELEASE, "agent");
            asm volatile("s_waitcnt vmcnt(0)" ::: "memory");
            const unsigned og = xb_add(&bar[XB_TOP], 1u);
            const unsigned tg = og / nx;
            if (og + 1u == (tg + 1u) * nx) xb_add(&bar[XB_TOPGEN], 1u);
            else XB_SPIN(xb_ld(&bar[XB_TOPGEN]) == tg, bar);
            __builtin_amdgcn_fence(__ATOMIC_ACQUIRE, "agent");
            xb_add(&bar[XB_XGEN(b.x)], 1u);
            asm volatile("s_waitcnt vmcnt(0)" ::: "memory");
        } else {
            XB_SPIN(xb_ld(&bar[XB_XGEN(b.x)]) == gen, bar);
            __builtin_amdgcn_fence(__ATOMIC_ACQUIRE, "agent");
            asm volatile("s_waitcnt vmcnt(0)" ::: "memory");
        }
    }
    __syncthreads();
}

constexpr int NSMALLJOBS = 20;
__global__ void __launch_bounds__(NTHREADS, 2) k_mega(Params p) {
    extern __shared__ __attribute__((aligned(16))) char lds_all[];
    if (threadIdx.x == 0) *(uint4*)lds_all = make_uint4(0u, 0u, 0u, 0u);
    __syncthreads();
    XcdBarrier bar = xcd_barrier_post((unsigned*)(p.ws + OFF_BAR), (volatile LAS unsigned*)lds_all);
    char* lds = lds_all + 16;
#define GBAR xcd_barrier(bar)
    phase_cvt(p, 0, NSMALLJOBS, lds);
    phase_ada(p, lds);
    GBAR;
    for (int l = 0; l < 4; ++l) {
        const bool last = l == 3, rw = (l & 1) == 0; const int j = l >> 1;
        const int nrows = (!last || rw) ? NT : NLAT;
        phase_norm<false>(p, l, 0, nrows, lds); GBAR;
        if (rw) {
            phase_rwkv_proj(p, j, lds); GBAR;
            phase_rwkv_up(p, j, lds); GBAR;
            phase_rwkv_prep(p, j); GBAR;
            phase_rwkv_scan(p, j, lds); GBAR;
            phase_rwkv_out(p, j); GBAR;
            phase_rwkv_wo(p, l, j, lds); GBAR;
        } else {
            phase_pool_dlt(p, nrows); GBAR;
            phase_pool_gemm(p, l, j, nrows, lds); GBAR;
        }
        const int mrows = last ? NLAT : NT;
        phase_cvt(p, NSMALLJOBS + 3 * l, NSMALLJOBS + 3 * l + 3, lds);
        phase_norm<true>(p, l, 1, mrows, lds); GBAR;
        phase_topk(p, !last, lds); GBAR;
        phase_gather(p, !last); GBAR;
        phase_moe_up(p, !last, lds); GBAR;
        phase_moe_down(p, !last, lds); GBAR;
        phase_moe_combine(p, l, mrows); GBAR;
    }
    phase_final(p);
#undef GBAR
}

enum { PH_CVT = 0, PH_ADA, PH_NORM1, PH_NORM2, PH_PROJ, PH_UP, PH_PREP, PH_SCAN, PH_OUT, PH_WO, PH_DLT, PH_POOLG, PH_TOPK, PH_GATHER, PH_MUP, PH_MDOWN, PH_COMB, PH_FINAL };
template <int PH>
__global__ void __launch_bounds__(NTHREADS) k_phase(Params p, int a0, int a1, int a2) {
    extern __shared__ __attribute__((aligned(16))) char lds[];
    if (PH == PH_CVT) phase_cvt(p, a0, a1, lds);
    if (PH == PH_ADA) phase_ada(p, lds);
    if (PH == PH_NORM1) phase_norm<false>(p, a0, 0, a1, lds);
    if (PH == PH_NORM2) phase_norm<true>(p, a0, 1, a1, lds);
    if (PH == PH_PROJ) phase_rwkv_proj(p, a0, lds);
    if (PH == PH_UP) phase_rwkv_up(p, a0, lds);
    if (PH == PH_PREP) phase_rwkv_prep(p, a0);
    if (PH == PH_SCAN) phase_rwkv_scan(p, a0, lds);
    if (PH == PH_OUT) phase_rwkv_out(p, a0);
    if (PH == PH_WO) phase_rwkv_wo(p, a0, a1, lds);
    if (PH == PH_DLT) phase_pool_dlt(p, a0);
    if (PH == PH_POOLG) phase_pool_gemm(p, a0, a1, a2, lds);
    if (PH == PH_TOPK) phase_topk(p, a0 != 0, lds);
    if (PH == PH_GATHER) phase_gather(p, a0 != 0);
    if (PH == PH_MUP) phase_moe_up(p, a0 != 0, lds);
    if (PH == PH_MDOWN) phase_moe_down(p, a0 != 0, lds);
    if (PH == PH_COMB) phase_moe_combine(p, a0, a1);
    if (PH == PH_FINAL) phase_final(p);
}

constexpr int LDS_BYTES = 112 * 1024;
template <int PH>
static void launch(const Params& p, int a0, int a1, int a2, hipStream_t s) {
    static bool init = false;
    if (!init) { hipFuncSetAttribute((const void*)k_phase<PH>, hipFuncAttributeMaxDynamicSharedMemorySize, LDS_BYTES); init = true; }
    hipLaunchKernelGGL(k_phase<PH>, dim3(256), dim3(NTHREADS), LDS_BYTES, s, p, a0, a1, a2);
}

static int add_job(Params& p, int n, const float* src, bf16_t* dst, int K, int N, int src_ld, int dst_ld, int n_mul, int n_off, int Kpad, int Npad, int nbatch, long src_bs, long dst_bs) {
    CvtJob& J = p.jobs[n];
    J.src = src; J.dst = dst; J.src_bs = src_bs; J.dst_bs = dst_bs; J.K = K; J.N = N; J.src_ld = src_ld; J.dst_ld = dst_ld; J.n_mul = n_mul; J.n_off = n_off;
    J.Kpad = Kpad; J.Npad = Npad; J.nbatch = nbatch; J.tiles = nbatch * (Kpad / 64) * (Npad / 64);
    return n + 1;
}

extern "C" void kernel_launch(void* const* d_in, const int* in_sizes, int n_in, void* d_out, int out_size, void* d_ws, size_t ws_size, hipStream_t stream) {
    Params p;
    memset(&p, 0, sizeof(p));
    for (int i = 0; i < 34; ++i) p.in[i] = (const float*)d_in[i];
    p.out = (float*)d_out; p.ws = (char*)d_ws;
    if (ws_size < WS_NEED) { fprintf(stderr, "workspace too small: %zu < %zu\n", ws_size, (size_t)WS_NEED); }
    bf16_t* wsm_ = (bf16_t*)(p.ws + OFF_WSM);
    bf16_t* wm_ = (bf16_t*)(p.ws + OFF_WM);
    int nj = 0;
    for (int j = 0; j < 2; ++j) {
        bf16_t* base = wsm_ + (size_t)j * WJ_SIZE;
        nj = add_job(p, nj, p.in[9] + (size_t)j * 3 * D * D, base + WJ_RKV, D, D, D, D, 1, 0, D, D, 3, (long)D * D, (long)D * D);
        nj = add_job(p, nj, p.in[26] + (size_t)j * D * D, base + WJ_WO, D, D, D, D, 1, 0, D, D, 1, 0, 0);
        nj = add_job(p, nj, p.in[11] + (size_t)j * 2 * D * 64, base + WJ_W1, D, 64, 64, D, 1, 0, D, 64, 2, (long)D * 64, (long)64 * D);
        nj = add_job(p, nj, p.in[14] + (size_t)j * 2 * D * 64, base + WJ_A1, D, 64, 64, D, 1, 0, D, 64, 2, (long)D * 64, (long)64 * D);
        nj = add_job(p, nj, p.in[19] + (size_t)j * D * 128, base + WJ_G1, D, 128, 128, D, 1, 0, D, 128, 1, 0, 0);
        nj = add_job(p, nj, p.in[12] + (size_t)j * 2 * 64 * D, base + WJ_W2, 64, D, D, 64, 1, 0, 64, D, 2, (long)64 * D, (long)D * 64);
        nj = add_job(p, nj, p.in[15] + (size_t)j * 2 * 64 * D, base + WJ_A2, 64, D, D, 64, 1, 0, 64, D, 2, (long)64 * D, (long)D * 64);
        nj = add_job(p, nj, p.in[20] + (size_t)j * 128 * D, base + WJ_G2, 128, D, D, 128, 1, 0, 128, D, 1, 0, 0);
        nj = add_job(p, nj, p.in[27] + (size_t)j * 4 * 256 * 256, base + WJ_POOL, 256, 256, 256, 256, 1, 0, 256, 256, 4, 65536, 65536);
    }
    nj = add_job(p, nj, p.in[17], wsm_ + W_V1, D, 32, 32, D, 1, 0, D, 128, 1, 0, 0);
    nj = add_job(p, nj, p.in[18], wsm_ + W_V2, 32, D, D, 64, 1, 0, 64, D, 1, 0, 0);
    const int nsmall = nj;
    for (int l = 0; l < 4; ++l) {
        nj = add_job(p, nj, p.in[30] + (size_t)l * 16 * D * FF, wm_ + WM_13, D, FF, FF, D, 2, 0, D, FF, 16, (long)D * FF, (long)4096 * 1024);
        nj = add_job(p, nj, p.in[31] + (size_t)l * 16 * D * FF, wm_ + WM_13, D, FF, FF, D, 2, 1, D, FF, 16, (long)D * FF, (long)4096 * 1024);
        nj = add_job(p, nj, p.in[32] + (size_t)l * 16 * FF * D, wm_ + WM_2, FF, D, D, FF, 1, 0, FF, D, 16, (long)FF * D, (long)D * FF);
    }
    hipMemcpyAsync(p.ws + OFF_X, d_in[0], (size_t)NLAT * D * 4, hipMemcpyDeviceToDevice, stream);
    hipMemcpyAsync(p.ws + OFF_X + (size_t)NLAT * D * 4, d_in[2], (size_t)NCTX * D * 4, hipMemcpyDeviceToDevice, stream);
#if MK_MULTI
    launch<PH_CVT>(p, 0, nsmall, 0, stream);
    launch<PH_ADA>(p, 0, 0, 0, stream);
    for (int l = 0; l < 4; ++l) {
        const bool last = l == 3, rw = (l % 2) == 0; const int j = l / 2;
        const bool need_ctx = !last || rw;
        const int nrows = need_ctx ? NT : NLAT;
        launch<PH_NORM1>(p, l, nrows, 0, stream);
        if (rw) {
            launch<PH_PROJ>(p, j, 0, 0, stream);
            launch<PH_UP>(p, j, 0, 0, stream);
            launch<PH_PREP>(p, j, 0, 0, stream);
            launch<PH_SCAN>(p, j, 0, 0, stream);
            launch<PH_OUT>(p, j, 0, 0, stream);
            launch<PH_WO>(p, l, j, 0, stream);
        } else {
            launch<PH_DLT>(p, nrows, 0, 0, stream);
            launch<PH_POOLG>(p, l, j, nrows, stream);
        }
        const int mrows = last ? NLAT : NT;
        launch<PH_CVT>(p, nsmall + 3 * l, nsmall + 3 * l + 3, 0, stream);
        launch<PH_NORM2>(p, l, mrows, 0, stream);
        launch<PH_TOPK>(p, last ? 0 : 1, 0, 0, stream);
        launch<PH_GATHER>(p, last ? 0 : 1, 0, 0, stream);
        launch<PH_MUP>(p, last ? 0 : 1, 0, 0, stream);
        launch<PH_MDOWN>(p, last ? 0 : 1, 0, 0, stream);
        launch<PH_COMB>(p, l, mrows, 0, stream);
    }
    launch<PH_FINAL>(p, 0, 0, 0, stream);
#else
    (void)nsmall;
    static int grid = 0;
    if (!grid) {
        hipFuncSetAttribute((const void*)k_mega, hipFuncAttributeMaxDynamicSharedMemorySize, LDS_BYTES + 16);
        int dev = 0, cus = 0, per_cu = 0;
        hipGetDevice(&dev);
        hipDeviceGetAttribute(&cus, hipDeviceAttributeMultiprocessorCount, dev);
        hipOccupancyMaxActiveBlocksPerMultiprocessor(&per_cu, (const void*)k_mega, NTHREADS, LDS_BYTES + 16);
        grid = cus * (per_cu < 1 ? per_cu : 1);
        if (grid <= 0) { fprintf(stderr, "occupancy query returned %d blocks per CU\n", per_cu); grid = 0; return; }
    }
    hipMemsetAsync(p.ws + OFF_BAR, 0, XCD_BAR_WORDS * sizeof(unsigned), stream);
    hipLaunchKernelGGL(k_mega, dim3(grid), dim3(NTHREADS), LDS_BYTES + 16, stream, p);
#endif
}
```

```cpp
#include <hip/hip_runtime.h>
#include <stdint.h>
#include <stdio.h>
#include <string.h>
#ifndef MK_MULTI
#define MK_MULTI 0
#endif

typedef unsigned short bf16_t;
typedef short bf16x8 __attribute__((ext_vector_type(8)));
typedef float f32x4 __attribute__((ext_vector_type(4)));
typedef unsigned u32x4 __attribute__((ext_vector_type(4)));
typedef unsigned u32x2 __attribute__((ext_vector_type(2)));

constexpr int D = 1024, NB = 16, TL = 4096, TC = 256;
constexpr int NLAT = NB * TL, NCTX = NB * TC, NT = NLAT + NCTX;
constexpr int NE = 16, FF = 2048, CAPL = 512, CAPC = 32;
constexpr int NSLOT_LAT = NB * NE * CAPL, NSLOT_CTX = NB * NE * CAPC, NSLOT = NSLOT_LAT + NSLOT_CTX;
constexpr int MODW = 6 * D;
constexpr int NTHREADS = 512;
constexpr int LDS_BYTES = 128 * 1024;

constexpr size_t MiB = 1ull << 20;
constexpr size_t U = (size_t)NT * D * 2;
constexpr size_t OFF_BAR = 0;
constexpr size_t OFF_MOD = 64 * 1024;
constexpr size_t OFF_WSM = 2 * MiB;
constexpr size_t OFF_AFF = 26 * MiB;
constexpr size_t OFF_BON = 31 * MiB;
constexpr size_t OFF_IDX = 36 * MiB;
constexpr size_t OFF_GTV = 37 * MiB;
constexpr size_t OFF_SLT = 38 * MiB;
constexpr size_t OFF_BIG = 48 * MiB;
constexpr size_t OFF_X = OFF_BIG;
constexpr size_t OFF_VF = OFF_BIG + 2 * U;
constexpr size_t OFF_H = OFF_BIG + 3 * U;
constexpr size_t OFF_R = OFF_BIG + 4 * U;
constexpr size_t OFF_K = OFF_BIG + 5 * U;
constexpr size_t OFF_LD = OFF_BIG + 6 * U;
constexpr size_t OFF_LW = OFF_BIG + 6 * U + U / 2;
constexpr size_t OFF_AD = OFF_BIG + 8 * U + U / 2;
constexpr size_t OFF_Y = OFF_BIG + 10 * U + U / 2;
constexpr size_t OFF_G = OFF_BIG + 12 * U + U / 2;
constexpr size_t OFF_WM = OFF_BIG + 4 * U;
constexpr size_t OFF_XG = OFF_BIG + 5 * U + U / 2;
constexpr size_t OFF_HID = OFF_BIG + 7 * U + U / 2;
constexpr size_t OFF_YS = OFF_BIG + 11 * U + U / 2;
constexpr size_t OFF_DLT = OFF_BIG + 4 * U;
constexpr size_t WS_NEED = OFF_BIG + 13 * U + U / 2;

constexpr size_t WJ_RKV = 0;
constexpr size_t WJ_WO = 3 * 1048576;
constexpr size_t WJ_W1 = 4 * 1048576;
constexpr size_t WJ_A1 = WJ_W1 + 131072;
constexpr size_t WJ_G1 = WJ_A1 + 131072;
constexpr size_t WJ_W2 = WJ_G1 + 131072;
constexpr size_t WJ_A2 = WJ_W2 + 131072;
constexpr size_t WJ_G2 = WJ_A2 + 131072;
constexpr size_t WJ_POOL = WJ_G2 + 131072;
constexpr size_t WJ_SIZE = WJ_POOL + 262144;
constexpr size_t W_V1 = 2 * WJ_SIZE;
constexpr size_t W_V2 = W_V1 + 131072;
constexpr size_t WM_13 = 0;
constexpr size_t WM_2 = (size_t)16 * 4096 * 1024;

struct CvtJob {
    const float* src; bf16_t* dst;
    long src_bs, dst_bs;
    int K, N, src_ld, dst_ld, n_mul, n_off, Kpad, Npad, nbatch, tiles;
};
constexpr int NJOBS = 32;
struct Params {
    const float* in[34];
    float* out;
    char* ws;
    CvtJob jobs[NJOBS];
};

__device__ __forceinline__ float bf2f(bf16_t v) { return __uint_as_float(((unsigned)v) << 16); }
__device__ __forceinline__ bf16_t f2bf(float f) { unsigned u = __float_as_uint(f); u += 0x7FFFu + ((u >> 16) & 1u); return (bf16_t)(u >> 16); }
__device__ __forceinline__ unsigned pack2(float lo, float hi) { return (unsigned)f2bf(lo) | ((unsigned)f2bf(hi) << 16); }
__device__ __forceinline__ float bflo(unsigned w) { return __uint_as_float(w << 16); }
__device__ __forceinline__ float bfhi(unsigned w) { return __uint_as_float(w & 0xffff0000u); }
__device__ __forceinline__ float wave_sum(float v) {
#pragma unroll
    for (int m = 32; m >= 1; m >>= 1) v += __shfl_xor(v, m, 64);
    return v;
}
__device__ __forceinline__ float sigmoidf_(float x) { return 1.f / (1.f + __expf(-x)); }
__device__ __forceinline__ float siluf_(float x) { return x / (1.f + __expf(-x)); }
__device__ __forceinline__ float rdlane(float v, int l) { return __uint_as_float(__builtin_amdgcn_readlane(__float_as_uint(v), l)); }

__device__ __forceinline__ int tidx() { int t = threadIdx.x; asm volatile("" : "+v"(t)); return t; }

__device__ __forceinline__ int mod_row(int row) { return row < NLAT ? (row >> 12) : 16; }

__device__ __forceinline__ void phase_cvt(const Params& p, int jlo, int jhi, char* lds) {
    float* tile = (float*)lds;
    const int tid = tidx();
    int total = 0;
    for (int j = jlo; j < jhi; ++j) total += p.jobs[j].tiles;
    for (int u = blockIdx.x; u < total; u += gridDim.x) {
        int j = jlo, uu = u;
        while (uu >= p.jobs[j].tiles) { uu -= p.jobs[j].tiles; ++j; }
        const CvtJob& J = p.jobs[j];
        const int tk = J.Kpad / 64, tn = J.Npad / 64;
        const int bt = uu / (tk * tn), r = uu % (tk * tn), kt = r / tn, nt = r % tn;
        const float* src = J.src + (size_t)bt * J.src_bs;
        bf16_t* dst = J.dst + (size_t)bt * J.dst_bs;
#pragma unroll
        for (int ps = 0; ps < 2; ++ps) {
            const int kl = ps * 32 + (tid >> 4), k = kt * 64 + kl, n = nt * 64 + (tid & 15) * 4;
            float v0 = 0.f, v1 = 0.f, v2 = 0.f, v3 = 0.f;
            if (k < J.K) {
                const float* s = src + (size_t)k * J.src_ld + n;
                if (n + 3 < J.N) { const float4 t = *(const float4*)s; v0 = t.x; v1 = t.y; v2 = t.z; v3 = t.w; }
                else { if (n < J.N) v0 = s[0]; if (n + 1 < J.N) v1 = s[1]; if (n + 2 < J.N) v2 = s[2]; }
            }
            float* tp = tile + kl * 65 + (tid & 15) * 4;
            tp[0] = v0; tp[1] = v1; tp[2] = v2; tp[3] = v3;
        }
        __syncthreads();
        {
            const int n = tid >> 3, kc = tid & 7;
            u32x4 o;
            o[0] = pack2(tile[(kc * 8 + 0) * 65 + n], tile[(kc * 8 + 1) * 65 + n]);
            o[1] = pack2(tile[(kc * 8 + 2) * 65 + n], tile[(kc * 8 + 3) * 65 + n]);
            o[2] = pack2(tile[(kc * 8 + 4) * 65 + n], tile[(kc * 8 + 5) * 65 + n]);
            o[3] = pack2(tile[(kc * 8 + 6) * 65 + n], tile[(kc * 8 + 7) * 65 + n]);
            *(u32x4*)(dst + ((size_t)(nt * 64 + n) * J.n_mul + J.n_off) * J.dst_ld + kt * 64 + kc * 8) = o;
        }
        __syncthreads();
    }
}

__device__ __forceinline__ void phase_ada(const Params& p, char* lds) {
    float* sc = (float*)lds;
    float* red = sc + 17 * 1024;
    const int tid = tidx();
    const float* c = p.in[1]; const float* cctx = p.in[3];
    for (int i = tid; i < 17 * 1024; i += NTHREADS) {
        const float v = i < 16 * 1024 ? c[i] : cctx[i - 16 * 1024];
        sc[i] = siluf_(v);
    }
    __syncthreads();
    float* MOD = (float*)(p.ws + OFF_MOD);
    const int col = tid & 63, ks = tid >> 6;
    for (int u = blockIdx.x; u < 4 * 96; u += gridDim.x) {
        const int l = u / 96, n = (u % 96) * 64 + col;
        const float* w = p.in[4] + (size_t)l * D * MODW + n;
        float acc[17];
#pragma unroll
        for (int r = 0; r < 17; ++r) acc[r] = 0.f;
        for (int k = ks * 128; k < ks * 128 + 128; ++k) {
            const float wv = w[(size_t)k * MODW];
#pragma unroll
            for (int r = 0; r < 17; ++r) acc[r] += sc[r * 1024 + k] * wv;
        }
#pragma unroll
        for (int r = 0; r < 17; ++r) red[(ks * 17 + r) * 64 + col] = acc[r];
        __syncthreads();
        for (int i = tid; i < 17 * 64; i += NTHREADS) {
            const int r = i >> 6, cc = i & 63;
            float s = 0.f;
#pragma unroll
            for (int q = 0; q < 8; ++q) s += red[(q * 17 + r) * 64 + cc];
            const int nn = (u % 96) * 64 + cc;
            MOD[((size_t)l * 17 + r) * MODW + nn] = s + p.in[5][(size_t)l * MODW + nn];
        }
        __syncthreads();
    }
}

template <bool ROUTER>
__device__ __forceinline__ void phase_norm(const Params& p, int l, int which, int nrows, char* lds) {
    const float* X = (const float*)(p.ws + OFF_X);
    bf16_t* H = (bf16_t*)(p.ws + OFF_H);
    const float* MOD = (const float*)(p.ws + OFF_MOD) + (size_t)l * 17 * MODW;
    const float* g = (which == 0 ? p.in[6] : p.in[7]) + (size_t)l * D;
    float* AFF = (float*)(p.ws + OFF_AFF);
    float* rt = (float*)lds;
    const int tid = tidx(), lane = tid & 63, wid = tid >> 6;
    if (ROUTER) {
        const float* rsrc = p.in[29] + (size_t)l * D * NE;
        for (int i = tid; i < D * NE; i += NTHREADS) rt[i] = rsrc[i];
        __syncthreads();
    }
    const int so = which == 0 ? 0 : 3 * D, co = which == 0 ? D : 4 * D;
    for (int row = blockIdx.x * 8 + wid; row < nrows; row += gridDim.x * 8) {
        const float* xr = X + (size_t)row * D;
        const float* mr = MOD + (size_t)mod_row(row) * MODW;
        float ss = 0.f;
#pragma unroll
        for (int i = 0; i < 4; ++i) { const float4 t = *(const float4*)(xr + i * 256 + lane * 4); ss += t.x * t.x + t.y * t.y + t.z * t.z + t.w * t.w; }
        ss = wave_sum(ss);
        const float rs = rsqrtf(ss * (1.f / D) + 1e-6f);
        float lg[16];
        if (ROUTER) {
#pragma unroll
            for (int e = 0; e < 16; ++e) lg[e] = 0.f;
        }
#pragma unroll 1
        for (int i = 0; i < 4; ++i) {
            const int c0 = i * 256 + lane * 4;
            const float4 xv = *(const float4*)(xr + c0);
            const float4 gg = *(const float4*)(g + c0), sh = *(const float4*)(mr + so + c0), sl = *(const float4*)(mr + co + c0);
            float h0 = xv.x * rs * gg.x * (1.f + sl.x) + sh.x;
            float h1 = xv.y * rs * gg.y * (1.f + sl.y) + sh.y;
            float h2 = xv.z * rs * gg.z * (1.f + sl.z) + sh.z;
            float h3 = xv.w * rs * gg.w * (1.f + sl.w) + sh.w;
            u32x2 o; o[0] = pack2(h0, h1); o[1] = pack2(h2, h3);
            *(u32x2*)(H + (size_t)row * D + c0) = o;
            if (ROUTER) {
                const float4* r0 = (const float4*)(rt + c0 * 16);
#pragma unroll
                for (int e4 = 0; e4 < 4; ++e4) {
                    const float4 a = r0[e4], b = r0[4 + e4], c = r0[8 + e4], d = r0[12 + e4];
                    lg[e4 * 4 + 0] += h0 * a.x + h1 * b.x + h2 * c.x + h3 * d.x;
                    lg[e4 * 4 + 1] += h0 * a.y + h1 * b.y + h2 * c.y + h3 * d.y;
                    lg[e4 * 4 + 2] += h0 * a.z + h1 * b.z + h2 * c.z + h3 * d.z;
                    lg[e4 * 4 + 3] += h0 * a.w + h1 * b.w + h2 * c.w + h3 * d.w;
                }
            }
        }
        if (ROUTER) {
            float mx = -1e30f;
#pragma unroll
            for (int e = 0; e < 16; ++e) { lg[e] = wave_sum(lg[e]); mx = fmaxf(mx, lg[e]); }
            float sum = 0.f;
#pragma unroll
            for (int e = 0; e < 16; ++e) { lg[e] = __expf(lg[e] - mx); sum += lg[e]; }
            const float inv = 1.f / sum;
            float mine = 0.f;
#pragma unroll
            for (int e = 0; e < 16; ++e) mine = (lane == e) ? lg[e] * inv : mine;
            if (lane < 16) AFF[(size_t)row * 16 + lane] = mine;
        }
    }
}

constexpr int GS_LD = 72;
template <class AL, class EP>
__device__ __forceinline__ void gemm_tile_small(char* lds, const AL& al, const bf16_t* __restrict__ Bt, int ldb, int K, int row0, int col0, const EP& ep) {
    bf16_t* As = (bf16_t*)lds; bf16_t* Bs = As + 128 * GS_LD;
    const int tid = tidx(), lane = tid & 63, wid = tid >> 6, wr = wid >> 1, wc = wid & 1, fr = lane & 15, fq = lane >> 4;
    const int lr = tid >> 3, kc = tid & 7;
    f32x4 acc[2][4];
#pragma unroll
    for (int m = 0; m < 2; ++m)
#pragma unroll
        for (int n = 0; n < 4; ++n) acc[m][n] = (f32x4){0.f, 0.f, 0.f, 0.f};
    bf16x8 ra0 = al(row0 + lr, kc * 8), ra1 = al(row0 + lr + 64, kc * 8);
    bf16x8 rb0 = *(const bf16x8*)(Bt + (size_t)(col0 + lr) * ldb + kc * 8), rb1 = *(const bf16x8*)(Bt + (size_t)(col0 + lr + 64) * ldb + kc * 8);
    for (int k0 = 0; k0 < K; k0 += 64) {
        __syncthreads();
        *(bf16x8*)(As + lr * GS_LD + kc * 8) = ra0; *(bf16x8*)(As + (lr + 64) * GS_LD + kc * 8) = ra1;
        *(bf16x8*)(Bs + lr * GS_LD + kc * 8) = rb0; *(bf16x8*)(Bs + (lr + 64) * GS_LD + kc * 8) = rb1;
        __syncthreads();
        if (k0 + 64 < K) {
            const int kn = k0 + 64 + kc * 8;
            ra0 = al(row0 + lr, kn); ra1 = al(row0 + lr + 64, kn);
            rb0 = *(const bf16x8*)(Bt + (size_t)(col0 + lr) * ldb + kn); rb1 = *(const bf16x8*)(Bt + (size_t)(col0 + lr + 64) * ldb + kn);
        }
#pragma unroll
        for (int ks = 0; ks < 2; ++ks) {
            bf16x8 a[2], b[4];
#pragma unroll
            for (int m = 0; m < 2; ++m) a[m] = *(const bf16x8*)(As + (wr * 32 + m * 16 + fr) * GS_LD + ks * 32 + fq * 8);
#pragma unroll
            for (int n = 0; n < 4; ++n) b[n] = *(const bf16x8*)(Bs + (wc * 64 + n * 16 + fr) * GS_LD + ks * 32 + fq * 8);
#pragma unroll
            for (int m = 0; m < 2; ++m)
#pragma unroll
                for (int n = 0; n < 4; ++n) acc[m][n] = __builtin_amdgcn_mfma_f32_16x16x32_bf16(b[n], a[m], acc[m][n], 0, 0, 0);
        }
    }
#pragma unroll
    for (int m = 0; m < 2; ++m)
#pragma unroll
        for (int n = 0; n < 4; ++n) ep(row0 + wr * 32 + m * 16 + fr, col0 + wc * 64 + n * 16 + fq * 4, acc[m][n]);
}

struct PlainLoader {
    const bf16_t* A; int lda;
    __device__ __forceinline__ bf16x8 operator()(int row, int k) const { return *(const bf16x8*)(A + (size_t)row * lda + k); }
};
struct MixLoader {
    const bf16_t* H; const float* mix;
    __device__ __forceinline__ bf16x8 operator()(int row, int k) const {
        int nb;
        if (row < NLAT) {
            const int t = row & (TL - 1), gc = t & 63, gr = t >> 6, q = k >> 8;
            if (q == 0) nb = gc > 0 ? row - 1 : -1;
            else if (q == 1) nb = gc < 63 ? row + 1 : -1;
            else if (q == 2) nb = gr > 0 ? row - 64 : -1;
            else nb = gr < 63 ? row + 64 : -1;
        } else {
            const int t = (row - NLAT) & (TC - 1);
            if (k < 512) nb = t > 0 ? row - 1 : -1;
            else nb = t < TC - 1 ? row + 1 : -1;
        }
        const u32x4 h = *(const u32x4*)(H + (size_t)row * D + k);
        u32x4 s = (u32x4){0u, 0u, 0u, 0u};
        if (nb >= 0) s = *(const u32x4*)(H + (size_t)nb * D + k);
        const float4 m0 = *(const float4*)(mix + k), m1 = *(const float4*)(mix + k + 4);
        u32x4 o;
        { float a = bflo(h[0]), b = bfhi(h[0]); o[0] = pack2(a + (bflo(s[0]) - a) * m0.x, b + (bfhi(s[0]) - b) * m0.y); }
        { float a = bflo(h[1]), b = bfhi(h[1]); o[1] = pack2(a + (bflo(s[1]) - a) * m0.z, b + (bfhi(s[1]) - b) * m0.w); }
        { float a = bflo(h[2]), b = bfhi(h[2]); o[2] = pack2(a + (bflo(s[2]) - a) * m1.x, b + (bfhi(s[2]) - b) * m1.y); }
        { float a = bflo(h[3]), b = bfhi(h[3]); o[3] = pack2(a + (bflo(s[3]) - a) * m1.z, b + (bfhi(s[3]) - b) * m1.w); }
        return __builtin_bit_cast(bf16x8, o);
    }
};

struct EpStoreBf16 {
    bf16_t* O; int ldo; int act;
    __device__ __forceinline__ void operator()(int row, int col, f32x4 v) const {
        if (act == 1) { v[0] = tanhf(v[0]); v[1] = tanhf(v[1]); v[2] = tanhf(v[2]); v[3] = tanhf(v[3]); }
        else if (act == 2) { v[0] = sigmoidf_(v[0]); v[1] = sigmoidf_(v[1]); v[2] = sigmoidf_(v[2]); v[3] = sigmoidf_(v[3]); }
        u32x2 o; o[0] = pack2(v[0], v[1]); o[1] = pack2(v[2], v[3]);
        *(u32x2*)(O + (size_t)row * ldo + col) = o;
    }
};
struct EpDecay {
    bf16_t* O; const float* w0;
    __device__ __forceinline__ void operator()(int row, int col, f32x4 v) const {
        const float4 b = *(const float4*)(w0 + col);
        u32x2 o;
        o[0] = pack2(-0.6065306597f * sigmoidf_(v[0] + b.x), -0.6065306597f * sigmoidf_(v[1] + b.y));
        o[1] = pack2(-0.6065306597f * sigmoidf_(v[2] + b.z), -0.6065306597f * sigmoidf_(v[3] + b.w));
        *(u32x2*)(O + (size_t)row * D + col) = o;
    }
};
struct EpSigBias {
    bf16_t* O; const float* b0;
    __device__ __forceinline__ void operator()(int row, int col, f32x4 v) const {
        const float4 b = *(const float4*)(b0 + col);
        u32x2 o;
        o[0] = pack2(sigmoidf_(v[0] + b.x), sigmoidf_(v[1] + b.y));
        o[1] = pack2(sigmoidf_(v[2] + b.z), sigmoidf_(v[3] + b.w));
        *(u32x2*)(O + (size_t)row * D + col) = o;
    }
};
struct EpVres {
    bf16_t* VF; const bf16_t* VRAW; const float* v0;
    __device__ __forceinline__ void operator()(int row, int col, f32x4 a) const {
        const float4 b = *(const float4*)(v0 + col);
        const u32x2 vr = *(const u32x2*)(VRAW + (size_t)row * D + col);
        const u32x2 vf = *(const u32x2*)(VF + (size_t)row * D + col);
        float x0 = bflo(vr[0]), x1 = bfhi(vr[0]), x2 = bflo(vr[1]), x3 = bfhi(vr[1]);
        float f0 = bflo(vf[0]), f1 = bfhi(vf[0]), f2 = bflo(vf[1]), f3 = bfhi(vf[1]);
        u32x2 o;
        o[0] = pack2(x0 + (f0 - x0) * sigmoidf_(a[0] + b.x), x1 + (f1 - x1) * sigmoidf_(a[1] + b.y));
        o[1] = pack2(x2 + (f2 - x2) * sigmoidf_(a[2] + b.z), x3 + (f3 - x3) * sigmoidf_(a[3] + b.w));
        *(u32x2*)(VF + (size_t)row * D + col) = o;
    }
};
struct EpResidual {
    float* X; const float* gate; const float* cscale;
    __device__ __forceinline__ void operator()(int row, int col, f32x4 a) const {
        const float4 gt = *(const float4*)(gate + (size_t)mod_row(row) * MODW + col);
        float4 cs = make_float4(1.f, 1.f, 1.f, 1.f);
        if (cscale) cs = *(const float4*)(cscale + col);
        float4* xp = (float4*)(X + (size_t)row * D + col);
        float4 x = *xp;
        x.x += gt.x * a[0] * cs.x; x.y += gt.y * a[1] * cs.y; x.z += gt.z * a[2] * cs.z; x.w += gt.w * a[3] * cs.w;
        *xp = x;
    }
};
struct EpSwiglu {
    bf16_t* HID;
    __device__ __forceinline__ void operator()(int row, int col, f32x4 a) const {
        *(unsigned*)(HID + (size_t)row * FF + (col >> 1)) = pack2(siluf_(a[0]) * a[1], siluf_(a[2]) * a[3]);
    }
};
struct EpGateRow {
    bf16_t* YS; const float* gatev;
    __device__ __forceinline__ void operator()(int row, int col, f32x4 a) const {
        const float gt = gatev[row];
        u32x2 o; o[0] = pack2(a[0] * gt, a[1] * gt); o[1] = pack2(a[2] * gt, a[3] * gt);
        *(u32x2*)(YS + (size_t)row * D + col) = o;
    }
};

#define LAS __attribute__((address_space(3)))
namespace g256 {
constexpr int BM = 256, BK = 64, HALF = 128, HTB = HALF * BK * 2, STAGE_BYTES = 8 * HTB;
__device__ __forceinline__ int lds_byte(int r, int c) { const int st = (r >> 4) * 2 + (c >> 5), rr = r & 15, cc = c & 31, ob = rr * 64 + cc * 2; return st * 1024 + (ob ^ (((ob >> 9) & 1) << 5)); }
__device__ __forceinline__ void stage_rc(int b, int& R, int& C) { const int st = b / 1024, sb = b % 1024, swz = sb ^ (((sb >> 9) & 1) << 5); R = (st >> 1) * 16 + swz / 64; C = (st & 1) * 32 + (swz % 64) / 2; }
struct Unit { const char* a; const char* b; int row0, col0; };

template <class Sched, class Ep>
__device__ __forceinline__ void gemm_phase(LAS unsigned char* lds, const int lda, const int ldb, const int K, const Sched& S, const Ep& E) {
    const int tid = tidx(), wid = __builtin_amdgcn_readfirstlane(tid >> 6), lane = tid & 63, wr = wid >> 2, wc = wid & 3, fr = lane & 15, fq = lane >> 4;
    const int nt = K / BK;
    unsigned voffA[2], voffB[2];
#pragma unroll
    for (int i = 0; i < 2; ++i) { int R, C; stage_rc(tid * 16 + i * 8192, R, C); voffA[i] = (unsigned)(R * lda + C) * 2u; voffB[i] = (unsigned)(R * ldb + C) * 2u; }
    const size_t kstep = (size_t)(BK * 2);
    const size_t hstepA = (size_t)HALF * lda * 2, hstepB = (size_t)HALF * ldb * 2;
    const unsigned ldsw = (unsigned)wid * 1024u;
    const int aoff = lds_byte(wr * 64 + fr, fq * 8), boff = lds_byte(wc * 32 + fr, fq * 8);
#define PG8_SA(b, h) (((b) * 2 + (h)) * HTB)
#define PG8_SB(b, h) ((4 + (b) * 2 + (h)) * HTB)
#define PG8_STAGE(bufoff, gbase, voff) do { _Pragma("unroll") for (int _i = 0; _i < 2; ++_i) \
        __builtin_amdgcn_global_load_lds((const unsigned*)((const char*)(gbase) + (voff)[_i]), (LAS unsigned*)(lds + (bufoff) + ldsw + _i * 8192), 16, 0, 0); } while (0)
#define PG8_LDA(dst, b, h) do { _Pragma("unroll") for (int m = 0; m < 4; ++m) _Pragma("unroll") for (int k = 0; k < 2; ++k) dst[m][k] = *(const LAS bf16x8*)(lds + PG8_SA(b, h) + aoff + m * 2048 + k * 1024); } while (0)
#define PG8_LDB(dst, b, h) do { _Pragma("unroll") for (int n = 0; n < 2; ++n) _Pragma("unroll") for (int k = 0; k < 2; ++k) dst[n][k] = *(const LAS bf16x8*)(lds + PG8_SB(b, h) + boff + n * 2048 + k * 1024); } while (0)
#define PG8_MMA(ai, bj, At, Bt) do { __builtin_amdgcn_s_setprio(1); _Pragma("unroll") for (int m = 0; m < 4; ++m) _Pragma("unroll") for (int n = 0; n < 2; ++n) _Pragma("unroll") for (int k = 0; k < 2; ++k) \
        acc[ai][bj][m][n] = __builtin_amdgcn_mfma_f32_16x16x32_bf16(Bt[n][k], At[m][k], acc[ai][bj][m][n], 0, 0, 0); __builtin_amdgcn_s_setprio(0); } while (0)
#define PG8_WAIT_V(n) asm volatile("s_waitcnt vmcnt(" #n ")" ::: "memory")
#define PG8_WAIT_L(n) asm volatile("s_waitcnt lgkmcnt(" #n ")" ::: "memory")
#define PG8_BAR __builtin_amdgcn_s_barrier()
#define PG8_SCHED __builtin_amdgcn_sched_barrier(0)
    Unit cur, nxt; int ui = 0;
    if (!S.next(0, cur)) return;
    f32x4 acc[2][2][4][2];
#pragma unroll
    for (int a = 0; a < 2; ++a)
#pragma unroll
        for (int b = 0; b < 2; ++b)
#pragma unroll
            for (int m = 0; m < 4; ++m)
#pragma unroll
                for (int n = 0; n < 2; ++n) acc[a][b][m][n] = (f32x4){0.f, 0.f, 0.f, 0.f};
    bf16x8 At[4][2], B0[2][2], B1[2][2];
    const char* cA = cur.a; const char* cB = cur.b;
    PG8_STAGE(PG8_SB(0, 0), cB, voffB); PG8_STAGE(PG8_SA(0, 0), cA, voffA); PG8_STAGE(PG8_SB(0, 1), cB + hstepB, voffB); PG8_STAGE(PG8_SA(0, 1), cA + hstepA, voffA);
    if (wr == 1) PG8_BAR;
    PG8_WAIT_V(4); PG8_BAR;
    PG8_STAGE(PG8_SB(1, 0), cB + kstep, voffB); PG8_STAGE(PG8_SA(1, 0), cA + kstep, voffA); PG8_STAGE(PG8_SB(1, 1), cB + hstepB + kstep, voffB);
    PG8_WAIT_V(6); PG8_BAR;
    for (;;) {
        const bool has_next = S.next(ui + 1, nxt);
        const char* nA = has_next ? nxt.a : cA; const char* nB = has_next ? nxt.b : cB;
        for (int t = 0; t < nt; t += 2) {
            const bool last = (t == nt - 2);
            const char* a1 = cA + (size_t)(t + 1) * kstep;
            const char* a2 = last ? nA : cA + (size_t)(t + 2) * kstep; const char* b2 = last ? nB : cB + (size_t)(t + 2) * kstep;
            const char* a3 = a2 + kstep; const char* b3 = b2 + kstep;
            PG8_LDB(B0, 0, 0); PG8_SCHED; PG8_LDA(At, 0, 0); PG8_STAGE(PG8_SA(1, 1), a1 + hstepA, voffA);
            PG8_WAIT_L(8); PG8_BAR; PG8_WAIT_L(0); PG8_MMA(0, 0, At, B0); PG8_BAR; PG8_SCHED;
            PG8_LDB(B1, 0, 1); PG8_STAGE(PG8_SB(0, 0), b2, voffB);
            PG8_BAR; PG8_WAIT_L(0); PG8_MMA(0, 1, At, B1); PG8_BAR;
            PG8_LDA(At, 0, 1); PG8_STAGE(PG8_SA(0, 0), a2, voffA);
            PG8_BAR; PG8_WAIT_L(0); PG8_MMA(1, 0, At, B0); PG8_BAR; PG8_SCHED;
            PG8_STAGE(PG8_SB(0, 1), b2 + hstepB, voffB);
            PG8_WAIT_V(6); PG8_BAR; PG8_MMA(1, 1, At, B1); PG8_BAR;
            PG8_LDB(B0, 1, 0); PG8_SCHED; PG8_LDA(At, 1, 0); PG8_STAGE(PG8_SA(0, 1), a2 + hstepA, voffA);
            PG8_WAIT_L(8); PG8_BAR; PG8_WAIT_L(0); PG8_MMA(0, 0, At, B0); PG8_BAR; PG8_SCHED;
            PG8_LDB(B1, 1, 1); PG8_STAGE(PG8_SB(1, 0), b3, voffB);
            PG8_BAR; PG8_WAIT_L(0); PG8_MMA(0, 1, At, B1); PG8_BAR;
            PG8_LDA(At, 1, 1); PG8_STAGE(PG8_SA(1, 0), a3, voffA);
            PG8_BAR; PG8_WAIT_L(0); PG8_MMA(1, 0, At, B0); PG8_BAR; PG8_SCHED;
            PG8_STAGE(PG8_SB(1, 1), b3 + hstepB, voffB);
            PG8_WAIT_V(6); PG8_BAR; PG8_MMA(1, 1, At, B1); PG8_BAR;
        }
#pragma unroll
        for (int ai = 0; ai < 2; ++ai)
#pragma unroll
            for (int m = 0; m < 4; ++m)
#pragma unroll
                for (int bj = 0; bj < 2; ++bj)
#pragma unroll
                    for (int n = 0; n < 2; ++n) E(cur.row0 + ai * HALF + wr * 64 + m * 16 + fr, cur.col0 + bj * HALF + wc * 32 + n * 16 + 4 * fq, acc[ai][bj][m][n]);
        if (!has_next) break;
#pragma unroll
        for (int a = 0; a < 2; ++a)
#pragma unroll
            for (int b = 0; b < 2; ++b)
#pragma unroll
                for (int m = 0; m < 4; ++m)
#pragma unroll
                    for (int n = 0; n < 2; ++n) acc[a][b][m][n] = (f32x4){0.f, 0.f, 0.f, 0.f};
        cur = nxt; cA = nA; cB = nB; ++ui;
    }
    PG8_WAIT_V(0);
    if (wr == 0) PG8_BAR;
    PG8_BAR;
#undef PG8_SA
#undef PG8_SB
#undef PG8_STAGE
#undef PG8_LDA
#undef PG8_LDB
#undef PG8_MMA
#undef PG8_WAIT_V
#undef PG8_WAIT_L
#undef PG8_BAR
#undef PG8_SCHED
}
__device__ __forceinline__ long unit_index(int i) {
    const int G = gridDim.x, c = blockIdx.x;
    if (G == 256) return ((long)i * 8 + (c & 7)) * 32 + (c >> 3);
    return (long)i * G + c;
}
}

__device__ __forceinline__ const bf16_t* wsm(const Params& p, int j, size_t off) { return (const bf16_t*)(p.ws + OFF_WSM) + (size_t)j * WJ_SIZE + off; }

__device__ __forceinline__ void phase_mix(const Params& p, int j) {
    const bf16_t* H = (const bf16_t*)(p.ws + OFF_H);
    const float* mix = p.in[8] + (size_t)j * 6 * D;
    bf16_t* XM = (bf16_t*)(p.ws + OFF_LW);
    const int tid_ = tidx(), lane = tid_ & 63, wid = tid_ >> 6;
    for (int row = blockIdx.x * 8 + wid; row < NT; row += gridDim.x * 8) {
#pragma unroll
        for (int cc = 0; cc < 2; ++cc) {
            const int k = cc * 512 + lane * 8;
            int nb;
            if (row < NLAT) {
                const int t = row & (TL - 1), gc = t & 63, gr = t >> 6, q = k >> 8;
                if (q == 0) nb = gc > 0 ? row - 1 : -1;
                else if (q == 1) nb = gc < 63 ? row + 1 : -1;
                else if (q == 2) nb = gr > 0 ? row - 64 : -1;
                else nb = gr < 63 ? row + 64 : -1;
            } else {
                const int t = (row - NLAT) & (TC - 1);
                if (k < 512) nb = t > 0 ? row - 1 : -1;
                else nb = t < TC - 1 ? row + 1 : -1;
            }
            const u32x4 h = *(const u32x4*)(H + (size_t)row * D + k);
            u32x4 s = (u32x4){0u, 0u, 0u, 0u};
            if (nb >= 0) s = *(const u32x4*)(H + (size_t)nb * D + k);
#pragma unroll
            for (int w = 0; w < 3; ++w) {
                const int mi = w == 0 ? 0 : (w == 1 ? 2 : 3);
                const float4 m0 = *(const float4*)(mix + mi * D + k), m1 = *(const float4*)(mix + mi * D + k + 4);
                u32x4 o;
                { float x = bflo(h[0]), y = bfhi(h[0]); o[0] = pack2(x + (bflo(s[0]) - x) * m0.x, y + (bfhi(s[0]) - y) * m0.y); }
                { float x = bflo(h[1]), y = bfhi(h[1]); o[1] = pack2(x + (bflo(s[1]) - x) * m0.z, y + (bfhi(s[1]) - y) * m0.w); }
                { float x = bflo(h[2]), y = bfhi(h[2]); o[2] = pack2(x + (bflo(s[2]) - x) * m1.x, y + (bfhi(s[2]) - y) * m1.y); }
                { float x = bflo(h[3]), y = bfhi(h[3]); o[3] = pack2(x + (bflo(s[3]) - x) * m1.z, y + (bfhi(s[3]) - y) * m1.w); }
                *(u32x4*)(XM + (size_t)w * NT * D + (size_t)row * D + k) = o;
            }
        }
    }
}

struct SchedGrid {
    const char* A; const char* B; size_t a_mat, b_mat, a_rt, a_ct, b_ct; int cpm, total;
    __device__ __forceinline__ bool next(int i, g256::Unit& u) const {
        const long L = g256::unit_index(i);
        if (L >= total) return false;
        const int chunk = (int)(L >> 5), o = (int)(L & 31), mat = chunk / cpm, ch = chunk % cpm, rt = ch * 8 + (o >> 2), ct = o & 3;
        u.a = A + (size_t)mat * a_mat + (size_t)rt * a_rt + (size_t)ct * a_ct; u.b = B + (size_t)mat * b_mat + (size_t)ct * b_ct;
        u.row0 = rt * 256; u.col0 = mat * 1024 + ct * 256;
        return true;
    }
};
struct EpRKV {
    bf16_t* R; long vdelta;
    __device__ __forceinline__ void operator()(int row, int col, f32x4 v) const {
        const int mat = col >> 10, c = col & 1023;
        bf16_t* O = R + (size_t)mat * NT * D + (mat == 2 ? vdelta : 0l);
        u32x2 o; o[0] = pack2(v[0], v[1]); o[1] = pack2(v[2], v[3]);
        *(u32x2*)(O + (size_t)row * D + c) = o;
    }
};

__device__ __forceinline__ void phase_rwkv_proj(const Params& p, int j, char* lds) {
    const bf16_t* H = (const bf16_t*)(p.ws + OFF_H);
    const float* mix = p.in[8] + (size_t)j * 6 * D;
    bf16_t* R = (bf16_t*)(p.ws + OFF_R);
    bf16_t* V = (bf16_t*)(p.ws + (j == 0 ? OFF_VF : OFF_Y));
    bf16_t* LD = (bf16_t*)(p.ws + OFF_LD);
    const bf16_t* XM = (const bf16_t*)(p.ws + OFF_LW);
    {
        SchedGrid S{(const char*)XM, (const char*)wsm(p, j, WJ_RKV), (size_t)NT * D * 2, (size_t)D * D * 2, (size_t)256 * D * 2, 0, (size_t)256 * D * 2, NT / 256 / 8, 3 * (NT / 256) * 4};
        EpRKV E{R, (long)(V - (R + (size_t)2 * NT * D))};
        g256::gemm_phase((LAS unsigned char*)lds, D, D, D, S, E);
    }
    constexpr int RT = NT / 128;
    const int nsmall = (j == 0 ? 3 : 4) * RT;
    for (int u = blockIdx.x; u < nsmall; u += gridDim.x) {
        const int which = u / RT, rt = u % RT;
        EpStoreBf16 ep{LD + (size_t)which * NT * 128, 128, which == 0 ? 1 : (which == 2 ? 2 : 0)};
        if (which < 3) {
            const int mi = which == 0 ? 1 : (which == 1 ? 4 : 5);
            MixLoader al{H, mix + mi * D};
            const bf16_t* Bt = which == 0 ? wsm(p, j, WJ_W1) : which == 1 ? wsm(p, j, WJ_A1) : wsm(p, j, WJ_G1);
            gemm_tile_small(lds, al, Bt, D, D, rt * 128, 0, ep);
        } else {
            PlainLoader al{XM + (size_t)2 * NT * D, D};
            gemm_tile_small(lds, al, (const bf16_t*)(p.ws + OFF_WSM) + W_V1, D, D, rt * 128, 0, ep);
        }
    }
}

__device__ __forceinline__ void phase_rwkv_up(const Params& p, int j, char* lds) {
    bf16_t* LD = (bf16_t*)(p.ws + OFF_LD);
    bf16_t* LW = (bf16_t*)(p.ws + OFF_LW); bf16_t* AD = (bf16_t*)(p.ws + OFF_AD); bf16_t* G = (bf16_t*)(p.ws + OFF_G);
    constexpr int RT = NT / 128;
    const int per = RT * 8, ntot = (j == 0 ? 5 : 6) * per;
    for (int u = blockIdx.x; u < ntot; u += gridDim.x) {
        const int which = u / per, r = u % per, rt = r / 8, ct = r % 8;
        if (which < 2) {
            const int d = which;
            PlainLoader al{LD + d * 64, 128};
            EpDecay ep{LW + (size_t)d * NT * D, p.in[10] + ((size_t)j * 2 + d) * D};
            gemm_tile_small(lds, al, wsm(p, j, WJ_W2) + (size_t)d * D * 64, 64, 64, rt * 128, ct * 128, ep);
        } else if (which < 4) {
            const int d = which - 2;
            PlainLoader al{LD + (size_t)NT * 128 + d * 64, 128};
            EpSigBias ep{AD + (size_t)d * NT * D, p.in[13] + ((size_t)j * 2 + d) * D};
            gemm_tile_small(lds, al, wsm(p, j, WJ_A2) + (size_t)d * D * 64, 64, 64, rt * 128, ct * 128, ep);
        } else if (which == 4) {
            PlainLoader al{LD + (size_t)2 * NT * 128, 128};
            EpStoreBf16 ep{G, D, 0};
            gemm_tile_small(lds, al, wsm(p, j, WJ_G2), 128, 128, rt * 128, ct * 128, ep);
        } else {
            PlainLoader al{LD + (size_t)3 * NT * 128, 128};
            EpVres ep{(bf16_t*)(p.ws + OFF_VF), (const bf16_t*)(p.ws + OFF_Y), p.in[16]};
            gemm_tile_small(lds, al, (const bf16_t*)(p.ws + OFF_WSM) + W_V2, 64, 64, rt * 128, ct * 128, ep);
        }
    }
}

__device__ __forceinline__ void phase_rwkv_prep(const Params& p, int j) {
    const bf16_t* R = (const bf16_t*)(p.ws + OFF_R); const bf16_t* Kb = (const bf16_t*)(p.ws + OFF_K);
    const bf16_t* AD = (const bf16_t*)(p.ws + OFF_AD);
    bf16_t* KK = (bf16_t*)(p.ws + OFF_H); float* BON = (float*)(p.ws + OFF_BON);
    const float* k_k = p.in[21] + (size_t)j * D; const float* k_a = p.in[22] + (size_t)j * D; const float* r_k = p.in[23] + (size_t)j * D;
    const int tid_ = tidx(), lane = tid_ & 63, wid = tid_ >> 6, c0 = lane * 16;
    float kkw[16], kaw[16], rkw[16];
#pragma unroll
    for (int i = 0; i < 16; ++i) { kkw[i] = k_k[c0 + i]; kaw[i] = k_a[c0 + i]; rkw[i] = r_k[c0 + i]; }
    for (int row = blockIdx.x * 8 + wid; row < NT; row += gridDim.x * 8) {
        const size_t o = (size_t)row * D + c0;
        u32x4 kv[2], rv[2], a0[2], a1[2];
#pragma unroll
        for (int i = 0; i < 2; ++i) {
            kv[i] = *(const u32x4*)(Kb + o + i * 8); rv[i] = *(const u32x4*)(R + o + i * 8);
            a0[i] = *(const u32x4*)(AD + o + i * 8); a1[i] = *(const u32x4*)(AD + (size_t)NT * D + o + i * 8);
        }
        float kk[16]; float n2 = 0.f, bon = 0.f;
#pragma unroll
        for (int i = 0; i < 16; ++i) {
            const unsigned kw = kv[i >> 3][(i >> 1) & 3], rw = rv[i >> 3][(i >> 1) & 3], aw0 = a0[i >> 3][(i >> 1) & 3], aw1 = a1[i >> 3][(i >> 1) & 3];
            const float k = (i & 1) ? bfhi(kw) : bflo(kw), r = (i & 1) ? bfhi(rw) : bflo(rw);
            const float am = 0.5f * (((i & 1) ? bfhi(aw0) : bflo(aw0)) + ((i & 1) ? bfhi(aw1) : bflo(aw1)));
            kk[i] = k * kkw[i]; n2 += kk[i] * kk[i];
            bon += r * (k * (1.f + (am - 1.f) * kaw[i])) * rkw[i];
        }
        n2 += __shfl_xor(n2, 1, 64); n2 += __shfl_xor(n2, 2, 64);
        bon += __shfl_xor(bon, 1, 64); bon += __shfl_xor(bon, 2, 64);
        const float inv = 1.f / fmaxf(sqrtf(n2), 1e-12f);
        u32x4 ov[2];
#pragma unroll
        for (int i = 0; i < 8; ++i) ov[i >> 2][i & 3] = pack2(kk[2 * i] * inv, kk[2 * i + 1] * inv);
        *(u32x4*)(KK + o) = ov[0]; *(u32x4*)(KK + o + 8) = ov[1];
        if ((lane & 3) == 0) BON[(size_t)row * 16 + (lane >> 2)] = bon;
    }
}

__device__ __forceinline__ void phase_rwkv_scan(const Params& p, int j, char* lds) {
    const bf16_t* R = (const bf16_t*)(p.ws + OFF_R); const bf16_t* Kb = (const bf16_t*)(p.ws + OFF_K);
    const bf16_t* V = (const bf16_t*)(p.ws + OFF_VF); const bf16_t* KK = (const bf16_t*)(p.ws + OFF_H);
    const bf16_t* LW = (const bf16_t*)(p.ws + OFF_LW); const bf16_t* AD = (const bf16_t*)(p.ws + OFF_AD);
    bf16_t* Y = (bf16_t*)(p.ws + OFF_Y);
    float* ex = (float*)lds;
    const int tid = tidx(), lane = tid & 63, wid = tid >> 6, cl = wid >> 2, q = wid & 3, jj = lane & 15;
    for (int cp = blockIdx.x; cp < 256; cp += gridDim.x) {
        const int chain = cp * 2 + cl, d = chain & 1, bh = chain >> 1, b = bh >> 4, h = bh & 15;
        const int col = h * 64 + q * 16 + jj, vcol = h * 64 + lane;
        const float ka = p.in[22][(size_t)j * D + col];
        const bf16_t* LWd = LW + (size_t)d * NT * D; const bf16_t* ADd = AD + (size_t)d * NT * D;
        bf16_t* Yd = Y + (size_t)d * NT * D;
        float S[16];
#pragma unroll
        for (int i = 0; i < 16; ++i) S[i] = 0.f;
        float py = 0.f; int prev_row = -1; int buf = 0;
        auto row_of = [&](int s) -> int {
            if (s < TC) { const int t = d ? (TC - 1 - s) : s; return NLAT + b * TC + t; }
            const int tl = s - TC; const int t = d ? (TL - 1 - tl) : tl; return b * TL + t;
        };
        bf16_t nr[4], nkk[4], nk[4], nlw[4], na[4], nv[4];
#pragma unroll
        for (int g = 0; g < 4; ++g) {
            const size_t o = (size_t)row_of(g) * D;
            nr[g] = R[o + col]; nkk[g] = KK[o + col]; nk[g] = Kb[o + col]; nlw[g] = LWd[o + col]; na[g] = ADd[o + col]; nv[g] = V[o + vcol];
        }
        constexpr int NSTEP = TC + TL;
        for (int s0 = 0; s0 < NSTEP; s0 += 4) {
            bf16_t cr[4], ckk[4], ck[4], clw[4], ca[4], cv[4];
#pragma unroll
            for (int g = 0; g < 4; ++g) { cr[g] = nr[g]; ckk[g] = nkk[g]; ck[g] = nk[g]; clw[g] = nlw[g]; ca[g] = na[g]; cv[g] = nv[g]; }
            if (s0 + 4 < NSTEP) {
#pragma unroll
                for (int g = 0; g < 4; ++g) {
                    const size_t o = (size_t)row_of(s0 + 4 + g) * D;
                    nr[g] = R[o + col]; nkk[g] = KK[o + col]; nk[g] = Kb[o + col]; nlw[g] = LWd[o + col]; na[g] = ADd[o + col]; nv[g] = V[o + vcol];
                }
            }
#pragma unroll
            for (int g = 0; g < 4; ++g) {
                const float rr = bf2f(cr[g]), kkv = bf2f(ckk[g]), kv = bf2f(ck[g]), av = bf2f(ca[g]), vv = bf2f(cv[g]);
                const float dec = __expf(bf2f(clw[g])), bb = kkv * av, kd = kv * (1.f + (av - 1.f) * ka);
                float psa = 0.f;
#pragma unroll
                for (int i = 0; i < 16; ++i) psa += S[i] * rdlane(kkv, i);
                float* e = ex + ((buf * 2 + cl) * 4 + q) * 128;
                e[lane] = psa; e[64 + lane] = py;
                __syncthreads();
                const float* eb = ex + (buf * 2 + cl) * 4 * 128;
                const float sa = -(eb[lane] + eb[128 + lane] + eb[256 + lane] + eb[384 + lane]);
                if (q == 0 && prev_row >= 0) {
                    const float yv = eb[64 + lane] + eb[192 + lane] + eb[320 + lane] + eb[448 + lane];
                    Yd[(size_t)prev_row * D + vcol] = f2bf(yv);
                }
                py = 0.f;
#pragma unroll
                for (int i = 0; i < 16; ++i) {
                    const float w = rdlane(dec, i), b_ = rdlane(bb, i), k_ = rdlane(kd, i), r_ = rdlane(rr, i);
                    S[i] = S[i] * w + sa * b_ + vv * k_;
                    py += S[i] * r_;
                }
                prev_row = row_of(s0 + g);
                buf ^= 1;
            }
        }
        {
            float* e = ex + ((buf * 2 + cl) * 4 + q) * 128;
            e[64 + lane] = py;
            __syncthreads();
            const float* eb = ex + (buf * 2 + cl) * 4 * 128;
            if (q == 0) {
                const float yv = eb[64 + lane] + eb[192 + lane] + eb[320 + lane] + eb[448 + lane];
                Yd[(size_t)prev_row * D + vcol] = f2bf(yv);
            }
            __syncthreads();
        }
    }
}

__device__ __forceinline__ void phase_rwkv_out(const Params& p, int j) {
    const bf16_t* Y = (const bf16_t*)(p.ws + OFF_Y); const bf16_t* V = (const bf16_t*)(p.ws + OFF_VF); const bf16_t* G = (const bf16_t*)(p.ws + OFF_G);
    const float* BON = (const float*)(p.ws + OFF_BON);
    bf16_t* YO = (bf16_t*)(p.ws + OFF_LW);
    const float* lnw = p.in[24] + (size_t)j * D; const float* lnb = p.in[25] + (size_t)j * D;
    const int tid_ = tidx(), lane = tid_ & 63, wid = tid_ >> 6, c0 = lane * 16;
    for (int row = blockIdx.x * 8 + wid; row < NT; row += gridDim.x * 8) {
        const size_t o = (size_t)row * D + c0;
        u32x4 y0[2], y1[2], vv[2], gg[2];
#pragma unroll
        for (int i = 0; i < 2; ++i) {
            y0[i] = *(const u32x4*)(Y + o + i * 8); y1[i] = *(const u32x4*)(Y + (size_t)NT * D + o + i * 8);
            vv[i] = *(const u32x4*)(V + o + i * 8); gg[i] = *(const u32x4*)(G + o + i * 8);
        }
        float ov[16]; float s1 = 0.f;
#pragma unroll
        for (int i = 0; i < 16; ++i) {
            const unsigned w0 = y0[i >> 3][(i >> 1) & 3], w1 = y1[i >> 3][(i >> 1) & 3];
            ov[i] = ((i & 1) ? bfhi(w0) : bflo(w0)) + ((i & 1) ? bfhi(w1) : bflo(w1));
            s1 += ov[i];
        }
        s1 += __shfl_xor(s1, 1, 64); s1 += __shfl_xor(s1, 2, 64);
        const float mu = s1 * (1.f / 64.f);
        float s2 = 0.f;
#pragma unroll
        for (int i = 0; i < 16; ++i) { const float dd = ov[i] - mu; s2 += dd * dd; }
        s2 += __shfl_xor(s2, 1, 64); s2 += __shfl_xor(s2, 2, 64);
        const float rs = rsqrtf(s2 * (1.f / 64.f) + 64e-5f);
        const float bon = BON[(size_t)row * 16 + (lane >> 2)];
        float res[16];
#pragma unroll
        for (int i = 0; i < 16; ++i) {
            const unsigned vw = vv[i >> 3][(i >> 1) & 3], gw = gg[i >> 3][(i >> 1) & 3];
            const float v = (i & 1) ? bfhi(vw) : bflo(vw), g = (i & 1) ? bfhi(gw) : bflo(gw);
            res[i] = ((ov[i] - mu) * rs * lnw[c0 + i] + lnb[c0 + i] + bon * v) * g;
        }
        u32x4 w[2];
#pragma unroll
        for (int i = 0; i < 8; ++i) w[i >> 2][i & 3] = pack2(res[2 * i], res[2 * i + 1]);
        *(u32x4*)(YO + o) = w[0]; *(u32x4*)(YO + o + 8) = w[1];
    }
}

__device__ __forceinline__ void phase_rwkv_wo(const Params& p, int l, int j, char* lds) {
    EpResidual ep{(float*)(p.ws + OFF_X), (const float*)(p.ws + OFF_MOD) + (size_t)l * 17 * MODW + 2 * D, nullptr};
    SchedGrid S{p.ws + OFF_LW, (const char*)wsm(p, j, WJ_WO), 0, 0, (size_t)256 * D * 2, 0, (size_t)256 * D * 2, NT / 256 / 8, (NT / 256) * 4};
    g256::gemm_phase((LAS unsigned char*)lds, D, D, D, S, ep);
}

__device__ __forceinline__ void phase_pool_dlt(const Params& p, int nrows) {
    const bf16_t* H = (const bf16_t*)(p.ws + OFF_H); bf16_t* DL = (bf16_t*)(p.ws + OFF_DLT);
    const int tid_ = tidx(), lane = tid_ & 63, wid = tid_ >> 6;
    for (int row = blockIdx.x * 8 + wid; row < nrows; row += gridDim.x * 8) {
        int t, T, base;
        if (row < NLAT) { t = row & (TL - 1); T = TL; base = row - t; } else { t = (row - NLAT) & (TC - 1); T = TC; base = row - t; }
#pragma unroll
        for (int g = 0; g < 4; ++g) {
            const int half = 1 << g;
            const int lo = max(t - half, 0), hi = min(t + half, T);
            const int c = g * 256 + lane * 4;
            float s0 = 0.f, s1 = 0.f, s2 = 0.f, s3 = 0.f;
            for (int tt = lo; tt < hi; ++tt) {
                const u32x2 w = *(const u32x2*)(H + (size_t)(base + tt) * D + c);
                s0 += bflo(w[0]); s1 += bfhi(w[0]); s2 += bflo(w[1]); s3 += bfhi(w[1]);
            }
            const float inv = 1.f / (float)(hi - lo);
            const u32x2 hw = *(const u32x2*)(H + (size_t)row * D + c);
            u32x2 o; o[0] = pack2(s0 * inv - bflo(hw[0]), s1 * inv - bfhi(hw[0])); o[1] = pack2(s2 * inv - bflo(hw[1]), s3 * inv - bfhi(hw[1]));
            *(u32x2*)(DL + (size_t)row * D + c) = o;
        }
    }
}
__device__ __forceinline__ void phase_pool_gemm(const Params& p, int l, int j, int nrows, char* lds) {
    EpResidual ep{(float*)(p.ws + OFF_X), (const float*)(p.ws + OFF_MOD) + (size_t)l * 17 * MODW + 2 * D, p.in[28] + (size_t)j * D};
    SchedGrid S{p.ws + OFF_DLT, (const char*)wsm(p, j, WJ_POOL), 0, 0, (size_t)256 * D * 2, (size_t)256 * 2, (size_t)256 * 256 * 2, nrows / 256 / 8, (nrows / 256) * 4};
    g256::gemm_phase((LAS unsigned char*)lds, D, 256, 256, S, ep);
}

__device__ __forceinline__ void phase_topk(const Params& p, bool with_ctx, char* lds) {
    const float* AFF = (const float*)(p.ws + OFF_AFF);
    int* IDX = (int*)(p.ws + OFF_IDX); float* GTV = (float*)(p.ws + OFF_GTV); short* SLT = (short*)(p.ws + OFF_SLT);
    unsigned* keys = (unsigned*)lds;
    unsigned* hist = keys + 4096;
    unsigned* scan = hist + 256;
    unsigned* bc = scan + 512;
    const int tid = tidx();
    const int nunits = with_ctx ? 512 : 256;
    for (int u = blockIdx.x; u < nunits; u += gridDim.x) {
        const bool lat = u < 256;
        const int uu = lat ? u : u - 256, b = uu >> 4, e = uu & 15;
        const int n = lat ? TL : TC, kq = lat ? CAPL : CAPC, per = lat ? 8 : 1;
        const int rowbase = lat ? b * TL : NLAT + b * TC;
        for (int i = tid; i < n; i += NTHREADS) keys[i] = __float_as_uint(AFF[(size_t)(rowbase + i) * 16 + e]);
        __syncthreads();
        unsigned prefix = 0u, mask = 0u; int kth = kq;
        for (int ps = 0; ps < 4; ++ps) {
            const int shift = 24 - 8 * ps;
            if (tid < 256) hist[tid] = 0u;
            __syncthreads();
            for (int i = tid; i < n; i += NTHREADS) { const unsigned k = keys[i]; if ((k & mask) == prefix) atomicAdd(&hist[(k >> shift) & 255u], 1u); }
            __syncthreads();
            if (tid == 0) {
                int cum = 0, dg = 0, rem = kth;
                for (int bin = 255; bin >= 0; --bin) { const int hc = (int)hist[bin]; if (cum + hc >= kth) { dg = bin; rem = kth - cum; break; } cum += hc; }
                bc[0] = (unsigned)dg; bc[1] = (unsigned)rem;
            }
            __syncthreads();
            prefix |= bc[0] << shift; mask |= 255u << shift; kth = (int)bc[1];
            __syncthreads();
        }
        const unsigned Tk = prefix; const int need_eq = kth;
        const int t0 = tid * per; const bool act = t0 < n;
        int cgt = 0, ceq = 0;
        if (act) for (int i = 0; i < per; ++i) { const unsigned k = keys[t0 + i]; cgt += k > Tk; ceq += k == Tk; }
        scan[tid] = ((unsigned)cgt << 16) | (unsigned)ceq;
        __syncthreads();
        if (tid == 0) { unsigned run = 0; for (int i = 0; i < NTHREADS; ++i) { const unsigned v = scan[i]; scan[i] = run; run += v; } }
        __syncthreads();
        const unsigned ex = scan[tid];
        int gt_before = (int)(ex >> 16), eq_before = (int)(ex & 0xffffu);
        if (act) {
            for (int i = 0; i < per; ++i) {
                const int t = t0 + i; const unsigned k = keys[t];
                int slot = -1;
                if (k > Tk) { slot = gt_before + min(eq_before, need_eq); ++gt_before; }
                else if (k == Tk) { if (eq_before < need_eq) slot = gt_before + eq_before; ++eq_before; }
                SLT[(size_t)(rowbase + t) * 16 + e] = (short)slot;
                if (slot >= 0) {
                    const int srow = lat ? (b * 16 + e) * CAPL + slot : NSLOT_LAT + (e * 16 + b) * CAPC + slot;
                    IDX[srow] = rowbase + t; GTV[srow] = __uint_as_float(k);
                }
            }
        }
        __syncthreads();
    }
}
__device__ __forceinline__ void phase_gather(const Params& p, bool with_ctx) {
    const bf16_t* H = (const bf16_t*)(p.ws + OFF_H); bf16_t* XG = (bf16_t*)(p.ws + OFF_XG);
    const int* IDX = (const int*)(p.ws + OFF_IDX);
    const int tid_ = tidx(), lane = tid_ & 63, wid = tid_ >> 6;
    const int nrows = with_ctx ? NSLOT : NSLOT_LAT;
    for (int r = blockIdx.x * 8 + wid; r < nrows; r += gridDim.x * 8) {
        const int src = IDX[r];
        const u32x4 a = *(const u32x4*)(H + (size_t)src * D + lane * 8), b = *(const u32x4*)(H + (size_t)src * D + 512 + lane * 8);
        *(u32x4*)(XG + (size_t)r * D + lane * 8) = a; *(u32x4*)(XG + (size_t)r * D + 512 + lane * 8) = b;
    }
}
__device__ __forceinline__ int expert_of_slotrow(int r) { return r < NSLOT_LAT ? ((r >> 9) & 15) : ((r - NSLOT_LAT) >> 9); }
struct SchedMoeUp {
    const char* XG; const char* W13; int cpe, total;
    __device__ __forceinline__ bool next(int i, g256::Unit& u) const {
        const long L = g256::unit_index(i);
        if (L >= total) return false;
        const int chunk = (int)(L >> 5), o = (int)(L & 31), e = chunk / cpe, r = chunk % cpe;
        int row0, ct;
        if (r < 16) { const int t = (r >> 1) * 4 + (o >> 3); ct = (r & 1) * 8 + (o & 7); row0 = ((t >> 1) * 16 + e) * CAPL + (t & 1) * 256; }
        else { ct = o & 15; row0 = NSLOT_LAT + e * 512 + (o >> 4) * 256; }
        u.a = XG + (size_t)row0 * D * 2; u.b = W13 + ((size_t)e * 4096 + ct * 256) * 1024 * 2; u.row0 = row0; u.col0 = ct * 256;
        return true;
    }
};
__device__ __forceinline__ void phase_moe_up(const Params& p, bool with_ctx, char* lds) {
    EpSwiglu ep{(bf16_t*)(p.ws + OFF_HID)};
    const int cpe = with_ctx ? 17 : 16;
    SchedMoeUp S{p.ws + OFF_XG, (const char*)((const bf16_t*)(p.ws + OFF_WM) + WM_13), cpe, 16 * cpe * 32};
    g256::gemm_phase((LAS unsigned char*)lds, D, D, D, S, ep);
}
struct SchedMoeDown {
    const char* HID; const char* W2; int total;
    __device__ __forceinline__ bool next(int i, g256::Unit& u) const {
        const long L = g256::unit_index(i);
        if (L >= total) return false;
        const int chunk = (int)(L >> 5), o = (int)(L & 31), ct = o & 3;
        int row0, e;
        if (chunk < 64) { e = chunk >> 2; const int t = (chunk & 3) * 8 + (o >> 2); row0 = ((t >> 1) * 16 + e) * CAPL + (t & 1) * 256; }
        else { e = (chunk - 64) * 4 + (o >> 3); row0 = NSLOT_LAT + e * 512 + ((o >> 2) & 1) * 256; }
        u.a = HID + (size_t)row0 * FF * 2; u.b = W2 + ((size_t)e * 1024 + ct * 256) * 2048 * 2; u.row0 = row0; u.col0 = ct * 256;
        return true;
    }
};
__device__ __forceinline__ void phase_moe_down(const Params& p, bool with_ctx, char* lds) {
    EpGateRow ep{(bf16_t*)(p.ws + OFF_YS), (const float*)(p.ws + OFF_GTV)};
    SchedMoeDown S{p.ws + OFF_HID, (const char*)((const bf16_t*)(p.ws + OFF_WM) + WM_2), (64 + (with_ctx ? 4 : 0)) * 32};
    g256::gemm_phase((LAS unsigned char*)lds, FF, FF, FF, S, ep);
}
__device__ __forceinline__ void phase_moe_combine(const Params& p, int l, int nrows) {
    float* X = (float*)(p.ws + OFF_X); const bf16_t* YS = (const bf16_t*)(p.ws + OFF_YS); const short* SLT = (const short*)(p.ws + OFF_SLT);
    const float* MOD = (const float*)(p.ws + OFF_MOD) + (size_t)l * 17 * MODW + 5 * D;
    const int tid_ = tidx(), lane = tid_ & 63, wid = tid_ >> 6;
    for (int row = blockIdx.x * 8 + wid; row < nrows; row += gridDim.x * 8) {
        float acc[16];
#pragma unroll
        for (int i = 0; i < 16; ++i) acc[i] = 0.f;
        const bool lat = row < NLAT;
        const int b = lat ? (row >> 12) : ((row - NLAT) >> 8);
        for (int e = 0; e < 16; ++e) {
            const int s = SLT[(size_t)row * 16 + e];
            if (s >= 0) {
                const int srow = lat ? (b * 16 + e) * CAPL + s : NSLOT_LAT + (e * 16 + b) * CAPC + s;
                const u32x4 a = *(const u32x4*)(YS + (size_t)srow * D + lane * 8), c = *(const u32x4*)(YS + (size_t)srow * D + 512 + lane * 8);
#pragma unroll
                for (int i = 0; i < 4; ++i) { acc[2 * i] += bflo(a[i]); acc[2 * i + 1] += bfhi(a[i]); acc[8 + 2 * i] += bflo(c[i]); acc[8 + 2 * i + 1] += bfhi(c[i]); }
            }
        }
        const float* gt = MOD + (size_t)mod_row(row) * MODW;
#pragma unroll
        for (int hh = 0; hh < 2; ++hh) {
            float* xp = X + (size_t)row * D + hh * 512 + lane * 8;
            const float* gp = gt + hh * 512 + lane * 8;
            float4 x0 = *(float4*)xp, x1 = *(float4*)(xp + 4);
            const float4 g0 = *(const float4*)gp, g1 = *(const float4*)(gp + 4);
            x0.x += g0.x * acc[hh * 8 + 0]; x0.y += g0.y * acc[hh * 8 + 1]; x0.z += g0.z * acc[hh * 8 + 2]; x0.w += g0.w * acc[hh * 8 + 3];
            x1.x += g1.x * acc[hh * 8 + 4]; x1.y += g1.y * acc[hh * 8 + 5]; x1.z += g1.z * acc[hh * 8 + 6]; x1.w += g1.w * acc[hh * 8 + 7];
            *(float4*)xp = x0; *(float4*)(xp + 4) = x1;
        }
    }
}
__device__ __forceinline__ void phase_final(const Params& p) {
    const float* X = (const float*)(p.ws + OFF_X); const float* g = p.in[33];
    const int tid_ = tidx(), lane = tid_ & 63, wid = tid_ >> 6;
    for (int row = blockIdx.x * 8 + wid; row < NLAT; row += gridDim.x * 8) {
        const float* xr = X + (size_t)row * D;
        float4 v[4]; float ss = 0.f;
#pragma unroll
        for (int i = 0; i < 4; ++i) { v[i] = *(const float4*)(xr + i * 256 + lane * 4); ss += v[i].x * v[i].x + v[i].y * v[i].y + v[i].z * v[i].z + v[i].w * v[i].w; }
        ss = wave_sum(ss);
        const float rs = rsqrtf(ss * (1.f / D) + 1e-6f);
#pragma unroll
        for (int i = 0; i < 4; ++i) {
            const float4 gg = *(const float4*)(g + i * 256 + lane * 4);
            float4 o; o.x = v[i].x * rs * gg.x; o.y = v[i].y * rs * gg.y; o.z = v[i].z * rs * gg.z; o.w = v[i].w * rs * gg.w;
            *(float4*)(p.out + (size_t)row * D + i * 256 + lane * 4) = o;
        }
    }
}

#define XB_TMO      128
#define XB_XCNT(j)  (256  + 64 * (j))
#define XB_XSUB(j)  (1280 + 64 * (j))
#define XB_XGEN(j)  (2304 + 64 * (j))
#define XB_TOP      3328
#define XB_TOPGEN   3392
#define XCD_BAR_WORDS 3456
#define XB_SPIN_CAP (1u << 25)
__device__ __forceinline__ unsigned xb_ld(unsigned* p)              { return __hip_atomic_load(p, __ATOMIC_RELAXED, __HIP_MEMORY_SCOPE_AGENT); }
__device__ __forceinline__ unsigned xb_add(unsigned* p, unsigned v) { return __hip_atomic_fetch_add(p, v, __ATOMIC_RELAXED, __HIP_MEMORY_SCOPE_AGENT); }
__device__ __forceinline__ unsigned xb_xcc_id() { return (unsigned)__builtin_amdgcn_s_getreg((3 << 11) | 20) & 0xFu; }
#define XB_SPIN(cond, bar) do { unsigned _sp = 0; while (cond) { __builtin_amdgcn_s_sleep(1); \
    if ((++_sp & 255u) == 0u) { if (xb_ld(&(bar)[XB_TMO])) break; if (_sp > XB_SPIN_CAP) { atomicAdd(&(bar)[XB_TMO], 1u); break; } } } } while (0)
struct XcdBarrier { unsigned* bar; unsigned x; volatile LAS unsigned* st; };
__device__ __forceinline__ XcdBarrier xcd_barrier_post(unsigned* bar, volatile LAS unsigned* st) {
    XcdBarrier b; b.bar = bar; b.x = xb_xcc_id(); b.st = st;
    if (threadIdx.x == 0) (void)xb_add(&bar[XB_XCNT(b.x)], 1u);
    return b;
}
__device__ __forceinline__ void xcd_barrier_complete(unsigned* bar, unsigned x, unsigned& nloc, unsigned& nx) {
    const unsigned G = gridDim.x * gridDim.y * gridDim.z;
    unsigned sum, cnt, mine, sp = 0u;
    for (;;) {
        sum = 0u; cnt = 0u; mine = 0u;
#pragma unroll
        for (unsigned j = 0; j < 16; ++j) { const unsigned c = xb_ld(&bar[XB_XCNT(j)]); sum += c; cnt += (c > 0u) ? 1u : 0u; mine = (j == x) ? c : mine; }
        if (sum == G) break;
        __builtin_amdgcn_s_sleep(1);
        if ((++sp & 255u) == 0u) { if (xb_ld(&bar[XB_TMO])) break; if (sp > XB_SPIN_CAP) { atomicAdd(&bar[XB_TMO], 1u); break; } }
    }
    nloc = mine > 0u ? mine : 1u; nx = cnt > 0u ? cnt : 1u;
}
__device__ __forceinline__ void xcd_barrier(const XcdBarrier& b) {
    asm volatile("s_waitcnt vmcnt(0)" ::: "memory");
    __syncthreads();
    if (threadIdx.x == 0) {
        unsigned* bar = b.bar;
        __builtin_amdgcn_s_waitcnt(0);
        unsigned nloc = b.st[0], nx = b.st[1];
        if (nloc == 0u) { xcd_barrier_complete(bar, b.x, nloc, nx); b.st[0] = nloc; b.st[1] = nx; }
        const unsigned old = xb_add(&bar[XB_XSUB(b.x)], 1u);
        const unsigned gen = old / nloc;
        if (old + 1u == (gen + 1u) * nloc) {
            __builtin_amdgcn_fence(__ATOMIC_RELEASE, "agent");
            asm volatile("s_waitcnt vmcnt(0)" ::: "memory");
            const unsigned og = xb_add(&bar[XB_TOP], 1u);
            const unsigned tg = og / nx;
            if (og + 1u == (tg + 1u) * nx) xb_add(&bar[XB_TOPGEN], 1u);
            else XB_SPIN(xb_ld(&bar[XB_TOPGEN]) == tg, bar);
            __builtin_amdgcn_fence(__ATOMIC_ACQUIRE, "agent");
            xb_add(&bar[XB_XGEN(b.x)], 1u);
            asm volatile("s_waitcnt vmcnt(0)" ::: "memory");
        } else {
            XB_SPIN(xb_ld(&bar[XB_XGEN(b.x)]) == gen, bar);
            __builtin_amdgcn_fence(__ATOMIC_ACQUIRE, "agent");
            asm volatile("s_waitcnt vmcnt(0)" ::: "memory");
        }
    }
    __syncthreads();
}

constexpr int NSMALLJOBS = 20;
__global__ void __launch_bounds__(NTHREADS, 2) k_mega(Params p) {
    extern __shared__ __attribute__((aligned(16))) char lds_all[];
    if (threadIdx.x == 0) *(uint4*)(lds_all + LDS_BYTES) = make_uint4(0u, 0u, 0u, 0u);
    __syncthreads();
    XcdBarrier bar = xcd_barrier_post((unsigned*)(p.ws + OFF_BAR), (volatile LAS unsigned*)(lds_all + LDS_BYTES));
    char* lds = lds_all;
#define GBAR xcd_barrier(bar)
    phase_cvt(p, 0, NSMALLJOBS, lds);
    phase_ada(p, lds);
    GBAR;
    for (int l = 0; l < 4; ++l) {
        const bool last = l == 3, rw = (l & 1) == 0; const int j = l >> 1;
        const int nrows = (!last || rw) ? NT : NLAT;
        phase_norm<false>(p, l, 0, nrows, lds); GBAR;
        if (rw) {
            phase_mix(p, j); GBAR;
            phase_rwkv_proj(p, j, lds); GBAR;
            phase_rwkv_up(p, j, lds); GBAR;
            phase_rwkv_prep(p, j); GBAR;
            phase_rwkv_scan(p, j, lds); GBAR;
            phase_rwkv_out(p, j); GBAR;
            phase_rwkv_wo(p, l, j, lds); GBAR;
        } else {
            phase_pool_dlt(p, nrows); GBAR;
            phase_pool_gemm(p, l, j, nrows, lds); GBAR;
        }
        const int mrows = last ? NLAT : NT;
        phase_cvt(p, NSMALLJOBS + 3 * l, NSMALLJOBS + 3 * l + 3, lds);
        phase_norm<true>(p, l, 1, mrows, lds); GBAR;
        phase_topk(p, !last, lds); GBAR;
        phase_gather(p, !last); GBAR;
        phase_moe_up(p, !last, lds); GBAR;
        phase_moe_down(p, !last, lds); GBAR;
        phase_moe_combine(p, l, mrows); GBAR;
    }
    phase_final(p);
#undef GBAR
}

enum { PH_CVT = 0, PH_ADA, PH_NORM1, PH_NORM2, PH_PROJ, PH_UP, PH_PREP, PH_SCAN, PH_OUT, PH_WO, PH_DLT, PH_POOLG, PH_TOPK, PH_GATHER, PH_MUP, PH_MDOWN, PH_COMB, PH_FINAL, PH_MIX };
template <int PH>
__global__ void __launch_bounds__(NTHREADS) k_phase(Params p, int a0, int a1, int a2) {
    extern __shared__ __attribute__((aligned(16))) char lds[];
    if (PH == PH_CVT) phase_cvt(p, a0, a1, lds);
    if (PH == PH_ADA) phase_ada(p, lds);
    if (PH == PH_NORM1) phase_norm<false>(p, a0, 0, a1, lds);
    if (PH == PH_NORM2) phase_norm<true>(p, a0, 1, a1, lds);
    if (PH == PH_PROJ) phase_rwkv_proj(p, a0, lds);
    if (PH == PH_UP) phase_rwkv_up(p, a0, lds);
    if (PH == PH_PREP) phase_rwkv_prep(p, a0);
    if (PH == PH_SCAN) phase_rwkv_scan(p, a0, lds);
    if (PH == PH_OUT) phase_rwkv_out(p, a0);
    if (PH == PH_WO) phase_rwkv_wo(p, a0, a1, lds);
    if (PH == PH_DLT) phase_pool_dlt(p, a0);
    if (PH == PH_POOLG) phase_pool_gemm(p, a0, a1, a2, lds);
    if (PH == PH_TOPK) phase_topk(p, a0 != 0, lds);
    if (PH == PH_GATHER) phase_gather(p, a0 != 0);
    if (PH == PH_MUP) phase_moe_up(p, a0 != 0, lds);
    if (PH == PH_MDOWN) phase_moe_down(p, a0 != 0, lds);
    if (PH == PH_COMB) phase_moe_combine(p, a0, a1);
    if (PH == PH_FINAL) phase_final(p);
    if (PH == PH_MIX) phase_mix(p, a0);
}

template <int PH>
static void launch(const Params& p, int a0, int a1, int a2, hipStream_t s) {
    static bool init = false;
    if (!init) { hipFuncSetAttribute((const void*)k_phase<PH>, hipFuncAttributeMaxDynamicSharedMemorySize, LDS_BYTES); init = true; }
    hipLaunchKernelGGL(k_phase<PH>, dim3(256), dim3(NTHREADS), LDS_BYTES, s, p, a0, a1, a2);
}

static int add_job(Params& p, int n, const float* src, bf16_t* dst, int K, int N, int src_ld, int dst_ld, int n_mul, int n_off, int Kpad, int Npad, int nbatch, long src_bs, long dst_bs) {
    CvtJob& J = p.jobs[n];
    J.src = src; J.dst = dst; J.src_bs = src_bs; J.dst_bs = dst_bs; J.K = K; J.N = N; J.src_ld = src_ld; J.dst_ld = dst_ld; J.n_mul = n_mul; J.n_off = n_off;
    J.Kpad = Kpad; J.Npad = Npad; J.nbatch = nbatch; J.tiles = nbatch * (Kpad / 64) * (Npad / 64);
    return n + 1;
}

extern "C" void kernel_launch(void* const* d_in, const int* in_sizes, int n_in, void* d_out, int out_size, void* d_ws, size_t ws_size, hipStream_t stream) {
    Params p;
    memset(&p, 0, sizeof(p));
    for (int i = 0; i < 34; ++i) p.in[i] = (const float*)d_in[i];
    p.out = (float*)d_out; p.ws = (char*)d_ws;
    if (ws_size < WS_NEED) { fprintf(stderr, "workspace too small: %zu < %zu\n", ws_size, (size_t)WS_NEED); }
    bf16_t* wsm_ = (bf16_t*)(p.ws + OFF_WSM);
    bf16_t* wm_ = (bf16_t*)(p.ws + OFF_WM);
    int nj = 0;
    for (int j = 0; j < 2; ++j) {
        bf16_t* base = wsm_ + (size_t)j * WJ_SIZE;
        nj = add_job(p, nj, p.in[9] + (size_t)j * 3 * D * D, base + WJ_RKV, D, D, D, D, 1, 0, D, D, 3, (long)D * D, (long)D * D);
        nj = add_job(p, nj, p.in[26] + (size_t)j * D * D, base + WJ_WO, D, D, D, D, 1, 0, D, D, 1, 0, 0);
        nj = add_job(p, nj, p.in[11] + (size_t)j * 2 * D * 64, base + WJ_W1, D, 64, 64, D, 1, 0, D, 64, 2, (long)D * 64, (long)64 * D);
        nj = add_job(p, nj, p.in[14] + (size_t)j * 2 * D * 64, base + WJ_A1, D, 64, 64, D, 1, 0, D, 64, 2, (long)D * 64, (long)64 * D);
        nj = add_job(p, nj, p.in[19] + (size_t)j * D * 128, base + WJ_G1, D, 128, 128, D, 1, 0, D, 128, 1, 0, 0);
        nj = add_job(p, nj, p.in[12] + (size_t)j * 2 * 64 * D, base + WJ_W2, 64, D, D, 64, 1, 0, 64, D, 2, (long)64 * D, (long)D * 64);
        nj = add_job(p, nj, p.in[15] + (size_t)j * 2 * 64 * D, base + WJ_A2, 64, D, D, 64, 1, 0, 64, D, 2, (long)64 * D, (long)D * 64);
        nj = add_job(p, nj, p.in[20] + (size_t)j * 128 * D, base + WJ_G2, 128, D, D, 128, 1, 0, 128, D, 1, 0, 0);
        nj = add_job(p, nj, p.in[27] + (size_t)j * 4 * 256 * 256, base + WJ_POOL, 256, 256, 256, 256, 1, 0, 256, 256, 4, 65536, 65536);
    }
    nj = add_job(p, nj, p.in[17], wsm_ + W_V1, D, 32, 32, D, 1, 0, D, 128, 1, 0, 0);
    nj = add_job(p, nj, p.in[18], wsm_ + W_V2, 32, D, D, 64, 1, 0, 64, D, 1, 0, 0);
    const int nsmall = nj;
    for (int l = 0; l < 4; ++l) {
        nj = add_job(p, nj, p.in[30] + (size_t)l * 16 * D * FF, wm_ + WM_13, D, FF, FF, D, 2, 0, D, FF, 16, (long)D * FF, (long)4096 * 1024);
        nj = add_job(p, nj, p.in[31] + (size_t)l * 16 * D * FF, wm_ + WM_13, D, FF, FF, D, 2, 1, D, FF, 16, (long)D * FF, (long)4096 * 1024);
        nj = add_job(p, nj, p.in[32] + (size_t)l * 16 * FF * D, wm_ + WM_2, FF, D, D, FF, 1, 0, FF, D, 16, (long)FF * D, (long)D * FF);
    }
    hipMemcpyAsync(p.ws + OFF_X, d_in[0], (size_t)NLAT * D * 4, hipMemcpyDeviceToDevice, stream);
    hipMemcpyAsync(p.ws + OFF_X + (size_t)NLAT * D * 4, d_in[2], (size_t)NCTX * D * 4, hipMemcpyDeviceToDevice, stream);
#if MK_MULTI
    launch<PH_CVT>(p, 0, nsmall, 0, stream);
    launch<PH_ADA>(p, 0, 0, 0, stream);
    for (int l = 0; l < 4; ++l) {
        const bool last = l == 3, rw = (l % 2) == 0; const int j = l / 2;
        const bool need_ctx = !last || rw;
        const int nrows = need_ctx ? NT : NLAT;
        launch<PH_NORM1>(p, l, nrows, 0, stream);
        if (rw) {
            launch<PH_MIX>(p, j, 0, 0, stream);
            launch<PH_PROJ>(p, j, 0, 0, stream);
            launch<PH_UP>(p, j, 0, 0, stream);
            launch<PH_PREP>(p, j, 0, 0, stream);
            launch<PH_SCAN>(p, j, 0, 0, stream);
            launch<PH_OUT>(p, j, 0, 0, stream);
            launch<PH_WO>(p, l, j, 0, stream);
        } else {
            launch<PH_DLT>(p, nrows, 0, 0, stream);
            launch<PH_POOLG>(p, l, j, nrows, stream);
        }
        const int mrows = last ? NLAT : NT;
        launch<PH_CVT>(p, nsmall + 3 * l, nsmall + 3 * l + 3, 0, stream);
        launch<PH_NORM2>(p, l, mrows, 0, stream);
        launch<PH_TOPK>(p, last ? 0 : 1, 0, 0, stream);
        launch<PH_GATHER>(p, last ? 0 : 1, 0, 0, stream);
        launch<PH_MUP>(p, last ? 0 : 1, 0, 0, stream);
        launch<PH_MDOWN>(p, last ? 0 : 1, 0, 0, stream);
        launch<PH_COMB>(p, l, mrows, 0, stream);
    }
    launch<PH_FINAL>(p, 0, 0, 0, stream);
#else
    (void)nsmall;
    static int grid = 0;
    if (!grid) {
        hipFuncSetAttribute((const void*)k_mega, hipFuncAttributeMaxDynamicSharedMemorySize, LDS_BYTES + 16);
        int dev = 0, cus = 0, per_cu = 0;
        hipGetDevice(&dev);
        hipDeviceGetAttribute(&cus, hipDeviceAttributeMultiprocessorCount, dev);
        hipOccupancyMaxActiveBlocksPerMultiprocessor(&per_cu, (const void*)k_mega, NTHREADS, LDS_BYTES + 16);
        grid = cus * (per_cu < 1 ? per_cu : 1);
        if (grid <= 0) { fprintf(stderr, "occupancy query returned %d blocks per CU\n", per_cu); grid = 0; return; }
    }
    hipMemsetAsync(p.ws + OFF_BAR, 0, XCD_BAR_WORDS * sizeof(unsigned), stream);
    hipLaunchKernelGGL(k_mega, dim3(grid), dim3(NTHREADS), LDS_BYTES + 16, stream, p);
#endif
}
```

```cpp
#include <hip/hip_runtime.h>
#include <stdint.h>
#include <stdio.h>
#include <string.h>
#ifndef MK_MULTI
#define MK_MULTI 0
#endif

typedef unsigned short bf16_t;
typedef short bf16x8 __attribute__((ext_vector_type(8)));
typedef float f32x4 __attribute__((ext_vector_type(4)));
typedef unsigned u32x4 __attribute__((ext_vector_type(4)));
typedef unsigned u32x2 __attribute__((ext_vector_type(2)));

constexpr int D = 1024, NB = 16, TL = 4096, TC = 256;
constexpr int NLAT = NB * TL, NCTX = NB * TC, NT = NLAT + NCTX;
constexpr int NE = 16, FF = 2048, CAPL = 512, CAPC = 32;
constexpr int NSLOT_LAT = NB * NE * CAPL, NSLOT_CTX = NB * NE * CAPC, NSLOT = NSLOT_LAT + NSLOT_CTX;
constexpr int MODW = 6 * D;
constexpr int NTHREADS = 512;
constexpr int LDS_BYTES = 128 * 1024;
constexpr int LDS_TOK = LDS_BYTES + 16;
constexpr int LDS_TOTAL = LDS_TOK + 1024;

constexpr size_t MiB = 1ull << 20;
constexpr size_t U = (size_t)NT * D * 2;
constexpr size_t OFF_BAR = 0;
constexpr size_t OFF_MOD = 64 * 1024;
constexpr size_t OFF_WSM = 2 * MiB;
constexpr size_t OFF_AFF = 26 * MiB;
constexpr size_t OFF_BON = 31 * MiB;
constexpr size_t OFF_BON2 = 41 * MiB;
constexpr size_t OFF_IDX = 36 * MiB;
constexpr size_t OFF_GTV = 37 * MiB;
constexpr size_t OFF_SLT = 38 * MiB;
constexpr size_t OFF_BIG = 48 * MiB;
constexpr size_t OFF_X = OFF_BIG;
constexpr size_t OFF_VF = OFF_BIG + 2 * U;
constexpr size_t OFF_H = OFF_BIG + 3 * U;
constexpr size_t OFF_R = OFF_BIG + 4 * U;
constexpr size_t OFF_K = OFF_BIG + 5 * U;
constexpr size_t OFF_LD = OFF_BIG + 6 * U;
constexpr size_t OFF_LW = OFF_BIG + 6 * U + U / 2;
constexpr size_t OFF_AD = OFF_BIG + 8 * U + U / 2;
constexpr size_t OFF_Y = OFF_BIG + 10 * U + U / 2;
constexpr size_t OFF_G = OFF_BIG + 12 * U + U / 2;
constexpr size_t OFF_WM = OFF_BIG + 4 * U;
constexpr size_t OFF_XG = OFF_BIG + 5 * U + U / 2;
constexpr size_t OFF_HID = OFF_BIG + 7 * U + U / 2;
constexpr size_t OFF_YS = OFF_BIG + 11 * U + U / 2;
constexpr size_t OFF_DLT = OFF_BIG + 4 * U;
constexpr size_t OFF_D1 = OFF_BIG + 13 * U + U / 2;
constexpr size_t WS_NEED = OFF_BIG + 14 * U + U / 2;

constexpr size_t WJ_RKV = 0;
constexpr size_t WJ_WO = 3 * 1048576;
constexpr size_t WJ_W1 = 4 * 1048576;
constexpr size_t WJ_A1 = WJ_W1 + 131072;
constexpr size_t WJ_G1 = WJ_A1 + 131072;
constexpr size_t WJ_W2 = WJ_G1 + 131072;
constexpr size_t WJ_A2 = WJ_W2 + 131072;
constexpr size_t WJ_G2 = WJ_A2 + 131072;
constexpr size_t WJ_POOL = WJ_G2 + 131072;
constexpr size_t WJ_SIZE = WJ_POOL + 262144;
constexpr size_t W_V1 = 2 * WJ_SIZE;
constexpr size_t W_V2 = W_V1 + 131072;
constexpr size_t WM_13 = 0;
constexpr size_t WM_2 = (size_t)16 * 4096 * 1024;
constexpr size_t WM8_2 = (size_t)16 * 4096 * 1024;
constexpr float W8_SCALE = 64.f;
#define MOE_F8 1
#ifndef PROBE_MASK
#define PROBE_MASK 0
#endif

struct CvtJob {
    const float* src; bf16_t* dst;
    long src_bs, dst_bs;
    int K, N, src_ld, dst_ld, n_mul, n_off, Kpad, Npad, nbatch, tiles;
    int f8; float scale;
};
constexpr int NJOBS = 32;
struct Params {
    const float* in[34];
    float* out;
    char* ws;
    CvtJob jobs[NJOBS];
};

__device__ __forceinline__ float bf2f(bf16_t v) { return __uint_as_float(((unsigned)v) << 16); }
__device__ __forceinline__ bf16_t f2bf(float f) { unsigned u = __float_as_uint(f); u += 0x7FFFu + ((u >> 16) & 1u); return (bf16_t)(u >> 16); }
typedef __bf16 bf16x2_t __attribute__((ext_vector_type(2)));
typedef float f32x2_t __attribute__((ext_vector_type(2)));
__device__ __forceinline__ unsigned pack2(float lo, float hi) {
    const f32x2_t v = {lo, hi};
    return __builtin_bit_cast(unsigned, __builtin_convertvector(v, bf16x2_t));
}
__device__ __forceinline__ float bflo(unsigned w) { return __uint_as_float(w << 16); }
__device__ __forceinline__ float bfhi(unsigned w) { return __uint_as_float(w & 0xffff0000u); }
typedef unsigned u32x2_t __attribute__((ext_vector_type(2)));
__device__ __forceinline__ float red4(float x) {
    const unsigned u = __float_as_uint(x);
    const u32x2_t a = __builtin_amdgcn_permlane16_swap(u, u, false, false);
    const float t = __uint_as_float(a[0]) + __uint_as_float(a[1]);
    const unsigned v = __float_as_uint(t);
    const u32x2_t b = __builtin_amdgcn_permlane32_swap(v, v, false, false);
    return __uint_as_float(b[0]) + __uint_as_float(b[1]);
}
__device__ __forceinline__ float wave_sum(float v) {
    v += __uint_as_float(__builtin_amdgcn_update_dpp(0u, __float_as_uint(v), 0xB1, 0xf, 0xf, true));
    v += __uint_as_float(__builtin_amdgcn_update_dpp(0u, __float_as_uint(v), 0x4E, 0xf, 0xf, true));
    v += __uint_as_float(__builtin_amdgcn_update_dpp(0u, __float_as_uint(v), 0x141, 0xf, 0xf, true));
    v += __uint_as_float(__builtin_amdgcn_update_dpp(0u, __float_as_uint(v), 0x140, 0xf, 0xf, true));
    return red4(v);
}
__device__ __forceinline__ float sigmoidf_(float x) { return __builtin_amdgcn_rcpf(1.f + __expf(-x)); }
__device__ __forceinline__ float siluf_(float x) { return x * __builtin_amdgcn_rcpf(1.f + __expf(-x)); }
__device__ __forceinline__ float rdlane(float v, int l) { return __uint_as_float(__builtin_amdgcn_readlane(__float_as_uint(v), l)); }

__device__ __forceinline__ int tidx() { int t = threadIdx.x; asm volatile("" : "+v"(t)); return t; }
__device__ __forceinline__ void lds_barrier() { asm volatile("s_waitcnt lgkmcnt(0)\n\ts_barrier" ::: "memory"); }

__device__ __forceinline__ int mod_row(int row) { return row < NLAT ? (row >> 12) : 16; }

__device__ __forceinline__ void phase_cvt(const Params& p, int jlo, int jhi, char* lds) {
    float* tile = (float*)lds;
#define CVT_T(k, n) tile[(k) * 321 + ((n) & 3) * 66 + ((n) >> 2)]
    const int tid = tidx();
    int total = 0;
    for (int j = jlo; j < jhi; ++j) total += p.jobs[j].tiles;
    auto locate = [&](int u, int& j, int& bt, int& kt, int& nt) {
        j = jlo; int uu = u;
        while (uu >= p.jobs[j].tiles) { uu -= p.jobs[j].tiles; ++j; }
        const int tk = p.jobs[j].Kpad / 64, tn = (p.jobs[j].Npad + 255) / 256;
        bt = uu / (tk * tn); const int r = uu % (tk * tn); kt = r / tn; nt = r % tn;
    };
    auto load = [&](int j, int bt, int kt, int nt, float4 (&v)[8]) {
        const CvtJob& J = p.jobs[j];
        const float* src = J.src + (size_t)bt * J.src_bs;
#pragma unroll
        for (int ps = 0; ps < 8; ++ps) {
            const int kl = ps * 8 + (tid >> 6), k = kt * 64 + kl, n = nt * 256 + (tid & 63) * 4;
            v[ps] = make_float4(0.f, 0.f, 0.f, 0.f);
            if (k < J.K) {
                const float* sp = src + (size_t)k * J.src_ld + n;
                if (n + 3 < J.N) v[ps] = *(const float4*)sp;
                else { if (n < J.N) v[ps].x = sp[0]; if (n + 1 < J.N) v[ps].y = sp[1]; if (n + 2 < J.N) v[ps].z = sp[2]; }
            }
        }
    };
    int u = blockIdx.x;
    if (u >= total) return;
    int j, bt, kt, nt;
    float4 v[8], v2[8];
    locate(u, j, bt, kt, nt);
    load(j, bt, kt, nt, v);
    int jn = j, btn = bt, ktn = kt, ntn = nt;
    if (u + (int)gridDim.x < total) { locate(u + gridDim.x, jn, btn, ktn, ntn); load(jn, btn, ktn, ntn, v2); }
    for (;;) {
#pragma unroll
        for (int ps = 0; ps < 8; ++ps) {
            float* tp = tile + (ps * 8 + (tid >> 6)) * 321 + (tid & 63);
            tp[0] = v[ps].x; tp[66] = v[ps].y; tp[132] = v[ps].z; tp[198] = v[ps].w;
        }
        lds_barrier();
        const int un = u + gridDim.x, un2 = un + gridDim.x;
        const int jc = jn, btc = btn, ktc = ktn, ntc = ntn;
        if (un < total) {
#pragma unroll
            for (int ps = 0; ps < 8; ++ps) v[ps] = v2[ps];
            if (un2 < total) { locate(un2, jn, btn, ktn, ntn); load(jn, btn, ktn, ntn, v2); }
        }
        const CvtJob& J = p.jobs[j];
        if (J.f8) {
            char* dstb = (char*)J.dst + (size_t)bt * J.dst_bs;
            const float sc = J.scale;
#pragma unroll
            for (int ps = 0; ps < 4; ++ps) {
                const int nl = ps * 64 + (tid >> 3), kc = tid & 7, n = nt * 256 + nl;
                if (n < J.Npad) {
                    int w0 = 0, w1 = 0;
                    w0 = __builtin_amdgcn_cvt_pk_fp8_f32(CVT_T(kc * 8 + 0, nl) * sc, CVT_T(kc * 8 + 1, nl) * sc, w0, false);
                    w0 = __builtin_amdgcn_cvt_pk_fp8_f32(CVT_T(kc * 8 + 2, nl) * sc, CVT_T(kc * 8 + 3, nl) * sc, w0, true);
                    w1 = __builtin_amdgcn_cvt_pk_fp8_f32(CVT_T(kc * 8 + 4, nl) * sc, CVT_T(kc * 8 + 5, nl) * sc, w1, false);
                    w1 = __builtin_amdgcn_cvt_pk_fp8_f32(CVT_T(kc * 8 + 6, nl) * sc, CVT_T(kc * 8 + 7, nl) * sc, w1, true);
                    const u32x2 o = {(unsigned)w0, (unsigned)w1};
                    *(u32x2*)(dstb + ((size_t)n * J.n_mul + J.n_off) * J.dst_ld + kt * 64 + kc * 8) = o;
                }
            }
        } else {
            bf16_t* dst = J.dst + (size_t)bt * J.dst_bs;
#pragma unroll
            for (int ps = 0; ps < 4; ++ps) {
                const int nl = ps * 64 + (tid >> 3), kc = tid & 7, n = nt * 256 + nl;
                if (n < J.Npad) {
                    u32x4 o;
                    o[0] = pack2(CVT_T(kc * 8 + 0, nl), CVT_T(kc * 8 + 1, nl));
                    o[1] = pack2(CVT_T(kc * 8 + 2, nl), CVT_T(kc * 8 + 3, nl));
                    o[2] = pack2(CVT_T(kc * 8 + 4, nl), CVT_T(kc * 8 + 5, nl));
                    o[3] = pack2(CVT_T(kc * 8 + 6, nl), CVT_T(kc * 8 + 7, nl));
                    *(u32x4*)(dst + ((size_t)n * J.n_mul + J.n_off) * J.dst_ld + kt * 64 + kc * 8) = o;
                }
            }
        }
        lds_barrier();
        if (un >= total) break;
        u = un; j = jc; bt = btc; kt = ktc; nt = ntc;
    }
}
#undef CVT_T

__device__ __forceinline__ void phase_ada(const Params& p, char* lds) {
    float* sc = (float*)lds;
    float* red = sc + 17 * 1024;
    const int tid = tidx();
    const float* c = p.in[1]; const float* cctx = p.in[3];
    for (int i = tid; i < 17 * 1024; i += NTHREADS) {
        const float v = i < 16 * 1024 ? c[i] : cctx[i - 16 * 1024];
        sc[i] = siluf_(v);
    }
    __syncthreads();
    float* MOD = (float*)(p.ws + OFF_MOD);
    const int col = tid & 63, ks = tid >> 6;
    for (int u = blockIdx.x; u < 4 * 96; u += gridDim.x) {
        const int l = u / 96, n = (u % 96) * 64 + col;
        const float* w = p.in[4] + (size_t)l * D * MODW + n;
        float acc[17];
#pragma unroll
        for (int r = 0; r < 17; ++r) acc[r] = 0.f;
        for (int k = ks * 128; k < ks * 128 + 128; ++k) {
            const float wv = w[(size_t)k * MODW];
#pragma unroll
            for (int r = 0; r < 17; ++r) acc[r] += sc[r * 1024 + k] * wv;
        }
#pragma unroll
        for (int r = 0; r < 17; ++r) red[(ks * 17 + r) * 64 + col] = acc[r];
        __syncthreads();
        for (int i = tid; i < 17 * 64; i += NTHREADS) {
            const int r = i >> 6, cc = i & 63;
            float s = 0.f;
#pragma unroll
            for (int q = 0; q < 8; ++q) s += red[(q * 17 + r) * 64 + cc];
            const int nn = (u % 96) * 64 + cc;
            MOD[((size_t)l * 17 + r) * MODW + nn] = s + p.in[5][(size_t)l * MODW + nn];
        }
        __syncthreads();
    }
}

#ifndef ROUTER_RW
#define ROUTER_RW 4
#endif
template <bool ROUTER>
__device__ __forceinline__ void phase_norm(const Params& p, int l, int which, int nrows, char* lds) {
    const float* X = (const float*)(p.ws + OFF_X);
    const bool from_in = l == 0;
    const bf16_t* D1 = (const bf16_t*)(p.ws + OFF_D1);
    bf16_t* H = (bf16_t*)(p.ws + OFF_H);
    const float* MOD = (const float*)(p.ws + OFF_MOD) + (size_t)l * 17 * MODW;
    const float* g = (which == 0 ? p.in[6] : p.in[7]) + (size_t)l * D;
    float* AFF = (float*)(p.ws + OFF_AFF);
    float* rt = (float*)lds;
    const int tid = tidx(), lane = tid & 63, wid = tid >> 6;
    if (ROUTER) {
        const float* rsrc = p.in[29] + (size_t)l * D * NE;
        for (int i = tid; i < D * NE; i += NTHREADS) { const int e = i & 15, col = i >> 4; rt[(((e >> 1) * 2 + ((col >> 1) & 1)) * 256 + (col >> 2)) * 4 + (col & 1) * 2 + (e & 1)] = rsrc[i]; }
        __syncthreads();
    }
    const int so = which == 0 ? 0 : 3 * D, co = which == 0 ? D : 4 * D;
    constexpr int RW = ROUTER ? ROUTER_RW : 4;
    for (int grp = blockIdx.x * 8 + wid; grp < nrows / RW; grp += gridDim.x * 8) {
        const int row0 = grp * RW;
        const float* mr = MOD + (size_t)mod_row(row0) * MODW;
        float4 x[RW][4];
#pragma unroll
        for (int r = 0; r < RW; ++r)
#pragma unroll
            for (int i = 0; i < 4; ++i) {
                const int rw_ = row0 + r, c0 = i * 256 + lane * 4;
                const float* xs = from_in ? (rw_ < NLAT ? p.in[0] + (size_t)rw_ * D : p.in[2] + (size_t)(rw_ - NLAT) * D) : X + (size_t)rw_ * D;
                x[r][i] = *(const float4*)(xs + c0);
                if (ROUTER) {
                    const u32x2 dw = *(const u32x2*)(D1 + (size_t)rw_ * D + c0);
                    const float4 gt = *(const float4*)(mr + 2 * D + c0);
                    x[r][i].x += gt.x * bflo(dw[0]); x[r][i].y += gt.y * bfhi(dw[0]); x[r][i].z += gt.z * bflo(dw[1]); x[r][i].w += gt.w * bfhi(dw[1]);
                }
            }
        float rs[RW];
#pragma unroll
        for (int r = 0; r < RW; ++r) {
            float ss = 0.f;
#pragma unroll
            for (int i = 0; i < 4; ++i) ss += x[r][i].x * x[r][i].x + x[r][i].y * x[r][i].y + x[r][i].z * x[r][i].z + x[r][i].w * x[r][i].w;
            rs[r] = rsqrtf(wave_sum(ss) * (1.f / D) + 1e-6f);
        }
#pragma unroll
        for (int i = 0; i < 4; ++i) {
            const int c0 = i * 256 + lane * 4;
            const float4 gg = *(const float4*)(g + c0), sh = *(const float4*)(mr + so + c0), sl = *(const float4*)(mr + co + c0);
            const float m0 = gg.x * (1.f + sl.x), m1 = gg.y * (1.f + sl.y), m2 = gg.z * (1.f + sl.z), m3 = gg.w * (1.f + sl.w);
#pragma unroll
            for (int r = 0; r < RW; ++r) {
                float4 h; h.x = x[r][i].x * rs[r] * m0 + sh.x; h.y = x[r][i].y * rs[r] * m1 + sh.y; h.z = x[r][i].z * rs[r] * m2 + sh.z; h.w = x[r][i].w * rs[r] * m3 + sh.w;
                x[r][i] = h;
                if (ROUTER && MOE_F8) {
                    int w = 0; w = __builtin_amdgcn_cvt_pk_fp8_f32(h.x, h.y, w, false); w = __builtin_amdgcn_cvt_pk_fp8_f32(h.z, h.w, w, true);
                    *(unsigned*)((char*)H + (size_t)(row0 + r) * D + c0) = (unsigned)w;
                } else {
                    u32x2 o; o[0] = pack2(h.x, h.y); o[1] = pack2(h.z, h.w);
                    *(u32x2*)(H + (size_t)(row0 + r) * D + c0) = o;
                }
            }
        }
        if (ROUTER) {
            f32x2_t lgp[RW][8];
#pragma unroll
            for (int r = 0; r < RW; ++r)
#pragma unroll
                for (int ep = 0; ep < 8; ++ep) lgp[r][ep] = (f32x2_t){0.f, 0.f};
#pragma unroll
            for (int i = 0; i < 4; ++i) {
#pragma unroll
                for (int ep = 0; ep < 8; ++ep) {
                    const float4 q0 = *(const float4*)(rt + ((ep * 2 + 0) * 256 + i * 64 + lane) * 4), q1 = *(const float4*)(rt + ((ep * 2 + 1) * 256 + i * 64 + lane) * 4);
                    const f32x2_t w0 = {q0.x, q0.y}, w1 = {q0.z, q0.w}, w2 = {q1.x, q1.y}, w3 = {q1.z, q1.w};
#pragma unroll
                    for (int r = 0; r < RW; ++r) {
                        const float4 h = x[r][i];
                        lgp[r][ep] += (f32x2_t){h.x, h.x} * w0; lgp[r][ep] += (f32x2_t){h.y, h.y} * w1; lgp[r][ep] += (f32x2_t){h.z, h.z} * w2; lgp[r][ep] += (f32x2_t){h.w, h.w} * w3;
                    }
#pragma unroll
                    for (int r = 0; r < RW; ++r) asm volatile("" : "+v"(lgp[r][ep]));
                }
            }
            const int b0 = lane & 1, b1 = (lane >> 1) & 1;
            const int eidx = b1 + 2 * b0 + 4 * (lane >> 5) + 8 * ((lane >> 4) & 1);
#pragma unroll
            for (int r = 0; r < RW; ++r) {
                float v8[8], v4[4], v2[2];
#pragma unroll
                for (int i = 0; i < 8; ++i) {
                    const float lo = (i & 1) ? lgp[r][i >> 1].y : lgp[r][i >> 1].x, hi = (i & 1) ? lgp[r][4 + (i >> 1)].y : lgp[r][4 + (i >> 1)].x;
                    const u32x2_t sw = __builtin_amdgcn_permlane16_swap(__float_as_uint(lo), __float_as_uint(hi), false, false);
                    v8[i] = __uint_as_float(sw[0]) + __uint_as_float(sw[1]);
                }
#pragma unroll
                for (int i = 0; i < 4; ++i) {
                    const u32x2_t sw = __builtin_amdgcn_permlane32_swap(__float_as_uint(v8[i]), __float_as_uint(v8[i + 4]), false, false);
                    v4[i] = __uint_as_float(sw[0]) + __uint_as_float(sw[1]);
                }
#pragma unroll
                for (int i = 0; i < 2; ++i) {
                    const float keep = b0 ? v4[i + 2] : v4[i], send = b0 ? v4[i] : v4[i + 2];
                    v2[i] = keep + __uint_as_float(__builtin_amdgcn_update_dpp(0u, __float_as_uint(send), 0xB1, 0xf, 0xf, true));
                }
                float lgt;
                {
                    const float keep = b1 ? v2[1] : v2[0], send = b1 ? v2[0] : v2[1];
                    lgt = keep + __uint_as_float(__builtin_amdgcn_update_dpp(0u, __float_as_uint(send), 0x4E, 0xf, 0xf, true));
                }
                lgt += __uint_as_float(__builtin_amdgcn_update_dpp(0u, __float_as_uint(lgt), 0x124, 0xf, 0xf, true));
                lgt += __uint_as_float(__builtin_amdgcn_update_dpp(0u, __float_as_uint(lgt), 0x128, 0xf, 0xf, true));
                float mx = lgt;
                mx = fmaxf(mx, __uint_as_float(__builtin_amdgcn_update_dpp(0u, __float_as_uint(mx), 0xB1, 0xf, 0xf, true)));
                mx = fmaxf(mx, __uint_as_float(__builtin_amdgcn_update_dpp(0u, __float_as_uint(mx), 0x4E, 0xf, 0xf, true)));
                { const u32x2_t sw = __builtin_amdgcn_permlane16_swap(__float_as_uint(mx), __float_as_uint(mx), false, false); mx = fmaxf(__uint_as_float(sw[0]), __uint_as_float(sw[1])); }
                { const u32x2_t sw = __builtin_amdgcn_permlane32_swap(__float_as_uint(mx), __float_as_uint(mx), false, false); mx = fmaxf(__uint_as_float(sw[0]), __uint_as_float(sw[1])); }
                const float ex = __expf(lgt - mx);
                float sum = ex;
                sum += __uint_as_float(__builtin_amdgcn_update_dpp(0u, __float_as_uint(sum), 0xB1, 0xf, 0xf, true));
                sum += __uint_as_float(__builtin_amdgcn_update_dpp(0u, __float_as_uint(sum), 0x4E, 0xf, 0xf, true));
                { const u32x2_t sw = __builtin_amdgcn_permlane16_swap(__float_as_uint(sum), __float_as_uint(sum), false, false); sum = __uint_as_float(sw[0]) + __uint_as_float(sw[1]); }
                { const u32x2_t sw = __builtin_amdgcn_permlane32_swap(__float_as_uint(sum), __float_as_uint(sum), false, false); sum = __uint_as_float(sw[0]) + __uint_as_float(sw[1]); }
                if ((lane & 12) == 0) AFF[(size_t)(row0 + r) * 16 + eidx] = ex / sum;
            }
        }
    }
}

constexpr int GS_LD = 72;
template <class AL, class EP>
__device__ __forceinline__ void gemm_tile_small(char* lds, const AL& al, const bf16_t* __restrict__ Bt, int ldb, int K, int row0, int col0, const EP& ep) {
    bf16_t* As = (bf16_t*)lds; bf16_t* Bs = As + 128 * GS_LD;
    const int tid = tidx(), lane = tid & 63, wid = tid >> 6, wr = wid >> 1, wc = wid & 1, fr = lane & 15, fq = lane >> 4;
    const int lr = tid >> 3, kc = tid & 7;
    f32x4 acc[2][4];
#pragma unroll
    for (int m = 0; m < 2; ++m)
#pragma unroll
        for (int n = 0; n < 4; ++n) acc[m][n] = (f32x4){0.f, 0.f, 0.f, 0.f};
    bf16x8 ra0 = al(row0 + lr, kc * 8), ra1 = al(row0 + lr + 64, kc * 8);
    bf16x8 rb0 = *(const bf16x8*)(Bt + (size_t)(col0 + lr) * ldb + kc * 8), rb1 = *(const bf16x8*)(Bt + (size_t)(col0 + lr + 64) * ldb + kc * 8);
    for (int k0 = 0; k0 < K; k0 += 64) {
        __syncthreads();
        *(bf16x8*)(As + lr * GS_LD + kc * 8) = ra0; *(bf16x8*)(As + (lr + 64) * GS_LD + kc * 8) = ra1;
        *(bf16x8*)(Bs + lr * GS_LD + kc * 8) = rb0; *(bf16x8*)(Bs + (lr + 64) * GS_LD + kc * 8) = rb1;
        __syncthreads();
        if (k0 + 64 < K) {
            const int kn = k0 + 64 + kc * 8;
            ra0 = al(row0 + lr, kn); ra1 = al(row0 + lr + 64, kn);
            rb0 = *(const bf16x8*)(Bt + (size_t)(col0 + lr) * ldb + kn); rb1 = *(const bf16x8*)(Bt + (size_t)(col0 + lr + 64) * ldb + kn);
        }
#pragma unroll
        for (int ks = 0; ks < 2; ++ks) {
            bf16x8 a[2], b[4];
#pragma unroll
            for (int m = 0; m < 2; ++m) a[m] = *(const bf16x8*)(As + (wr * 32 + m * 16 + fr) * GS_LD + ks * 32 + fq * 8);
#pragma unroll
            for (int n = 0; n < 4; ++n) b[n] = *(const bf16x8*)(Bs + (wc * 64 + n * 16 + fr) * GS_LD + ks * 32 + fq * 8);
#pragma unroll
            for (int m = 0; m < 2; ++m)
#pragma unroll
                for (int n = 0; n < 4; ++n) acc[m][n] = __builtin_amdgcn_mfma_f32_16x16x32_bf16(b[n], a[m], acc[m][n], 0, 0, 0);
        }
    }
#pragma unroll
    for (int m = 0; m < 2; ++m)
#pragma unroll
        for (int n = 0; n < 4; ++n) ep(row0 + wr * 32 + m * 16 + fr, col0 + wc * 64 + n * 16 + fq * 4, acc[m][n]);
}

struct PlainLoader {
    const bf16_t* A; int lda;
    __device__ __forceinline__ bf16x8 operator()(int row, int k) const { return *(const bf16x8*)(A + (size_t)row * lda + k); }
    struct Raw { u32x4 h; };
    struct RawK { int dummy; };
    __device__ __forceinline__ void loadk(int k, RawK& r) const { r.dummy = 0; }
    __device__ __forceinline__ void load(int row, int k, Raw& r) const { r.h = *(const u32x4*)(A + (size_t)row * lda + k); }
    __device__ __forceinline__ bf16x8 finish(const Raw& r, const RawK&) const { return __builtin_bit_cast(bf16x8, r.h); }
};
struct MixLoader {
    const bf16_t* H; const float* mix;
    __device__ __forceinline__ bf16x8 operator()(int row, int k) const {
        int nb;
        if (row < NLAT) {
            const int t = row & (TL - 1), gc = t & 63, gr = t >> 6, q = k >> 8;
            if (q == 0) nb = gc > 0 ? row - 1 : -1;
            else if (q == 1) nb = gc < 63 ? row + 1 : -1;
            else if (q == 2) nb = gr > 0 ? row - 64 : -1;
            else nb = gr < 63 ? row + 64 : -1;
        } else {
            const int t = (row - NLAT) & (TC - 1);
            if (k < 512) nb = t > 0 ? row - 1 : -1;
            else nb = t < TC - 1 ? row + 1 : -1;
        }
        const u32x4 h = *(const u32x4*)(H + (size_t)row * D + k);
        u32x4 s = (u32x4){0u, 0u, 0u, 0u};
        if (nb >= 0) s = *(const u32x4*)(H + (size_t)nb * D + k);
        const float4 m0 = *(const float4*)(mix + k), m1 = *(const float4*)(mix + k + 4);
        u32x4 o;
        { float a = bflo(h[0]), b = bfhi(h[0]); o[0] = pack2(a + (bflo(s[0]) - a) * m0.x, b + (bfhi(s[0]) - b) * m0.y); }
        { float a = bflo(h[1]), b = bfhi(h[1]); o[1] = pack2(a + (bflo(s[1]) - a) * m0.z, b + (bfhi(s[1]) - b) * m0.w); }
        { float a = bflo(h[2]), b = bfhi(h[2]); o[2] = pack2(a + (bflo(s[2]) - a) * m1.x, b + (bfhi(s[2]) - b) * m1.y); }
        { float a = bflo(h[3]), b = bfhi(h[3]); o[3] = pack2(a + (bflo(s[3]) - a) * m1.z, b + (bfhi(s[3]) - b) * m1.w); }
        return __builtin_bit_cast(bf16x8, o);
    }
    struct Raw { u32x4 h, s; };
    struct RawK { float4 m0, m1; };
    __device__ __forceinline__ void loadk(int k, RawK& r) const { r.m0 = *(const float4*)(mix + k); r.m1 = *(const float4*)(mix + k + 4); }
    __device__ __forceinline__ void load(int row, int k, Raw& r) const {
        int nb;
        if (row < NLAT) {
            const int t = row & (TL - 1), gc = t & 63, gr = t >> 6, q = k >> 8;
            if (q == 0) nb = gc > 0 ? row - 1 : -1;
            else if (q == 1) nb = gc < 63 ? row + 1 : -1;
            else if (q == 2) nb = gr > 0 ? row - 64 : -1;
            else nb = gr < 63 ? row + 64 : -1;
        } else {
            const int t = (row - NLAT) & (TC - 1);
            if (k < 512) nb = t > 0 ? row - 1 : -1;
            else nb = t < TC - 1 ? row + 1 : -1;
        }
        r.h = *(const u32x4*)(H + (size_t)row * D + k);
        r.s = (u32x4){0u, 0u, 0u, 0u};
        if (nb >= 0) r.s = *(const u32x4*)(H + (size_t)nb * D + k);
    }
    __device__ __forceinline__ bf16x8 finish(const Raw& r, const RawK& c) const {
        u32x4 o;
        { float a = bflo(r.h[0]), b = bfhi(r.h[0]); o[0] = pack2(a + (bflo(r.s[0]) - a) * c.m0.x, b + (bfhi(r.s[0]) - b) * c.m0.y); }
        { float a = bflo(r.h[1]), b = bfhi(r.h[1]); o[1] = pack2(a + (bflo(r.s[1]) - a) * c.m0.z, b + (bfhi(r.s[1]) - b) * c.m0.w); }
        { float a = bflo(r.h[2]), b = bfhi(r.h[2]); o[2] = pack2(a + (bflo(r.s[2]) - a) * c.m1.x, b + (bfhi(r.s[2]) - b) * c.m1.y); }
        { float a = bflo(r.h[3]), b = bfhi(r.h[3]); o[3] = pack2(a + (bflo(r.s[3]) - a) * c.m1.z, b + (bfhi(r.s[3]) - b) * c.m1.w); }
        return __builtin_bit_cast(bf16x8, o);
    }
};

template <class AL, class EP>
__device__ __forceinline__ void gemm_tile_small2(char* lds, const AL& al, const bf16_t* __restrict__ Bt, int ldb, int K, int row0, int col0, const EP& ep) {
    bf16_t* As = (bf16_t*)lds; bf16_t* Bs = As + 128 * GS_LD;
    const int tid = tidx(), lane = tid & 63, wid = tid >> 6, wr = wid >> 1, wc = wid & 1, fr = lane & 15, fq = lane >> 4;
    const int lr = tid >> 3, kc = tid & 7;
    constexpr int PD = 4;
    f32x4 acc[2][4];
#pragma unroll
    for (int m = 0; m < 2; ++m)
#pragma unroll
        for (int n = 0; n < 4; ++n) acc[m][n] = (f32x4){0.f, 0.f, 0.f, 0.f};
    typename AL::Raw qa0[PD], qa1[PD]; typename AL::RawK qk[PD]; u32x4 qb0[PD], qb1[PD];
    const int nsteps = K / 64;
#define GTS2_ISSUE(SLOT, STEP) do { const int kn_ = (STEP) * 64 + kc * 8; al.loadk(kn_, qk[SLOT]); al.load(row0 + lr, kn_, qa0[SLOT]); al.load(row0 + lr + 64, kn_, qa1[SLOT]); \
        qb0[SLOT] = *(const u32x4*)(Bt + (size_t)(col0 + lr) * ldb + kn_); qb1[SLOT] = *(const u32x4*)(Bt + (size_t)(col0 + lr + 64) * ldb + kn_); } while (0)
#pragma unroll
    for (int d = 0; d < PD; ++d) GTS2_ISSUE(d, d);
    for (int s0 = 0; s0 < nsteps; s0 += PD) {
#pragma unroll
        for (int d = 0; d < PD; ++d) {
            const int step = s0 + d;
            lds_barrier();
            *(bf16x8*)(As + lr * GS_LD + kc * 8) = al.finish(qa0[d], qk[d]); *(bf16x8*)(As + (lr + 64) * GS_LD + kc * 8) = al.finish(qa1[d], qk[d]);
            *(u32x4*)(Bs + lr * GS_LD + kc * 8) = qb0[d]; *(u32x4*)(Bs + (lr + 64) * GS_LD + kc * 8) = qb1[d];
            lds_barrier();
            if (step + PD < nsteps) GTS2_ISSUE(d, step + PD);
#pragma unroll
            for (int ks = 0; ks < 2; ++ks) {
                bf16x8 a[2], b[4];
#pragma unroll
                for (int m = 0; m < 2; ++m) a[m] = *(const bf16x8*)(As + (wr * 32 + m * 16 + fr) * GS_LD + ks * 32 + fq * 8);
#pragma unroll
                for (int n = 0; n < 4; ++n) b[n] = *(const bf16x8*)(Bs + (wc * 64 + n * 16 + fr) * GS_LD + ks * 32 + fq * 8);
#pragma unroll
                for (int m = 0; m < 2; ++m)
#pragma unroll
                    for (int n = 0; n < 4; ++n) acc[m][n] = __builtin_amdgcn_mfma_f32_16x16x32_bf16(b[n], a[m], acc[m][n], 0, 0, 0);
            }
        }
    }
#undef GTS2_ISSUE
#pragma unroll
    for (int m = 0; m < 2; ++m)
#pragma unroll
        for (int n = 0; n < 4; ++n) ep(row0 + wr * 32 + m * 16 + fr, col0 + wc * 64 + n * 16 + fq * 4, acc[m][n]);
}

struct EpStoreBf16 {
    bf16_t* O; int ldo; int act;
    __device__ __forceinline__ void operator()(int row, int col, f32x4 v) const {
        if (act == 1) { v[0] = tanhf(v[0]); v[1] = tanhf(v[1]); v[2] = tanhf(v[2]); v[3] = tanhf(v[3]); }
        else if (act == 2) { v[0] = sigmoidf_(v[0]); v[1] = sigmoidf_(v[1]); v[2] = sigmoidf_(v[2]); v[3] = sigmoidf_(v[3]); }
        u32x2 o; o[0] = pack2(v[0], v[1]); o[1] = pack2(v[2], v[3]);
        *(u32x2*)(O + (size_t)row * ldo + col) = o;
    }
};
struct EpDecay {
    bf16_t* O; const float* w0;
    __device__ __forceinline__ void operator()(int row, int col, f32x4 v) const {
        const float4 b = *(const float4*)(w0 + col);
        u32x2 o;
        o[0] = pack2(-0.6065306597f * sigmoidf_(v[0] + b.x), -0.6065306597f * sigmoidf_(v[1] + b.y));
        o[1] = pack2(-0.6065306597f * sigmoidf_(v[2] + b.z), -0.6065306597f * sigmoidf_(v[3] + b.w));
        *(u32x2*)(O + (size_t)row * D + col) = o;
    }
};
struct EpSigBias {
    bf16_t* O; const float* b0;
    __device__ __forceinline__ void operator()(int row, int col, f32x4 v) const {
        const float4 b = *(const float4*)(b0 + col);
        u32x2 o;
        o[0] = pack2(sigmoidf_(v[0] + b.x), sigmoidf_(v[1] + b.y));
        o[1] = pack2(sigmoidf_(v[2] + b.z), sigmoidf_(v[3] + b.w));
        *(u32x2*)(O + (size_t)row * D + col) = o;
    }
};
struct EpVres {
    bf16_t* VF; const bf16_t* VRAW; const float* v0;
    __device__ __forceinline__ void operator()(int row, int col, f32x4 a) const {
        const float4 b = *(const float4*)(v0 + col);
        const u32x2 vr = *(const u32x2*)(VRAW + (size_t)row * D + col);
        const u32x2 vf = *(const u32x2*)(VF + (size_t)row * D + col);
        float x0 = bflo(vr[0]), x1 = bfhi(vr[0]), x2 = bflo(vr[1]), x3 = bfhi(vr[1]);
        float f0 = bflo(vf[0]), f1 = bfhi(vf[0]), f2 = bflo(vf[1]), f3 = bfhi(vf[1]);
        u32x2 o;
        o[0] = pack2(x0 + (f0 - x0) * sigmoidf_(a[0] + b.x), x1 + (f1 - x1) * sigmoidf_(a[1] + b.y));
        o[1] = pack2(x2 + (f2 - x2) * sigmoidf_(a[2] + b.z), x3 + (f3 - x3) * sigmoidf_(a[3] + b.w));
        *(u32x2*)(VF + (size_t)row * D + col) = o;
    }
};
struct EpResidual {
    float* X; const float* gate; const float* cscale; float amp;
    const float* xin; const float* cin;
    __device__ __forceinline__ void operator()(int row, int col, f32x4 a) const {
        const float4 gt = *(const float4*)(gate + (size_t)mod_row(row) * MODW + col);
        float4 cs = make_float4(amp, amp, amp, amp);
        if (cscale) { const float4 t = *(const float4*)(cscale + col); cs.x *= t.x; cs.y *= t.y; cs.z *= t.z; cs.w *= t.w; }
        float4* xp = (float4*)(X + (size_t)row * D + col);
        const float4* sp = xin ? (const float4*)((row < NLAT ? xin + (size_t)row * D : cin + (size_t)(row - NLAT) * D) + col) : (const float4*)xp;
        float4 x = *sp;
        x.x += gt.x * a[0] * cs.x; x.y += gt.y * a[1] * cs.y; x.z += gt.z * a[2] * cs.z; x.w += gt.w * a[3] * cs.w;
        *xp = x;
    }
};
struct EpD1 {
    bf16_t* D1; const float* cscale;
    __device__ __forceinline__ void operator()(int row, int col, f32x4 a, f32x4 b) const {
        if (cscale) { const float4 s0 = *(const float4*)(cscale + col), s1 = *(const float4*)(cscale + col + 4);
            a[0] *= s0.x; a[1] *= s0.y; a[2] *= s0.z; a[3] *= s0.w; b[0] *= s1.x; b[1] *= s1.y; b[2] *= s1.z; b[3] *= s1.w; }
        const u32x4 o = {pack2(a[0], a[1]), pack2(a[2], a[3]), pack2(b[0], b[1]), pack2(b[2], b[3])};
        *(u32x4*)(D1 + (size_t)row * D + col) = o;
    }
};
struct EpSwiglu {
    bf16_t* HID;
    __device__ __forceinline__ void operator()(int row, int col, f32x4 a) const {
        *(unsigned*)(HID + (size_t)row * FF + (col >> 1)) = pack2(siluf_(a[0]) * a[1], siluf_(a[2]) * a[3]);
    }
    __device__ __forceinline__ void operator()(int row, int col, f32x4 a, f32x4 b) const {
        const f32x2_t g0 = {a[0], a[2]}, u0 = {a[1], a[3]}, g1 = {b[0], b[2]}, u1 = {b[1], b[3]};
        const f32x2_t t0 = g0 * -1.44269504089f, t1 = g1 * -1.44269504089f;
        f32x2_t e0, e1; e0.x = __builtin_amdgcn_exp2f(t0.x); e0.y = __builtin_amdgcn_exp2f(t0.y); e1.x = __builtin_amdgcn_exp2f(t1.x); e1.y = __builtin_amdgcn_exp2f(t1.y);
        const f32x2_t d0 = e0 + 1.0f, d1 = e1 + 1.0f;
        f32x2_t r0, r1; r0.x = __builtin_amdgcn_rcpf(d0.x); r0.y = __builtin_amdgcn_rcpf(d0.y); r1.x = __builtin_amdgcn_rcpf(d1.x); r1.y = __builtin_amdgcn_rcpf(d1.y);
        const f32x2_t h0 = (g0 * u0) * r0, h1 = (g1 * u1) * r1;
        const u32x2 o = {pack2(h0.x, h0.y), pack2(h1.x, h1.y)};
        *(u32x2*)(HID + (size_t)row * FF + (col >> 1)) = o;
    }
};
struct EpSwiglu8 {
    char* HID;
    __device__ __forceinline__ void operator()(int row, int col, f32x4 a) const {
        int w = 0; w = __builtin_amdgcn_cvt_pk_fp8_f32(siluf_(a[0]) * a[1], siluf_(a[2]) * a[3], w, false);
        *(unsigned short*)(HID + (size_t)row * FF + (col >> 1)) = (unsigned short)w;
    }
    __device__ __forceinline__ void operator()(int row, int col, f32x4 a, f32x4 b) const {
        const f32x2_t g0 = {a[0], a[2]}, u0 = {a[1], a[3]}, g1 = {b[0], b[2]}, u1 = {b[1], b[3]};
        const f32x2_t t0 = g0 * -1.44269504089f, t1 = g1 * -1.44269504089f;
        f32x2_t e0, e1; e0.x = __builtin_amdgcn_exp2f(t0.x); e0.y = __builtin_amdgcn_exp2f(t0.y); e1.x = __builtin_amdgcn_exp2f(t1.x); e1.y = __builtin_amdgcn_exp2f(t1.y);
        const f32x2_t d0 = e0 + 1.0f, d1 = e1 + 1.0f;
        f32x2_t r0, r1; r0.x = __builtin_amdgcn_rcpf(d0.x); r0.y = __builtin_amdgcn_rcpf(d0.y); r1.x = __builtin_amdgcn_rcpf(d1.x); r1.y = __builtin_amdgcn_rcpf(d1.y);
        const f32x2_t h0 = (g0 * u0) * r0, h1 = (g1 * u1) * r1;
        int w = 0;
        w = __builtin_amdgcn_cvt_pk_fp8_f32(h0.x, h0.y, w, false);
        w = __builtin_amdgcn_cvt_pk_fp8_f32(h1.x, h1.y, w, true);
        *(unsigned*)(HID + (size_t)row * FF + (col >> 1)) = (unsigned)w;
    }
};
struct EpGateRow {
    bf16_t* YS; const float* gatev;
    __device__ __forceinline__ void operator()(int row, int col, f32x4 a) const {
        const float gt = gatev[row];
        u32x2 o; o[0] = pack2(a[0] * gt, a[1] * gt); o[1] = pack2(a[2] * gt, a[3] * gt);
        *(u32x2*)(YS + (size_t)row * D + col) = o;
    }
    __device__ __forceinline__ void operator()(int row, int col, f32x4 a, f32x4 b) const {
        const float gt = gatev[row];
        const u32x4 o = {pack2(a[0] * gt, a[1] * gt), pack2(a[2] * gt, a[3] * gt), pack2(b[0] * gt, b[1] * gt), pack2(b[2] * gt, b[3] * gt)};
        *(u32x4*)(YS + (size_t)row * D + col) = o;
    }
};

#define LAS __attribute__((address_space(3)))
namespace g256 {
constexpr int BM = 256, BK = 64, HALF = 128, HTB = HALF * BK * 2, STAGE_BYTES = 8 * HTB;
__device__ __forceinline__ int lds_byte(int r, int c) { const int st = (r >> 4) * 2 + (c >> 5), rr = r & 15, cc = c & 31, ob = rr * 64 + cc * 2; return st * 1024 + (ob ^ (((ob >> 9) & 1) << 5)); }
__device__ __forceinline__ void stage_rc(int b, int& R, int& C) { const int st = b / 1024, sb = b % 1024, swz = sb ^ (((sb >> 9) & 1) << 5); R = (st >> 1) * 16 + swz / 64; C = (st & 1) * 32 + (swz % 64) / 2; }
struct Unit { const char* a; const char* b; int row0, col0; };
typedef int i32x4_t __attribute__((ext_vector_type(4)));
typedef int i32x8_t __attribute__((ext_vector_type(8)));
__device__ __forceinline__ i32x8_t cat8(bf16x8 lo, bf16x8 hi) { return __builtin_shufflevector(__builtin_bit_cast(i32x4_t, lo), __builtin_bit_cast(i32x4_t, hi), 0, 1, 2, 3, 4, 5, 6, 7); }

__device__ __forceinline__ int perm32(int rho) { const int n = rho >> 4, i = rho & 15; return 8 * (i >> 2) + 4 * n + (i & 3); }
template <bool PERM, bool F8 = false, bool GATHER = false, class Sched, class Ep>
__device__ __forceinline__ void gemm_phase(LAS unsigned char* lds, const int lda, const int ldb, const int K, const Sched& S, const Ep& E) {
    const int tid = tidx(), wid = __builtin_amdgcn_readfirstlane(tid >> 6), lane = tid & 63, wr = wid >> 2, wc = wid & 3, fr = lane & 15, fq = lane >> 4;
    const int nt = K / BK;
    int scw = 0x79797979, sca = 0x7F7F7F7F;
    if constexpr (F8) asm volatile("" : "+v"(scw), "+v"(sca));
    unsigned voffA[2], voffB[2], cbA[2];
#pragma unroll
    for (int i = 0; i < 2; ++i) { int R, C; stage_rc(tid * 16 + i * 8192, R, C); const int Rb = PERM ? ((R & ~31) + perm32(R & 31)) : R; voffA[i] = GATHER ? (unsigned)(R * 4) : (unsigned)(R * lda + C) * 2u; voffB[i] = (unsigned)(Rb * ldb + C) * 2u; cbA[i] = (unsigned)C * 2u; }
    LAS unsigned char* tokl = lds + LDS_TOK;
    unsigned gc[2][2], gn[2][2];
    const unsigned rowb = (unsigned)lda * 2u;
    const size_t kstep = (size_t)(BK * 2);
    const size_t hstepA = (size_t)HALF * lda * 2, hstepB = (size_t)HALF * ldb * 2;
    const unsigned ldsw = (unsigned)wid * 1024u;
    const int aoff = lds_byte(wr * 64 + fr, fq * 8), boff = lds_byte(wc * 32 + fr, fq * 8);
#define PG8_SA(b, h) (((b) * 2 + (h)) * HTB)
#define PG8_SB(b, h) ((4 + (b) * 2 + (h)) * HTB)
#define PG8_STAGE(bufoff, gbase, voff) do { _Pragma("unroll") for (int _i = 0; _i < 2; ++_i) \
        __builtin_amdgcn_global_load_lds((const unsigned*)((const char*)(gbase) + (voff)[_i]), (LAS unsigned*)(lds + (bufoff) + ldsw + _i * 8192), 16, 0, 0); } while (0)
#define PG8_STAGE_A(bufoff, ptr, h, goffs, koff) do { if constexpr (GATHER) { _Pragma("unroll") for (int _i = 0; _i < 2; ++_i) \
        __builtin_amdgcn_global_load_lds((const unsigned*)(S.abase + (size_t)(koff) + (goffs)[h][_i]), (LAS unsigned*)(lds + (bufoff) + ldsw + _i * 8192), 16, 0, 0); } \
        else PG8_STAGE(bufoff, ptr, voffA); } while (0)
#define PG8_LDA(dst, b, h) do { _Pragma("unroll") for (int m = 0; m < 4; ++m) _Pragma("unroll") for (int k = 0; k < 2; ++k) dst[m][k] = *(const LAS bf16x8*)(lds + PG8_SA(b, h) + aoff + m * 2048 + k * 1024); } while (0)
#define PG8_LDB(dst, b, h) do { _Pragma("unroll") for (int n = 0; n < 2; ++n) _Pragma("unroll") for (int k = 0; k < 2; ++k) dst[n][k] = *(const LAS bf16x8*)(lds + PG8_SB(b, h) + boff + n * 2048 + k * 1024); } while (0)
#define PG8_MMA(ai, bj, At, Bt) do { __builtin_amdgcn_s_setprio(1); _Pragma("unroll") for (int m = 0; m < 4; ++m) _Pragma("unroll") for (int n = 0; n < 2; ++n) { \
        if constexpr (F8) asm volatile("v_mfma_scale_f32_16x16x128_f8f6f4 %0, %1, %2, %0, %3, %4 op_sel_hi:[0,0,0]" : "+v"(acc[ai][bj][m][n]) : "v"(cat8(Bt[n][0], Bt[n][1])), "v"(cat8(At[m][0], At[m][1])), "v"(scw), "v"(sca)); \
        else { _Pragma("unroll") for (int k = 0; k < 2; ++k) acc[ai][bj][m][n] = __builtin_amdgcn_mfma_f32_16x16x32_bf16(Bt[n][k], At[m][k], acc[ai][bj][m][n], 0, 0, 0); } } \
        __builtin_amdgcn_s_setprio(0); } while (0)
#define PG8_WAIT_V(n) asm volatile("s_waitcnt vmcnt(" #n ")" ::: "memory")
#define PG8_WAIT_L(n) asm volatile("s_waitcnt lgkmcnt(" #n ")" ::: "memory")
#define PG8_BAR __builtin_amdgcn_s_barrier()
#define PG8_SCHED __builtin_amdgcn_sched_barrier(0)
    Unit cur, nxt; int ui = 0;
    if (!S.next(0, cur)) return;
    f32x4 acc[2][2][4][2];
#pragma unroll
    for (int a = 0; a < 2; ++a)
#pragma unroll
        for (int b = 0; b < 2; ++b)
#pragma unroll
            for (int m = 0; m < 4; ++m)
#pragma unroll
                for (int n = 0; n < 2; ++n) acc[a][b][m][n] = (f32x4){0.f, 0.f, 0.f, 0.f};
    bf16x8 At[4][2], B0[2][2], B1[2][2];
    const char* cA = cur.a; const char* cB = cur.b;
    if constexpr (GATHER) {
        if (tid < 256) *(LAS unsigned*)(tokl + tid * 4) = (unsigned)S.tok[cur.row0 + tid];
        __syncthreads();
#pragma unroll
        for (int h = 0; h < 2; ++h)
#pragma unroll
            for (int i = 0; i < 2; ++i) { gc[h][i] = *(const LAS unsigned*)(tokl + h * 512 + voffA[i]) * rowb + cbA[i]; gn[h][i] = gc[h][i]; }
        __syncthreads();
    }
    PG8_STAGE(PG8_SB(0, 0), cB, voffB); PG8_STAGE_A(PG8_SA(0, 0), cA, 0, gc, 0); PG8_STAGE(PG8_SB(0, 1), cB + hstepB, voffB); PG8_STAGE_A(PG8_SA(0, 1), cA + hstepA, 1, gc, 0);
    if (wr == 1) PG8_BAR;
    PG8_WAIT_V(4); PG8_BAR;
    PG8_STAGE(PG8_SB(1, 0), cB + kstep, voffB); PG8_STAGE_A(PG8_SA(1, 0), cA + kstep, 0, gc, kstep); PG8_STAGE(PG8_SB(1, 1), cB + hstepB + kstep, voffB);
    PG8_WAIT_V(6); PG8_BAR;
    for (;;) {
        const bool has_next = S.next(ui + 1, nxt);
        const char* nA = has_next ? nxt.a : cA; const char* nB = has_next ? nxt.b : cB;
        if constexpr (GATHER) {
            if (has_next && wid < 4) __builtin_amdgcn_global_load_lds((const unsigned*)(S.tok + nxt.row0 + tid), (LAS unsigned*)(tokl + wid * 256), 4, 0, 0);
        }
#pragma unroll 1
        for (int t = 0; t < nt; t += 2) {
            const bool last = (t == nt - 2);
            const char* a1 = cA + (size_t)(t + 1) * kstep;
            const char* a2 = last ? nA : cA + (size_t)(t + 2) * kstep; const char* b2 = last ? nB : cB + (size_t)(t + 2) * kstep;
            const char* a3 = a2 + kstep; const char* b3 = b2 + kstep;
            const size_t k1 = (size_t)(t + 1) * kstep, k2 = last ? (size_t)0 : (size_t)(t + 2) * kstep;
            unsigned o2[2][2];
            if constexpr (GATHER) {
                if (last && has_next) {
#pragma unroll
                    for (int h = 0; h < 2; ++h)
#pragma unroll
                        for (int i = 0; i < 2; ++i) gn[h][i] = *(const LAS unsigned*)(tokl + h * 512 + voffA[i]) * rowb + cbA[i];
                }
#pragma unroll
                for (int h = 0; h < 2; ++h)
#pragma unroll
                    for (int i = 0; i < 2; ++i) o2[h][i] = last ? gn[h][i] : gc[h][i];
            }
            PG8_LDB(B0, 0, 0); PG8_SCHED; PG8_LDA(At, 0, 0); PG8_STAGE_A(PG8_SA(1, 1), a1 + hstepA, 1, gc, k1);
            PG8_WAIT_L(8); PG8_BAR; PG8_WAIT_L(0); PG8_MMA(0, 0, At, B0); PG8_BAR; PG8_SCHED;
            PG8_LDB(B1, 0, 1); PG8_STAGE(PG8_SB(0, 0), b2, voffB);
            PG8_BAR; PG8_WAIT_L(0); PG8_MMA(0, 1, At, B1); PG8_BAR;
            PG8_LDA(At, 0, 1); PG8_STAGE_A(PG8_SA(0, 0), a2, 0, o2, k2);
            PG8_BAR; PG8_WAIT_L(0); PG8_MMA(1, 0, At, B0); PG8_BAR; PG8_SCHED;
            PG8_STAGE(PG8_SB(0, 1), b2 + hstepB, voffB);
            PG8_WAIT_V(6); PG8_BAR; PG8_MMA(1, 1, At, B1); PG8_BAR;
            PG8_LDB(B0, 1, 0); PG8_SCHED; PG8_LDA(At, 1, 0); PG8_STAGE_A(PG8_SA(0, 1), a2 + hstepA, 1, o2, k2);
            PG8_WAIT_L(8); PG8_BAR; PG8_WAIT_L(0); PG8_MMA(0, 0, At, B0); PG8_BAR; PG8_SCHED;
            PG8_LDB(B1, 1, 1); PG8_STAGE(PG8_SB(1, 0), b3, voffB);
            PG8_BAR; PG8_WAIT_L(0); PG8_MMA(0, 1, At, B1); PG8_BAR;
            PG8_LDA(At, 1, 1); PG8_STAGE_A(PG8_SA(1, 0), a3, 0, o2, k2 + kstep);
            PG8_BAR; PG8_WAIT_L(0); PG8_MMA(1, 0, At, B0); PG8_BAR; PG8_SCHED;
            PG8_STAGE(PG8_SB(1, 1), b3 + hstepB, voffB);
            PG8_WAIT_V(6); PG8_BAR; PG8_MMA(1, 1, At, B1); PG8_BAR;
        }
        if constexpr (F8) {
            asm volatile("s_nop 15\n\ts_nop 7" ::: "memory");
#pragma unroll
            for (int a = 0; a < 2; ++a)
#pragma unroll
                for (int b = 0; b < 2; ++b)
#pragma unroll
                    for (int m = 0; m < 4; ++m)
#pragma unroll
                        for (int n = 0; n < 2; ++n) asm volatile("" : "+v"(acc[a][b][m][n]));
        }
#pragma unroll
        for (int ai = 0; ai < 2; ++ai)
#pragma unroll
            for (int m = 0; m < 4; ++m)
#pragma unroll
                for (int bj = 0; bj < 2; ++bj) {
                    if constexpr (PERM) E(cur.row0 + ai * HALF + wr * 64 + m * 16 + fr, cur.col0 + bj * HALF + wc * 32 + 8 * fq, acc[ai][bj][m][0], acc[ai][bj][m][1]);
                    else {
#pragma unroll
                        for (int n = 0; n < 2; ++n) E(cur.row0 + ai * HALF + wr * 64 + m * 16 + fr, cur.col0 + bj * HALF + wc * 32 + n * 16 + 4 * fq, acc[ai][bj][m][n]);
                    }
                }
        if (!has_next) break;
#pragma unroll
        for (int a = 0; a < 2; ++a)
#pragma unroll
            for (int b = 0; b < 2; ++b)
#pragma unroll
                for (int m = 0; m < 4; ++m)
#pragma unroll
                    for (int n = 0; n < 2; ++n) acc[a][b][m][n] = (f32x4){0.f, 0.f, 0.f, 0.f};
        cur = nxt; cA = nA; cB = nB; ++ui;
        if constexpr (GATHER) {
#pragma unroll
            for (int h = 0; h < 2; ++h)
#pragma unroll
                for (int i = 0; i < 2; ++i) gc[h][i] = gn[h][i];
        }
    }
    PG8_WAIT_V(0);
    if (wr == 0) PG8_BAR;
    PG8_BAR;
#undef PG8_SA
#undef PG8_SB
#undef PG8_STAGE
#undef PG8_STAGE_A
#undef PG8_LDA
#undef PG8_LDB
#undef PG8_MMA
#undef PG8_WAIT_V
#undef PG8_WAIT_L
#undef PG8_BAR
#undef PG8_SCHED
}
__device__ __forceinline__ long unit_index(int i) {
    const int G = gridDim.x, c = blockIdx.x;
    if (G == 256) return ((long)i * 8 + (c & 7)) * 32 + (c >> 3);
    return (long)i * G + c;
}
}

__device__ __forceinline__ const bf16_t* wsm(const Params& p, int j, size_t off) { return (const bf16_t*)(p.ws + OFF_WSM) + (size_t)j * WJ_SIZE + off; }

__device__ __forceinline__ void phase_mix(const Params& p, int j) {
    const bf16_t* H = (const bf16_t*)(p.ws + OFF_H);
    const float* mix = p.in[8] + (size_t)j * 6 * D;
    bf16_t* XM = (bf16_t*)(p.ws + OFF_LW);
    const int tid_ = tidx(), lane = tid_ & 63, wid = tid_ >> 6;
    for (int cc = 0; cc < 2; ++cc) {
        const int k = cc * 512 + lane * 8;
        float m[3][8];
#pragma unroll
        for (int w = 0; w < 3; ++w) {
            const int mi = w == 0 ? 0 : (w == 1 ? 2 : 3);
            const float4 m0 = *(const float4*)(mix + mi * D + k), m1 = *(const float4*)(mix + mi * D + k + 4);
            m[w][0] = m0.x; m[w][1] = m0.y; m[w][2] = m0.z; m[w][3] = m0.w; m[w][4] = m1.x; m[w][5] = m1.y; m[w][6] = m1.z; m[w][7] = m1.w;
        }
        const int q = k >> 8;
        for (int grp = blockIdx.x * 8 + wid; grp < NT / 4; grp += gridDim.x * 8) {
            u32x4 h[4], s[4];
#pragma unroll
            for (int r = 0; r < 4; ++r) {
                const int row = grp * 4 + r;
                int nb;
                if (row < NLAT) {
                    const int t = row & (TL - 1), gc = t & 63, gr = t >> 6;
                    if (q == 0) nb = gc > 0 ? row - 1 : -1;
                    else if (q == 1) nb = gc < 63 ? row + 1 : -1;
                    else if (q == 2) nb = gr > 0 ? row - 64 : -1;
                    else nb = gr < 63 ? row + 64 : -1;
                } else {
                    const int t = (row - NLAT) & (TC - 1);
                    if (k < 512) nb = t > 0 ? row - 1 : -1;
                    else nb = t < TC - 1 ? row + 1 : -1;
                }
                h[r] = *(const u32x4*)(H + (size_t)row * D + k);
                s[r] = (u32x4){0u, 0u, 0u, 0u};
                if (nb >= 0) s[r] = *(const u32x4*)(H + (size_t)nb * D + k);
            }
#pragma unroll
            for (int r = 0; r < 4; ++r) {
                const int row = grp * 4 + r;
#pragma unroll
                for (int w = 0; w < 3; ++w) {
                    u32x4 o;
#pragma unroll
                    for (int e = 0; e < 4; ++e) {
                        const float x = bflo(h[r][e]), y = bfhi(h[r][e]);
                        o[e] = pack2(x + (bflo(s[r][e]) - x) * m[w][2 * e], y + (bfhi(s[r][e]) - y) * m[w][2 * e + 1]);
                    }
                    *(u32x4*)(XM + (size_t)w * NT * D + (size_t)row * D + k) = o;
                }
            }
        }
    }
}

struct SchedGrid {
    const char* A; const char* B; size_t a_mat, b_mat, a_rt, a_ct, b_ct; int cpm, total;
    __device__ __forceinline__ bool next(int i, g256::Unit& u) const {
        const long L = g256::unit_index(i);
        if (L >= total) return false;
        const int chunk = (int)(L >> 5), o = (int)(L & 31), mat = chunk / cpm, ch = chunk % cpm, rt = ch * 8 + (o >> 2), ct = o & 3;
        u.a = A + (size_t)mat * a_mat + (size_t)rt * a_rt + (size_t)ct * a_ct; u.b = B + (size_t)mat * b_mat + (size_t)ct * b_ct;
        u.row0 = rt * 256; u.col0 = mat * 1024 + ct * 256;
        return true;
    }
};
struct EpRKV {
    bf16_t* R; long vdelta;
    __device__ __forceinline__ void operator()(int row, int col, f32x4 v) const {
        const int mat = col >> 10, c = col & 1023;
        bf16_t* O = R + (size_t)mat * NT * D + (mat == 2 ? vdelta : 0l);
        u32x2 o; o[0] = pack2(v[0], v[1]); o[1] = pack2(v[2], v[3]);
        *(u32x2*)(O + (size_t)row * D + c) = o;
    }
    __device__ __forceinline__ void operator()(int row, int col, f32x4 v, f32x4 w) const {
        const int mat = col >> 10, c = col & 1023;
        bf16_t* O = R + (size_t)mat * NT * D + (mat == 2 ? vdelta : 0l);
        const u32x4 o = {pack2(v[0], v[1]), pack2(v[2], v[3]), pack2(w[0], w[1]), pack2(w[2], w[3])};
        *(u32x4*)(O + (size_t)row * D + c) = o;
    }
};

__device__ __forceinline__ void phase_rwkv_proj(const Params& p, int j, char* lds) {
    const bf16_t* H = (const bf16_t*)(p.ws + OFF_H);
    const float* mix = p.in[8] + (size_t)j * 6 * D;
    bf16_t* R = (bf16_t*)(p.ws + OFF_R);
    bf16_t* V = (bf16_t*)(p.ws + (j == 0 ? OFF_VF : OFF_Y));
    bf16_t* LD = (bf16_t*)(p.ws + OFF_LD);
    const bf16_t* XM = (const bf16_t*)(p.ws + OFF_LW);
    {
        SchedGrid S{(const char*)XM, (const char*)wsm(p, j, WJ_RKV), (size_t)NT * D * 2, (size_t)D * D * 2, (size_t)256 * D * 2, 0, (size_t)256 * D * 2, NT / 256 / 8, 3 * (NT / 256) * 4};
        EpRKV E{R, (long)(V - (R + (size_t)2 * NT * D))};
        g256::gemm_phase<true>((LAS unsigned char*)lds, D, D, D, S, E);
    }
    constexpr int RT = NT / 128;
    const int nsmall = (j == 0 ? 3 : 4) * RT;
    for (int u = blockIdx.x; u < nsmall; u += gridDim.x) {
        const int which = u / RT, rt = u % RT;
        EpStoreBf16 ep{LD + (size_t)which * NT * 128, 128, which == 0 ? 1 : (which == 2 ? 2 : 0)};
        if (which < 3) {
            const int mi = which == 0 ? 1 : (which == 1 ? 4 : 5);
            MixLoader al{H, mix + mi * D};
            const bf16_t* Bt = which == 0 ? wsm(p, j, WJ_W1) : which == 1 ? wsm(p, j, WJ_A1) : wsm(p, j, WJ_G1);
            gemm_tile_small2(lds, al, Bt, D, D, rt * 128, 0, ep);
        } else {
            PlainLoader al{XM + (size_t)2 * NT * D, D};
            gemm_tile_small2(lds, al, (const bf16_t*)(p.ws + OFF_WSM) + W_V1, D, D, rt * 128, 0, ep);
        }
    }
}

template <int KS, int MODE>
__device__ __forceinline__ void gemm_bstat(const bf16_t* __restrict__ A, int lda, const bf16_t* __restrict__ Bt, int ldb, int col0, int rt0, int rt1,
                                           bf16_t* O, const float* bias, const bf16_t* VRAW) {
    const int tid = tidx(), lane = tid & 63, wid = tid >> 6, wr = wid >> 2, wc = wid & 3, fr = lane & 15, fq = lane >> 4;
    bf16x8 bfr[4][KS];
#pragma unroll
    for (int n = 0; n < 4; ++n) {
        const int colb = col0 + wc * 64 + (n >> 1) * 32 + 8 * (fr >> 2) + 4 * (n & 1) + (fr & 3);
#pragma unroll
        for (int ks = 0; ks < KS; ++ks) bfr[n][ks] = *(const bf16x8*)(Bt + (size_t)colb * ldb + ks * 32 + fq * 8);
    }
    float bs[2][8];
#pragma unroll
    for (int pp = 0; pp < 2; ++pp)
#pragma unroll
        for (int e = 0; e < 8; ++e) bs[pp][e] = MODE == 2 ? 0.f : bias[col0 + wc * 64 + pp * 32 + 8 * fq + e] * ((MODE == 0 || MODE == 1) ? -1.44269504089f : 1.f);
    bf16x8 afr[4][KS];
#pragma unroll
    for (int m = 0; m < 4; ++m)
#pragma unroll
        for (int ks = 0; ks < KS; ++ks) afr[m][ks] = *(const bf16x8*)(A + (size_t)(rt0 * 128 + wr * 64 + m * 16 + fr) * lda + ks * 32 + fq * 8);
    for (int rt = rt0; rt < rt1; ++rt) {
        f32x4 acc[4][4];
#pragma unroll
        for (int m = 0; m < 4; ++m)
#pragma unroll
            for (int n = 0; n < 4; ++n) {
                acc[m][n] = (f32x4){0.f, 0.f, 0.f, 0.f};
#pragma unroll
                for (int ks = 0; ks < KS; ++ks) acc[m][n] = __builtin_amdgcn_mfma_f32_16x16x32_bf16(bfr[n][ks], afr[m][ks], acc[m][n], 0, 0, 0);
            }
        if (rt + 1 < rt1) {
#pragma unroll
            for (int m = 0; m < 4; ++m)
#pragma unroll
                for (int ks = 0; ks < KS; ++ks) afr[m][ks] = *(const bf16x8*)(A + (size_t)((rt + 1) * 128 + wr * 64 + m * 16 + fr) * lda + ks * 32 + fq * 8);
        }
#pragma unroll
        for (int m = 0; m < 4; ++m)
#pragma unroll
            for (int pp = 0; pp < 2; ++pp) {
                const size_t o = (size_t)(rt * 128 + wr * 64 + m * 16 + fr) * D + col0 + wc * 64 + pp * 32 + 8 * fq;
                float v[8];
#pragma unroll
                for (int e = 0; e < 4; ++e) { v[e] = acc[m][2 * pp][e]; v[4 + e] = acc[m][2 * pp + 1][e]; }
                if (MODE == 0 || MODE == 1) {
#pragma unroll
                    for (int e = 0; e < 8; e += 2) {
                        const f32x2_t x = {v[e], v[e + 1]}, bb = {bs[pp][e], bs[pp][e + 1]};
                        const f32x2_t t = x * -1.44269504089f + bb;
                        f32x2_t ex; ex.x = __builtin_amdgcn_exp2f(t.x); ex.y = __builtin_amdgcn_exp2f(t.y);
                        const f32x2_t dn = ex + 1.0f;
                        f32x2_t r; r.x = __builtin_amdgcn_rcpf(dn.x); r.y = __builtin_amdgcn_rcpf(dn.y);
                        if (MODE == 0) r = r * -0.6065306597f;
                        v[e] = r.x; v[e + 1] = r.y;
                    }
                } else if (MODE == 3) {
                    const u32x4 vr = *(const u32x4*)(VRAW + o), vf = *(const u32x4*)(O + o);
#pragma unroll
                    for (int e = 0; e < 8; ++e) {
                        const float x = (e & 1) ? bfhi(vr[e >> 1]) : bflo(vr[e >> 1]), f = (e & 1) ? bfhi(vf[e >> 1]) : bflo(vf[e >> 1]);
                        v[e] = x + (f - x) * sigmoidf_(v[e] + bs[pp][e]);
                    }
                }
                const u32x4 w = {pack2(v[0], v[1]), pack2(v[2], v[3]), pack2(v[4], v[5]), pack2(v[6], v[7])};
                *(u32x4*)(O + o) = w;
            }
    }
}
__device__ __forceinline__ void phase_rwkv_up(const Params& p, int j, char* lds) {
    bf16_t* LD = (bf16_t*)(p.ws + OFF_LD);
    bf16_t* LW = (bf16_t*)(p.ws + OFF_LW); bf16_t* AD = (bf16_t*)(p.ws + OFF_AD); bf16_t* G = (bf16_t*)(p.ws + OFF_G);
    constexpr int RT = NT / 128, NRC = 32, RPC = RT / NRC;
    const int ntot = j == 0 ? 0 : 4 * NRC;
    for (int u = blockIdx.x; u < ntot; u += gridDim.x) {
        const int which = 5, r = u % (4 * NRC), ct = r / NRC, rc = r % NRC;
        const int rt0 = rc * RPC, rt1 = rt0 + RPC, col0 = ct * 256;
        if (which < 2) {
            const int d = which;
            gemm_bstat<2, 0>(LD + d * 64, 128, wsm(p, j, WJ_W2) + (size_t)d * D * 64, 64, col0, rt0, rt1, LW + (size_t)d * NT * D, p.in[10] + ((size_t)j * 2 + d) * D, nullptr);
        } else if (which < 4) {
            const int d = which - 2;
            gemm_bstat<2, 1>(LD + (size_t)NT * 128 + d * 64, 128, wsm(p, j, WJ_A2) + (size_t)d * D * 64, 64, col0, rt0, rt1, AD + (size_t)d * NT * D, p.in[13] + ((size_t)j * 2 + d) * D, nullptr);
        } else if (which == 4) {
            gemm_bstat<4, 2>(LD + (size_t)2 * NT * 128, 128, wsm(p, j, WJ_G2), 128, col0, rt0, rt1, G, nullptr, nullptr);
        } else {
            gemm_bstat<2, 3>(LD + (size_t)3 * NT * 128, 128, (const bf16_t*)(p.ws + OFF_WSM) + W_V2, 64, col0, rt0, rt1, (bf16_t*)(p.ws + OFF_VF), p.in[16], (const bf16_t*)(p.ws + OFF_Y));
        }
    }
}

__device__ __forceinline__ void phase_rwkv_up2(const Params& p, int j, char* lds) {
    const bf16_t* R = (const bf16_t*)(p.ws + OFF_R); const bf16_t* Kb = (const bf16_t*)(p.ws + OFF_K);
    bf16_t* KK = (bf16_t*)(p.ws + OFF_H); float* BON = (float*)(p.ws + OFF_BON);
    const float* k_k = p.in[21] + (size_t)j * D; const float* k_a = p.in[22] + (size_t)j * D; const float* r_k = p.in[23] + (size_t)j * D;
    float* cst = (float*)lds;
    constexpr int TR = 32, MT = 1, RT = NT / TR, NRC = 64, RPC = RT / NRC, KS = 2;
    const int tid = tidx(), lane = tid & 63, wid = tid >> 6, wr = wid >> 2, wc = wid & 3, fr = lane & 15, fq = lane >> 4;
    const bf16_t* A = (const bf16_t*)(p.ws + OFF_LD) + (size_t)NT * 128;
    bf16_t* AD = (bf16_t*)(p.ws + OFF_AD);
    for (int u = blockIdx.x; u < 4 * NRC; u += gridDim.x) {
        const int ct = u / NRC, rc = u % NRC, rt0 = rc * RPC, rt1 = rt0 + RPC, col0 = ct * 256, head = ct * 4 + wc;
        __syncthreads();
        if (tid < 256) {
            const float kk_ = k_k[col0 + tid], ka_ = k_a[col0 + tid], rk_ = r_k[col0 + tid];
            cst[tid] = kk_; cst[256 + tid] = rk_ * (1.f - ka_); cst[512 + tid] = 0.5f * rk_ * ka_;
            cst[768 + tid] = p.in[13][((size_t)j * 2 + 0) * D + col0 + tid] * -1.44269504089f; cst[1024 + tid] = p.in[13][((size_t)j * 2 + 1) * D + col0 + tid] * -1.44269504089f;
        }
        __syncthreads();
        bf16x8 bfr[2][4][KS];
#pragma unroll
        for (int d = 0; d < 2; ++d)
#pragma unroll
            for (int n = 0; n < 4; ++n) {
                const int colb = col0 + wc * 64 + (n >> 1) * 32 + 8 * (fr >> 2) + 4 * (n & 1) + (fr & 3);
#pragma unroll
                for (int ks = 0; ks < KS; ++ks) bfr[d][n][ks] = *(const bf16x8*)(wsm(p, j, WJ_A2) + (size_t)d * D * 64 + (size_t)colb * 64 + ks * 32 + fq * 8);
            }
        bf16x8 afr[MT][2][KS];
#pragma unroll
        for (int m = 0; m < MT; ++m)
#pragma unroll
            for (int d = 0; d < 2; ++d)
#pragma unroll
                for (int ks = 0; ks < KS; ++ks) afr[m][d][ks] = *(const bf16x8*)(A + (size_t)(rt0 * TR + wr * (16 * MT) + m * 16 + fr) * 128 + d * 64 + ks * 32 + fq * 8);
#pragma unroll 1
        for (int rt = rt0; rt < rt1; ++rt) {
#pragma unroll
            for (int m = 0; m < MT; ++m) {
                const int row = rt * TR + wr * (16 * MT) + m * 16 + fr;
                const size_t o = (size_t)row * D + col0 + wc * 64 + 8 * fq;
                u32x4 kv[2], rv[2];
#pragma unroll
                for (int pp = 0; pp < 2; ++pp) { kv[pp] = *(const u32x4*)(Kb + o + pp * 32); rv[pp] = *(const u32x4*)(R + o + pp * 32); }
                float asum[16];
#pragma unroll
                for (int d = 0; d < 2; ++d) {
                    f32x4 acc[4];
#pragma unroll
                    for (int n = 0; n < 4; ++n) {
                        acc[n] = (f32x4){0.f, 0.f, 0.f, 0.f};
#pragma unroll
                        for (int ks = 0; ks < KS; ++ks) acc[n] = __builtin_amdgcn_mfma_f32_16x16x32_bf16(bfr[d][n][ks], afr[m][d][ks], acc[n], 0, 0, 0);
                    }
#pragma unroll
                    for (int pp = 0; pp < 2; ++pp) {
                        const float* bp = cst + 768 + d * 256 + wc * 64 + pp * 32 + 8 * fq;
                        const float4 b0 = *(const float4*)bp, b1 = *(const float4*)(bp + 4);
                        const float bs[8] = {b0.x, b0.y, b0.z, b0.w, b1.x, b1.y, b1.z, b1.w};
                        float av[8];
#pragma unroll
                        for (int e = 0; e < 8; e += 2) {
                            const f32x2_t x = {acc[2 * pp + (e >> 2)][e & 3], acc[2 * pp + (e >> 2)][(e & 3) + 1]}, bb = {bs[e], bs[e + 1]};
                            const f32x2_t t = x * -1.44269504089f + bb;
                            f32x2_t ex; ex.x = __builtin_amdgcn_exp2f(t.x); ex.y = __builtin_amdgcn_exp2f(t.y);
                            const f32x2_t dn = ex + 1.0f;
                            av[e] = __builtin_amdgcn_rcpf(dn.x); av[e + 1] = __builtin_amdgcn_rcpf(dn.y);
                        }
                        const u32x4 w = {pack2(av[0], av[1]), pack2(av[2], av[3]), pack2(av[4], av[5]), pack2(av[6], av[7])};
                        *(u32x4*)(AD + (size_t)d * NT * D + o + pp * 32) = w;
#pragma unroll
                        for (int e = 0; e < 8; ++e) { const float ab = bf2f(f2bf(av[e])); asum[pp * 8 + e] = d == 0 ? ab : asum[pp * 8 + e] + ab; }
                    }
                }
                if (rt + 1 < rt1) {
#pragma unroll
                    for (int d = 0; d < 2; ++d)
#pragma unroll
                        for (int ks = 0; ks < KS; ++ks) afr[m][d][ks] = *(const bf16x8*)(A + (size_t)((rt + 1) * TR + wr * (16 * MT) + m * 16 + fr) * 128 + d * 64 + ks * 32 + fq * 8);
                }
                float kk[16]; float n2 = 0.f, bon = 0.f;
#pragma unroll
                for (int pp = 0; pp < 2; ++pp) {
                    const float* cp = cst + wc * 64 + pp * 32 + 8 * fq;
                    const float4 q0 = *(const float4*)cp, q1 = *(const float4*)(cp + 4), c10 = *(const float4*)(cp + 256), c11 = *(const float4*)(cp + 260), c20 = *(const float4*)(cp + 512), c21 = *(const float4*)(cp + 516);
                    const float kkw[8] = {q0.x, q0.y, q0.z, q0.w, q1.x, q1.y, q1.z, q1.w}, c1[8] = {c10.x, c10.y, c10.z, c10.w, c11.x, c11.y, c11.z, c11.w}, c2[8] = {c20.x, c20.y, c20.z, c20.w, c21.x, c21.y, c21.z, c21.w};
#pragma unroll
                    for (int e = 0; e < 8; ++e) {
                        const unsigned kw = kv[pp][e >> 1], rw = rv[pp][e >> 1];
                        const float k = (e & 1) ? bfhi(kw) : bflo(kw), rr = (e & 1) ? bfhi(rw) : bflo(rw);
                        kk[pp * 8 + e] = k * kkw[e]; n2 += kk[pp * 8 + e] * kk[pp * 8 + e];
                        bon += rr * k * (c1[e] + c2[e] * asum[pp * 8 + e]);
                    }
                }
                bon = red4(bon); n2 = red4(n2);
                if (fq == 0) BON[(size_t)row * 16 + head] = bon;
                const float inv = 1.f / fmaxf(sqrtf(n2), 1e-12f);
#pragma unroll
                for (int pp = 0; pp < 2; ++pp) {
                    const u32x4 w = {pack2(kk[pp * 8 + 0] * inv, kk[pp * 8 + 1] * inv), pack2(kk[pp * 8 + 2] * inv, kk[pp * 8 + 3] * inv), pack2(kk[pp * 8 + 4] * inv, kk[pp * 8 + 5] * inv), pack2(kk[pp * 8 + 6] * inv, kk[pp * 8 + 7] * inv)};
                    *(u32x4*)(KK + o + pp * 32) = w;
                }
            }
        }
    }
}

__device__ __forceinline__ void phase_rwkv_prep(const Params& p, int j) {
    const bf16_t* R = (const bf16_t*)(p.ws + OFF_R); const bf16_t* Kb = (const bf16_t*)(p.ws + OFF_K);
    const bf16_t* AD = (const bf16_t*)(p.ws + OFF_AD);
    bf16_t* KK = (bf16_t*)(p.ws + OFF_H); float* BON = (float*)(p.ws + OFF_BON);
    const float* k_k = p.in[21] + (size_t)j * D; const float* k_a = p.in[22] + (size_t)j * D; const float* r_k = p.in[23] + (size_t)j * D;
    const int tid_ = tidx(), lane = tid_ & 63, wid = tid_ >> 6, c0 = lane * 16;
    float kkw[16], kaw[16], rkw[16];
#pragma unroll
    for (int i = 0; i < 16; ++i) { kkw[i] = k_k[c0 + i]; kaw[i] = k_a[c0 + i]; rkw[i] = r_k[c0 + i]; }
    constexpr int RW = 2;
    for (int grp = blockIdx.x * 8 + wid; grp < NT / RW; grp += gridDim.x * 8) {
        u32x4 kv[RW][2], rv[RW][2], a0[RW][2], a1[RW][2];
#pragma unroll
        for (int r = 0; r < RW; ++r) {
            const size_t o = (size_t)(grp * RW + r) * D + c0;
#pragma unroll
            for (int i = 0; i < 2; ++i) {
                kv[r][i] = *(const u32x4*)(Kb + o + i * 8); rv[r][i] = *(const u32x4*)(R + o + i * 8);
                a0[r][i] = *(const u32x4*)(AD + o + i * 8); a1[r][i] = *(const u32x4*)(AD + (size_t)NT * D + o + i * 8);
            }
        }
#pragma unroll
        for (int r = 0; r < RW; ++r) {
            const int row = grp * RW + r;
            const size_t o = (size_t)row * D + c0;
            float kk[16]; float n2 = 0.f, bon = 0.f;
#pragma unroll
            for (int i = 0; i < 16; ++i) {
                const unsigned kw = kv[r][i >> 3][(i >> 1) & 3], rw = rv[r][i >> 3][(i >> 1) & 3], aw0 = a0[r][i >> 3][(i >> 1) & 3], aw1 = a1[r][i >> 3][(i >> 1) & 3];
                const float k = (i & 1) ? bfhi(kw) : bflo(kw), rr = (i & 1) ? bfhi(rw) : bflo(rw);
                const float am = 0.5f * (((i & 1) ? bfhi(aw0) : bflo(aw0)) + ((i & 1) ? bfhi(aw1) : bflo(aw1)));
                kk[i] = k * kkw[i]; n2 += kk[i] * kk[i];
                bon += rr * (k * (1.f + (am - 1.f) * kaw[i])) * rkw[i];
            }
            n2 += __shfl_xor(n2, 1, 64); n2 += __shfl_xor(n2, 2, 64);
            bon += __shfl_xor(bon, 1, 64); bon += __shfl_xor(bon, 2, 64);
            const float inv = 1.f / fmaxf(sqrtf(n2), 1e-12f);
            u32x4 ov[2];
#pragma unroll
            for (int i = 0; i < 8; ++i) ov[i >> 2][i & 3] = pack2(kk[2 * i] * inv, kk[2 * i + 1] * inv);
            *(u32x4*)(KK + o) = ov[0]; *(u32x4*)(KK + o + 8) = ov[1];
            if ((lane & 3) == 0) BON[(size_t)row * 16 + (lane >> 2)] = bon;
        }
    }
}

#define SCAN_STEP_ASM \
    "s_nop 1\n\t" \
    "v_mul_f32_dpp %0, %20, %0 row_newbcast:0 row_mask:0xf bank_mask:0xf\n\t" \
    "v_mul_f32_dpp %1, %20, %1 row_newbcast:1 row_mask:0xf bank_mask:0xf\n\t" \
    "v_mul_f32_dpp %2, %20, %2 row_newbcast:2 row_mask:0xf bank_mask:0xf\n\t" \
    "v_mul_f32_dpp %3, %20, %3 row_newbcast:3 row_mask:0xf bank_mask:0xf\n\t" \
    "v_mul_f32_dpp %4, %20, %4 row_newbcast:4 row_mask:0xf bank_mask:0xf\n\t" \
    "v_mul_f32_dpp %5, %20, %5 row_newbcast:5 row_mask:0xf bank_mask:0xf\n\t" \
    "v_mul_f32_dpp %6, %20, %6 row_newbcast:6 row_mask:0xf bank_mask:0xf\n\t" \
    "v_mul_f32_dpp %7, %20, %7 row_newbcast:7 row_mask:0xf bank_mask:0xf\n\t" \
    "v_mul_f32_dpp %8, %20, %8 row_newbcast:8 row_mask:0xf bank_mask:0xf\n\t" \
    "v_mul_f32_dpp %9, %20, %9 row_newbcast:9 row_mask:0xf bank_mask:0xf\n\t" \
    "v_mul_f32_dpp %10, %20, %10 row_newbcast:10 row_mask:0xf bank_mask:0xf\n\t" \
    "v_mul_f32_dpp %11, %20, %11 row_newbcast:11 row_mask:0xf bank_mask:0xf\n\t" \
    "v_mul_f32_dpp %12, %20, %12 row_newbcast:12 row_mask:0xf bank_mask:0xf\n\t" \
    "v_mul_f32_dpp %13, %20, %13 row_newbcast:13 row_mask:0xf bank_mask:0xf\n\t" \
    "v_mul_f32_dpp %14, %20, %14 row_newbcast:14 row_mask:0xf bank_mask:0xf\n\t" \
    "v_mul_f32_dpp %15, %20, %15 row_newbcast:15 row_mask:0xf bank_mask:0xf\n\t" \
    "v_fmac_f32_dpp %0, %21, %25 row_newbcast:0 row_mask:0xf bank_mask:0xf\n\t" \
    "v_fmac_f32_dpp %1, %21, %25 row_newbcast:1 row_mask:0xf bank_mask:0xf\n\t" \
    "v_fmac_f32_dpp %2, %21, %25 row_newbcast:2 row_mask:0xf bank_mask:0xf\n\t" \
    "v_fmac_f32_dpp %3, %21, %25 row_newbcast:3 row_mask:0xf bank_mask:0xf\n\t" \
    "v_fmac_f32_dpp %4, %21, %25 row_newbcast:4 row_mask:0xf bank_mask:0xf\n\t" \
    "v_fmac_f32_dpp %5, %21, %25 row_newbcast:5 row_mask:0xf bank_mask:0xf\n\t" \
    "v_fmac_f32_dpp %6, %21, %25 row_newbcast:6 row_mask:0xf bank_mask:0xf\n\t" \
    "v_fmac_f32_dpp %7, %21, %25 row_newbcast:7 row_mask:0xf bank_mask:0xf\n\t" \
    "v_fmac_f32_dpp %8, %21, %25 row_newbcast:8 row_mask:0xf bank_mask:0xf\n\t" \
    "v_fmac_f32_dpp %9, %21, %25 row_newbcast:9 row_mask:0xf bank_mask:0xf\n\t" \
    "v_fmac_f32_dpp %10, %21, %25 row_newbcast:10 row_mask:0xf bank_mask:0xf\n\t" \
    "v_fmac_f32_dpp %11, %21, %25 row_newbcast:11 row_mask:0xf bank_mask:0xf\n\t" \
    "v_fmac_f32_dpp %12, %21, %25 row_newbcast:12 row_mask:0xf bank_mask:0xf\n\t" \
    "v_fmac_f32_dpp %13, %21, %25 row_newbcast:13 row_mask:0xf bank_mask:0xf\n\t" \
    "v_fmac_f32_dpp %14, %21, %25 row_newbcast:14 row_mask:0xf bank_mask:0xf\n\t" \
    "v_fmac_f32_dpp %15, %21, %25 row_newbcast:15 row_mask:0xf bank_mask:0xf\n\t" \
    "v_fmac_f32_dpp %0, %22, %26 row_newbcast:0 row_mask:0xf bank_mask:0xf\n\t" \
    "v_fmac_f32_dpp %1, %22, %26 row_newbcast:1 row_mask:0xf bank_mask:0xf\n\t" \
    "v_fmac_f32_dpp %2, %22, %26 row_newbcast:2 row_mask:0xf bank_mask:0xf\n\t" \
    "v_fmac_f32_dpp %3, %22, %26 row_newbcast:3 row_mask:0xf bank_mask:0xf\n\t" \
    "v_fmac_f32_dpp %4, %22, %26 row_newbcast:4 row_mask:0xf bank_mask:0xf\n\t" \
    "v_fmac_f32_dpp %5, %22, %26 row_newbcast:5 row_mask:0xf bank_mask:0xf\n\t" \
    "v_fmac_f32_dpp %6, %22, %26 row_newbcast:6 row_mask:0xf bank_mask:0xf\n\t" \
    "v_fmac_f32_dpp %7, %22, %26 row_newbcast:7 row_mask:0xf bank_mask:0xf\n\t" \
    "v_fmac_f32_dpp %8, %22, %26 row_newbcast:8 row_mask:0xf bank_mask:0xf\n\t" \
    "v_fmac_f32_dpp %9, %22, %26 row_newbcast:9 row_mask:0xf bank_mask:0xf\n\t" \
    "v_fmac_f32_dpp %10, %22, %26 row_newbcast:10 row_mask:0xf bank_mask:0xf\n\t" \
    "v_fmac_f32_dpp %11, %22, %26 row_newbcast:11 row_mask:0xf bank_mask:0xf\n\t" \
    "v_fmac_f32_dpp %12, %22, %26 row_newbcast:12 row_mask:0xf bank_mask:0xf\n\t" \
    "v_fmac_f32_dpp %13, %22, %26 row_newbcast:13 row_mask:0xf bank_mask:0xf\n\t" \
    "v_fmac_f32_dpp %14, %22, %26 row_newbcast:14 row_mask:0xf bank_mask:0xf\n\t" \
    "v_fmac_f32_dpp %15, %22, %26 row_newbcast:15 row_mask:0xf bank_mask:0xf\n\t" \
    "v_mul_f32_dpp %16, %23, %0 row_newbcast:0 row_mask:0xf bank_mask:0xf\n\t" \
    "v_mul_f32_dpp %18, %24, %0 row_newbcast:0 row_mask:0xf bank_mask:0xf\n\t" \
    "v_mul_f32_dpp %17, %23, %1 row_newbcast:1 row_mask:0xf bank_mask:0xf\n\t" \
    "v_mul_f32_dpp %19, %24, %1 row_newbcast:1 row_mask:0xf bank_mask:0xf\n\t" \
    "v_fmac_f32_dpp %16, %23, %2 row_newbcast:2 row_mask:0xf bank_mask:0xf\n\t" \
    "v_fmac_f32_dpp %18, %24, %2 row_newbcast:2 row_mask:0xf bank_mask:0xf\n\t" \
    "v_fmac_f32_dpp %17, %23, %3 row_newbcast:3 row_mask:0xf bank_mask:0xf\n\t" \
    "v_fmac_f32_dpp %19, %24, %3 row_newbcast:3 row_mask:0xf bank_mask:0xf\n\t" \
    "v_fmac_f32_dpp %16, %23, %4 row_newbcast:4 row_mask:0xf bank_mask:0xf\n\t" \
    "v_fmac_f32_dpp %18, %24, %4 row_newbcast:4 row_mask:0xf bank_mask:0xf\n\t" \
    "v_fmac_f32_dpp %17, %23, %5 row_newbcast:5 row_mask:0xf bank_mask:0xf\n\t" \
    "v_fmac_f32_dpp %19, %24, %5 row_newbcast:5 row_mask:0xf bank_mask:0xf\n\t" \
    "v_fmac_f32_dpp %16, %23, %6 row_newbcast:6 row_mask:0xf bank_mask:0xf\n\t" \
    "v_fmac_f32_dpp %18, %24, %6 row_newbcast:6 row_mask:0xf bank_mask:0xf\n\t" \
    "v_fmac_f32_dpp %17, %23, %7 row_newbcast:7 row_mask:0xf bank_mask:0xf\n\t" \
    "v_fmac_f32_dpp %19, %24, %7 row_newbcast:7 row_mask:0xf bank_mask:0xf\n\t" \
    "v_fmac_f32_dpp %16, %23, %8 row_newbcast:8 row_mask:0xf bank_mask:0xf\n\t" \
    "v_fmac_f32_dpp %18, %24, %8 row_newbcast:8 row_mask:0xf bank_mask:0xf\n\t" \
    "v_fmac_f32_dpp %17, %23, %9 row_newbcast:9 row_mask:0xf bank_mask:0xf\n\t" \
    "v_fmac_f32_dpp %19, %24, %9 row_newbcast:9 row_mask:0xf bank_mask:0xf\n\t" \
    "v_fmac_f32_dpp %16, %23, %10 row_newbcast:10 row_mask:0xf bank_mask:0xf\n\t" \
    "v_fmac_f32_dpp %18, %24, %10 row_newbcast:10 row_mask:0xf bank_mask:0xf\n\t" \
    "v_fmac_f32_dpp %17, %23, %11 row_newbcast:11 row_mask:0xf bank_mask:0xf\n\t" \
    "v_fmac_f32_dpp %19, %24, %11 row_newbcast:11 row_mask:0xf bank_mask:0xf\n\t" \
    "v_fmac_f32_dpp %16, %23, %12 row_newbcast:12 row_mask:0xf bank_mask:0xf\n\t" \
    "v_fmac_f32_dpp %18, %24, %12 row_newbcast:12 row_mask:0xf bank_mask:0xf\n\t" \
    "v_fmac_f32_dpp %17, %23, %13 row_newbcast:13 row_mask:0xf bank_mask:0xf\n\t" \
    "v_fmac_f32_dpp %19, %24, %13 row_newbcast:13 row_mask:0xf bank_mask:0xf\n\t" \
    "v_fmac_f32_dpp %16, %23, %14 row_newbcast:14 row_mask:0xf bank_mask:0xf\n\t" \
    "v_fmac_f32_dpp %18, %24, %14 row_newbcast:14 row_mask:0xf bank_mask:0xf\n\t" \
    "v_fmac_f32_dpp %17, %23, %15 row_newbcast:15 row_mask:0xf bank_mask:0xf\n\t" \
    "v_fmac_f32_dpp %19, %24, %15 row_newbcast:15 row_mask:0xf bank_mask:0xf\n\t" \
    ""

__device__ __forceinline__ void phase_rwkv_scan(const Params& p, int j, char* lds) {
    const bf16_t* R = (const bf16_t*)(p.ws + OFF_R); const bf16_t* Kb = (const bf16_t*)(p.ws + OFF_K);
    const bf16_t* V = (const bf16_t*)(p.ws + OFF_VF); const bf16_t* KK = (const bf16_t*)(p.ws + OFF_H);
    const bf16_t* LW = (const bf16_t*)(p.ws + OFF_LW); const bf16_t* AD = (const bf16_t*)(p.ws + OFF_AD);
    bf16_t* Y = (bf16_t*)(p.ws + OFF_Y);
    const int tid = tidx(), lane = tid & 63, wid = tid >> 6, cl = wid >> 2, q = wid & 3;
    for (int cp = blockIdx.x; cp < 256; cp += gridDim.x) {
        const int chain = cp * 2 + cl, d = chain & 1, bh = chain >> 1, b = bh >> 4, h = bh & 15;
        const int col = h * 64 + lane, vcol = h * 64 + q * 16 + (lane & 15);
        const float ka = p.in[22][(size_t)j * D + col];
        const bf16_t* LWd = LW + (size_t)d * NT * D; const bf16_t* ADd = AD + (size_t)d * NT * D;
        bf16_t* Yd = Y + (size_t)d * NT * D;
        float S0 = 0.f, S1 = 0.f, S2 = 0.f, S3 = 0.f, S4 = 0.f, S5 = 0.f, S6 = 0.f, S7 = 0.f, S8 = 0.f, S9 = 0.f, S10 = 0.f, S11 = 0.f, S12 = 0.f, S13 = 0.f, S14 = 0.f, S15 = 0.f;
        float sa = 0.f;
        auto row_of = [&](int s) -> int {
            if (s < TC) { const int t = d ? (TC - 1 - s) : s; return NLAT + b * TC + t; }
            const int tl = s - TC; const int t = d ? (TL - 1 - tl) : tl; return b * TL + t;
        };
        auto row_kk = [&](int s) -> int { return row_of(s < TC + TL ? s : TC + TL - 1); };
        const int colw = col & ~1, vcolw = vcol & ~1;
        const unsigned shc = (col & 1) ? 0u : 16u, shv = (vcol & 1) ? 0u : 16u;
#define LDW(P, off) (*(const unsigned*)((P) + (off)))
#define UNP(w, sh) __uint_as_float(((w) << (sh)) & 0xffff0000u)
        unsigned nr[4], nkk[4], nk[4], nlw[4], na[4], nv[4];
#pragma unroll
        for (int g = 0; g < 4; ++g) {
            const size_t o = (size_t)row_of(g) * D;
            nr[g] = LDW(R, o + colw); nk[g] = LDW(Kb, o + colw); nlw[g] = LDW(LWd, o + colw); na[g] = LDW(ADd, o + colw); nv[g] = LDW(V, o + vcolw);
            nkk[g] = LDW(KK, (size_t)row_kk(g + 1) * D + colw);
        }
        float kk_cur = bf2f(KK[(size_t)row_of(0) * D + col]);
        constexpr int NSTEP = TC + TL;
        for (int s0 = 0; s0 < NSTEP; s0 += 4) {
            unsigned cr[4], ckk[4], ck[4], clw[4], ca[4], cv[4];
#pragma unroll
            for (int g = 0; g < 4; ++g) { cr[g] = nr[g]; ckk[g] = nkk[g]; ck[g] = nk[g]; clw[g] = nlw[g]; ca[g] = na[g]; cv[g] = nv[g]; }
            if (s0 + 4 < NSTEP) {
#pragma unroll
                for (int g = 0; g < 4; ++g) {
                    const size_t o = (size_t)row_of(s0 + 4 + g) * D;
                    nr[g] = LDW(R, o + colw); nk[g] = LDW(Kb, o + colw); nlw[g] = LDW(LWd, o + colw); na[g] = LDW(ADd, o + colw); nv[g] = LDW(V, o + vcolw);
                    nkk[g] = LDW(KK, (size_t)row_kk(s0 + 5 + g) * D + colw);
                }
            }
#pragma unroll
            for (int g = 0; g < 4; ++g) {
                const float rr = UNP(cr[g], shc), kkc = kk_cur, kkn = UNP(ckk[g], shc), kv = UNP(ck[g], shc), av = UNP(ca[g], shc), vv = UNP(cv[g], shv);
                kk_cur = kkn;
                const float dec = __expf(UNP(clw[g], shc)), bb = kkc * av, kd = kv * (1.f + (av - 1.f) * ka);
                float py0, py1, ps0, ps1;
                asm volatile(SCAN_STEP_ASM
                    : "+v"(S0), "+v"(S1), "+v"(S2), "+v"(S3), "+v"(S4), "+v"(S5), "+v"(S6), "+v"(S7), "+v"(S8), "+v"(S9), "+v"(S10), "+v"(S11), "+v"(S12), "+v"(S13), "+v"(S14), "+v"(S15),
                      "=&v"(py0), "=&v"(py1), "=&v"(ps0), "=&v"(ps1)
                    : "v"(dec), "v"(bb), "v"(kd), "v"(rr), "v"(kkn), "v"(sa), "v"(vv));
                sa = -red4(ps0 + ps1);
                const float yv = red4(py0 + py1);
                if (lane < 16) Yd[(size_t)row_of(s0 + g) * D + vcol] = f2bf(yv);
            }
        }
#undef LDW
#undef UNP
    }
}

#define TRI_ASM1 \
    "s_nop 1\n\t" \
    "v_xor_b32 %0, 0x80000000, %0\n\t" \
    "v_fmac_f32_dpp %1, %8, %0 row_newbcast:1 row_mask:0xf bank_mask:0xf\n\t" \
    "v_xor_b32 %1, 0x80000000, %1\n\t" \
    "v_fmac_f32_dpp %2, %8, %0 row_newbcast:2 row_mask:0xf bank_mask:0xf\n\t" \
    "v_fmac_f32_dpp %2, %9, %1 row_newbcast:2 row_mask:0xf bank_mask:0xf\n\t" \
    "v_xor_b32 %2, 0x80000000, %2\n\t" \
    "v_fmac_f32_dpp %3, %8, %0 row_newbcast:3 row_mask:0xf bank_mask:0xf\n\t" \
    "v_fmac_f32_dpp %3, %9, %1 row_newbcast:3 row_mask:0xf bank_mask:0xf\n\t" \
    "v_fmac_f32_dpp %3, %10, %2 row_newbcast:3 row_mask:0xf bank_mask:0xf\n\t" \
    "v_xor_b32 %3, 0x80000000, %3\n\t" \
    "v_fmac_f32_dpp %4, %8, %0 row_newbcast:4 row_mask:0xf bank_mask:0xf\n\t" \
    "v_fmac_f32_dpp %4, %9, %1 row_newbcast:4 row_mask:0xf bank_mask:0xf\n\t" \
    "v_fmac_f32_dpp %4, %10, %2 row_newbcast:4 row_mask:0xf bank_mask:0xf\n\t" \
    "v_fmac_f32_dpp %4, %11, %3 row_newbcast:4 row_mask:0xf bank_mask:0xf\n\t" \
    "v_xor_b32 %4, 0x80000000, %4\n\t" \
    "v_fmac_f32_dpp %5, %8, %0 row_newbcast:5 row_mask:0xf bank_mask:0xf\n\t" \
    "v_fmac_f32_dpp %5, %9, %1 row_newbcast:5 row_mask:0xf bank_mask:0xf\n\t" \
    "v_fmac_f32_dpp %5, %10, %2 row_newbcast:5 row_mask:0xf bank_mask:0xf\n\t" \
    "v_fmac_f32_dpp %5, %11, %3 row_newbcast:5 row_mask:0xf bank_mask:0xf\n\t" \
    "v_fmac_f32_dpp %5, %12, %4 row_newbcast:5 row_mask:0xf bank_mask:0xf\n\t" \
    "v_xor_b32 %5, 0x80000000, %5\n\t" \
    "v_fmac_f32_dpp %6, %8, %0 row_newbcast:6 row_mask:0xf bank_mask:0xf\n\t" \
    "v_fmac_f32_dpp %6, %9, %1 row_newbcast:6 row_mask:0xf bank_mask:0xf\n\t" \
    "v_fmac_f32_dpp %6, %10, %2 row_newbcast:6 row_mask:0xf bank_mask:0xf\n\t" \
    "v_fmac_f32_dpp %6, %11, %3 row_newbcast:6 row_mask:0xf bank_mask:0xf\n\t" \
    "v_fmac_f32_dpp %6, %12, %4 row_newbcast:6 row_mask:0xf bank_mask:0xf\n\t" \
    "v_fmac_f32_dpp %6, %13, %5 row_newbcast:6 row_mask:0xf bank_mask:0xf\n\t" \
    "v_xor_b32 %6, 0x80000000, %6\n\t" \
    "v_fmac_f32_dpp %7, %8, %0 row_newbcast:7 row_mask:0xf bank_mask:0xf\n\t" \
    "v_fmac_f32_dpp %7, %9, %1 row_newbcast:7 row_mask:0xf bank_mask:0xf\n\t" \
    "v_fmac_f32_dpp %7, %10, %2 row_newbcast:7 row_mask:0xf bank_mask:0xf\n\t" \
    "v_fmac_f32_dpp %7, %11, %3 row_newbcast:7 row_mask:0xf bank_mask:0xf\n\t" \
    "v_fmac_f32_dpp %7, %12, %4 row_newbcast:7 row_mask:0xf bank_mask:0xf\n\t" \
    "v_fmac_f32_dpp %7, %13, %5 row_newbcast:7 row_mask:0xf bank_mask:0xf\n\t" \
    "v_fmac_f32_dpp %7, %14, %6 row_newbcast:7 row_mask:0xf bank_mask:0xf\n\t" \
    "v_xor_b32 %7, 0x80000000, %7\n\t" \
    ""
#define TRI_ASM2 \
    "s_nop 1\n\t" \
    "v_fmac_f32_dpp %0, %16, %8 row_newbcast:8 row_mask:0xf bank_mask:0xf\n\t" \
    "v_fmac_f32_dpp %0, %17, %9 row_newbcast:8 row_mask:0xf bank_mask:0xf\n\t" \
    "v_fmac_f32_dpp %0, %18, %10 row_newbcast:8 row_mask:0xf bank_mask:0xf\n\t" \
    "v_fmac_f32_dpp %0, %19, %11 row_newbcast:8 row_mask:0xf bank_mask:0xf\n\t" \
    "v_fmac_f32_dpp %0, %20, %12 row_newbcast:8 row_mask:0xf bank_mask:0xf\n\t" \
    "v_fmac_f32_dpp %0, %21, %13 row_newbcast:8 row_mask:0xf bank_mask:0xf\n\t" \
    "v_fmac_f32_dpp %0, %22, %14 row_newbcast:8 row_mask:0xf bank_mask:0xf\n\t" \
    "v_fmac_f32_dpp %0, %23, %15 row_newbcast:8 row_mask:0xf bank_mask:0xf\n\t" \
    "v_fmac_f32_dpp %1, %16, %8 row_newbcast:9 row_mask:0xf bank_mask:0xf\n\t" \
    "v_fmac_f32_dpp %1, %17, %9 row_newbcast:9 row_mask:0xf bank_mask:0xf\n\t" \
    "v_fmac_f32_dpp %1, %18, %10 row_newbcast:9 row_mask:0xf bank_mask:0xf\n\t" \
    "v_fmac_f32_dpp %1, %19, %11 row_newbcast:9 row_mask:0xf bank_mask:0xf\n\t" \
    "v_fmac_f32_dpp %1, %20, %12 row_newbcast:9 row_mask:0xf bank_mask:0xf\n\t" \
    "v_fmac_f32_dpp %1, %21, %13 row_newbcast:9 row_mask:0xf bank_mask:0xf\n\t" \
    "v_fmac_f32_dpp %1, %22, %14 row_newbcast:9 row_mask:0xf bank_mask:0xf\n\t" \
    "v_fmac_f32_dpp %1, %23, %15 row_newbcast:9 row_mask:0xf bank_mask:0xf\n\t" \
    "v_fmac_f32_dpp %2, %16, %8 row_newbcast:10 row_mask:0xf bank_mask:0xf\n\t" \
    "v_fmac_f32_dpp %2, %17, %9 row_newbcast:10 row_mask:0xf bank_mask:0xf\n\t" \
    "v_fmac_f32_dpp %2, %18, %10 row_newbcast:10 row_mask:0xf bank_mask:0xf\n\t" \
    "v_fmac_f32_dpp %2, %19, %11 row_newbcast:10 row_mask:0xf bank_mask:0xf\n\t" \
    "v_fmac_f32_dpp %2, %20, %12 row_newbcast:10 row_mask:0xf bank_mask:0xf\n\t" \
    "v_fmac_f32_dpp %2, %21, %13 row_newbcast:10 row_mask:0xf bank_mask:0xf\n\t" \
    "v_fmac_f32_dpp %2, %22, %14 row_newbcast:10 row_mask:0xf bank_mask:0xf\n\t" \
    "v_fmac_f32_dpp %2, %23, %15 row_newbcast:10 row_mask:0xf bank_mask:0xf\n\t" \
    "v_fmac_f32_dpp %3, %16, %8 row_newbcast:11 row_mask:0xf bank_mask:0xf\n\t" \
    "v_fmac_f32_dpp %3, %17, %9 row_newbcast:11 row_mask:0xf bank_mask:0xf\n\t" \
    "v_fmac_f32_dpp %3, %18, %10 row_newbcast:11 row_mask:0xf bank_mask:0xf\n\t" \
    "v_fmac_f32_dpp %3, %19, %11 row_newbcast:11 row_mask:0xf bank_mask:0xf\n\t" \
    "v_fmac_f32_dpp %3, %20, %12 row_newbcast:11 row_mask:0xf bank_mask:0xf\n\t" \
    "v_fmac_f32_dpp %3, %21, %13 row_newbcast:11 row_mask:0xf bank_mask:0xf\n\t" \
    "v_fmac_f32_dpp %3, %22, %14 row_newbcast:11 row_mask:0xf bank_mask:0xf\n\t" \
    "v_fmac_f32_dpp %3, %23, %15 row_newbcast:11 row_mask:0xf bank_mask:0xf\n\t" \
    "v_fmac_f32_dpp %4, %16, %8 row_newbcast:12 row_mask:0xf bank_mask:0xf\n\t" \
    "v_fmac_f32_dpp %4, %17, %9 row_newbcast:12 row_mask:0xf bank_mask:0xf\n\t" \
    "v_fmac_f32_dpp %4, %18, %10 row_newbcast:12 row_mask:0xf bank_mask:0xf\n\t" \
    "v_fmac_f32_dpp %4, %19, %11 row_newbcast:12 row_mask:0xf bank_mask:0xf\n\t" \
    "v_fmac_f32_dpp %4, %20, %12 row_newbcast:12 row_mask:0xf bank_mask:0xf\n\t" \
    "v_fmac_f32_dpp %4, %21, %13 row_newbcast:12 row_mask:0xf bank_mask:0xf\n\t" \
    "v_fmac_f32_dpp %4, %22, %14 row_newbcast:12 row_mask:0xf bank_mask:0xf\n\t" \
    "v_fmac_f32_dpp %4, %23, %15 row_newbcast:12 row_mask:0xf bank_mask:0xf\n\t" \
    "v_fmac_f32_dpp %5, %16, %8 row_newbcast:13 row_mask:0xf bank_mask:0xf\n\t" \
    "v_fmac_f32_dpp %5, %17, %9 row_newbcast:13 row_mask:0xf bank_mask:0xf\n\t" \
    "v_fmac_f32_dpp %5, %18, %10 row_newbcast:13 row_mask:0xf bank_mask:0xf\n\t" \
    "v_fmac_f32_dpp %5, %19, %11 row_newbcast:13 row_mask:0xf bank_mask:0xf\n\t" \
    "v_fmac_f32_dpp %5, %20, %12 row_newbcast:13 row_mask:0xf bank_mask:0xf\n\t" \
    "v_fmac_f32_dpp %5, %21, %13 row_newbcast:13 row_mask:0xf bank_mask:0xf\n\t" \
    "v_fmac_f32_dpp %5, %22, %14 row_newbcast:13 row_mask:0xf bank_mask:0xf\n\t" \
    "v_fmac_f32_dpp %5, %23, %15 row_newbcast:13 row_mask:0xf bank_mask:0xf\n\t" \
    "v_fmac_f32_dpp %6, %16, %8 row_newbcast:14 row_mask:0xf bank_mask:0xf\n\t" \
    "v_fmac_f32_dpp %6, %17, %9 row_newbcast:14 row_mask:0xf bank_mask:0xf\n\t" \
    "v_fmac_f32_dpp %6, %18, %10 row_newbcast:14 row_mask:0xf bank_mask:0xf\n\t" \
    "v_fmac_f32_dpp %6, %19, %11 row_newbcast:14 row_mask:0xf bank_mask:0xf\n\t" \
    "v_fmac_f32_dpp %6, %20, %12 row_newbcast:14 row_mask:0xf bank_mask:0xf\n\t" \
    "v_fmac_f32_dpp %6, %21, %13 row_newbcast:14 row_mask:0xf bank_mask:0xf\n\t" \
    "v_fmac_f32_dpp %6, %22, %14 row_newbcast:14 row_mask:0xf bank_mask:0xf\n\t" \
    "v_fmac_f32_dpp %6, %23, %15 row_newbcast:14 row_mask:0xf bank_mask:0xf\n\t" \
    "v_fmac_f32_dpp %7, %16, %8 row_newbcast:15 row_mask:0xf bank_mask:0xf\n\t" \
    "v_fmac_f32_dpp %7, %17, %9 row_newbcast:15 row_mask:0xf bank_mask:0xf\n\t" \
    "v_fmac_f32_dpp %7, %18, %10 row_newbcast:15 row_mask:0xf bank_mask:0xf\n\t" \
    "v_fmac_f32_dpp %7, %19, %11 row_newbcast:15 row_mask:0xf bank_mask:0xf\n\t" \
    "v_fmac_f32_dpp %7, %20, %12 row_newbcast:15 row_mask:0xf bank_mask:0xf\n\t" \
    "v_fmac_f32_dpp %7, %21, %13 row_newbcast:15 row_mask:0xf bank_mask:0xf\n\t" \
    "v_fmac_f32_dpp %7, %22, %14 row_newbcast:15 row_mask:0xf bank_mask:0xf\n\t" \
    "v_fmac_f32_dpp %7, %23, %15 row_newbcast:15 row_mask:0xf bank_mask:0xf\n\t" \
    ""
#define TRI_ASM3 \
    "s_nop 1\n\t" \
    "v_xor_b32 %0, 0x80000000, %0\n\t" \
    "v_fmac_f32_dpp %1, %8, %0 row_newbcast:9 row_mask:0xf bank_mask:0xf\n\t" \
    "v_xor_b32 %1, 0x80000000, %1\n\t" \
    "v_fmac_f32_dpp %2, %8, %0 row_newbcast:10 row_mask:0xf bank_mask:0xf\n\t" \
    "v_fmac_f32_dpp %2, %9, %1 row_newbcast:10 row_mask:0xf bank_mask:0xf\n\t" \
    "v_xor_b32 %2, 0x80000000, %2\n\t" \
    "v_fmac_f32_dpp %3, %8, %0 row_newbcast:11 row_mask:0xf bank_mask:0xf\n\t" \
    "v_fmac_f32_dpp %3, %9, %1 row_newbcast:11 row_mask:0xf bank_mask:0xf\n\t" \
    "v_fmac_f32_dpp %3, %10, %2 row_newbcast:11 row_mask:0xf bank_mask:0xf\n\t" \
    "v_xor_b32 %3, 0x80000000, %3\n\t" \
    "v_fmac_f32_dpp %4, %8, %0 row_newbcast:12 row_mask:0xf bank_mask:0xf\n\t" \
    "v_fmac_f32_dpp %4, %9, %1 row_newbcast:12 row_mask:0xf bank_mask:0xf\n\t" \
    "v_fmac_f32_dpp %4, %10, %2 row_newbcast:12 row_mask:0xf bank_mask:0xf\n\t" \
    "v_fmac_f32_dpp %4, %11, %3 row_newbcast:12 row_mask:0xf bank_mask:0xf\n\t" \
    "v_xor_b32 %4, 0x80000000, %4\n\t" \
    "v_fmac_f32_dpp %5, %8, %0 row_newbcast:13 row_mask:0xf bank_mask:0xf\n\t" \
    "v_fmac_f32_dpp %5, %9, %1 row_newbcast:13 row_mask:0xf bank_mask:0xf\n\t" \
    "v_fmac_f32_dpp %5, %10, %2 row_newbcast:13 row_mask:0xf bank_mask:0xf\n\t" \
    "v_fmac_f32_dpp %5, %11, %3 row_newbcast:13 row_mask:0xf bank_mask:0xf\n\t" \
    "v_fmac_f32_dpp %5, %12, %4 row_newbcast:13 row_mask:0xf bank_mask:0xf\n\t" \
    "v_xor_b32 %5, 0x80000000, %5\n\t" \
    "v_fmac_f32_dpp %6, %8, %0 row_newbcast:14 row_mask:0xf bank_mask:0xf\n\t" \
    "v_fmac_f32_dpp %6, %9, %1 row_newbcast:14 row_mask:0xf bank_mask:0xf\n\t" \
    "v_fmac_f32_dpp %6, %10, %2 row_newbcast:14 row_mask:0xf bank_mask:0xf\n\t" \
    "v_fmac_f32_dpp %6, %11, %3 row_newbcast:14 row_mask:0xf bank_mask:0xf\n\t" \
    "v_fmac_f32_dpp %6, %12, %4 row_newbcast:14 row_mask:0xf bank_mask:0xf\n\t" \
    "v_fmac_f32_dpp %6, %13, %5 row_newbcast:14 row_mask:0xf bank_mask:0xf\n\t" \
    "v_xor_b32 %6, 0x80000000, %6\n\t" \
    "v_fmac_f32_dpp %7, %8, %0 row_newbcast:15 row_mask:0xf bank_mask:0xf\n\t" \
    "v_fmac_f32_dpp %7, %9, %1 row_newbcast:15 row_mask:0xf bank_mask:0xf\n\t" \
    "v_fmac_f32_dpp %7, %10, %2 row_newbcast:15 row_mask:0xf bank_mask:0xf\n\t" \
    "v_fmac_f32_dpp %7, %11, %3 row_newbcast:15 row_mask:0xf bank_mask:0xf\n\t" \
    "v_fmac_f32_dpp %7, %12, %4 row_newbcast:15 row_mask:0xf bank_mask:0xf\n\t" \
    "v_fmac_f32_dpp %7, %13, %5 row_newbcast:15 row_mask:0xf bank_mask:0xf\n\t" \
    "v_fmac_f32_dpp %7, %14, %6 row_newbcast:15 row_mask:0xf bank_mask:0xf\n\t" \
    "v_xor_b32 %7, 0x80000000, %7\n\t" \
    ""

constexpr int SC_KKT = 0, SC_RRT = 2048, SC_BHT = 4096, SC_KHT = 6144, SC_BHJ = 8192, SC_KHJ = 10240, SC_MBF = 12288, SC_RHF = 13312, SC_WLF = 14336, SC_STRIDE = 15360;
__device__ __forceinline__ bf16x8 mk8(unsigned a, unsigned b, unsigned c, unsigned d) { const u32x4 w = {a, b, c, d}; return __builtin_bit_cast(bf16x8, w); }
typedef short bf16x4 __attribute__((ext_vector_type(4)));
__device__ __forceinline__ bf16x4 mk4(unsigned a, unsigned b) { const u32x2 w = {a, b}; return __builtin_bit_cast(bf16x4, w); }
__device__ __forceinline__ void phase_rwkv_scan2(const Params& p, int j, char* lds_, bf16_t* Y, int dsel  ) {
    const bf16_t* R = (const bf16_t*)(p.ws + OFF_R); const bf16_t* Kb = (const bf16_t*)(p.ws + OFF_K);
    const bf16_t* V = (const bf16_t*)(p.ws + OFF_VF); const bf16_t* KK = (const bf16_t*)(p.ws + OFF_H);
    const bf16_t* LW = (const bf16_t*)(p.ws + OFF_LW); const bf16_t* AD = (const bf16_t*)(p.ws + OFF_AD);
    const int tid = tidx(), lane = tid & 63, wid = __builtin_amdgcn_readfirstlane(tid >> 6), cl = wid >> 2, q = wid & 3, g = lane >> 4, li = lane & 15;
    LAS unsigned char* wl = (LAS unsigned char*)lds_ + wid * SC_STRIDE;
    for (int cp = blockIdx.x; cp < 256; cp += gridDim.x) {
        const int chain = cp * 2 + cl, d = chain & 1, bh = chain >> 1, b = bh >> 4, h = bh & 15;
        if (dsel >= 0 && d != dsel) continue;
        const int col = h * 64 + lane;
        const int vcol = h * 64 + q * 16 + li;
        const float ka = p.in[22][(size_t)j * D + col];
        const bf16_t* LWd = LW + (size_t)d * NT * D; const bf16_t* ADd = AD + (size_t)d * NT * D;
        bf16_t* Yd = Y + (size_t)d * NT * D;
        const int dir = d ? -1 : 1;
        f32x4 T[4];
#pragma unroll
        for (int jb = 0; jb < 4; ++jb) T[jb] = (f32x4){0.f, 0.f, 0.f, 0.f};
        for (int c = 0; c < (TC + TL) / 16; ++c) {
            const int s0 = c * 16;
            int row0;
            if (s0 < TC) row0 = NLAT + b * TC + (d ? (TC - 1 - s0) : s0);
            else { const int tl = s0 - TC; row0 = b * TL + (d ? (TL - 1 - tl) : tl); }
            {
                float cw = 0.f, ep_prev = 1.f;
                unsigned bhp[8], khp[8];
                float bh_e = 0.f, kh_e = 0.f;
#pragma unroll
                for (int t = 0; t < 16; ++t) {
                    const size_t o = (size_t)(row0 + t * dir) * D + col;
                    const float rv = bf2f(R[o]), kkv = bf2f(KK[o]), kv = bf2f(Kb[o]), lwv = bf2f(LWd[o]), av = bf2f(ADd[o]);
                    cw += lwv;
                    const float ep = __expf(cw), em = __expf(-cw);
                    const float kkt = kkv * ep_prev, rt = rv * ep, bhv = kkv * av * em, khv = kv * (1.f + (av - 1.f) * ka) * em;
                    ep_prev = ep;
                    *(LAS bf16_t*)(wl + SC_KKT + t * 128 + lane * 2) = (bf16_t)(pack2(kkt, 0.f) & 0xffffu);
                    *(LAS bf16_t*)(wl + SC_RRT + t * 128 + lane * 2) = (bf16_t)(pack2(rt, 0.f) & 0xffffu);
                    *(LAS bf16_t*)(wl + SC_BHT + t * 128 + lane * 2) = (bf16_t)(pack2(bhv, 0.f) & 0xffffu);
                    *(LAS bf16_t*)(wl + SC_KHT + t * 128 + lane * 2) = (bf16_t)(pack2(khv, 0.f) & 0xffffu);
                    if (t & 1) { bhp[t >> 1] = pack2(bh_e, bhv); khp[t >> 1] = pack2(kh_e, khv); } else { bh_e = bhv; kh_e = khv; }
                }
                *(LAS u32x4*)(wl + SC_BHJ + lane * 32) = (u32x4){bhp[0], bhp[1], bhp[2], bhp[3]};
                *(LAS u32x4*)(wl + SC_BHJ + lane * 32 + 16) = (u32x4){bhp[4], bhp[5], bhp[6], bhp[7]};
                *(LAS u32x4*)(wl + SC_KHJ + lane * 32) = (u32x4){khp[0], khp[1], khp[2], khp[3]};
                *(LAS u32x4*)(wl + SC_KHJ + lane * 32 + 16) = (u32x4){khp[4], khp[5], khp[6], khp[7]};
                *(LAS float*)(wl + SC_WLF + lane * 4) = ep_prev;
            }
            unsigned vw0, vw1;
            {
                const size_t o = (size_t)(row0 + (4 * g) * dir) * D + vcol; const long st = (long)dir * D;
                const unsigned v0 = V[o], v1 = V[o + st], v2 = V[o + 2 * st], v3 = V[o + 3 * st];
                vw0 = v0 | (v1 << 16); vw1 = v2 | (v3 << 16);
            }
            asm volatile("" ::: "memory");
            f32x4 Mb = {0.f, 0.f, 0.f, 0.f}, Mk = Mb, Nb = Mb, Nk = Mb;
#pragma unroll
            for (int kk = 0; kk < 2; ++kk) {
                const int ko = li * 128 + (32 * kk + 8 * g) * 2;
                const bf16x8 aB = *(const LAS bf16x8*)(wl + SC_BHT + ko), aK = *(const LAS bf16x8*)(wl + SC_KHT + ko);
                const bf16x8 bK = *(const LAS bf16x8*)(wl + SC_KKT + ko), bR = *(const LAS bf16x8*)(wl + SC_RRT + ko);
                Mb = __builtin_amdgcn_mfma_f32_16x16x32_bf16(aB, bK, Mb, 0, 0, 0);
                Mk = __builtin_amdgcn_mfma_f32_16x16x32_bf16(aK, bK, Mk, 0, 0, 0);
                Nb = __builtin_amdgcn_mfma_f32_16x16x32_bf16(aB, bR, Nb, 0, 0, 0);
                Nk = __builtin_amdgcn_mfma_f32_16x16x32_bf16(aK, bR, Nk, 0, 0, 0);
            }
#pragma unroll
            for (int r = 0; r < 4; ++r) {
                const int s = 4 * g + r;
                Mb[r] = s < li ? Mb[r] : 0.f; Mk[r] = s < li ? Mk[r] : 0.f;
                Nb[r] = s <= li ? Nb[r] : 0.f; Nk[r] = s <= li ? Nk[r] : 0.f;
            }
            f32x4 PT = {0.f, 0.f, 0.f, 0.f}, QT = PT;
#pragma unroll
            for (int kk = 0; kk < 2; ++kk) {
                const bf16x8 bw = mk8(pack2(T[2 * kk][0], T[2 * kk][1]), pack2(T[2 * kk][2], T[2 * kk][3]), pack2(T[2 * kk + 1][0], T[2 * kk + 1][1]), pack2(T[2 * kk + 1][2], T[2 * kk + 1][3]));
                const int ko = li * 128 + (32 * kk + 4 * g) * 2;
                const u32x2 k0 = *(const LAS u32x2*)(wl + SC_KKT + ko), k1 = *(const LAS u32x2*)(wl + SC_KKT + ko + 32);
                const u32x2 r0 = *(const LAS u32x2*)(wl + SC_RRT + ko), r1 = *(const LAS u32x2*)(wl + SC_RRT + ko + 32);
                PT = __builtin_amdgcn_mfma_f32_16x16x32_bf16(mk8(k0[0], k0[1], k1[0], k1[1]), bw, PT, 0, 0, 0);
                QT = __builtin_amdgcn_mfma_f32_16x16x32_bf16(mk8(r0[0], r0[1], r1[0], r1[1]), bw, QT, 0, 0, 0);
            }
            const f32x4 RT = __builtin_amdgcn_mfma_f32_16x16x32_bf16(mk8(pack2(Mk[0], Mk[1]), pack2(Mk[2], Mk[3]), 0u, 0u), mk8(vw0, vw1, 0u, 0u), PT, 0, 0, 0);
            *(LAS f32x4*)(wl + SC_RHF + li * 64 + g * 16) = RT;
#pragma unroll
            for (int r = 0; r < 4; ++r) *(LAS float*)(wl + SC_MBF + (4 * g + r) * 64 + li * 4) = Mb[r];
            asm volatile("" ::: "memory");
            float x0, x1, x2, x3, x4, x5, x6, x7, x8, x9, x10, x11, x12, x13, x14, x15;
            { const f32x4 u = *(const LAS f32x4*)(wl + SC_RHF + li * 64); x0 = u[0]; x1 = u[1]; x2 = u[2]; x3 = u[3]; }
            { const f32x4 u = *(const LAS f32x4*)(wl + SC_RHF + li * 64 + 16); x4 = u[0]; x5 = u[1]; x6 = u[2]; x7 = u[3]; }
            { const f32x4 u = *(const LAS f32x4*)(wl + SC_RHF + li * 64 + 32); x8 = u[0]; x9 = u[1]; x10 = u[2]; x11 = u[3]; }
            { const f32x4 u = *(const LAS f32x4*)(wl + SC_RHF + li * 64 + 48); x12 = u[0]; x13 = u[1]; x14 = u[2]; x15 = u[3]; }
            float m0, m1, m2, m3, m4, m5, m6, m7, m8, m9, m10, m11, m12, m13, m14;
#define LDM(s) (*(const LAS float*)(wl + SC_MBF + (s) * 64 + li * 4))
            m0 = LDM(0); m1 = LDM(1); m2 = LDM(2); m3 = LDM(3); m4 = LDM(4); m5 = LDM(5); m6 = LDM(6); m7 = LDM(7);
            m8 = LDM(8); m9 = LDM(9); m10 = LDM(10); m11 = LDM(11); m12 = LDM(12); m13 = LDM(13); m14 = LDM(14);
#undef LDM
            asm volatile(TRI_ASM1 : "+v"(x0), "+v"(x1), "+v"(x2), "+v"(x3), "+v"(x4), "+v"(x5), "+v"(x6), "+v"(x7)
                                  : "v"(m0), "v"(m1), "v"(m2), "v"(m3), "v"(m4), "v"(m5), "v"(m6));
            asm volatile(TRI_ASM2 : "+v"(x8), "+v"(x9), "+v"(x10), "+v"(x11), "+v"(x12), "+v"(x13), "+v"(x14), "+v"(x15)
                                  : "v"(x0), "v"(x1), "v"(x2), "v"(x3), "v"(x4), "v"(x5), "v"(x6), "v"(x7), "v"(m0), "v"(m1), "v"(m2), "v"(m3), "v"(m4), "v"(m5), "v"(m6), "v"(m7));
            asm volatile(TRI_ASM3 : "+v"(x8), "+v"(x9), "+v"(x10), "+v"(x11), "+v"(x12), "+v"(x13), "+v"(x14), "+v"(x15)
                                  : "v"(m8), "v"(m9), "v"(m10), "v"(m11), "v"(m12), "v"(m13), "v"(m14));
            const float xs0 = g == 0 ? x0 : (g == 1 ? x4 : (g == 2 ? x8 : x12));
            const float xs1 = g == 0 ? x1 : (g == 1 ? x5 : (g == 2 ? x9 : x13));
            const float xs2 = g == 0 ? x2 : (g == 1 ? x6 : (g == 2 ? x10 : x14));
            const float xs3 = g == 0 ? x3 : (g == 1 ? x7 : (g == 2 ? x11 : x15));
            const bf16x8 bop = mk8(pack2(xs0, xs1), pack2(xs2, xs3), vw0, vw1);
            const f32x4 YT = __builtin_amdgcn_mfma_f32_16x16x32_bf16(mk8(pack2(Nb[0], Nb[1]), pack2(Nb[2], Nb[3]), pack2(Nk[0], Nk[1]), pack2(Nk[2], Nk[3])), bop, QT, 0, 0, 0);
#pragma unroll
            for (int r = 0; r < 4; ++r) Yd[(size_t)(row0 + (4 * g + r) * dir) * D + vcol] = (bf16_t)(pack2(YT[r], 0.f) & 0xffffu);
#pragma unroll
            for (int jb = 0; jb < 4; ++jb) {
                const u32x2 b2 = *(const LAS u32x2*)(wl + SC_BHJ + (16 * jb + li) * 32 + g * 8), k2 = *(const LAS u32x2*)(wl + SC_KHJ + (16 * jb + li) * 32 + g * 8);
                T[jb] = __builtin_amdgcn_mfma_f32_16x16x32_bf16(mk8(b2[0], b2[1], k2[0], k2[1]), bop, T[jb], 0, 0, 0);
                const f32x4 wv = *(const LAS f32x4*)(wl + SC_WLF + (16 * jb + 4 * g) * 4);
                T[jb] = T[jb] * wv;
            }
            asm volatile("" ::: "memory");
        }
    }
}

#define TRI2_ASMA \
    "s_nop 1\n\t" \
    "v_xor_b32 %0, 0x80000000, %0\n\t" \
    "v_fmac_f32_dpp %1, %16, %0 row_newbcast:1 row_mask:0xf bank_mask:0xf\n\t" \
    "v_fmac_f32_dpp %2, %16, %0 row_newbcast:2 row_mask:0xf bank_mask:0xf\n\t" \
    "v_fmac_f32_dpp %3, %16, %0 row_newbcast:3 row_mask:0xf bank_mask:0xf\n\t" \
    "v_fmac_f32_dpp %4, %16, %0 row_newbcast:4 row_mask:0xf bank_mask:0xf\n\t" \
    "v_fmac_f32_dpp %5, %16, %0 row_newbcast:5 row_mask:0xf bank_mask:0xf\n\t" \
    "v_fmac_f32_dpp %6, %16, %0 row_newbcast:6 row_mask:0xf bank_mask:0xf\n\t" \
    "v_fmac_f32_dpp %7, %16, %0 row_newbcast:7 row_mask:0xf bank_mask:0xf\n\t" \
    "v_fmac_f32_dpp %8, %16, %0 row_newbcast:8 row_mask:0xf bank_mask:0xf\n\t" \
    "v_fmac_f32_dpp %9, %16, %0 row_newbcast:9 row_mask:0xf bank_mask:0xf\n\t" \
    "v_fmac_f32_dpp %10, %16, %0 row_newbcast:10 row_mask:0xf bank_mask:0xf\n\t" \
    "v_fmac_f32_dpp %11, %16, %0 row_newbcast:11 row_mask:0xf bank_mask:0xf\n\t" \
    "v_fmac_f32_dpp %12, %16, %0 row_newbcast:12 row_mask:0xf bank_mask:0xf\n\t" \
    "v_fmac_f32_dpp %13, %16, %0 row_newbcast:13 row_mask:0xf bank_mask:0xf\n\t" \
    "v_fmac_f32_dpp %14, %16, %0 row_newbcast:14 row_mask:0xf bank_mask:0xf\n\t" \
    "v_fmac_f32_dpp %15, %16, %0 row_newbcast:15 row_mask:0xf bank_mask:0xf\n\t" \
    "v_xor_b32 %1, 0x80000000, %1\n\t" \
    "v_fmac_f32_dpp %2, %17, %1 row_newbcast:2 row_mask:0xf bank_mask:0xf\n\t" \
    "v_fmac_f32_dpp %3, %17, %1 row_newbcast:3 row_mask:0xf bank_mask:0xf\n\t" \
    "v_fmac_f32_dpp %4, %17, %1 row_newbcast:4 row_mask:0xf bank_mask:0xf\n\t" \
    "v_fmac_f32_dpp %5, %17, %1 row_newbcast:5 row_mask:0xf bank_mask:0xf\n\t" \
    "v_fmac_f32_dpp %6, %17, %1 row_newbcast:6 row_mask:0xf bank_mask:0xf\n\t" \
    "v_fmac_f32_dpp %7, %17, %1 row_newbcast:7 row_mask:0xf bank_mask:0xf\n\t" \
    "v_fmac_f32_dpp %8, %17, %1 row_newbcast:8 row_mask:0xf bank_mask:0xf\n\t" \
    "v_fmac_f32_dpp %9, %17, %1 row_newbcast:9 row_mask:0xf bank_mask:0xf\n\t" \
    "v_fmac_f32_dpp %10, %17, %1 row_newbcast:10 row_mask:0xf bank_mask:0xf\n\t" \
    "v_fmac_f32_dpp %11, %17, %1 row_newbcast:11 row_mask:0xf bank_mask:0xf\n\t" \
    "v_fmac_f32_dpp %12, %17, %1 row_newbcast:12 row_mask:0xf bank_mask:0xf\n\t" \
    "v_fmac_f32_dpp %13, %17, %1 row_newbcast:13 row_mask:0xf bank_mask:0xf\n\t" \
    "v_fmac_f32_dpp %14, %17, %1 row_newbcast:14 row_mask:0xf bank_mask:0xf\n\t" \
    "v_fmac_f32_dpp %15, %17, %1 row_newbcast:15 row_mask:0xf bank_mask:0xf\n\t" \
    "v_xor_b32 %2, 0x80000000, %2\n\t" \
    "v_fmac_f32_dpp %3, %18, %2 row_newbcast:3 row_mask:0xf bank_mask:0xf\n\t" \
    "v_fmac_f32_dpp %4, %18, %2 row_newbcast:4 row_mask:0xf bank_mask:0xf\n\t" \
    "v_fmac_f32_dpp %5, %18, %2 row_newbcast:5 row_mask:0xf bank_mask:0xf\n\t" \
    "v_fmac_f32_dpp %6, %18, %2 row_newbcast:6 row_mask:0xf bank_mask:0xf\n\t" \
    "v_fmac_f32_dpp %7, %18, %2 row_newbcast:7 row_mask:0xf bank_mask:0xf\n\t" \
    "v_fmac_f32_dpp %8, %18, %2 row_newbcast:8 row_mask:0xf bank_mask:0xf\n\t" \
    "v_fmac_f32_dpp %9, %18, %2 row_newbcast:9 row_mask:0xf bank_mask:0xf\n\t" \
    "v_fmac_f32_dpp %10, %18, %2 row_newbcast:10 row_mask:0xf bank_mask:0xf\n\t" \
    "v_fmac_f32_dpp %11, %18, %2 row_newbcast:11 row_mask:0xf bank_mask:0xf\n\t" \
    "v_fmac_f32_dpp %12, %18, %2 row_newbcast:12 row_mask:0xf bank_mask:0xf\n\t" \
    "v_fmac_f32_dpp %13, %18, %2 row_newbcast:13 row_mask:0xf bank_mask:0xf\n\t" \
    "v_fmac_f32_dpp %14, %18, %2 row_newbcast:14 row_mask:0xf bank_mask:0xf\n\t" \
    "v_fmac_f32_dpp %15, %18, %2 row_newbcast:15 row_mask:0xf bank_mask:0xf\n\t" \
    "v_xor_b32 %3, 0x80000000, %3\n\t" \
    "v_fmac_f32_dpp %4, %19, %3 row_newbcast:4 row_mask:0xf bank_mask:0xf\n\t" \
    "v_fmac_f32_dpp %5, %19, %3 row_newbcast:5 row_mask:0xf bank_mask:0xf\n\t" \
    "v_fmac_f32_dpp %6, %19, %3 row_newbcast:6 row_mask:0xf bank_mask:0xf\n\t" \
    "v_fmac_f32_dpp %7, %19, %3 row_newbcast:7 row_mask:0xf bank_mask:0xf\n\t" \
    "v_fmac_f32_dpp %8, %19, %3 row_newbcast:8 row_mask:0xf bank_mask:0xf\n\t" \
    "v_fmac_f32_dpp %9, %19, %3 row_newbcast:9 row_mask:0xf bank_mask:0xf\n\t" \
    "v_fmac_f32_dpp %10, %19, %3 row_newbcast:10 row_mask:0xf bank_mask:0xf\n\t" \
    "v_fmac_f32_dpp %11, %19, %3 row_newbcast:11 row_mask:0xf bank_mask:0xf\n\t" \
    "v_fmac_f32_dpp %12, %19, %3 row_newbcast:12 row_mask:0xf bank_mask:0xf\n\t" \
    "v_fmac_f32_dpp %13, %19, %3 row_newbcast:13 row_mask:0xf bank_mask:0xf\n\t" \
    "v_fmac_f32_dpp %14, %19, %3 row_newbcast:14 row_mask:0xf bank_mask:0xf\n\t" \
    "v_fmac_f32_dpp %15, %19, %3 row_newbcast:15 row_mask:0xf bank_mask:0xf\n\t" \
    "v_xor_b32 %4, 0x80000000, %4\n\t" \
    "v_fmac_f32_dpp %5, %20, %4 row_newbcast:5 row_mask:0xf bank_mask:0xf\n\t" \
    "v_fmac_f32_dpp %6, %20, %4 row_newbcast:6 row_mask:0xf bank_mask:0xf\n\t" \
    "v_fmac_f32_dpp %7, %20, %4 row_newbcast:7 row_mask:0xf bank_mask:0xf\n\t" \
    "v_fmac_f32_dpp %8, %20, %4 row_newbcast:8 row_mask:0xf bank_mask:0xf\n\t" \
    "v_fmac_f32_dpp %9, %20, %4 row_newbcast:9 row_mask:0xf bank_mask:0xf\n\t" \
    "v_fmac_f32_dpp %10, %20, %4 row_newbcast:10 row_mask:0xf bank_mask:0xf\n\t" \
    "v_fmac_f32_dpp %11, %20, %4 row_newbcast:11 row_mask:0xf bank_mask:0xf\n\t" \
    "v_fmac_f32_dpp %12, %20, %4 row_newbcast:12 row_mask:0xf bank_mask:0xf\n\t" \
    "v_fmac_f32_dpp %13, %20, %4 row_newbcast:13 row_mask:0xf bank_mask:0xf\n\t" \
    "v_fmac_f32_dpp %14, %20, %4 row_newbcast:14 row_mask:0xf bank_mask:0xf\n\t" \
    "v_fmac_f32_dpp %15, %20, %4 row_newbcast:15 row_mask:0xf bank_mask:0xf\n\t" \
    "v_xor_b32 %5, 0x80000000, %5\n\t" \
    "v_fmac_f32_dpp %6, %21, %5 row_newbcast:6 row_mask:0xf bank_mask:0xf\n\t" \
    "v_fmac_f32_dpp %7, %21, %5 row_newbcast:7 row_mask:0xf bank_mask:0xf\n\t" \
    "v_fmac_f32_dpp %8, %21, %5 row_newbcast:8 row_mask:0xf bank_mask:0xf\n\t" \
    "v_fmac_f32_dpp %9, %21, %5 row_newbcast:9 row_mask:0xf bank_mask:0xf\n\t" \
    "v_fmac_f32_dpp %10, %21, %5 row_newbcast:10 row_mask:0xf bank_mask:0xf\n\t" \
    "v_fmac_f32_dpp %11, %21, %5 row_newbcast:11 row_mask:0xf bank_mask:0xf\n\t" \
    "v_fmac_f32_dpp %12, %21, %5 row_newbcast:12 row_mask:0xf bank_mask:0xf\n\t" \
    "v_fmac_f32_dpp %13, %21, %5 row_newbcast:13 row_mask:0xf bank_mask:0xf\n\t" \
    "v_fmac_f32_dpp %14, %21, %5 row_newbcast:14 row_mask:0xf bank_mask:0xf\n\t" \
    "v_fmac_f32_dpp %15, %21, %5 row_newbcast:15 row_mask:0xf bank_mask:0xf\n\t" \
    "v_xor_b32 %6, 0x80000000, %6\n\t" \
    "v_fmac_f32_dpp %7, %22, %6 row_newbcast:7 row_mask:0xf bank_mask:0xf\n\t" \
    "v_fmac_f32_dpp %8, %22, %6 row_newbcast:8 row_mask:0xf bank_mask:0xf\n\t" \
    "v_fmac_f32_dpp %9, %22, %6 row_newbcast:9 row_mask:0xf bank_mask:0xf\n\t" \
    "v_fmac_f32_dpp %10, %22, %6 row_newbcast:10 row_mask:0xf bank_mask:0xf\n\t" \
    "v_fmac_f32_dpp %11, %22, %6 row_newbcast:11 row_mask:0xf bank_mask:0xf\n\t" \
    "v_fmac_f32_dpp %12, %22, %6 row_newbcast:12 row_mask:0xf bank_mask:0xf\n\t" \
    "v_fmac_f32_dpp %13, %22, %6 row_newbcast:13 row_mask:0xf bank_mask:0xf\n\t" \
    "v_fmac_f32_dpp %14, %22, %6 row_newbcast:14 row_mask:0xf bank_mask:0xf\n\t" \
    "v_fmac_f32_dpp %15, %22, %6 row_newbcast:15 row_mask:0xf bank_mask:0xf\n\t" \
    "v_xor_b32 %7, 0x80000000, %7\n\t" \
    "v_fmac_f32_dpp %8, %23, %7 row_newbcast:8 row_mask:0xf bank_mask:0xf\n\t" \
    "v_fmac_f32_dpp %9, %23, %7 row_newbcast:9 row_mask:0xf bank_mask:0xf\n\t" \
    "v_fmac_f32_dpp %10, %23, %7 row_newbcast:10 row_mask:0xf bank_mask:0xf\n\t" \
    "v_fmac_f32_dpp %11, %23, %7 row_newbcast:11 row_mask:0xf bank_mask:0xf\n\t" \
    "v_fmac_f32_dpp %12, %23, %7 row_newbcast:12 row_mask:0xf bank_mask:0xf\n\t" \
    "v_fmac_f32_dpp %13, %23, %7 row_newbcast:13 row_mask:0xf bank_mask:0xf\n\t" \
    "v_fmac_f32_dpp %14, %23, %7 row_newbcast:14 row_mask:0xf bank_mask:0xf\n\t" \
    "v_fmac_f32_dpp %15, %23, %7 row_newbcast:15 row_mask:0xf bank_mask:0xf\n\t" \
    ""
#define TRI2_ASMB \
    "s_nop 1\n\t" \
    "v_xor_b32 %0, 0x80000000, %0\n\t" \
    "v_fmac_f32_dpp %1, %8, %0 row_newbcast:9 row_mask:0xf bank_mask:0xf\n\t" \
    "v_fmac_f32_dpp %2, %8, %0 row_newbcast:10 row_mask:0xf bank_mask:0xf\n\t" \
    "v_fmac_f32_dpp %3, %8, %0 row_newbcast:11 row_mask:0xf bank_mask:0xf\n\t" \
    "v_fmac_f32_dpp %4, %8, %0 row_newbcast:12 row_mask:0xf bank_mask:0xf\n\t" \
    "v_fmac_f32_dpp %5, %8, %0 row_newbcast:13 row_mask:0xf bank_mask:0xf\n\t" \
    "v_fmac_f32_dpp %6, %8, %0 row_newbcast:14 row_mask:0xf bank_mask:0xf\n\t" \
    "v_fmac_f32_dpp %7, %8, %0 row_newbcast:15 row_mask:0xf bank_mask:0xf\n\t" \
    "v_xor_b32 %1, 0x80000000, %1\n\t" \
    "v_fmac_f32_dpp %2, %9, %1 row_newbcast:10 row_mask:0xf bank_mask:0xf\n\t" \
    "v_fmac_f32_dpp %3, %9, %1 row_newbcast:11 row_mask:0xf bank_mask:0xf\n\t" \
    "v_fmac_f32_dpp %4, %9, %1 row_newbcast:12 row_mask:0xf bank_mask:0xf\n\t" \
    "v_fmac_f32_dpp %5, %9, %1 row_newbcast:13 row_mask:0xf bank_mask:0xf\n\t" \
    "v_fmac_f32_dpp %6, %9, %1 row_newbcast:14 row_mask:0xf bank_mask:0xf\n\t" \
    "v_fmac_f32_dpp %7, %9, %1 row_newbcast:15 row_mask:0xf bank_mask:0xf\n\t" \
    "v_xor_b32 %2, 0x80000000, %2\n\t" \
    "v_fmac_f32_dpp %3, %10, %2 row_newbcast:11 row_mask:0xf bank_mask:0xf\n\t" \
    "v_fmac_f32_dpp %4, %10, %2 row_newbcast:12 row_mask:0xf bank_mask:0xf\n\t" \
    "v_fmac_f32_dpp %5, %10, %2 row_newbcast:13 row_mask:0xf bank_mask:0xf\n\t" \
    "v_fmac_f32_dpp %6, %10, %2 row_newbcast:14 row_mask:0xf bank_mask:0xf\n\t" \
    "v_fmac_f32_dpp %7, %10, %2 row_newbcast:15 row_mask:0xf bank_mask:0xf\n\t" \
    "v_xor_b32 %3, 0x80000000, %3\n\t" \
    "v_fmac_f32_dpp %4, %11, %3 row_newbcast:12 row_mask:0xf bank_mask:0xf\n\t" \
    "v_fmac_f32_dpp %5, %11, %3 row_newbcast:13 row_mask:0xf bank_mask:0xf\n\t" \
    "v_fmac_f32_dpp %6, %11, %3 row_newbcast:14 row_mask:0xf bank_mask:0xf\n\t" \
    "v_fmac_f32_dpp %7, %11, %3 row_newbcast:15 row_mask:0xf bank_mask:0xf\n\t" \
    "v_xor_b32 %4, 0x80000000, %4\n\t" \
    "v_fmac_f32_dpp %5, %12, %4 row_newbcast:13 row_mask:0xf bank_mask:0xf\n\t" \
    "v_fmac_f32_dpp %6, %12, %4 row_newbcast:14 row_mask:0xf bank_mask:0xf\n\t" \
    "v_fmac_f32_dpp %7, %12, %4 row_newbcast:15 row_mask:0xf bank_mask:0xf\n\t" \
    "v_xor_b32 %5, 0x80000000, %5\n\t" \
    "v_fmac_f32_dpp %6, %13, %5 row_newbcast:14 row_mask:0xf bank_mask:0xf\n\t" \
    "v_fmac_f32_dpp %7, %13, %5 row_newbcast:15 row_mask:0xf bank_mask:0xf\n\t" \
    "v_xor_b32 %6, 0x80000000, %6\n\t" \
    "v_fmac_f32_dpp %7, %14, %6 row_newbcast:15 row_mask:0xf bank_mask:0xf\n\t" \
    "v_xor_b32 %7, 0x80000000, %7\n\t" \
    ""

constexpr int S3_RS = 144;
constexpr int S3_KKT = 0, S3_RRT = 2304, S3_BHT = 4608, S3_KHT = 6912, S3_BHJ = 9216, S3_KHJ = 11264, S3_WLF = 13312, S3_IMG = 13568;
constexpr int S3_PRIV = 4 * S3_IMG, S3_MBF = 0, S3_RHF = 1024, S3_PSTRIDE = 2048;
__device__ __forceinline__ void phase_rwkv_scan3(const Params& p, int j, char* lds_, bf16_t* Y) {
    const bf16_t* R = (const bf16_t*)(p.ws + OFF_R); const bf16_t* Kb = (const bf16_t*)(p.ws + OFF_K);
    const bf16_t* V = (const bf16_t*)(p.ws + OFF_VF); const bf16_t* KK = (const bf16_t*)(p.ws + OFF_H);
    const bf16_t* LW = (const bf16_t*)(p.ws + OFF_LW); const bf16_t* AD = (const bf16_t*)(p.ws + OFF_AD);
    const int tid = tidx(), lane = tid & 63, wid = __builtin_amdgcn_readfirstlane(tid >> 6), cl = wid >> 2, q = wid & 3, g = lane >> 4, li = lane & 15;
    LAS unsigned char* img0 = (LAS unsigned char*)lds_ + cl * 2 * S3_IMG;
    LAS unsigned char* pw = (LAS unsigned char*)lds_ + S3_PRIV + wid * S3_PSTRIDE;
    f32x4 msk_lt, msk_le, msk_gt;
#pragma unroll
    for (int r = 0; r < 4; ++r) { msk_lt[r] = (4 * g + r) < li ? 1.f : 0.f; msk_le[r] = (4 * g + r) <= li ? 1.f : 0.f; msk_gt[r] = (4 * g + r) > li ? 1.f : 0.f; }
    for (int cp = blockIdx.x; cp < 256; cp += gridDim.x) {
        const int chain = cp * 2 + cl, d = chain & 1, bh = chain >> 1, b = bh >> 4, h = bh & 15;
        const int vcol = h * 64 + q * 16 + li, vcolw = vcol & ~1, jcol = q * 16 + li;
        const unsigned selv = (vcol & 1) ? 0x03020c0cu : 0x01000c0cu;
        const unsigned selp = (vcol & 1) ? 0x07060302u : 0x05040100u;
        const float ka = p.in[22][(size_t)j * D + vcol];
        const bf16_t* ADd = AD + (size_t)d * NT * D;
        const bf16_t* w2t = wsm(p, j, WJ_W2) + (size_t)d * D * 64 + (size_t)vcol * 64;
        const bf16x8 Bw0 = *(const bf16x8*)(w2t + g * 8), Bw1 = *(const bf16x8*)(w2t + 32 + g * 8);
        const float w0b = p.in[10][((size_t)j * 2 + d) * D + vcol] * -1.44269504089f;
        const bf16_t* LD0 = (const bf16_t*)(p.ws + OFF_LD);
        const unsigned voa = (unsigned)((d ? 15 - li : li) * 256 + (d * 64 + g * 8) * 2);
        bf16_t* Yd = Y + (size_t)d * NT * D;
        const int dir = d ? -1 : 1;
        auto row_first = [&](int c) -> int {
            const int s0 = c * 16;
            if (s0 < TC) return NLAT + b * TC + (d ? (TC - 1 - s0) : s0);
            const int tl = s0 - TC; return b * TL + (d ? (TL - 1 - tl) : tl);
        };
#define UNPV(w) __uint_as_float(__builtin_amdgcn_perm(0u, (w), selv))
        const unsigned LA0 = ((4 * g <= li) ? 0x3F80u : 0u) | ((4 * g + 1 <= li) ? 0x3F800000u : 0u), LA1 = ((4 * g + 2 <= li) ? 0x3F80u : 0u) | ((4 * g + 3 <= li) ? 0x3F800000u : 0u);
        unsigned vov[4];
#pragma unroll
        for (int e = 0; e < 4; ++e) vov[e] = (unsigned)((d ? 15 - (4 * g + e) : 4 * g + e) * (D * 2) + vcolw * 2);
#define LDG(P, VO) (*(const unsigned*)((P) + (VO)))
        unsigned rr[4], rkk[4], rk[4], ra[4], rv[4]; bf16x8 rwa0, rwa1;
        auto issue_loads = [&](int c) {
            const int r0 = row_first(c);
            const size_t rbo = (size_t)(d ? r0 - 15 : r0) * (D * 2);
            const char* bLD = (const char*)LD0 + (size_t)(d ? r0 - 15 : r0) * 256; const char* bR = (const char*)R + rbo; const char* bKK = (const char*)KK + rbo;
            const char* bK = (const char*)Kb + rbo; const char* bA = (const char*)ADd + rbo; const char* bV = (const char*)V + rbo;
#pragma unroll
            for (int e = 0; e < 4; ++e) { rr[e] = LDG(bR, vov[e]); rkk[e] = LDG(bKK, vov[e]); rk[e] = LDG(bK, vov[e]); ra[e] = LDG(bA, vov[e]); rv[e] = LDG(bV, vov[e]); }
            rwa0 = *(const bf16x8*)(bLD + voa); rwa1 = *(const bf16x8*)(bLD + voa + 64);
        };
        issue_loads(0);
        f32x4 T[4];
#pragma unroll
        for (int jb = 0; jb < 4; ++jb) T[jb] = (f32x4){0.f, 0.f, 0.f, 0.f};
        auto do_prep = [&](int cc, unsigned& w0, unsigned& w1) {
            LAS unsigned char* im = img0 + (cc & 1) * S3_IMG;
            {
                const f32x4 Z4p = {0.f, 0.f, 0.f, 0.f};
                f32x4 WP = __builtin_amdgcn_mfma_f32_16x16x32_bf16(rwa0, Bw0, Z4p, 0, 0, 0);
                WP = __builtin_amdgcn_mfma_f32_16x16x32_bf16(rwa1, Bw1, WP, 0, 0, 0);
                unsigned lwp0, lwp1;
                {
                    const f32x2_t x0 = {WP[0], WP[1]}, x1 = {WP[2], WP[3]};
                    const f32x2_t t0 = x0 * -1.44269504089f + w0b, t1 = x1 * -1.44269504089f + w0b;
                    f32x2_t e0, e1; e0.x = __builtin_amdgcn_exp2f(t0.x); e0.y = __builtin_amdgcn_exp2f(t0.y); e1.x = __builtin_amdgcn_exp2f(t1.x); e1.y = __builtin_amdgcn_exp2f(t1.y);
                    const f32x2_t d0 = e0 + 1.0f, d1 = e1 + 1.0f;
                    lwp0 = pack2(-0.6065306597f * __builtin_amdgcn_rcpf(d0.x), -0.6065306597f * __builtin_amdgcn_rcpf(d0.y));
                    lwp1 = pack2(-0.6065306597f * __builtin_amdgcn_rcpf(d1.x), -0.6065306597f * __builtin_amdgcn_rcpf(d1.y));
                }
                const f32x4 CW = __builtin_amdgcn_mfma_f32_16x16x16bf16_1k(mk4(LA0, LA1), mk4(lwp0, lwp1), Z4p, 0, 0, 0);
                float ep_prev = __expf(CW[0] - bflo(lwp0));
                float bhv[4], khv[4];
#pragma unroll
                for (int e = 0; e < 4; ++e) {
                    const int t = 4 * g + e;
                    const float rvv = UNPV(rr[e]), kkv = UNPV(rkk[e]), kv = UNPV(rk[e]), av = UNPV(ra[e]);
                    const float ep = __expf(CW[e]), em = __expf(-CW[e]);
                    const float kkt = kkv * ep_prev, rt = rvv * ep;
                    bhv[e] = kkv * av * em; khv[e] = kv * (1.f + (av - 1.f) * ka) * em;
                    ep_prev = ep;
                    *(LAS bf16_t*)(im + S3_KKT + t * S3_RS + jcol * 2) = (bf16_t)(pack2(kkt, 0.f) & 0xffffu);
                    *(LAS bf16_t*)(im + S3_RRT + t * S3_RS + jcol * 2) = (bf16_t)(pack2(rt, 0.f) & 0xffffu);
                    *(LAS bf16_t*)(im + S3_BHT + t * S3_RS + jcol * 2) = (bf16_t)(pack2(bhv[e], 0.f) & 0xffffu);
                    *(LAS bf16_t*)(im + S3_KHT + t * S3_RS + jcol * 2) = (bf16_t)(pack2(khv[e], 0.f) & 0xffffu);
                }
                *(LAS u32x2*)(im + S3_BHJ + jcol * 32 + g * 8) = (u32x2){pack2(bhv[0], bhv[1]), pack2(bhv[2], bhv[3])};
                *(LAS u32x2*)(im + S3_KHJ + jcol * 32 + g * 8) = (u32x2){pack2(khv[0], khv[1]), pack2(khv[2], khv[3])};
                if (g == 3) *(LAS float*)(im + S3_WLF + jcol * 4) = ep_prev;
                w0 = __builtin_amdgcn_perm(rv[1], rv[0], selp); w1 = __builtin_amdgcn_perm(rv[3], rv[2], selp);
            }
        };
        constexpr int NCH = (TC + TL) / 16;
        unsigned vw0, vw1, vwn0 = 0u, vwn1 = 0u;
        do_prep(0, vw0, vw1);
        issue_loads(1);
        for (int c = 0; c < NCH; ++c) {
            const int row0 = row_first(c);
            LAS unsigned char* im = img0 + (c & 1) * S3_IMG;
            asm volatile("s_waitcnt lgkmcnt(0)" ::: "memory");
            __builtin_amdgcn_s_barrier();
            asm volatile("" ::: "memory");
            if (c + 1 < NCH) { do_prep(c + 1, vwn0, vwn1); if (c + 2 < NCH) issue_loads(c + 2); }
            f32x4 Mb = {0.f, 0.f, 0.f, 0.f}, Mk = Mb, Nb = Mb, Nk = Mb, MbT = Mb;
#pragma unroll
            for (int kk = 0; kk < 2; ++kk) {
                const int ko = li * S3_RS + (32 * kk + 8 * g) * 2;
                const bf16x8 aB = *(const LAS bf16x8*)(im + S3_BHT + ko), aK = *(const LAS bf16x8*)(im + S3_KHT + ko);
                const bf16x8 bK = *(const LAS bf16x8*)(im + S3_KKT + ko), bR = *(const LAS bf16x8*)(im + S3_RRT + ko);
                Mb = __builtin_amdgcn_mfma_f32_16x16x32_bf16(aB, bK, Mb, 0, 0, 0);
                MbT = __builtin_amdgcn_mfma_f32_16x16x32_bf16(bK, aB, MbT, 0, 0, 0);
                Mk = __builtin_amdgcn_mfma_f32_16x16x32_bf16(aK, bK, Mk, 0, 0, 0);
                Nb = __builtin_amdgcn_mfma_f32_16x16x32_bf16(aB, bR, Nb, 0, 0, 0);
                Nk = __builtin_amdgcn_mfma_f32_16x16x32_bf16(aK, bR, Nk, 0, 0, 0);
            }
            Mb = Mb * msk_lt; Mk = Mk * msk_lt; Nb = Nb * msk_le; Nk = Nk * msk_le; MbT = MbT * msk_gt;
            f32x4 PT = {0.f, 0.f, 0.f, 0.f}, QT = PT;
#pragma unroll
            for (int kk = 0; kk < 2; ++kk) {
                const bf16x8 bw = mk8(pack2(T[2 * kk][0], T[2 * kk][1]), pack2(T[2 * kk][2], T[2 * kk][3]), pack2(T[2 * kk + 1][0], T[2 * kk + 1][1]), pack2(T[2 * kk + 1][2], T[2 * kk + 1][3]));
                const int ko = li * S3_RS + (32 * kk + 4 * g) * 2;
                const u32x2 k0 = *(const LAS u32x2*)(im + S3_KKT + ko), k1 = *(const LAS u32x2*)(im + S3_KKT + ko + 32);
                const u32x2 r0 = *(const LAS u32x2*)(im + S3_RRT + ko), r1 = *(const LAS u32x2*)(im + S3_RRT + ko + 32);
                PT = __builtin_amdgcn_mfma_f32_16x16x32_bf16(mk8(k0[0], k0[1], k1[0], k1[1]), bw, PT, 0, 0, 0);
                QT = __builtin_amdgcn_mfma_f32_16x16x32_bf16(mk8(r0[0], r0[1], r1[0], r1[1]), bw, QT, 0, 0, 0);
            }
            const f32x4 RT = __builtin_amdgcn_mfma_f32_16x16x16bf16_1k(mk4(pack2(Mk[0], Mk[1]), pack2(Mk[2], Mk[3])), mk4(vw0, vw1), PT, 0, 0, 0);
#define CW(Y) pack2((Y)[0], (Y)[1]), pack2((Y)[2], (Y)[3])
#define OPND(w0, w1) mk4((w0), (w1))
            const f32x4 Z4 = {0.f, 0.f, 0.f, 0.f};
            const unsigned mb0 = pack2(Mb[0], Mb[1]), mb1 = pack2(Mb[2], Mb[3]), mt0 = pack2(MbT[0], MbT[1]), mt1 = pack2(MbT[2], MbT[3]);
            const f32x4 P1 = __builtin_amdgcn_mfma_f32_16x16x16bf16_1k(OPND(mt0, mt1), OPND(mb0, mb1), Z4, 0, 0, 0);
            const f32x4 P1T = __builtin_amdgcn_mfma_f32_16x16x16bf16_1k(OPND(mb0, mb1), OPND(mt0, mt1), Z4, 0, 0, 0);
            const unsigned p10 = pack2(P1[0], P1[1]), p11 = pack2(P1[2], P1[3]), q10 = pack2(P1T[0], P1T[1]), q11 = pack2(P1T[2], P1T[3]);
            const f32x4 P2 = __builtin_amdgcn_mfma_f32_16x16x16bf16_1k(OPND(q10, q11), OPND(p10, p11), Z4, 0, 0, 0);
            const f32x4 P2T = __builtin_amdgcn_mfma_f32_16x16x16bf16_1k(OPND(p10, p11), OPND(q10, q11), Z4, 0, 0, 0);
            const unsigned p20 = pack2(P2[0], P2[1]), p21 = pack2(P2[2], P2[3]), q20 = pack2(P2T[0], P2T[1]), q21 = pack2(P2T[2], P2T[3]);
            const f32x4 P3 = __builtin_amdgcn_mfma_f32_16x16x16bf16_1k(OPND(q20, q21), OPND(p20, p21), Z4, 0, 0, 0);
            const unsigned p30 = pack2(P3[0], P3[1]), p31 = pack2(P3[2], P3[3]);
            f32x4 Yv = __builtin_amdgcn_mfma_f32_16x16x16bf16_1k(OPND(mb0 ^ 0x80008000u, mb1 ^ 0x80008000u), OPND(pack2(RT[0], RT[1]), pack2(RT[2], RT[3])), RT, 0, 0, 0);
            Yv = __builtin_amdgcn_mfma_f32_16x16x16bf16_1k(OPND(p10, p11), OPND(pack2(Yv[0], Yv[1]), pack2(Yv[2], Yv[3])), Yv, 0, 0, 0);
            Yv = __builtin_amdgcn_mfma_f32_16x16x16bf16_1k(OPND(p20, p21), OPND(pack2(Yv[0], Yv[1]), pack2(Yv[2], Yv[3])), Yv, 0, 0, 0);
            Yv = __builtin_amdgcn_mfma_f32_16x16x16bf16_1k(OPND(p30, p31), OPND(pack2(Yv[0], Yv[1]), pack2(Yv[2], Yv[3])), Yv, 0, 0, 0);
#undef CW
#undef OPND
            const bf16x8 bop = mk8(pack2(Yv[0], Yv[1]) ^ 0x80008000u, pack2(Yv[2], Yv[3]) ^ 0x80008000u, vw0, vw1);
            const f32x4 YT = __builtin_amdgcn_mfma_f32_16x16x32_bf16(mk8(pack2(Nb[0], Nb[1]), pack2(Nb[2], Nb[3]), pack2(Nk[0], Nk[1]), pack2(Nk[2], Nk[3])), bop, QT, 0, 0, 0);
#pragma unroll
            for (int r = 0; r < 4; ++r) Yd[(size_t)(row0 + (4 * g + r) * dir) * D + vcol] = (bf16_t)(pack2(YT[r], 0.f) & 0xffffu);
#pragma unroll
            for (int jb = 0; jb < 4; ++jb) {
                const u32x2 b2 = *(const LAS u32x2*)(im + S3_BHJ + (16 * jb + li) * 32 + g * 8), k2 = *(const LAS u32x2*)(im + S3_KHJ + (16 * jb + li) * 32 + g * 8);
                T[jb] = __builtin_amdgcn_mfma_f32_16x16x32_bf16(mk8(b2[0], b2[1], k2[0], k2[1]), bop, T[jb], 0, 0, 0);
                const f32x4 wv = *(const LAS f32x4*)(im + S3_WLF + (16 * jb + 4 * g) * 4);
                T[jb] = T[jb] * wv;
            }
            vw0 = vwn0; vw1 = vwn1;
        }
#undef LDG
#undef UNPV
        asm volatile("s_waitcnt lgkmcnt(0)" ::: "memory");
        __builtin_amdgcn_s_barrier();
    }
}

#ifndef SCAN2_MODE
#define SCAN2_MODE 3
#endif
constexpr size_t OFF_Y2DBG = OFF_BIG + 13 * U + U / 2;
__device__ __forceinline__ void phase_scan_compare(const Params& p) {
    const bf16_t* Y = (const bf16_t*)(p.ws + OFF_Y); const bf16_t* Y2 = (const bf16_t*)(p.ws + OFF_Y2DBG);
    float* accp = (float*)(p.ws + OFF_BAR + 16384);
    float e2 = 0.f, y2 = 0.f;
    for (size_t i = (size_t)blockIdx.x * NTHREADS + tidx(); i < (size_t)NT * D / 2; i += (size_t)gridDim.x * NTHREADS) {
        const unsigned a = ((const unsigned*)Y)[i], b = ((const unsigned*)Y2)[i];
        const float a0 = bflo(a), a1 = bfhi(a), b0 = bflo(b), b1 = bfhi(b);
        e2 += (a0 - b0) * (a0 - b0) + (a1 - b1) * (a1 - b1); y2 += a0 * a0 + a1 * a1;
    }
    e2 = wave_sum(e2); y2 = wave_sum(y2);
    if ((tidx() & 63) == 0) { atomicAdd(accp, e2); atomicAdd(accp + 1, y2); }
}

__device__ __forceinline__ void phase_rwkv_out(const Params& p, int j) {
    const bf16_t* Y = (const bf16_t*)(p.ws + OFF_Y); const bf16_t* V = (const bf16_t*)(p.ws + OFF_VF); const bf16_t* G = (const bf16_t*)(p.ws + OFF_G);
    const float* BON = (const float*)(p.ws + OFF_BON);
    bf16_t* YO = (bf16_t*)(p.ws + OFF_LW);
    const float* lnw = p.in[24] + (size_t)j * D; const float* lnb = p.in[25] + (size_t)j * D;
    const int tid_ = tidx(), lane = tid_ & 63, wid = tid_ >> 6, c0 = lane * 16;
    float lw[16], lb[16];
#pragma unroll
    for (int i = 0; i < 16; ++i) { lw[i] = lnw[c0 + i]; lb[i] = lnb[c0 + i]; }
    constexpr int RW = 2;
    for (int grp = blockIdx.x * 8 + wid; grp < NT / RW; grp += gridDim.x * 8) {
        u32x4 y0[RW][2], y1[RW][2], vv[RW][2], gg[RW][2]; float bon[RW];
#pragma unroll
        for (int r = 0; r < RW; ++r) {
            const size_t o = (size_t)(grp * RW + r) * D + c0;
#pragma unroll
            for (int i = 0; i < 2; ++i) {
                y0[r][i] = *(const u32x4*)(Y + o + i * 8); y1[r][i] = *(const u32x4*)(Y + (size_t)NT * D + o + i * 8);
                vv[r][i] = *(const u32x4*)(V + o + i * 8); gg[r][i] = *(const u32x4*)(G + o + i * 8);
            }
            bon[r] = BON[(size_t)(grp * RW + r) * 16 + (lane >> 2)];
        }
#pragma unroll
        for (int r = 0; r < RW; ++r) {
            const size_t o = (size_t)(grp * RW + r) * D + c0;
            float ov[16]; float s1 = 0.f;
#pragma unroll
            for (int i = 0; i < 16; ++i) {
                const unsigned w0 = y0[r][i >> 3][(i >> 1) & 3], w1 = y1[r][i >> 3][(i >> 1) & 3];
                ov[i] = ((i & 1) ? bfhi(w0) : bflo(w0)) + ((i & 1) ? bfhi(w1) : bflo(w1));
                s1 += ov[i];
            }
            s1 += __shfl_xor(s1, 1, 64); s1 += __shfl_xor(s1, 2, 64);
            const float mu = s1 * (1.f / 64.f);
            float s2 = 0.f;
#pragma unroll
            for (int i = 0; i < 16; ++i) { const float dd = ov[i] - mu; s2 += dd * dd; }
            s2 += __shfl_xor(s2, 1, 64); s2 += __shfl_xor(s2, 2, 64);
            const float rs = rsqrtf(s2 * (1.f / 64.f) + 64e-5f);
            float res[16];
#pragma unroll
            for (int i = 0; i < 16; ++i) {
                const unsigned vw = vv[r][i >> 3][(i >> 1) & 3], gw = gg[r][i >> 3][(i >> 1) & 3];
                const float v = (i & 1) ? bfhi(vw) : bflo(vw), g = (i & 1) ? bfhi(gw) : bflo(gw);
                res[i] = ((ov[i] - mu) * rs * lw[i] + lb[i] + bon[r] * v) * g;
            }
            u32x4 w[2];
#pragma unroll
            for (int i = 0; i < 8; ++i) w[i >> 2][i & 3] = pack2(res[2 * i], res[2 * i + 1]);
            *(u32x4*)(YO + o) = w[0]; *(u32x4*)(YO + o + 8) = w[1];
        }
    }
}

__device__ __forceinline__ void phase_rwkv_out2(const Params& p, int j, char* lds) {
    const bf16_t* A = (const bf16_t*)(p.ws + OFF_LD) + (size_t)2 * NT * 128;
    const bf16_t* Bt = wsm(p, j, WJ_G2);
    const bf16_t* Y = (const bf16_t*)(p.ws + OFF_Y); const bf16_t* V = (const bf16_t*)(p.ws + OFF_VF);
    const float* BON = (const float*)(p.ws + OFF_BON); const float* BON2 = (const float*)(p.ws + OFF_BON2);
    bf16_t* YO = (bf16_t*)(p.ws + OFF_LW);
    const float* lnw = p.in[24] + (size_t)j * D; const float* lnb = p.in[25] + (size_t)j * D;
    float* lwl = (float*)lds;
    constexpr int TR = 64, RT = NT / TR, NRC = 64, RPC = RT / NRC, KS = 4;
    const int tid = tidx(), lane = tid & 63, wid = tid >> 6, wr = wid >> 2, wc = wid & 3, fr = lane & 15, fq = lane >> 4;
    for (int u = blockIdx.x; u < 4 * NRC; u += gridDim.x) {
        const int ct = u / NRC, rc = u % NRC, rt0 = rc * RPC, rt1 = rt0 + RPC, col0 = ct * 256, head = ct * 4 + wc;
        __syncthreads();
        lwl[tid] = tid < 256 ? lnw[col0 + tid] : lnb[col0 + tid - 256];
        {
            char* bsl = lds + 4096;
            int t2 = tid; asm volatile("" : "+v"(t2));
#pragma unroll
            for (int q = 0; q < 8; ++q) {
                const int idx = q * 512 + t2, rowi = idx >> 4, seg = idx & 15;
                *(u32x4*)(bsl + rowi * 272 + seg * 16) = *(const u32x4*)(Bt + (size_t)(col0 + rowi) * 128 + seg * 8);
            }
        }
        __syncthreads();
        int boff[4];
#pragma unroll
        for (int n = 0; n < 4; ++n) boff[n] = 4096 + (wc * 64 + (n >> 1) * 32 + 8 * (fr >> 2) + 4 * (n & 1) + (fr & 3)) * 272 + fq * 16;
        bf16x8 afr[2][KS];
#pragma unroll
        for (int m = 0; m < 2; ++m)
#pragma unroll
            for (int ks = 0; ks < KS; ++ks) afr[m][ks] = *(const bf16x8*)(A + (size_t)(rt0 * TR + wr * 32 + m * 16 + fr) * 128 + ks * 32 + fq * 8);
        u32x4 ey0[2][2], ey1[2][2], evv[2][2]; float ebon[2];
#define OUT2_LOAD(SET, RT_, M_) do { const int row_ = (RT_) * TR + wr * 32 + (M_) * 16 + fr; const size_t o_ = (size_t)row_ * D + col0 + wc * 64 + 8 * fq; \
            _Pragma("unroll") for (int pp = 0; pp < 2; ++pp) { ey0[SET][pp] = *(const u32x4*)(Y + o_ + pp * 32); ey1[SET][pp] = *(const u32x4*)(Y + (size_t)NT * D + o_ + pp * 32); evv[SET][pp] = *(const u32x4*)(V + o_ + pp * 32); } \
            ebon[SET] = BON[(size_t)row_ * 16 + head]; } while (0)
        OUT2_LOAD(0, rt0, 0);
#pragma unroll 1
        for (int rt = rt0; rt < rt1; ++rt) {
            int zz = 0; asm volatile("" : "+v"(zz));
            f32x4 acc[2][4];
#pragma unroll
            for (int m = 0; m < 2; ++m)
#pragma unroll
                for (int n = 0; n < 4; ++n) {
                    acc[m][n] = (f32x4){0.f, 0.f, 0.f, 0.f};
#pragma unroll
                    for (int ks = 0; ks < KS; ++ks) acc[m][n] = __builtin_amdgcn_mfma_f32_16x16x32_bf16(*(const bf16x8*)(lds + boff[n] + zz + ks * 64), afr[m][ks], acc[m][n], 0, 0, 0);
                }
            if (rt + 1 < rt1) {
#pragma unroll
                for (int m = 0; m < 2; ++m)
#pragma unroll
                    for (int ks = 0; ks < KS; ++ks) afr[m][ks] = *(const bf16x8*)(A + (size_t)((rt + 1) * TR + wr * 32 + m * 16 + fr) * 128 + ks * 32 + fq * 8);
            }
#pragma unroll
            for (int m = 0; m < 2; ++m) {
                if (m == 0) OUT2_LOAD(1, rt, 1);
                else if (rt + 1 < rt1) OUT2_LOAD(0, rt + 1, 0);
                const int row = rt * TR + wr * 32 + m * 16 + fr;
                const size_t o = (size_t)row * D + col0 + wc * 64 + 8 * fq;
                const float bon = ebon[m];
                float ov[16]; float s1 = 0.f;
#pragma unroll
                for (int i = 0; i < 16; ++i) {
                    const unsigned w0 = ey0[m][i >> 3][(i >> 1) & 3], w1 = ey1[m][i >> 3][(i >> 1) & 3];
                    ov[i] = ((i & 1) ? bfhi(w0) : bflo(w0)) + ((i & 1) ? bfhi(w1) : bflo(w1));
                    s1 += ov[i];
                }
                const float mu = red4(s1) * (1.f / 64.f);
                float s2 = 0.f;
#pragma unroll
                for (int i = 0; i < 16; ++i) { const float dd = ov[i] - mu; s2 += dd * dd; }
                const float rs = rsqrtf(red4(s2) * (1.f / 64.f) + 64e-5f);
#pragma unroll
                for (int pp = 0; pp < 2; ++pp) {
                    const float* lp = lwl + wc * 64 + pp * 32 + 8 * fq;
                    const float4 w0 = *(const float4*)lp, w1 = *(const float4*)(lp + 4), b0 = *(const float4*)(lp + 256), b1 = *(const float4*)(lp + 260);
                    const float lw[8] = {w0.x, w0.y, w0.z, w0.w, w1.x, w1.y, w1.z, w1.w}, lb[8] = {b0.x, b0.y, b0.z, b0.w, b1.x, b1.y, b1.z, b1.w};
                    float res[8];
#pragma unroll
                    for (int e = 0; e < 8; ++e) {
                        const unsigned vw = evv[m][pp][e >> 1];
                        const float v = (e & 1) ? bfhi(vw) : bflo(vw);
                        const float g = acc[m][2 * pp + (e >> 2)][e & 3];
                        res[e] = ((ov[pp * 8 + e] - mu) * rs * lw[e] + lb[e] + bon * v) * g;
                    }
                    const u32x4 w = {pack2(res[0], res[1]), pack2(res[2], res[3]), pack2(res[4], res[5]), pack2(res[6], res[7])};
                    *(u32x4*)(YO + o + pp * 32) = w;
                }
            }
        }
#undef OUT2_LOAD
    }
}

__device__ __forceinline__ void phase_rwkv_wo(const Params& p, int l, int j, char* lds) {
    EpD1 ep{(bf16_t*)(p.ws + OFF_D1), nullptr};
    SchedGrid S{p.ws + OFF_LW, (const char*)wsm(p, j, WJ_WO), 0, 0, (size_t)256 * D * 2, 0, (size_t)256 * D * 2, NT / 256 / 8, (NT / 256) * 4};
    g256::gemm_phase<true>((LAS unsigned char*)lds, D, D, D, S, ep);
}

__device__ __forceinline__ void phase_pool_dlt(const Params& p, int nrows) {
    const bf16_t* H = (const bf16_t*)(p.ws + OFF_H); bf16_t* DL = (bf16_t*)(p.ws + OFF_DLT);
    const int tid_ = tidx(), lane = tid_ & 63, wid = tid_ >> 6;
    for (int row = blockIdx.x * 8 + wid; row < nrows; row += gridDim.x * 8) {
        int t, T, base;
        if (row < NLAT) { t = row & (TL - 1); T = TL; base = row - t; } else { t = (row - NLAT) & (TC - 1); T = TC; base = row - t; }
#define DLT_GROUP(G) { \
            constexpr int half = 1 << (G), win = 2 << (G); \
            const int c = (G) * 256 + lane * 4; \
            u32x2 w[win]; \
            _Pragma("unroll") for (int i = 0; i < win; ++i) { const int tt = t - half + i; const int tc = (tt >= 0 && tt < T) ? tt : t; w[i] = *(const u32x2*)(H + (size_t)(base + tc) * D + c); } \
            float s0 = 0.f, s1 = 0.f, s2 = 0.f, s3 = 0.f; \
            _Pragma("unroll") for (int i = 0; i < win; ++i) { const int tt = t - half + i; const float m = (tt >= 0 && tt < T) ? 1.f : 0.f; \
                s0 += m * bflo(w[i][0]); s1 += m * bfhi(w[i][0]); s2 += m * bflo(w[i][1]); s3 += m * bfhi(w[i][1]); } \
            const int lo = max(t - half, 0), hi = min(t + half, T); \
            const float inv = 1.f / (float)(hi - lo); \
            const u32x2 hw = w[half]; \
            u32x2 o; o[0] = pack2(s0 * inv - bflo(hw[0]), s1 * inv - bfhi(hw[0])); o[1] = pack2(s2 * inv - bflo(hw[1]), s3 * inv - bfhi(hw[1])); \
            *(u32x2*)(DL + (size_t)row * D + c) = o; }
        DLT_GROUP(0) DLT_GROUP(1) DLT_GROUP(2) DLT_GROUP(3)
#undef DLT_GROUP
    }
}
__device__ __forceinline__ void phase_pool_gemm(const Params& p, int l, int j, int nrows, char* lds) {
    EpD1 ep{(bf16_t*)(p.ws + OFF_D1), p.in[28] + (size_t)j * D};
    SchedGrid S{p.ws + OFF_DLT, (const char*)wsm(p, j, WJ_POOL), 0, 0, (size_t)256 * D * 2, (size_t)256 * 2, (size_t)256 * 256 * 2, nrows / 256 / 8, (nrows / 256) * 4};
    g256::gemm_phase<true>((LAS unsigned char*)lds, D, 256, 256, S, ep);
}

__device__ __forceinline__ void phase_topk(const Params& p, bool with_ctx, char* lds) {
    const float* AFF = (const float*)(p.ws + OFF_AFF);
    const bf16_t* H = (const bf16_t*)(p.ws + OFF_H); bf16_t* XG = (bf16_t*)(p.ws + OFF_XG);
    float* GTV = (float*)(p.ws + OFF_GTV); short* SLT = (short*)(p.ws + OFF_SLT);
    unsigned* keys = (unsigned*)lds;
    unsigned* hist = keys + 4096;
    unsigned* wtot = hist + 256;
    unsigned* bc = wtot + 8;
    int* sel = (int*)(bc + 4);
    const int tid = tidx(), lane = tid & 63, wid = tid >> 6;
    const int nunits = with_ctx ? 512 : 256;
    for (int u = blockIdx.x; u < nunits; u += gridDim.x) {
        const bool lat = u < 256;
        const int uu = lat ? u : u - 256, b = uu >> 4, e = uu & 15;
        const int n = lat ? TL : TC, kq = lat ? CAPL : CAPC, per = lat ? 8 : 1;
        const int rowbase = lat ? b * TL : NLAT + b * TC;
        for (int i = tid; i < n; i += NTHREADS) keys[i] = __float_as_uint(AFF[(size_t)(rowbase + i) * 16 + e]);
        __syncthreads();
        unsigned prefix = 0u, mask = 0u; int kth = kq;
        for (int ps = 0; ps < 4; ++ps) {
            const int shift = 24 - 8 * ps;
            if (tid < 256) hist[tid] = 0u;
            __syncthreads();
            for (int i = tid; i < n; i += NTHREADS) { const unsigned k = keys[i]; if ((k & mask) == prefix) atomicAdd(&hist[(k >> shift) & 255u], 1u); }
            __syncthreads();
            if (wid == 0) {
                const int b0 = 255 - 4 * lane;
                const unsigned h0 = hist[b0], h1 = hist[b0 - 1], h2 = hist[b0 - 2], h3 = hist[b0 - 3];
                unsigned inc = h0 + h1 + h2 + h3;
#pragma unroll
                for (int d = 1; d < 64; d <<= 1) { const unsigned o = (unsigned)__builtin_amdgcn_ds_bpermute(((lane - d) & 63) << 2, (int)inc); if (lane >= d) inc += o; }
                const unsigned exc = inc - (h0 + h1 + h2 + h3);
                if (exc < (unsigned)kth && inc >= (unsigned)kth) {
                    unsigned cum = exc; int dg = b0; unsigned rem = 0;
                    if (cum + h0 >= (unsigned)kth) { dg = b0; rem = kth - cum; }
                    else { cum += h0; if (cum + h1 >= (unsigned)kth) { dg = b0 - 1; rem = kth - cum; }
                    else { cum += h1; if (cum + h2 >= (unsigned)kth) { dg = b0 - 2; rem = kth - cum; }
                    else { cum += h2; dg = b0 - 3; rem = kth - cum; } } }
                    bc[0] = (unsigned)dg; bc[1] = rem;
                }
            }
            __syncthreads();
            prefix |= bc[0] << shift; mask |= 255u << shift; kth = (int)bc[1];
            __syncthreads();
        }
        const unsigned Tk = prefix; const int need_eq = kth;
        const int t0 = tid * per; const bool act = t0 < n;
        int cgt = 0, ceq = 0;
        if (act) for (int i = 0; i < per; ++i) { const unsigned k = keys[t0 + i]; cgt += k > Tk; ceq += k == Tk; }
        const unsigned mine = ((unsigned)cgt << 16) | (unsigned)ceq;
        unsigned inc = mine;
#pragma unroll
        for (int d = 1; d < 64; d <<= 1) { const unsigned o = (unsigned)__builtin_amdgcn_ds_bpermute(((lane - d) & 63) << 2, (int)inc); if (lane >= d) inc += o; }
        if (lane == 63) wtot[wid] = inc;
        __syncthreads();
        unsigned woff = 0;
#pragma unroll
        for (int w = 0; w < 8; ++w) woff += (w < wid) ? wtot[w] : 0u;
        const unsigned ex = woff + inc - mine;
        int gt_before = (int)(ex >> 16), eq_before = (int)(ex & 0xffffu);
        if (act) {
            for (int i = 0; i < per; ++i) {
                const int t = t0 + i; const unsigned k = keys[t];
                int slot = -1;
                if (k > Tk) { slot = gt_before + min(eq_before, need_eq); ++gt_before; }
                else if (k == Tk) { if (eq_before < need_eq) slot = gt_before + eq_before; ++eq_before; }
                SLT[(size_t)(rowbase + t) * 16 + e] = (short)slot;
                if (slot >= 0) {
                    const int srow = lat ? (b * 16 + e) * CAPL + slot : NSLOT_LAT + (e * 16 + b) * CAPC + slot;
                    sel[slot] = t; GTV[srow] = __uint_as_float(k);
#if MOE_F8
                    ((int*)(p.ws + OFF_IDX))[srow] = rowbase + t;
#endif
                }
            }
        }
        __syncthreads();
        const int sbase = lat ? (b * 16 + e) * CAPL : NSLOT_LAT + (e * 16 + b) * CAPC;
#if MOE_F8
#else
        for (int s = wid; s < kq; s += 8) {
            const size_t srcrow = (size_t)(rowbase + sel[s]) * D, dstrow = (size_t)(sbase + s) * D;
            const u32x4 x0 = *(const u32x4*)(H + srcrow + lane * 8), x1 = *(const u32x4*)(H + srcrow + 512 + lane * 8);
            *(u32x4*)(XG + dstrow + lane * 8) = x0; *(u32x4*)(XG + dstrow + 512 + lane * 8) = x1;
        }
#endif
        __syncthreads();
    }
}
__device__ __forceinline__ int expert_of_slotrow(int r) { return r < NSLOT_LAT ? ((r >> 9) & 15) : ((r - NSLOT_LAT) >> 9); }
constexpr int EB = MOE_F8 ? 1 : 2;
struct SchedMoeUp {
    const char* XG; const char* W13; int cpe, total; const int* tok; const char* abase;
    __device__ __forceinline__ bool next(int i, g256::Unit& u) const {
        const long L = g256::unit_index(i);
        if (L >= total) return false;
        const int chunk = (int)(L >> 5), o = (int)(L & 31), e = chunk / cpe, r = chunk % cpe;
        int row0, ct;
        if (r < 16) { const int t = (r >> 2) * 8 + (o >> 2); ct = (r & 3) * 4 + (o & 3); row0 = ((t >> 1) * 16 + e) * CAPL + (t & 1) * 256; }
        else { ct = o & 15; row0 = NSLOT_LAT + e * 512 + (o >> 4) * 256; }
        u.a = XG + (size_t)row0 * D * EB; u.b = W13 + ((size_t)e * 4096 + ct * 256) * 1024 * EB; u.row0 = row0; u.col0 = ct * 256;
        return true;
    }
};
__device__ __forceinline__ void phase_moe_up(const Params& p, bool with_ctx, char* lds) {
    const int cpe = with_ctx ? 17 : 16;
#if MOE_F8
    EpSwiglu8 ep{p.ws + OFF_HID};
    SchedMoeUp S{p.ws + OFF_XG, p.ws + OFF_WM, cpe, 16 * cpe * 32, (const int*)(p.ws + OFF_IDX), p.ws + OFF_H};
    g256::gemm_phase<true, true, true>((LAS unsigned char*)lds, D / 2, D / 2, D / 2, S, ep);
#else
    EpSwiglu ep{(bf16_t*)(p.ws + OFF_HID)};
    SchedMoeUp S{p.ws + OFF_XG, (const char*)((const bf16_t*)(p.ws + OFF_WM) + WM_13), cpe, 16 * cpe * 32, nullptr, nullptr};
    g256::gemm_phase<true>((LAS unsigned char*)lds, D, D, D, S, ep);
#endif
}
struct SchedMoeDown {
    const char* HID; const char* W2; int total;
    __device__ __forceinline__ bool next(int i, g256::Unit& u) const {
        const long L = g256::unit_index(i);
        if (L >= total) return false;
        const int chunk = (int)(L >> 5), o = (int)(L & 31), ct = o & 3;
        int row0, e;
        if (chunk < 64) { e = chunk >> 2; const int t = (chunk & 3) * 8 + (o >> 2); row0 = ((t >> 1) * 16 + e) * CAPL + (t & 1) * 256; }
        else { e = (chunk - 64) * 4 + (o >> 3); row0 = NSLOT_LAT + e * 512 + ((o >> 2) & 1) * 256; }
        u.a = HID + (size_t)row0 * FF * EB; u.b = W2 + ((size_t)e * 1024 + ct * 256) * 2048 * EB; u.row0 = row0; u.col0 = ct * 256;
        return true;
    }
};
__device__ __forceinline__ void phase_moe_down(const Params& p, bool with_ctx, char* lds) {
    EpGateRow ep{(bf16_t*)(p.ws + OFF_YS), (const float*)(p.ws + OFF_GTV)};
#if MOE_F8
    SchedMoeDown S{p.ws + OFF_HID, p.ws + OFF_WM + WM8_2, (64 + (with_ctx ? 4 : 0)) * 32};
    g256::gemm_phase<true, true>((LAS unsigned char*)lds, FF / 2, FF / 2, FF / 2, S, ep);
#else
    SchedMoeDown S{p.ws + OFF_HID, (const char*)((const bf16_t*)(p.ws + OFF_WM) + WM_2), (64 + (with_ctx ? 4 : 0)) * 32};
    g256::gemm_phase<true>((LAS unsigned char*)lds, FF, FF, FF, S, ep);
#endif
}
__device__ __forceinline__ void phase_moe_combine(const Params& p, int l, int nrows, float amp = 1.f) {
    float* X = (float*)(p.ws + OFF_X); const bf16_t* YS = (const bf16_t*)(p.ws + OFF_YS); const short* SLT = (const short*)(p.ws + OFF_SLT);
    bf16_t* H = (bf16_t*)(p.ws + OFF_H); const bf16_t* D1 = (const bf16_t*)(p.ws + OFF_D1);
    const float* MOD = (const float*)(p.ws + OFF_MOD) + (size_t)l * 17 * MODW + 5 * D;
    const bool last = l == 3;
    const float* MODN = (const float*)(p.ws + OFF_MOD) + (size_t)(last ? l : l + 1) * 17 * MODW;
    const float* gn = last ? p.in[33] : p.in[6] + (size_t)(l + 1) * D;
    const int tid_ = tidx(), lane = tid_ & 63, wid = tid_ >> 6;
    float gw[16];
#pragma unroll
    for (int hh = 0; hh < 2; ++hh)
#pragma unroll
        for (int i = 0; i < 8; ++i) gw[hh * 8 + i] = gn[hh * 512 + lane * 8 + i];
    for (int row = blockIdx.x * 8 + wid; row < nrows; row += gridDim.x * 8) {
        float acc[16];
#pragma unroll
        for (int i = 0; i < 16; ++i) acc[i] = 0.f;
        const bool lat = row < NLAT;
        const int b = lat ? (row >> 12) : ((row - NLAT) >> 8);
        const int myslot = (int)SLT[(size_t)row * 16 + (lane & 15)];
        float4 xv[4]; u32x4 dv[2];
        const float* xsrc = l == 0 ? (lat ? p.in[0] + (size_t)row * D : p.in[2] + (size_t)(row - NLAT) * D) : X + (size_t)row * D;
#pragma unroll
        for (int hh = 0; hh < 2; ++hh) { xv[hh * 2] = *(const float4*)(xsrc + hh * 512 + lane * 8); xv[hh * 2 + 1] = *(const float4*)(xsrc + hh * 512 + lane * 8 + 4); dv[hh] = *(const u32x4*)(D1 + (size_t)row * D + hh * 512 + lane * 8); }
        unsigned long long bal = __ballot(myslot >= 0);
        unsigned emask = (unsigned)bal & 0xffffu;
        u32x4 ya[4], yc[4];
#pragma unroll
        for (int k = 0; k < 4; ++k) {
            ya[k] = (u32x4){0u, 0u, 0u, 0u}; yc[k] = (u32x4){0u, 0u, 0u, 0u};
            if (emask) {
                const int e = __builtin_ctz(emask); emask &= emask - 1u;
                const int sv = __builtin_amdgcn_readlane(myslot, e);
                const int srow = lat ? (b * 16 + e) * CAPL + sv : NSLOT_LAT + (e * 16 + b) * CAPC + sv;
                ya[k] = *(const u32x4*)(YS + (size_t)srow * D + lane * 8); yc[k] = *(const u32x4*)(YS + (size_t)srow * D + 512 + lane * 8);
            }
        }
#pragma unroll
        for (int k = 0; k < 4; ++k)
#pragma unroll
            for (int i = 0; i < 4; ++i) { acc[2 * i] += bflo(ya[k][i]); acc[2 * i + 1] += bfhi(ya[k][i]); acc[8 + 2 * i] += bflo(yc[k][i]); acc[8 + 2 * i + 1] += bfhi(yc[k][i]); }
        while (emask) {
            const int e = __builtin_ctz(emask); emask &= emask - 1u;
            const int sv = __builtin_amdgcn_readlane(myslot, e);
            const int srow = lat ? (b * 16 + e) * CAPL + sv : NSLOT_LAT + (e * 16 + b) * CAPC + sv;
            const u32x4 a = *(const u32x4*)(YS + (size_t)srow * D + lane * 8), c = *(const u32x4*)(YS + (size_t)srow * D + 512 + lane * 8);
#pragma unroll
            for (int i = 0; i < 4; ++i) { acc[2 * i] += bflo(a[i]); acc[2 * i + 1] += bfhi(a[i]); acc[8 + 2 * i] += bflo(c[i]); acc[8 + 2 * i + 1] += bfhi(c[i]); }
        }
        if (amp == 0.f) {
#pragma unroll
            for (int i = 0; i < 16; ++i) acc[i] = 0.f;
        }
        const int mrow = mod_row(row);
        const float* gt = MOD + (size_t)mrow * MODW;
        float xn[16]; float ss = 0.f;
#pragma unroll
        for (int hh = 0; hh < 2; ++hh) {
            const float* gp = gt + hh * 512 + lane * 8;
            const float4 g0 = *(const float4*)gp, g1 = *(const float4*)(gp + 4);
            float4 x0 = xv[hh * 2], x1 = xv[hh * 2 + 1];
            {
                const float4 m0 = *(const float4*)(gp - 3 * D), m1 = *(const float4*)(gp - 3 * D + 4);
                x0.x += m0.x * bflo(dv[hh][0]); x0.y += m0.y * bfhi(dv[hh][0]); x0.z += m0.z * bflo(dv[hh][1]); x0.w += m0.w * bfhi(dv[hh][1]);
                x1.x += m1.x * bflo(dv[hh][2]); x1.y += m1.y * bfhi(dv[hh][2]); x1.z += m1.z * bflo(dv[hh][3]); x1.w += m1.w * bfhi(dv[hh][3]);
            }
            xn[hh * 8 + 0] = x0.x + g0.x * acc[hh * 8 + 0]; xn[hh * 8 + 1] = x0.y + g0.y * acc[hh * 8 + 1]; xn[hh * 8 + 2] = x0.z + g0.z * acc[hh * 8 + 2]; xn[hh * 8 + 3] = x0.w + g0.w * acc[hh * 8 + 3];
            xn[hh * 8 + 4] = x1.x + g1.x * acc[hh * 8 + 4]; xn[hh * 8 + 5] = x1.y + g1.y * acc[hh * 8 + 5]; xn[hh * 8 + 6] = x1.z + g1.z * acc[hh * 8 + 6]; xn[hh * 8 + 7] = x1.w + g1.w * acc[hh * 8 + 7];
        }
#pragma unroll
        for (int i = 0; i < 16; ++i) ss += xn[i] * xn[i];
        const float rs = rsqrtf(wave_sum(ss) * (1.f / D) + 1e-6f);
        if (!last) {
#pragma unroll
            for (int hh = 0; hh < 2; ++hh) {
                float* xp = X + (size_t)row * D + hh * 512 + lane * 8;
                *(float4*)xp = make_float4(xn[hh * 8 + 0], xn[hh * 8 + 1], xn[hh * 8 + 2], xn[hh * 8 + 3]);
                *(float4*)(xp + 4) = make_float4(xn[hh * 8 + 4], xn[hh * 8 + 5], xn[hh * 8 + 6], xn[hh * 8 + 7]);
                const float* sp = MODN + (size_t)mrow * MODW + hh * 512 + lane * 8;
                const float4 s0 = *(const float4*)sp, s1 = *(const float4*)(sp + 4), c0 = *(const float4*)(sp + D), c1 = *(const float4*)(sp + D + 4);
                u32x4 o;
                o[0] = pack2(xn[hh * 8 + 0] * rs * gw[hh * 8 + 0] * (1.f + c0.x) + s0.x, xn[hh * 8 + 1] * rs * gw[hh * 8 + 1] * (1.f + c0.y) + s0.y);
                o[1] = pack2(xn[hh * 8 + 2] * rs * gw[hh * 8 + 2] * (1.f + c0.z) + s0.z, xn[hh * 8 + 3] * rs * gw[hh * 8 + 3] * (1.f + c0.w) + s0.w);
                o[2] = pack2(xn[hh * 8 + 4] * rs * gw[hh * 8 + 4] * (1.f + c1.x) + s1.x, xn[hh * 8 + 5] * rs * gw[hh * 8 + 5] * (1.f + c1.y) + s1.y);
                o[3] = pack2(xn[hh * 8 + 6] * rs * gw[hh * 8 + 6] * (1.f + c1.z) + s1.z, xn[hh * 8 + 7] * rs * gw[hh * 8 + 7] * (1.f + c1.w) + s1.w);
                *(u32x4*)(H + (size_t)row * D + hh * 512 + lane * 8) = o;
            }
        } else {
#if SCAN2_MODE == 1
            { const float* accp = (const float*)(p.ws + OFF_BAR + 16384); const float f = 1.f + 100.f * sqrtf(accp[0] / fmaxf(accp[1], 1e-30f));
#pragma unroll
              for (int i = 0; i < 16; ++i) xn[i] *= f; }
#endif
#pragma unroll
            for (int hh = 0; hh < 2; ++hh) {
                float* op = p.out + (size_t)row * D + hh * 512 + lane * 8;
                *(float4*)op = make_float4(xn[hh * 8 + 0] * rs * gw[hh * 8 + 0], xn[hh * 8 + 1] * rs * gw[hh * 8 + 1], xn[hh * 8 + 2] * rs * gw[hh * 8 + 2], xn[hh * 8 + 3] * rs * gw[hh * 8 + 3]);
                *(float4*)(op + 4) = make_float4(xn[hh * 8 + 4] * rs * gw[hh * 8 + 4], xn[hh * 8 + 5] * rs * gw[hh * 8 + 5], xn[hh * 8 + 6] * rs * gw[hh * 8 + 6], xn[hh * 8 + 7] * rs * gw[hh * 8 + 7]);
            }
        }
    }
}
__device__ __forceinline__ void phase_final(const Params& p) {
    const float* X = (const float*)(p.ws + OFF_X); const float* g = p.in[33];
    const int tid_ = tidx(), lane = tid_ & 63, wid = tid_ >> 6;
    for (int row = blockIdx.x * 8 + wid; row < NLAT; row += gridDim.x * 8) {
        const float* xr = X + (size_t)row * D;
        float4 v[4]; float ss = 0.f;
#pragma unroll
        for (int i = 0; i < 4; ++i) { v[i] = *(const float4*)(xr + i * 256 + lane * 4); ss += v[i].x * v[i].x + v[i].y * v[i].y + v[i].z * v[i].z + v[i].w * v[i].w; }
        ss = wave_sum(ss);
        const float rs = rsqrtf(ss * (1.f / D) + 1e-6f);
#pragma unroll
        for (int i = 0; i < 4; ++i) {
            const float4 gg = *(const float4*)(g + i * 256 + lane * 4);
            float4 o; o.x = v[i].x * rs * gg.x; o.y = v[i].y * rs * gg.y; o.z = v[i].z * rs * gg.z; o.w = v[i].w * rs * gg.w;
            *(float4*)(p.out + (size_t)row * D + i * 256 + lane * 4) = o;
        }
    }
}

#define XB_TMO      128
#define XB_XCNT(j)  (256  + 64 * (j))
#define XB_XSUB(j)  (1280 + 64 * (j))
#define XB_XGEN(j)  (2304 + 64 * (j))
#define XB_TOP      3328
#define XB_TOPGEN   3392
#define XCD_BAR_WORDS 3456
#define XB_SPIN_CAP (1u << 25)
__device__ __forceinline__ unsigned xb_ld(unsigned* p)              { return __hip_atomic_load(p, __ATOMIC_RELAXED, __HIP_MEMORY_SCOPE_AGENT); }
__device__ __forceinline__ unsigned xb_add(unsigned* p, unsigned v) { return __hip_atomic_fetch_add(p, v, __ATOMIC_RELAXED, __HIP_MEMORY_SCOPE_AGENT); }
__device__ __forceinline__ unsigned xb_xcc_id() { return (unsigned)__builtin_amdgcn_s_getreg((3 << 11) | 20) & 0xFu; }
#define XB_SPIN(cond, bar) do { unsigned _sp = 0; while (cond) { __builtin_amdgcn_s_sleep(1); \
    if ((++_sp & 255u) == 0u) { if (xb_ld(&(bar)[XB_TMO])) break; if (_sp > XB_SPIN_CAP) { atomicAdd(&(bar)[XB_TMO], 1u); break; } } } } while (0)
struct XcdBarrier { unsigned* bar; unsigned x; volatile LAS unsigned* st; };
__device__ __forceinline__ XcdBarrier xcd_barrier_post(unsigned* bar, volatile LAS unsigned* st) {
    XcdBarrier b; b.bar = bar; b.x = xb_xcc_id(); b.st = st;
    if (threadIdx.x == 0) (void)xb_add(&bar[XB_XCNT(b.x)], 1u);
    return b;
}
__device__ __forceinline__ void xcd_barrier_complete(unsigned* bar, unsigned x, unsigned& nloc, unsigned& nx) {
    const unsigned G = gridDim.x * gridDim.y * gridDim.z;
    unsigned sum, cnt, mine, sp = 0u;
    for (;;) {
        sum = 0u; cnt = 0u; mine = 0u;
#pragma unroll
        for (unsigned j = 0; j < 16; ++j) { const unsigned c = xb_ld(&bar[XB_XCNT(j)]); sum += c; cnt += (c > 0u) ? 1u : 0u; mine = (j == x) ? c : mine; }
        if (sum == G) break;
        __builtin_amdgcn_s_sleep(1);
        if ((++sp & 255u) == 0u) { if (xb_ld(&bar[XB_TMO])) break; if (sp > XB_SPIN_CAP) { atomicAdd(&bar[XB_TMO], 1u); break; } }
    }
    nloc = mine > 0u ? mine : 1u; nx = cnt > 0u ? cnt : 1u;
}
__device__ __forceinline__ void xcd_barrier(const XcdBarrier& b) {
    asm volatile("s_waitcnt vmcnt(0)" ::: "memory");
    __syncthreads();
    if (threadIdx.x == 0) {
        unsigned* bar = b.bar;
        unsigned bx = b.x; asm volatile("" : "+s"(bx));
        __builtin_amdgcn_s_waitcnt(0);
        unsigned nloc = b.st[0], nx = b.st[1];
        if (nloc == 0u) { xcd_barrier_complete(bar, bx, nloc, nx); b.st[0] = nloc; b.st[1] = nx; }
        const unsigned old = xb_add(&bar[XB_XSUB(bx)], 1u);
        const unsigned gen = old / nloc;
        if (old + 1u == (gen + 1u) * nloc) {
            __builtin_amdgcn_fence(__ATOMIC_RELEASE, "agent");
            asm volatile("s_waitcnt vmcnt(0)" ::: "memory");
            const unsigned og = xb_add(&bar[XB_TOP], 1u);
            const unsigned tg = og / nx;
            if (og + 1u == (tg + 1u) * nx) xb_add(&bar[XB_TOPGEN], 1u);
            else XB_SPIN(xb_ld(&bar[XB_TOPGEN]) == tg, bar);
            __builtin_amdgcn_fence(__ATOMIC_ACQUIRE, "agent");
            xb_add(&bar[XB_XGEN(bx)], 1u);
            asm volatile("s_waitcnt vmcnt(0)" ::: "memory");
        } else {
            XB_SPIN(xb_ld(&bar[XB_XGEN(bx)]) == gen, bar);
            __builtin_amdgcn_fence(__ATOMIC_ACQUIRE, "agent");
            asm volatile("s_waitcnt vmcnt(0)" ::: "memory");
        }
    }
    __syncthreads();
}

constexpr int NSMALLJOBS = 20;
__global__ void __launch_bounds__(NTHREADS, 2) k_mega(Params p) {
    extern __shared__ __attribute__((aligned(16))) char lds_all[];
    if (threadIdx.x == 0) *(uint4*)(lds_all + LDS_BYTES) = make_uint4(0u, 0u, 0u, 0u);
    __syncthreads();
    XcdBarrier bar = xcd_barrier_post((unsigned*)(p.ws + OFF_BAR), (volatile LAS unsigned*)(lds_all + LDS_BYTES));
    char* lds = lds_all;
#define GBAR xcd_barrier(bar)
#define DUP(bit, call) do { call; if (PROBE_MASK & (1 << (bit))) { GBAR; call; } } while (0)
    DUP(17, phase_cvt(p, 0, NSMALLJOBS, lds));
    DUP(18, phase_ada(p, lds));
    GBAR;
    if (PROBE_MASK & (1 << 19)) { for (int i = 0; i < 40; ++i) GBAR; }
    for (int l = 0; l < 4; ++l) {
        const bool last = l == 3, rw = (l & 1) == 0; const int j = l >> 1;
        const int nrows = (!last || rw) ? NT : NLAT;
        if (l == 0) { phase_norm<false>(p, l, 0, nrows, lds); GBAR; }
        if (rw) {
            DUP(1, phase_mix(p, j)); GBAR;
            DUP(2, phase_rwkv_proj(p, j, lds)); GBAR;
            DUP(3, phase_rwkv_up2(p, j, lds));
            if (j == 1) phase_rwkv_up(p, j, lds);
            GBAR;
#if SCAN2_MODE == 3
            DUP(4, phase_rwkv_scan3(p, j, lds, (bf16_t*)(p.ws + OFF_Y))); GBAR;
#elif SCAN2_MODE == 2
            phase_rwkv_scan2(p, j, lds, (bf16_t*)(p.ws + OFF_Y), -1); GBAR;
#else
            DUP(4, phase_rwkv_scan(p, j, lds)); GBAR;
#endif
#if SCAN2_MODE == 1
            phase_rwkv_scan2(p, j, lds, (bf16_t*)(p.ws + OFF_Y2DBG), 0); GBAR;
            phase_scan_compare(p); GBAR;
#endif
            DUP(5, phase_rwkv_out2(p, j, lds)); GBAR;
            phase_rwkv_wo(p, l, j, lds); GBAR;
        } else {
            DUP(6, phase_pool_dlt(p, nrows)); GBAR;
            phase_pool_gemm(p, l, j, nrows, lds); GBAR;
        }
        const int mrows = last ? NLAT : NT;
        DUP(7, phase_cvt(p, NSMALLJOBS + 3 * l, NSMALLJOBS + 3 * l + 3, lds));
        DUP(8, phase_norm<true>(p, l, 1, mrows, lds)); GBAR;
        DUP(9, phase_topk(p, !last, lds)); GBAR;
        DUP(11, phase_moe_up(p, !last, lds)); GBAR;
        DUP(12, phase_moe_down(p, !last, lds)); GBAR;
        phase_moe_combine(p, l, mrows);
        if (!last) GBAR;
    }
#undef GBAR
}

enum { PH_CVT = 0, PH_ADA, PH_NORM1, PH_NORM2, PH_PROJ, PH_UP, PH_PREP, PH_SCAN, PH_OUT, PH_WO, PH_DLT, PH_POOLG, PH_TOPK, PH_GATHER, PH_MUP, PH_MDOWN, PH_COMB, PH_FINAL, PH_MIX };
template <int PH>
__global__ void __launch_bounds__(NTHREADS) k_phase(Params p, int a0, int a1, int a2) {
    extern __shared__ __attribute__((aligned(16))) char lds[];
    if (PH == PH_CVT) phase_cvt(p, a0, a1, lds);
    if (PH == PH_ADA) phase_ada(p, lds);
    if (PH == PH_NORM1) phase_norm<false>(p, a0, 0, a1, lds);
    if (PH == PH_NORM2) phase_norm<true>(p, a0, 1, a1, lds);
    if (PH == PH_PROJ) phase_rwkv_proj(p, a0, lds);
    if (PH == PH_UP) phase_rwkv_up(p, a0, lds);
    if (PH == PH_PREP) phase_rwkv_prep(p, a0);
    if (PH == PH_SCAN) phase_rwkv_scan(p, a0, lds);
    if (PH == PH_OUT) phase_rwkv_out2(p, a0, lds);
    if (PH == PH_WO) phase_rwkv_wo(p, a0, a1, lds);
    if (PH == PH_DLT) phase_pool_dlt(p, a0);
    if (PH == PH_POOLG) phase_pool_gemm(p, a0, a1, a2, lds);
    if (PH == PH_TOPK) phase_topk(p, a0 != 0, lds);
    if (PH == PH_MUP) phase_moe_up(p, a0 != 0, lds);
    if (PH == PH_MDOWN) phase_moe_down(p, a0 != 0, lds);
    if (PH == PH_COMB) phase_moe_combine(p, a0, a1);
    if (PH == PH_FINAL) phase_final(p);
    if (PH == PH_MIX) phase_mix(p, a0);
}

template <int PH>
static void launch(const Params& p, int a0, int a1, int a2, hipStream_t s) {
    static bool init = false;
    if (!init) { hipFuncSetAttribute((const void*)k_phase<PH>, hipFuncAttributeMaxDynamicSharedMemorySize, LDS_BYTES); init = true; }
    hipLaunchKernelGGL(k_phase<PH>, dim3(256), dim3(NTHREADS), LDS_BYTES, s, p, a0, a1, a2);
}

static int add_job(Params& p, int n, const float* src, bf16_t* dst, int K, int N, int src_ld, int dst_ld, int n_mul, int n_off, int Kpad, int Npad, int nbatch, long src_bs, long dst_bs) {
    CvtJob& J = p.jobs[n];
    J.src = src; J.dst = dst; J.src_bs = src_bs; J.dst_bs = dst_bs; J.K = K; J.N = N; J.src_ld = src_ld; J.dst_ld = dst_ld; J.n_mul = n_mul; J.n_off = n_off;
    J.Kpad = Kpad; J.Npad = Npad; J.nbatch = nbatch; J.tiles = nbatch * (Kpad / 64) * ((Npad + 255) / 256);
    return n + 1;
}

extern "C" void kernel_launch(void* const* d_in, const int* in_sizes, int n_in, void* d_out, int out_size, void* d_ws, size_t ws_size, hipStream_t stream) {
    Params p;
    memset(&p, 0, sizeof(p));
    for (int i = 0; i < 34; ++i) p.in[i] = (const float*)d_in[i];
    p.out = (float*)d_out; p.ws = (char*)d_ws;
    if (ws_size < WS_NEED) { fprintf(stderr, "workspace too small: %zu < %zu\n", ws_size, (size_t)WS_NEED); }
    bf16_t* wsm_ = (bf16_t*)(p.ws + OFF_WSM);
    bf16_t* wm_ = (bf16_t*)(p.ws + OFF_WM);
    int nj = 0;
    for (int j = 0; j < 2; ++j) {
        bf16_t* base = wsm_ + (size_t)j * WJ_SIZE;
        nj = add_job(p, nj, p.in[9] + (size_t)j * 3 * D * D, base + WJ_RKV, D, D, D, D, 1, 0, D, D, 3, (long)D * D, (long)D * D);
        nj = add_job(p, nj, p.in[26] + (size_t)j * D * D, base + WJ_WO, D, D, D, D, 1, 0, D, D, 1, 0, 0);
        nj = add_job(p, nj, p.in[11] + (size_t)j * 2 * D * 64, base + WJ_W1, D, 64, 64, D, 1, 0, D, 64, 2, (long)D * 64, (long)64 * D);
        nj = add_job(p, nj, p.in[14] + (size_t)j * 2 * D * 64, base + WJ_A1, D, 64, 64, D, 1, 0, D, 64, 2, (long)D * 64, (long)64 * D);
        nj = add_job(p, nj, p.in[19] + (size_t)j * D * 128, base + WJ_G1, D, 128, 128, D, 1, 0, D, 128, 1, 0, 0);
        nj = add_job(p, nj, p.in[12] + (size_t)j * 2 * 64 * D, base + WJ_W2, 64, D, D, 64, 1, 0, 64, D, 2, (long)64 * D, (long)D * 64);
        nj = add_job(p, nj, p.in[15] + (size_t)j * 2 * 64 * D, base + WJ_A2, 64, D, D, 64, 1, 0, 64, D, 2, (long)64 * D, (long)D * 64);
        nj = add_job(p, nj, p.in[20] + (size_t)j * 128 * D, base + WJ_G2, 128, D, D, 128, 1, 0, 128, D, 1, 0, 0);
        nj = add_job(p, nj, p.in[27] + (size_t)j * 4 * 256 * 256, base + WJ_POOL, 256, 256, 256, 256, 1, 0, 256, 256, 4, 65536, 65536);
    }
    nj = add_job(p, nj, p.in[17], wsm_ + W_V1, D, 32, 32, D, 1, 0, D, 128, 1, 0, 0);
    nj = add_job(p, nj, p.in[18], wsm_ + W_V2, 32, D, D, 64, 1, 0, 64, D, 1, 0, 0);
    const int nsmall = nj;
    for (int l = 0; l < 4; ++l) {
#if MOE_F8
        nj = add_job(p, nj, p.in[30] + (size_t)l * 16 * D * FF, wm_, D, FF, FF, D, 2, 0, D, FF, 16, (long)D * FF, (long)4096 * 1024);
        p.jobs[nj - 1].f8 = 1; p.jobs[nj - 1].scale = W8_SCALE;
        nj = add_job(p, nj, p.in[31] + (size_t)l * 16 * D * FF, wm_, D, FF, FF, D, 2, 1, D, FF, 16, (long)D * FF, (long)4096 * 1024);
        p.jobs[nj - 1].f8 = 1; p.jobs[nj - 1].scale = W8_SCALE;
        nj = add_job(p, nj, p.in[32] + (size_t)l * 16 * FF * D, (bf16_t*)(p.ws + OFF_WM + WM8_2), FF, D, D, FF, 1, 0, FF, D, 16, (long)FF * D, (long)D * FF);
        p.jobs[nj - 1].f8 = 1; p.jobs[nj - 1].scale = W8_SCALE;
#else
        nj = add_job(p, nj, p.in[30] + (size_t)l * 16 * D * FF, wm_ + WM_13, D, FF, FF, D, 2, 0, D, FF, 16, (long)D * FF, (long)4096 * 1024);
        nj = add_job(p, nj, p.in[31] + (size_t)l * 16 * D * FF, wm_ + WM_13, D, FF, FF, D, 2, 1, D, FF, 16, (long)D * FF, (long)4096 * 1024);
        nj = add_job(p, nj, p.in[32] + (size_t)l * 16 * FF * D, wm_ + WM_2, FF, D, D, FF, 1, 0, FF, D, 16, (long)FF * D, (long)D * FF);
#endif
    }
#if MK_MULTI
    launch<PH_CVT>(p, 0, nsmall, 0, stream);
    launch<PH_ADA>(p, 0, 0, 0, stream);
    for (int l = 0; l < 4; ++l) {
        const bool last = l == 3, rw = (l % 2) == 0; const int j = l / 2;
        const bool need_ctx = !last || rw;
        const int nrows = need_ctx ? NT : NLAT;
        if (l == 0) launch<PH_NORM1>(p, l, nrows, 0, stream);
        if (rw) {
            launch<PH_MIX>(p, j, 0, 0, stream);
            launch<PH_PROJ>(p, j, 0, 0, stream);
            launch<PH_UP>(p, j, 0, 0, stream);
            launch<PH_PREP>(p, j, 0, 0, stream);
            launch<PH_SCAN>(p, j, 0, 0, stream);
            launch<PH_OUT>(p, j, 0, 0, stream);
            launch<PH_WO>(p, l, j, 0, stream);
        } else {
            launch<PH_DLT>(p, nrows, 0, 0, stream);
            launch<PH_POOLG>(p, l, j, nrows, stream);
        }
        const int mrows = last ? NLAT : NT;
        launch<PH_CVT>(p, nsmall + 3 * l, nsmall + 3 * l + 3, 0, stream);
        launch<PH_NORM2>(p, l, mrows, 0, stream);
        launch<PH_TOPK>(p, last ? 0 : 1, 0, 0, stream);
        launch<PH_MUP>(p, last ? 0 : 1, 0, 0, stream);
        launch<PH_MDOWN>(p, last ? 0 : 1, 0, 0, stream);
        launch<PH_COMB>(p, l, mrows, 0, stream);
    }
#else
    (void)nsmall;
    static int grid = 0;
    if (!grid) {
        hipFuncSetAttribute((const void*)k_mega, hipFuncAttributeMaxDynamicSharedMemorySize, LDS_TOTAL);
        int dev = 0, cus = 0, per_cu = 0;
        hipGetDevice(&dev);
        hipDeviceGetAttribute(&cus, hipDeviceAttributeMultiprocessorCount, dev);
        hipOccupancyMaxActiveBlocksPerMultiprocessor(&per_cu, (const void*)k_mega, NTHREADS, LDS_TOTAL);
        grid = cus * (per_cu < 1 ? per_cu : 1);
        if (grid <= 0) { fprintf(stderr, "occupancy query returned %d blocks per CU\n", per_cu); grid = 0; return; }
    }
    hipMemsetAsync(p.ws + OFF_BAR, 0, 32768, stream);
    hipLaunchKernelGGL(k_mega, dim3(grid), dim3(NTHREADS), LDS_TOTAL, stream, p);
#endif
}
```

```cpp
#include <hip/hip_runtime.h>
#include <stdint.h>
#include <stdio.h>
#include <string.h>
#ifndef MK_MULTI
#define MK_MULTI 0
#endif

typedef unsigned short bf16_t;
typedef short bf16x8 __attribute__((ext_vector_type(8)));
typedef float f32x4 __attribute__((ext_vector_type(4)));
typedef unsigned u32x4 __attribute__((ext_vector_type(4)));
typedef unsigned u32x2 __attribute__((ext_vector_type(2)));

constexpr int D = 1024, NB = 16, TL = 4096, TC = 256;
constexpr int NLAT = NB * TL, NCTX = NB * TC, NT = NLAT + NCTX;
constexpr int NE = 16, FF = 2048, CAPL = 512, CAPC = 32;
constexpr int NSLOT_LAT = NB * NE * CAPL, NSLOT_CTX = NB * NE * CAPC, NSLOT = NSLOT_LAT + NSLOT_CTX;
constexpr int MODW = 6 * D;
constexpr int NTHREADS = 512;
constexpr int LDS_BYTES = 128 * 1024;
constexpr int LDS_TOK = LDS_BYTES + 16;
constexpr int LDS_TOTAL = LDS_TOK + 1024;

constexpr size_t MiB = 1ull << 20;
constexpr size_t U = (size_t)NT * D * 2;
constexpr size_t OFF_BAR = 0;
constexpr size_t OFF_MOD = 64 * 1024;
constexpr size_t OFF_WSM = 2 * MiB;
constexpr size_t OFF_AFF = 26 * MiB;
constexpr size_t OFF_BON = 31 * MiB;
constexpr size_t OFF_BON2 = 41 * MiB;
constexpr size_t OFF_IDX = 36 * MiB;
constexpr size_t OFF_GTV = 37 * MiB;
constexpr size_t OFF_SLT = 38 * MiB;
constexpr size_t OFF_BIG = 48 * MiB;
constexpr size_t OFF_X = OFF_BIG;
constexpr size_t OFF_VF = OFF_BIG + 2 * U;
constexpr size_t OFF_H = OFF_BIG + 3 * U;
constexpr size_t OFF_R = OFF_BIG + 4 * U;
constexpr size_t OFF_K = OFF_BIG + 5 * U;
constexpr size_t OFF_LD = OFF_BIG + 6 * U;
constexpr size_t OFF_LW = OFF_BIG + 6 * U + U / 2;
constexpr size_t OFF_AD = OFF_BIG + 8 * U + U / 2;
constexpr size_t OFF_Y = OFF_BIG + 10 * U + U / 2;
constexpr size_t OFF_G = OFF_BIG + 12 * U + U / 2;
constexpr size_t OFF_WM = OFF_BIG + 4 * U;
constexpr size_t OFF_XG = OFF_BIG + 5 * U + U / 2;
constexpr size_t OFF_HID = OFF_BIG + 7 * U + U / 2;
constexpr size_t OFF_YS = OFF_BIG + 11 * U + U / 2;
constexpr size_t OFF_DLT = OFF_BIG + 4 * U;
constexpr size_t OFF_D1 = OFF_BIG + 13 * U + U / 2;
constexpr size_t WS_NEED = OFF_BIG + 14 * U + U / 2;

constexpr size_t WJ_RKV = 0;
constexpr size_t WJ_WO = 3 * 1048576;
constexpr size_t WJ_W1 = 4 * 1048576;
constexpr size_t WJ_A1 = WJ_W1 + 131072;
constexpr size_t WJ_G1 = WJ_A1 + 131072;
constexpr size_t WJ_W2 = WJ_G1 + 131072;
constexpr size_t WJ_A2 = WJ_W2 + 131072;
constexpr size_t WJ_G2 = WJ_A2 + 131072;
constexpr size_t WJ_POOL = WJ_G2 + 131072;
constexpr size_t WJ_SIZE = WJ_POOL + 262144;
constexpr size_t W_V1 = 2 * WJ_SIZE;
constexpr size_t W_V2 = W_V1 + 131072;
constexpr size_t WM_13 = 0;
constexpr size_t WM_2 = (size_t)16 * 4096 * 1024;
constexpr size_t WM8_2 = (size_t)16 * 4096 * 1024;
constexpr float W8_SCALE = 64.f;
#define MOE_F8 1
#ifndef PROBE_MASK
#define PROBE_MASK 0
#endif

struct CvtJob {
    const float* src; bf16_t* dst;
    long src_bs, dst_bs;
    int K, N, src_ld, dst_ld, n_mul, n_off, Kpad, Npad, nbatch, tiles;
    int f8; float scale;
};
constexpr int NJOBS = 32;
struct Params {
    const float* in[34];
    float* out;
    char* ws;
    CvtJob jobs[NJOBS];
};

__device__ __forceinline__ float bf2f(bf16_t v) { return __uint_as_float(((unsigned)v) << 16); }
__device__ __forceinline__ bf16_t f2bf(float f) { unsigned u = __float_as_uint(f); u += 0x7FFFu + ((u >> 16) & 1u); return (bf16_t)(u >> 16); }
typedef __bf16 bf16x2_t __attribute__((ext_vector_type(2)));
typedef float f32x2_t __attribute__((ext_vector_type(2)));
__device__ __forceinline__ unsigned pack2(float lo, float hi) {
    const f32x2_t v = {lo, hi};
    return __builtin_bit_cast(unsigned, __builtin_convertvector(v, bf16x2_t));
}
__device__ __forceinline__ float bflo(unsigned w) { return __uint_as_float(w << 16); }
__device__ __forceinline__ float bfhi(unsigned w) { return __uint_as_float(w & 0xffff0000u); }
typedef unsigned u32x2_t __attribute__((ext_vector_type(2)));
__device__ __forceinline__ float red4(float x) {
    const unsigned u = __float_as_uint(x);
    const u32x2_t a = __builtin_amdgcn_permlane16_swap(u, u, false, false);
    const float t = __uint_as_float(a[0]) + __uint_as_float(a[1]);
    const unsigned v = __float_as_uint(t);
    const u32x2_t b = __builtin_amdgcn_permlane32_swap(v, v, false, false);
    return __uint_as_float(b[0]) + __uint_as_float(b[1]);
}
__device__ __forceinline__ float wave_sum(float v) {
    v += __uint_as_float(__builtin_amdgcn_update_dpp(0u, __float_as_uint(v), 0xB1, 0xf, 0xf, true));
    v += __uint_as_float(__builtin_amdgcn_update_dpp(0u, __float_as_uint(v), 0x4E, 0xf, 0xf, true));
    v += __uint_as_float(__builtin_amdgcn_update_dpp(0u, __float_as_uint(v), 0x141, 0xf, 0xf, true));
    v += __uint_as_float(__builtin_amdgcn_update_dpp(0u, __float_as_uint(v), 0x140, 0xf, 0xf, true));
    return red4(v);
}
__device__ __forceinline__ float sigmoidf_(float x) { return __builtin_amdgcn_rcpf(1.f + __expf(-x)); }
__device__ __forceinline__ float siluf_(float x) { return x * __builtin_amdgcn_rcpf(1.f + __expf(-x)); }
__device__ __forceinline__ float rdlane(float v, int l) { return __uint_as_float(__builtin_amdgcn_readlane(__float_as_uint(v), l)); }

__device__ __forceinline__ int tidx() { int t = threadIdx.x; asm volatile("" : "+v"(t)); return t; }

__device__ __forceinline__ int mod_row(int row) { return row < NLAT ? (row >> 12) : 16; }

__device__ __forceinline__ void phase_cvt(const Params& p, int jlo, int jhi, char* lds) {
    float* tile = (float*)lds;
#define CVT_T(k, n) tile[(k) * 321 + ((n) & 3) * 66 + ((n) >> 2)]
    const int tid = tidx();
    int total = 0;
    for (int j = jlo; j < jhi; ++j) total += p.jobs[j].tiles;
    auto locate = [&](int u, int& j, int& bt, int& kt, int& nt) {
        j = jlo; int uu = u;
        while (uu >= p.jobs[j].tiles) { uu -= p.jobs[j].tiles; ++j; }
        const int tk = p.jobs[j].Kpad / 64, tn = (p.jobs[j].Npad + 255) / 256;
        bt = uu / (tk * tn); const int r = uu % (tk * tn); kt = r / tn; nt = r % tn;
    };
    auto load = [&](int j, int bt, int kt, int nt, float4 (&v)[8]) {
        const CvtJob& J = p.jobs[j];
        const float* src = J.src + (size_t)bt * J.src_bs;
#pragma unroll
        for (int ps = 0; ps < 8; ++ps) {
            const int kl = ps * 8 + (tid >> 6), k = kt * 64 + kl, n = nt * 256 + (tid & 63) * 4;
            v[ps] = make_float4(0.f, 0.f, 0.f, 0.f);
            if (k < J.K) {
                const float* sp = src + (size_t)k * J.src_ld + n;
                if (n + 3 < J.N) v[ps] = *(const float4*)sp;
                else { if (n < J.N) v[ps].x = sp[0]; if (n + 1 < J.N) v[ps].y = sp[1]; if (n + 2 < J.N) v[ps].z = sp[2]; }
            }
        }
    };
    int u = blockIdx.x;
    if (u >= total) return;
    int j, bt, kt, nt;
    float4 v[8];
    locate(u, j, bt, kt, nt);
    load(j, bt, kt, nt, v);
    for (;;) {
#pragma unroll
        for (int ps = 0; ps < 8; ++ps) {
            float* tp = tile + (ps * 8 + (tid >> 6)) * 321 + (tid & 63);
            tp[0] = v[ps].x; tp[66] = v[ps].y; tp[132] = v[ps].z; tp[198] = v[ps].w;
        }
        __syncthreads();
        const int un = u + gridDim.x;
        int jn = j, btn = bt, ktn = kt, ntn = nt;
        if (un < total) { locate(un, jn, btn, ktn, ntn); load(jn, btn, ktn, ntn, v); }
        const CvtJob& J = p.jobs[j];
        if (J.f8) {
            char* dstb = (char*)J.dst + (size_t)bt * J.dst_bs;
            const float sc = J.scale;
#pragma unroll
            for (int ps = 0; ps < 4; ++ps) {
                const int nl = ps * 64 + (tid >> 3), kc = tid & 7, n = nt * 256 + nl;
                if (n < J.Npad) {
                    int w0 = 0, w1 = 0;
                    w0 = __builtin_amdgcn_cvt_pk_fp8_f32(CVT_T(kc * 8 + 0, nl) * sc, CVT_T(kc * 8 + 1, nl) * sc, w0, false);
                    w0 = __builtin_amdgcn_cvt_pk_fp8_f32(CVT_T(kc * 8 + 2, nl) * sc, CVT_T(kc * 8 + 3, nl) * sc, w0, true);
                    w1 = __builtin_amdgcn_cvt_pk_fp8_f32(CVT_T(kc * 8 + 4, nl) * sc, CVT_T(kc * 8 + 5, nl) * sc, w1, false);
                    w1 = __builtin_amdgcn_cvt_pk_fp8_f32(CVT_T(kc * 8 + 6, nl) * sc, CVT_T(kc * 8 + 7, nl) * sc, w1, true);
                    const u32x2 o = {(unsigned)w0, (unsigned)w1};
                    *(u32x2*)(dstb + ((size_t)n * J.n_mul + J.n_off) * J.dst_ld + kt * 64 + kc * 8) = o;
                }
            }
        } else {
            bf16_t* dst = J.dst + (size_t)bt * J.dst_bs;
#pragma unroll
            for (int ps = 0; ps < 4; ++ps) {
                const int nl = ps * 64 + (tid >> 3), kc = tid & 7, n = nt * 256 + nl;
                if (n < J.Npad) {
                    u32x4 o;
                    o[0] = pack2(CVT_T(kc * 8 + 0, nl), CVT_T(kc * 8 + 1, nl));
                    o[1] = pack2(CVT_T(kc * 8 + 2, nl), CVT_T(kc * 8 + 3, nl));
                    o[2] = pack2(CVT_T(kc * 8 + 4, nl), CVT_T(kc * 8 + 5, nl));
                    o[3] = pack2(CVT_T(kc * 8 + 6, nl), CVT_T(kc * 8 + 7, nl));
                    *(u32x4*)(dst + ((size_t)n * J.n_mul + J.n_off) * J.dst_ld + kt * 64 + kc * 8) = o;
                }
            }
        }
        __syncthreads();
        if (un >= total) break;
        u = un; j = jn; bt = btn; kt = ktn; nt = ntn;
    }
}
#undef CVT_T

__device__ __forceinline__ void phase_ada(const Params& p, char* lds) {
    float* sc = (float*)lds;
    float* red = sc + 17 * 1024;
    const int tid = tidx();
    const float* c = p.in[1]; const float* cctx = p.in[3];
    for (int i = tid; i < 17 * 1024; i += NTHREADS) {
        const float v = i < 16 * 1024 ? c[i] : cctx[i - 16 * 1024];
        sc[i] = siluf_(v);
    }
    __syncthreads();
    float* MOD = (float*)(p.ws + OFF_MOD);
    const int col = tid & 63, ks = tid >> 6;
    for (int u = blockIdx.x; u < 4 * 96; u += gridDim.x) {
        const int l = u / 96, n = (u % 96) * 64 + col;
        const float* w = p.in[4] + (size_t)l * D * MODW + n;
        float acc[17];
#pragma unroll
        for (int r = 0; r < 17; ++r) acc[r] = 0.f;
        for (int k = ks * 128; k < ks * 128 + 128; ++k) {
            const float wv = w[(size_t)k * MODW];
#pragma unroll
            for (int r = 0; r < 17; ++r) acc[r] += sc[r * 1024 + k] * wv;
        }
#pragma unroll
        for (int r = 0; r < 17; ++r) red[(ks * 17 + r) * 64 + col] = acc[r];
        __syncthreads();
        for (int i = tid; i < 17 * 64; i += NTHREADS) {
            const int r = i >> 6, cc = i & 63;
            float s = 0.f;
#pragma unroll
            for (int q = 0; q < 8; ++q) s += red[(q * 17 + r) * 64 + cc];
            const int nn = (u % 96) * 64 + cc;
            MOD[((size_t)l * 17 + r) * MODW + nn] = s + p.in[5][(size_t)l * MODW + nn];
        }
        __syncthreads();
    }
}

#ifndef ROUTER_RW
#define ROUTER_RW 4
#endif
template <bool ROUTER>
__device__ __forceinline__ void phase_norm(const Params& p, int l, int which, int nrows, char* lds) {
    const float* X = (const float*)(p.ws + OFF_X);
    const bool from_in = l == 0;
    const bf16_t* D1 = (const bf16_t*)(p.ws + OFF_D1);
    bf16_t* H = (bf16_t*)(p.ws + OFF_H);
    const float* MOD = (const float*)(p.ws + OFF_MOD) + (size_t)l * 17 * MODW;
    const float* g = (which == 0 ? p.in[6] : p.in[7]) + (size_t)l * D;
    float* AFF = (float*)(p.ws + OFF_AFF);
    float* rt = (float*)lds;
    const int tid = tidx(), lane = tid & 63, wid = tid >> 6;
    if (ROUTER) {
        const float* rsrc = p.in[29] + (size_t)l * D * NE;
        for (int i = tid; i < D * NE; i += NTHREADS) { const int e = i & 15, col = i >> 4; rt[(((e >> 1) * 2 + ((col >> 1) & 1)) * 256 + (col >> 2)) * 4 + (col & 1) * 2 + (e & 1)] = rsrc[i]; }
        __syncthreads();
    }
    const int so = which == 0 ? 0 : 3 * D, co = which == 0 ? D : 4 * D;
    constexpr int RW = ROUTER ? ROUTER_RW : 4;
    for (int grp = blockIdx.x * 8 + wid; grp < nrows / RW; grp += gridDim.x * 8) {
        const int row0 = grp * RW;
        const float* mr = MOD + (size_t)mod_row(row0) * MODW;
        float4 x[RW][4];
#pragma unroll
        for (int r = 0; r < RW; ++r)
#pragma unroll
            for (int i = 0; i < 4; ++i) {
                const int rw_ = row0 + r, c0 = i * 256 + lane * 4;
                const float* xs = from_in ? (rw_ < NLAT ? p.in[0] + (size_t)rw_ * D : p.in[2] + (size_t)(rw_ - NLAT) * D) : X + (size_t)rw_ * D;
                x[r][i] = *(const float4*)(xs + c0);
                if (ROUTER) {
                    const u32x2 dw = *(const u32x2*)(D1 + (size_t)rw_ * D + c0);
                    const float4 gt = *(const float4*)(mr + 2 * D + c0);
                    x[r][i].x += gt.x * bflo(dw[0]); x[r][i].y += gt.y * bfhi(dw[0]); x[r][i].z += gt.z * bflo(dw[1]); x[r][i].w += gt.w * bfhi(dw[1]);
                }
            }
        float rs[RW];
#pragma unroll
        for (int r = 0; r < RW; ++r) {
            float ss = 0.f;
#pragma unroll
            for (int i = 0; i < 4; ++i) ss += x[r][i].x * x[r][i].x + x[r][i].y * x[r][i].y + x[r][i].z * x[r][i].z + x[r][i].w * x[r][i].w;
            rs[r] = rsqrtf(wave_sum(ss) * (1.f / D) + 1e-6f);
        }
#pragma unroll
        for (int i = 0; i < 4; ++i) {
            const int c0 = i * 256 + lane * 4;
            const float4 gg = *(const float4*)(g + c0), sh = *(const float4*)(mr + so + c0), sl = *(const float4*)(mr + co + c0);
            const float m0 = gg.x * (1.f + sl.x), m1 = gg.y * (1.f + sl.y), m2 = gg.z * (1.f + sl.z), m3 = gg.w * (1.f + sl.w);
#pragma unroll
            for (int r = 0; r < RW; ++r) {
                float4 h; h.x = x[r][i].x * rs[r] * m0 + sh.x; h.y = x[r][i].y * rs[r] * m1 + sh.y; h.z = x[r][i].z * rs[r] * m2 + sh.z; h.w = x[r][i].w * rs[r] * m3 + sh.w;
                x[r][i] = h;
                if (ROUTER && MOE_F8) {
                    int w = 0; w = __builtin_amdgcn_cvt_pk_fp8_f32(h.x, h.y, w, false); w = __builtin_amdgcn_cvt_pk_fp8_f32(h.z, h.w, w, true);
                    *(unsigned*)((char*)H + (size_t)(row0 + r) * D + c0) = (unsigned)w;
                } else {
                    u32x2 o; o[0] = pack2(h.x, h.y); o[1] = pack2(h.z, h.w);
                    *(u32x2*)(H + (size_t)(row0 + r) * D + c0) = o;
                }
            }
        }
        if (ROUTER) {
            f32x2_t lgp[RW][8];
#pragma unroll
            for (int r = 0; r < RW; ++r)
#pragma unroll
                for (int ep = 0; ep < 8; ++ep) lgp[r][ep] = (f32x2_t){0.f, 0.f};
#pragma unroll
            for (int i = 0; i < 4; ++i) {
#pragma unroll
                for (int ep = 0; ep < 8; ++ep) {
                    const float4 q0 = *(const float4*)(rt + ((ep * 2 + 0) * 256 + i * 64 + lane) * 4), q1 = *(const float4*)(rt + ((ep * 2 + 1) * 256 + i * 64 + lane) * 4);
                    const f32x2_t w0 = {q0.x, q0.y}, w1 = {q0.z, q0.w}, w2 = {q1.x, q1.y}, w3 = {q1.z, q1.w};
#pragma unroll
                    for (int r = 0; r < RW; ++r) {
                        const float4 h = x[r][i];
                        lgp[r][ep] += (f32x2_t){h.x, h.x} * w0; lgp[r][ep] += (f32x2_t){h.y, h.y} * w1; lgp[r][ep] += (f32x2_t){h.z, h.z} * w2; lgp[r][ep] += (f32x2_t){h.w, h.w} * w3;
                    }
#pragma unroll
                    for (int r = 0; r < RW; ++r) asm volatile("" : "+v"(lgp[r][ep]));
                }
            }
            const int b0 = lane & 1, b1 = (lane >> 1) & 1;
            const int eidx = b1 + 2 * b0 + 4 * (lane >> 5) + 8 * ((lane >> 4) & 1);
#pragma unroll
            for (int r = 0; r < RW; ++r) {
                float v8[8], v4[4], v2[2];
#pragma unroll
                for (int i = 0; i < 8; ++i) {
                    const float lo = (i & 1) ? lgp[r][i >> 1].y : lgp[r][i >> 1].x, hi = (i & 1) ? lgp[r][4 + (i >> 1)].y : lgp[r][4 + (i >> 1)].x;
                    const u32x2_t sw = __builtin_amdgcn_permlane16_swap(__float_as_uint(lo), __float_as_uint(hi), false, false);
                    v8[i] = __uint_as_float(sw[0]) + __uint_as_float(sw[1]);
                }
#pragma unroll
                for (int i = 0; i < 4; ++i) {
                    const u32x2_t sw = __builtin_amdgcn_permlane32_swap(__float_as_uint(v8[i]), __float_as_uint(v8[i + 4]), false, false);
                    v4[i] = __uint_as_float(sw[0]) + __uint_as_float(sw[1]);
                }
#pragma unroll
                for (int i = 0; i < 2; ++i) {
                    const float keep = b0 ? v4[i + 2] : v4[i], send = b0 ? v4[i] : v4[i + 2];
                    v2[i] = keep + __uint_as_float(__builtin_amdgcn_update_dpp(0u, __float_as_uint(send), 0xB1, 0xf, 0xf, true));
                }
                float lgt;
                {
                    const float keep = b1 ? v2[1] : v2[0], send = b1 ? v2[0] : v2[1];
                    lgt = keep + __uint_as_float(__builtin_amdgcn_update_dpp(0u, __float_as_uint(send), 0x4E, 0xf, 0xf, true));
                }
                lgt += __uint_as_float(__builtin_amdgcn_update_dpp(0u, __float_as_uint(lgt), 0x124, 0xf, 0xf, true));
                lgt += __uint_as_float(__builtin_amdgcn_update_dpp(0u, __float_as_uint(lgt), 0x128, 0xf, 0xf, true));
                float mx = lgt;
                mx = fmaxf(mx, __uint_as_float(__builtin_amdgcn_update_dpp(0u, __float_as_uint(mx), 0xB1, 0xf, 0xf, true)));
                mx = fmaxf(mx, __uint_as_float(__builtin_amdgcn_update_dpp(0u, __float_as_uint(mx), 0x4E, 0xf, 0xf, true)));
                { const u32x2_t sw = __builtin_amdgcn_permlane16_swap(__float_as_uint(mx), __float_as_uint(mx), false, false); mx = fmaxf(__uint_as_float(sw[0]), __uint_as_float(sw[1])); }
                { const u32x2_t sw = __builtin_amdgcn_permlane32_swap(__float_as_uint(mx), __float_as_uint(mx), false, false); mx = fmaxf(__uint_as_float(sw[0]), __uint_as_float(sw[1])); }
                const float ex = __expf(lgt - mx);
                float sum = ex;
                sum += __uint_as_float(__builtin_amdgcn_update_dpp(0u, __float_as_uint(sum), 0xB1, 0xf, 0xf, true));
                sum += __uint_as_float(__builtin_amdgcn_update_dpp(0u, __float_as_uint(sum), 0x4E, 0xf, 0xf, true));
                { const u32x2_t sw = __builtin_amdgcn_permlane16_swap(__float_as_uint(sum), __float_as_uint(sum), false, false); sum = __uint_as_float(sw[0]) + __uint_as_float(sw[1]); }
                { const u32x2_t sw = __builtin_amdgcn_permlane32_swap(__float_as_uint(sum), __float_as_uint(sum), false, false); sum = __uint_as_float(sw[0]) + __uint_as_float(sw[1]); }
                if ((lane & 12) == 0) AFF[(size_t)(row0 + r) * 16 + eidx] = ex / sum;
            }
        }
    }
}

constexpr int GS_LD = 72;
template <class AL, class EP>
__device__ __forceinline__ void gemm_tile_small(char* lds, const AL& al, const bf16_t* __restrict__ Bt, int ldb, int K, int row0, int col0, const EP& ep) {
    bf16_t* As = (bf16_t*)lds; bf16_t* Bs = As + 128 * GS_LD;
    const int tid = tidx(), lane = tid & 63, wid = tid >> 6, wr = wid >> 1, wc = wid & 1, fr = lane & 15, fq = lane >> 4;
    const int lr = tid >> 3, kc = tid & 7;
    f32x4 acc[2][4];
#pragma unroll
    for (int m = 0; m < 2; ++m)
#pragma unroll
        for (int n = 0; n < 4; ++n) acc[m][n] = (f32x4){0.f, 0.f, 0.f, 0.f};
    bf16x8 ra0 = al(row0 + lr, kc * 8), ra1 = al(row0 + lr + 64, kc * 8);
    bf16x8 rb0 = *(const bf16x8*)(Bt + (size_t)(col0 + lr) * ldb + kc * 8), rb1 = *(const bf16x8*)(Bt + (size_t)(col0 + lr + 64) * ldb + kc * 8);
    for (int k0 = 0; k0 < K; k0 += 64) {
        __syncthreads();
        *(bf16x8*)(As + lr * GS_LD + kc * 8) = ra0; *(bf16x8*)(As + (lr + 64) * GS_LD + kc * 8) = ra1;
        *(bf16x8*)(Bs + lr * GS_LD + kc * 8) = rb0; *(bf16x8*)(Bs + (lr + 64) * GS_LD + kc * 8) = rb1;
        __syncthreads();
        if (k0 + 64 < K) {
            const int kn = k0 + 64 + kc * 8;
            ra0 = al(row0 + lr, kn); ra1 = al(row0 + lr + 64, kn);
            rb0 = *(const bf16x8*)(Bt + (size_t)(col0 + lr) * ldb + kn); rb1 = *(const bf16x8*)(Bt + (size_t)(col0 + lr + 64) * ldb + kn);
        }
#pragma unroll
        for (int ks = 0; ks < 2; ++ks) {
            bf16x8 a[2], b[4];
#pragma unroll
            for (int m = 0; m < 2; ++m) a[m] = *(const bf16x8*)(As + (wr * 32 + m * 16 + fr) * GS_LD + ks * 32 + fq * 8);
#pragma unroll
            for (int n = 0; n < 4; ++n) b[n] = *(const bf16x8*)(Bs + (wc * 64 + n * 16 + fr) * GS_LD + ks * 32 + fq * 8);
#pragma unroll
            for (int m = 0; m < 2; ++m)
#pragma unroll
                for (int n = 0; n < 4; ++n) acc[m][n] = __builtin_amdgcn_mfma_f32_16x16x32_bf16(b[n], a[m], acc[m][n], 0, 0, 0);
        }
    }
#pragma unroll
    for (int m = 0; m < 2; ++m)
#pragma unroll
        for (int n = 0; n < 4; ++n) ep(row0 + wr * 32 + m * 16 + fr, col0 + wc * 64 + n * 16 + fq * 4, acc[m][n]);
}

struct PlainLoader {
    const bf16_t* A; int lda;
    __device__ __forceinline__ bf16x8 operator()(int row, int k) const { return *(const bf16x8*)(A + (size_t)row * lda + k); }
    struct Raw { u32x4 h; };
    struct RawK { int dummy; };
    __device__ __forceinline__ void loadk(int k, RawK& r) const { r.dummy = 0; }
    __device__ __forceinline__ void load(int row, int k, Raw& r) const { r.h = *(const u32x4*)(A + (size_t)row * lda + k); }
    __device__ __forceinline__ bf16x8 finish(const Raw& r, const RawK&) const { return __builtin_bit_cast(bf16x8, r.h); }
};
struct MixLoader {
    const bf16_t* H; const float* mix;
    __device__ __forceinline__ bf16x8 operator()(int row, int k) const {
        int nb;
        if (row < NLAT) {
            const int t = row & (TL - 1), gc = t & 63, gr = t >> 6, q = k >> 8;
            if (q == 0) nb = gc > 0 ? row - 1 : -1;
            else if (q == 1) nb = gc < 63 ? row + 1 : -1;
            else if (q == 2) nb = gr > 0 ? row - 64 : -1;
            else nb = gr < 63 ? row + 64 : -1;
        } else {
            const int t = (row - NLAT) & (TC - 1);
            if (k < 512) nb = t > 0 ? row - 1 : -1;
            else nb = t < TC - 1 ? row + 1 : -1;
        }
        const u32x4 h = *(const u32x4*)(H + (size_t)row * D + k);
        u32x4 s = (u32x4){0u, 0u, 0u, 0u};
        if (nb >= 0) s = *(const u32x4*)(H + (size_t)nb * D + k);
        const float4 m0 = *(const float4*)(mix + k), m1 = *(const float4*)(mix + k + 4);
        u32x4 o;
        { float a = bflo(h[0]), b = bfhi(h[0]); o[0] = pack2(a + (bflo(s[0]) - a) * m0.x, b + (bfhi(s[0]) - b) * m0.y); }
        { float a = bflo(h[1]), b = bfhi(h[1]); o[1] = pack2(a + (bflo(s[1]) - a) * m0.z, b + (bfhi(s[1]) - b) * m0.w); }
        { float a = bflo(h[2]), b = bfhi(h[2]); o[2] = pack2(a + (bflo(s[2]) - a) * m1.x, b + (bfhi(s[2]) - b) * m1.y); }
        { float a = bflo(h[3]), b = bfhi(h[3]); o[3] = pack2(a + (bflo(s[3]) - a) * m1.z, b + (bfhi(s[3]) - b) * m1.w); }
        return __builtin_bit_cast(bf16x8, o);
    }
    struct Raw { u32x4 h, s; };
    struct RawK { float4 m0, m1; };
    __device__ __forceinline__ void loadk(int k, RawK& r) const { r.m0 = *(const float4*)(mix + k); r.m1 = *(const float4*)(mix + k + 4); }
    __device__ __forceinline__ void load(int row, int k, Raw& r) const {
        int nb;
        if (row < NLAT) {
            const int t = row & (TL - 1), gc = t & 63, gr = t >> 6, q = k >> 8;
            if (q == 0) nb = gc > 0 ? row - 1 : -1;
            else if (q == 1) nb = gc < 63 ? row + 1 : -1;
            else if (q == 2) nb = gr > 0 ? row - 64 : -1;
            else nb = gr < 63 ? row + 64 : -1;
        } else {
            const int t = (row - NLAT) & (TC - 1);
            if (k < 512) nb = t > 0 ? row - 1 : -1;
            else nb = t < TC - 1 ? row + 1 : -1;
        }
        r.h = *(const u32x4*)(H + (size_t)row * D + k);
        r.s = (u32x4){0u, 0u, 0u, 0u};
        if (nb >= 0) r.s = *(const u32x4*)(H + (size_t)nb * D + k);
    }
    __device__ __forceinline__ bf16x8 finish(const Raw& r, const RawK& c) const {
        u32x4 o;
        { float a = bflo(r.h[0]), b = bfhi(r.h[0]); o[0] = pack2(a + (bflo(r.s[0]) - a) * c.m0.x, b + (bfhi(r.s[0]) - b) * c.m0.y); }
        { float a = bflo(r.h[1]), b = bfhi(r.h[1]); o[1] = pack2(a + (bflo(r.s[1]) - a) * c.m0.z, b + (bfhi(r.s[1]) - b) * c.m0.w); }
        { float a = bflo(r.h[2]), b = bfhi(r.h[2]); o[2] = pack2(a + (bflo(r.s[2]) - a) * c.m1.x, b + (bfhi(r.s[2]) - b) * c.m1.y); }
        { float a = bflo(r.h[3]), b = bfhi(r.h[3]); o[3] = pack2(a + (bflo(r.s[3]) - a) * c.m1.z, b + (bfhi(r.s[3]) - b) * c.m1.w); }
        return __builtin_bit_cast(bf16x8, o);
    }
};

__device__ __forceinline__ void lds_barrier() { asm volatile("s_waitcnt lgkmcnt(0)\n\ts_barrier" ::: "memory"); }
template <class AL, class EP>
__device__ __forceinline__ void gemm_tile_small2(char* lds, const AL& al, const bf16_t* __restrict__ Bt, int ldb, int K, int row0, int col0, const EP& ep) {
    bf16_t* As0 = (bf16_t*)lds;
    const int tid = tidx(), lane = tid & 63, wid = tid >> 6, wr = wid >> 1, wc = wid & 1, fr = lane & 15, fq = lane >> 4;
    const int lr = tid >> 3, kc = tid & 7;
    constexpr int PD = 4;
    f32x4 acc[2][4];
#pragma unroll
    for (int m = 0; m < 2; ++m)
#pragma unroll
        for (int n = 0; n < 4; ++n) acc[m][n] = (f32x4){0.f, 0.f, 0.f, 0.f};
    typename AL::Raw qa0[PD], qa1[PD]; typename AL::RawK qk[PD]; u32x4 qb0[PD], qb1[PD];
    const int nsteps = K / 64;
#define GTS2_ISSUE(SLOT, STEP) do { const int kn_ = (STEP) * 64 + kc * 8; al.loadk(kn_, qk[SLOT]); al.load(row0 + lr, kn_, qa0[SLOT]); al.load(row0 + lr + 64, kn_, qa1[SLOT]); \
        qb0[SLOT] = *(const u32x4*)(Bt + (size_t)(col0 + lr) * ldb + kn_); qb1[SLOT] = *(const u32x4*)(Bt + (size_t)(col0 + lr + 64) * ldb + kn_); } while (0)
#pragma unroll
    for (int d = 0; d < PD; ++d) GTS2_ISSUE(d, d);
    for (int s0 = 0; s0 < nsteps; s0 += PD) {
#pragma unroll
        for (int d = 0; d < PD; ++d) {
            const int step = s0 + d;
            bf16_t* As = As0 + (d & 1) * (256 * GS_LD); bf16_t* Bs = As + 128 * GS_LD;
            *(bf16x8*)(As + lr * GS_LD + kc * 8) = al.finish(qa0[d], qk[d]); *(bf16x8*)(As + (lr + 64) * GS_LD + kc * 8) = al.finish(qa1[d], qk[d]);
            *(u32x4*)(Bs + lr * GS_LD + kc * 8) = qb0[d]; *(u32x4*)(Bs + (lr + 64) * GS_LD + kc * 8) = qb1[d];
            lds_barrier();
            if (step + PD < nsteps) GTS2_ISSUE(d, step + PD);
#pragma unroll
            for (int ks = 0; ks < 2; ++ks) {
                bf16x8 a[2], b[4];
#pragma unroll
                for (int m = 0; m < 2; ++m) a[m] = *(const bf16x8*)(As + (wr * 32 + m * 16 + fr) * GS_LD + ks * 32 + fq * 8);
#pragma unroll
                for (int n = 0; n < 4; ++n) b[n] = *(const bf16x8*)(Bs + (wc * 64 + n * 16 + fr) * GS_LD + ks * 32 + fq * 8);
#pragma unroll
                for (int m = 0; m < 2; ++m)
#pragma unroll
                    for (int n = 0; n < 4; ++n) acc[m][n] = __builtin_amdgcn_mfma_f32_16x16x32_bf16(b[n], a[m], acc[m][n], 0, 0, 0);
            }
        }
    }
#undef GTS2_ISSUE
#pragma unroll
    for (int m = 0; m < 2; ++m)
#pragma unroll
        for (int n = 0; n < 4; ++n) ep(row0 + wr * 32 + m * 16 + fr, col0 + wc * 64 + n * 16 + fq * 4, acc[m][n]);
}

struct EpStoreBf16 {
    bf16_t* O; int ldo; int act;
    __device__ __forceinline__ void operator()(int row, int col, f32x4 v) const {
        if (act == 1) { v[0] = tanhf(v[0]); v[1] = tanhf(v[1]); v[2] = tanhf(v[2]); v[3] = tanhf(v[3]); }
        else if (act == 2) { v[0] = sigmoidf_(v[0]); v[1] = sigmoidf_(v[1]); v[2] = sigmoidf_(v[2]); v[3] = sigmoidf_(v[3]); }
        u32x2 o; o[0] = pack2(v[0], v[1]); o[1] = pack2(v[2], v[3]);
        *(u32x2*)(O + (size_t)row * ldo + col) = o;
    }
};
struct EpDecay {
    bf16_t* O; const float* w0;
    __device__ __forceinline__ void operator()(int row, int col, f32x4 v) const {
        const float4 b = *(const float4*)(w0 + col);
        u32x2 o;
        o[0] = pack2(-0.6065306597f * sigmoidf_(v[0] + b.x), -0.6065306597f * sigmoidf_(v[1] + b.y));
        o[1] = pack2(-0.6065306597f * sigmoidf_(v[2] + b.z), -0.6065306597f * sigmoidf_(v[3] + b.w));
        *(u32x2*)(O + (size_t)row * D + col) = o;
    }
};
struct EpSigBias {
    bf16_t* O; const float* b0;
    __device__ __forceinline__ void operator()(int row, int col, f32x4 v) const {
        const float4 b = *(const float4*)(b0 + col);
        u32x2 o;
        o[0] = pack2(sigmoidf_(v[0] + b.x), sigmoidf_(v[1] + b.y));
        o[1] = pack2(sigmoidf_(v[2] + b.z), sigmoidf_(v[3] + b.w));
        *(u32x2*)(O + (size_t)row * D + col) = o;
    }
};
struct EpVres {
    bf16_t* VF; const bf16_t* VRAW; const float* v0;
    __device__ __forceinline__ void operator()(int row, int col, f32x4 a) const {
        const float4 b = *(const float4*)(v0 + col);
        const u32x2 vr = *(const u32x2*)(VRAW + (size_t)row * D + col);
        const u32x2 vf = *(const u32x2*)(VF + (size_t)row * D + col);
        float x0 = bflo(vr[0]), x1 = bfhi(vr[0]), x2 = bflo(vr[1]), x3 = bfhi(vr[1]);
        float f0 = bflo(vf[0]), f1 = bfhi(vf[0]), f2 = bflo(vf[1]), f3 = bfhi(vf[1]);
        u32x2 o;
        o[0] = pack2(x0 + (f0 - x0) * sigmoidf_(a[0] + b.x), x1 + (f1 - x1) * sigmoidf_(a[1] + b.y));
        o[1] = pack2(x2 + (f2 - x2) * sigmoidf_(a[2] + b.z), x3 + (f3 - x3) * sigmoidf_(a[3] + b.w));
        *(u32x2*)(VF + (size_t)row * D + col) = o;
    }
};
struct EpResidual {
    float* X; const float* gate; const float* cscale; float amp;
    const float* xin; const float* cin;
    __device__ __forceinline__ void operator()(int row, int col, f32x4 a) const {
        const float4 gt = *(const float4*)(gate + (size_t)mod_row(row) * MODW + col);
        float4 cs = make_float4(amp, amp, amp, amp);
        if (cscale) { const float4 t = *(const float4*)(cscale + col); cs.x *= t.x; cs.y *= t.y; cs.z *= t.z; cs.w *= t.w; }
        float4* xp = (float4*)(X + (size_t)row * D + col);
        const float4* sp = xin ? (const float4*)((row < NLAT ? xin + (size_t)row * D : cin + (size_t)(row - NLAT) * D) + col) : (const float4*)xp;
        float4 x = *sp;
        x.x += gt.x * a[0] * cs.x; x.y += gt.y * a[1] * cs.y; x.z += gt.z * a[2] * cs.z; x.w += gt.w * a[3] * cs.w;
        *xp = x;
    }
};
struct EpD1 {
    bf16_t* D1; const float* cscale;
    __device__ __forceinline__ void operator()(int row, int col, f32x4 a, f32x4 b) const {
        if (cscale) { const float4 s0 = *(const float4*)(cscale + col), s1 = *(const float4*)(cscale + col + 4);
            a[0] *= s0.x; a[1] *= s0.y; a[2] *= s0.z; a[3] *= s0.w; b[0] *= s1.x; b[1] *= s1.y; b[2] *= s1.z; b[3] *= s1.w; }
        const u32x4 o = {pack2(a[0], a[1]), pack2(a[2], a[3]), pack2(b[0], b[1]), pack2(b[2], b[3])};
        *(u32x4*)(D1 + (size_t)row * D + col) = o;
    }
};
struct EpSwiglu {
    bf16_t* HID;
    __device__ __forceinline__ void operator()(int row, int col, f32x4 a) const {
        *(unsigned*)(HID + (size_t)row * FF + (col >> 1)) = pack2(siluf_(a[0]) * a[1], siluf_(a[2]) * a[3]);
    }
    __device__ __forceinline__ void operator()(int row, int col, f32x4 a, f32x4 b) const {
        const f32x2_t g0 = {a[0], a[2]}, u0 = {a[1], a[3]}, g1 = {b[0], b[2]}, u1 = {b[1], b[3]};
        const f32x2_t t0 = g0 * -1.44269504089f, t1 = g1 * -1.44269504089f;
        f32x2_t e0, e1; e0.x = __builtin_amdgcn_exp2f(t0.x); e0.y = __builtin_amdgcn_exp2f(t0.y); e1.x = __builtin_amdgcn_exp2f(t1.x); e1.y = __builtin_amdgcn_exp2f(t1.y);
        const f32x2_t d0 = e0 + 1.0f, d1 = e1 + 1.0f;
        f32x2_t r0, r1; r0.x = __builtin_amdgcn_rcpf(d0.x); r0.y = __builtin_amdgcn_rcpf(d0.y); r1.x = __builtin_amdgcn_rcpf(d1.x); r1.y = __builtin_amdgcn_rcpf(d1.y);
        const f32x2_t h0 = (g0 * u0) * r0, h1 = (g1 * u1) * r1;
        const u32x2 o = {pack2(h0.x, h0.y), pack2(h1.x, h1.y)};
        *(u32x2*)(HID + (size_t)row * FF + (col >> 1)) = o;
    }
};
struct EpSwiglu8 {
    char* HID;
    __device__ __forceinline__ void operator()(int row, int col, f32x4 a) const {
        int w = 0; w = __builtin_amdgcn_cvt_pk_fp8_f32(siluf_(a[0]) * a[1], siluf_(a[2]) * a[3], w, false);
        *(unsigned short*)(HID + (size_t)row * FF + (col >> 1)) = (unsigned short)w;
    }
    __device__ __forceinline__ void operator()(int row, int col, f32x4 a, f32x4 b) const {
        const f32x2_t g0 = {a[0], a[2]}, u0 = {a[1], a[3]}, g1 = {b[0], b[2]}, u1 = {b[1], b[3]};
        const f32x2_t t0 = g0 * -1.44269504089f, t1 = g1 * -1.44269504089f;
        f32x2_t e0, e1; e0.x = __builtin_amdgcn_exp2f(t0.x); e0.y = __builtin_amdgcn_exp2f(t0.y); e1.x = __builtin_amdgcn_exp2f(t1.x); e1.y = __builtin_amdgcn_exp2f(t1.y);
        const f32x2_t d0 = e0 + 1.0f, d1 = e1 + 1.0f;
        f32x2_t r0, r1; r0.x = __builtin_amdgcn_rcpf(d0.x); r0.y = __builtin_amdgcn_rcpf(d0.y); r1.x = __builtin_amdgcn_rcpf(d1.x); r1.y = __builtin_amdgcn_rcpf(d1.y);
        const f32x2_t h0 = (g0 * u0) * r0, h1 = (g1 * u1) * r1;
        int w = 0;
        w = __builtin_amdgcn_cvt_pk_fp8_f32(h0.x, h0.y, w, false);
        w = __builtin_amdgcn_cvt_pk_fp8_f32(h1.x, h1.y, w, true);
        *(unsigned*)(HID + (size_t)row * FF + (col >> 1)) = (unsigned)w;
    }
};
struct EpGateRow {
    bf16_t* YS; const float* gatev;
    __device__ __forceinline__ void operator()(int row, int col, f32x4 a) const {
        const float gt = gatev[row];
        u32x2 o; o[0] = pack2(a[0] * gt, a[1] * gt); o[1] = pack2(a[2] * gt, a[3] * gt);
        *(u32x2*)(YS + (size_t)row * D + col) = o;
    }
    __device__ __forceinline__ void operator()(int row, int col, f32x4 a, f32x4 b) const {
        const float gt = gatev[row];
        const u32x4 o = {pack2(a[0] * gt, a[1] * gt), pack2(a[2] * gt, a[3] * gt), pack2(b[0] * gt, b[1] * gt), pack2(b[2] * gt, b[3] * gt)};
        *(u32x4*)(YS + (size_t)row * D + col) = o;
    }
};

#define LAS __attribute__((address_space(3)))
namespace g256 {
constexpr int BM = 256, BK = 64, HALF = 128, HTB = HALF * BK * 2, STAGE_BYTES = 8 * HTB;
__device__ __forceinline__ int lds_byte(int r, int c) { const int st = (r >> 4) * 2 + (c >> 5), rr = r & 15, cc = c & 31, ob = rr * 64 + cc * 2; return st * 1024 + (ob ^ (((ob >> 9) & 1) << 5)); }
__device__ __forceinline__ void stage_rc(int b, int& R, int& C) { const int st = b / 1024, sb = b % 1024, swz = sb ^ (((sb >> 9) & 1) << 5); R = (st >> 1) * 16 + swz / 64; C = (st & 1) * 32 + (swz % 64) / 2; }
struct Unit { const char* a; const char* b; int row0, col0; };
typedef int i32x4_t __attribute__((ext_vector_type(4)));
typedef int i32x8_t __attribute__((ext_vector_type(8)));
__device__ __forceinline__ i32x8_t cat8(bf16x8 lo, bf16x8 hi) { return __builtin_shufflevector(__builtin_bit_cast(i32x4_t, lo), __builtin_bit_cast(i32x4_t, hi), 0, 1, 2, 3, 4, 5, 6, 7); }

__device__ __forceinline__ int perm32(int rho) { const int n = rho >> 4, i = rho & 15; return 8 * (i >> 2) + 4 * n + (i & 3); }
template <bool PERM, bool F8 = false, bool GATHER = false, class Sched, class Ep>
__device__ __forceinline__ void gemm_phase(LAS unsigned char* lds, const int lda, const int ldb, const int K, const Sched& S, const Ep& E) {
    const int tid = tidx(), wid = __builtin_amdgcn_readfirstlane(tid >> 6), lane = tid & 63, wr = wid >> 2, wc = wid & 3, fr = lane & 15, fq = lane >> 4;
    const int nt = K / BK;
    int scw = 0x79797979, sca = 0x7F7F7F7F;
    if constexpr (F8) asm volatile("" : "+v"(scw), "+v"(sca));
    unsigned voffA[2], voffB[2], cbA[2];
#pragma unroll
    for (int i = 0; i < 2; ++i) { int R, C; stage_rc(tid * 16 + i * 8192, R, C); const int Rb = PERM ? ((R & ~31) + perm32(R & 31)) : R; voffA[i] = GATHER ? (unsigned)(R * 4) : (unsigned)(R * lda + C) * 2u; voffB[i] = (unsigned)(Rb * ldb + C) * 2u; cbA[i] = (unsigned)C * 2u; }
    LAS unsigned char* tokl = lds + LDS_TOK;
    unsigned gc[2][2], gn[2][2];
    const unsigned rowb = (unsigned)lda * 2u;
    const size_t kstep = (size_t)(BK * 2);
    const size_t hstepA = (size_t)HALF * lda * 2, hstepB = (size_t)HALF * ldb * 2;
    const unsigned ldsw = (unsigned)wid * 1024u;
    const int aoff = lds_byte(wr * 64 + fr, fq * 8), boff = lds_byte(wc * 32 + fr, fq * 8);
#define PG8_SA(b, h) (((b) * 2 + (h)) * HTB)
#define PG8_SB(b, h) ((4 + (b) * 2 + (h)) * HTB)
#define PG8_STAGE(bufoff, gbase, voff) do { _Pragma("unroll") for (int _i = 0; _i < 2; ++_i) \
        __builtin_amdgcn_global_load_lds((const unsigned*)((const char*)(gbase) + (voff)[_i]), (LAS unsigned*)(lds + (bufoff) + ldsw + _i * 8192), 16, 0, 0); } while (0)
#define PG8_STAGE_A(bufoff, ptr, h, goffs, koff) do { if constexpr (GATHER) { _Pragma("unroll") for (int _i = 0; _i < 2; ++_i) \
        __builtin_amdgcn_global_load_lds((const unsigned*)(S.abase + (size_t)(koff) + (goffs)[h][_i]), (LAS unsigned*)(lds + (bufoff) + ldsw + _i * 8192), 16, 0, 0); } \
        else PG8_STAGE(bufoff, ptr, voffA); } while (0)
#define PG8_LDA(dst, b, h) do { _Pragma("unroll") for (int m = 0; m < 4; ++m) _Pragma("unroll") for (int k = 0; k < 2; ++k) dst[m][k] = *(const LAS bf16x8*)(lds + PG8_SA(b, h) + aoff + m * 2048 + k * 1024); } while (0)
#define PG8_LDB(dst, b, h) do { _Pragma("unroll") for (int n = 0; n < 2; ++n) _Pragma("unroll") for (int k = 0; k < 2; ++k) dst[n][k] = *(const LAS bf16x8*)(lds + PG8_SB(b, h) + boff + n * 2048 + k * 1024); } while (0)
#define PG8_MMA(ai, bj, At, Bt) do { __builtin_amdgcn_s_setprio(1); _Pragma("unroll") for (int m = 0; m < 4; ++m) _Pragma("unroll") for (int n = 0; n < 2; ++n) { \
        if constexpr (F8) asm volatile("v_mfma_scale_f32_16x16x128_f8f6f4 %0, %1, %2, %0, %3, %4 op_sel_hi:[0,0,0]" : "+v"(acc[ai][bj][m][n]) : "v"(cat8(Bt[n][0], Bt[n][1])), "v"(cat8(At[m][0], At[m][1])), "v"(scw), "v"(sca)); \
        else { _Pragma("unroll") for (int k = 0; k < 2; ++k) acc[ai][bj][m][n] = __builtin_amdgcn_mfma_f32_16x16x32_bf16(Bt[n][k], At[m][k], acc[ai][bj][m][n], 0, 0, 0); } } \
        __builtin_amdgcn_s_setprio(0); } while (0)
#define PG8_WAIT_V(n) asm volatile("s_waitcnt vmcnt(" #n ")" ::: "memory")
#define PG8_WAIT_L(n) asm volatile("s_waitcnt lgkmcnt(" #n ")" ::: "memory")
#define PG8_BAR __builtin_amdgcn_s_barrier()
#define PG8_SCHED __builtin_amdgcn_sched_barrier(0)
    Unit cur, nxt; int ui = 0;
    if (!S.next(0, cur)) return;
    f32x4 acc[2][2][4][2];
#pragma unroll
    for (int a = 0; a < 2; ++a)
#pragma unroll
        for (int b = 0; b < 2; ++b)
#pragma unroll
            for (int m = 0; m < 4; ++m)
#pragma unroll
                for (int n = 0; n < 2; ++n) acc[a][b][m][n] = (f32x4){0.f, 0.f, 0.f, 0.f};
    bf16x8 At[4][2], B0[2][2], B1[2][2];
    const char* cA = cur.a; const char* cB = cur.b;
    if constexpr (GATHER) {
        if (tid < 256) *(LAS unsigned*)(tokl + tid * 4) = (unsigned)S.tok[cur.row0 + tid];
        __syncthreads();
#pragma unroll
        for (int h = 0; h < 2; ++h)
#pragma unroll
            for (int i = 0; i < 2; ++i) { gc[h][i] = *(const LAS unsigned*)(tokl + h * 512 + voffA[i]) * rowb + cbA[i]; gn[h][i] = gc[h][i]; }
        __syncthreads();
    }
    PG8_STAGE(PG8_SB(0, 0), cB, voffB); PG8_STAGE_A(PG8_SA(0, 0), cA, 0, gc, 0); PG8_STAGE(PG8_SB(0, 1), cB + hstepB, voffB); PG8_STAGE_A(PG8_SA(0, 1), cA + hstepA, 1, gc, 0);
    if (wr == 1) PG8_BAR;
    PG8_WAIT_V(4); PG8_BAR;
    PG8_STAGE(PG8_SB(1, 0), cB + kstep, voffB); PG8_STAGE_A(PG8_SA(1, 0), cA + kstep, 0, gc, kstep); PG8_STAGE(PG8_SB(1, 1), cB + hstepB + kstep, voffB);
    PG8_WAIT_V(6); PG8_BAR;
    for (;;) {
        const bool has_next = S.next(ui + 1, nxt);
        const char* nA = has_next ? nxt.a : cA; const char* nB = has_next ? nxt.b : cB;
        if constexpr (GATHER) {
            if (has_next && wid < 4) __builtin_amdgcn_global_load_lds((const unsigned*)(S.tok + nxt.row0 + tid), (LAS unsigned*)(tokl + wid * 256), 4, 0, 0);
        }
#pragma unroll 1
        for (int t = 0; t < nt; t += 2) {
            const bool last = (t == nt - 2);
            const char* a1 = cA + (size_t)(t + 1) * kstep;
            const char* a2 = last ? nA : cA + (size_t)(t + 2) * kstep; const char* b2 = last ? nB : cB + (size_t)(t + 2) * kstep;
            const char* a3 = a2 + kstep; const char* b3 = b2 + kstep;
            const size_t k1 = (size_t)(t + 1) * kstep, k2 = last ? (size_t)0 : (size_t)(t + 2) * kstep;
            unsigned o2[2][2];
            if constexpr (GATHER) {
                if (last && has_next) {
#pragma unroll
                    for (int h = 0; h < 2; ++h)
#pragma unroll
                        for (int i = 0; i < 2; ++i) gn[h][i] = *(const LAS unsigned*)(tokl + h * 512 + voffA[i]) * rowb + cbA[i];
                }
#pragma unroll
                for (int h = 0; h < 2; ++h)
#pragma unroll
                    for (int i = 0; i < 2; ++i) o2[h][i] = last ? gn[h][i] : gc[h][i];
            }
            PG8_LDB(B0, 0, 0); PG8_SCHED; PG8_LDA(At, 0, 0); PG8_STAGE_A(PG8_SA(1, 1), a1 + hstepA, 1, gc, k1);
            PG8_WAIT_L(8); PG8_BAR; PG8_WAIT_L(0); PG8_MMA(0, 0, At, B0); PG8_BAR; PG8_SCHED;
            PG8_LDB(B1, 0, 1); PG8_STAGE(PG8_SB(0, 0), b2, voffB);
            PG8_BAR; PG8_WAIT_L(0); PG8_MMA(0, 1, At, B1); PG8_BAR;
            PG8_LDA(At, 0, 1); PG8_STAGE_A(PG8_SA(0, 0), a2, 0, o2, k2);
            PG8_BAR; PG8_WAIT_L(0); PG8_MMA(1, 0, At, B0); PG8_BAR; PG8_SCHED;
            PG8_STAGE(PG8_SB(0, 1), b2 + hstepB, voffB);
            PG8_WAIT_V(6); PG8_BAR; PG8_MMA(1, 1, At, B1); PG8_BAR;
            PG8_LDB(B0, 1, 0); PG8_SCHED; PG8_LDA(At, 1, 0); PG8_STAGE_A(PG8_SA(0, 1), a2 + hstepA, 1, o2, k2);
            PG8_WAIT_L(8); PG8_BAR; PG8_WAIT_L(0); PG8_MMA(0, 0, At, B0); PG8_BAR; PG8_SCHED;
            PG8_LDB(B1, 1, 1); PG8_STAGE(PG8_SB(1, 0), b3, voffB);
            PG8_BAR; PG8_WAIT_L(0); PG8_MMA(0, 1, At, B1); PG8_BAR;
            PG8_LDA(At, 1, 1); PG8_STAGE_A(PG8_SA(1, 0), a3, 0, o2, k2 + kstep);
            PG8_BAR; PG8_WAIT_L(0); PG8_MMA(1, 0, At, B0); PG8_BAR; PG8_SCHED;
            PG8_STAGE(PG8_SB(1, 1), b3 + hstepB, voffB);
            PG8_WAIT_V(6); PG8_BAR; PG8_MMA(1, 1, At, B1); PG8_BAR;
        }
        if constexpr (F8) {
            asm volatile("s_nop 15\n\ts_nop 7" ::: "memory");
#pragma unroll
            for (int a = 0; a < 2; ++a)
#pragma unroll
                for (int b = 0; b < 2; ++b)
#pragma unroll
                    for (int m = 0; m < 4; ++m)
#pragma unroll
                        for (int n = 0; n < 2; ++n) asm volatile("" : "+v"(acc[a][b][m][n]));
        }
#pragma unroll
        for (int ai = 0; ai < 2; ++ai)
#pragma unroll
            for (int m = 0; m < 4; ++m)
#pragma unroll
                for (int bj = 0; bj < 2; ++bj) {
                    if constexpr (PERM) E(cur.row0 + ai * HALF + wr * 64 + m * 16 + fr, cur.col0 + bj * HALF + wc * 32 + 8 * fq, acc[ai][bj][m][0], acc[ai][bj][m][1]);
                    else {
#pragma unroll
                        for (int n = 0; n < 2; ++n) E(cur.row0 + ai * HALF + wr * 64 + m * 16 + fr, cur.col0 + bj * HALF + wc * 32 + n * 16 + 4 * fq, acc[ai][bj][m][n]);
                    }
                }
        if (!has_next) break;
#pragma unroll
        for (int a = 0; a < 2; ++a)
#pragma unroll
            for (int b = 0; b < 2; ++b)
#pragma unroll
                for (int m = 0; m < 4; ++m)
#pragma unroll
                    for (int n = 0; n < 2; ++n) acc[a][b][m][n] = (f32x4){0.f, 0.f, 0.f, 0.f};
        cur = nxt; cA = nA; cB = nB; ++ui;
        if constexpr (GATHER) {
#pragma unroll
            for (int h = 0; h < 2; ++h)
#pragma unroll
                for (int i = 0; i < 2; ++i) gc[h][i] = gn[h][i];
        }
    }
    PG8_WAIT_V(0);
    if (wr == 0) PG8_BAR;
    PG8_BAR;
#undef PG8_SA
#undef PG8_SB
#undef PG8_STAGE
#undef PG8_STAGE_A
#undef PG8_LDA
#undef PG8_LDB
#undef PG8_MMA
#undef PG8_WAIT_V
#undef PG8_WAIT_L
#undef PG8_BAR
#undef PG8_SCHED
}
__device__ __forceinline__ long unit_index(int i) {
    const int G = gridDim.x, c = blockIdx.x;
    if (G == 256) return ((long)i * 8 + (c & 7)) * 32 + (c >> 3);
    return (long)i * G + c;
}
}

__device__ __forceinline__ const bf16_t* wsm(const Params& p, int j, size_t off) { return (const bf16_t*)(p.ws + OFF_WSM) + (size_t)j * WJ_SIZE + off; }

__device__ __forceinline__ void phase_mix(const Params& p, int j) {
    const bf16_t* H = (const bf16_t*)(p.ws + OFF_H);
    const float* mix = p.in[8] + (size_t)j * 6 * D;
    bf16_t* XM = (bf16_t*)(p.ws + OFF_LW);
    const int tid_ = tidx(), lane = tid_ & 63, wid = tid_ >> 6;
    for (int cc = 0; cc < 2; ++cc) {
        const int k = cc * 512 + lane * 8;
        float m[3][8];
#pragma unroll
        for (int w = 0; w < 3; ++w) {
            const int mi = w == 0 ? 0 : (w == 1 ? 2 : 3);
            const float4 m0 = *(const float4*)(mix + mi * D + k), m1 = *(const float4*)(mix + mi * D + k + 4);
            m[w][0] = m0.x; m[w][1] = m0.y; m[w][2] = m0.z; m[w][3] = m0.w; m[w][4] = m1.x; m[w][5] = m1.y; m[w][6] = m1.z; m[w][7] = m1.w;
        }
        const int q = k >> 8;
        for (int grp = blockIdx.x * 8 + wid; grp < NT / 4; grp += gridDim.x * 8) {
            u32x4 h[4], s[4];
#pragma unroll
            for (int r = 0; r < 4; ++r) {
                const int row = grp * 4 + r;
                int nb;
                if (row < NLAT) {
                    const int t = row & (TL - 1), gc = t & 63, gr = t >> 6;
                    if (q == 0) nb = gc > 0 ? row - 1 : -1;
                    else if (q == 1) nb = gc < 63 ? row + 1 : -1;
                    else if (q == 2) nb = gr > 0 ? row - 64 : -1;
                    else nb = gr < 63 ? row + 64 : -1;
                } else {
                    const int t = (row - NLAT) & (TC - 1);
                    if (k < 512) nb = t > 0 ? row - 1 : -1;
                    else nb = t < TC - 1 ? row + 1 : -1;
                }
                h[r] = *(const u32x4*)(H + (size_t)row * D + k);
                s[r] = (u32x4){0u, 0u, 0u, 0u};
                if (nb >= 0) s[r] = *(const u32x4*)(H + (size_t)nb * D + k);
            }
#pragma unroll
            for (int r = 0; r < 4; ++r) {
                const int row = grp * 4 + r;
#pragma unroll
                for (int w = 0; w < 3; ++w) {
                    u32x4 o;
#pragma unroll
                    for (int e = 0; e < 4; ++e) {
                        const float x = bflo(h[r][e]), y = bfhi(h[r][e]);
                        o[e] = pack2(x + (bflo(s[r][e]) - x) * m[w][2 * e], y + (bfhi(s[r][e]) - y) * m[w][2 * e + 1]);
                    }
                    *(u32x4*)(XM + (size_t)w * NT * D + (size_t)row * D + k) = o;
                }
            }
        }
    }
}

struct SchedGrid {
    const char* A; const char* B; size_t a_mat, b_mat, a_rt, a_ct, b_ct; int cpm, total;
    __device__ __forceinline__ bool next(int i, g256::Unit& u) const {
        const long L = g256::unit_index(i);
        if (L >= total) return false;
        const int chunk = (int)(L >> 5), o = (int)(L & 31), mat = chunk / cpm, ch = chunk % cpm, rt = ch * 8 + (o >> 2), ct = o & 3;
        u.a = A + (size_t)mat * a_mat + (size_t)rt * a_rt + (size_t)ct * a_ct; u.b = B + (size_t)mat * b_mat + (size_t)ct * b_ct;
        u.row0 = rt * 256; u.col0 = mat * 1024 + ct * 256;
        return true;
    }
};
struct EpRKV {
    bf16_t* R; long vdelta;
    __device__ __forceinline__ void operator()(int row, int col, f32x4 v) const {
        const int mat = col >> 10, c = col & 1023;
        bf16_t* O = R + (size_t)mat * NT * D + (mat == 2 ? vdelta : 0l);
        u32x2 o; o[0] = pack2(v[0], v[1]); o[1] = pack2(v[2], v[3]);
        *(u32x2*)(O + (size_t)row * D + c) = o;
    }
    __device__ __forceinline__ void operator()(int row, int col, f32x4 v, f32x4 w) const {
        const int mat = col >> 10, c = col & 1023;
        bf16_t* O = R + (size_t)mat * NT * D + (mat == 2 ? vdelta : 0l);
        const u32x4 o = {pack2(v[0], v[1]), pack2(v[2], v[3]), pack2(w[0], w[1]), pack2(w[2], w[3])};
        *(u32x4*)(O + (size_t)row * D + c) = o;
    }
};

__device__ __forceinline__ void phase_rwkv_proj(const Params& p, int j, char* lds) {
    const bf16_t* H = (const bf16_t*)(p.ws + OFF_H);
    const float* mix = p.in[8] + (size_t)j * 6 * D;
    bf16_t* R = (bf16_t*)(p.ws + OFF_R);
    bf16_t* V = (bf16_t*)(p.ws + (j == 0 ? OFF_VF : OFF_Y));
    bf16_t* LD = (bf16_t*)(p.ws + OFF_LD);
    const bf16_t* XM = (const bf16_t*)(p.ws + OFF_LW);
    {
        SchedGrid S{(const char*)XM, (const char*)wsm(p, j, WJ_RKV), (size_t)NT * D * 2, (size_t)D * D * 2, (size_t)256 * D * 2, 0, (size_t)256 * D * 2, NT / 256 / 8, 3 * (NT / 256) * 4};
        EpRKV E{R, (long)(V - (R + (size_t)2 * NT * D))};
        g256::gemm_phase<true>((LAS unsigned char*)lds, D, D, D, S, E);
    }
    constexpr int RT = NT / 128;
    const int nsmall = (j == 0 ? 3 : 4) * RT;
    for (int u = blockIdx.x; u < nsmall; u += gridDim.x) {
        const int which = u / RT, rt = u % RT;
        EpStoreBf16 ep{LD + (size_t)which * NT * 128, 128, which == 0 ? 1 : (which == 2 ? 2 : 0)};
        if (which < 3) {
            const int mi = which == 0 ? 1 : (which == 1 ? 4 : 5);
            MixLoader al{H, mix + mi * D};
            const bf16_t* Bt = which == 0 ? wsm(p, j, WJ_W1) : which == 1 ? wsm(p, j, WJ_A1) : wsm(p, j, WJ_G1);
            gemm_tile_small2(lds, al, Bt, D, D, rt * 128, 0, ep);
        } else {
            PlainLoader al{XM + (size_t)2 * NT * D, D};
            gemm_tile_small2(lds, al, (const bf16_t*)(p.ws + OFF_WSM) + W_V1, D, D, rt * 128, 0, ep);
        }
    }
}

template <int KS, int MODE>
__device__ __forceinline__ void gemm_bstat(const bf16_t* __restrict__ A, int lda, const bf16_t* __restrict__ Bt, int ldb, int col0, int rt0, int rt1,
                                           bf16_t* O, const float* bias, const bf16_t* VRAW) {
    const int tid = tidx(), lane = tid & 63, wid = tid >> 6, wr = wid >> 2, wc = wid & 3, fr = lane & 15, fq = lane >> 4;
    bf16x8 bfr[4][KS];
#pragma unroll
    for (int n = 0; n < 4; ++n) {
        const int colb = col0 + wc * 64 + (n >> 1) * 32 + 8 * (fr >> 2) + 4 * (n & 1) + (fr & 3);
#pragma unroll
        for (int ks = 0; ks < KS; ++ks) bfr[n][ks] = *(const bf16x8*)(Bt + (size_t)colb * ldb + ks * 32 + fq * 8);
    }
    float bs[2][8];
#pragma unroll
    for (int pp = 0; pp < 2; ++pp)
#pragma unroll
        for (int e = 0; e < 8; ++e) bs[pp][e] = MODE == 2 ? 0.f : bias[col0 + wc * 64 + pp * 32 + 8 * fq + e] * ((MODE == 0 || MODE == 1) ? -1.44269504089f : 1.f);
    bf16x8 afr[4][KS];
#pragma unroll
    for (int m = 0; m < 4; ++m)
#pragma unroll
        for (int ks = 0; ks < KS; ++ks) afr[m][ks] = *(const bf16x8*)(A + (size_t)(rt0 * 128 + wr * 64 + m * 16 + fr) * lda + ks * 32 + fq * 8);
    for (int rt = rt0; rt < rt1; ++rt) {
        f32x4 acc[4][4];
#pragma unroll
        for (int m = 0; m < 4; ++m)
#pragma unroll
            for (int n = 0; n < 4; ++n) {
                acc[m][n] = (f32x4){0.f, 0.f, 0.f, 0.f};
#pragma unroll
                for (int ks = 0; ks < KS; ++ks) acc[m][n] = __builtin_amdgcn_mfma_f32_16x16x32_bf16(bfr[n][ks], afr[m][ks], acc[m][n], 0, 0, 0);
            }
        if (rt + 1 < rt1) {
#pragma unroll
            for (int m = 0; m < 4; ++m)
#pragma unroll
                for (int ks = 0; ks < KS; ++ks) afr[m][ks] = *(const bf16x8*)(A + (size_t)((rt + 1) * 128 + wr * 64 + m * 16 + fr) * lda + ks * 32 + fq * 8);
        }
#pragma unroll
        for (int m = 0; m < 4; ++m)
#pragma unroll
            for (int pp = 0; pp < 2; ++pp) {
                const size_t o = (size_t)(rt * 128 + wr * 64 + m * 16 + fr) * D + col0 + wc * 64 + pp * 32 + 8 * fq;
                float v[8];
#pragma unroll
                for (int e = 0; e < 4; ++e) { v[e] = acc[m][2 * pp][e]; v[4 + e] = acc[m][2 * pp + 1][e]; }
                if (MODE == 0 || MODE == 1) {
#pragma unroll
                    for (int e = 0; e < 8; e += 2) {
                        const f32x2_t x = {v[e], v[e + 1]}, bb = {bs[pp][e], bs[pp][e + 1]};
                        const f32x2_t t = x * -1.44269504089f + bb;
                        f32x2_t ex; ex.x = __builtin_amdgcn_exp2f(t.x); ex.y = __builtin_amdgcn_exp2f(t.y);
                        const f32x2_t dn = ex + 1.0f;
                        f32x2_t r; r.x = __builtin_amdgcn_rcpf(dn.x); r.y = __builtin_amdgcn_rcpf(dn.y);
                        if (MODE == 0) r = r * -0.6065306597f;
                        v[e] = r.x; v[e + 1] = r.y;
                    }
                } else if (MODE == 3) {
                    const u32x4 vr = *(const u32x4*)(VRAW + o), vf = *(const u32x4*)(O + o);
#pragma unroll
                    for (int e = 0; e < 8; ++e) {
                        const float x = (e & 1) ? bfhi(vr[e >> 1]) : bflo(vr[e >> 1]), f = (e & 1) ? bfhi(vf[e >> 1]) : bflo(vf[e >> 1]);
                        v[e] = x + (f - x) * sigmoidf_(v[e] + bs[pp][e]);
                    }
                }
                const u32x4 w = {pack2(v[0], v[1]), pack2(v[2], v[3]), pack2(v[4], v[5]), pack2(v[6], v[7])};
                *(u32x4*)(O + o) = w;
            }
    }
}
__device__ __forceinline__ void phase_rwkv_up(const Params& p, int j, char* lds) {
    bf16_t* LD = (bf16_t*)(p.ws + OFF_LD);
    bf16_t* LW = (bf16_t*)(p.ws + OFF_LW); bf16_t* AD = (bf16_t*)(p.ws + OFF_AD); bf16_t* G = (bf16_t*)(p.ws + OFF_G);
    constexpr int RT = NT / 128, NRC = 32, RPC = RT / NRC;
    const int ntot = j == 0 ? 0 : 4 * NRC;
    for (int u = blockIdx.x; u < ntot; u += gridDim.x) {
        const int which = 5, r = u % (4 * NRC), ct = r / NRC, rc = r % NRC;
        const int rt0 = rc * RPC, rt1 = rt0 + RPC, col0 = ct * 256;
        if (which < 2) {
            const int d = which;
            gemm_bstat<2, 0>(LD + d * 64, 128, wsm(p, j, WJ_W2) + (size_t)d * D * 64, 64, col0, rt0, rt1, LW + (size_t)d * NT * D, p.in[10] + ((size_t)j * 2 + d) * D, nullptr);
        } else if (which < 4) {
            const int d = which - 2;
            gemm_bstat<2, 1>(LD + (size_t)NT * 128 + d * 64, 128, wsm(p, j, WJ_A2) + (size_t)d * D * 64, 64, col0, rt0, rt1, AD + (size_t)d * NT * D, p.in[13] + ((size_t)j * 2 + d) * D, nullptr);
        } else if (which == 4) {
            gemm_bstat<4, 2>(LD + (size_t)2 * NT * 128, 128, wsm(p, j, WJ_G2), 128, col0, rt0, rt1, G, nullptr, nullptr);
        } else {
            gemm_bstat<2, 3>(LD + (size_t)3 * NT * 128, 128, (const bf16_t*)(p.ws + OFF_WSM) + W_V2, 64, col0, rt0, rt1, (bf16_t*)(p.ws + OFF_VF), p.in[16], (const bf16_t*)(p.ws + OFF_Y));
        }
    }
}

__device__ __forceinline__ void phase_rwkv_up2(const Params& p, int j, char* lds) {
    const bf16_t* R = (const bf16_t*)(p.ws + OFF_R); const bf16_t* Kb = (const bf16_t*)(p.ws + OFF_K);
    bf16_t* KK = (bf16_t*)(p.ws + OFF_H); float* BON = (float*)(p.ws + OFF_BON);
    const float* k_k = p.in[21] + (size_t)j * D; const float* k_a = p.in[22] + (size_t)j * D; const float* r_k = p.in[23] + (size_t)j * D;
    float* cst = (float*)lds;
    constexpr int TR = 32, MT = 1, RT = NT / TR, NRC = 64, RPC = RT / NRC, KS = 2;
    const int tid = tidx(), lane = tid & 63, wid = tid >> 6, wr = wid >> 2, wc = wid & 3, fr = lane & 15, fq = lane >> 4;
    const bf16_t* A = (const bf16_t*)(p.ws + OFF_LD) + (size_t)NT * 128;
    bf16_t* AD = (bf16_t*)(p.ws + OFF_AD);
    for (int u = blockIdx.x; u < 4 * NRC; u += gridDim.x) {
        const int ct = u / NRC, rc = u % NRC, rt0 = rc * RPC, rt1 = rt0 + RPC, col0 = ct * 256, head = ct * 4 + wc;
        __syncthreads();
        if (tid < 256) {
            const float kk_ = k_k[col0 + tid], ka_ = k_a[col0 + tid], rk_ = r_k[col0 + tid];
            cst[tid] = kk_; cst[256 + tid] = rk_ * (1.f - ka_); cst[512 + tid] = 0.5f * rk_ * ka_;
            cst[768 + tid] = p.in[13][((size_t)j * 2 + 0) * D + col0 + tid] * -1.44269504089f; cst[1024 + tid] = p.in[13][((size_t)j * 2 + 1) * D + col0 + tid] * -1.44269504089f;
        }
        __syncthreads();
        bf16x8 bfr[2][4][KS];
#pragma unroll
        for (int d = 0; d < 2; ++d)
#pragma unroll
            for (int n = 0; n < 4; ++n) {
                const int colb = col0 + wc * 64 + (n >> 1) * 32 + 8 * (fr >> 2) + 4 * (n & 1) + (fr & 3);
#pragma unroll
                for (int ks = 0; ks < KS; ++ks) bfr[d][n][ks] = *(const bf16x8*)(wsm(p, j, WJ_A2) + (size_t)d * D * 64 + (size_t)colb * 64 + ks * 32 + fq * 8);
            }
        bf16x8 afr[MT][2][KS];
#pragma unroll
        for (int m = 0; m < MT; ++m)
#pragma unroll
            for (int d = 0; d < 2; ++d)
#pragma unroll
                for (int ks = 0; ks < KS; ++ks) afr[m][d][ks] = *(const bf16x8*)(A + (size_t)(rt0 * TR + wr * (16 * MT) + m * 16 + fr) * 128 + d * 64 + ks * 32 + fq * 8);
#pragma unroll 1
        for (int rt = rt0; rt < rt1; ++rt) {
#pragma unroll
            for (int m = 0; m < MT; ++m) {
                const int row = rt * TR + wr * (16 * MT) + m * 16 + fr;
                const size_t o = (size_t)row * D + col0 + wc * 64 + 8 * fq;
                u32x4 kv[2], rv[2];
#pragma unroll
                for (int pp = 0; pp < 2; ++pp) { kv[pp] = *(const u32x4*)(Kb + o + pp * 32); rv[pp] = *(const u32x4*)(R + o + pp * 32); }
                float asum[16];
#pragma unroll
                for (int d = 0; d < 2; ++d) {
                    f32x4 acc[4];
#pragma unroll
                    for (int n = 0; n < 4; ++n) {
                        acc[n] = (f32x4){0.f, 0.f, 0.f, 0.f};
#pragma unroll
                        for (int ks = 0; ks < KS; ++ks) acc[n] = __builtin_amdgcn_mfma_f32_16x16x32_bf16(bfr[d][n][ks], afr[m][d][ks], acc[n], 0, 0, 0);
                    }
#pragma unroll
                    for (int pp = 0; pp < 2; ++pp) {
                        const float* bp = cst + 768 + d * 256 + wc * 64 + pp * 32 + 8 * fq;
                        const float4 b0 = *(const float4*)bp, b1 = *(const float4*)(bp + 4);
                        const float bs[8] = {b0.x, b0.y, b0.z, b0.w, b1.x, b1.y, b1.z, b1.w};
                        float av[8];
#pragma unroll
                        for (int e = 0; e < 8; e += 2) {
                            const f32x2_t x = {acc[2 * pp + (e >> 2)][e & 3], acc[2 * pp + (e >> 2)][(e & 3) + 1]}, bb = {bs[e], bs[e + 1]};
                            const f32x2_t t = x * -1.44269504089f + bb;
                            f32x2_t ex; ex.x = __builtin_amdgcn_exp2f(t.x); ex.y = __builtin_amdgcn_exp2f(t.y);
                            const f32x2_t dn = ex + 1.0f;
                            av[e] = __builtin_amdgcn_rcpf(dn.x); av[e + 1] = __builtin_amdgcn_rcpf(dn.y);
                        }
                        const u32x4 w = {pack2(av[0], av[1]), pack2(av[2], av[3]), pack2(av[4], av[5]), pack2(av[6], av[7])};
                        *(u32x4*)(AD + (size_t)d * NT * D + o + pp * 32) = w;
#pragma unroll
                        for (int e = 0; e < 8; ++e) { const float ab = bf2f(f2bf(av[e])); asum[pp * 8 + e] = d == 0 ? ab : asum[pp * 8 + e] + ab; }
                    }
                }
                if (rt + 1 < rt1) {
#pragma unroll
                    for (int d = 0; d < 2; ++d)
#pragma unroll
                        for (int ks = 0; ks < KS; ++ks) afr[m][d][ks] = *(const bf16x8*)(A + (size_t)((rt + 1) * TR + wr * (16 * MT) + m * 16 + fr) * 128 + d * 64 + ks * 32 + fq * 8);
                }
                float kk[16]; float n2 = 0.f, bon = 0.f;
#pragma unroll
                for (int pp = 0; pp < 2; ++pp) {
                    const float* cp = cst + wc * 64 + pp * 32 + 8 * fq;
                    const float4 q0 = *(const float4*)cp, q1 = *(const float4*)(cp + 4), c10 = *(const float4*)(cp + 256), c11 = *(const float4*)(cp + 260), c20 = *(const float4*)(cp + 512), c21 = *(const float4*)(cp + 516);
                    const float kkw[8] = {q0.x, q0.y, q0.z, q0.w, q1.x, q1.y, q1.z, q1.w}, c1[8] = {c10.x, c10.y, c10.z, c10.w, c11.x, c11.y, c11.z, c11.w}, c2[8] = {c20.x, c20.y, c20.z, c20.w, c21.x, c21.y, c21.z, c21.w};
#pragma unroll
                    for (int e = 0; e < 8; ++e) {
                        const unsigned kw = kv[pp][e >> 1], rw = rv[pp][e >> 1];
                        const float k = (e & 1) ? bfhi(kw) : bflo(kw), rr = (e & 1) ? bfhi(rw) : bflo(rw);
                        kk[pp * 8 + e] = k * kkw[e]; n2 += kk[pp * 8 + e] * kk[pp * 8 + e];
                        bon += rr * k * (c1[e] + c2[e] * asum[pp * 8 + e]);
                    }
                }
                bon = red4(bon); n2 = red4(n2);
                if (fq == 0) BON[(size_t)row * 16 + head] = bon;
                const float inv = 1.f / fmaxf(sqrtf(n2), 1e-12f);
#pragma unroll
                for (int pp = 0; pp < 2; ++pp) {
                    const u32x4 w = {pack2(kk[pp * 8 + 0] * inv, kk[pp * 8 + 1] * inv), pack2(kk[pp * 8 + 2] * inv, kk[pp * 8 + 3] * inv), pack2(kk[pp * 8 + 4] * inv, kk[pp * 8 + 5] * inv), pack2(kk[pp * 8 + 6] * inv, kk[pp * 8 + 7] * inv)};
                    *(u32x4*)(KK + o + pp * 32) = w;
                }
            }
        }
    }
}

__device__ __forceinline__ void phase_rwkv_prep(const Params& p, int j) {
    const bf16_t* R = (const bf16_t*)(p.ws + OFF_R); const bf16_t* Kb = (const bf16_t*)(p.ws + OFF_K);
    const bf16_t* AD = (const bf16_t*)(p.ws + OFF_AD);
    bf16_t* KK = (bf16_t*)(p.ws + OFF_H); float* BON = (float*)(p.ws + OFF_BON);
    const float* k_k = p.in[21] + (size_t)j * D; const float* k_a = p.in[22] + (size_t)j * D; const float* r_k = p.in[23] + (size_t)j * D;
    const int tid_ = tidx(), lane = tid_ & 63, wid = tid_ >> 6, c0 = lane * 16;
    float kkw[16], kaw[16], rkw[16];
#pragma unroll
    for (int i = 0; i < 16; ++i) { kkw[i] = k_k[c0 + i]; kaw[i] = k_a[c0 + i]; rkw[i] = r_k[c0 + i]; }
    constexpr int RW = 2;
    for (int grp = blockIdx.x * 8 + wid; grp < NT / RW; grp += gridDim.x * 8) {
        u32x4 kv[RW][2], rv[RW][2], a0[RW][2], a1[RW][2];
#pragma unroll
        for (int r = 0; r < RW; ++r) {
            const size_t o = (size_t)(grp * RW + r) * D + c0;
#pragma unroll
            for (int i = 0; i < 2; ++i) {
                kv[r][i] = *(const u32x4*)(Kb + o + i * 8); rv[r][i] = *(const u32x4*)(R + o + i * 8);
                a0[r][i] = *(const u32x4*)(AD + o + i * 8); a1[r][i] = *(const u32x4*)(AD + (size_t)NT * D + o + i * 8);
            }
        }
#pragma unroll
        for (int r = 0; r < RW; ++r) {
            const int row = grp * RW + r;
            const size_t o = (size_t)row * D + c0;
            float kk[16]; float n2 = 0.f, bon = 0.f;
#pragma unroll
            for (int i = 0; i < 16; ++i) {
                const unsigned kw = kv[r][i >> 3][(i >> 1) & 3], rw = rv[r][i >> 3][(i >> 1) & 3], aw0 = a0[r][i >> 3][(i >> 1) & 3], aw1 = a1[r][i >> 3][(i >> 1) & 3];
                const float k = (i & 1) ? bfhi(kw) : bflo(kw), rr = (i & 1) ? bfhi(rw) : bflo(rw);
                const float am = 0.5f * (((i & 1) ? bfhi(aw0) : bflo(aw0)) + ((i & 1) ? bfhi(aw1) : bflo(aw1)));
                kk[i] = k * kkw[i]; n2 += kk[i] * kk[i];
                bon += rr * (k * (1.f + (am - 1.f) * kaw[i])) * rkw[i];
            }
            n2 += __shfl_xor(n2, 1, 64); n2 += __shfl_xor(n2, 2, 64);
            bon += __shfl_xor(bon, 1, 64); bon += __shfl_xor(bon, 2, 64);
            const float inv = 1.f / fmaxf(sqrtf(n2), 1e-12f);
            u32x4 ov[2];
#pragma unroll
            for (int i = 0; i < 8; ++i) ov[i >> 2][i & 3] = pack2(kk[2 * i] * inv, kk[2 * i + 1] * inv);
            *(u32x4*)(KK + o) = ov[0]; *(u32x4*)(KK + o + 8) = ov[1];
            if ((lane & 3) == 0) BON[(size_t)row * 16 + (lane >> 2)] = bon;
        }
    }
}

#define SCAN_STEP_ASM \
    "s_nop 1\n\t" \
    "v_mul_f32_dpp %0, %20, %0 row_newbcast:0 row_mask:0xf bank_mask:0xf\n\t" \
    "v_mul_f32_dpp %1, %20, %1 row_newbcast:1 row_mask:0xf bank_mask:0xf\n\t" \
    "v_mul_f32_dpp %2, %20, %2 row_newbcast:2 row_mask:0xf bank_mask:0xf\n\t" \
    "v_mul_f32_dpp %3, %20, %3 row_newbcast:3 row_mask:0xf bank_mask:0xf\n\t" \
    "v_mul_f32_dpp %4, %20, %4 row_newbcast:4 row_mask:0xf bank_mask:0xf\n\t" \
    "v_mul_f32_dpp %5, %20, %5 row_newbcast:5 row_mask:0xf bank_mask:0xf\n\t" \
    "v_mul_f32_dpp %6, %20, %6 row_newbcast:6 row_mask:0xf bank_mask:0xf\n\t" \
    "v_mul_f32_dpp %7, %20, %7 row_newbcast:7 row_mask:0xf bank_mask:0xf\n\t" \
    "v_mul_f32_dpp %8, %20, %8 row_newbcast:8 row_mask:0xf bank_mask:0xf\n\t" \
    "v_mul_f32_dpp %9, %20, %9 row_newbcast:9 row_mask:0xf bank_mask:0xf\n\t" \
    "v_mul_f32_dpp %10, %20, %10 row_newbcast:10 row_mask:0xf bank_mask:0xf\n\t" \
    "v_mul_f32_dpp %11, %20, %11 row_newbcast:11 row_mask:0xf bank_mask:0xf\n\t" \
    "v_mul_f32_dpp %12, %20, %12 row_newbcast:12 row_mask:0xf bank_mask:0xf\n\t" \
    "v_mul_f32_dpp %13, %20, %13 row_newbcast:13 row_mask:0xf bank_mask:0xf\n\t" \
    "v_mul_f32_dpp %14, %20, %14 row_newbcast:14 row_mask:0xf bank_mask:0xf\n\t" \
    "v_mul_f32_dpp %15, %20, %15 row_newbcast:15 row_mask:0xf bank_mask:0xf\n\t" \
    "v_fmac_f32_dpp %0, %21, %25 row_newbcast:0 row_mask:0xf bank_mask:0xf\n\t" \
    "v_fmac_f32_dpp %1, %21, %25 row_newbcast:1 row_mask:0xf bank_mask:0xf\n\t" \
    "v_fmac_f32_dpp %2, %21, %25 row_newbcast:2 row_mask:0xf bank_mask:0xf\n\t" \
    "v_fmac_f32_dpp %3, %21, %25 row_newbcast:3 row_mask:0xf bank_mask:0xf\n\t" \
    "v_fmac_f32_dpp %4, %21, %25 row_newbcast:4 row_mask:0xf bank_mask:0xf\n\t" \
    "v_fmac_f32_dpp %5, %21, %25 row_newbcast:5 row_mask:0xf bank_mask:0xf\n\t" \
    "v_fmac_f32_dpp %6, %21, %25 row_newbcast:6 row_mask:0xf bank_mask:0xf\n\t" \
    "v_fmac_f32_dpp %7, %21, %25 row_newbcast:7 row_mask:0xf bank_mask:0xf\n\t" \
    "v_fmac_f32_dpp %8, %21, %25 row_newbcast:8 row_mask:0xf bank_mask:0xf\n\t" \
    "v_fmac_f32_dpp %9, %21, %25 row_newbcast:9 row_mask:0xf bank_mask:0xf\n\t" \
    "v_fmac_f32_dpp %10, %21, %25 row_newbcast:10 row_mask:0xf bank_mask:0xf\n\t" \
    "v_fmac_f32_dpp %11, %21, %25 row_newbcast:11 row_mask:0xf bank_mask:0xf\n\t" \
    "v_fmac_f32_dpp %12, %21, %25 row_newbcast:12 row_mask:0xf bank_mask:0xf\n\t" \
    "v_fmac_f32_dpp %13, %21, %25 row_newbcast:13 row_mask:0xf bank_mask:0xf\n\t" \
    "v_fmac_f32_dpp %14, %21, %25 row_newbcast:14 row_mask:0xf bank_mask:0xf\n\t" \
    "v_fmac_f32_dpp %15, %21, %25 row_newbcast:15 row_mask:0xf bank_mask:0xf\n\t" \
    "v_fmac_f32_dpp %0, %22, %26 row_newbcast:0 row_mask:0xf bank_mask:0xf\n\t" \
    "v_fmac_f32_dpp %1, %22, %26 row_newbcast:1 row_mask:0xf bank_mask:0xf\n\t" \
    "v_fmac_f32_dpp %2, %22, %26 row_newbcast:2 row_mask:0xf bank_mask:0xf\n\t" \
    "v_fmac_f32_dpp %3, %22, %26 row_newbcast:3 row_mask:0xf bank_mask:0xf\n\t" \
    "v_fmac_f32_dpp %4, %22, %26 row_newbcast:4 row_mask:0xf bank_mask:0xf\n\t" \
    "v_fmac_f32_dpp %5, %22, %26 row_newbcast:5 row_mask:0xf bank_mask:0xf\n\t" \
    "v_fmac_f32_dpp %6, %22, %26 row_newbcast:6 row_mask:0xf bank_mask:0xf\n\t" \
    "v_fmac_f32_dpp %7, %22, %26 row_newbcast:7 row_mask:0xf bank_mask:0xf\n\t" \
    "v_fmac_f32_dpp %8, %22, %26 row_newbcast:8 row_mask:0xf bank_mask:0xf\n\t" \
    "v_fmac_f32_dpp %9, %22, %26 row_newbcast:9 row_mask:0xf bank_mask:0xf\n\t" \
    "v_fmac_f32_dpp %10, %22, %26 row_newbcast:10 row_mask:0xf bank_mask:0xf\n\t" \
    "v_fmac_f32_dpp %11, %22, %26 row_newbcast:11 row_mask:0xf bank_mask:0xf\n\t" \
    "v_fmac_f32_dpp %12, %22, %26 row_newbcast:12 row_mask:0xf bank_mask:0xf\n\t" \
    "v_fmac_f32_dpp %13, %22, %26 row_newbcast:13 row_mask:0xf bank_mask:0xf\n\t" \
    "v_fmac_f32_dpp %14, %22, %26 row_newbcast:14 row_mask:0xf bank_mask:0xf\n\t" \
    "v_fmac_f32_dpp %15, %22, %26 row_newbcast:15 row_mask:0xf bank_mask:0xf\n\t" \
    "v_mul_f32_dpp %16, %23, %0 row_newbcast:0 row_mask:0xf bank_mask:0xf\n\t" \
    "v_mul_f32_dpp %18, %24, %0 row_newbcast:0 row_mask:0xf bank_mask:0xf\n\t" \
    "v_mul_f32_dpp %17, %23, %1 row_newbcast:1 row_mask:0xf bank_mask:0xf\n\t" \
    "v_mul_f32_dpp %19, %24, %1 row_newbcast:1 row_mask:0xf bank_mask:0xf\n\t" \
    "v_fmac_f32_dpp %16, %23, %2 row_newbcast:2 row_mask:0xf bank_mask:0xf\n\t" \
    "v_fmac_f32_dpp %18, %24, %2 row_newbcast:2 row_mask:0xf bank_mask:0xf\n\t" \
    "v_fmac_f32_dpp %17, %23, %3 row_newbcast:3 row_mask:0xf bank_mask:0xf\n\t" \
    "v_fmac_f32_dpp %19, %24, %3 row_newbcast:3 row_mask:0xf bank_mask:0xf\n\t" \
    "v_fmac_f32_dpp %16, %23, %4 row_newbcast:4 row_mask:0xf bank_mask:0xf\n\t" \
    "v_fmac_f32_dpp %18, %24, %4 row_newbcast:4 row_mask:0xf bank_mask:0xf\n\t" \
    "v_fmac_f32_dpp %17, %23, %5 row_newbcast:5 row_mask:0xf bank_mask:0xf\n\t" \
    "v_fmac_f32_dpp %19, %24, %5 row_newbcast:5 row_mask:0xf bank_mask:0xf\n\t" \
    "v_fmac_f32_dpp %16, %23, %6 row_newbcast:6 row_mask:0xf bank_mask:0xf\n\t" \
    "v_fmac_f32_dpp %18, %24, %6 row_newbcast:6 row_mask:0xf bank_mask:0xf\n\t" \
    "v_fmac_f32_dpp %17, %23, %7 row_newbcast:7 row_mask:0xf bank_mask:0xf\n\t" \
    "v_fmac_f32_dpp %19, %24, %7 row_newbcast:7 row_mask:0xf bank_mask:0xf\n\t" \
    "v_fmac_f32_dpp %16, %23, %8 row_newbcast:8 row_mask:0xf bank_mask:0xf\n\t" \
    "v_fmac_f32_dpp %18, %24, %8 row_newbcast:8 row_mask:0xf bank_mask:0xf\n\t" \
    "v_fmac_f32_dpp %17, %23, %9 row_newbcast:9 row_mask:0xf bank_mask:0xf\n\t" \
    "v_fmac_f32_dpp %19, %24, %9 row_newbcast:9 row_mask:0xf bank_mask:0xf\n\t" \
    "v_fmac_f32_dpp %16, %23, %10 row_newbcast:10 row_mask:0xf bank_mask:0xf\n\t" \
    "v_fmac_f32_dpp %18, %24, %10 row_newbcast:10 row_mask:0xf bank_mask:0xf\n\t" \
    "v_fmac_f32_dpp %17, %23, %11 row_newbcast:11 row_mask:0xf bank_mask:0xf\n\t" \
    "v_fmac_f32_dpp %19, %24, %11 row_newbcast:11 row_mask:0xf bank_mask:0xf\n\t" \
    "v_fmac_f32_dpp %16, %23, %12 row_newbcast:12 row_mask:0xf bank_mask:0xf\n\t" \
    "v_fmac_f32_dpp %18, %24, %12 row_newbcast:12 row_mask:0xf bank_mask:0xf\n\t" \
    "v_fmac_f32_dpp %17, %23, %13 row_newbcast:13 row_mask:0xf bank_mask:0xf\n\t" \
    "v_fmac_f32_dpp %19, %24, %13 row_newbcast:13 row_mask:0xf bank_mask:0xf\n\t" \
    "v_fmac_f32_dpp %16, %23, %14 row_newbcast:14 row_mask:0xf bank_mask:0xf\n\t" \
    "v_fmac_f32_dpp %18, %24, %14 row_newbcast:14 row_mask:0xf bank_mask:0xf\n\t" \
    "v_fmac_f32_dpp %17, %23, %15 row_newbcast:15 row_mask:0xf bank_mask:0xf\n\t" \
    "v_fmac_f32_dpp %19, %24, %15 row_newbcast:15 row_mask:0xf bank_mask:0xf\n\t" \
    ""

__device__ __forceinline__ void phase_rwkv_scan(const Params& p, int j, char* lds) {
    const bf16_t* R = (const bf16_t*)(p.ws + OFF_R); const bf16_t* Kb = (const bf16_t*)(p.ws + OFF_K);
    const bf16_t* V = (const bf16_t*)(p.ws + OFF_VF); const bf16_t* KK = (const bf16_t*)(p.ws + OFF_H);
    const bf16_t* LW = (const bf16_t*)(p.ws + OFF_LW); const bf16_t* AD = (const bf16_t*)(p.ws + OFF_AD);
    bf16_t* Y = (bf16_t*)(p.ws + OFF_Y);
    const int tid = tidx(), lane = tid & 63, wid = tid >> 6, cl = wid >> 2, q = wid & 3;
    for (int cp = blockIdx.x; cp < 256; cp += gridDim.x) {
        const int chain = cp * 2 + cl, d = chain & 1, bh = chain >> 1, b = bh >> 4, h = bh & 15;
        const int col = h * 64 + lane, vcol = h * 64 + q * 16 + (lane & 15);
        const float ka = p.in[22][(size_t)j * D + col];
        const bf16_t* LWd = LW + (size_t)d * NT * D; const bf16_t* ADd = AD + (size_t)d * NT * D;
        bf16_t* Yd = Y + (size_t)d * NT * D;
        float S0 = 0.f, S1 = 0.f, S2 = 0.f, S3 = 0.f, S4 = 0.f, S5 = 0.f, S6 = 0.f, S7 = 0.f, S8 = 0.f, S9 = 0.f, S10 = 0.f, S11 = 0.f, S12 = 0.f, S13 = 0.f, S14 = 0.f, S15 = 0.f;
        float sa = 0.f;
        auto row_of = [&](int s) -> int {
            if (s < TC) { const int t = d ? (TC - 1 - s) : s; return NLAT + b * TC + t; }
            const int tl = s - TC; const int t = d ? (TL - 1 - tl) : tl; return b * TL + t;
        };
        auto row_kk = [&](int s) -> int { return row_of(s < TC + TL ? s : TC + TL - 1); };
        const int colw = col & ~1, vcolw = vcol & ~1;
        const unsigned shc = (col & 1) ? 0u : 16u, shv = (vcol & 1) ? 0u : 16u;
#define LDW(P, off) (*(const unsigned*)((P) + (off)))
#define UNP(w, sh) __uint_as_float(((w) << (sh)) & 0xffff0000u)
        unsigned nr[4], nkk[4], nk[4], nlw[4], na[4], nv[4];
#pragma unroll
        for (int g = 0; g < 4; ++g) {
            const size_t o = (size_t)row_of(g) * D;
            nr[g] = LDW(R, o + colw); nk[g] = LDW(Kb, o + colw); nlw[g] = LDW(LWd, o + colw); na[g] = LDW(ADd, o + colw); nv[g] = LDW(V, o + vcolw);
            nkk[g] = LDW(KK, (size_t)row_kk(g + 1) * D + colw);
        }
        float kk_cur = bf2f(KK[(size_t)row_of(0) * D + col]);
        constexpr int NSTEP = TC + TL;
        for (int s0 = 0; s0 < NSTEP; s0 += 4) {
            unsigned cr[4], ckk[4], ck[4], clw[4], ca[4], cv[4];
#pragma unroll
            for (int g = 0; g < 4; ++g) { cr[g] = nr[g]; ckk[g] = nkk[g]; ck[g] = nk[g]; clw[g] = nlw[g]; ca[g] = na[g]; cv[g] = nv[g]; }
            if (s0 + 4 < NSTEP) {
#pragma unroll
                for (int g = 0; g < 4; ++g) {
                    const size_t o = (size_t)row_of(s0 + 4 + g) * D;
                    nr[g] = LDW(R, o + colw); nk[g] = LDW(Kb, o + colw); nlw[g] = LDW(LWd, o + colw); na[g] = LDW(ADd, o + colw); nv[g] = LDW(V, o + vcolw);
                    nkk[g] = LDW(KK, (size_t)row_kk(s0 + 5 + g) * D + colw);
                }
            }
#pragma unroll
            for (int g = 0; g < 4; ++g) {
                const float rr = UNP(cr[g], shc), kkc = kk_cur, kkn = UNP(ckk[g], shc), kv = UNP(ck[g], shc), av = UNP(ca[g], shc), vv = UNP(cv[g], shv);
                kk_cur = kkn;
                const float dec = __expf(UNP(clw[g], shc)), bb = kkc * av, kd = kv * (1.f + (av - 1.f) * ka);
                float py0, py1, ps0, ps1;
                asm volatile(SCAN_STEP_ASM
                    : "+v"(S0), "+v"(S1), "+v"(S2), "+v"(S3), "+v"(S4), "+v"(S5), "+v"(S6), "+v"(S7), "+v"(S8), "+v"(S9), "+v"(S10), "+v"(S11), "+v"(S12), "+v"(S13), "+v"(S14), "+v"(S15),
                      "=&v"(py0), "=&v"(py1), "=&v"(ps0), "=&v"(ps1)
                    : "v"(dec), "v"(bb), "v"(kd), "v"(rr), "v"(kkn), "v"(sa), "v"(vv));
                sa = -red4(ps0 + ps1);
                const float yv = red4(py0 + py1);
                if (lane < 16) Yd[(size_t)row_of(s0 + g) * D + vcol] = f2bf(yv);
            }
        }
#undef LDW
#undef UNP
    }
}

#define TRI_ASM1 \
    "s_nop 1\n\t" \
    "v_xor_b32 %0, 0x80000000, %0\n\t" \
    "v_fmac_f32_dpp %1, %8, %0 row_newbcast:1 row_mask:0xf bank_mask:0xf\n\t" \
    "v_xor_b32 %1, 0x80000000, %1\n\t" \
    "v_fmac_f32_dpp %2, %8, %0 row_newbcast:2 row_mask:0xf bank_mask:0xf\n\t" \
    "v_fmac_f32_dpp %2, %9, %1 row_newbcast:2 row_mask:0xf bank_mask:0xf\n\t" \
    "v_xor_b32 %2, 0x80000000, %2\n\t" \
    "v_fmac_f32_dpp %3, %8, %0 row_newbcast:3 row_mask:0xf bank_mask:0xf\n\t" \
    "v_fmac_f32_dpp %3, %9, %1 row_newbcast:3 row_mask:0xf bank_mask:0xf\n\t" \
    "v_fmac_f32_dpp %3, %10, %2 row_newbcast:3 row_mask:0xf bank_mask:0xf\n\t" \
    "v_xor_b32 %3, 0x80000000, %3\n\t" \
    "v_fmac_f32_dpp %4, %8, %0 row_newbcast:4 row_mask:0xf bank_mask:0xf\n\t" \
    "v_fmac_f32_dpp %4, %9, %1 row_newbcast:4 row_mask:0xf bank_mask:0xf\n\t" \
    "v_fmac_f32_dpp %4, %10, %2 row_newbcast:4 row_mask:0xf bank_mask:0xf\n\t" \
    "v_fmac_f32_dpp %4, %11, %3 row_newbcast:4 row_mask:0xf bank_mask:0xf\n\t" \
    "v_xor_b32 %4, 0x80000000, %4\n\t" \
    "v_fmac_f32_dpp %5, %8, %0 row_newbcast:5 row_mask:0xf bank_mask:0xf\n\t" \
    "v_fmac_f32_dpp %5, %9, %1 row_newbcast:5 row_mask:0xf bank_mask:0xf\n\t" \
    "v_fmac_f32_dpp %5, %10, %2 row_newbcast:5 row_mask:0xf bank_mask:0xf\n\t" \
    "v_fmac_f32_dpp %5, %11, %3 row_newbcast:5 row_mask:0xf bank_mask:0xf\n\t" \
    "v_fmac_f32_dpp %5, %12, %4 row_newbcast:5 row_mask:0xf bank_mask:0xf\n\t" \
    "v_xor_b32 %5, 0x80000000, %5\n\t" \
    "v_fmac_f32_dpp %6, %8, %0 row_newbcast:6 row_mask:0xf bank_mask:0xf\n\t" \
    "v_fmac_f32_dpp %6, %9, %1 row_newbcast:6 row_mask:0xf bank_mask:0xf\n\t" \
    "v_fmac_f32_dpp %6, %10, %2 row_newbcast:6 row_mask:0xf bank_mask:0xf\n\t" \
    "v_fmac_f32_dpp %6, %11, %3 row_newbcast:6 row_mask:0xf bank_mask:0xf\n\t" \
    "v_fmac_f32_dpp %6, %12, %4 row_newbcast:6 row_mask:0xf bank_mask:0xf\n\t" \
    "v_fmac_f32_dpp %6, %13, %5 row_newbcast:6 row_mask:0xf bank_mask:0xf\n\t" \
    "v_xor_b32 %6, 0x80000000, %6\n\t" \
    "v_fmac_f32_dpp %7, %8, %0 row_newbcast:7 row_mask:0xf bank_mask:0xf\n\t" \
    "v_fmac_f32_dpp %7, %9, %1 row_newbcast:7 row_mask:0xf bank_mask:0xf\n\t" \
    "v_fmac_f32_dpp %7, %10, %2 row_newbcast:7 row_mask:0xf bank_mask:0xf\n\t" \
    "v_fmac_f32_dpp %7, %11, %3 row_newbcast:7 row_mask:0xf bank_mask:0xf\n\t" \
    "v_fmac_f32_dpp %7, %12, %4 row_newbcast:7 row_mask:0xf bank_mask:0xf\n\t" \
    "v_fmac_f32_dpp %7, %13, %5 row_newbcast:7 row_mask:0xf bank_mask:0xf\n\t" \
    "v_fmac_f32_dpp %7, %14, %6 row_newbcast:7 row_mask:0xf bank_mask:0xf\n\t" \
    "v_xor_b32 %7, 0x80000000, %7\n\t" \
    ""
#define TRI_ASM2 \
    "s_nop 1\n\t" \
    "v_fmac_f32_dpp %0, %16, %8 row_newbcast:8 row_mask:0xf bank_mask:0xf\n\t" \
    "v_fmac_f32_dpp %0, %17, %9 row_newbcast:8 row_mask:0xf bank_mask:0xf\n\t" \
    "v_fmac_f32_dpp %0, %18, %10 row_newbcast:8 row_mask:0xf bank_mask:0xf\n\t" \
    "v_fmac_f32_dpp %0, %19, %11 row_newbcast:8 row_mask:0xf bank_mask:0xf\n\t" \
    "v_fmac_f32_dpp %0, %20, %12 row_newbcast:8 row_mask:0xf bank_mask:0xf\n\t" \
    "v_fmac_f32_dpp %0, %21, %13 row_newbcast:8 row_mask:0xf bank_mask:0xf\n\t" \
    "v_fmac_f32_dpp %0, %22, %14 row_newbcast:8 row_mask:0xf bank_mask:0xf\n\t" \
    "v_fmac_f32_dpp %0, %23, %15 row_newbcast:8 row_mask:0xf bank_mask:0xf\n\t" \
    "v_fmac_f32_dpp %1, %16, %8 row_newbcast:9 row_mask:0xf bank_mask:0xf\n\t" \
    "v_fmac_f32_dpp %1, %17, %9 row_newbcast:9 row_mask:0xf bank_mask:0xf\n\t" \
    "v_fmac_f32_dpp %1, %18, %10 row_newbcast:9 row_mask:0xf bank_mask:0xf\n\t" \
    "v_fmac_f32_dpp %1, %19, %11 row_newbcast:9 row_mask:0xf bank_mask:0xf\n\t" \
    "v_fmac_f32_dpp %1, %20, %12 row_newbcast:9 row_mask:0xf bank_mask:0xf\n\t" \
    "v_fmac_f32_dpp %1, %21, %13 row_newbcast:9 row_mask:0xf bank_mask:0xf\n\t" \
    "v_fmac_f32_dpp %1, %22, %14 row_newbcast:9 row_mask:0xf bank_mask:0xf\n\t" \
    "v_fmac_f32_dpp %1, %23, %15 row_newbcast:9 row_mask:0xf bank_mask:0xf\n\t" \
    "v_fmac_f32_dpp %2, %16, %8 row_newbcast:10 row_mask:0xf bank_mask:0xf\n\t" \
    "v_fmac_f32_dpp %2, %17, %9 row_newbcast:10 row_mask:0xf bank_mask:0xf\n\t" \
    "v_fmac_f32_dpp %2, %18, %10 row_newbcast:10 row_mask:0xf bank_mask:0xf\n\t" \
    "v_fmac_f32_dpp %2, %19, %11 row_newbcast:10 row_mask:0xf bank_mask:0xf\n\t" \
    "v_fmac_f32_dpp %2, %20, %12 row_newbcast:10 row_mask:0xf bank_mask:0xf\n\t" \
    "v_fmac_f32_dpp %2, %21, %13 row_newbcast:10 row_mask:0xf bank_mask:0xf\n\t" \
    "v_fmac_f32_dpp %2, %22, %14 row_newbcast:10 row_mask:0xf bank_mask:0xf\n\t" \
    "v_fmac_f32_dpp %2, %23, %15 row_newbcast:10 row_mask:0xf bank_mask:0xf\n\t" \
    "v_fmac_f32_dpp %3, %16, %8 row_newbcast:11 row_mask:0xf bank_mask:0xf\n\t" \
    "v_fmac_f32_dpp %3, %17, %9 row_newbcast:11 row_mask:0xf bank_mask:0xf\n\t" \
    "v_fmac_f32_dpp %3, %18, %10 row_newbcast:11 row_mask:0xf bank_mask:0xf\n\t" \
    "v_fmac_f32_dpp %3, %19, %11 row_newbcast:11 row_mask:0xf bank_mask:0xf\n\t" \
    "v_fmac_f32_dpp %3, %20, %12 row_newbcast:11 row_mask:0xf bank_mask:0xf\n\t" \
    "v_fmac_f32_dpp %3, %21, %13 row_newbcast:11 row_mask:0xf bank_mask:0xf\n\t" \
    "v_fmac_f32_dpp %3, %22, %14 row_newbcast:11 row_mask:0xf bank_mask:0xf\n\t" \
    "v_fmac_f32_dpp %3, %23, %15 row_newbcast:11 row_mask:0xf bank_mask:0xf\n\t" \
    "v_fmac_f32_dpp %4, %16, %8 row_newbcast:12 row_mask:0xf bank_mask:0xf\n\t" \
    "v_fmac_f32_dpp %4, %17, %9 row_newbcast:12 row_mask:0xf bank_mask:0xf\n\t" \
    "v_fmac_f32_dpp %4, %18, %10 row_newbcast:12 row_mask:0xf bank_mask:0xf\n\t" \
    "v_fmac_f32_dpp %4, %19, %11 row_newbcast:12 row_mask:0xf bank_mask:0xf\n\t" \
    "v_fmac_f32_dpp %4, %20, %12 row_newbcast:12 row_mask:0xf bank_mask:0xf\n\t" \
    "v_fmac_f32_dpp %4, %21, %13 row_newbcast:12 row_mask:0xf bank_mask:0xf\n\t" \
    "v_fmac_f32_dpp %4, %22, %14 row_newbcast:12 row_mask:0xf bank_mask:0xf\n\t" \
    "v_fmac_f32_dpp %4, %23, %15 row_newbcast:12 row_mask:0xf bank_mask:0xf\n\t" \
    "v_fmac_f32_dpp %5, %16, %8 row_newbcast:13 row_mask:0xf bank_mask:0xf\n\t" \
    "v_fmac_f32_dpp %5, %17, %9 row_newbcast:13 row_mask:0xf bank_mask:0xf\n\t" \
    "v_fmac_f32_dpp %5, %18, %10 row_newbcast:13 row_mask:0xf bank_mask:0xf\n\t" \
    "v_fmac_f32_dpp %5, %19, %11 row_newbcast:13 row_mask:0xf bank_mask:0xf\n\t" \
    "v_fmac_f32_dpp %5, %20, %12 row_newbcast:13 row_mask:0xf bank_mask:0xf\n\t" \
    "v_fmac_f32_dpp %5, %21, %13 row_newbcast:13 row_mask:0xf bank_mask:0xf\n\t" \
    "v_fmac_f32_dpp %5, %22, %14 row_newbcast:13 row_mask:0xf bank_mask:0xf\n\t" \
    "v_fmac_f32_dpp %5, %23, %15 row_newbcast:13 row_mask:0xf bank_mask:0xf\n\t" \
    "v_fmac_f32_dpp %6, %16, %8 row_newbcast:14 row_mask:0xf bank_mask:0xf\n\t" \
    "v_fmac_f32_dpp %6, %17, %9 row_newbcast:14 row_mask:0xf bank_mask:0xf\n\t" \
    "v_fmac_f32_dpp %6, %18, %10 row_newbcast:14 row_mask:0xf bank_mask:0xf\n\t" \
    "v_fmac_f32_dpp %6, %19, %11 row_newbcast:14 row_mask:0xf bank_mask:0xf\n\t" \
    "v_fmac_f32_dpp %6, %20, %12 row_newbcast:14 row_mask:0xf bank_mask:0xf\n\t" \
    "v_fmac_f32_dpp %6, %21, %13 row_newbcast:14 row_mask:0xf bank_mask:0xf\n\t" \
    "v_fmac_f32_dpp %6, %22, %14 row_newbcast:14 row_mask:0xf bank_mask:0xf\n\t" \
    "v_fmac_f32_dpp %6, %23, %15 row_newbcast:14 row_mask:0xf bank_mask:0xf\n\t" \
    "v_fmac_f32_dpp %7, %16, %8 row_newbcast:15 row_mask:0xf bank_mask:0xf\n\t" \
    "v_fmac_f32_dpp %7, %17, %9 row_newbcast:15 row_mask:0xf bank_mask:0xf\n\t" \
    "v_fmac_f32_dpp %7, %18, %10 row_newbcast:15 row_mask:0xf bank_mask:0xf\n\t" \
    "v_fmac_f32_dpp %7, %19, %11 row_newbcast:15 row_mask:0xf bank_mask:0xf\n\t" \
    "v_fmac_f32_dpp %7, %20, %12 row_newbcast:15 row_mask:0xf bank_mask:0xf\n\t" \
    "v_fmac_f32_dpp %7, %21, %13 row_newbcast:15 row_mask:0xf bank_mask:0xf\n\t" \
    "v_fmac_f32_dpp %7, %22, %14 row_newbcast:15 row_mask:0xf bank_mask:0xf\n\t" \
    "v_fmac_f32_dpp %7, %23, %15 row_newbcast:15 row_mask:0xf bank_mask:0xf\n\t" \
    ""
#define TRI_ASM3 \
    "s_nop 1\n\t" \
    "v_xor_b32 %0, 0x80000000, %0\n\t" \
    "v_fmac_f32_dpp %1, %8, %0 row_newbcast:9 row_mask:0xf bank_mask:0xf\n\t" \
    "v_xor_b32 %1, 0x80000000, %1\n\t" \
    "v_fmac_f32_dpp %2, %8, %0 row_newbcast:10 row_mask:0xf bank_mask:0xf\n\t" \
    "v_fmac_f32_dpp %2, %9, %1 row_newbcast:10 row_mask:0xf bank_mask:0xf\n\t" \
    "v_xor_b32 %2, 0x80000000, %2\n\t" \
    "v_fmac_f32_dpp %3, %8, %0 row_newbcast:11 row_mask:0xf bank_mask:0xf\n\t" \
    "v_fmac_f32_dpp %3, %9, %1 row_newbcast:11 row_mask:0xf bank_mask:0xf\n\t" \
    "v_fmac_f32_dpp %3, %10, %2 row_newbcast:11 row_mask:0xf bank_mask:0xf\n\t" \
    "v_xor_b32 %3, 0x80000000, %3\n\t" \
    "v_fmac_f32_dpp %4, %8, %0 row_newbcast:12 row_mask:0xf bank_mask:0xf\n\t" \
    "v_fmac_f32_dpp %4, %9, %1 row_newbcast:12 row_mask:0xf bank_mask:0xf\n\t" \
    "v_fmac_f32_dpp %4, %10, %2 row_newbcast:12 row_mask:0xf bank_mask:0xf\n\t" \
    "v_fmac_f32_dpp %4, %11, %3 row_newbcast:12 row_mask:0xf bank_mask:0xf\n\t" \
    "v_xor_b32 %4, 0x80000000, %4\n\t" \
    "v_fmac_f32_dpp %5, %8, %0 row_newbcast:13 row_mask:0xf bank_mask:0xf\n\t" \
    "v_fmac_f32_dpp %5, %9, %1 row_newbcast:13 row_mask:0xf bank_mask:0xf\n\t" \
    "v_fmac_f32_dpp %5, %10, %2 row_newbcast:13 row_mask:0xf bank_mask:0xf\n\t" \
    "v_fmac_f32_dpp %5, %11, %3 row_newbcast:13 row_mask:0xf bank_mask:0xf\n\t" \
    "v_fmac_f32_dpp %5, %12, %4 row_newbcast:13 row_mask:0xf bank_mask:0xf\n\t" \
    "v_xor_b32 %5, 0x80000000, %5\n\t" \
    "v_fmac_f32_dpp %6, %8, %0 row_newbcast:14 row_mask:0xf bank_mask:0xf\n\t" \
    "v_fmac_f32_dpp %6, %9, %1 row_newbcast:14 row_mask:0xf bank_mask:0xf\n\t" \
    "v_fmac_f32_dpp %6, %10, %2 row_newbcast:14 row_mask:0xf bank_mask:0xf\n\t" \
    "v_fmac_f32_dpp %6, %11, %3 row_newbcast:14 row_mask:0xf bank_mask:0xf\n\t" \
    "v_fmac_f32_dpp %6, %12, %4 row_newbcast:14 row_mask:0xf bank_mask:0xf\n\t" \
    "v_fmac_f32_dpp %6, %13, %5 row_newbcast:14 row_mask:0xf bank_mask:0xf\n\t" \
    "v_xor_b32 %6, 0x80000000, %6\n\t" \
    "v_fmac_f32_dpp %7, %8, %0 row_newbcast:15 row_mask:0xf bank_mask:0xf\n\t" \
    "v_fmac_f32_dpp %7, %9, %1 row_newbcast:15 row_mask:0xf bank_mask:0xf\n\t" \
    "v_fmac_f32_dpp %7, %10, %2 row_newbcast:15 row_mask:0xf bank_mask:0xf\n\t" \
    "v_fmac_f32_dpp %7, %11, %3 row_newbcast:15 row_mask:0xf bank_mask:0xf\n\t" \
    "v_fmac_f32_dpp %7, %12, %4 row_newbcast:15 row_mask:0xf bank_mask:0xf\n\t" \
    "v_fmac_f32_dpp %7, %13, %5 row_newbcast:15 row_mask:0xf bank_mask:0xf\n\t" \
    "v_fmac_f32_dpp %7, %14, %6 row_newbcast:15 row_mask:0xf bank_mask:0xf\n\t" \
    "v_xor_b32 %7, 0x80000000, %7\n\t" \
    ""

constexpr int SC_KKT = 0, SC_RRT = 2048, SC_BHT = 4096, SC_KHT = 6144, SC_BHJ = 8192, SC_KHJ = 10240, SC_MBF = 12288, SC_RHF = 13312, SC_WLF = 14336, SC_STRIDE = 15360;
__device__ __forceinline__ bf16x8 mk8(unsigned a, unsigned b, unsigned c, unsigned d) { const u32x4 w = {a, b, c, d}; return __builtin_bit_cast(bf16x8, w); }
typedef short bf16x4 __attribute__((ext_vector_type(4)));
__device__ __forceinline__ bf16x4 mk4(unsigned a, unsigned b) { const u32x2 w = {a, b}; return __builtin_bit_cast(bf16x4, w); }
__device__ __forceinline__ void phase_rwkv_scan2(const Params& p, int j, char* lds_, bf16_t* Y, int dsel  ) {
    const bf16_t* R = (const bf16_t*)(p.ws + OFF_R); const bf16_t* Kb = (const bf16_t*)(p.ws + OFF_K);
    const bf16_t* V = (const bf16_t*)(p.ws + OFF_VF); const bf16_t* KK = (const bf16_t*)(p.ws + OFF_H);
    const bf16_t* LW = (const bf16_t*)(p.ws + OFF_LW); const bf16_t* AD = (const bf16_t*)(p.ws + OFF_AD);
    const int tid = tidx(), lane = tid & 63, wid = __builtin_amdgcn_readfirstlane(tid >> 6), cl = wid >> 2, q = wid & 3, g = lane >> 4, li = lane & 15;
    LAS unsigned char* wl = (LAS unsigned char*)lds_ + wid * SC_STRIDE;
    for (int cp = blockIdx.x; cp < 256; cp += gridDim.x) {
        const int chain = cp * 2 + cl, d = chain & 1, bh = chain >> 1, b = bh >> 4, h = bh & 15;
        if (dsel >= 0 && d != dsel) continue;
        const int col = h * 64 + lane;
        const int vcol = h * 64 + q * 16 + li;
        const float ka = p.in[22][(size_t)j * D + col];
        const bf16_t* LWd = LW + (size_t)d * NT * D; const bf16_t* ADd = AD + (size_t)d * NT * D;
        bf16_t* Yd = Y + (size_t)d * NT * D;
        const int dir = d ? -1 : 1;
        f32x4 T[4];
#pragma unroll
        for (int jb = 0; jb < 4; ++jb) T[jb] = (f32x4){0.f, 0.f, 0.f, 0.f};
        for (int c = 0; c < (TC + TL) / 16; ++c) {
            const int s0 = c * 16;
            int row0;
            if (s0 < TC) row0 = NLAT + b * TC + (d ? (TC - 1 - s0) : s0);
            else { const int tl = s0 - TC; row0 = b * TL + (d ? (TL - 1 - tl) : tl); }
            {
                float cw = 0.f, ep_prev = 1.f;
                unsigned bhp[8], khp[8];
                float bh_e = 0.f, kh_e = 0.f;
#pragma unroll
                for (int t = 0; t < 16; ++t) {
                    const size_t o = (size_t)(row0 + t * dir) * D + col;
                    const float rv = bf2f(R[o]), kkv = bf2f(KK[o]), kv = bf2f(Kb[o]), lwv = bf2f(LWd[o]), av = bf2f(ADd[o]);
                    cw += lwv;
                    const float ep = __expf(cw), em = __expf(-cw);
                    const float kkt = kkv * ep_prev, rt = rv * ep, bhv = kkv * av * em, khv = kv * (1.f + (av - 1.f) * ka) * em;
                    ep_prev = ep;
                    *(LAS bf16_t*)(wl + SC_KKT + t * 128 + lane * 2) = (bf16_t)(pack2(kkt, 0.f) & 0xffffu);
                    *(LAS bf16_t*)(wl + SC_RRT + t * 128 + lane * 2) = (bf16_t)(pack2(rt, 0.f) & 0xffffu);
                    *(LAS bf16_t*)(wl + SC_BHT + t * 128 + lane * 2) = (bf16_t)(pack2(bhv, 0.f) & 0xffffu);
                    *(LAS bf16_t*)(wl + SC_KHT + t * 128 + lane * 2) = (bf16_t)(pack2(khv, 0.f) & 0xffffu);
                    if (t & 1) { bhp[t >> 1] = pack2(bh_e, bhv); khp[t >> 1] = pack2(kh_e, khv); } else { bh_e = bhv; kh_e = khv; }
                }
                *(LAS u32x4*)(wl + SC_BHJ + lane * 32) = (u32x4){bhp[0], bhp[1], bhp[2], bhp[3]};
                *(LAS u32x4*)(wl + SC_BHJ + lane * 32 + 16) = (u32x4){bhp[4], bhp[5], bhp[6], bhp[7]};
                *(LAS u32x4*)(wl + SC_KHJ + lane * 32) = (u32x4){khp[0], khp[1], khp[2], khp[3]};
                *(LAS u32x4*)(wl + SC_KHJ + lane * 32 + 16) = (u32x4){khp[4], khp[5], khp[6], khp[7]};
                *(LAS float*)(wl + SC_WLF + lane * 4) = ep_prev;
            }
            unsigned vw0, vw1;
            {
                const size_t o = (size_t)(row0 + (4 * g) * dir) * D + vcol; const long st = (long)dir * D;
                const unsigned v0 = V[o], v1 = V[o + st], v2 = V[o + 2 * st], v3 = V[o + 3 * st];
                vw0 = v0 | (v1 << 16); vw1 = v2 | (v3 << 16);
            }
            asm volatile("" ::: "memory");
            f32x4 Mb = {0.f, 0.f, 0.f, 0.f}, Mk = Mb, Nb = Mb, Nk = Mb;
#pragma unroll
            for (int kk = 0; kk < 2; ++kk) {
                const int ko = li * 128 + (32 * kk + 8 * g) * 2;
                const bf16x8 aB = *(const LAS bf16x8*)(wl + SC_BHT + ko), aK = *(const LAS bf16x8*)(wl + SC_KHT + ko);
                const bf16x8 bK = *(const LAS bf16x8*)(wl + SC_KKT + ko), bR = *(const LAS bf16x8*)(wl + SC_RRT + ko);
                Mb = __builtin_amdgcn_mfma_f32_16x16x32_bf16(aB, bK, Mb, 0, 0, 0);
                Mk = __builtin_amdgcn_mfma_f32_16x16x32_bf16(aK, bK, Mk, 0, 0, 0);
                Nb = __builtin_amdgcn_mfma_f32_16x16x32_bf16(aB, bR, Nb, 0, 0, 0);
                Nk = __builtin_amdgcn_mfma_f32_16x16x32_bf16(aK, bR, Nk, 0, 0, 0);
            }
#pragma unroll
            for (int r = 0; r < 4; ++r) {
                const int s = 4 * g + r;
                Mb[r] = s < li ? Mb[r] : 0.f; Mk[r] = s < li ? Mk[r] : 0.f;
                Nb[r] = s <= li ? Nb[r] : 0.f; Nk[r] = s <= li ? Nk[r] : 0.f;
            }
            f32x4 PT = {0.f, 0.f, 0.f, 0.f}, QT = PT;
#pragma unroll
            for (int kk = 0; kk < 2; ++kk) {
                const bf16x8 bw = mk8(pack2(T[2 * kk][0], T[2 * kk][1]), pack2(T[2 * kk][2], T[2 * kk][3]), pack2(T[2 * kk + 1][0], T[2 * kk + 1][1]), pack2(T[2 * kk + 1][2], T[2 * kk + 1][3]));
                const int ko = li * 128 + (32 * kk + 4 * g) * 2;
                const u32x2 k0 = *(const LAS u32x2*)(wl + SC_KKT + ko), k1 = *(const LAS u32x2*)(wl + SC_KKT + ko + 32);
                const u32x2 r0 = *(const LAS u32x2*)(wl + SC_RRT + ko), r1 = *(const LAS u32x2*)(wl + SC_RRT + ko + 32);
                PT = __builtin_amdgcn_mfma_f32_16x16x32_bf16(mk8(k0[0], k0[1], k1[0], k1[1]), bw, PT, 0, 0, 0);
                QT = __builtin_amdgcn_mfma_f32_16x16x32_bf16(mk8(r0[0], r0[1], r1[0], r1[1]), bw, QT, 0, 0, 0);
            }
            const f32x4 RT = __builtin_amdgcn_mfma_f32_16x16x32_bf16(mk8(pack2(Mk[0], Mk[1]), pack2(Mk[2], Mk[3]), 0u, 0u), mk8(vw0, vw1, 0u, 0u), PT, 0, 0, 0);
            *(LAS f32x4*)(wl + SC_RHF + li * 64 + g * 16) = RT;
#pragma unroll
            for (int r = 0; r < 4; ++r) *(LAS float*)(wl + SC_MBF + (4 * g + r) * 64 + li * 4) = Mb[r];
            asm volatile("" ::: "memory");
            float x0, x1, x2, x3, x4, x5, x6, x7, x8, x9, x10, x11, x12, x13, x14, x15;
            { const f32x4 u = *(const LAS f32x4*)(wl + SC_RHF + li * 64); x0 = u[0]; x1 = u[1]; x2 = u[2]; x3 = u[3]; }
            { const f32x4 u = *(const LAS f32x4*)(wl + SC_RHF + li * 64 + 16); x4 = u[0]; x5 = u[1]; x6 = u[2]; x7 = u[3]; }
            { const f32x4 u = *(const LAS f32x4*)(wl + SC_RHF + li * 64 + 32); x8 = u[0]; x9 = u[1]; x10 = u[2]; x11 = u[3]; }
            { const f32x4 u = *(const LAS f32x4*)(wl + SC_RHF + li * 64 + 48); x12 = u[0]; x13 = u[1]; x14 = u[2]; x15 = u[3]; }
            float m0, m1, m2, m3, m4, m5, m6, m7, m8, m9, m10, m11, m12, m13, m14;
#define LDM(s) (*(const LAS float*)(wl + SC_MBF + (s) * 64 + li * 4))
            m0 = LDM(0); m1 = LDM(1); m2 = LDM(2); m3 = LDM(3); m4 = LDM(4); m5 = LDM(5); m6 = LDM(6); m7 = LDM(7);
            m8 = LDM(8); m9 = LDM(9); m10 = LDM(10); m11 = LDM(11); m12 = LDM(12); m13 = LDM(13); m14 = LDM(14);
#undef LDM
            asm volatile(TRI_ASM1 : "+v"(x0), "+v"(x1), "+v"(x2), "+v"(x3), "+v"(x4), "+v"(x5), "+v"(x6), "+v"(x7)
                                  : "v"(m0), "v"(m1), "v"(m2), "v"(m3), "v"(m4), "v"(m5), "v"(m6));
            asm volatile(TRI_ASM2 : "+v"(x8), "+v"(x9), "+v"(x10), "+v"(x11), "+v"(x12), "+v"(x13), "+v"(x14), "+v"(x15)
                                  : "v"(x0), "v"(x1), "v"(x2), "v"(x3), "v"(x4), "v"(x5), "v"(x6), "v"(x7), "v"(m0), "v"(m1), "v"(m2), "v"(m3), "v"(m4), "v"(m5), "v"(m6), "v"(m7));
            asm volatile(TRI_ASM3 : "+v"(x8), "+v"(x9), "+v"(x10), "+v"(x11), "+v"(x12), "+v"(x13), "+v"(x14), "+v"(x15)
                                  : "v"(m8), "v"(m9), "v"(m10), "v"(m11), "v"(m12), "v"(m13), "v"(m14));
            const float xs0 = g == 0 ? x0 : (g == 1 ? x4 : (g == 2 ? x8 : x12));
            const float xs1 = g == 0 ? x1 : (g == 1 ? x5 : (g == 2 ? x9 : x13));
            const float xs2 = g == 0 ? x2 : (g == 1 ? x6 : (g == 2 ? x10 : x14));
            const float xs3 = g == 0 ? x3 : (g == 1 ? x7 : (g == 2 ? x11 : x15));
            const bf16x8 bop = mk8(pack2(xs0, xs1), pack2(xs2, xs3), vw0, vw1);
            const f32x4 YT = __builtin_amdgcn_mfma_f32_16x16x32_bf16(mk8(pack2(Nb[0], Nb[1]), pack2(Nb[2], Nb[3]), pack2(Nk[0], Nk[1]), pack2(Nk[2], Nk[3])), bop, QT, 0, 0, 0);
#pragma unroll
            for (int r = 0; r < 4; ++r) Yd[(size_t)(row0 + (4 * g + r) * dir) * D + vcol] = (bf16_t)(pack2(YT[r], 0.f) & 0xffffu);
#pragma unroll
            for (int jb = 0; jb < 4; ++jb) {
                const u32x2 b2 = *(const LAS u32x2*)(wl + SC_BHJ + (16 * jb + li) * 32 + g * 8), k2 = *(const LAS u32x2*)(wl + SC_KHJ + (16 * jb + li) * 32 + g * 8);
                T[jb] = __builtin_amdgcn_mfma_f32_16x16x32_bf16(mk8(b2[0], b2[1], k2[0], k2[1]), bop, T[jb], 0, 0, 0);
                const f32x4 wv = *(const LAS f32x4*)(wl + SC_WLF + (16 * jb + 4 * g) * 4);
                T[jb] = T[jb] * wv;
            }
            asm volatile("" ::: "memory");
        }
    }
}

#define TRI2_ASMA \
    "s_nop 1\n\t" \
    "v_xor_b32 %0, 0x80000000, %0\n\t" \
    "v_fmac_f32_dpp %1, %16, %0 row_newbcast:1 row_mask:0xf bank_mask:0xf\n\t" \
    "v_fmac_f32_dpp %2, %16, %0 row_newbcast:2 row_mask:0xf bank_mask:0xf\n\t" \
    "v_fmac_f32_dpp %3, %16, %0 row_newbcast:3 row_mask:0xf bank_mask:0xf\n\t" \
    "v_fmac_f32_dpp %4, %16, %0 row_newbcast:4 row_mask:0xf bank_mask:0xf\n\t" \
    "v_fmac_f32_dpp %5, %16, %0 row_newbcast:5 row_mask:0xf bank_mask:0xf\n\t" \
    "v_fmac_f32_dpp %6, %16, %0 row_newbcast:6 row_mask:0xf bank_mask:0xf\n\t" \
    "v_fmac_f32_dpp %7, %16, %0 row_newbcast:7 row_mask:0xf bank_mask:0xf\n\t" \
    "v_fmac_f32_dpp %8, %16, %0 row_newbcast:8 row_mask:0xf bank_mask:0xf\n\t" \
    "v_fmac_f32_dpp %9, %16, %0 row_newbcast:9 row_mask:0xf bank_mask:0xf\n\t" \
    "v_fmac_f32_dpp %10, %16, %0 row_newbcast:10 row_mask:0xf bank_mask:0xf\n\t" \
    "v_fmac_f32_dpp %11, %16, %0 row_newbcast:11 row_mask:0xf bank_mask:0xf\n\t" \
    "v_fmac_f32_dpp %12, %16, %0 row_newbcast:12 row_mask:0xf bank_mask:0xf\n\t" \
    "v_fmac_f32_dpp %13, %16, %0 row_newbcast:13 row_mask:0xf bank_mask:0xf\n\t" \
    "v_fmac_f32_dpp %14, %16, %0 row_newbcast:14 row_mask:0xf bank_mask:0xf\n\t" \
    "v_fmac_f32_dpp %15, %16, %0 row_newbcast:15 row_mask:0xf bank_mask:0xf\n\t" \
    "v_xor_b32 %1, 0x80000000, %1\n\t" \
    "v_fmac_f32_dpp %2, %17, %1 row_newbcast:2 row_mask:0xf bank_mask:0xf\n\t" \
    "v_fmac_f32_dpp %3, %17, %1 row_newbcast:3 row_mask:0xf bank_mask:0xf\n\t" \
    "v_fmac_f32_dpp %4, %17, %1 row_newbcast:4 row_mask:0xf bank_mask:0xf\n\t" \
    "v_fmac_f32_dpp %5, %17, %1 row_newbcast:5 row_mask:0xf bank_mask:0xf\n\t" \
    "v_fmac_f32_dpp %6, %17, %1 row_newbcast:6 row_mask:0xf bank_mask:0xf\n\t" \
    "v_fmac_f32_dpp %7, %17, %1 row_newbcast:7 row_mask:0xf bank_mask:0xf\n\t" \
    "v_fmac_f32_dpp %8, %17, %1 row_newbcast:8 row_mask:0xf bank_mask:0xf\n\t" \
    "v_fmac_f32_dpp %9, %17, %1 row_newbcast:9 row_mask:0xf bank_mask:0xf\n\t" \
    "v_fmac_f32_dpp %10, %17, %1 row_newbcast:10 row_mask:0xf bank_mask:0xf\n\t" \
    "v_fmac_f32_dpp %11, %17, %1 row_newbcast:11 row_mask:0xf bank_mask:0xf\n\t" \
    "v_fmac_f32_dpp %12, %17, %1 row_newbcast:12 row_mask:0xf bank_mask:0xf\n\t" \
    "v_fmac_f32_dpp %13, %17, %1 row_newbcast:13 row_mask:0xf bank_mask:0xf\n\t" \
    "v_fmac_f32_dpp %14, %17, %1 row_newbcast:14 row_mask:0xf bank_mask:0xf\n\t" \
    "v_fmac_f32_dpp %15, %17, %1 row_newbcast:15 row_mask:0xf bank_mask:0xf\n\t" \
    "v_xor_b32 %2, 0x80000000, %2\n\t" \
    "v_fmac_f32_dpp %3, %18, %2 row_newbcast:3 row_mask:0xf bank_mask:0xf\n\t" \
    "v_fmac_f32_dpp %4, %18, %2 row_newbcast:4 row_mask:0xf bank_mask:0xf\n\t" \
    "v_fmac_f32_dpp %5, %18, %2 row_newbcast:5 row_mask:0xf bank_mask:0xf\n\t" \
    "v_fmac_f32_dpp %6, %18, %2 row_newbcast:6 row_mask:0xf bank_mask:0xf\n\t" \
    "v_fmac_f32_dpp %7, %18, %2 row_newbcast:7 row_mask:0xf bank_mask:0xf\n\t" \
    "v_fmac_f32_dpp %8, %18, %2 row_newbcast:8 row_mask:0xf bank_mask:0xf\n\t" \
    "v_fmac_f32_dpp %9, %18, %2 row_newbcast:9 row_mask:0xf bank_mask:0xf\n\t" \
    "v_fmac_f32_dpp %10, %18, %2 row_newbcast:10 row_mask:0xf bank_mask:0xf\n\t" \
    "v_fmac_f32_dpp %11, %18, %2 row_newbcast:11 row_mask:0xf bank_mask:0xf\n\t" \
    "v_fmac_f32_dpp %12, %18, %2 row_newbcast:12 row_mask:0xf bank_mask:0xf\n\t" \
    "v_fmac_f32_dpp %13, %18, %2 row_newbcast:13 row_mask:0xf bank_mask:0xf\n\t" \
    "v_fmac_f32_dpp %14, %18, %2 row_newbcast:14 row_mask:0xf bank_mask:0xf\n\t" \
    "v_fmac_f32_dpp %15, %18, %2 row_newbcast:15 row_mask:0xf bank_mask:0xf\n\t" \
    "v_xor_b32 %3, 0x80000000, %3\n\t" \
    "v_fmac_f32_dpp %4, %19, %3 row_newbcast:4 row_mask:0xf bank_mask:0xf\n\t" \
    "v_fmac_f32_dpp %5, %19, %3 row_newbcast:5 row_mask:0xf bank_mask:0xf\n\t" \
    "v_fmac_f32_dpp %6, %19, %3 row_newbcast:6 row_mask:0xf bank_mask:0xf\n\t" \
    "v_fmac_f32_dpp %7, %19, %3 row_newbcast:7 row_mask:0xf bank_mask:0xf\n\t" \
    "v_fmac_f32_dpp %8, %19, %3 row_newbcast:8 row_mask:0xf bank_mask:0xf\n\t" \
    "v_fmac_f32_dpp %9, %19, %3 row_newbcast:9 row_mask:0xf bank_mask:0xf\n\t" \
    "v_fmac_f32_dpp %10, %19, %3 row_newbcast:10 row_mask:0xf bank_mask:0xf\n\t" \
    "v_fmac_f32_dpp %11, %19, %3 row_newbcast:11 row_mask:0xf bank_mask:0xf\n\t" \
    "v_fmac_f32_dpp %12, %19, %3 row_newbcast:12 row_mask:0xf bank_mask:0xf\n\t" \
    "v_fmac_f32_dpp %13, %19, %3 row_newbcast:13 row_mask:0xf bank_mask:0xf\n\t" \
    "v_fmac_f32_dpp %14, %19, %3 row_newbcast:14 row_mask:0xf bank_mask:0xf\n\t" \
    "v_fmac_f32_dpp %15, %19, %3 row_newbcast:15 row_mask:0xf bank_mask:0xf\n\t" \
    "v_xor_b32 %4, 0x80000000, %4\n\t" \
    "v_fmac_f32_dpp %5, %20, %4 row_newbcast:5 row_mask:0xf bank_mask:0xf\n\t" \
    "v_fmac_f32_dpp %6, %20, %4 row_newbcast:6 row_mask:0xf bank_mask:0xf\n\t" \
    "v_fmac_f32_dpp %7, %20, %4 row_newbcast:7 row_mask:0xf bank_mask:0xf\n\t" \
    "v_fmac_f32_dpp %8, %20, %4 row_newbcast:8 row_mask:0xf bank_mask:0xf\n\t" \
    "v_fmac_f32_dpp %9, %20, %4 row_newbcast:9 row_mask:0xf bank_mask:0xf\n\t" \
    "v_fmac_f32_dpp %10, %20, %4 row_newbcast:10 row_mask:0xf bank_mask:0xf\n\t" \
    "v_fmac_f32_dpp %11, %20, %4 row_newbcast:11 row_mask:0xf bank_mask:0xf\n\t" \
    "v_fmac_f32_dpp %12, %20, %4 row_newbcast:12 row_mask:0xf bank_mask:0xf\n\t" \
    "v_fmac_f32_dpp %13, %20, %4 row_newbcast:13 row_mask:0xf bank_mask:0xf\n\t" \
    "v_fmac_f32_dpp %14, %20, %4 row_newbcast:14 row_mask:0xf bank_mask:0xf\n\t" \
    "v_fmac_f32_dpp %15, %20, %4 row_newbcast:15 row_mask:0xf bank_mask:0xf\n\t" \
    "v_xor_b32 %5, 0x80000000, %5\n\t" \
    "v_fmac_f32_dpp %6, %21, %5 row_newbcast:6 row_mask:0xf bank_mask:0xf\n\t" \
    "v_fmac_f32_dpp %7, %21, %5 row_newbcast:7 row_mask:0xf bank_mask:0xf\n\t" \
    "v_fmac_f32_dpp %8, %21, %5 row_newbcast:8 row_mask:0xf bank_mask:0xf\n\t" \
    "v_fmac_f32_dpp %9, %21, %5 row_newbcast:9 row_mask:0xf bank_mask:0xf\n\t" \
    "v_fmac_f32_dpp %10, %21, %5 row_newbcast:10 row_mask:0xf bank_mask:0xf\n\t" \
    "v_fmac_f32_dpp %11, %21, %5 row_newbcast:11 row_mask:0xf bank_mask:0xf\n\t" \
    "v_fmac_f32_dpp %12, %21, %5 row_newbcast:12 row_mask:0xf bank_mask:0xf\n\t" \
    "v_fmac_f32_dpp %13, %21, %5 row_newbcast:13 row_mask:0xf bank_mask:0xf\n\t" \
    "v_fmac_f32_dpp %14, %21, %5 row_newbcast:14 row_mask:0xf bank_mask:0xf\n\t" \
    "v_fmac_f32_dpp %15, %21, %5 row_newbcast:15 row_mask:0xf bank_mask:0xf\n\t" \
    "v_xor_b32 %6, 0x80000000, %6\n\t" \
    "v_fmac_f32_dpp %7, %22, %6 row_newbcast:7 row_mask:0xf bank_mask:0xf\n\t" \
    "v_fmac_f32_dpp %8, %22, %6 row_newbcast:8 row_mask:0xf bank_mask:0xf\n\t" \
    "v_fmac_f32_dpp %9, %22, %6 row_newbcast:9 row_mask:0xf bank_mask:0xf\n\t" \
    "v_fmac_f32_dpp %10, %22, %6 row_newbcast:10 row_mask:0xf bank_mask:0xf\n\t" \
    "v_fmac_f32_dpp %11, %22, %6 row_newbcast:11 row_mask:0xf bank_mask:0xf\n\t" \
    "v_fmac_f32_dpp %12, %22, %6 row_newbcast:12 row_mask:0xf bank_mask:0xf\n\t" \
    "v_fmac_f32_dpp %13, %22, %6 row_newbcast:13 row_mask:0xf bank_mask:0xf\n\t" \
    "v_fmac_f32_dpp %14, %22, %6 row_newbcast:14 row_mask:0xf bank_mask:0xf\n\t" \
    "v_fmac_f32_dpp %15, %22, %6 row_newbcast:15 row_mask:0xf bank_mask:0xf\n\t" \
    "v_xor_b32 %7, 0x80000000, %7\n\t" \
    "v_fmac_f32_dpp %8, %23, %7 row_newbcast:8 row_mask:0xf bank_mask:0xf\n\t" \
    "v_fmac_f32_dpp %9, %23, %7 row_newbcast:9 row_mask:0xf bank_mask:0xf\n\t" \
    "v_fmac_f32_dpp %10, %23, %7 row_newbcast:10 row_mask:0xf bank_mask:0xf\n\t" \
    "v_fmac_f32_dpp %11, %23, %7 row_newbcast:11 row_mask:0xf bank_mask:0xf\n\t" \
    "v_fmac_f32_dpp %12, %23, %7 row_newbcast:12 row_mask:0xf bank_mask:0xf\n\t" \
    "v_fmac_f32_dpp %13, %23, %7 row_newbcast:13 row_mask:0xf bank_mask:0xf\n\t" \
    "v_fmac_f32_dpp %14, %23, %7 row_newbcast:14 row_mask:0xf bank_mask:0xf\n\t" \
    "v_fmac_f32_dpp %15, %23, %7 row_newbcast:15 row_mask:0xf bank_mask:0xf\n\t" \
    ""
#define TRI2_ASMB \
    "s_nop 1\n\t" \
    "v_xor_b32 %0, 0x80000000, %0\n\t" \
    "v_fmac_f32_dpp %1, %8, %0 row_newbcast:9 row_mask:0xf bank_mask:0xf\n\t" \
    "v_fmac_f32_dpp %2, %8, %0 row_newbcast:10 row_mask:0xf bank_mask:0xf\n\t" \
    "v_fmac_f32_dpp %3, %8, %0 row_newbcast:11 row_mask:0xf bank_mask:0xf\n\t" \
    "v_fmac_f32_dpp %4, %8, %0 row_newbcast:12 row_mask:0xf bank_mask:0xf\n\t" \
    "v_fmac_f32_dpp %5, %8, %0 row_newbcast:13 row_mask:0xf bank_mask:0xf\n\t" \
    "v_fmac_f32_dpp %6, %8, %0 row_newbcast:14 row_mask:0xf bank_mask:0xf\n\t" \
    "v_fmac_f32_dpp %7, %8, %0 row_newbcast:15 row_mask:0xf bank_mask:0xf\n\t" \
    "v_xor_b32 %1, 0x80000000, %1\n\t" \
    "v_fmac_f32_dpp %2, %9, %1 row_newbcast:10 row_mask:0xf bank_mask:0xf\n\t" \
    "v_fmac_f32_dpp %3, %9, %1 row_newbcast:11 row_mask:0xf bank_mask:0xf\n\t" \
    "v_fmac_f32_dpp %4, %9, %1 row_newbcast:12 row_mask:0xf bank_mask:0xf\n\t" \
    "v_fmac_f32_dpp %5, %9, %1 row_newbcast:13 row_mask:0xf bank_mask:0xf\n\t" \
    "v_fmac_f32_dpp %6, %9, %1 row_newbcast:14 row_mask:0xf bank_mask:0xf\n\t" \
    "v_fmac_f32_dpp %7, %9, %1 row_newbcast:15 row_mask:0xf bank_mask:0xf\n\t" \
    "v_xor_b32 %2, 0x80000000, %2\n\t" \
    "v_fmac_f32_dpp %3, %10, %2 row_newbcast:11 row_mask:0xf bank_mask:0xf\n\t" \
    "v_fmac_f32_dpp %4, %10, %2 row_newbcast:12 row_mask:0xf bank_mask:0xf\n\t" \
    "v_fmac_f32_dpp %5, %10, %2 row_newbcast:13 row_mask:0xf bank_mask:0xf\n\t" \
    "v_fmac_f32_dpp %6, %10, %2 row_newbcast:14 row_mask:0xf bank_mask:0xf\n\t" \
    "v_fmac_f32_dpp %7, %10, %2 row_newbcast:15 row_mask:0xf bank_mask:0xf\n\t" \
    "v_xor_b32 %3, 0x80000000, %3\n\t" \
    "v_fmac_f32_dpp %4, %11, %3 row_newbcast:12 row_mask:0xf bank_mask:0xf\n\t" \
    "v_fmac_f32_dpp %5, %11, %3 row_newbcast:13 row_mask:0xf bank_mask:0xf\n\t" \
    "v_fmac_f32_dpp %6, %11, %3 row_newbcast:14 row_mask:0xf bank_mask:0xf\n\t" \
    "v_fmac_f32_dpp %7, %11, %3 row_newbcast:15 row_mask:0xf bank_mask:0xf\n\t" \
    "v_xor_b32 %4, 0x80000000, %4\n\t" \
    "v_fmac_f32_dpp %5, %12, %4 row_newbcast:13 row_mask:0xf bank_mask:0xf\n\t" \
    "v_fmac_f32_dpp %6, %12, %4 row_newbcast:14 row_mask:0xf bank_mask:0xf\n\t" \
    "v_fmac_f32_dpp %7, %12, %4 row_newbcast:15 row_mask:0xf bank_mask:0xf\n\t" \
    "v_xor_b32 %5, 0x80000000, %5\n\t" \
    "v_fmac_f32_dpp %6, %13, %5 row_newbcast:14 row_mask:0xf bank_mask:0xf\n\t" \
    "v_fmac_f32_dpp %7, %13, %5 row_newbcast:15 row_mask:0xf bank_mask:0xf\n\t" \
    "v_xor_b32 %6, 0x80000000, %6\n\t" \
    "v_fmac_f32_dpp %7, %14, %6 row_newbcast:15 row_mask:0xf bank_mask:0xf\n\t" \
    "v_xor_b32 %7, 0x80000000, %7\n\t" \
    ""

constexpr int S3_RS = 144;
constexpr int S3_KKT = 0, S3_RRT = 2304, S3_BHT = 4608, S3_KHT = 6912, S3_BHJ = 9216, S3_KHJ = 11264, S3_WLF = 13312, S3_IMG = 13568;
constexpr int S3_PRIV = 4 * S3_IMG, S3_MBF = 0, S3_RHF = 1024, S3_PSTRIDE = 2048;
__device__ __forceinline__ void phase_rwkv_scan3(const Params& p, int j, char* lds_, bf16_t* Y) {
    const bf16_t* R = (const bf16_t*)(p.ws + OFF_R); const bf16_t* Kb = (const bf16_t*)(p.ws + OFF_K);
    const bf16_t* V = (const bf16_t*)(p.ws + OFF_VF); const bf16_t* KK = (const bf16_t*)(p.ws + OFF_H);
    const bf16_t* LW = (const bf16_t*)(p.ws + OFF_LW); const bf16_t* AD = (const bf16_t*)(p.ws + OFF_AD);
    const int tid = tidx(), lane = tid & 63, wid = __builtin_amdgcn_readfirstlane(tid >> 6), cl = wid >> 2, q = wid & 3, g = lane >> 4, li = lane & 15;
    LAS unsigned char* img0 = (LAS unsigned char*)lds_ + cl * 2 * S3_IMG;
    LAS unsigned char* pw = (LAS unsigned char*)lds_ + S3_PRIV + wid * S3_PSTRIDE;
    f32x4 msk_lt, msk_le, msk_gt;
#pragma unroll
    for (int r = 0; r < 4; ++r) { msk_lt[r] = (4 * g + r) < li ? 1.f : 0.f; msk_le[r] = (4 * g + r) <= li ? 1.f : 0.f; msk_gt[r] = (4 * g + r) > li ? 1.f : 0.f; }
    for (int cp = blockIdx.x; cp < 256; cp += gridDim.x) {
        const int chain = cp * 2 + cl, d = chain & 1, bh = chain >> 1, b = bh >> 4, h = bh & 15;
        const int vcol = h * 64 + q * 16 + li, vcolw = vcol & ~1, jcol = q * 16 + li;
        const unsigned selv = (vcol & 1) ? 0x03020c0cu : 0x01000c0cu;
        const unsigned selp = (vcol & 1) ? 0x07060302u : 0x05040100u;
        const float ka = p.in[22][(size_t)j * D + vcol];
        const bf16_t* ADd = AD + (size_t)d * NT * D;
        const bf16_t* w2t = wsm(p, j, WJ_W2) + (size_t)d * D * 64 + (size_t)vcol * 64;
        const bf16x8 Bw0 = *(const bf16x8*)(w2t + g * 8), Bw1 = *(const bf16x8*)(w2t + 32 + g * 8);
        const float w0b = p.in[10][((size_t)j * 2 + d) * D + vcol] * -1.44269504089f;
        const bf16_t* LD0 = (const bf16_t*)(p.ws + OFF_LD);
        const unsigned voa = (unsigned)((d ? 15 - li : li) * 256 + (d * 64 + g * 8) * 2);
        bf16_t* Yd = Y + (size_t)d * NT * D;
        const int dir = d ? -1 : 1;
        auto row_first = [&](int c) -> int {
            const int s0 = c * 16;
            if (s0 < TC) return NLAT + b * TC + (d ? (TC - 1 - s0) : s0);
            const int tl = s0 - TC; return b * TL + (d ? (TL - 1 - tl) : tl);
        };
#define UNPV(w) __uint_as_float(__builtin_amdgcn_perm(0u, (w), selv))
        const unsigned LA0 = ((4 * g <= li) ? 0x3F80u : 0u) | ((4 * g + 1 <= li) ? 0x3F800000u : 0u), LA1 = ((4 * g + 2 <= li) ? 0x3F80u : 0u) | ((4 * g + 3 <= li) ? 0x3F800000u : 0u);
        unsigned vov[4];
#pragma unroll
        for (int e = 0; e < 4; ++e) vov[e] = (unsigned)((d ? 15 - (4 * g + e) : 4 * g + e) * (D * 2) + vcolw * 2);
#define LDG(P, VO) (*(const unsigned*)((P) + (VO)))
        unsigned rr[4], rkk[4], rk[4], ra[4], rv[4]; bf16x8 rwa0, rwa1;
        auto issue_loads = [&](int c) {
            const int r0 = row_first(c);
            const size_t rbo = (size_t)(d ? r0 - 15 : r0) * (D * 2);
            const char* bLD = (const char*)LD0 + (size_t)(d ? r0 - 15 : r0) * 256; const char* bR = (const char*)R + rbo; const char* bKK = (const char*)KK + rbo;
            const char* bK = (const char*)Kb + rbo; const char* bA = (const char*)ADd + rbo; const char* bV = (const char*)V + rbo;
#pragma unroll
            for (int e = 0; e < 4; ++e) { rr[e] = LDG(bR, vov[e]); rkk[e] = LDG(bKK, vov[e]); rk[e] = LDG(bK, vov[e]); ra[e] = LDG(bA, vov[e]); rv[e] = LDG(bV, vov[e]); }
            rwa0 = *(const bf16x8*)(bLD + voa); rwa1 = *(const bf16x8*)(bLD + voa + 64);
        };
        issue_loads(0);
        f32x4 T[4];
#pragma unroll
        for (int jb = 0; jb < 4; ++jb) T[jb] = (f32x4){0.f, 0.f, 0.f, 0.f};
        auto do_prep = [&](int cc, unsigned& w0, unsigned& w1) {
            LAS unsigned char* im = img0 + (cc & 1) * S3_IMG;
            {
                const f32x4 Z4p = {0.f, 0.f, 0.f, 0.f};
                f32x4 WP = __builtin_amdgcn_mfma_f32_16x16x32_bf16(rwa0, Bw0, Z4p, 0, 0, 0);
                WP = __builtin_amdgcn_mfma_f32_16x16x32_bf16(rwa1, Bw1, WP, 0, 0, 0);
                unsigned lwp0, lwp1;
                {
                    const f32x2_t x0 = {WP[0], WP[1]}, x1 = {WP[2], WP[3]};
                    const f32x2_t t0 = x0 * -1.44269504089f + w0b, t1 = x1 * -1.44269504089f + w0b;
                    f32x2_t e0, e1; e0.x = __builtin_amdgcn_exp2f(t0.x); e0.y = __builtin_amdgcn_exp2f(t0.y); e1.x = __builtin_amdgcn_exp2f(t1.x); e1.y = __builtin_amdgcn_exp2f(t1.y);
                    const f32x2_t d0 = e0 + 1.0f, d1 = e1 + 1.0f;
                    lwp0 = pack2(-0.6065306597f * __builtin_amdgcn_rcpf(d0.x), -0.6065306597f * __builtin_amdgcn_rcpf(d0.y));
                    lwp1 = pack2(-0.6065306597f * __builtin_amdgcn_rcpf(d1.x), -0.6065306597f * __builtin_amdgcn_rcpf(d1.y));
                }
                const f32x4 CW = __builtin_amdgcn_mfma_f32_16x16x16bf16_1k(mk4(LA0, LA1), mk4(lwp0, lwp1), Z4p, 0, 0, 0);
                float ep_prev = __expf(CW[0] - bflo(lwp0));
                float bhv[4], khv[4];
#pragma unroll
                for (int e = 0; e < 4; ++e) {
                    const int t = 4 * g + e;
                    const float rvv = UNPV(rr[e]), kkv = UNPV(rkk[e]), kv = UNPV(rk[e]), av = UNPV(ra[e]);
                    const float ep = __expf(CW[e]), em = __expf(-CW[e]);
                    const float kkt = kkv * ep_prev, rt = rvv * ep;
                    bhv[e] = kkv * av * em; khv[e] = kv * (1.f + (av - 1.f) * ka) * em;
                    ep_prev = ep;
                    *(LAS bf16_t*)(im + S3_KKT + t * S3_RS + jcol * 2) = (bf16_t)(pack2(kkt, 0.f) & 0xffffu);
                    *(LAS bf16_t*)(im + S3_RRT + t * S3_RS + jcol * 2) = (bf16_t)(pack2(rt, 0.f) & 0xffffu);
                    *(LAS bf16_t*)(im + S3_BHT + t * S3_RS + jcol * 2) = (bf16_t)(pack2(bhv[e], 0.f) & 0xffffu);
                    *(LAS bf16_t*)(im + S3_KHT + t * S3_RS + jcol * 2) = (bf16_t)(pack2(khv[e], 0.f) & 0xffffu);
                }
                *(LAS u32x2*)(im + S3_BHJ + jcol * 32 + g * 8) = (u32x2){pack2(bhv[0], bhv[1]), pack2(bhv[2], bhv[3])};
                *(LAS u32x2*)(im + S3_KHJ + jcol * 32 + g * 8) = (u32x2){pack2(khv[0], khv[1]), pack2(khv[2], khv[3])};
                if (g == 3) *(LAS float*)(im + S3_WLF + jcol * 4) = ep_prev;
                w0 = __builtin_amdgcn_perm(rv[1], rv[0], selp); w1 = __builtin_amdgcn_perm(rv[3], rv[2], selp);
            }
        };
        constexpr int NCH = (TC + TL) / 16;
        unsigned vw0, vw1, vwn0 = 0u, vwn1 = 0u;
        do_prep(0, vw0, vw1);
        issue_loads(1);
        for (int c = 0; c < NCH; ++c) {
            const int row0 = row_first(c);
            LAS unsigned char* im = img0 + (c & 1) * S3_IMG;
            asm volatile("s_waitcnt lgkmcnt(0)" ::: "memory");
            __builtin_amdgcn_s_barrier();
            asm volatile("" ::: "memory");
            if (c + 1 < NCH) { do_prep(c + 1, vwn0, vwn1); if (c + 2 < NCH) issue_loads(c + 2); }
            f32x4 Mb = {0.f, 0.f, 0.f, 0.f}, Mk = Mb, Nb = Mb, Nk = Mb, MbT = Mb;
#pragma unroll
            for (int kk = 0; kk < 2; ++kk) {
                const int ko = li * S3_RS + (32 * kk + 8 * g) * 2;
                const bf16x8 aB = *(const LAS bf16x8*)(im + S3_BHT + ko), aK = *(const LAS bf16x8*)(im + S3_KHT + ko);
                const bf16x8 bK = *(const LAS bf16x8*)(im + S3_KKT + ko), bR = *(const LAS bf16x8*)(im + S3_RRT + ko);
                Mb = __builtin_amdgcn_mfma_f32_16x16x32_bf16(aB, bK, Mb, 0, 0, 0);
                MbT = __builtin_amdgcn_mfma_f32_16x16x32_bf16(bK, aB, MbT, 0, 0, 0);
                Mk = __builtin_amdgcn_mfma_f32_16x16x32_bf16(aK, bK, Mk, 0, 0, 0);
                Nb = __builtin_amdgcn_mfma_f32_16x16x32_bf16(aB, bR, Nb, 0, 0, 0);
                Nk = __builtin_amdgcn_mfma_f32_16x16x32_bf16(aK, bR, Nk, 0, 0, 0);
            }
            Mb = Mb * msk_lt; Mk = Mk * msk_lt; Nb = Nb * msk_le; Nk = Nk * msk_le; MbT = MbT * msk_gt;
            f32x4 PT = {0.f, 0.f, 0.f, 0.f}, QT = PT;
#pragma unroll
            for (int kk = 0; kk < 2; ++kk) {
                const bf16x8 bw = mk8(pack2(T[2 * kk][0], T[2 * kk][1]), pack2(T[2 * kk][2], T[2 * kk][3]), pack2(T[2 * kk + 1][0], T[2 * kk + 1][1]), pack2(T[2 * kk + 1][2], T[2 * kk + 1][3]));
                const int ko = li * S3_RS + (32 * kk + 4 * g) * 2;
                const u32x2 k0 = *(const LAS u32x2*)(im + S3_KKT + ko), k1 = *(const LAS u32x2*)(im + S3_KKT + ko + 32);
                const u32x2 r0 = *(const LAS u32x2*)(im + S3_RRT + ko), r1 = *(const LAS u32x2*)(im + S3_RRT + ko + 32);
                PT = __builtin_amdgcn_mfma_f32_16x16x32_bf16(mk8(k0[0], k0[1], k1[0], k1[1]), bw, PT, 0, 0, 0);
                QT = __builtin_amdgcn_mfma_f32_16x16x32_bf16(mk8(r0[0], r0[1], r1[0], r1[1]), bw, QT, 0, 0, 0);
            }
            const f32x4 RT = __builtin_amdgcn_mfma_f32_16x16x16bf16_1k(mk4(pack2(Mk[0], Mk[1]), pack2(Mk[2], Mk[3])), mk4(vw0, vw1), PT, 0, 0, 0);
#define CW(Y) pack2((Y)[0], (Y)[1]), pack2((Y)[2], (Y)[3])
#define OPND(w0, w1) mk4((w0), (w1))
            const f32x4 Z4 = {0.f, 0.f, 0.f, 0.f};
            const unsigned mb0 = pack2(Mb[0], Mb[1]), mb1 = pack2(Mb[2], Mb[3]), mt0 = pack2(MbT[0], MbT[1]), mt1 = pack2(MbT[2], MbT[3]);
            const f32x4 P1 = __builtin_amdgcn_mfma_f32_16x16x16bf16_1k(OPND(mt0, mt1), OPND(mb0, mb1), Z4, 0, 0, 0);
            const f32x4 P1T = __builtin_amdgcn_mfma_f32_16x16x16bf16_1k(OPND(mb0, mb1), OPND(mt0, mt1), Z4, 0, 0, 0);
            const unsigned p10 = pack2(P1[0], P1[1]), p11 = pack2(P1[2], P1[3]), q10 = pack2(P1T[0], P1T[1]), q11 = pack2(P1T[2], P1T[3]);
            const f32x4 P2 = __builtin_amdgcn_mfma_f32_16x16x16bf16_1k(OPND(q10, q11), OPND(p10, p11), Z4, 0, 0, 0);
            const f32x4 P2T = __builtin_amdgcn_mfma_f32_16x16x16bf16_1k(OPND(p10, p11), OPND(q10, q11), Z4, 0, 0, 0);
            const unsigned p20 = pack2(P2[0], P2[1]), p21 = pack2(P2[2], P2[3]), q20 = pack2(P2T[0], P2T[1]), q21 = pack2(P2T[2], P2T[3]);
            const f32x4 P3 = __builtin_amdgcn_mfma_f32_16x16x16bf16_1k(OPND(q20, q21), OPND(p20, p21), Z4, 0, 0, 0);
            const unsigned p30 = pack2(P3[0], P3[1]), p31 = pack2(P3[2], P3[3]);
            f32x4 Yv = __builtin_amdgcn_mfma_f32_16x16x16bf16_1k(OPND(mb0 ^ 0x80008000u, mb1 ^ 0x80008000u), OPND(pack2(RT[0], RT[1]), pack2(RT[2], RT[3])), RT, 0, 0, 0);
            Yv = __builtin_amdgcn_mfma_f32_16x16x16bf16_1k(OPND(p10, p11), OPND(pack2(Yv[0], Yv[1]), pack2(Yv[2], Yv[3])), Yv, 0, 0, 0);
            Yv = __builtin_amdgcn_mfma_f32_16x16x16bf16_1k(OPND(p20, p21), OPND(pack2(Yv[0], Yv[1]), pack2(Yv[2], Yv[3])), Yv, 0, 0, 0);
            Yv = __builtin_amdgcn_mfma_f32_16x16x16bf16_1k(OPND(p30, p31), OPND(pack2(Yv[0], Yv[1]), pack2(Yv[2], Yv[3])), Yv, 0, 0, 0);
#undef CW
#undef OPND
            const bf16x8 bop = mk8(pack2(Yv[0], Yv[1]) ^ 0x80008000u, pack2(Yv[2], Yv[3]) ^ 0x80008000u, vw0, vw1);
            const f32x4 YT = __builtin_amdgcn_mfma_f32_16x16x32_bf16(mk8(pack2(Nb[0], Nb[1]), pack2(Nb[2], Nb[3]), pack2(Nk[0], Nk[1]), pack2(Nk[2], Nk[3])), bop, QT, 0, 0, 0);
#pragma unroll
            for (int r = 0; r < 4; ++r) Yd[(size_t)(row0 + (4 * g + r) * dir) * D + vcol] = (bf16_t)(pack2(YT[r], 0.f) & 0xffffu);
#pragma unroll
            for (int jb = 0; jb < 4; ++jb) {
                const u32x2 b2 = *(const LAS u32x2*)(im + S3_BHJ + (16 * jb + li) * 32 + g * 8), k2 = *(const LAS u32x2*)(im + S3_KHJ + (16 * jb + li) * 32 + g * 8);
                T[jb] = __builtin_amdgcn_mfma_f32_16x16x32_bf16(mk8(b2[0], b2[1], k2[0], k2[1]), bop, T[jb], 0, 0, 0);
                const f32x4 wv = *(const LAS f32x4*)(im + S3_WLF + (16 * jb + 4 * g) * 4);
                T[jb] = T[jb] * wv;
            }
            vw0 = vwn0; vw1 = vwn1;
        }
#undef LDG
#undef UNPV
        asm volatile("s_waitcnt lgkmcnt(0)" ::: "memory");
        __builtin_amdgcn_s_barrier();
    }
}

#ifndef SCAN2_MODE
#define SCAN2_MODE 3
#endif
constexpr size_t OFF_Y2DBG = OFF_BIG + 13 * U + U / 2;
__device__ __forceinline__ void phase_scan_compare(const Params& p) {
    const bf16_t* Y = (const bf16_t*)(p.ws + OFF_Y); const bf16_t* Y2 = (const bf16_t*)(p.ws + OFF_Y2DBG);
    float* accp = (float*)(p.ws + OFF_BAR + 16384);
    float e2 = 0.f, y2 = 0.f;
    for (size_t i = (size_t)blockIdx.x * NTHREADS + tidx(); i < (size_t)NT * D / 2; i += (size_t)gridDim.x * NTHREADS) {
        const unsigned a = ((const unsigned*)Y)[i], b = ((const unsigned*)Y2)[i];
        const float a0 = bflo(a), a1 = bfhi(a), b0 = bflo(b), b1 = bfhi(b);
        e2 += (a0 - b0) * (a0 - b0) + (a1 - b1) * (a1 - b1); y2 += a0 * a0 + a1 * a1;
    }
    e2 = wave_sum(e2); y2 = wave_sum(y2);
    if ((tidx() & 63) == 0) { atomicAdd(accp, e2); atomicAdd(accp + 1, y2); }
}

__device__ __forceinline__ void phase_rwkv_out(const Params& p, int j) {
    const bf16_t* Y = (const bf16_t*)(p.ws + OFF_Y); const bf16_t* V = (const bf16_t*)(p.ws + OFF_VF); const bf16_t* G = (const bf16_t*)(p.ws + OFF_G);
    const float* BON = (const float*)(p.ws + OFF_BON);
    bf16_t* YO = (bf16_t*)(p.ws + OFF_LW);
    const float* lnw = p.in[24] + (size_t)j * D; const float* lnb = p.in[25] + (size_t)j * D;
    const int tid_ = tidx(), lane = tid_ & 63, wid = tid_ >> 6, c0 = lane * 16;
    float lw[16], lb[16];
#pragma unroll
    for (int i = 0; i < 16; ++i) { lw[i] = lnw[c0 + i]; lb[i] = lnb[c0 + i]; }
    constexpr int RW = 2;
    for (int grp = blockIdx.x * 8 + wid; grp < NT / RW; grp += gridDim.x * 8) {
        u32x4 y0[RW][2], y1[RW][2], vv[RW][2], gg[RW][2]; float bon[RW];
#pragma unroll
        for (int r = 0; r < RW; ++r) {
            const size_t o = (size_t)(grp * RW + r) * D + c0;
#pragma unroll
            for (int i = 0; i < 2; ++i) {
                y0[r][i] = *(const u32x4*)(Y + o + i * 8); y1[r][i] = *(const u32x4*)(Y + (size_t)NT * D + o + i * 8);
                vv[r][i] = *(const u32x4*)(V + o + i * 8); gg[r][i] = *(const u32x4*)(G + o + i * 8);
            }
            bon[r] = BON[(size_t)(grp * RW + r) * 16 + (lane >> 2)];
        }
#pragma unroll
        for (int r = 0; r < RW; ++r) {
            const size_t o = (size_t)(grp * RW + r) * D + c0;
            float ov[16]; float s1 = 0.f;
#pragma unroll
            for (int i = 0; i < 16; ++i) {
                const unsigned w0 = y0[r][i >> 3][(i >> 1) & 3], w1 = y1[r][i >> 3][(i >> 1) & 3];
                ov[i] = ((i & 1) ? bfhi(w0) : bflo(w0)) + ((i & 1) ? bfhi(w1) : bflo(w1));
                s1 += ov[i];
            }
            s1 += __shfl_xor(s1, 1, 64); s1 += __shfl_xor(s1, 2, 64);
            const float mu = s1 * (1.f / 64.f);
            float s2 = 0.f;
#pragma unroll
            for (int i = 0; i < 16; ++i) { const float dd = ov[i] - mu; s2 += dd * dd; }
            s2 += __shfl_xor(s2, 1, 64); s2 += __shfl_xor(s2, 2, 64);
            const float rs = rsqrtf(s2 * (1.f / 64.f) + 64e-5f);
            float res[16];
#pragma unroll
            for (int i = 0; i < 16; ++i) {
                const unsigned vw = vv[r][i >> 3][(i >> 1) & 3], gw = gg[r][i >> 3][(i >> 1) & 3];
                const float v = (i & 1) ? bfhi(vw) : bflo(vw), g = (i & 1) ? bfhi(gw) : bflo(gw);
                res[i] = ((ov[i] - mu) * rs * lw[i] + lb[i] + bon[r] * v) * g;
            }
            u32x4 w[2];
#pragma unroll
            for (int i = 0; i < 8; ++i) w[i >> 2][i & 3] = pack2(res[2 * i], res[2 * i + 1]);
            *(u32x4*)(YO + o) = w[0]; *(u32x4*)(YO + o + 8) = w[1];
        }
    }
}

__device__ __forceinline__ void phase_rwkv_out2(const Params& p, int j, char* lds) {
    const bf16_t* A = (const bf16_t*)(p.ws + OFF_LD) + (size_t)2 * NT * 128;
    const bf16_t* Bt = wsm(p, j, WJ_G2);
    const bf16_t* Y = (const bf16_t*)(p.ws + OFF_Y); const bf16_t* V = (const bf16_t*)(p.ws + OFF_VF);
    const float* BON = (const float*)(p.ws + OFF_BON); const float* BON2 = (const float*)(p.ws + OFF_BON2);
    bf16_t* YO = (bf16_t*)(p.ws + OFF_LW);
    const float* lnw = p.in[24] + (size_t)j * D; const float* lnb = p.in[25] + (size_t)j * D;
    float* lwl = (float*)lds;
    constexpr int TR = 64, RT = NT / TR, NRC = 64, RPC = RT / NRC, KS = 4;
    const int tid = tidx(), lane = tid & 63, wid = tid >> 6, wr = wid >> 2, wc = wid & 3, fr = lane & 15, fq = lane >> 4;
    for (int u = blockIdx.x; u < 4 * NRC; u += gridDim.x) {
        const int ct = u / NRC, rc = u % NRC, rt0 = rc * RPC, rt1 = rt0 + RPC, col0 = ct * 256, head = ct * 4 + wc;
        __syncthreads();
        lwl[tid] = tid < 256 ? lnw[col0 + tid] : lnb[col0 + tid - 256];
        {
            char* bsl = lds + 4096;
            int t2 = tid; asm volatile("" : "+v"(t2));
#pragma unroll
            for (int q = 0; q < 8; ++q) {
                const int idx = q * 512 + t2, rowi = idx >> 4, seg = idx & 15;
                *(u32x4*)(bsl + rowi * 272 + seg * 16) = *(const u32x4*)(Bt + (size_t)(col0 + rowi) * 128 + seg * 8);
            }
        }
        __syncthreads();
        int boff[4];
#pragma unroll
        for (int n = 0; n < 4; ++n) boff[n] = 4096 + (wc * 64 + (n >> 1) * 32 + 8 * (fr >> 2) + 4 * (n & 1) + (fr & 3)) * 272 + fq * 16;
        bf16x8 afr[2][KS];
#pragma unroll
        for (int m = 0; m < 2; ++m)
#pragma unroll
            for (int ks = 0; ks < KS; ++ks) afr[m][ks] = *(const bf16x8*)(A + (size_t)(rt0 * TR + wr * 32 + m * 16 + fr) * 128 + ks * 32 + fq * 8);
        u32x4 ey0[2][2], ey1[2][2], evv[2][2]; float ebon[2];
#define OUT2_LOAD(SET, RT_, M_) do { const int row_ = (RT_) * TR + wr * 32 + (M_) * 16 + fr; const size_t o_ = (size_t)row_ * D + col0 + wc * 64 + 8 * fq; \
            _Pragma("unroll") for (int pp = 0; pp < 2; ++pp) { ey0[SET][pp] = *(const u32x4*)(Y + o_ + pp * 32); ey1[SET][pp] = *(const u32x4*)(Y + (size_t)NT * D + o_ + pp * 32); evv[SET][pp] = *(const u32x4*)(V + o_ + pp * 32); } \
            ebon[SET] = BON[(size_t)row_ * 16 + head]; } while (0)
        OUT2_LOAD(0, rt0, 0);
#pragma unroll 1
        for (int rt = rt0; rt < rt1; ++rt) {
            int zz = 0; asm volatile("" : "+v"(zz));
            f32x4 acc[2][4];
#pragma unroll
            for (int m = 0; m < 2; ++m)
#pragma unroll
                for (int n = 0; n < 4; ++n) {
                    acc[m][n] = (f32x4){0.f, 0.f, 0.f, 0.f};
#pragma unroll
                    for (int ks = 0; ks < KS; ++ks) acc[m][n] = __builtin_amdgcn_mfma_f32_16x16x32_bf16(*(const bf16x8*)(lds + boff[n] + zz + ks * 64), afr[m][ks], acc[m][n], 0, 0, 0);
                }
            if (rt + 1 < rt1) {
#pragma unroll
                for (int m = 0; m < 2; ++m)
#pragma unroll
                    for (int ks = 0; ks < KS; ++ks) afr[m][ks] = *(const bf16x8*)(A + (size_t)((rt + 1) * TR + wr * 32 + m * 16 + fr) * 128 + ks * 32 + fq * 8);
            }
#pragma unroll
            for (int m = 0; m < 2; ++m) {
                if (m == 0) OUT2_LOAD(1, rt, 1);
                else if (rt + 1 < rt1) OUT2_LOAD(0, rt + 1, 0);
                const int row = rt * TR + wr * 32 + m * 16 + fr;
                const size_t o = (size_t)row * D + col0 + wc * 64 + 8 * fq;
                const float bon = ebon[m];
                float ov[16]; float s1 = 0.f;
#pragma unroll
                for (int i = 0; i < 16; ++i) {
                    const unsigned w0 = ey0[m][i >> 3][(i >> 1) & 3], w1 = ey1[m][i >> 3][(i >> 1) & 3];
                    ov[i] = ((i & 1) ? bfhi(w0) : bflo(w0)) + ((i & 1) ? bfhi(w1) : bflo(w1));
                    s1 += ov[i];
                }
                const float mu = red4(s1) * (1.f / 64.f);
                float s2 = 0.f;
#pragma unroll
                for (int i = 0; i < 16; ++i) { const float dd = ov[i] - mu; s2 += dd * dd; }
                const float rs = rsqrtf(red4(s2) * (1.f / 64.f) + 64e-5f);
#pragma unroll
                for (int pp = 0; pp < 2; ++pp) {
                    const float* lp = lwl + wc * 64 + pp * 32 + 8 * fq;
                    const float4 w0 = *(const float4*)lp, w1 = *(const float4*)(lp + 4), b0 = *(const float4*)(lp + 256), b1 = *(const float4*)(lp + 260);
                    const float lw[8] = {w0.x, w0.y, w0.z, w0.w, w1.x, w1.y, w1.z, w1.w}, lb[8] = {b0.x, b0.y, b0.z, b0.w, b1.x, b1.y, b1.z, b1.w};
                    float res[8];
#pragma unroll
                    for (int e = 0; e < 8; ++e) {
                        const unsigned vw = evv[m][pp][e >> 1];
                        const float v = (e & 1) ? bfhi(vw) : bflo(vw);
                        const float g = acc[m][2 * pp + (e >> 2)][e & 3];
                        res[e] = ((ov[pp * 8 + e] - mu) * rs * lw[e] + lb[e] + bon * v) * g;
                    }
                    const u32x4 w = {pack2(res[0], res[1]), pack2(res[2], res[3]), pack2(res[4], res[5]), pack2(res[6], res[7])};
                    *(u32x4*)(YO + o + pp * 32) = w;
                }
            }
        }
#undef OUT2_LOAD
    }
}

__device__ __forceinline__ void phase_rwkv_wo(const Params& p, int l, int j, char* lds) {
    EpD1 ep{(bf16_t*)(p.ws + OFF_D1), nullptr};
    SchedGrid S{p.ws + OFF_LW, (const char*)wsm(p, j, WJ_WO), 0, 0, (size_t)256 * D * 2, 0, (size_t)256 * D * 2, NT / 256 / 8, (NT / 256) * 4};
    g256::gemm_phase<true>((LAS unsigned char*)lds, D, D, D, S, ep);
}

__device__ __forceinline__ void phase_pool_dlt(const Params& p, int nrows) {
    const bf16_t* H = (const bf16_t*)(p.ws + OFF_H); bf16_t* DL = (bf16_t*)(p.ws + OFF_DLT);
    const int tid_ = tidx(), lane = tid_ & 63, wid = tid_ >> 6;
    for (int row = blockIdx.x * 8 + wid; row < nrows; row += gridDim.x * 8) {
        int t, T, base;
        if (row < NLAT) { t = row & (TL - 1); T = TL; base = row - t; } else { t = (row - NLAT) & (TC - 1); T = TC; base = row - t; }
#define DLT_GROUP(G) { \
            constexpr int half = 1 << (G), win = 2 << (G); \
            const int c = (G) * 256 + lane * 4; \
            u32x2 w[win]; \
            _Pragma("unroll") for (int i = 0; i < win; ++i) { const int tt = t - half + i; const int tc = (tt >= 0 && tt < T) ? tt : t; w[i] = *(const u32x2*)(H + (size_t)(base + tc) * D + c); } \
            float s0 = 0.f, s1 = 0.f, s2 = 0.f, s3 = 0.f; \
            _Pragma("unroll") for (int i = 0; i < win; ++i) { const int tt = t - half + i; const float m = (tt >= 0 && tt < T) ? 1.f : 0.f; \
                s0 += m * bflo(w[i][0]); s1 += m * bfhi(w[i][0]); s2 += m * bflo(w[i][1]); s3 += m * bfhi(w[i][1]); } \
            const int lo = max(t - half, 0), hi = min(t + half, T); \
            const float inv = 1.f / (float)(hi - lo); \
            const u32x2 hw = w[half]; \
            u32x2 o; o[0] = pack2(s0 * inv - bflo(hw[0]), s1 * inv - bfhi(hw[0])); o[1] = pack2(s2 * inv - bflo(hw[1]), s3 * inv - bfhi(hw[1])); \
            *(u32x2*)(DL + (size_t)row * D + c) = o; }
        DLT_GROUP(0) DLT_GROUP(1) DLT_GROUP(2) DLT_GROUP(3)
#undef DLT_GROUP
    }
}
__device__ __forceinline__ void phase_pool_gemm(const Params& p, int l, int j, int nrows, char* lds) {
    EpD1 ep{(bf16_t*)(p.ws + OFF_D1), p.in[28] + (size_t)j * D};
    SchedGrid S{p.ws + OFF_DLT, (const char*)wsm(p, j, WJ_POOL), 0, 0, (size_t)256 * D * 2, (size_t)256 * 2, (size_t)256 * 256 * 2, nrows / 256 / 8, (nrows / 256) * 4};
    g256::gemm_phase<true>((LAS unsigned char*)lds, D, 256, 256, S, ep);
}

__device__ __forceinline__ void phase_topk(const Params& p, bool with_ctx, char* lds) {
    const float* AFF = (const float*)(p.ws + OFF_AFF);
    const bf16_t* H = (const bf16_t*)(p.ws + OFF_H); bf16_t* XG = (bf16_t*)(p.ws + OFF_XG);
    float* GTV = (float*)(p.ws + OFF_GTV); short* SLT = (short*)(p.ws + OFF_SLT);
    unsigned* keys = (unsigned*)lds;
    unsigned* hist = keys + 4096;
    unsigned* wtot = hist + 256;
    unsigned* bc = wtot + 8;
    int* sel = (int*)(bc + 4);
    const int tid = tidx(), lane = tid & 63, wid = tid >> 6;
    const int nunits = with_ctx ? 512 : 256;
    for (int u = blockIdx.x; u < nunits; u += gridDim.x) {
        const bool lat = u < 256;
        const int uu = lat ? u : u - 256, b = uu >> 4, e = uu & 15;
        const int n = lat ? TL : TC, kq = lat ? CAPL : CAPC, per = lat ? 8 : 1;
        const int rowbase = lat ? b * TL : NLAT + b * TC;
        for (int i = tid; i < n; i += NTHREADS) keys[i] = __float_as_uint(AFF[(size_t)(rowbase + i) * 16 + e]);
        __syncthreads();
        unsigned prefix = 0u, mask = 0u; int kth = kq;
        for (int ps = 0; ps < 4; ++ps) {
            const int shift = 24 - 8 * ps;
            if (tid < 256) hist[tid] = 0u;
            __syncthreads();
            for (int i = tid; i < n; i += NTHREADS) { const unsigned k = keys[i]; if ((k & mask) == prefix) atomicAdd(&hist[(k >> shift) & 255u], 1u); }
            __syncthreads();
            if (wid == 0) {
                const int b0 = 255 - 4 * lane;
                const unsigned h0 = hist[b0], h1 = hist[b0 - 1], h2 = hist[b0 - 2], h3 = hist[b0 - 3];
                unsigned inc = h0 + h1 + h2 + h3;
#pragma unroll
                for (int d = 1; d < 64; d <<= 1) { const unsigned o = (unsigned)__builtin_amdgcn_ds_bpermute(((lane - d) & 63) << 2, (int)inc); if (lane >= d) inc += o; }
                const unsigned exc = inc - (h0 + h1 + h2 + h3);
                if (exc < (unsigned)kth && inc >= (unsigned)kth) {
                    unsigned cum = exc; int dg = b0; unsigned rem = 0;
                    if (cum + h0 >= (unsigned)kth) { dg = b0; rem = kth - cum; }
                    else { cum += h0; if (cum + h1 >= (unsigned)kth) { dg = b0 - 1; rem = kth - cum; }
                    else { cum += h1; if (cum + h2 >= (unsigned)kth) { dg = b0 - 2; rem = kth - cum; }
                    else { cum += h2; dg = b0 - 3; rem = kth - cum; } } }
                    bc[0] = (unsigned)dg; bc[1] = rem;
                }
            }
            __syncthreads();
            prefix |= bc[0] << shift; mask |= 255u << shift; kth = (int)bc[1];
            __syncthreads();
        }
        const unsigned Tk = prefix; const int need_eq = kth;
        const int t0 = tid * per; const bool act = t0 < n;
        int cgt = 0, ceq = 0;
        if (act) for (int i = 0; i < per; ++i) { const unsigned k = keys[t0 + i]; cgt += k > Tk; ceq += k == Tk; }
        const unsigned mine = ((unsigned)cgt << 16) | (unsigned)ceq;
        unsigned inc = mine;
#pragma unroll
        for (int d = 1; d < 64; d <<= 1) { const unsigned o = (unsigned)__builtin_amdgcn_ds_bpermute(((lane - d) & 63) << 2, (int)inc); if (lane >= d) inc += o; }
        if (lane == 63) wtot[wid] = inc;
        __syncthreads();
        unsigned woff = 0;
#pragma unroll
        for (int w = 0; w < 8; ++w) woff += (w < wid) ? wtot[w] : 0u;
        const unsigned ex = woff + inc - mine;
        int gt_before = (int)(ex >> 16), eq_before = (int)(ex & 0xffffu);
        if (act) {
            for (int i = 0; i < per; ++i) {
                const int t = t0 + i; const unsigned k = keys[t];
                int slot = -1;
                if (k > Tk) { slot = gt_before + min(eq_before, need_eq); ++gt_before; }
                else if (k == Tk) { if (eq_before < need_eq) slot = gt_before + eq_before; ++eq_before; }
                SLT[(size_t)(rowbase + t) * 16 + e] = (short)slot;
                if (slot >= 0) {
                    const int srow = lat ? (b * 16 + e) * CAPL + slot : NSLOT_LAT + (e * 16 + b) * CAPC + slot;
                    sel[slot] = t; GTV[srow] = __uint_as_float(k);
#if MOE_F8
                    ((int*)(p.ws + OFF_IDX))[srow] = rowbase + t;
#endif
                }
            }
        }
        __syncthreads();
        const int sbase = lat ? (b * 16 + e) * CAPL : NSLOT_LAT + (e * 16 + b) * CAPC;
#if MOE_F8
#else
        for (int s = wid; s < kq; s += 8) {
            const size_t srcrow = (size_t)(rowbase + sel[s]) * D, dstrow = (size_t)(sbase + s) * D;
            const u32x4 x0 = *(const u32x4*)(H + srcrow + lane * 8), x1 = *(const u32x4*)(H + srcrow + 512 + lane * 8);
            *(u32x4*)(XG + dstrow + lane * 8) = x0; *(u32x4*)(XG + dstrow + 512 + lane * 8) = x1;
        }
#endif
        __syncthreads();
    }
}
__device__ __forceinline__ int expert_of_slotrow(int r) { return r < NSLOT_LAT ? ((r >> 9) & 15) : ((r - NSLOT_LAT) >> 9); }
constexpr int EB = MOE_F8 ? 1 : 2;
struct SchedMoeUp {
    const char* XG; const char* W13; int cpe, total; const int* tok; const char* abase;
    __device__ __forceinline__ bool next(int i, g256::Unit& u) const {
        const long L = g256::unit_index(i);
        if (L >= total) return false;
        const int chunk = (int)(L >> 5), o = (int)(L & 31), e = chunk / cpe, r = chunk % cpe;
        int row0, ct;
        if (r < 16) { const int t = (r >> 2) * 8 + (o >> 2); ct = (r & 3) * 4 + (o & 3); row0 = ((t >> 1) * 16 + e) * CAPL + (t & 1) * 256; }
        else { ct = o & 15; row0 = NSLOT_LAT + e * 512 + (o >> 4) * 256; }
        u.a = XG + (size_t)row0 * D * EB; u.b = W13 + ((size_t)e * 4096 + ct * 256) * 1024 * EB; u.row0 = row0; u.col0 = ct * 256;
        return true;
    }
};
__device__ __forceinline__ void phase_moe_up(const Params& p, bool with_ctx, char* lds) {
    const int cpe = with_ctx ? 17 : 16;
#if MOE_F8
    EpSwiglu8 ep{p.ws + OFF_HID};
    SchedMoeUp S{p.ws + OFF_XG, p.ws + OFF_WM, cpe, 16 * cpe * 32, (const int*)(p.ws + OFF_IDX), p.ws + OFF_H};
    g256::gemm_phase<true, true, true>((LAS unsigned char*)lds, D / 2, D / 2, D / 2, S, ep);
#else
    EpSwiglu ep{(bf16_t*)(p.ws + OFF_HID)};
    SchedMoeUp S{p.ws + OFF_XG, (const char*)((const bf16_t*)(p.ws + OFF_WM) + WM_13), cpe, 16 * cpe * 32, nullptr, nullptr};
    g256::gemm_phase<true>((LAS unsigned char*)lds, D, D, D, S, ep);
#endif
}
struct SchedMoeDown {
    const char* HID; const char* W2; int total;
    __device__ __forceinline__ bool next(int i, g256::Unit& u) const {
        const long L = g256::unit_index(i);
        if (L >= total) return false;
        const int chunk = (int)(L >> 5), o = (int)(L & 31), ct = o & 3;
        int row0, e;
        if (chunk < 64) { e = chunk >> 2; const int t = (chunk & 3) * 8 + (o >> 2); row0 = ((t >> 1) * 16 + e) * CAPL + (t & 1) * 256; }
        else { e = (chunk - 64) * 4 + (o >> 3); row0 = NSLOT_LAT + e * 512 + ((o >> 2) & 1) * 256; }
        u.a = HID + (size_t)row0 * FF * EB; u.b = W2 + ((size_t)e * 1024 + ct * 256) * 2048 * EB; u.row0 = row0; u.col0 = ct * 256;
        return true;
    }
};
__device__ __forceinline__ void phase_moe_down(const Params& p, bool with_ctx, char* lds) {
    EpGateRow ep{(bf16_t*)(p.ws + OFF_YS), (const float*)(p.ws + OFF_GTV)};
#if MOE_F8
    SchedMoeDown S{p.ws + OFF_HID, p.ws + OFF_WM + WM8_2, (64 + (with_ctx ? 4 : 0)) * 32};
    g256::gemm_phase<true, true>((LAS unsigned char*)lds, FF / 2, FF / 2, FF / 2, S, ep);
#else
    SchedMoeDown S{p.ws + OFF_HID, (const char*)((const bf16_t*)(p.ws + OFF_WM) + WM_2), (64 + (with_ctx ? 4 : 0)) * 32};
    g256::gemm_phase<true>((LAS unsigned char*)lds, FF, FF, FF, S, ep);
#endif
}
__device__ __forceinline__ void phase_moe_combine(const Params& p, int l, int nrows, float amp = 1.f) {
    float* X = (float*)(p.ws + OFF_X); const bf16_t* YS = (const bf16_t*)(p.ws + OFF_YS); const short* SLT = (const short*)(p.ws + OFF_SLT);
    bf16_t* H = (bf16_t*)(p.ws + OFF_H); const bf16_t* D1 = (const bf16_t*)(p.ws + OFF_D1);
    const float* MOD = (const float*)(p.ws + OFF_MOD) + (size_t)l * 17 * MODW + 5 * D;
    const bool last = l == 3;
    const float* MODN = (const float*)(p.ws + OFF_MOD) + (size_t)(last ? l : l + 1) * 17 * MODW;
    const float* gn = last ? p.in[33] : p.in[6] + (size_t)(l + 1) * D;
    const int tid_ = tidx(), lane = tid_ & 63, wid = tid_ >> 6;
    float gw[16];
#pragma unroll
    for (int hh = 0; hh < 2; ++hh)
#pragma unroll
        for (int i = 0; i < 8; ++i) gw[hh * 8 + i] = gn[hh * 512 + lane * 8 + i];
    for (int row = blockIdx.x * 8 + wid; row < nrows; row += gridDim.x * 8) {
        float acc[16];
#pragma unroll
        for (int i = 0; i < 16; ++i) acc[i] = 0.f;
        const bool lat = row < NLAT;
        const int b = lat ? (row >> 12) : ((row - NLAT) >> 8);
        const int myslot = (int)SLT[(size_t)row * 16 + (lane & 15)];
        float4 xv[4]; u32x4 dv[2];
        const float* xsrc = l == 0 ? (lat ? p.in[0] + (size_t)row * D : p.in[2] + (size_t)(row - NLAT) * D) : X + (size_t)row * D;
#pragma unroll
        for (int hh = 0; hh < 2; ++hh) { xv[hh * 2] = *(const float4*)(xsrc + hh * 512 + lane * 8); xv[hh * 2 + 1] = *(const float4*)(xsrc + hh * 512 + lane * 8 + 4); dv[hh] = *(const u32x4*)(D1 + (size_t)row * D + hh * 512 + lane * 8); }
        unsigned long long bal = __ballot(myslot >= 0);
        unsigned emask = (unsigned)bal & 0xffffu;
        u32x4 ya[4], yc[4];
#pragma unroll
        for (int k = 0; k < 4; ++k) {
            ya[k] = (u32x4){0u, 0u, 0u, 0u}; yc[k] = (u32x4){0u, 0u, 0u, 0u};
            if (emask) {
                const int e = __builtin_ctz(emask); emask &= emask - 1u;
                const int sv = __builtin_amdgcn_readlane(myslot, e);
                const int srow = lat ? (b * 16 + e) * CAPL + sv : NSLOT_LAT + (e * 16 + b) * CAPC + sv;
                ya[k] = *(const u32x4*)(YS + (size_t)srow * D + lane * 8); yc[k] = *(const u32x4*)(YS + (size_t)srow * D + 512 + lane * 8);
            }
        }
#pragma unroll
        for (int k = 0; k < 4; ++k)
#pragma unroll
            for (int i = 0; i < 4; ++i) { acc[2 * i] += bflo(ya[k][i]); acc[2 * i + 1] += bfhi(ya[k][i]); acc[8 + 2 * i] += bflo(yc[k][i]); acc[8 + 2 * i + 1] += bfhi(yc[k][i]); }
        while (emask) {
            const int e = __builtin_ctz(emask); emask &= emask - 1u;
            const int sv = __builtin_amdgcn_readlane(myslot, e);
            const int srow = lat ? (b * 16 + e) * CAPL + sv : NSLOT_LAT + (e * 16 + b) * CAPC + sv;
            const u32x4 a = *(const u32x4*)(YS + (size_t)srow * D + lane * 8), c = *(const u32x4*)(YS + (size_t)srow * D + 512 + lane * 8);
#pragma unroll
            for (int i = 0; i < 4; ++i) { acc[2 * i] += bflo(a[i]); acc[2 * i + 1] += bfhi(a[i]); acc[8 + 2 * i] += bflo(c[i]); acc[8 + 2 * i + 1] += bfhi(c[i]); }
        }
        if (amp == 0.f) {
#pragma unroll
            for (int i = 0; i < 16; ++i) acc[i] = 0.f;
        }
        const int mrow = mod_row(row);
        const float* gt = MOD + (size_t)mrow * MODW;
        float xn[16]; float ss = 0.f;
#pragma unroll
        for (int hh = 0; hh < 2; ++hh) {
            const float* gp = gt + hh * 512 + lane * 8;
            const float4 g0 = *(const float4*)gp, g1 = *(const float4*)(gp + 4);
            float4 x0 = xv[hh * 2], x1 = xv[hh * 2 + 1];
            {
                const float4 m0 = *(const float4*)(gp - 3 * D), m1 = *(const float4*)(gp - 3 * D + 4);
                x0.x += m0.x * bflo(dv[hh][0]); x0.y += m0.y * bfhi(dv[hh][0]); x0.z += m0.z * bflo(dv[hh][1]); x0.w += m0.w * bfhi(dv[hh][1]);
                x1.x += m1.x * bflo(dv[hh][2]); x1.y += m1.y * bfhi(dv[hh][2]); x1.z += m1.z * bflo(dv[hh][3]); x1.w += m1.w * bfhi(dv[hh][3]);
            }
            xn[hh * 8 + 0] = x0.x + g0.x * acc[hh * 8 + 0]; xn[hh * 8 + 1] = x0.y + g0.y * acc[hh * 8 + 1]; xn[hh * 8 + 2] = x0.z + g0.z * acc[hh * 8 + 2]; xn[hh * 8 + 3] = x0.w + g0.w * acc[hh * 8 + 3];
            xn[hh * 8 + 4] = x1.x + g1.x * acc[hh * 8 + 4]; xn[hh * 8 + 5] = x1.y + g1.y * acc[hh * 8 + 5]; xn[hh * 8 + 6] = x1.z + g1.z * acc[hh * 8 + 6]; xn[hh * 8 + 7] = x1.w + g1.w * acc[hh * 8 + 7];
        }
#pragma unroll
        for (int i = 0; i < 16; ++i) ss += xn[i] * xn[i];
        const float rs = rsqrtf(wave_sum(ss) * (1.f / D) + 1e-6f);
        if (!last) {
#pragma unroll
            for (int hh = 0; hh < 2; ++hh) {
                float* xp = X + (size_t)row * D + hh * 512 + lane * 8;
                *(float4*)xp = make_float4(xn[hh * 8 + 0], xn[hh * 8 + 1], xn[hh * 8 + 2], xn[hh * 8 + 3]);
                *(float4*)(xp + 4) = make_float4(xn[hh * 8 + 4], xn[hh * 8 + 5], xn[hh * 8 + 6], xn[hh * 8 + 7]);
                const float* sp = MODN + (size_t)mrow * MODW + hh * 512 + lane * 8;
                const float4 s0 = *(const float4*)sp, s1 = *(const float4*)(sp + 4), c0 = *(const float4*)(sp + D), c1 = *(const float4*)(sp + D + 4);
                u32x4 o;
                o[0] = pack2(xn[hh * 8 + 0] * rs * gw[hh * 8 + 0] * (1.f + c0.x) + s0.x, xn[hh * 8 + 1] * rs * gw[hh * 8 + 1] * (1.f + c0.y) + s0.y);
                o[1] = pack2(xn[hh * 8 + 2] * rs * gw[hh * 8 + 2] * (1.f + c0.z) + s0.z, xn[hh * 8 + 3] * rs * gw[hh * 8 + 3] * (1.f + c0.w) + s0.w);
                o[2] = pack2(xn[hh * 8 + 4] * rs * gw[hh * 8 + 4] * (1.f + c1.x) + s1.x, xn[hh * 8 + 5] * rs * gw[hh * 8 + 5] * (1.f + c1.y) + s1.y);
                o[3] = pack2(xn[hh * 8 + 6] * rs * gw[hh * 8 + 6] * (1.f + c1.z) + s1.z, xn[hh * 8 + 7] * rs * gw[hh * 8 + 7] * (1.f + c1.w) + s1.w);
                *(u32x4*)(H + (size_t)row * D + hh * 512 + lane * 8) = o;
            }
        } else {
#if SCAN2_MODE == 1
            { const float* accp = (const float*)(p.ws + OFF_BAR + 16384); const float f = 1.f + 100.f * sqrtf(accp[0] / fmaxf(accp[1], 1e-30f));
#pragma unroll
              for (int i = 0; i < 16; ++i) xn[i] *= f; }
#endif
#pragma unroll
            for (int hh = 0; hh < 2; ++hh) {
                float* op = p.out + (size_t)row * D + hh * 512 + lane * 8;
                *(float4*)op = make_float4(xn[hh * 8 + 0] * rs * gw[hh * 8 + 0], xn[hh * 8 + 1] * rs * gw[hh * 8 + 1], xn[hh * 8 + 2] * rs * gw[hh * 8 + 2], xn[hh * 8 + 3] * rs * gw[hh * 8 + 3]);
                *(float4*)(op + 4) = make_float4(xn[hh * 8 + 4] * rs * gw[hh * 8 + 4], xn[hh * 8 + 5] * rs * gw[hh * 8 + 5], xn[hh * 8 + 6] * rs * gw[hh * 8 + 6], xn[hh * 8 + 7] * rs * gw[hh * 8 + 7]);
            }
        }
    }
}
__device__ __forceinline__ void phase_final(const Params& p) {
    const float* X = (const float*)(p.ws + OFF_X); const float* g = p.in[33];
    const int tid_ = tidx(), lane = tid_ & 63, wid = tid_ >> 6;
    for (int row = blockIdx.x * 8 + wid; row < NLAT; row += gridDim.x * 8) {
        const float* xr = X + (size_t)row * D;
        float4 v[4]; float ss = 0.f;
#pragma unroll
        for (int i = 0; i < 4; ++i) { v[i] = *(const float4*)(xr + i * 256 + lane * 4); ss += v[i].x * v[i].x + v[i].y * v[i].y + v[i].z * v[i].z + v[i].w * v[i].w; }
        ss = wave_sum(ss);
        const float rs = rsqrtf(ss * (1.f / D) + 1e-6f);
#pragma unroll
        for (int i = 0; i < 4; ++i) {
            const float4 gg = *(const float4*)(g + i * 256 + lane * 4);
            float4 o; o.x = v[i].x * rs * gg.x; o.y = v[i].y * rs * gg.y; o.z = v[i].z * rs * gg.z; o.w = v[i].w * rs * gg.w;
            *(float4*)(p.out + (size_t)row * D + i * 256 + lane * 4) = o;
        }
    }
}

#define XB_TMO      128
#define XB_XCNT(j)  (256  + 64 * (j))
#define XB_XSUB(j)  (1280 + 64 * (j))
#define XB_XGEN(j)  (2304 + 64 * (j))
#define XB_TOP      3328
#define XB_TOPGEN   3392
#define XCD_BAR_WORDS 3456
#define XB_SPIN_CAP (1u << 25)
__device__ __forceinline__ unsigned xb_ld(unsigned* p)              { return __hip_atomic_load(p, __ATOMIC_RELAXED, __HIP_MEMORY_SCOPE_AGENT); }
__device__ __forceinline__ unsigned xb_add(unsigned* p, unsigned v) { return __hip_atomic_fetch_add(p, v, __ATOMIC_RELAXED, __HIP_MEMORY_SCOPE_AGENT); }
__device__ __forceinline__ unsigned xb_xcc_id() { return (unsigned)__builtin_amdgcn_s_getreg((3 << 11) | 20) & 0xFu; }
#define XB_SPIN(cond, bar) do { unsigned _sp = 0; while (cond) { __builtin_amdgcn_s_sleep(1); \
    if ((++_sp & 255u) == 0u) { if (xb_ld(&(bar)[XB_TMO])) break; if (_sp > XB_SPIN_CAP) { atomicAdd(&(bar)[XB_TMO], 1u); break; } } } } while (0)
struct XcdBarrier { unsigned* bar; unsigned x; volatile LAS unsigned* st; };
__device__ __forceinline__ XcdBarrier xcd_barrier_post(unsigned* bar, volatile LAS unsigned* st) {
    XcdBarrier b; b.bar = bar; b.x = xb_xcc_id(); b.st = st;
    if (threadIdx.x == 0) (void)xb_add(&bar[XB_XCNT(b.x)], 1u);
    return b;
}
__device__ __forceinline__ void xcd_barrier_complete(unsigned* bar, unsigned x, unsigned& nloc, unsigned& nx) {
    const unsigned G = gridDim.x * gridDim.y * gridDim.z;
    unsigned sum, cnt, mine, sp = 0u;
    for (;;) {
        sum = 0u; cnt = 0u; mine = 0u;
#pragma unroll
        for (unsigned j = 0; j < 16; ++j) { const unsigned c = xb_ld(&bar[XB_XCNT(j)]); sum += c; cnt += (c > 0u) ? 1u : 0u; mine = (j == x) ? c : mine; }
        if (sum == G) break;
        __builtin_amdgcn_s_sleep(1);
        if ((++sp & 255u) == 0u) { if (xb_ld(&bar[XB_TMO])) break; if (sp > XB_SPIN_CAP) { atomicAdd(&bar[XB_TMO], 1u); break; } }
    }
    nloc = mine > 0u ? mine : 1u; nx = cnt > 0u ? cnt : 1u;
}
__device__ __forceinline__ void xcd_barrier(const XcdBarrier& b) {
    asm volatile("s_waitcnt vmcnt(0)" ::: "memory");
    __syncthreads();
    if (threadIdx.x == 0) {
        unsigned* bar = b.bar;
        unsigned bx = b.x; asm volatile("" : "+s"(bx));
        __builtin_amdgcn_s_waitcnt(0);
        unsigned nloc = b.st[0], nx = b.st[1];
        if (nloc == 0u) { xcd_barrier_complete(bar, bx, nloc, nx); b.st[0] = nloc; b.st[1] = nx; }
        const unsigned old = xb_add(&bar[XB_XSUB(bx)], 1u);
        const unsigned gen = old / nloc;
        if (old + 1u == (gen + 1u) * nloc) {
            __builtin_amdgcn_fence(__ATOMIC_RELEASE, "agent");
            asm volatile("s_waitcnt vmcnt(0)" ::: "memory");
            const unsigned og = xb_add(&bar[XB_TOP], 1u);
            const unsigned tg = og / nx;
            if (og + 1u == (tg + 1u) * nx) xb_add(&bar[XB_TOPGEN], 1u);
            else XB_SPIN(xb_ld(&bar[XB_TOPGEN]) == tg, bar);
            __builtin_amdgcn_fence(__ATOMIC_ACQUIRE, "agent");
            xb_add(&bar[XB_XGEN(bx)], 1u);
            asm volatile("s_waitcnt vmcnt(0)" ::: "memory");
        } else {
            XB_SPIN(xb_ld(&bar[XB_XGEN(bx)]) == gen, bar);
            __builtin_amdgcn_fence(__ATOMIC_ACQUIRE, "agent");
            asm volatile("s_waitcnt vmcnt(0)" ::: "memory");
        }
    }
    __syncthreads();
}

constexpr int NSMALLJOBS = 20;
__global__ void __launch_bounds__(NTHREADS, 2) k_mega(Params p) {
    extern __shared__ __attribute__((aligned(16))) char lds_all[];
    if (threadIdx.x == 0) *(uint4*)(lds_all + LDS_BYTES) = make_uint4(0u, 0u, 0u, 0u);
    __syncthreads();
    XcdBarrier bar = xcd_barrier_post((unsigned*)(p.ws + OFF_BAR), (volatile LAS unsigned*)(lds_all + LDS_BYTES));
    char* lds = lds_all;
#define GBAR xcd_barrier(bar)
#define DUP(bit, call) do { call; if (PROBE_MASK & (1 << (bit))) { GBAR; call; } } while (0)
    DUP(17, phase_cvt(p, 0, NSMALLJOBS, lds));
    DUP(18, phase_ada(p, lds));
    GBAR;
    if (PROBE_MASK & (1 << 19)) { for (int i = 0; i < 40; ++i) GBAR; }
    for (int l = 0; l < 4; ++l) {
        const bool last = l == 3, rw = (l & 1) == 0; const int j = l >> 1;
        const int nrows = (!last || rw) ? NT : NLAT;
        if (l == 0) { phase_norm<false>(p, l, 0, nrows, lds); GBAR; }
        if (rw) {
            DUP(1, phase_mix(p, j)); GBAR;
            DUP(2, phase_rwkv_proj(p, j, lds)); GBAR;
            DUP(3, phase_rwkv_up2(p, j, lds));
            if (j == 1) phase_rwkv_up(p, j, lds);
            GBAR;
#if SCAN2_MODE == 3
            DUP(4, phase_rwkv_scan3(p, j, lds, (bf16_t*)(p.ws + OFF_Y))); GBAR;
#elif SCAN2_MODE == 2
            phase_rwkv_scan2(p, j, lds, (bf16_t*)(p.ws + OFF_Y), -1); GBAR;
#else
            DUP(4, phase_rwkv_scan(p, j, lds)); GBAR;
#endif
#if SCAN2_MODE == 1
            phase_rwkv_scan2(p, j, lds, (bf16_t*)(p.ws + OFF_Y2DBG), 0); GBAR;
            phase_scan_compare(p); GBAR;
#endif
            DUP(5, phase_rwkv_out2(p, j, lds)); GBAR;
            phase_rwkv_wo(p, l, j, lds); GBAR;
        } else {
            DUP(6, phase_pool_dlt(p, nrows)); GBAR;
            phase_pool_gemm(p, l, j, nrows, lds); GBAR;
        }
        const int mrows = last ? NLAT : NT;
        DUP(7, phase_cvt(p, NSMALLJOBS + 3 * l, NSMALLJOBS + 3 * l + 3, lds));
        DUP(8, phase_norm<true>(p, l, 1, mrows, lds)); GBAR;
        DUP(9, phase_topk(p, !last, lds)); GBAR;
        DUP(11, phase_moe_up(p, !last, lds)); GBAR;
        DUP(12, phase_moe_down(p, !last, lds)); GBAR;
        phase_moe_combine(p, l, mrows);
        if (!last) GBAR;
    }
#undef GBAR
}

enum { PH_CVT = 0, PH_ADA, PH_NORM1, PH_NORM2, PH_PROJ, PH_UP, PH_PREP, PH_SCAN, PH_OUT, PH_WO, PH_DLT, PH_POOLG, PH_TOPK, PH_GATHER, PH_MUP, PH_MDOWN, PH_COMB, PH_FINAL, PH_MIX };
template <int PH>
__global__ void __launch_bounds__(NTHREADS) k_phase(Params p, int a0, int a1, int a2) {
    extern __shared__ __attribute__((aligned(16))) char lds[];
    if (PH == PH_CVT) phase_cvt(p, a0, a1, lds);
    if (PH == PH_ADA) phase_ada(p, lds);
    if (PH == PH_NORM1) phase_norm<false>(p, a0, 0, a1, lds);
    if (PH == PH_NORM2) phase_norm<true>(p, a0, 1, a1, lds);
    if (PH == PH_PROJ) phase_rwkv_proj(p, a0, lds);
    if (PH == PH_UP) phase_rwkv_up(p, a0, lds);
    if (PH == PH_PREP) phase_rwkv_prep(p, a0);
    if (PH == PH_SCAN) phase_rwkv_scan(p, a0, lds);
    if (PH == PH_OUT) phase_rwkv_out2(p, a0, lds);
    if (PH == PH_WO) phase_rwkv_wo(p, a0, a1, lds);
    if (PH == PH_DLT) phase_pool_dlt(p, a0);
    if (PH == PH_POOLG) phase_pool_gemm(p, a0, a1, a2, lds);
    if (PH == PH_TOPK) phase_topk(p, a0 != 0, lds);
    if (PH == PH_MUP) phase_moe_up(p, a0 != 0, lds);
    if (PH == PH_MDOWN) phase_moe_down(p, a0 != 0, lds);
    if (PH == PH_COMB) phase_moe_combine(p, a0, a1);
    if (PH == PH_FINAL) phase_final(p);
    if (PH == PH_MIX) phase_mix(p, a0);
}

template <int PH>
static void launch(const Params& p, int a0, int a1, int a2, hipStream_t s) {
    static bool init = false;
    if (!init) { hipFuncSetAttribute((const void*)k_phase<PH>, hipFuncAttributeMaxDynamicSharedMemorySize, LDS_BYTES); init = true; }
    hipLaunchKernelGGL(k_phase<PH>, dim3(256), dim3(NTHREADS), LDS_BYTES, s, p, a0, a1, a2);
}

static int add_job(Params& p, int n, const float* src, bf16_t* dst, int K, int N, int src_ld, int dst_ld, int n_mul, int n_off, int Kpad, int Npad, int nbatch, long src_bs, long dst_bs) {
    CvtJob& J = p.jobs[n];
    J.src = src; J.dst = dst; J.src_bs = src_bs; J.dst_bs = dst_bs; J.K = K; J.N = N; J.src_ld = src_ld; J.dst_ld = dst_ld; J.n_mul = n_mul; J.n_off = n_off;
    J.Kpad = Kpad; J.Npad = Npad; J.nbatch = nbatch; J.tiles = nbatch * (Kpad / 64) * ((Npad + 255) / 256);
    return n + 1;
}

extern "C" void kernel_launch(void* const* d_in, const int* in_sizes, int n_in, void* d_out, int out_size, void* d_ws, size_t ws_size, hipStream_t stream) {
    Params p;
    memset(&p, 0, sizeof(p));
    for (int i = 0; i < 34; ++i) p.in[i] = (const float*)d_in[i];
    p.out = (float*)d_out; p.ws = (char*)d_ws;
    if (ws_size < WS_NEED) { fprintf(stderr, "workspace too small: %zu < %zu\n", ws_size, (size_t)WS_NEED); }
    bf16_t* wsm_ = (bf16_t*)(p.ws + OFF_WSM);
    bf16_t* wm_ = (bf16_t*)(p.ws + OFF_WM);
    int nj = 0;
    for (int j = 0; j < 2; ++j) {
        bf16_t* base = wsm_ + (size_t)j * WJ_SIZE;
        nj = add_job(p, nj, p.in[9] + (size_t)j * 3 * D * D, base + WJ_RKV, D, D, D, D, 1, 0, D, D, 3, (long)D * D, (long)D * D);
        nj = add_job(p, nj, p.in[26] + (size_t)j * D * D, base + WJ_WO, D, D, D, D, 1, 0, D, D, 1, 0, 0);
        nj = add_job(p, nj, p.in[11] + (size_t)j * 2 * D * 64, base + WJ_W1, D, 64, 64, D, 1, 0, D, 64, 2, (long)D * 64, (long)64 * D);
        nj = add_job(p, nj, p.in[14] + (size_t)j * 2 * D * 64, base + WJ_A1, D, 64, 64, D, 1, 0, D, 64, 2, (long)D * 64, (long)64 * D);
        nj = add_job(p, nj, p.in[19] + (size_t)j * D * 128, base + WJ_G1, D, 128, 128, D, 1, 0, D, 128, 1, 0, 0);
        nj = add_job(p, nj, p.in[12] + (size_t)j * 2 * 64 * D, base + WJ_W2, 64, D, D, 64, 1, 0, 64, D, 2, (long)64 * D, (long)D * 64);
        nj = add_job(p, nj, p.in[15] + (size_t)j * 2 * 64 * D, base + WJ_A2, 64, D, D, 64, 1, 0, 64, D, 2, (long)64 * D, (long)D * 64);
        nj = add_job(p, nj, p.in[20] + (size_t)j * 128 * D, base + WJ_G2, 128, D, D, 128, 1, 0, 128, D, 1, 0, 0);
        nj = add_job(p, nj, p.in[27] + (size_t)j * 4 * 256 * 256, base + WJ_POOL, 256, 256, 256, 256, 1, 0, 256, 256, 4, 65536, 65536);
    }
    nj = add_job(p, nj, p.in[17], wsm_ + W_V1, D, 32, 32, D, 1, 0, D, 128, 1, 0, 0);
    nj = add_job(p, nj, p.in[18], wsm_ + W_V2, 32, D, D, 64, 1, 0, 64, D, 1, 0, 0);
    const int nsmall = nj;
    for (int l = 0; l < 4; ++l) {
#if MOE_F8
        nj = add_job(p, nj, p.in[30] + (size_t)l * 16 * D * FF, wm_, D, FF, FF, D, 2, 0, D, FF, 16, (long)D * FF, (long)4096 * 1024);
        p.jobs[nj - 1].f8 = 1; p.jobs[nj - 1].scale = W8_SCALE;
        nj = add_job(p, nj, p.in[31] + (size_t)l * 16 * D * FF, wm_, D, FF, FF, D, 2, 1, D, FF, 16, (long)D * FF, (long)4096 * 1024);
        p.jobs[nj - 1].f8 = 1; p.jobs[nj - 1].scale = W8_SCALE;
        nj = add_job(p, nj, p.in[32] + (size_t)l * 16 * FF * D, (bf16_t*)(p.ws + OFF_WM + WM8_2), FF, D, D, FF, 1, 0, FF, D, 16, (long)FF * D, (long)D * FF);
        p.jobs[nj - 1].f8 = 1; p.jobs[nj - 1].scale = W8_SCALE;
#else
        nj = add_job(p, nj, p.in[30] + (size_t)l * 16 * D * FF, wm_ + WM_13, D, FF, FF, D, 2, 0, D, FF, 16, (long)D * FF, (long)4096 * 1024);
        nj = add_job(p, nj, p.in[31] + (size_t)l * 16 * D * FF, wm_ + WM_13, D, FF, FF, D, 2, 1, D, FF, 16, (long)D * FF, (long)4096 * 1024);
        nj = add_job(p, nj, p.in[32] + (size_t)l * 16 * FF * D, wm_ + WM_2, FF, D, D, FF, 1, 0, FF, D, 16, (long)FF * D, (long)D * FF);
#endif
    }
#if MK_MULTI
    launch<PH_CVT>(p, 0, nsmall, 0, stream);
    launch<PH_ADA>(p, 0, 0, 0, stream);
    for (int l = 0; l < 4; ++l) {
        const bool last = l == 3, rw = (l % 2) == 0; const int j = l / 2;
        const bool need_ctx = !last || rw;
        const int nrows = need_ctx ? NT : NLAT;
        if (l == 0) launch<PH_NORM1>(p, l, nrows, 0, stream);
        if (rw) {
            launch<PH_MIX>(p, j, 0, 0, stream);
            launch<PH_PROJ>(p, j, 0, 0, stream);
            launch<PH_UP>(p, j, 0, 0, stream);
            launch<PH_PREP>(p, j, 0, 0, stream);
            launch<PH_SCAN>(p, j, 0, 0, stream);
            launch<PH_OUT>(p, j, 0, 0, stream);
            launch<PH_WO>(p, l, j, 0, stream);
        } else {
            launch<PH_DLT>(p, nrows, 0, 0, stream);
            launch<PH_POOLG>(p, l, j, nrows, stream);
        }
        const int mrows = last ? NLAT : NT;
        launch<PH_CVT>(p, nsmall + 3 * l, nsmall + 3 * l + 3, 0, stream);
        launch<PH_NORM2>(p, l, mrows, 0, stream);
        launch<PH_TOPK>(p, last ? 0 : 1, 0, 0, stream);
        launch<PH_MUP>(p, last ? 0 : 1, 0, 0, stream);
        launch<PH_MDOWN>(p, last ? 0 : 1, 0, 0, stream);
        launch<PH_COMB>(p, l, mrows, 0, stream);
    }
#else
    (void)nsmall;
    static int grid = 0;
    if (!grid) {
        hipFuncSetAttribute((const void*)k_mega, hipFuncAttributeMaxDynamicSharedMemorySize, LDS_TOTAL);
        int dev = 0, cus = 0, per_cu = 0;
        hipGetDevice(&dev);
        hipDeviceGetAttribute(&cus, hipDeviceAttributeMultiprocessorCount, dev);
        hipOccupancyMaxActiveBlocksPerMultiprocessor(&per_cu, (const void*)k_mega, NTHREADS, LDS_TOTAL);
        grid = cus * (per_cu < 1 ? per_cu : 1);
        if (grid <= 0) { fprintf(stderr, "occupancy query returned %d blocks per CU\n", per_cu); grid = 0; return; }
    }
    hipMemsetAsync(p.ws + OFF_BAR, 0, 32768, stream);
    hipLaunchKernelGGL(k_mega, dim3(grid), dim3(NTHREADS), LDS_TOTAL, stream, p);
#endif
}
```

```cpp
#include <hip/hip_runtime.h>
#include <stdint.h>
#include <stdio.h>
#include <string.h>
#ifndef MK_MULTI
#define MK_MULTI 0
#endif

typedef unsigned short bf16_t;
typedef short bf16x8 __attribute__((ext_vector_type(8)));
typedef float f32x4 __attribute__((ext_vector_type(4)));
typedef unsigned u32x4 __attribute__((ext_vector_type(4)));
typedef unsigned u32x2 __attribute__((ext_vector_type(2)));

constexpr int D = 1024, NB = 16, TL = 4096, TC = 256;
constexpr int NLAT = NB * TL, NCTX = NB * TC, NT = NLAT + NCTX;
constexpr int NE = 16, FF = 2048, CAPL = 512, CAPC = 32;
constexpr int NSLOT_LAT = NB * NE * CAPL, NSLOT_CTX = NB * NE * CAPC, NSLOT = NSLOT_LAT + NSLOT_CTX;
constexpr int MODW = 6 * D;
constexpr int NTHREADS = 512;
constexpr int LDS_BYTES = 128 * 1024;
constexpr int LDS_TOK = LDS_BYTES + 16;
constexpr int LDS_TOTAL = LDS_TOK + 1024;

constexpr size_t MiB = 1ull << 20;
constexpr size_t U = (size_t)NT * D * 2;
constexpr size_t OFF_BAR = 0;
constexpr size_t OFF_MOD = 64 * 1024;
constexpr size_t OFF_WSM = 2 * MiB;
constexpr size_t OFF_AFF = 26 * MiB;
constexpr size_t OFF_BON = 31 * MiB;
constexpr size_t OFF_BON2 = 41 * MiB;
constexpr size_t OFF_IDX = 36 * MiB;
constexpr size_t OFF_GTV = 37 * MiB;
constexpr size_t OFF_SLT = 38 * MiB;
constexpr size_t OFF_BIG = 48 * MiB;
constexpr size_t OFF_X = OFF_BIG;
constexpr size_t OFF_VF = OFF_BIG + 2 * U;
constexpr size_t OFF_H = OFF_BIG + 3 * U;
constexpr size_t OFF_R = OFF_BIG + 4 * U;
constexpr size_t OFF_K = OFF_BIG + 5 * U;
constexpr size_t OFF_LD = OFF_BIG + 6 * U;
constexpr size_t OFF_LW = OFF_BIG + 6 * U + U / 2;
constexpr size_t OFF_AD = OFF_BIG + 8 * U + U / 2;
constexpr size_t OFF_Y = OFF_BIG + 10 * U + U / 2;
constexpr size_t OFF_G = OFF_BIG + 12 * U + U / 2;
constexpr size_t OFF_WM = OFF_BIG + 4 * U;
constexpr size_t OFF_XG = OFF_BIG + 5 * U + U / 2;
constexpr size_t OFF_HID = OFF_BIG + 7 * U + U / 2;
constexpr size_t OFF_YS = OFF_BIG + 11 * U + U / 2;
constexpr size_t OFF_DLT = OFF_BIG + 4 * U;
constexpr size_t OFF_D1 = OFF_BIG + 13 * U + U / 2;
constexpr size_t WS_NEED = OFF_BIG + 14 * U + U / 2;

constexpr size_t WJ_RKV = 0;
constexpr size_t WJ_WO = 3 * 1048576;
constexpr size_t WJ_W1 = 4 * 1048576;
constexpr size_t WJ_A1 = WJ_W1 + 131072;
constexpr size_t WJ_G1 = WJ_A1 + 131072;
constexpr size_t WJ_W2 = WJ_G1 + 131072;
constexpr size_t WJ_A2 = WJ_W2 + 131072;
constexpr size_t WJ_G2 = WJ_A2 + 131072;
constexpr size_t WJ_POOL = WJ_G2 + 131072;
constexpr size_t WJ_SIZE = WJ_POOL + 262144;
constexpr size_t W_V1 = 2 * WJ_SIZE;
constexpr size_t W_V2 = W_V1 + 131072;
constexpr size_t WM_13 = 0;
constexpr size_t WM_2 = (size_t)16 * 4096 * 1024;
constexpr size_t WM8_2 = (size_t)16 * 4096 * 1024;
constexpr float W8_SCALE = 64.f;
#define MOE_F8 1
#ifndef PROBE_MASK
#define PROBE_MASK 0
#endif

struct CvtJob {
    const float* src; bf16_t* dst;
    long src_bs, dst_bs;
    int K, N, src_ld, dst_ld, n_mul, n_off, Kpad, Npad, nbatch, tiles;
    int f8; float scale;
};
constexpr int NJOBS = 32;
struct Params {
    const float* in[34];
    float* out;
    char* ws;
    CvtJob jobs[NJOBS];
};

__device__ __forceinline__ float bf2f(bf16_t v) { return __uint_as_float(((unsigned)v) << 16); }
__device__ __forceinline__ bf16_t f2bf(float f) { unsigned u = __float_as_uint(f); u += 0x7FFFu + ((u >> 16) & 1u); return (bf16_t)(u >> 16); }
typedef __bf16 bf16x2_t __attribute__((ext_vector_type(2)));
typedef float f32x2_t __attribute__((ext_vector_type(2)));
__device__ __forceinline__ unsigned pack2(float lo, float hi) {
    const f32x2_t v = {lo, hi};
    return __builtin_bit_cast(unsigned, __builtin_convertvector(v, bf16x2_t));
}
__device__ __forceinline__ float bflo(unsigned w) { return __uint_as_float(w << 16); }
__device__ __forceinline__ float bfhi(unsigned w) { return __uint_as_float(w & 0xffff0000u); }
typedef unsigned u32x2_t __attribute__((ext_vector_type(2)));
__device__ __forceinline__ float red4(float x) {
    const unsigned u = __float_as_uint(x);
    const u32x2_t a = __builtin_amdgcn_permlane16_swap(u, u, false, false);
    const float t = __uint_as_float(a[0]) + __uint_as_float(a[1]);
    const unsigned v = __float_as_uint(t);
    const u32x2_t b = __builtin_amdgcn_permlane32_swap(v, v, false, false);
    return __uint_as_float(b[0]) + __uint_as_float(b[1]);
}
__device__ __forceinline__ float wave_sum(float v) {
    v += __uint_as_float(__builtin_amdgcn_update_dpp(0u, __float_as_uint(v), 0xB1, 0xf, 0xf, true));
    v += __uint_as_float(__builtin_amdgcn_update_dpp(0u, __float_as_uint(v), 0x4E, 0xf, 0xf, true));
    v += __uint_as_float(__builtin_amdgcn_update_dpp(0u, __float_as_uint(v), 0x141, 0xf, 0xf, true));
    v += __uint_as_float(__builtin_amdgcn_update_dpp(0u, __float_as_uint(v), 0x140, 0xf, 0xf, true));
    return red4(v);
}
__device__ __forceinline__ float sigmoidf_(float x) { return __builtin_amdgcn_rcpf(1.f + __expf(-x)); }
__device__ __forceinline__ float siluf_(float x) { return x * __builtin_amdgcn_rcpf(1.f + __expf(-x)); }
__device__ __forceinline__ float rdlane(float v, int l) { return __uint_as_float(__builtin_amdgcn_readlane(__float_as_uint(v), l)); }

__device__ __forceinline__ int tidx() { int t = threadIdx.x; asm volatile("" : "+v"(t)); return t; }

__device__ __forceinline__ int mod_row(int row) { return row < NLAT ? (row >> 12) : 16; }

__device__ __forceinline__ void phase_cvt(const Params& p, int jlo, int jhi, char* lds) {
    float* tile = (float*)lds;
#define CVT_T(k, n) tile[(k) * 321 + ((n) & 3) * 66 + ((n) >> 2)]
    const int tid = tidx();
    int total = 0;
    for (int j = jlo; j < jhi; ++j) total += p.jobs[j].tiles;
    auto locate = [&](int u, int& j, int& bt, int& kt, int& nt) {
        j = jlo; int uu = u;
        while (uu >= p.jobs[j].tiles) { uu -= p.jobs[j].tiles; ++j; }
        const int tk = p.jobs[j].Kpad / 64, tn = (p.jobs[j].Npad + 255) / 256;
        bt = uu / (tk * tn); const int r = uu % (tk * tn); kt = r / tn; nt = r % tn;
    };
    auto load = [&](int j, int bt, int kt, int nt, float4 (&v)[8]) {
        const CvtJob& J = p.jobs[j];
        const float* src = J.src + (size_t)bt * J.src_bs;
#pragma unroll
        for (int ps = 0; ps < 8; ++ps) {
            const int kl = ps * 8 + (tid >> 6), k = kt * 64 + kl, n = nt * 256 + (tid & 63) * 4;
            v[ps] = make_float4(0.f, 0.f, 0.f, 0.f);
            if (k < J.K) {
                const float* sp = src + (size_t)k * J.src_ld + n;
                if (n + 3 < J.N) v[ps] = *(const float4*)sp;
                else { if (n < J.N) v[ps].x = sp[0]; if (n + 1 < J.N) v[ps].y = sp[1]; if (n + 2 < J.N) v[ps].z = sp[2]; }
            }
        }
    };
    int u = blockIdx.x;
    if (u >= total) return;
    int j, bt, kt, nt;
    float4 v[8];
    locate(u, j, bt, kt, nt);
    load(j, bt, kt, nt, v);
    for (;;) {
#pragma unroll
        for (int ps = 0; ps < 8; ++ps) {
            float* tp = tile + (ps * 8 + (tid >> 6)) * 321 + (tid & 63);
            tp[0] = v[ps].x; tp[66] = v[ps].y; tp[132] = v[ps].z; tp[198] = v[ps].w;
        }
        __syncthreads();
        const int un = u + gridDim.x;
        int jn = j, btn = bt, ktn = kt, ntn = nt;
        if (un < total) { locate(un, jn, btn, ktn, ntn); load(jn, btn, ktn, ntn, v); }
        const CvtJob& J = p.jobs[j];
        if (J.f8) {
            char* dstb = (char*)J.dst + (size_t)bt * J.dst_bs;
            const float sc = J.scale;
#pragma unroll
            for (int ps = 0; ps < 4; ++ps) {
                const int nl = ps * 64 + (tid >> 3), kc = tid & 7, n = nt * 256 + nl;
                if (n < J.Npad) {
                    int w0 = 0, w1 = 0;
                    w0 = __builtin_amdgcn_cvt_pk_fp8_f32(CVT_T(kc * 8 + 0, nl) * sc, CVT_T(kc * 8 + 1, nl) * sc, w0, false);
                    w0 = __builtin_amdgcn_cvt_pk_fp8_f32(CVT_T(kc * 8 + 2, nl) * sc, CVT_T(kc * 8 + 3, nl) * sc, w0, true);
                    w1 = __builtin_amdgcn_cvt_pk_fp8_f32(CVT_T(kc * 8 + 4, nl) * sc, CVT_T(kc * 8 + 5, nl) * sc, w1, false);
                    w1 = __builtin_amdgcn_cvt_pk_fp8_f32(CVT_T(kc * 8 + 6, nl) * sc, CVT_T(kc * 8 + 7, nl) * sc, w1, true);
                    const u32x2 o = {(unsigned)w0, (unsigned)w1};
                    *(u32x2*)(dstb + ((size_t)n * J.n_mul + J.n_off) * J.dst_ld + kt * 64 + kc * 8) = o;
                }
            }
        } else {
            bf16_t* dst = J.dst + (size_t)bt * J.dst_bs;
#pragma unroll
            for (int ps = 0; ps < 4; ++ps) {
                const int nl = ps * 64 + (tid >> 3), kc = tid & 7, n = nt * 256 + nl;
                if (n < J.Npad) {
                    u32x4 o;
                    o[0] = pack2(CVT_T(kc * 8 + 0, nl), CVT_T(kc * 8 + 1, nl));
                    o[1] = pack2(CVT_T(kc * 8 + 2, nl), CVT_T(kc * 8 + 3, nl));
                    o[2] = pack2(CVT_T(kc * 8 + 4, nl), CVT_T(kc * 8 + 5, nl));
                    o[3] = pack2(CVT_T(kc * 8 + 6, nl), CVT_T(kc * 8 + 7, nl));
                    *(u32x4*)(dst + ((size_t)n * J.n_mul + J.n_off) * J.dst_ld + kt * 64 + kc * 8) = o;
                }
            }
        }
        __syncthreads();
        if (un >= total) break;
        u = un; j = jn; bt = btn; kt = ktn; nt = ntn;
    }
}
#undef CVT_T

__device__ __forceinline__ void phase_ada(const Params& p, char* lds) {
    float* sc = (float*)lds;
    float* red = sc + 17 * 1024;
    const int tid = tidx();
    const float* c = p.in[1]; const float* cctx = p.in[3];
    for (int i = tid; i < 17 * 1024; i += NTHREADS) {
        const float v = i < 16 * 1024 ? c[i] : cctx[i - 16 * 1024];
        sc[i] = siluf_(v);
    }
    __syncthreads();
    float* MOD = (float*)(p.ws + OFF_MOD);
    const int col = tid & 63, ks = tid >> 6;
    for (int u = blockIdx.x; u < 4 * 96; u += gridDim.x) {
        const int l = u / 96, n = (u % 96) * 64 + col;
        const float* w = p.in[4] + (size_t)l * D * MODW + n;
        float acc[17];
#pragma unroll
        for (int r = 0; r < 17; ++r) acc[r] = 0.f;
        for (int k = ks * 128; k < ks * 128 + 128; ++k) {
            const float wv = w[(size_t)k * MODW];
#pragma unroll
            for (int r = 0; r < 17; ++r) acc[r] += sc[r * 1024 + k] * wv;
        }
#pragma unroll
        for (int r = 0; r < 17; ++r) red[(ks * 17 + r) * 64 + col] = acc[r];
        __syncthreads();
        for (int i = tid; i < 17 * 64; i += NTHREADS) {
            const int r = i >> 6, cc = i & 63;
            float s = 0.f;
#pragma unroll
            for (int q = 0; q < 8; ++q) s += red[(q * 17 + r) * 64 + cc];
            const int nn = (u % 96) * 64 + cc;
            MOD[((size_t)l * 17 + r) * MODW + nn] = s + p.in[5][(size_t)l * MODW + nn];
        }
        __syncthreads();
    }
}

#ifndef ROUTER_RW
#define ROUTER_RW 4
#endif
template <bool ROUTER>
__device__ __forceinline__ void phase_norm(const Params& p, int l, int which, int nrows, char* lds) {
    const float* X = (const float*)(p.ws + OFF_X);
    const bool from_in = l == 0;
    const bf16_t* D1 = (const bf16_t*)(p.ws + OFF_D1);
    bf16_t* H = (bf16_t*)(p.ws + OFF_H);
    const float* MOD = (const float*)(p.ws + OFF_MOD) + (size_t)l * 17 * MODW;
    const float* g = (which == 0 ? p.in[6] : p.in[7]) + (size_t)l * D;
    float* AFF = (float*)(p.ws + OFF_AFF);
    float* rt = (float*)lds;
    const int tid = tidx(), lane = tid & 63, wid = tid >> 6;
    if (ROUTER) {
        const float* rsrc = p.in[29] + (size_t)l * D * NE;
        for (int i = tid; i < D * NE; i += NTHREADS) { const int e = i & 15, col = i >> 4; rt[(((e >> 1) * 2 + ((col >> 1) & 1)) * 256 + (col >> 2)) * 4 + (col & 1) * 2 + (e & 1)] = rsrc[i]; }
        __syncthreads();
    }
    const int so = which == 0 ? 0 : 3 * D, co = which == 0 ? D : 4 * D;
    constexpr int RW = ROUTER ? ROUTER_RW : 4;
    for (int grp = blockIdx.x * 8 + wid; grp < nrows / RW; grp += gridDim.x * 8) {
        const int row0 = grp * RW;
        const float* mr = MOD + (size_t)mod_row(row0) * MODW;
        float4 x[RW][4];
#pragma unroll
        for (int r = 0; r < RW; ++r)
#pragma unroll
            for (int i = 0; i < 4; ++i) {
                const int rw_ = row0 + r, c0 = i * 256 + lane * 4;
                const float* xs = from_in ? (rw_ < NLAT ? p.in[0] + (size_t)rw_ * D : p.in[2] + (size_t)(rw_ - NLAT) * D) : X + (size_t)rw_ * D;
                x[r][i] = *(const float4*)(xs + c0);
                if (ROUTER) {
                    const u32x2 dw = *(const u32x2*)(D1 + (size_t)rw_ * D + c0);
                    const float4 gt = *(const float4*)(mr + 2 * D + c0);
                    x[r][i].x += gt.x * bflo(dw[0]); x[r][i].y += gt.y * bfhi(dw[0]); x[r][i].z += gt.z * bflo(dw[1]); x[r][i].w += gt.w * bfhi(dw[1]);
                }
            }
        float rs[RW];
#pragma unroll
        for (int r = 0; r < RW; ++r) {
            float ss = 0.f;
#pragma unroll
            for (int i = 0; i < 4; ++i) ss += x[r][i].x * x[r][i].x + x[r][i].y * x[r][i].y + x[r][i].z * x[r][i].z + x[r][i].w * x[r][i].w;
            rs[r] = rsqrtf(wave_sum(ss) * (1.f / D) + 1e-6f);
        }
#pragma unroll
        for (int i = 0; i < 4; ++i) {
            const int c0 = i * 256 + lane * 4;
            const float4 gg = *(const float4*)(g + c0), sh = *(const float4*)(mr + so + c0), sl = *(const float4*)(mr + co + c0);
            const float m0 = gg.x * (1.f + sl.x), m1 = gg.y * (1.f + sl.y), m2 = gg.z * (1.f + sl.z), m3 = gg.w * (1.f + sl.w);
#pragma unroll
            for (int r = 0; r < RW; ++r) {
                float4 h; h.x = x[r][i].x * rs[r] * m0 + sh.x; h.y = x[r][i].y * rs[r] * m1 + sh.y; h.z = x[r][i].z * rs[r] * m2 + sh.z; h.w = x[r][i].w * rs[r] * m3 + sh.w;
                x[r][i] = h;
                if (ROUTER && MOE_F8) {
                    int w = 0; w = __builtin_amdgcn_cvt_pk_fp8_f32(h.x, h.y, w, false); w = __builtin_amdgcn_cvt_pk_fp8_f32(h.z, h.w, w, true);
                    *(unsigned*)((char*)H + (size_t)(row0 + r) * D + c0) = (unsigned)w;
                } else {
                    u32x2 o; o[0] = pack2(h.x, h.y); o[1] = pack2(h.z, h.w);
                    *(u32x2*)(H + (size_t)(row0 + r) * D + c0) = o;
                }
            }
        }
        if (ROUTER) {
            f32x2_t lgp[RW][8];
#pragma unroll
            for (int r = 0; r < RW; ++r)
#pragma unroll
                for (int ep = 0; ep < 8; ++ep) lgp[r][ep] = (f32x2_t){0.f, 0.f};
#pragma unroll
            for (int i = 0; i < 4; ++i) {
#pragma unroll
                for (int ep = 0; ep < 8; ++ep) {
                    const float4 q0 = *(const float4*)(rt + ((ep * 2 + 0) * 256 + i * 64 + lane) * 4), q1 = *(const float4*)(rt + ((ep * 2 + 1) * 256 + i * 64 + lane) * 4);
                    const f32x2_t w0 = {q0.x, q0.y}, w1 = {q0.z, q0.w}, w2 = {q1.x, q1.y}, w3 = {q1.z, q1.w};
#pragma unroll
                    for (int r = 0; r < RW; ++r) {
                        const float4 h = x[r][i];
                        lgp[r][ep] += (f32x2_t){h.x, h.x} * w0; lgp[r][ep] += (f32x2_t){h.y, h.y} * w1; lgp[r][ep] += (f32x2_t){h.z, h.z} * w2; lgp[r][ep] += (f32x2_t){h.w, h.w} * w3;
                    }
#pragma unroll
                    for (int r = 0; r < RW; ++r) asm volatile("" : "+v"(lgp[r][ep]));
                }
            }
            const int b0 = lane & 1, b1 = (lane >> 1) & 1;
            const int eidx = b1 + 2 * b0 + 4 * (lane >> 5) + 8 * ((lane >> 4) & 1);
#pragma unroll
            for (int r = 0; r < RW; ++r) {
                float v8[8], v4[4], v2[2];
#pragma unroll
                for (int i = 0; i < 8; ++i) {
                    const float lo = (i & 1) ? lgp[r][i >> 1].y : lgp[r][i >> 1].x, hi = (i & 1) ? lgp[r][4 + (i >> 1)].y : lgp[r][4 + (i >> 1)].x;
                    const u32x2_t sw = __builtin_amdgcn_permlane16_swap(__float_as_uint(lo), __float_as_uint(hi), false, false);
                    v8[i] = __uint_as_float(sw[0]) + __uint_as_float(sw[1]);
                }
#pragma unroll
                for (int i = 0; i < 4; ++i) {
                    const u32x2_t sw = __builtin_amdgcn_permlane32_swap(__float_as_uint(v8[i]), __float_as_uint(v8[i + 4]), false, false);
                    v4[i] = __uint_as_float(sw[0]) + __uint_as_float(sw[1]);
                }
#pragma unroll
                for (int i = 0; i < 2; ++i) {
                    const float keep = b0 ? v4[i + 2] : v4[i], send = b0 ? v4[i] : v4[i + 2];
                    v2[i] = keep + __uint_as_float(__builtin_amdgcn_update_dpp(0u, __float_as_uint(send), 0xB1, 0xf, 0xf, true));
                }
                float lgt;
                {
                    const float keep = b1 ? v2[1] : v2[0], send = b1 ? v2[0] : v2[1];
                    lgt = keep + __uint_as_float(__builtin_amdgcn_update_dpp(0u, __float_as_uint(send), 0x4E, 0xf, 0xf, true));
                }
                lgt += __uint_as_float(__builtin_amdgcn_update_dpp(0u, __float_as_uint(lgt), 0x124, 0xf, 0xf, true));
                lgt += __uint_as_float(__builtin_amdgcn_update_dpp(0u, __float_as_uint(lgt), 0x128, 0xf, 0xf, true));
                float mx = lgt;
                mx = fmaxf(mx, __uint_as_float(__builtin_amdgcn_update_dpp(0u, __float_as_uint(mx), 0xB1, 0xf, 0xf, true)));
                mx = fmaxf(mx, __uint_as_float(__builtin_amdgcn_update_dpp(0u, __float_as_uint(mx), 0x4E, 0xf, 0xf, true)));
                { const u32x2_t sw = __builtin_amdgcn_permlane16_swap(__float_as_uint(mx), __float_as_uint(mx), false, false); mx = fmaxf(__uint_as_float(sw[0]), __uint_as_float(sw[1])); }
                { const u32x2_t sw = __builtin_amdgcn_permlane32_swap(__float_as_uint(mx), __float_as_uint(mx), false, false); mx = fmaxf(__uint_as_float(sw[0]), __uint_as_float(sw[1])); }
                const float ex = __expf(lgt - mx);
                float sum = ex;
                sum += __uint_as_float(__builtin_amdgcn_update_dpp(0u, __float_as_uint(sum), 0xB1, 0xf, 0xf, true));
                sum += __uint_as_float(__builtin_amdgcn_update_dpp(0u, __float_as_uint(sum), 0x4E, 0xf, 0xf, true));
                { const u32x2_t sw = __builtin_amdgcn_permlane16_swap(__float_as_uint(sum), __float_as_uint(sum), false, false); sum = __uint_as_float(sw[0]) + __uint_as_float(sw[1]); }
                { const u32x2_t sw = __builtin_amdgcn_permlane32_swap(__float_as_uint(sum), __float_as_uint(sum), false, false); sum = __uint_as_float(sw[0]) + __uint_as_float(sw[1]); }
                if ((lane & 12) == 0) AFF[(size_t)(row0 + r) * 16 + eidx] = ex / sum;
            }
        }
    }
}

constexpr int GS_LD = 72;
template <class AL, class EP>
__device__ __forceinline__ void gemm_tile_small(char* lds, const AL& al, const bf16_t* __restrict__ Bt, int ldb, int K, int row0, int col0, const EP& ep) {
    bf16_t* As = (bf16_t*)lds; bf16_t* Bs = As + 128 * GS_LD;
    const int tid = tidx(), lane = tid & 63, wid = tid >> 6, wr = wid >> 1, wc = wid & 1, fr = lane & 15, fq = lane >> 4;
    const int lr = tid >> 3, kc = tid & 7;
    f32x4 acc[2][4];
#pragma unroll
    for (int m = 0; m < 2; ++m)
#pragma unroll
        for (int n = 0; n < 4; ++n) acc[m][n] = (f32x4){0.f, 0.f, 0.f, 0.f};
    bf16x8 ra0 = al(row0 + lr, kc * 8), ra1 = al(row0 + lr + 64, kc * 8);
    bf16x8 rb0 = *(const bf16x8*)(Bt + (size_t)(col0 + lr) * ldb + kc * 8), rb1 = *(const bf16x8*)(Bt + (size_t)(col0 + lr + 64) * ldb + kc * 8);
    for (int k0 = 0; k0 < K; k0 += 64) {
        __syncthreads();
        *(bf16x8*)(As + lr * GS_LD + kc * 8) = ra0; *(bf16x8*)(As + (lr + 64) * GS_LD + kc * 8) = ra1;
        *(bf16x8*)(Bs + lr * GS_LD + kc * 8) = rb0; *(bf16x8*)(Bs + (lr + 64) * GS_LD + kc * 8) = rb1;
        __syncthreads();
        if (k0 + 64 < K) {
            const int kn = k0 + 64 + kc * 8;
            ra0 = al(row0 + lr, kn); ra1 = al(row0 + lr + 64, kn);
            rb0 = *(const bf16x8*)(Bt + (size_t)(col0 + lr) * ldb + kn); rb1 = *(const bf16x8*)(Bt + (size_t)(col0 + lr + 64) * ldb + kn);
        }
#pragma unroll
        for (int ks = 0; ks < 2; ++ks) {
            bf16x8 a[2], b[4];
#pragma unroll
            for (int m = 0; m < 2; ++m) a[m] = *(const bf16x8*)(As + (wr * 32 + m * 16 + fr) * GS_LD + ks * 32 + fq * 8);
#pragma unroll
            for (int n = 0; n < 4; ++n) b[n] = *(const bf16x8*)(Bs + (wc * 64 + n * 16 + fr) * GS_LD + ks * 32 + fq * 8);
#pragma unroll
            for (int m = 0; m < 2; ++m)
#pragma unroll
                for (int n = 0; n < 4; ++n) acc[m][n] = __builtin_amdgcn_mfma_f32_16x16x32_bf16(b[n], a[m], acc[m][n], 0, 0, 0);
        }
    }
#pragma unroll
    for (int m = 0; m < 2; ++m)
#pragma unroll
        for (int n = 0; n < 4; ++n) ep(row0 + wr * 32 + m * 16 + fr, col0 + wc * 64 + n * 16 + fq * 4, acc[m][n]);
}

struct PlainLoader {
    const bf16_t* A; int lda;
    __device__ __forceinline__ bf16x8 operator()(int row, int k) const { return *(const bf16x8*)(A + (size_t)row * lda + k); }
    struct Raw { u32x4 h; };
    struct RawK { int dummy; };
    __device__ __forceinline__ void loadk(int k, RawK& r) const { r.dummy = 0; }
    __device__ __forceinline__ void load(int row, int k, Raw& r) const { r.h = *(const u32x4*)(A + (size_t)row * lda + k); }
    __device__ __forceinline__ bf16x8 finish(const Raw& r, const RawK&) const { return __builtin_bit_cast(bf16x8, r.h); }
};
struct MixLoader {
    const bf16_t* H; const float* mix;
    __device__ __forceinline__ bf16x8 operator()(int row, int k) const {
        int nb;
        if (row < NLAT) {
            const int t = row & (TL - 1), gc = t & 63, gr = t >> 6, q = k >> 8;
            if (q == 0) nb = gc > 0 ? row - 1 : -1;
            else if (q == 1) nb = gc < 63 ? row + 1 : -1;
            else if (q == 2) nb = gr > 0 ? row - 64 : -1;
            else nb = gr < 63 ? row + 64 : -1;
        } else {
            const int t = (row - NLAT) & (TC - 1);
            if (k < 512) nb = t > 0 ? row - 1 : -1;
            else nb = t < TC - 1 ? row + 1 : -1;
        }
        const u32x4 h = *(const u32x4*)(H + (size_t)row * D + k);
        u32x4 s = (u32x4){0u, 0u, 0u, 0u};
        if (nb >= 0) s = *(const u32x4*)(H + (size_t)nb * D + k);
        const float4 m0 = *(const float4*)(mix + k), m1 = *(const float4*)(mix + k + 4);
        u32x4 o;
        { float a = bflo(h[0]), b = bfhi(h[0]); o[0] = pack2(a + (bflo(s[0]) - a) * m0.x, b + (bfhi(s[0]) - b) * m0.y); }
        { float a = bflo(h[1]), b = bfhi(h[1]); o[1] = pack2(a + (bflo(s[1]) - a) * m0.z, b + (bfhi(s[1]) - b) * m0.w); }
        { float a = bflo(h[2]), b = bfhi(h[2]); o[2] = pack2(a + (bflo(s[2]) - a) * m1.x, b + (bfhi(s[2]) - b) * m1.y); }
        { float a = bflo(h[3]), b = bfhi(h[3]); o[3] = pack2(a + (bflo(s[3]) - a) * m1.z, b + (bfhi(s[3]) - b) * m1.w); }
        return __builtin_bit_cast(bf16x8, o);
    }
    struct Raw { u32x4 h, s; };
    struct RawK { float4 m0, m1; };
    __device__ __forceinline__ void loadk(int k, RawK& r) const { r.m0 = *(const float4*)(mix + k); r.m1 = *(const float4*)(mix + k + 4); }
    __device__ __forceinline__ void load(int row, int k, Raw& r) const {
        int nb;
        if (row < NLAT) {
            const int t = row & (TL - 1), gc = t & 63, gr = t >> 6, q = k >> 8;
            if (q == 0) nb = gc > 0 ? row - 1 : -1;
            else if (q == 1) nb = gc < 63 ? row + 1 : -1;
            else if (q == 2) nb = gr > 0 ? row - 64 : -1;
            else nb = gr < 63 ? row + 64 : -1;
        } else {
            const int t = (row - NLAT) & (TC - 1);
            if (k < 512) nb = t > 0 ? row - 1 : -1;
            else nb = t < TC - 1 ? row + 1 : -1;
        }
        r.h = *(const u32x4*)(H + (size_t)row * D + k);
        r.s = (u32x4){0u, 0u, 0u, 0u};
        if (nb >= 0) r.s = *(const u32x4*)(H + (size_t)nb * D + k);
    }
    __device__ __forceinline__ bf16x8 finish(const Raw& r, const RawK& c) const {
        u32x4 o;
        { float a = bflo(r.h[0]), b = bfhi(r.h[0]); o[0] = pack2(a + (bflo(r.s[0]) - a) * c.m0.x, b + (bfhi(r.s[0]) - b) * c.m0.y); }
        { float a = bflo(r.h[1]), b = bfhi(r.h[1]); o[1] = pack2(a + (bflo(r.s[1]) - a) * c.m0.z, b + (bfhi(r.s[1]) - b) * c.m0.w); }
        { float a = bflo(r.h[2]), b = bfhi(r.h[2]); o[2] = pack2(a + (bflo(r.s[2]) - a) * c.m1.x, b + (bfhi(r.s[2]) - b) * c.m1.y); }
        { float a = bflo(r.h[3]), b = bfhi(r.h[3]); o[3] = pack2(a + (bflo(r.s[3]) - a) * c.m1.z, b + (bfhi(r.s[3]) - b) * c.m1.w); }
        return __builtin_bit_cast(bf16x8, o);
    }
};

__device__ __forceinline__ void lds_barrier() { asm volatile("s_waitcnt lgkmcnt(0)\n\ts_barrier" ::: "memory"); }
template <class AL, class EP>
__device__ __forceinline__ void gemm_tile_small2(char* lds, const AL& al, const bf16_t* __restrict__ Bt, int ldb, int K, int row0, int col0, const EP& ep) {
    bf16_t* As0 = (bf16_t*)lds;
    const int tid = tidx(), lane = tid & 63, wid = tid >> 6, wr = wid >> 1, wc = wid & 1, fr = lane & 15, fq = lane >> 4;
    const int lr = tid >> 3, kc = tid & 7;
    constexpr int PD = 4;
    f32x4 acc[2][4];
#pragma unroll
    for (int m = 0; m < 2; ++m)
#pragma unroll
        for (int n = 0; n < 4; ++n) acc[m][n] = (f32x4){0.f, 0.f, 0.f, 0.f};
    typename AL::Raw qa0[PD], qa1[PD]; typename AL::RawK qk[PD]; u32x4 qb0[PD], qb1[PD];
    const int nsteps = K / 64;
#define GTS2_ISSUE(SLOT, STEP) do { const int kn_ = (STEP) * 64 + kc * 8; al.loadk(kn_, qk[SLOT]); al.load(row0 + lr, kn_, qa0[SLOT]); al.load(row0 + lr + 64, kn_, qa1[SLOT]); \
        qb0[SLOT] = *(const u32x4*)(Bt + (size_t)(col0 + lr) * ldb + kn_); qb1[SLOT] = *(const u32x4*)(Bt + (size_t)(col0 + lr + 64) * ldb + kn_); } while (0)
#pragma unroll
    for (int d = 0; d < PD; ++d) GTS2_ISSUE(d, d);
    for (int s0 = 0; s0 < nsteps; s0 += PD) {
#pragma unroll
        for (int d = 0; d < PD; ++d) {
            const int step = s0 + d;
            bf16_t* As = As0 + (d & 1) * (256 * GS_LD); bf16_t* Bs = As + 128 * GS_LD;
            *(bf16x8*)(As + lr * GS_LD + kc * 8) = al.finish(qa0[d], qk[d]); *(bf16x8*)(As + (lr + 64) * GS_LD + kc * 8) = al.finish(qa1[d], qk[d]);
            *(u32x4*)(Bs + lr * GS_LD + kc * 8) = qb0[d]; *(u32x4*)(Bs + (lr + 64) * GS_LD + kc * 8) = qb1[d];
            lds_barrier();
            if (step + PD < nsteps) GTS2_ISSUE(d, step + PD);
#pragma unroll
            for (int ks = 0; ks < 2; ++ks) {
                bf16x8 a[2], b[4];
#pragma unroll
                for (int m = 0; m < 2; ++m) a[m] = *(const bf16x8*)(As + (wr * 32 + m * 16 + fr) * GS_LD + ks * 32 + fq * 8);
#pragma unroll
                for (int n = 0; n < 4; ++n) b[n] = *(const bf16x8*)(Bs + (wc * 64 + n * 16 + fr) * GS_LD + ks * 32 + fq * 8);
#pragma unroll
                for (int m = 0; m < 2; ++m)
#pragma unroll
                    for (int n = 0; n < 4; ++n) acc[m][n] = __builtin_amdgcn_mfma_f32_16x16x32_bf16(b[n], a[m], acc[m][n], 0, 0, 0);
            }
        }
    }
#undef GTS2_ISSUE
#pragma unroll
    for (int m = 0; m < 2; ++m)
#pragma unroll
        for (int n = 0; n < 4; ++n) ep(row0 + wr * 32 + m * 16 + fr, col0 + wc * 64 + n * 16 + fq * 4, acc[m][n]);
}

struct EpStoreBf16 {
    bf16_t* O; int ldo; int act;
    __device__ __forceinline__ void operator()(int row, int col, f32x4 v) const {
        if (act == 1) { v[0] = tanhf(v[0]); v[1] = tanhf(v[1]); v[2] = tanhf(v[2]); v[3] = tanhf(v[3]); }
        else if (act == 2) { v[0] = sigmoidf_(v[0]); v[1] = sigmoidf_(v[1]); v[2] = sigmoidf_(v[2]); v[3] = sigmoidf_(v[3]); }
        u32x2 o; o[0] = pack2(v[0], v[1]); o[1] = pack2(v[2], v[3]);
        *(u32x2*)(O + (size_t)row * ldo + col) = o;
    }
};
struct EpDecay {
    bf16_t* O; const float* w0;
    __device__ __forceinline__ void operator()(int row, int col, f32x4 v) const {
        const float4 b = *(const float4*)(w0 + col);
        u32x2 o;
        o[0] = pack2(-0.6065306597f * sigmoidf_(v[0] + b.x), -0.6065306597f * sigmoidf_(v[1] + b.y));
        o[1] = pack2(-0.6065306597f * sigmoidf_(v[2] + b.z), -0.6065306597f * sigmoidf_(v[3] + b.w));
        *(u32x2*)(O + (size_t)row * D + col) = o;
    }
};
struct EpSigBias {
    bf16_t* O; const float* b0;
    __device__ __forceinline__ void operator()(int row, int col, f32x4 v) const {
        const float4 b = *(const float4*)(b0 + col);
        u32x2 o;
        o[0] = pack2(sigmoidf_(v[0] + b.x), sigmoidf_(v[1] + b.y));
        o[1] = pack2(sigmoidf_(v[2] + b.z), sigmoidf_(v[3] + b.w));
        *(u32x2*)(O + (size_t)row * D + col) = o;
    }
};
struct EpVres {
    bf16_t* VF; const bf16_t* VRAW; const float* v0;
    __device__ __forceinline__ void operator()(int row, int col, f32x4 a) const {
        const float4 b = *(const float4*)(v0 + col);
        const u32x2 vr = *(const u32x2*)(VRAW + (size_t)row * D + col);
        const u32x2 vf = *(const u32x2*)(VF + (size_t)row * D + col);
        float x0 = bflo(vr[0]), x1 = bfhi(vr[0]), x2 = bflo(vr[1]), x3 = bfhi(vr[1]);
        float f0 = bflo(vf[0]), f1 = bfhi(vf[0]), f2 = bflo(vf[1]), f3 = bfhi(vf[1]);
        u32x2 o;
        o[0] = pack2(x0 + (f0 - x0) * sigmoidf_(a[0] + b.x), x1 + (f1 - x1) * sigmoidf_(a[1] + b.y));
        o[1] = pack2(x2 + (f2 - x2) * sigmoidf_(a[2] + b.z), x3 + (f3 - x3) * sigmoidf_(a[3] + b.w));
        *(u32x2*)(VF + (size_t)row * D + col) = o;
    }
};
struct EpResidual {
    float* X; const float* gate; const float* cscale; float amp;
    const float* xin; const float* cin;
    __device__ __forceinline__ void operator()(int row, int col, f32x4 a) const {
        const float4 gt = *(const float4*)(gate + (size_t)mod_row(row) * MODW + col);
        float4 cs = make_float4(amp, amp, amp, amp);
        if (cscale) { const float4 t = *(const float4*)(cscale + col); cs.x *= t.x; cs.y *= t.y; cs.z *= t.z; cs.w *= t.w; }
        float4* xp = (float4*)(X + (size_t)row * D + col);
        const float4* sp = xin ? (const float4*)((row < NLAT ? xin + (size_t)row * D : cin + (size_t)(row - NLAT) * D) + col) : (const float4*)xp;
        float4 x = *sp;
        x.x += gt.x * a[0] * cs.x; x.y += gt.y * a[1] * cs.y; x.z += gt.z * a[2] * cs.z; x.w += gt.w * a[3] * cs.w;
        *xp = x;
    }
};
struct EpD1 {
    bf16_t* D1; const float* cscale;
    __device__ __forceinline__ void operator()(int row, int col, f32x4 a, f32x4 b) const {
        if (cscale) { const float4 s0 = *(const float4*)(cscale + col), s1 = *(const float4*)(cscale + col + 4);
            a[0] *= s0.x; a[1] *= s0.y; a[2] *= s0.z; a[3] *= s0.w; b[0] *= s1.x; b[1] *= s1.y; b[2] *= s1.z; b[3] *= s1.w; }
        const u32x4 o = {pack2(a[0], a[1]), pack2(a[2], a[3]), pack2(b[0], b[1]), pack2(b[2], b[3])};
        *(u32x4*)(D1 + (size_t)row * D + col) = o;
    }
};
struct EpSwiglu {
    bf16_t* HID;
    __device__ __forceinline__ void operator()(int row, int col, f32x4 a) const {
        *(unsigned*)(HID + (size_t)row * FF + (col >> 1)) = pack2(siluf_(a[0]) * a[1], siluf_(a[2]) * a[3]);
    }
    __device__ __forceinline__ void operator()(int row, int col, f32x4 a, f32x4 b) const {
        const f32x2_t g0 = {a[0], a[2]}, u0 = {a[1], a[3]}, g1 = {b[0], b[2]}, u1 = {b[1], b[3]};
        const f32x2_t t0 = g0 * -1.44269504089f, t1 = g1 * -1.44269504089f;
        f32x2_t e0, e1; e0.x = __builtin_amdgcn_exp2f(t0.x); e0.y = __builtin_amdgcn_exp2f(t0.y); e1.x = __builtin_amdgcn_exp2f(t1.x); e1.y = __builtin_amdgcn_exp2f(t1.y);
        const f32x2_t d0 = e0 + 1.0f, d1 = e1 + 1.0f;
        f32x2_t r0, r1; r0.x = __builtin_amdgcn_rcpf(d0.x); r0.y = __builtin_amdgcn_rcpf(d0.y); r1.x = __builtin_amdgcn_rcpf(d1.x); r1.y = __builtin_amdgcn_rcpf(d1.y);
        const f32x2_t h0 = (g0 * u0) * r0, h1 = (g1 * u1) * r1;
        const u32x2 o = {pack2(h0.x, h0.y), pack2(h1.x, h1.y)};
        *(u32x2*)(HID + (size_t)row * FF + (col >> 1)) = o;
    }
};
struct EpSwiglu8 {
    char* HID;
    __device__ __forceinline__ void operator()(int row, int col, f32x4 a) const {
        int w = 0; w = __builtin_amdgcn_cvt_pk_fp8_f32(siluf_(a[0]) * a[1], siluf_(a[2]) * a[3], w, false);
        *(unsigned short*)(HID + (size_t)row * FF + (col >> 1)) = (unsigned short)w;
    }
    __device__ __forceinline__ void operator()(int row, int col, f32x4 a, f32x4 b) const {
        const f32x2_t g0 = {a[0], a[2]}, u0 = {a[1], a[3]}, g1 = {b[0], b[2]}, u1 = {b[1], b[3]};
        const f32x2_t t0 = g0 * -1.44269504089f, t1 = g1 * -1.44269504089f;
        f32x2_t e0, e1; e0.x = __builtin_amdgcn_exp2f(t0.x); e0.y = __builtin_amdgcn_exp2f(t0.y); e1.x = __builtin_amdgcn_exp2f(t1.x); e1.y = __builtin_amdgcn_exp2f(t1.y);
        const f32x2_t d0 = e0 + 1.0f, d1 = e1 + 1.0f;
        f32x2_t r0, r1; r0.x = __builtin_amdgcn_rcpf(d0.x); r0.y = __builtin_amdgcn_rcpf(d0.y); r1.x = __builtin_amdgcn_rcpf(d1.x); r1.y = __builtin_amdgcn_rcpf(d1.y);
        const f32x2_t h0 = (g0 * u0) * r0, h1 = (g1 * u1) * r1;
        int w = 0;
        w = __builtin_amdgcn_cvt_pk_fp8_f32(h0.x, h0.y, w, false);
        w = __builtin_amdgcn_cvt_pk_fp8_f32(h1.x, h1.y, w, true);
        *(unsigned*)(HID + (size_t)row * FF + (col >> 1)) = (unsigned)w;
    }
};
struct EpGateRow {
    bf16_t* YS; const float* gatev;
    __device__ __forceinline__ void operator()(int row, int col, f32x4 a) const {
        const float gt = gatev[row];
        u32x2 o; o[0] = pack2(a[0] * gt, a[1] * gt); o[1] = pack2(a[2] * gt, a[3] * gt);
        *(u32x2*)(YS + (size_t)row * D + col) = o;
    }
    __device__ __forceinline__ void operator()(int row, int col, f32x4 a, f32x4 b) const {
        const float gt = gatev[row];
        const u32x4 o = {pack2(a[0] * gt, a[1] * gt), pack2(a[2] * gt, a[3] * gt), pack2(b[0] * gt, b[1] * gt), pack2(b[2] * gt, b[3] * gt)};
        *(u32x4*)(YS + (size_t)row * D + col) = o;
    }
};

#define LAS __attribute__((address_space(3)))
namespace g256 {
constexpr int BM = 256, BK = 64, HALF = 128, HTB = HALF * BK * 2, STAGE_BYTES = 8 * HTB;
__device__ __forceinline__ int lds_byte(int r, int c) { const int st = (r >> 4) * 2 + (c >> 5), rr = r & 15, cc = c & 31, ob = rr * 64 + cc * 2; return st * 1024 + (ob ^ (((ob >> 9) & 1) << 5)); }
__device__ __forceinline__ void stage_rc(int b, int& R, int& C) { const int st = b / 1024, sb = b % 1024, swz = sb ^ (((sb >> 9) & 1) << 5); R = (st >> 1) * 16 + swz / 64; C = (st & 1) * 32 + (swz % 64) / 2; }
struct Unit { const char* a; const char* b; int row0, col0; };
typedef int i32x4_t __attribute__((ext_vector_type(4)));
typedef int i32x8_t __attribute__((ext_vector_type(8)));
__device__ __forceinline__ i32x8_t cat8(bf16x8 lo, bf16x8 hi) { return __builtin_shufflevector(__builtin_bit_cast(i32x4_t, lo), __builtin_bit_cast(i32x4_t, hi), 0, 1, 2, 3, 4, 5, 6, 7); }

__device__ __forceinline__ int perm32(int rho) { const int n = rho >> 4, i = rho & 15; return 8 * (i >> 2) + 4 * n + (i & 3); }
template <bool PERM, bool F8 = false, bool GATHER = false, class Sched, class Ep>
__device__ __forceinline__ void gemm_phase(LAS unsigned char* lds, const int lda, const int ldb, const int K, const Sched& S, const Ep& E) {
    const int tid = tidx(), wid = __builtin_amdgcn_readfirstlane(tid >> 6), lane = tid & 63, wr = wid >> 2, wc = wid & 3, fr = lane & 15, fq = lane >> 4;
    const int nt = K / BK;
    int scw = 0x79797979, sca = 0x7F7F7F7F;
    if constexpr (F8) asm volatile("" : "+v"(scw), "+v"(sca));
    unsigned voffA[2], voffB[2], cbA[2];
#pragma unroll
    for (int i = 0; i < 2; ++i) { int R, C; stage_rc(tid * 16 + i * 8192, R, C); const int Rb = PERM ? ((R & ~31) + perm32(R & 31)) : R; voffA[i] = GATHER ? (unsigned)(R * 4) : (unsigned)(R * lda + C) * 2u; voffB[i] = (unsigned)(Rb * ldb + C) * 2u; cbA[i] = (unsigned)C * 2u; }
    LAS unsigned char* tokl = lds + LDS_TOK;
    unsigned gc[2][2], gn[2][2];
    const unsigned rowb = (unsigned)lda * 2u;
    const size_t kstep = (size_t)(BK * 2);
    const size_t hstepA = (size_t)HALF * lda * 2, hstepB = (size_t)HALF * ldb * 2;
    const unsigned ldsw = (unsigned)wid * 1024u;
    const int aoff = lds_byte(wr * 64 + fr, fq * 8), boff = lds_byte(wc * 32 + fr, fq * 8);
#define PG8_SA(b, h) (((b) * 2 + (h)) * HTB)
#define PG8_SB(b, h) ((4 + (b) * 2 + (h)) * HTB)
#define PG8_STAGE(bufoff, gbase, voff) do { _Pragma("unroll") for (int _i = 0; _i < 2; ++_i) \
        __builtin_amdgcn_global_load_lds((const unsigned*)((const char*)(gbase) + (voff)[_i]), (LAS unsigned*)(lds + (bufoff) + ldsw + _i * 8192), 16, 0, 0); } while (0)
#define PG8_STAGE_A(bufoff, ptr, h, goffs, koff) do { if constexpr (GATHER) { _Pragma("unroll") for (int _i = 0; _i < 2; ++_i) \
        __builtin_amdgcn_global_load_lds((const unsigned*)(S.abase + (size_t)(koff) + (goffs)[h][_i]), (LAS unsigned*)(lds + (bufoff) + ldsw + _i * 8192), 16, 0, 0); } \
        else PG8_STAGE(bufoff, ptr, voffA); } while (0)
#define PG8_LDA(dst, b, h) do { _Pragma("unroll") for (int m = 0; m < 4; ++m) _Pragma("unroll") for (int k = 0; k < 2; ++k) dst[m][k] = *(const LAS bf16x8*)(lds + PG8_SA(b, h) + aoff + m * 2048 + k * 1024); } while (0)
#define PG8_LDB(dst, b, h) do { _Pragma("unroll") for (int n = 0; n < 2; ++n) _Pragma("unroll") for (int k = 0; k < 2; ++k) dst[n][k] = *(const LAS bf16x8*)(lds + PG8_SB(b, h) + boff + n * 2048 + k * 1024); } while (0)
#define PG8_MMA(ai, bj, At, Bt) do { __builtin_amdgcn_s_setprio(1); _Pragma("unroll") for (int m = 0; m < 4; ++m) _Pragma("unroll") for (int n = 0; n < 2; ++n) { \
        if constexpr (F8) asm volatile("v_mfma_scale_f32_16x16x128_f8f6f4 %0, %1, %2, %0, %3, %4 op_sel_hi:[0,0,0]" : "+v"(acc[ai][bj][m][n]) : "v"(cat8(Bt[n][0], Bt[n][1])), "v"(cat8(At[m][0], At[m][1])), "v"(scw), "v"(sca)); \
        else { _Pragma("unroll") for (int k = 0; k < 2; ++k) acc[ai][bj][m][n] = __builtin_amdgcn_mfma_f32_16x16x32_bf16(Bt[n][k], At[m][k], acc[ai][bj][m][n], 0, 0, 0); } } \
        __builtin_amdgcn_s_setprio(0); } while (0)
#define PG8_WAIT_V(n) asm volatile("s_waitcnt vmcnt(" #n ")" ::: "memory")
#define PG8_WAIT_L(n) asm volatile("s_waitcnt lgkmcnt(" #n ")" ::: "memory")
#define PG8_BAR __builtin_amdgcn_s_barrier()
#define PG8_SCHED __builtin_amdgcn_sched_barrier(0)
    Unit cur, nxt; int ui = 0;
    if (!S.next(0, cur)) return;
    f32x4 acc[2][2][4][2];
#pragma unroll
    for (int a = 0; a < 2; ++a)
#pragma unroll
        for (int b = 0; b < 2; ++b)
#pragma unroll
            for (int m = 0; m < 4; ++m)
#pragma unroll
                for (int n = 0; n < 2; ++n) acc[a][b][m][n] = (f32x4){0.f, 0.f, 0.f, 0.f};
    bf16x8 At[4][2], B0[2][2], B1[2][2];
    const char* cA = cur.a; const char* cB = cur.b;
    if constexpr (GATHER) {
        if (tid < 256) *(LAS unsigned*)(tokl + tid * 4) = (unsigned)S.tok[cur.row0 + tid];
        __syncthreads();
#pragma unroll
        for (int h = 0; h < 2; ++h)
#pragma unroll
            for (int i = 0; i < 2; ++i) { gc[h][i] = *(const LAS unsigned*)(tokl + h * 512 + voffA[i]) * rowb + cbA[i]; gn[h][i] = gc[h][i]; }
        __syncthreads();
    }
    PG8_STAGE(PG8_SB(0, 0), cB, voffB); PG8_STAGE_A(PG8_SA(0, 0), cA, 0, gc, 0); PG8_STAGE(PG8_SB(0, 1), cB + hstepB, voffB); PG8_STAGE_A(PG8_SA(0, 1), cA + hstepA, 1, gc, 0);
    if (wr == 1) PG8_BAR;
    PG8_WAIT_V(4); PG8_BAR;
    PG8_STAGE(PG8_SB(1, 0), cB + kstep, voffB); PG8_STAGE_A(PG8_SA(1, 0), cA + kstep, 0, gc, kstep); PG8_STAGE(PG8_SB(1, 1), cB + hstepB + kstep, voffB);
    PG8_WAIT_V(6); PG8_BAR;
    for (;;) {
        const bool has_next = S.next(ui + 1, nxt);
        const char* nA = has_next ? nxt.a : cA; const char* nB = has_next ? nxt.b : cB;
        if constexpr (GATHER) {
            if (has_next && wid < 4) __builtin_amdgcn_global_load_lds((const unsigned*)(S.tok + nxt.row0 + tid), (LAS unsigned*)(tokl + wid * 256), 4, 0, 0);
        }
#pragma unroll 1
        for (int t = 0; t < nt; t += 2) {
            const bool last = (t == nt - 2);
            const char* a1 = cA + (size_t)(t + 1) * kstep;
            const char* a2 = last ? nA : cA + (size_t)(t + 2) * kstep; const char* b2 = last ? nB : cB + (size_t)(t + 2) * kstep;
            const char* a3 = a2 + kstep; const char* b3 = b2 + kstep;
            const size_t k1 = (size_t)(t + 1) * kstep, k2 = last ? (size_t)0 : (size_t)(t + 2) * kstep;
            unsigned o2[2][2];
            if constexpr (GATHER) {
                if (last && has_next) {
#pragma unroll
                    for (int h = 0; h < 2; ++h)
#pragma unroll
                        for (int i = 0; i < 2; ++i) gn[h][i] = *(const LAS unsigned*)(tokl + h * 512 + voffA[i]) * rowb + cbA[i];
                }
#pragma unroll
                for (int h = 0; h < 2; ++h)
#pragma unroll
                    for (int i = 0; i < 2; ++i) o2[h][i] = last ? gn[h][i] : gc[h][i];
            }
            PG8_LDB(B0, 0, 0); PG8_SCHED; PG8_LDA(At, 0, 0); PG8_STAGE_A(PG8_SA(1, 1), a1 + hstepA, 1, gc, k1);
            PG8_WAIT_L(8); PG8_BAR; PG8_WAIT_L(0); PG8_MMA(0, 0, At, B0); PG8_BAR; PG8_SCHED;
            PG8_LDB(B1, 0, 1); PG8_STAGE(PG8_SB(0, 0), b2, voffB);
            PG8_BAR; PG8_WAIT_L(0); PG8_MMA(0, 1, At, B1); PG8_BAR;
            PG8_LDA(At, 0, 1); PG8_STAGE_A(PG8_SA(0, 0), a2, 0, o2, k2);
            PG8_BAR; PG8_WAIT_L(0); PG8_MMA(1, 0, At, B0); PG8_BAR; PG8_SCHED;
            PG8_STAGE(PG8_SB(0, 1), b2 + hstepB, voffB);
            PG8_WAIT_V(6); PG8_BAR; PG8_MMA(1, 1, At, B1); PG8_BAR;
            PG8_LDB(B0, 1, 0); PG8_SCHED; PG8_LDA(At, 1, 0); PG8_STAGE_A(PG8_SA(0, 1), a2 + hstepA, 1, o2, k2);
            PG8_WAIT_L(8); PG8_BAR; PG8_WAIT_L(0); PG8_MMA(0, 0, At, B0); PG8_BAR; PG8_SCHED;
            PG8_LDB(B1, 1, 1); PG8_STAGE(PG8_SB(1, 0), b3, voffB);
            PG8_BAR; PG8_WAIT_L(0); PG8_MMA(0, 1, At, B1); PG8_BAR;
            PG8_LDA(At, 1, 1); PG8_STAGE_A(PG8_SA(1, 0), a3, 0, o2, k2 + kstep);
            PG8_BAR; PG8_WAIT_L(0); PG8_MMA(1, 0, At, B0); PG8_BAR; PG8_SCHED;
            PG8_STAGE(PG8_SB(1, 1), b3 + hstepB, voffB);
            PG8_WAIT_V(6); PG8_BAR; PG8_MMA(1, 1, At, B1); PG8_BAR;
        }
        if constexpr (F8) {
            asm volatile("s_nop 15\n\ts_nop 7" ::: "memory");
#pragma unroll
            for (int a = 0; a < 2; ++a)
#pragma unroll
                for (int b = 0; b < 2; ++b)
#pragma unroll
                    for (int m = 0; m < 4; ++m)
#pragma unroll
                        for (int n = 0; n < 2; ++n) asm volatile("" : "+v"(acc[a][b][m][n]));
        }
#pragma unroll
        for (int ai = 0; ai < 2; ++ai)
#pragma unroll
            for (int m = 0; m < 4; ++m)
#pragma unroll
                for (int bj = 0; bj < 2; ++bj) {
                    if constexpr (PERM) E(cur.row0 + ai * HALF + wr * 64 + m * 16 + fr, cur.col0 + bj * HALF + wc * 32 + 8 * fq, acc[ai][bj][m][0], acc[ai][bj][m][1]);
                    else {
#pragma unroll
                        for (int n = 0; n < 2; ++n) E(cur.row0 + ai * HALF + wr * 64 + m * 16 + fr, cur.col0 + bj * HALF + wc * 32 + n * 16 + 4 * fq, acc[ai][bj][m][n]);
                    }
                }
        if (!has_next) break;
#pragma unroll
        for (int a = 0; a < 2; ++a)
#pragma unroll
            for (int b = 0; b < 2; ++b)
#pragma unroll
                for (int m = 0; m < 4; ++m)
#pragma unroll
                    for (int n = 0; n < 2; ++n) acc[a][b][m][n] = (f32x4){0.f, 0.f, 0.f, 0.f};
        cur = nxt; cA = nA; cB = nB; ++ui;
        if constexpr (GATHER) {
#pragma unroll
            for (int h = 0; h < 2; ++h)
#pragma unroll
                for (int i = 0; i < 2; ++i) gc[h][i] = gn[h][i];
        }
    }
    PG8_WAIT_V(0);
    if (wr == 0) PG8_BAR;
    PG8_BAR;
#undef PG8_SA
#undef PG8_SB
#undef PG8_STAGE
#undef PG8_STAGE_A
#undef PG8_LDA
#undef PG8_LDB
#undef PG8_MMA
#undef PG8_WAIT_V
#undef PG8_WAIT_L
#undef PG8_BAR
#undef PG8_SCHED
}
__device__ __forceinline__ long unit_index(int i) {
    const int G = gridDim.x, c = blockIdx.x;
    if (G == 256) return ((long)i * 8 + (c & 7)) * 32 + (c >> 3);
    return (long)i * G + c;
}
}

__device__ __forceinline__ const bf16_t* wsm(const Params& p, int j, size_t off) { return (const bf16_t*)(p.ws + OFF_WSM) + (size_t)j * WJ_SIZE + off; }

__device__ __forceinline__ void phase_mix(const Params& p, int j) {
    const bf16_t* H = (const bf16_t*)(p.ws + OFF_H);
    const float* mix = p.in[8] + (size_t)j * 6 * D;
    bf16_t* XM = (bf16_t*)(p.ws + OFF_LW);
    const int tid_ = tidx(), lane = tid_ & 63, wid = tid_ >> 6;
    for (int cc = 0; cc < 2; ++cc) {
        const int k = cc * 512 + lane * 8;
        float m[3][8];
#pragma unroll
        for (int w = 0; w < 3; ++w) {
            const int mi = w == 0 ? 0 : (w == 1 ? 2 : 3);
            const float4 m0 = *(const float4*)(mix + mi * D + k), m1 = *(const float4*)(mix + mi * D + k + 4);
            m[w][0] = m0.x; m[w][1] = m0.y; m[w][2] = m0.z; m[w][3] = m0.w; m[w][4] = m1.x; m[w][5] = m1.y; m[w][6] = m1.z; m[w][7] = m1.w;
        }
        const int q = k >> 8;
        for (int grp = blockIdx.x * 8 + wid; grp < NT / 4; grp += gridDim.x * 8) {
            u32x4 h[4], s[4];
#pragma unroll
            for (int r = 0; r < 4; ++r) {
                const int row = grp * 4 + r;
                int nb;
                if (row < NLAT) {
                    const int t = row & (TL - 1), gc = t & 63, gr = t >> 6;
                    if (q == 0) nb = gc > 0 ? row - 1 : -1;
                    else if (q == 1) nb = gc < 63 ? row + 1 : -1;
                    else if (q == 2) nb = gr > 0 ? row - 64 : -1;
                    else nb = gr < 63 ? row + 64 : -1;
                } else {
                    const int t = (row - NLAT) & (TC - 1);
                    if (k < 512) nb = t > 0 ? row - 1 : -1;
                    else nb = t < TC - 1 ? row + 1 : -1;
                }
                h[r] = *(const u32x4*)(H + (size_t)row * D + k);
                s[r] = (u32x4){0u, 0u, 0u, 0u};
                if (nb >= 0) s[r] = *(const u32x4*)(H + (size_t)nb * D + k);
            }
#pragma unroll
            for (int r = 0; r < 4; ++r) {
                const int row = grp * 4 + r;
#pragma unroll
                for (int w = 0; w < 3; ++w) {
                    u32x4 o;
#pragma unroll
                    for (int e = 0; e < 4; ++e) {
                        const float x = bflo(h[r][e]), y = bfhi(h[r][e]);
                        o[e] = pack2(x + (bflo(s[r][e]) - x) * m[w][2 * e], y + (bfhi(s[r][e]) - y) * m[w][2 * e + 1]);
                    }
                    *(u32x4*)(XM + (size_t)w * NT * D + (size_t)row * D + k) = o;
                }
            }
        }
    }
}

struct SchedGrid {
    const char* A; const char* B; size_t a_mat, b_mat, a_rt, a_ct, b_ct; int cpm, total;
    __device__ __forceinline__ bool next(int i, g256::Unit& u) const {
        const long L = g256::unit_index(i);
        if (L >= total) return false;
        const int chunk = (int)(L >> 5), o = (int)(L & 31), mat = chunk / cpm, ch = chunk % cpm, rt = ch * 8 + (o >> 2), ct = o & 3;
        u.a = A + (size_t)mat * a_mat + (size_t)rt * a_rt + (size_t)ct * a_ct; u.b = B + (size_t)mat * b_mat + (size_t)ct * b_ct;
        u.row0 = rt * 256; u.col0 = mat * 1024 + ct * 256;
        return true;
    }
};
struct EpRKV {
    bf16_t* R; long vdelta;
    __device__ __forceinline__ void operator()(int row, int col, f32x4 v) const {
        const int mat = col >> 10, c = col & 1023;
        bf16_t* O = R + (size_t)mat * NT * D + (mat == 2 ? vdelta : 0l);
        u32x2 o; o[0] = pack2(v[0], v[1]); o[1] = pack2(v[2], v[3]);
        *(u32x2*)(O + (size_t)row * D + c) = o;
    }
    __device__ __forceinline__ void operator()(int row, int col, f32x4 v, f32x4 w) const {
        const int mat = col >> 10, c = col & 1023;
        bf16_t* O = R + (size_t)mat * NT * D + (mat == 2 ? vdelta : 0l);
        const u32x4 o = {pack2(v[0], v[1]), pack2(v[2], v[3]), pack2(w[0], w[1]), pack2(w[2], w[3])};
        *(u32x4*)(O + (size_t)row * D + c) = o;
    }
};

__device__ __forceinline__ void phase_rwkv_proj(const Params& p, int j, char* lds) {
    const bf16_t* H = (const bf16_t*)(p.ws + OFF_H);
    const float* mix = p.in[8] + (size_t)j * 6 * D;
    bf16_t* R = (bf16_t*)(p.ws + OFF_R);
    bf16_t* V = (bf16_t*)(p.ws + (j == 0 ? OFF_VF : OFF_Y));
    bf16_t* LD = (bf16_t*)(p.ws + OFF_LD);
    const bf16_t* XM = (const bf16_t*)(p.ws + OFF_LW);
    {
        SchedGrid S{(const char*)XM, (const char*)wsm(p, j, WJ_RKV), (size_t)NT * D * 2, (size_t)D * D * 2, (size_t)256 * D * 2, 0, (size_t)256 * D * 2, NT / 256 / 8, 3 * (NT / 256) * 4};
        EpRKV E{R, (long)(V - (R + (size_t)2 * NT * D))};
        g256::gemm_phase<true>((LAS unsigned char*)lds, D, D, D, S, E);
    }
    constexpr int RT = NT / 128;
    const int nsmall = (j == 0 ? 3 : 4) * RT;
    for (int u = blockIdx.x; u < nsmall; u += gridDim.x) {
        const int which = u / RT, rt = u % RT;
        EpStoreBf16 ep{LD + (size_t)which * NT * 128, 128, which == 0 ? 1 : (which == 2 ? 2 : 0)};
        if (which < 3) {
            const int mi = which == 0 ? 1 : (which == 1 ? 4 : 5);
            MixLoader al{H, mix + mi * D};
            const bf16_t* Bt = which == 0 ? wsm(p, j, WJ_W1) : which == 1 ? wsm(p, j, WJ_A1) : wsm(p, j, WJ_G1);
            gemm_tile_small2(lds, al, Bt, D, D, rt * 128, 0, ep);
        } else {
            PlainLoader al{XM + (size_t)2 * NT * D, D};
            gemm_tile_small2(lds, al, (const bf16_t*)(p.ws + OFF_WSM) + W_V1, D, D, rt * 128, 0, ep);
        }
    }
}

template <int KS, int MODE>
__device__ __forceinline__ void gemm_bstat(const bf16_t* __restrict__ A, int lda, const bf16_t* __restrict__ Bt, int ldb, int col0, int rt0, int rt1,
                                           bf16_t* O, const float* bias, const bf16_t* VRAW) {
    const int tid = tidx(), lane = tid & 63, wid = tid >> 6, wr = wid >> 2, wc = wid & 3, fr = lane & 15, fq = lane >> 4;
    bf16x8 bfr[4][KS];
#pragma unroll
    for (int n = 0; n < 4; ++n) {
        const int colb = col0 + wc * 64 + (n >> 1) * 32 + 8 * (fr >> 2) + 4 * (n & 1) + (fr & 3);
#pragma unroll
        for (int ks = 0; ks < KS; ++ks) bfr[n][ks] = *(const bf16x8*)(Bt + (size_t)colb * ldb + ks * 32 + fq * 8);
    }
    float bs[2][8];
#pragma unroll
    for (int pp = 0; pp < 2; ++pp)
#pragma unroll
        for (int e = 0; e < 8; ++e) bs[pp][e] = MODE == 2 ? 0.f : bias[col0 + wc * 64 + pp * 32 + 8 * fq + e] * ((MODE == 0 || MODE == 1) ? -1.44269504089f : 1.f);
    bf16x8 afr[4][KS];
#pragma unroll
    for (int m = 0; m < 4; ++m)
#pragma unroll
        for (int ks = 0; ks < KS; ++ks) afr[m][ks] = *(const bf16x8*)(A + (size_t)(rt0 * 128 + wr * 64 + m * 16 + fr) * lda + ks * 32 + fq * 8);
    for (int rt = rt0; rt < rt1; ++rt) {
        f32x4 acc[4][4];
#pragma unroll
        for (int m = 0; m < 4; ++m)
#pragma unroll
            for (int n = 0; n < 4; ++n) {
                acc[m][n] = (f32x4){0.f, 0.f, 0.f, 0.f};
#pragma unroll
                for (int ks = 0; ks < KS; ++ks) acc[m][n] = __builtin_amdgcn_mfma_f32_16x16x32_bf16(bfr[n][ks], afr[m][ks], acc[m][n], 0, 0, 0);
            }
        if (rt + 1 < rt1) {
#pragma unroll
            for (int m = 0; m < 4; ++m)
#pragma unroll
                for (int ks = 0; ks < KS; ++ks) afr[m][ks] = *(const bf16x8*)(A + (size_t)((rt + 1) * 128 + wr * 64 + m * 16 + fr) * lda + ks * 32 + fq * 8);
        }
#pragma unroll
        for (int m = 0; m < 4; ++m)
#pragma unroll
            for (int pp = 0; pp < 2; ++pp) {
                const size_t o = (size_t)(rt * 128 + wr * 64 + m * 16 + fr) * D + col0 + wc * 64 + pp * 32 + 8 * fq;
                float v[8];
#pragma unroll
                for (int e = 0; e < 4; ++e) { v[e] = acc[m][2 * pp][e]; v[4 + e] = acc[m][2 * pp + 1][e]; }
                if (MODE == 0 || MODE == 1) {
#pragma unroll
                    for (int e = 0; e < 8; e += 2) {
                        const f32x2_t x = {v[e], v[e + 1]}, bb = {bs[pp][e], bs[pp][e + 1]};
                        const f32x2_t t = x * -1.44269504089f + bb;
                        f32x2_t ex; ex.x = __builtin_amdgcn_exp2f(t.x); ex.y = __builtin_amdgcn_exp2f(t.y);
                        const f32x2_t dn = ex + 1.0f;
                        f32x2_t r; r.x = __builtin_amdgcn_rcpf(dn.x); r.y = __builtin_amdgcn_rcpf(dn.y);
                        if (MODE == 0) r = r * -0.6065306597f;
                        v[e] = r.x; v[e + 1] = r.y;
                    }
                } else if (MODE == 3) {
                    const u32x4 vr = *(const u32x4*)(VRAW + o), vf = *(const u32x4*)(O + o);
#pragma unroll
                    for (int e = 0; e < 8; ++e) {
                        const float x = (e & 1) ? bfhi(vr[e >> 1]) : bflo(vr[e >> 1]), f = (e & 1) ? bfhi(vf[e >> 1]) : bflo(vf[e >> 1]);
                        v[e] = x + (f - x) * sigmoidf_(v[e] + bs[pp][e]);
                    }
                }
                const u32x4 w = {pack2(v[0], v[1]), pack2(v[2], v[3]), pack2(v[4], v[5]), pack2(v[6], v[7])};
                *(u32x4*)(O + o) = w;
            }
    }
}
__device__ __forceinline__ void phase_rwkv_up(const Params& p, int j, char* lds) {
    bf16_t* LD = (bf16_t*)(p.ws + OFF_LD);
    bf16_t* LW = (bf16_t*)(p.ws + OFF_LW); bf16_t* AD = (bf16_t*)(p.ws + OFF_AD); bf16_t* G = (bf16_t*)(p.ws + OFF_G);
    constexpr int RT = NT / 128, NRC = 32, RPC = RT / NRC;
    const int ntot = j == 0 ? 0 : 4 * NRC;
    for (int u = blockIdx.x; u < ntot; u += gridDim.x) {
        const int which = 5, r = u % (4 * NRC), ct = r / NRC, rc = r % NRC;
        const int rt0 = rc * RPC, rt1 = rt0 + RPC, col0 = ct * 256;
        if (which < 2) {
            const int d = which;
            gemm_bstat<2, 0>(LD + d * 64, 128, wsm(p, j, WJ_W2) + (size_t)d * D * 64, 64, col0, rt0, rt1, LW + (size_t)d * NT * D, p.in[10] + ((size_t)j * 2 + d) * D, nullptr);
        } else if (which < 4) {
            const int d = which - 2;
            gemm_bstat<2, 1>(LD + (size_t)NT * 128 + d * 64, 128, wsm(p, j, WJ_A2) + (size_t)d * D * 64, 64, col0, rt0, rt1, AD + (size_t)d * NT * D, p.in[13] + ((size_t)j * 2 + d) * D, nullptr);
        } else if (which == 4) {
            gemm_bstat<4, 2>(LD + (size_t)2 * NT * 128, 128, wsm(p, j, WJ_G2), 128, col0, rt0, rt1, G, nullptr, nullptr);
        } else {
            gemm_bstat<2, 3>(LD + (size_t)3 * NT * 128, 128, (const bf16_t*)(p.ws + OFF_WSM) + W_V2, 64, col0, rt0, rt1, (bf16_t*)(p.ws + OFF_VF), p.in[16], (const bf16_t*)(p.ws + OFF_Y));
        }
    }
}

__device__ __forceinline__ void phase_rwkv_up2(const Params& p, int j, char* lds) {
    const bf16_t* R = (const bf16_t*)(p.ws + OFF_R); const bf16_t* Kb = (const bf16_t*)(p.ws + OFF_K);
    bf16_t* KK = (bf16_t*)(p.ws + OFF_H); float* BON = (float*)(p.ws + OFF_BON);
    const float* k_k = p.in[21] + (size_t)j * D; const float* k_a = p.in[22] + (size_t)j * D; const float* r_k = p.in[23] + (size_t)j * D;
    float* cst = (float*)lds;
    constexpr int TR = 32, MT = 1, RT = NT / TR, NRC = 64, RPC = RT / NRC, KS = 2;
    const int tid = tidx(), lane = tid & 63, wid = tid >> 6, wr = wid >> 2, wc = wid & 3, fr = lane & 15, fq = lane >> 4;
    const bf16_t* A = (const bf16_t*)(p.ws + OFF_LD) + (size_t)NT * 128;
    bf16_t* AD = (bf16_t*)(p.ws + OFF_AD);
    for (int u = blockIdx.x; u < 4 * NRC; u += gridDim.x) {
        const int ct = u / NRC, rc = u % NRC, rt0 = rc * RPC, rt1 = rt0 + RPC, col0 = ct * 256, head = ct * 4 + wc;
        __syncthreads();
        if (tid < 256) {
            const float kk_ = k_k[col0 + tid], ka_ = k_a[col0 + tid], rk_ = r_k[col0 + tid];
            cst[tid] = kk_; cst[256 + tid] = rk_ * (1.f - ka_); cst[512 + tid] = 0.5f * rk_ * ka_;
            cst[768 + tid] = p.in[13][((size_t)j * 2 + 0) * D + col0 + tid] * -1.44269504089f; cst[1024 + tid] = p.in[13][((size_t)j * 2 + 1) * D + col0 + tid] * -1.44269504089f;
        }
        __syncthreads();
        bf16x8 bfr[2][4][KS];
#pragma unroll
        for (int d = 0; d < 2; ++d)
#pragma unroll
            for (int n = 0; n < 4; ++n) {
                const int colb = col0 + wc * 64 + (n >> 1) * 32 + 8 * (fr >> 2) + 4 * (n & 1) + (fr & 3);
#pragma unroll
                for (int ks = 0; ks < KS; ++ks) bfr[d][n][ks] = *(const bf16x8*)(wsm(p, j, WJ_A2) + (size_t)d * D * 64 + (size_t)colb * 64 + ks * 32 + fq * 8);
            }
        bf16x8 afr[MT][2][KS];
#pragma unroll
        for (int m = 0; m < MT; ++m)
#pragma unroll
            for (int d = 0; d < 2; ++d)
#pragma unroll
                for (int ks = 0; ks < KS; ++ks) afr[m][d][ks] = *(const bf16x8*)(A + (size_t)(rt0 * TR + wr * (16 * MT) + m * 16 + fr) * 128 + d * 64 + ks * 32 + fq * 8);
#pragma unroll 1
        for (int rt = rt0; rt < rt1; ++rt) {
#pragma unroll
            for (int m = 0; m < MT; ++m) {
                const int row = rt * TR + wr * (16 * MT) + m * 16 + fr;
                const size_t o = (size_t)row * D + col0 + wc * 64 + 8 * fq;
                u32x4 kv[2], rv[2];
#pragma unroll
                for (int pp = 0; pp < 2; ++pp) { kv[pp] = *(const u32x4*)(Kb + o + pp * 32); rv[pp] = *(const u32x4*)(R + o + pp * 32); }
                float asum[16];
#pragma unroll
                for (int d = 0; d < 2; ++d) {
                    f32x4 acc[4];
#pragma unroll
                    for (int n = 0; n < 4; ++n) {
                        acc[n] = (f32x4){0.f, 0.f, 0.f, 0.f};
#pragma unroll
                        for (int ks = 0; ks < KS; ++ks) acc[n] = __builtin_amdgcn_mfma_f32_16x16x32_bf16(bfr[d][n][ks], afr[m][d][ks], acc[n], 0, 0, 0);
                    }
#pragma unroll
                    for (int pp = 0; pp < 2; ++pp) {
                        const float* bp = cst + 768 + d * 256 + wc * 64 + pp * 32 + 8 * fq;
                        const float4 b0 = *(const float4*)bp, b1 = *(const float4*)(bp + 4);
                        const float bs[8] = {b0.x, b0.y, b0.z, b0.w, b1.x, b1.y, b1.z, b1.w};
                        float av[8];
#pragma unroll
                        for (int e = 0; e < 8; e += 2) {
                            const f32x2_t x = {acc[2 * pp + (e >> 2)][e & 3], acc[2 * pp + (e >> 2)][(e & 3) + 1]}, bb = {bs[e], bs[e + 1]};
                            const f32x2_t t = x * -1.44269504089f + bb;
                            f32x2_t ex; ex.x = __builtin_amdgcn_exp2f(t.x); ex.y = __builtin_amdgcn_exp2f(t.y);
                            const f32x2_t dn = ex + 1.0f;
                            av[e] = __builtin_amdgcn_rcpf(dn.x); av[e + 1] = __builtin_amdgcn_rcpf(dn.y);
                        }
                        const u32x4 w = {pack2(av[0], av[1]), pack2(av[2], av[3]), pack2(av[4], av[5]), pack2(av[6], av[7])};
                        *(u32x4*)(AD + (size_t)d * NT * D + o + pp * 32) = w;
#pragma unroll
                        for (int e = 0; e < 8; ++e) { const float ab = bf2f(f2bf(av[e])); asum[pp * 8 + e] = d == 0 ? ab : asum[pp * 8 + e] + ab; }
                    }
                }
                if (rt + 1 < rt1) {
#pragma unroll
                    for (int d = 0; d < 2; ++d)
#pragma unroll
                        for (int ks = 0; ks < KS; ++ks) afr[m][d][ks] = *(const bf16x8*)(A + (size_t)((rt + 1) * TR + wr * (16 * MT) + m * 16 + fr) * 128 + d * 64 + ks * 32 + fq * 8);
                }
                float kk[16]; float n2 = 0.f, bon = 0.f;
#pragma unroll
                for (int pp = 0; pp < 2; ++pp) {
                    const float* cp = cst + wc * 64 + pp * 32 + 8 * fq;
                    const float4 q0 = *(const float4*)cp, q1 = *(const float4*)(cp + 4), c10 = *(const float4*)(cp + 256), c11 = *(const float4*)(cp + 260), c20 = *(const float4*)(cp + 512), c21 = *(const float4*)(cp + 516);
                    const float kkw[8] = {q0.x, q0.y, q0.z, q0.w, q1.x, q1.y, q1.z, q1.w}, c1[8] = {c10.x, c10.y, c10.z, c10.w, c11.x, c11.y, c11.z, c11.w}, c2[8] = {c20.x, c20.y, c20.z, c20.w, c21.x, c21.y, c21.z, c21.w};
#pragma unroll
                    for (int e = 0; e < 8; ++e) {
                        const unsigned kw = kv[pp][e >> 1], rw = rv[pp][e >> 1];
                        const float k = (e & 1) ? bfhi(kw) : bflo(kw), rr = (e & 1) ? bfhi(rw) : bflo(rw);
                        kk[pp * 8 + e] = k * kkw[e]; n2 += kk[pp * 8 + e] * kk[pp * 8 + e];
                        bon += rr * k * (c1[e] + c2[e] * asum[pp * 8 + e]);
                    }
                }
                bon = red4(bon); n2 = red4(n2);
                if (fq == 0) BON[(size_t)row * 16 + head] = bon;
                const float inv = 1.f / fmaxf(sqrtf(n2), 1e-12f);
#pragma unroll
                for (int pp = 0; pp < 2; ++pp) {
                    const u32x4 w = {pack2(kk[pp * 8 + 0] * inv, kk[pp * 8 + 1] * inv), pack2(kk[pp * 8 + 2] * inv, kk[pp * 8 + 3] * inv), pack2(kk[pp * 8 + 4] * inv, kk[pp * 8 + 5] * inv), pack2(kk[pp * 8 + 6] * inv, kk[pp * 8 + 7] * inv)};
                    *(u32x4*)(KK + o + pp * 32) = w;
                }
            }
        }
    }
}

__device__ __forceinline__ void phase_rwkv_prep(const Params& p, int j) {
    const bf16_t* R = (const bf16_t*)(p.ws + OFF_R); const bf16_t* Kb = (const bf16_t*)(p.ws + OFF_K);
    const bf16_t* AD = (const bf16_t*)(p.ws + OFF_AD);
    bf16_t* KK = (bf16_t*)(p.ws + OFF_H); float* BON = (float*)(p.ws + OFF_BON);
    const float* k_k = p.in[21] + (size_t)j * D; const float* k_a = p.in[22] + (size_t)j * D; const float* r_k = p.in[23] + (size_t)j * D;
    const int tid_ = tidx(), lane = tid_ & 63, wid = tid_ >> 6, c0 = lane * 16;
    float kkw[16], kaw[16], rkw[16];
#pragma unroll
    for (int i = 0; i < 16; ++i) { kkw[i] = k_k[c0 + i]; kaw[i] = k_a[c0 + i]; rkw[i] = r_k[c0 + i]; }
    constexpr int RW = 2;
    for (int grp = blockIdx.x * 8 + wid; grp < NT / RW; grp += gridDim.x * 8) {
        u32x4 kv[RW][2], rv[RW][2], a0[RW][2], a1[RW][2];
#pragma unroll
        for (int r = 0; r < RW; ++r) {
            const size_t o = (size_t)(grp * RW + r) * D + c0;
#pragma unroll
            for (int i = 0; i < 2; ++i) {
                kv[r][i] = *(const u32x4*)(Kb + o + i * 8); rv[r][i] = *(const u32x4*)(R + o + i * 8);
                a0[r][i] = *(const u32x4*)(AD + o + i * 8); a1[r][i] = *(const u32x4*)(AD + (size_t)NT * D + o + i * 8);
            }
        }
#pragma unroll
        for (int r = 0; r < RW; ++r) {
            const int row = grp * RW + r;
            const size_t o = (size_t)row * D + c0;
            float kk[16]; float n2 = 0.f, bon = 0.f;
#pragma unroll
            for (int i = 0; i < 16; ++i) {
                const unsigned kw = kv[r][i >> 3][(i >> 1) & 3], rw = rv[r][i >> 3][(i >> 1) & 3], aw0 = a0[r][i >> 3][(i >> 1) & 3], aw1 = a1[r][i >> 3][(i >> 1) & 3];
                const float k = (i & 1) ? bfhi(kw) : bflo(kw), rr = (i & 1) ? bfhi(rw) : bflo(rw);
                const float am = 0.5f * (((i & 1) ? bfhi(aw0) : bflo(aw0)) + ((i & 1) ? bfhi(aw1) : bflo(aw1)));
                kk[i] = k * kkw[i]; n2 += kk[i] * kk[i];
                bon += rr * (k * (1.f + (am - 1.f) * kaw[i])) * rkw[i];
            }
            n2 += __shfl_xor(n2, 1, 64); n2 += __shfl_xor(n2, 2, 64);
            bon += __shfl_xor(bon, 1, 64); bon += __shfl_xor(bon, 2, 64);
            const float inv = 1.f / fmaxf(sqrtf(n2), 1e-12f);
            u32x4 ov[2];
#pragma unroll
            for (int i = 0; i < 8; ++i) ov[i >> 2][i & 3] = pack2(kk[2 * i] * inv, kk[2 * i + 1] * inv);
            *(u32x4*)(KK + o) = ov[0]; *(u32x4*)(KK + o + 8) = ov[1];
            if ((lane & 3) == 0) BON[(size_t)row * 16 + (lane >> 2)] = bon;
        }
    }
}

#define SCAN_STEP_ASM \
    "s_nop 1\n\t" \
    "v_mul_f32_dpp %0, %20, %0 row_newbcast:0 row_mask:0xf bank_mask:0xf\n\t" \
    "v_mul_f32_dpp %1, %20, %1 row_newbcast:1 row_mask:0xf bank_mask:0xf\n\t" \
    "v_mul_f32_dpp %2, %20, %2 row_newbcast:2 row_mask:0xf bank_mask:0xf\n\t" \
    "v_mul_f32_dpp %3, %20, %3 row_newbcast:3 row_mask:0xf bank_mask:0xf\n\t" \
    "v_mul_f32_dpp %4, %20, %4 row_newbcast:4 row_mask:0xf bank_mask:0xf\n\t" \
    "v_mul_f32_dpp %5, %20, %5 row_newbcast:5 row_mask:0xf bank_mask:0xf\n\t" \
    "v_mul_f32_dpp %6, %20, %6 row_newbcast:6 row_mask:0xf bank_mask:0xf\n\t" \
    "v_mul_f32_dpp %7, %20, %7 row_newbcast:7 row_mask:0xf bank_mask:0xf\n\t" \
    "v_mul_f32_dpp %8, %20, %8 row_newbcast:8 row_mask:0xf bank_mask:0xf\n\t" \
    "v_mul_f32_dpp %9, %20, %9 row_newbcast:9 row_mask:0xf bank_mask:0xf\n\t" \
    "v_mul_f32_dpp %10, %20, %10 row_newbcast:10 row_mask:0xf bank_mask:0xf\n\t" \
    "v_mul_f32_dpp %11, %20, %11 row_newbcast:11 row_mask:0xf bank_mask:0xf\n\t" \
    "v_mul_f32_dpp %12, %20, %12 row_newbcast:12 row_mask:0xf bank_mask:0xf\n\t" \
    "v_mul_f32_dpp %13, %20, %13 row_newbcast:13 row_mask:0xf bank_mask:0xf\n\t" \
    "v_mul_f32_dpp %14, %20, %14 row_newbcast:14 row_mask:0xf bank_mask:0xf\n\t" \
    "v_mul_f32_dpp %15, %20, %15 row_newbcast:15 row_mask:0xf bank_mask:0xf\n\t" \
    "v_fmac_f32_dpp %0, %21, %25 row_newbcast:0 row_mask:0xf bank_mask:0xf\n\t" \
    "v_fmac_f32_dpp %1, %21, %25 row_newbcast:1 row_mask:0xf bank_mask:0xf\n\t" \
    "v_fmac_f32_dpp %2, %21, %25 row_newbcast:2 row_mask:0xf bank_mask:0xf\n\t" \
    "v_fmac_f32_dpp %3, %21, %25 row_newbcast:3 row_mask:0xf bank_mask:0xf\n\t" \
    "v_fmac_f32_dpp %4, %21, %25 row_newbcast:4 row_mask:0xf bank_mask:0xf\n\t" \
    "v_fmac_f32_dpp %5, %21, %25 row_newbcast:5 row_mask:0xf bank_mask:0xf\n\t" \
    "v_fmac_f32_dpp %6, %21, %25 row_newbcast:6 row_mask:0xf bank_mask:0xf\n\t" \
    "v_fmac_f32_dpp %7, %21, %25 row_newbcast:7 row_mask:0xf bank_mask:0xf\n\t" \
    "v_fmac_f32_dpp %8, %21, %25 row_newbcast:8 row_mask:0xf bank_mask:0xf\n\t" \
    "v_fmac_f32_dpp %9, %21, %25 row_newbcast:9 row_mask:0xf bank_mask:0xf\n\t" \
    "v_fmac_f32_dpp %10, %21, %25 row_newbcast:10 row_mask:0xf bank_mask:0xf\n\t" \
    "v_fmac_f32_dpp %11, %21, %25 row_newbcast:11 row_mask:0xf bank_mask:0xf\n\t" \
    "v_fmac_f32_dpp %12, %21, %25 row_newbcast:12 row_mask:0xf bank_mask:0xf\n\t" \
    "v_fmac_f32_dpp %13, %21, %25 row_newbcast:13 row_mask:0xf bank_mask:0xf\n\t" \
    "v_fmac_f32_dpp %14, %21, %25 row_newbcast:14 row_mask:0xf bank_mask:0xf\n\t" \
    "v_fmac_f32_dpp %15, %21, %25 row_newbcast:15 row_mask:0xf bank_mask:0xf\n\t" \
    "v_fmac_f32_dpp %0, %22, %26 row_newbcast:0 row_mask:0xf bank_mask:0xf\n\t" \
    "v_fmac_f32_dpp %1, %22, %26 row_newbcast:1 row_mask:0xf bank_mask:0xf\n\t" \
    "v_fmac_f32_dpp %2, %22, %26 row_newbcast:2 row_mask:0xf bank_mask:0xf\n\t" \
    "v_fmac_f32_dpp %3, %22, %26 row_newbcast:3 row_mask:0xf bank_mask:0xf\n\t" \
    "v_fmac_f32_dpp %4, %22, %26 row_newbcast:4 row_mask:0xf bank_mask:0xf\n\t" \
    "v_fmac_f32_dpp %5, %22, %26 row_newbcast:5 row_mask:0xf bank_mask:0xf\n\t" \
    "v_fmac_f32_dpp %6, %22, %26 row_newbcast:6 row_mask:0xf bank_mask:0xf\n\t" \
    "v_fmac_f32_dpp %7, %22, %26 row_newbcast:7 row_mask:0xf bank_mask:0xf\n\t" \
    "v_fmac_f32_dpp %8, %22, %26 row_newbcast:8 row_mask:0xf bank_mask:0xf\n\t" \
    "v_fmac_f32_dpp %9, %22, %26 row_newbcast:9 row_mask:0xf bank_mask:0xf\n\t" \
    "v_fmac_f32_dpp %10, %22, %26 row_newbcast:10 row_mask:0xf bank_mask:0xf\n\t" \
    "v_fmac_f32_dpp %11, %22, %26 row_newbcast:11 row_mask:0xf bank_mask:0xf\n\t" \
    "v_fmac_f32_dpp %12, %22, %26 row_newbcast:12 row_mask:0xf bank_mask:0xf\n\t" \
    "v_fmac_f32_dpp %13, %22, %26 row_newbcast:13 row_mask:0xf bank_mask:0xf\n\t" \
    "v_fmac_f32_dpp %14, %22, %26 row_newbcast:14 row_mask:0xf bank_mask:0xf\n\t" \
    "v_fmac_f32_dpp %15, %22, %26 row_newbcast:15 row_mask:0xf bank_mask:0xf\n\t" \
    "v_mul_f32_dpp %16, %23, %0 row_newbcast:0 row_mask:0xf bank_mask:0xf\n\t" \
    "v_mul_f32_dpp %18, %24, %0 row_newbcast:0 row_mask:0xf bank_mask:0xf\n\t" \
    "v_mul_f32_dpp %17, %23, %1 row_newbcast:1 row_mask:0xf bank_mask:0xf\n\t" \
    "v_mul_f32_dpp %19, %24, %1 row_newbcast:1 row_mask:0xf bank_mask:0xf\n\t" \
    "v_fmac_f32_dpp %16, %23, %2 row_newbcast:2 row_mask:0xf bank_mask:0xf\n\t" \
    "v_fmac_f32_dpp %18, %24, %2 row_newbcast:2 row_mask:0xf bank_mask:0xf\n\t" \
    "v_fmac_f32_dpp %17, %23, %3 row_newbcast:3 row_mask:0xf bank_mask:0xf\n\t" \
    "v_fmac_f32_dpp %19, %24, %3 row_newbcast:3 row_mask:0xf bank_mask:0xf\n\t" \
    "v_fmac_f32_dpp %16, %23, %4 row_newbcast:4 row_mask:0xf bank_mask:0xf\n\t" \
    "v_fmac_f32_dpp %18, %24, %4 row_newbcast:4 row_mask:0xf bank_mask:0xf\n\t" \
    "v_fmac_f32_dpp %17, %23, %5 row_newbcast:5 row_mask:0xf bank_mask:0xf\n\t" \
    "v_fmac_f32_dpp %19, %24, %5 row_newbcast:5 row_mask:0xf bank_mask:0xf\n\t" \
    "v_fmac_f32_dpp %16, %23, %6 row_newbcast:6 row_mask:0xf bank_mask:0xf\n\t" \
    "v_fmac_f32_dpp %18, %24, %6 row_newbcast:6 row_mask:0xf bank_mask:0xf\n\t" \
    "v_fmac_f32_dpp %17, %23, %7 row_newbcast:7 row_mask:0xf bank_mask:0xf\n\t" \
    "v_fmac_f32_dpp %19, %24, %7 row_newbcast:7 row_mask:0xf bank_mask:0xf\n\t" \
    "v_fmac_f32_dpp %16, %23, %8 row_newbcast:8 row_mask:0xf bank_mask:0xf\n\t" \
    "v_fmac_f32_dpp %18, %24, %8 row_newbcast:8 row_mask:0xf bank_mask:0xf\n\t" \
    "v_fmac_f32_dpp %17, %23, %9 row_newbcast:9 row_mask:0xf bank_mask:0xf\n\t" \
    "v_fmac_f32_dpp %19, %24, %9 row_newbcast:9 row_mask:0xf bank_mask:0xf\n\t" \
    "v_fmac_f32_dpp %16, %23, %10 row_newbcast:10 row_mask:0xf bank_mask:0xf\n\t" \
    "v_fmac_f32_dpp %18, %24, %10 row_newbcast:10 row_mask:0xf bank_mask:0xf\n\t" \
    "v_fmac_f32_dpp %17, %23, %11 row_newbcast:11 row_mask:0xf bank_mask:0xf\n\t" \
    "v_fmac_f32_dpp %19, %24, %11 row_newbcast:11 row_mask:0xf bank_mask:0xf\n\t" \
    "v_fmac_f32_dpp %16, %23, %12 row_newbcast:12 row_mask:0xf bank_mask:0xf\n\t" \
    "v_fmac_f32_dpp %18, %24, %12 row_newbcast:12 row_mask:0xf bank_mask:0xf\n\t" \
    "v_fmac_f32_dpp %17, %23, %13 row_newbcast:13 row_mask:0xf bank_mask:0xf\n\t" \
    "v_fmac_f32_dpp %19, %24, %13 row_newbcast:13 row_mask:0xf bank_mask:0xf\n\t" \
    "v_fmac_f32_dpp %16, %23, %14 row_newbcast:14 row_mask:0xf bank_mask:0xf\n\t" \
    "v_fmac_f32_dpp %18, %24, %14 row_newbcast:14 row_mask:0xf bank_mask:0xf\n\t" \
    "v_fmac_f32_dpp %17, %23, %15 row_newbcast:15 row_mask:0xf bank_mask:0xf\n\t" \
    "v_fmac_f32_dpp %19, %24, %15 row_newbcast:15 row_mask:0xf bank_mask:0xf\n\t" \
    ""

__device__ __forceinline__ void phase_rwkv_scan(const Params& p, int j, char* lds) {
    const bf16_t* R = (const bf16_t*)(p.ws + OFF_R); const bf16_t* Kb = (const bf16_t*)(p.ws + OFF_K);
    const bf16_t* V = (const bf16_t*)(p.ws + OFF_VF); const bf16_t* KK = (const bf16_t*)(p.ws + OFF_H);
    const bf16_t* LW = (const bf16_t*)(p.ws + OFF_LW); const bf16_t* AD = (const bf16_t*)(p.ws + OFF_AD);
    bf16_t* Y = (bf16_t*)(p.ws + OFF_Y);
    const int tid = tidx(), lane = tid & 63, wid = tid >> 6, cl = wid >> 2, q = wid & 3;
    for (int cp = blockIdx.x; cp < 256; cp += gridDim.x) {
        const int chain = cp * 2 + cl, d = chain & 1, bh = chain >> 1, b = bh >> 4, h = bh & 15;
        const int col = h * 64 + lane, vcol = h * 64 + q * 16 + (lane & 15);
        const float ka = p.in[22][(size_t)j * D + col];
        const bf16_t* LWd = LW + (size_t)d * NT * D; const bf16_t* ADd = AD + (size_t)d * NT * D;
        bf16_t* Yd = Y + (size_t)d * NT * D;
        float S0 = 0.f, S1 = 0.f, S2 = 0.f, S3 = 0.f, S4 = 0.f, S5 = 0.f, S6 = 0.f, S7 = 0.f, S8 = 0.f, S9 = 0.f, S10 = 0.f, S11 = 0.f, S12 = 0.f, S13 = 0.f, S14 = 0.f, S15 = 0.f;
        float sa = 0.f;
        auto row_of = [&](int s) -> int {
            if (s < TC) { const int t = d ? (TC - 1 - s) : s; return NLAT + b * TC + t; }
            const int tl = s - TC; const int t = d ? (TL - 1 - tl) : tl; return b * TL + t;
        };
        auto row_kk = [&](int s) -> int { return row_of(s < TC + TL ? s : TC + TL - 1); };
        const int colw = col & ~1, vcolw = vcol & ~1;
        const unsigned shc = (col & 1) ? 0u : 16u, shv = (vcol & 1) ? 0u : 16u;
#define LDW(P, off) (*(const unsigned*)((P) + (off)))
#define UNP(w, sh) __uint_as_float(((w) << (sh)) & 0xffff0000u)
        unsigned nr[4], nkk[4], nk[4], nlw[4], na[4], nv[4];
#pragma unroll
        for (int g = 0; g < 4; ++g) {
            const size_t o = (size_t)row_of(g) * D;
            nr[g] = LDW(R, o + colw); nk[g] = LDW(Kb, o + colw); nlw[g] = LDW(LWd, o + colw); na[g] = LDW(ADd, o + colw); nv[g] = LDW(V, o + vcolw);
            nkk[g] = LDW(KK, (size_t)row_kk(g + 1) * D + colw);
        }
        float kk_cur = bf2f(KK[(size_t)row_of(0) * D + col]);
        constexpr int NSTEP = TC + TL;
        for (int s0 = 0; s0 < NSTEP; s0 += 4) {
            unsigned cr[4], ckk[4], ck[4], clw[4], ca[4], cv[4];
#pragma unroll
            for (int g = 0; g < 4; ++g) { cr[g] = nr[g]; ckk[g] = nkk[g]; ck[g] = nk[g]; clw[g] = nlw[g]; ca[g] = na[g]; cv[g] = nv[g]; }
            if (s0 + 4 < NSTEP) {
#pragma unroll
                for (int g = 0; g < 4; ++g) {
                    const size_t o = (size_t)row_of(s0 + 4 + g) * D;
                    nr[g] = LDW(R, o + colw); nk[g] = LDW(Kb, o + colw); nlw[g] = LDW(LWd, o + colw); na[g] = LDW(ADd, o + colw); nv[g] = LDW(V, o + vcolw);
                    nkk[g] = LDW(KK, (size_t)row_kk(s0 + 5 + g) * D + colw);
                }
            }
#pragma unroll
            for (int g = 0; g < 4; ++g) {
                const float rr = UNP(cr[g], shc), kkc = kk_cur, kkn = UNP(ckk[g], shc), kv = UNP(ck[g], shc), av = UNP(ca[g], shc), vv = UNP(cv[g], shv);
                kk_cur = kkn;
                const float dec = __expf(UNP(clw[g], shc)), bb = kkc * av, kd = kv * (1.f + (av - 1.f) * ka);
                float py0, py1, ps0, ps1;
                asm volatile(SCAN_STEP_ASM
                    : "+v"(S0), "+v"(S1), "+v"(S2), "+v"(S3), "+v"(S4), "+v"(S5), "+v"(S6), "+v"(S7), "+v"(S8), "+v"(S9), "+v"(S10), "+v"(S11), "+v"(S12), "+v"(S13), "+v"(S14), "+v"(S15),
                      "=&v"(py0), "=&v"(py1), "=&v"(ps0), "=&v"(ps1)
                    : "v"(dec), "v"(bb), "v"(kd), "v"(rr), "v"(kkn), "v"(sa), "v"(vv));
                sa = -red4(ps0 + ps1);
                const float yv = red4(py0 + py1);
                if (lane < 16) Yd[(size_t)row_of(s0 + g) * D + vcol] = f2bf(yv);
            }
        }
#undef LDW
#undef UNP
    }
}

#define TRI_ASM1 \
    "s_nop 1\n\t" \
    "v_xor_b32 %0, 0x80000000, %0\n\t" \
    "v_fmac_f32_dpp %1, %8, %0 row_newbcast:1 row_mask:0xf bank_mask:0xf\n\t" \
    "v_xor_b32 %1, 0x80000000, %1\n\t" \
    "v_fmac_f32_dpp %2, %8, %0 row_newbcast:2 row_mask:0xf bank_mask:0xf\n\t" \
    "v_fmac_f32_dpp %2, %9, %1 row_newbcast:2 row_mask:0xf bank_mask:0xf\n\t" \
    "v_xor_b32 %2, 0x80000000, %2\n\t" \
    "v_fmac_f32_dpp %3, %8, %0 row_newbcast:3 row_mask:0xf bank_mask:0xf\n\t" \
    "v_fmac_f32_dpp %3, %9, %1 row_newbcast:3 row_mask:0xf bank_mask:0xf\n\t" \
    "v_fmac_f32_dpp %3, %10, %2 row_newbcast:3 row_mask:0xf bank_mask:0xf\n\t" \
    "v_xor_b32 %3, 0x80000000, %3\n\t" \
    "v_fmac_f32_dpp %4, %8, %0 row_newbcast:4 row_mask:0xf bank_mask:0xf\n\t" \
    "v_fmac_f32_dpp %4, %9, %1 row_newbcast:4 row_mask:0xf bank_mask:0xf\n\t" \
    "v_fmac_f32_dpp %4, %10, %2 row_newbcast:4 row_mask:0xf bank_mask:0xf\n\t" \
    "v_fmac_f32_dpp %4, %11, %3 row_newbcast:4 row_mask:0xf bank_mask:0xf\n\t" \
    "v_xor_b32 %4, 0x80000000, %4\n\t" \
    "v_fmac_f32_dpp %5, %8, %0 row_newbcast:5 row_mask:0xf bank_mask:0xf\n\t" \
    "v_fmac_f32_dpp %5, %9, %1 row_newbcast:5 row_mask:0xf bank_mask:0xf\n\t" \
    "v_fmac_f32_dpp %5, %10, %2 row_newbcast:5 row_mask:0xf bank_mask:0xf\n\t" \
    "v_fmac_f32_dpp %5, %11, %3 row_newbcast:5 row_mask:0xf bank_mask:0xf\n\t" \
    "v_fmac_f32_dpp %5, %12, %4 row_newbcast:5 row_mask:0xf bank_mask:0xf\n\t" \
    "v_xor_b32 %5, 0x80000000, %5\n\t" \
    "v_fmac_f32_dpp %6, %8, %0 row_newbcast:6 row_mask:0xf bank_mask:0xf\n\t" \
    "v_fmac_f32_dpp %6, %9, %1 row_newbcast:6 row_mask:0xf bank_mask:0xf\n\t" \
    "v_fmac_f32_dpp %6, %10, %2 row_newbcast:6 row_mask:0xf bank_mask:0xf\n\t" \
    "v_fmac_f32_dpp %6, %11, %3 row_newbcast:6 row_mask:0xf bank_mask:0xf\n\t" \
    "v_fmac_f32_dpp %6, %12, %4 row_newbcast:6 row_mask:0xf bank_mask:0xf\n\t" \
    "v_fmac_f32_dpp %6, %13, %5 row_newbcast:6 row_mask:0xf bank_mask:0xf\n\t" \
    "v_xor_b32 %6, 0x80000000, %6\n\t" \
    "v_fmac_f32_dpp %7, %8, %0 row_newbcast:7 row_mask:0xf bank_mask:0xf\n\t" \
    "v_fmac_f32_dpp %7, %9, %1 row_newbcast:7 row_mask:0xf bank_mask:0xf\n\t" \
    "v_fmac_f32_dpp %7, %10, %2 row_newbcast:7 row_mask:0xf bank_mask:0xf\n\t" \
    "v_fmac_f32_dpp %7, %11, %3 row_newbcast:7 row_mask:0xf bank_mask:0xf\n\t" \
    "v_fmac_f32_dpp %7, %12, %4 row_newbcast:7 row_mask:0xf bank_mask:0xf\n\t" \
    "v_fmac_f32_dpp %7, %13, %5 row_newbcast:7 row_mask:0xf bank_mask:0xf\n\t" \
    "v_fmac_f32_dpp %7, %14, %6 row_newbcast:7 row_mask:0xf bank_mask:0xf\n\t" \
    "v_xor_b32 %7, 0x80000000, %7\n\t" \
    ""
#define TRI_ASM2 \
    "s_nop 1\n\t" \
    "v_fmac_f32_dpp %0, %16, %8 row_newbcast:8 row_mask:0xf bank_mask:0xf\n\t" \
    "v_fmac_f32_dpp %0, %17, %9 row_newbcast:8 row_mask:0xf bank_mask:0xf\n\t" \
    "v_fmac_f32_dpp %0, %18, %10 row_newbcast:8 row_mask:0xf bank_mask:0xf\n\t" \
    "v_fmac_f32_dpp %0, %19, %11 row_newbcast:8 row_mask:0xf bank_mask:0xf\n\t" \
    "v_fmac_f32_dpp %0, %20, %12 row_newbcast:8 row_mask:0xf bank_mask:0xf\n\t" \
    "v_fmac_f32_dpp %0, %21, %13 row_newbcast:8 row_mask:0xf bank_mask:0xf\n\t" \
    "v_fmac_f32_dpp %0, %22, %14 row_newbcast:8 row_mask:0xf bank_mask:0xf\n\t" \
    "v_fmac_f32_dpp %0, %23, %15 row_newbcast:8 row_mask:0xf bank_mask:0xf\n\t" \
    "v_fmac_f32_dpp %1, %16, %8 row_newbcast:9 row_mask:0xf bank_mask:0xf\n\t" \
    "v_fmac_f32_dpp %1, %17, %9 row_newbcast:9 row_mask:0xf bank_mask:0xf\n\t" \
    "v_fmac_f32_dpp %1, %18, %10 row_newbcast:9 row_mask:0xf bank_mask:0xf\n\t" \
    "v_fmac_f32_dpp %1, %19, %11 row_newbcast:9 row_mask:0xf bank_mask:0xf\n\t" \
    "v_fmac_f32_dpp %1, %20, %12 row_newbcast:9 row_mask:0xf bank_mask:0xf\n\t" \
    "v_fmac_f32_dpp %1, %21, %13 row_newbcast:9 row_mask:0xf bank_mask:0xf\n\t" \
    "v_fmac_f32_dpp %1, %22, %14 row_newbcast:9 row_mask:0xf bank_mask:0xf\n\t" \
    "v_fmac_f32_dpp %1, %23, %15 row_newbcast:9 row_mask:0xf bank_mask:0xf\n\t" \
    "v_fmac_f32_dpp %2, %16, %8 row_newbcast:10 row_mask:0xf bank_mask:0xf\n\t" \
    "v_fmac_f32_dpp %2, %17, %9 row_newbcast:10 row_mask:0xf bank_mask:0xf\n\t" \
    "v_fmac_f32_dpp %2, %18, %10 row_newbcast:10 row_mask:0xf bank_mask:0xf\n\t" \
    "v_fmac_f32_dpp %2, %19, %11 row_newbcast:10 row_mask:0xf bank_mask:0xf\n\t" \
    "v_fmac_f32_dpp %2, %20, %12 row_newbcast:10 row_mask:0xf bank_mask:0xf\n\t" \
    "v_fmac_f32_dpp %2, %21, %13 row_newbcast:10 row_mask:0xf bank_mask:0xf\n\t" \
    "v_fmac_f32_dpp %2, %22, %14 row_newbcast:10 row_mask:0xf bank_mask:0xf\n\t" \
    "v_fmac_f32_dpp %2, %23, %15 row_newbcast:10 row_mask:0xf bank_mask:0xf\n\t" \
    "v_fmac_f32_dpp %3, %16, %8 row_newbcast:11 row_mask:0xf bank_mask:0xf\n\t" \
    "v_fmac_f32_dpp %3, %17, %9 row_newbcast:11 row_mask:0xf bank_mask:0xf\n\t" \
    "v_fmac_f32_dpp %3, %18, %10 row_newbcast:11 row_mask:0xf bank_mask:0xf\n\t" \
    "v_fmac_f32_dpp %3, %19, %11 row_newbcast:11 row_mask:0xf bank_mask:0xf\n\t" \
    "v_fmac_f32_dpp %3, %20, %12 row_newbcast:11 row_mask:0xf bank_mask:0xf\n\t" \
    "v_fmac_f32_dpp %3, %21, %13 row_newbcast:11 row_mask:0xf bank_mask:0xf\n\t" \
    "v_fmac_f32_dpp %3, %22, %14 row_newbcast:11 row_mask:0xf bank_mask:0xf\n\t" \
    "v_fmac_f32_dpp %3, %23, %15 row_newbcast:11 row_mask:0xf bank_mask:0xf\n\t" \
    "v_fmac_f32_dpp %4, %16, %8 row_newbcast:12 row_mask:0xf bank_mask:0xf\n\t" \
    "v_fmac_f32_dpp %4, %17, %9 row_newbcast:12 row_mask:0xf bank_mask:0xf\n\t" \
    "v_fmac_f32_dpp %4, %18, %10 row_newbcast:12 row_mask:0xf bank_mask:0xf\n\t" \
    "v_fmac_f32_dpp %4, %19, %11 row_newbcast:12 row_mask:0xf bank_mask:0xf\n\t" \
    "v_fmac_f32_dpp %4, %20, %12 row_newbcast:12 row_mask:0xf bank_mask:0xf\n\t" \
    "v_fmac_f32_dpp %4, %21, %13 row_newbcast:12 row_mask:0xf bank_mask:0xf\n\t" \
    "v_fmac_f32_dpp %4, %22, %14 row_newbcast:12 row_mask:0xf bank_mask:0xf\n\t" \
    "v_fmac_f32_dpp %4, %23, %15 row_newbcast:12 row_mask:0xf bank_mask:0xf\n\t" \
    "v_fmac_f32_dpp %5, %16, %8 row_newbcast:13 row_mask:0xf bank_mask:0xf\n\t" \
    "v_fmac_f32_dpp %5, %17, %9 row_newbcast:13 row_mask:0xf bank_mask:0xf\n\t" \
    "v_fmac_f32_dpp %5, %18, %10 row_newbcast:13 row_mask:0xf bank_mask:0xf\n\t" \
    "v_fmac_f32_dpp %5, %19, %11 row_newbcast:13 row_mask:0xf bank_mask:0xf\n\t" \
    "v_fmac_f32_dpp %5, %20, %12 row_newbcast:13 row_mask:0xf bank_mask:0xf\n\t" \
    "v_fmac_f32_dpp %5, %21, %13 row_newbcast:13 row_mask:0xf bank_mask:0xf\n\t" \
    "v_fmac_f32_dpp %5, %22, %14 row_newbcast:13 row_mask:0xf bank_mask:0xf\n\t" \
    "v_fmac_f32_dpp %5, %23, %15 row_newbcast:13 row_mask:0xf bank_mask:0xf\n\t" \
    "v_fmac_f32_dpp %6, %16, %8 row_newbcast:14 row_mask:0xf bank_mask:0xf\n\t" \
    "v_fmac_f32_dpp %6, %17, %9 row_newbcast:14 row_mask:0xf bank_mask:0xf\n\t" \
    "v_fmac_f32_dpp %6, %18, %10 row_newbcast:14 row_mask:0xf bank_mask:0xf\n\t" \
    "v_fmac_f32_dpp %6, %19, %11 row_newbcast:14 row_mask:0xf bank_mask:0xf\n\t" \
    "v_fmac_f32_dpp %6, %20, %12 row_newbcast:14 row_mask:0xf bank_mask:0xf\n\t" \
    "v_fmac_f32_dpp %6, %21, %13 row_newbcast:14 row_mask:0xf bank_mask:0xf\n\t" \
    "v_fmac_f32_dpp %6, %22, %14 row_newbcast:14 row_mask:0xf bank_mask:0xf\n\t" \
    "v_fmac_f32_dpp %6, %23, %15 row_newbcast:14 row_mask:0xf bank_mask:0xf\n\t" \
    "v_fmac_f32_dpp %7, %16, %8 row_newbcast:15 row_mask:0xf bank_mask:0xf\n\t" \
    "v_fmac_f32_dpp %7, %17, %9 row_newbcast:15 row_mask:0xf bank_mask:0xf\n\t" \
    "v_fmac_f32_dpp %7, %18, %10 row_newbcast:15 row_mask:0xf bank_mask:0xf\n\t" \
    "v_fmac_f32_dpp %7, %19, %11 row_newbcast:15 row_mask:0xf bank_mask:0xf\n\t" \
    "v_fmac_f32_dpp %7, %20, %12 row_newbcast:15 row_mask:0xf bank_mask:0xf\n\t" \
    "v_fmac_f32_dpp %7, %21, %13 row_newbcast:15 row_mask:0xf bank_mask:0xf\n\t" \
    "v_fmac_f32_dpp %7, %22, %14 row_newbcast:15 row_mask:0xf bank_mask:0xf\n\t" \
    "v_fmac_f32_dpp %7, %23, %15 row_newbcast:15 row_mask:0xf bank_mask:0xf\n\t" \
    ""
#define TRI_ASM3 \
    "s_nop 1\n\t" \
    "v_xor_b32 %0, 0x80000000, %0\n\t" \
    "v_fmac_f32_dpp %1, %8, %0 row_newbcast:9 row_mask:0xf bank_mask:0xf\n\t" \
    "v_xor_b32 %1, 0x80000000, %1\n\t" \
    "v_fmac_f32_dpp %2, %8, %0 row_newbcast:10 row_mask:0xf bank_mask:0xf\n\t" \
    "v_fmac_f32_dpp %2, %9, %1 row_newbcast:10 row_mask:0xf bank_mask:0xf\n\t" \
    "v_xor_b32 %2, 0x80000000, %2\n\t" \
    "v_fmac_f32_dpp %3, %8, %0 row_newbcast:11 row_mask:0xf bank_mask:0xf\n\t" \
    "v_fmac_f32_dpp %3, %9, %1 row_newbcast:11 row_mask:0xf bank_mask:0xf\n\t" \
    "v_fmac_f32_dpp %3, %10, %2 row_newbcast:11 row_mask:0xf bank_mask:0xf\n\t" \
    "v_xor_b32 %3, 0x80000000, %3\n\t" \
    "v_fmac_f32_dpp %4, %8, %0 row_newbcast:12 row_mask:0xf bank_mask:0xf\n\t" \
    "v_fmac_f32_dpp %4, %9, %1 row_newbcast:12 row_mask:0xf bank_mask:0xf\n\t" \
    "v_fmac_f32_dpp %4, %10, %2 row_newbcast:12 row_mask:0xf bank_mask:0xf\n\t" \
    "v_fmac_f32_dpp %4, %11, %3 row_newbcast:12 row_mask:0xf bank_mask:0xf\n\t" \
    "v_xor_b32 %4, 0x80000000, %4\n\t" \
    "v_fmac_f32_dpp %5, %8, %0 row_newbcast:13 row_mask:0xf bank_mask:0xf\n\t" \
    "v_fmac_f32_dpp %5, %9, %1 row_newbcast:13 row_mask:0xf bank_mask:0xf\n\t" \
    "v_fmac_f32_dpp %5, %10, %2 row_newbcast:13 row_mask:0xf bank_mask:0xf\n\t" \
    "v_fmac_f32_dpp %5, %11, %3 row_newbcast:13 row_mask:0xf bank_mask:0xf\n\t" \
    "v_fmac_f32_dpp %5, %12, %4 row_newbcast:13 row_mask:0xf bank_mask:0xf\n\t" \
    "v_xor_b32 %5, 0x80000000, %5\n\t" \
    "v_fmac_f32_dpp %6, %8, %0 row_newbcast:14 row_mask:0xf bank_mask:0xf\n\t" \
    "v_fmac_f32_dpp %6, %9, %1 row_newbcast:14 row_mask:0xf bank_mask:0xf\n\t" \
    "v_fmac_f32_dpp %6, %10, %2 row_newbcast:14 row_mask:0xf bank_mask:0xf\n\t" \
    "v_fmac_f32_dpp %6, %11, %3 row_newbcast:14 row_mask:0xf bank_mask:0xf\n\t" \
    "v_fmac_f32_dpp %6, %12, %4 row_newbcast:14 row_mask:0xf bank_mask:0xf\n\t" \
    "v_fmac_f32_dpp %6, %13, %5 row_newbcast:14 row_mask:0xf bank_mask:0xf\n\t" \
    "v_xor_b32 %6, 0x80000000, %6\n\t" \
    "v_fmac_f32_dpp %7, %8, %0 row_newbcast:15 row_mask:0xf bank_mask:0xf\n\t" \
    "v_fmac_f32_dpp %7, %9, %1 row_newbcast:15 row_mask:0xf bank_mask:0xf\n\t" \
    "v_fmac_f32_dpp %7, %10, %2 row_newbcast:15 row_mask:0xf bank_mask:0xf\n\t" \
    "v_fmac_f32_dpp %7, %11, %3 row_newbcast:15 row_mask:0xf bank_mask:0xf\n\t" \
    "v_fmac_f32_dpp %7, %12, %4 row_newbcast:15 row_mask:0xf bank_mask:0xf\n\t" \
    "v_fmac_f32_dpp %7, %13, %5 row_newbcast:15 row_mask:0xf bank_mask:0xf\n\t" \
    "v_fmac_f32_dpp %7, %14, %6 row_newbcast:15 row_mask:0xf bank_mask:0xf\n\t" \
    "v_xor_b32 %7, 0x80000000, %7\n\t" \
    ""

constexpr int SC_KKT = 0, SC_RRT = 2048, SC_BHT = 4096, SC_KHT = 6144, SC_BHJ = 8192, SC_KHJ = 10240, SC_MBF = 12288, SC_RHF = 13312, SC_WLF = 14336, SC_STRIDE = 15360;
__device__ __forceinline__ bf16x8 mk8(unsigned a, unsigned b, unsigned c, unsigned d) { const u32x4 w = {a, b, c, d}; return __builtin_bit_cast(bf16x8, w); }
typedef short bf16x4 __attribute__((ext_vector_type(4)));
__device__ __forceinline__ bf16x4 mk4(unsigned a, unsigned b) { const u32x2 w = {a, b}; return __builtin_bit_cast(bf16x4, w); }
__device__ __forceinline__ void phase_rwkv_scan2(const Params& p, int j, char* lds_, bf16_t* Y, int dsel  ) {
    const bf16_t* R = (const bf16_t*)(p.ws + OFF_R); const bf16_t* Kb = (const bf16_t*)(p.ws + OFF_K);
    const bf16_t* V = (const bf16_t*)(p.ws + OFF_VF); const bf16_t* KK = (const bf16_t*)(p.ws + OFF_H);
    const bf16_t* LW = (const bf16_t*)(p.ws + OFF_LW); const bf16_t* AD = (const bf16_t*)(p.ws + OFF_AD);
    const int tid = tidx(), lane = tid & 63, wid = __builtin_amdgcn_readfirstlane(tid >> 6), cl = wid >> 2, q = wid & 3, g = lane >> 4, li = lane & 15;
    LAS unsigned char* wl = (LAS unsigned char*)lds_ + wid * SC_STRIDE;
    for (int cp = blockIdx.x; cp < 256; cp += gridDim.x) {
        const int chain = cp * 2 + cl, d = chain & 1, bh = chain >> 1, b = bh >> 4, h = bh & 15;
        if (dsel >= 0 && d != dsel) continue;
        const int col = h * 64 + lane;
        const int vcol = h * 64 + q * 16 + li;
        const float ka = p.in[22][(size_t)j * D + col];
        const bf16_t* LWd = LW + (size_t)d * NT * D; const bf16_t* ADd = AD + (size_t)d * NT * D;
        bf16_t* Yd = Y + (size_t)d * NT * D;
        const int dir = d ? -1 : 1;
        f32x4 T[4];
#pragma unroll
        for (int jb = 0; jb < 4; ++jb) T[jb] = (f32x4){0.f, 0.f, 0.f, 0.f};
        for (int c = 0; c < (TC + TL) / 16; ++c) {
            const int s0 = c * 16;
            int row0;
            if (s0 < TC) row0 = NLAT + b * TC + (d ? (TC - 1 - s0) : s0);
            else { const int tl = s0 - TC; row0 = b * TL + (d ? (TL - 1 - tl) : tl); }
            {
                float cw = 0.f, ep_prev = 1.f;
                unsigned bhp[8], khp[8];
                float bh_e = 0.f, kh_e = 0.f;
#pragma unroll
                for (int t = 0; t < 16; ++t) {
                    const size_t o = (size_t)(row0 + t * dir) * D + col;
                    const float rv = bf2f(R[o]), kkv = bf2f(KK[o]), kv = bf2f(Kb[o]), lwv = bf2f(LWd[o]), av = bf2f(ADd[o]);
                    cw += lwv;
                    const float ep = __expf(cw), em = __expf(-cw);
                    const float kkt = kkv * ep_prev, rt = rv * ep, bhv = kkv * av * em, khv = kv * (1.f + (av - 1.f) * ka) * em;
                    ep_prev = ep;
                    *(LAS bf16_t*)(wl + SC_KKT + t * 128 + lane * 2) = (bf16_t)(pack2(kkt, 0.f) & 0xffffu);
                    *(LAS bf16_t*)(wl + SC_RRT + t * 128 + lane * 2) = (bf16_t)(pack2(rt, 0.f) & 0xffffu);
                    *(LAS bf16_t*)(wl + SC_BHT + t * 128 + lane * 2) = (bf16_t)(pack2(bhv, 0.f) & 0xffffu);
                    *(LAS bf16_t*)(wl + SC_KHT + t * 128 + lane * 2) = (bf16_t)(pack2(khv, 0.f) & 0xffffu);
                    if (t & 1) { bhp[t >> 1] = pack2(bh_e, bhv); khp[t >> 1] = pack2(kh_e, khv); } else { bh_e = bhv; kh_e = khv; }
                }
                *(LAS u32x4*)(wl + SC_BHJ + lane * 32) = (u32x4){bhp[0], bhp[1], bhp[2], bhp[3]};
                *(LAS u32x4*)(wl + SC_BHJ + lane * 32 + 16) = (u32x4){bhp[4], bhp[5], bhp[6], bhp[7]};
                *(LAS u32x4*)(wl + SC_KHJ + lane * 32) = (u32x4){khp[0], khp[1], khp[2], khp[3]};
                *(LAS u32x4*)(wl + SC_KHJ + lane * 32 + 16) = (u32x4){khp[4], khp[5], khp[6], khp[7]};
                *(LAS float*)(wl + SC_WLF + lane * 4) = ep_prev;
            }
            unsigned vw0, vw1;
            {
                const size_t o = (size_t)(row0 + (4 * g) * dir) * D + vcol; const long st = (long)dir * D;
                const unsigned v0 = V[o], v1 = V[o + st], v2 = V[o + 2 * st], v3 = V[o + 3 * st];
                vw0 = v0 | (v1 << 16); vw1 = v2 | (v3 << 16);
            }
            asm volatile("" ::: "memory");
            f32x4 Mb = {0.f, 0.f, 0.f, 0.f}, Mk = Mb, Nb = Mb, Nk = Mb;
#pragma unroll
            for (int kk = 0; kk < 2; ++kk) {
                const int ko = li * 128 + (32 * kk + 8 * g) * 2;
                const bf16x8 aB = *(const LAS bf16x8*)(wl + SC_BHT + ko), aK = *(const LAS bf16x8*)(wl + SC_KHT + ko);
                const bf16x8 bK = *(const LAS bf16x8*)(wl + SC_KKT + ko), bR = *(const LAS bf16x8*)(wl + SC_RRT + ko);
                Mb = __builtin_amdgcn_mfma_f32_16x16x32_bf16(aB, bK, Mb, 0, 0, 0);
                Mk = __builtin_amdgcn_mfma_f32_16x16x32_bf16(aK, bK, Mk, 0, 0, 0);
                Nb = __builtin_amdgcn_mfma_f32_16x16x32_bf16(aB, bR, Nb, 0, 0, 0);
                Nk = __builtin_amdgcn_mfma_f32_16x16x32_bf16(aK, bR, Nk, 0, 0, 0);
            }
#pragma unroll
            for (int r = 0; r < 4; ++r) {
                const int s = 4 * g + r;
                Mb[r] = s < li ? Mb[r] : 0.f; Mk[r] = s < li ? Mk[r] : 0.f;
                Nb[r] = s <= li ? Nb[r] : 0.f; Nk[r] = s <= li ? Nk[r] : 0.f;
            }
            f32x4 PT = {0.f, 0.f, 0.f, 0.f}, QT = PT;
#pragma unroll
            for (int kk = 0; kk < 2; ++kk) {
                const bf16x8 bw = mk8(pack2(T[2 * kk][0], T[2 * kk][1]), pack2(T[2 * kk][2], T[2 * kk][3]), pack2(T[2 * kk + 1][0], T[2 * kk + 1][1]), pack2(T[2 * kk + 1][2], T[2 * kk + 1][3]));
                const int ko = li * 128 + (32 * kk + 4 * g) * 2;
                const u32x2 k0 = *(const LAS u32x2*)(wl + SC_KKT + ko), k1 = *(const LAS u32x2*)(wl + SC_KKT + ko + 32);
                const u32x2 r0 = *(const LAS u32x2*)(wl + SC_RRT + ko), r1 = *(const LAS u32x2*)(wl + SC_RRT + ko + 32);
                PT = __builtin_amdgcn_mfma_f32_16x16x32_bf16(mk8(k0[0], k0[1], k1[0], k1[1]), bw, PT, 0, 0, 0);
                QT = __builtin_amdgcn_mfma_f32_16x16x32_bf16(mk8(r0[0], r0[1], r1[0], r1[1]), bw, QT, 0, 0, 0);
            }
            const f32x4 RT = __builtin_amdgcn_mfma_f32_16x16x32_bf16(mk8(pack2(Mk[0], Mk[1]), pack2(Mk[2], Mk[3]), 0u, 0u), mk8(vw0, vw1, 0u, 0u), PT, 0, 0, 0);
            *(LAS f32x4*)(wl + SC_RHF + li * 64 + g * 16) = RT;
#pragma unroll
            for (int r = 0; r < 4; ++r) *(LAS float*)(wl + SC_MBF + (4 * g + r) * 64 + li * 4) = Mb[r];
            asm volatile("" ::: "memory");
            float x0, x1, x2, x3, x4, x5, x6, x7, x8, x9, x10, x11, x12, x13, x14, x15;
            { const f32x4 u = *(const LAS f32x4*)(wl + SC_RHF + li * 64); x0 = u[0]; x1 = u[1]; x2 = u[2]; x3 = u[3]; }
            { const f32x4 u = *(const LAS f32x4*)(wl + SC_RHF + li * 64 + 16); x4 = u[0]; x5 = u[1]; x6 = u[2]; x7 = u[3]; }
            { const f32x4 u = *(const LAS f32x4*)(wl + SC_RHF + li * 64 + 32); x8 = u[0]; x9 = u[1]; x10 = u[2]; x11 = u[3]; }
            { const f32x4 u = *(const LAS f32x4*)(wl + SC_RHF + li * 64 + 48); x12 = u[0]; x13 = u[1]; x14 = u[2]; x15 = u[3]; }
            float m0, m1, m2, m3, m4, m5, m6, m7, m8, m9, m10, m11, m12, m13, m14;
#define LDM(s) (*(const LAS float*)(wl + SC_MBF + (s) * 64 + li * 4))
            m0 = LDM(0); m1 = LDM(1); m2 = LDM(2); m3 = LDM(3); m4 = LDM(4); m5 = LDM(5); m6 = LDM(6); m7 = LDM(7);
            m8 = LDM(8); m9 = LDM(9); m10 = LDM(10); m11 = LDM(11); m12 = LDM(12); m13 = LDM(13); m14 = LDM(14);
#undef LDM
            asm volatile(TRI_ASM1 : "+v"(x0), "+v"(x1), "+v"(x2), "+v"(x3), "+v"(x4), "+v"(x5), "+v"(x6), "+v"(x7)
                                  : "v"(m0), "v"(m1), "v"(m2), "v"(m3), "v"(m4), "v"(m5), "v"(m6));
            asm volatile(TRI_ASM2 : "+v"(x8), "+v"(x9), "+v"(x10), "+v"(x11), "+v"(x12), "+v"(x13), "+v"(x14), "+v"(x15)
                                  : "v"(x0), "v"(x1), "v"(x2), "v"(x3), "v"(x4), "v"(x5), "v"(x6), "v"(x7), "v"(m0), "v"(m1), "v"(m2), "v"(m3), "v"(m4), "v"(m5), "v"(m6), "v"(m7));
            asm volatile(TRI_ASM3 : "+v"(x8), "+v"(x9), "+v"(x10), "+v"(x11), "+v"(x12), "+v"(x13), "+v"(x14), "+v"(x15)
                                  : "v"(m8), "v"(m9), "v"(m10), "v"(m11), "v"(m12), "v"(m13), "v"(m14));
            const float xs0 = g == 0 ? x0 : (g == 1 ? x4 : (g == 2 ? x8 : x12));
            const float xs1 = g == 0 ? x1 : (g == 1 ? x5 : (g == 2 ? x9 : x13));
            const float xs2 = g == 0 ? x2 : (g == 1 ? x6 : (g == 2 ? x10 : x14));
            const float xs3 = g == 0 ? x3 : (g == 1 ? x7 : (g == 2 ? x11 : x15));
            const bf16x8 bop = mk8(pack2(xs0, xs1), pack2(xs2, xs3), vw0, vw1);
            const f32x4 YT = __builtin_amdgcn_mfma_f32_16x16x32_bf16(mk8(pack2(Nb[0], Nb[1]), pack2(Nb[2], Nb[3]), pack2(Nk[0], Nk[1]), pack2(Nk[2], Nk[3])), bop, QT, 0, 0, 0);
#pragma unroll
            for (int r = 0; r < 4; ++r) Yd[(size_t)(row0 + (4 * g + r) * dir) * D + vcol] = (bf16_t)(pack2(YT[r], 0.f) & 0xffffu);
#pragma unroll
            for (int jb = 0; jb < 4; ++jb) {
                const u32x2 b2 = *(const LAS u32x2*)(wl + SC_BHJ + (16 * jb + li) * 32 + g * 8), k2 = *(const LAS u32x2*)(wl + SC_KHJ + (16 * jb + li) * 32 + g * 8);
                T[jb] = __builtin_amdgcn_mfma_f32_16x16x32_bf16(mk8(b2[0], b2[1], k2[0], k2[1]), bop, T[jb], 0, 0, 0);
                const f32x4 wv = *(const LAS f32x4*)(wl + SC_WLF + (16 * jb + 4 * g) * 4);
                T[jb] = T[jb] * wv;
            }
            asm volatile("" ::: "memory");
        }
    }
}

#define TRI2_ASMA \
    "s_nop 1\n\t" \
    "v_xor_b32 %0, 0x80000000, %0\n\t" \
    "v_fmac_f32_dpp %1, %16, %0 row_newbcast:1 row_mask:0xf bank_mask:0xf\n\t" \
    "v_fmac_f32_dpp %2, %16, %0 row_newbcast:2 row_mask:0xf bank_mask:0xf\n\t" \
    "v_fmac_f32_dpp %3, %16, %0 row_newbcast:3 row_mask:0xf bank_mask:0xf\n\t" \
    "v_fmac_f32_dpp %4, %16, %0 row_newbcast:4 row_mask:0xf bank_mask:0xf\n\t" \
    "v_fmac_f32_dpp %5, %16, %0 row_newbcast:5 row_mask:0xf bank_mask:0xf\n\t" \
    "v_fmac_f32_dpp %6, %16, %0 row_newbcast:6 row_mask:0xf bank_mask:0xf\n\t" \
    "v_fmac_f32_dpp %7, %16, %0 row_newbcast:7 row_mask:0xf bank_mask:0xf\n\t" \
    "v_fmac_f32_dpp %8, %16, %0 row_newbcast:8 row_mask:0xf bank_mask:0xf\n\t" \
    "v_fmac_f32_dpp %9, %16, %0 row_newbcast:9 row_mask:0xf bank_mask:0xf\n\t" \
    "v_fmac_f32_dpp %10, %16, %0 row_newbcast:10 row_mask:0xf bank_mask:0xf\n\t" \
    "v_fmac_f32_dpp %11, %16, %0 row_newbcast:11 row_mask:0xf bank_mask:0xf\n\t" \
    "v_fmac_f32_dpp %12, %16, %0 row_newbcast:12 row_mask:0xf bank_mask:0xf\n\t" \
    "v_fmac_f32_dpp %13, %16, %0 row_newbcast:13 row_mask:0xf bank_mask:0xf\n\t" \
    "v_fmac_f32_dpp %14, %16, %0 row_newbcast:14 row_mask:0xf bank_mask:0xf\n\t" \
    "v_fmac_f32_dpp %15, %16, %0 row_newbcast:15 row_mask:0xf bank_mask:0xf\n\t" \
    "v_xor_b32 %1, 0x80000000, %1\n\t" \
    "v_fmac_f32_dpp %2, %17, %1 row_newbcast:2 row_mask:0xf bank_mask:0xf\n\t" \
    "v_fmac_f32_dpp %3, %17, %1 row_newbcast:3 row_mask:0xf bank_mask:0xf\n\t" \
    "v_fmac_f32_dpp %4, %17, %1 row_newbcast:4 row_mask:0xf bank_mask:0xf\n\t" \
    "v_fmac_f32_dpp %5, %17, %1 row_newbcast:5 row_mask:0xf bank_mask:0xf\n\t" \
    "v_fmac_f32_dpp %6, %17, %1 row_newbcast:6 row_mask:0xf bank_mask:0xf\n\t" \
    "v_fmac_f32_dpp %7, %17, %1 row_newbcast:7 row_mask:0xf bank_mask:0xf\n\t" \
    "v_fmac_f32_dpp %8, %17, %1 row_newbcast:8 row_mask:0xf bank_mask:0xf\n\t" \
    "v_fmac_f32_dpp %9, %17, %1 row_newbcast:9 row_mask:0xf bank_mask:0xf\n\t" \
    "v_fmac_f32_dpp %10, %17, %1 row_newbcast:10 row_mask:0xf bank_mask:0xf\n\t" \
    "v_fmac_f32_dpp %11, %17, %1 row_newbcast:11 row_mask:0xf bank_mask:0xf\n\t" \
    "v_fmac_f32_dpp %12, %17, %1 row_newbcast:12 row_mask:0xf bank_mask:0xf\n\t" \
    "v_fmac_f32_dpp %13, %17, %1 row_newbcast:13 row_mask:0xf bank_mask:0xf\n\t" \
    "v_fmac_f32_dpp %14, %17, %1 row_newbcast:14 row_mask:0xf bank_mask:0xf\n\t" \
    "v_fmac_f32_dpp %15, %17, %1 row_newbcast:15 row_mask:0xf bank_mask:0xf\n\t" \
    "v_xor_b32 %2, 0x80000000, %2\n\t" \
    "v_fmac_f32_dpp %3, %18, %2 row_newbcast:3 row_mask:0xf bank_mask:0xf\n\t" \
    "v_fmac_f32_dpp %4, %18, %2 row_newbcast:4 row_mask:0xf bank_mask:0xf\n\t" \
    "v_fmac_f32_dpp %5, %18, %2 row_newbcast:5 row_mask:0xf bank_mask:0xf\n\t" \
    "v_fmac_f32_dpp %6, %18, %2 row_newbcast:6 row_mask:0xf bank_mask:0xf\n\t" \
    "v_fmac_f32_dpp %7, %18, %2 row_newbcast:7 row_mask:0xf bank_mask:0xf\n\t" \
    "v_fmac_f32_dpp %8, %18, %2 row_newbcast:8 row_mask:0xf bank_mask:0xf\n\t" \
    "v_fmac_f32_dpp %9, %18, %2 row_newbcast:9 row_mask:0xf bank_mask:0xf\n\t" \
    "v_fmac_f32_dpp %10, %18, %2 row_newbcast:10 row_mask:0xf bank_mask:0xf\n\t" \
    "v_fmac_f32_dpp %11, %18, %2 row_newbcast:11 row_mask:0xf bank_mask:0xf\n\t" \
    "v_fmac_f32_dpp %12, %18, %2 row_newbcast:12 row_mask:0xf bank_mask:0xf\n\t" \
    "v_fmac_f32_dpp %13, %18, %2 row_newbcast:13 row_mask:0xf bank_mask:0xf\n\t" \
    "v_fmac_f32_dpp %14, %18, %2 row_newbcast:14 row_mask:0xf bank_mask:0xf\n\t" \
    "v_fmac_f32_dpp %15, %18, %2 row_newbcast:15 row_mask:0xf bank_mask:0xf\n\t" \
    "v_xor_b32 %3, 0x80000000, %3\n\t" \
    "v_fmac_f32_dpp %4, %19, %3 row_newbcast:4 row_mask:0xf bank_mask:0xf\n\t" \
    "v_fmac_f32_dpp %5, %19, %3 row_newbcast:5 row_mask:0xf bank_mask:0xf\n\t" \
    "v_fmac_f32_dpp %6, %19, %3 row_newbcast:6 row_mask:0xf bank_mask:0xf\n\t" \
    "v_fmac_f32_dpp %7, %19, %3 row_newbcast:7 row_mask:0xf bank_mask:0xf\n\t" \
    "v_fmac_f32_dpp %8, %19, %3 row_newbcast:8 row_mask:0xf bank_mask:0xf\n\t" \
    "v_fmac_f32_dpp %9, %19, %3 row_newbcast:9 row_mask:0xf bank_mask:0xf\n\t" \
    "v_fmac_f32_dpp %10, %19, %3 row_newbcast:10 row_mask:0xf bank_mask:0xf\n\t" \
    "v_fmac_f32_dpp %11, %19, %3 row_newbcast:11 row_mask:0xf bank_mask:0xf\n\t" \
    "v_fmac_f32_dpp %12, %19, %3 row_newbcast:12 row_mask:0xf bank_mask:0xf\n\t" \
    "v_fmac_f32_dpp %13, %19, %3 row_newbcast:13 row_mask:0xf bank_mask:0xf\n\t" \
    "v_fmac_f32_dpp %14, %19, %3 row_newbcast:14 row_mask:0xf bank_mask:0xf\n\t" \
    "v_fmac_f32_dpp %15, %19, %3 row_newbcast:15 row_mask:0xf bank_mask:0xf\n\t" \
    "v_xor_b32 %4, 0x80000000, %4\n\t" \
    "v_fmac_f32_dpp %5, %20, %4 row_newbcast:5 row_mask:0xf bank_mask:0xf\n\t" \
    "v_fmac_f32_dpp %6, %20, %4 row_newbcast:6 row_mask:0xf bank_mask:0xf\n\t" \
    "v_fmac_f32_dpp %7, %20, %4 row_newbcast:7 row_mask:0xf bank_mask:0xf\n\t" \
    "v_fmac_f32_dpp %8, %20, %4 row_newbcast:8 row_mask:0xf bank_mask:0xf\n\t" \
    "v_fmac_f32_dpp %9, %20, %4 row_newbcast:9 row_mask:0xf bank_mask:0xf\n\t" \
    "v_fmac_f32_dpp %10, %20, %4 row_newbcast:10 row_mask:0xf bank_mask:0xf\n\t" \
    "v_fmac_f32_dpp %11, %20, %4 row_newbcast:11 row_mask:0xf bank_mask:0xf\n\t" \
    "v_fmac_f32_dpp %12, %20, %4 row_newbcast:12 row_mask:0xf bank_mask:0xf\n\t" \
    "v_fmac_f32_dpp %13, %20, %4 row_newbcast:13 row_mask:0xf bank_mask:0xf\n\t" \
    "v_fmac_f32_dpp %14, %20, %4 row_newbcast:14 row_mask:0xf bank_mask:0xf\n\t" \
    "v_fmac_f32_dpp %15, %20, %4 row_newbcast:15 row_mask:0xf bank_mask:0xf\n\t" \
    "v_xor_b32 %5, 0x80000000, %5\n\t" \
    "v_fmac_f32_dpp %6, %21, %5 row_newbcast:6 row_mask:0xf bank_mask:0xf\n\t" \
    "v_fmac_f32_dpp %7, %21, %5 row_newbcast:7 row_mask:0xf bank_mask:0xf\n\t" \
    "v_fmac_f32_dpp %8, %21, %5 row_newbcast:8 row_mask:0xf bank_mask:0xf\n\t" \
    "v_fmac_f32_dpp %9, %21, %5 row_newbcast:9 row_mask:0xf bank_mask:0xf\n\t" \
    "v_fmac_f32_dpp %10, %21, %5 row_newbcast:10 row_mask:0xf bank_mask:0xf\n\t" \
    "v_fmac_f32_dpp %11, %21, %5 row_newbcast:11 row_mask:0xf bank_mask:0xf\n\t" \
    "v_fmac_f32_dpp %12, %21, %5 row_newbcast:12 row_mask:0xf bank_mask:0xf\n\t" \
    "v_fmac_f32_dpp %13, %21, %5 row_newbcast:13 row_mask:0xf bank_mask:0xf\n\t" \
    "v_fmac_f32_dpp %14, %21, %5 row_newbcast:14 row_mask:0xf bank_mask:0xf\n\t" \
    "v_fmac_f32_dpp %15, %21, %5 row_newbcast:15 row_mask:0xf bank_mask:0xf\n\t" \
    "v_xor_b32 %6, 0x80000000, %6\n\t" \
    "v_fmac_f32_dpp %7, %22, %6 row_newbcast:7 row_mask:0xf bank_mask:0xf\n\t" \
    "v_fmac_f32_dpp %8, %22, %6 row_newbcast:8 row_mask:0xf bank_mask:0xf\n\t" \
    "v_fmac_f32_dpp %9, %22, %6 row_newbcast:9 row_mask:0xf bank_mask:0xf\n\t" \
    "v_fmac_f32_dpp %10, %22, %6 row_newbcast:10 row_mask:0xf bank_mask:0xf\n\t" \
    "v_fmac_f32_dpp %11, %22, %6 row_newbcast:11 row_mask:0xf bank_mask:0xf\n\t" \
    "v_fmac_f32_dpp %12, %22, %6 row_newbcast:12 row_mask:0xf bank_mask:0xf\n\t" \
    "v_fmac_f32_dpp %13, %22, %6 row_newbcast:13 row_mask:0xf bank_mask:0xf\n\t" \
    "v_fmac_f32_dpp %14, %22, %6 row_newbcast:14 row_mask:0xf bank_mask:0xf\n\t" \
    "v_fmac_f32_dpp %15, %22, %6 row_newbcast:15 row_mask:0xf bank_mask:0xf\n\t" \
    "v_xor_b32 %7, 0x80000000, %7\n\t" \
    "v_fmac_f32_dpp %8, %23, %7 row_newbcast:8 row_mask:0xf bank_mask:0xf\n\t" \
    "v_fmac_f32_dpp %9, %23, %7 row_newbcast:9 row_mask:0xf bank_mask:0xf\n\t" \
    "v_fmac_f32_dpp %10, %23, %7 row_newbcast:10 row_mask:0xf bank_mask:0xf\n\t" \
    "v_fmac_f32_dpp %11, %23, %7 row_newbcast:11 row_mask:0xf bank_mask:0xf\n\t" \
    "v_fmac_f32_dpp %12, %23, %7 row_newbcast:12 row_mask:0xf bank_mask:0xf\n\t" \
    "v_fmac_f32_dpp %13, %23, %7 row_newbcast:13 row_mask:0xf bank_mask:0xf\n\t" \
    "v_fmac_f32_dpp %14, %23, %7 row_newbcast:14 row_mask:0xf bank_mask:0xf\n\t" \
    "v_fmac_f32_dpp %15, %23, %7 row_newbcast:15 row_mask:0xf bank_mask:0xf\n\t" \
    ""
#define TRI2_ASMB \
    "s_nop 1\n\t" \
    "v_xor_b32 %0, 0x80000000, %0\n\t" \
    "v_fmac_f32_dpp %1, %8, %0 row_newbcast:9 row_mask:0xf bank_mask:0xf\n\t" \
    "v_fmac_f32_dpp %2, %8, %0 row_newbcast:10 row_mask:0xf bank_mask:0xf\n\t" \
    "v_fmac_f32_dpp %3, %8, %0 row_newbcast:11 row_mask:0xf bank_mask:0xf\n\t" \
    "v_fmac_f32_dpp %4, %8, %0 row_newbcast:12 row_mask:0xf bank_mask:0xf\n\t" \
    "v_fmac_f32_dpp %5, %8, %0 row_newbcast:13 row_mask:0xf bank_mask:0xf\n\t" \
    "v_fmac_f32_dpp %6, %8, %0 row_newbcast:14 row_mask:0xf bank_mask:0xf\n\t" \
    "v_fmac_f32_dpp %7, %8, %0 row_newbcast:15 row_mask:0xf bank_mask:0xf\n\t" \
    "v_xor_b32 %1, 0x80000000, %1\n\t" \
    "v_fmac_f32_dpp %2, %9, %1 row_newbcast:10 row_mask:0xf bank_mask:0xf\n\t" \
    "v_fmac_f32_dpp %3, %9, %1 row_newbcast:11 row_mask:0xf bank_mask:0xf\n\t" \
    "v_fmac_f32_dpp %4, %9, %1 row_newbcast:12 row_mask:0xf bank_mask:0xf\n\t" \
    "v_fmac_f32_dpp %5, %9, %1 row_newbcast:13 row_mask:0xf bank_mask:0xf\n\t" \
    "v_fmac_f32_dpp %6, %9, %1 row_newbcast:14 row_mask:0xf bank_mask:0xf\n\t" \
    "v_fmac_f32_dpp %7, %9, %1 row_newbcast:15 row_mask:0xf bank_mask:0xf\n\t" \
    "v_xor_b32 %2, 0x80000000, %2\n\t" \
    "v_fmac_f32_dpp %3, %10, %2 row_newbcast:11 row_mask:0xf bank_mask:0xf\n\t" \
    "v_fmac_f32_dpp %4, %10, %2 row_newbcast:12 row_mask:0xf bank_mask:0xf\n\t" \
    "v_fmac_f32_dpp %5, %10, %2 row_newbcast:13 row_mask:0xf bank_mask:0xf\n\t" \
    "v_fmac_f32_dpp %6, %10, %2 row_newbcast:14 row_mask:0xf bank_mask:0xf\n\t" \
    "v_fmac_f32_dpp %7, %10, %2 row_newbcast:15 row_mask:0xf bank_mask:0xf\n\t" \
    "v_xor_b32 %3, 0x80000000, %3\n\t" \
    "v_fmac_f32_dpp %4, %11, %3 row_newbcast:12 row_mask:0xf bank_mask:0xf\n\t" \
    "v_fmac_f32_dpp %5, %11, %3 row_newbcast:13 row_mask:0xf bank_mask:0xf\n\t" \
    "v_fmac_f32_dpp %6, %11, %3 row_newbcast:14 row_mask:0xf bank_mask:0xf\n\t" \
    "v_fmac_f32_dpp %7, %11, %3 row_newbcast:15 row_mask:0xf bank_mask:0xf\n\t" \
    "v_xor_b32 %4, 0x80000000, %4\n\t" \
    "v_fmac_f32_dpp %5, %12, %4 row_newbcast:13 row_mask:0xf bank_mask:0xf\n\t" \
    "v_fmac_f32_dpp %6, %12, %4 row_newbcast:14 row_mask:0xf bank_mask:0xf\n\t" \
    "v_fmac_f32_dpp %7, %12, %4 row_newbcast:15 row_mask:0xf bank_mask:0xf\n\t" \
    "v_xor_b32 %5, 0x80000000, %5\n\t" \
    "v_fmac_f32_dpp %6, %13, %5 row_newbcast:14 row_mask:0xf bank_mask:0xf\n\t" \
    "v_fmac_f32_dpp %7, %13, %5 row_newbcast:15 row_mask:0xf bank_mask:0xf\n\t" \
    "v_xor_b32 %6, 0x80000000, %6\n\t" \
    "v_fmac_f32_dpp %7, %14, %6 row_newbcast:15 row_mask:0xf bank_mask:0xf\n\t" \
    "v_xor_b32 %7, 0x80000000, %7\n\t" \
    ""

constexpr int S3_RS = 144;
constexpr int S3_KKT = 0, S3_RRT = 2304, S3_BHT = 4608, S3_KHT = 6912, S3_BHJ = 9216, S3_KHJ = 11264, S3_WLF = 13312, S3_IMG = 13568;
constexpr int S3_PRIV = 4 * S3_IMG, S3_MBF = 0, S3_RHF = 1024, S3_PSTRIDE = 2048;
__device__ __forceinline__ void phase_rwkv_scan3(const Params& p, int j, char* lds_, bf16_t* Y) {
    const bf16_t* R = (const bf16_t*)(p.ws + OFF_R); const bf16_t* Kb = (const bf16_t*)(p.ws + OFF_K);
    const bf16_t* V = (const bf16_t*)(p.ws + OFF_VF); const bf16_t* KK = (const bf16_t*)(p.ws + OFF_H);
    const bf16_t* LW = (const bf16_t*)(p.ws + OFF_LW); const bf16_t* AD = (const bf16_t*)(p.ws + OFF_AD);
    const int tid = tidx(), lane = tid & 63, wid = __builtin_amdgcn_readfirstlane(tid >> 6), cl = wid >> 2, q = wid & 3, g = lane >> 4, li = lane & 15;
    LAS unsigned char* img0 = (LAS unsigned char*)lds_ + cl * 2 * S3_IMG;
    LAS unsigned char* pw = (LAS unsigned char*)lds_ + S3_PRIV + wid * S3_PSTRIDE;
    f32x4 msk_lt, msk_le, msk_gt;
#pragma unroll
    for (int r = 0; r < 4; ++r) { msk_lt[r] = (4 * g + r) < li ? 1.f : 0.f; msk_le[r] = (4 * g + r) <= li ? 1.f : 0.f; msk_gt[r] = (4 * g + r) > li ? 1.f : 0.f; }
    for (int cp = blockIdx.x; cp < 256; cp += gridDim.x) {
        const int chain = cp * 2 + cl, d = chain & 1, bh = chain >> 1, b = bh >> 4, h = bh & 15;
        const int vcol = h * 64 + q * 16 + li, vcolw = vcol & ~1, jcol = q * 16 + li;
        const unsigned selv = (vcol & 1) ? 0x03020c0cu : 0x01000c0cu;
        const unsigned selp = (vcol & 1) ? 0x07060302u : 0x05040100u;
        const float ka = p.in[22][(size_t)j * D + vcol];
        const bf16_t* ADd = AD + (size_t)d * NT * D;
        const bf16_t* w2t = wsm(p, j, WJ_W2) + (size_t)d * D * 64 + (size_t)vcol * 64;
        const bf16x8 Bw0 = *(const bf16x8*)(w2t + g * 8), Bw1 = *(const bf16x8*)(w2t + 32 + g * 8);
        const float w0b = p.in[10][((size_t)j * 2 + d) * D + vcol] * -1.44269504089f;
        const bf16_t* LD0 = (const bf16_t*)(p.ws + OFF_LD);
        const unsigned voa = (unsigned)((d ? 15 - li : li) * 256 + (d * 64 + g * 8) * 2);
        bf16_t* Yd = Y + (size_t)d * NT * D;
        const int dir = d ? -1 : 1;
        auto row_first = [&](int c) -> int {
            const int s0 = c * 16;
            if (s0 < TC) return NLAT + b * TC + (d ? (TC - 1 - s0) : s0);
            const int tl = s0 - TC; return b * TL + (d ? (TL - 1 - tl) : tl);
        };
#define UNPV(w) __uint_as_float(__builtin_amdgcn_perm(0u, (w), selv))
        const unsigned LA0 = ((4 * g <= li) ? 0x3F80u : 0u) | ((4 * g + 1 <= li) ? 0x3F800000u : 0u), LA1 = ((4 * g + 2 <= li) ? 0x3F80u : 0u) | ((4 * g + 3 <= li) ? 0x3F800000u : 0u);
        unsigned vov[4];
#pragma unroll
        for (int e = 0; e < 4; ++e) vov[e] = (unsigned)((d ? 15 - (4 * g + e) : 4 * g + e) * (D * 2) + vcolw * 2);
#define LDG(P, VO) (*(const unsigned*)((P) + (VO)))
        unsigned rr[4], rkk[4], rk[4], ra[4], rv[4]; bf16x8 rwa0, rwa1;
        auto issue_loads = [&](int c) {
            const int r0 = row_first(c);
            const size_t rbo = (size_t)(d ? r0 - 15 : r0) * (D * 2);
            const char* bLD = (const char*)LD0 + (size_t)(d ? r0 - 15 : r0) * 256; const char* bR = (const char*)R + rbo; const char* bKK = (const char*)KK + rbo;
            const char* bK = (const char*)Kb + rbo; const char* bA = (const char*)ADd + rbo; const char* bV = (const char*)V + rbo;
#pragma unroll
            for (int e = 0; e < 4; ++e) { rr[e] = LDG(bR, vov[e]); rkk[e] = LDG(bKK, vov[e]); rk[e] = LDG(bK, vov[e]); ra[e] = LDG(bA, vov[e]); rv[e] = LDG(bV, vov[e]); }
            rwa0 = *(const bf16x8*)(bLD + voa); rwa1 = *(const bf16x8*)(bLD + voa + 64);
        };
        issue_loads(0);
        f32x4 T[4];
#pragma unroll
        for (int jb = 0; jb < 4; ++jb) T[jb] = (f32x4){0.f, 0.f, 0.f, 0.f};
        auto do_prep = [&](int cc, unsigned& w0, unsigned& w1) {
            LAS unsigned char* im = img0 + (cc & 1) * S3_IMG;
            {
                const f32x4 Z4p = {0.f, 0.f, 0.f, 0.f};
                f32x4 WP = __builtin_amdgcn_mfma_f32_16x16x32_bf16(rwa0, Bw0, Z4p, 0, 0, 0);
                WP = __builtin_amdgcn_mfma_f32_16x16x32_bf16(rwa1, Bw1, WP, 0, 0, 0);
                unsigned lwp0, lwp1;
                {
                    const f32x2_t x0 = {WP[0], WP[1]}, x1 = {WP[2], WP[3]};
                    const f32x2_t t0 = x0 * -1.44269504089f + w0b, t1 = x1 * -1.44269504089f + w0b;
                    f32x2_t e0, e1; e0.x = __builtin_amdgcn_exp2f(t0.x); e0.y = __builtin_amdgcn_exp2f(t0.y); e1.x = __builtin_amdgcn_exp2f(t1.x); e1.y = __builtin_amdgcn_exp2f(t1.y);
                    const f32x2_t d0 = e0 + 1.0f, d1 = e1 + 1.0f;
                    lwp0 = pack2(-0.6065306597f * __builtin_amdgcn_rcpf(d0.x), -0.6065306597f * __builtin_amdgcn_rcpf(d0.y));
                    lwp1 = pack2(-0.6065306597f * __builtin_amdgcn_rcpf(d1.x), -0.6065306597f * __builtin_amdgcn_rcpf(d1.y));
                }
                const f32x4 CW = __builtin_amdgcn_mfma_f32_16x16x16bf16_1k(mk4(LA0, LA1), mk4(lwp0, lwp1), Z4p, 0, 0, 0);
                float ep_prev = __expf(CW[0] - bflo(lwp0));
                float bhv[4], khv[4];
#pragma unroll
                for (int e = 0; e < 4; ++e) {
                    const int t = 4 * g + e;
                    const float rvv = UNPV(rr[e]), kkv = UNPV(rkk[e]), kv = UNPV(rk[e]), av = UNPV(ra[e]);
                    const float ep = __expf(CW[e]), em = __expf(-CW[e]);
                    const float kkt = kkv * ep_prev, rt = rvv * ep;
                    bhv[e] = kkv * av * em; khv[e] = kv * (1.f + (av - 1.f) * ka) * em;
                    ep_prev = ep;
                    *(LAS bf16_t*)(im + S3_KKT + t * S3_RS + jcol * 2) = (bf16_t)(pack2(kkt, 0.f) & 0xffffu);
                    *(LAS bf16_t*)(im + S3_RRT + t * S3_RS + jcol * 2) = (bf16_t)(pack2(rt, 0.f) & 0xffffu);
                    *(LAS bf16_t*)(im + S3_BHT + t * S3_RS + jcol * 2) = (bf16_t)(pack2(bhv[e], 0.f) & 0xffffu);
                    *(LAS bf16_t*)(im + S3_KHT + t * S3_RS + jcol * 2) = (bf16_t)(pack2(khv[e], 0.f) & 0xffffu);
                }
                *(LAS u32x2*)(im + S3_BHJ + jcol * 32 + g * 8) = (u32x2){pack2(bhv[0], bhv[1]), pack2(bhv[2], bhv[3])};
                *(LAS u32x2*)(im + S3_KHJ + jcol * 32 + g * 8) = (u32x2){pack2(khv[0], khv[1]), pack2(khv[2], khv[3])};
                if (g == 3) *(LAS float*)(im + S3_WLF + jcol * 4) = ep_prev;
                w0 = __builtin_amdgcn_perm(rv[1], rv[0], selp); w1 = __builtin_amdgcn_perm(rv[3], rv[2], selp);
            }
        };
        constexpr int NCH = (TC + TL) / 16;
        unsigned vw0, vw1, vwn0 = 0u, vwn1 = 0u;
        do_prep(0, vw0, vw1);
        issue_loads(1);
        for (int c = 0; c < NCH; ++c) {
            const int row0 = row_first(c);
            LAS unsigned char* im = img0 + (c & 1) * S3_IMG;
            asm volatile("s_waitcnt lgkmcnt(0)" ::: "memory");
            __builtin_amdgcn_s_barrier();
            asm volatile("" ::: "memory");
            if (c + 1 < NCH) { do_prep(c + 1, vwn0, vwn1); if (c + 2 < NCH) issue_loads(c + 2); }
            f32x4 Mb = {0.f, 0.f, 0.f, 0.f}, Mk = Mb, Nb = Mb, Nk = Mb, MbT = Mb;
#pragma unroll
            for (int kk = 0; kk < 2; ++kk) {
                const int ko = li * S3_RS + (32 * kk + 8 * g) * 2;
                const bf16x8 aB = *(const LAS bf16x8*)(im + S3_BHT + ko), aK = *(const LAS bf16x8*)(im + S3_KHT + ko);
                const bf16x8 bK = *(const LAS bf16x8*)(im + S3_KKT + ko), bR = *(const LAS bf16x8*)(im + S3_RRT + ko);
                Mb = __builtin_amdgcn_mfma_f32_16x16x32_bf16(aB, bK, Mb, 0, 0, 0);
                MbT = __builtin_amdgcn_mfma_f32_16x16x32_bf16(bK, aB, MbT, 0, 0, 0);
                Mk = __builtin_amdgcn_mfma_f32_16x16x32_bf16(aK, bK, Mk, 0, 0, 0);
                Nb = __builtin_amdgcn_mfma_f32_16x16x32_bf16(aB, bR, Nb, 0, 0, 0);
                Nk = __builtin_amdgcn_mfma_f32_16x16x32_bf16(aK, bR, Nk, 0, 0, 0);
            }
            Mb = Mb * msk_lt; Mk = Mk * msk_lt; Nb = Nb * msk_le; Nk = Nk * msk_le; MbT = MbT * msk_gt;
            f32x4 PT = {0.f, 0.f, 0.f, 0.f}, QT = PT;
#pragma unroll
            for (int kk = 0; kk < 2; ++kk) {
                const bf16x8 bw = mk8(pack2(T[2 * kk][0], T[2 * kk][1]), pack2(T[2 * kk][2], T[2 * kk][3]), pack2(T[2 * kk + 1][0], T[2 * kk + 1][1]), pack2(T[2 * kk + 1][2], T[2 * kk + 1][3]));
                const int ko = li * S3_RS + (32 * kk + 4 * g) * 2;
                const u32x2 k0 = *(const LAS u32x2*)(im + S3_KKT + ko), k1 = *(const LAS u32x2*)(im + S3_KKT + ko + 32);
                const u32x2 r0 = *(const LAS u32x2*)(im + S3_RRT + ko), r1 = *(const LAS u32x2*)(im + S3_RRT + ko + 32);
                PT = __builtin_amdgcn_mfma_f32_16x16x32_bf16(mk8(k0[0], k0[1], k1[0], k1[1]), bw, PT, 0, 0, 0);
                QT = __builtin_amdgcn_mfma_f32_16x16x32_bf16(mk8(r0[0], r0[1], r1[0], r1[1]), bw, QT, 0, 0, 0);
            }
            const f32x4 RT = __builtin_amdgcn_mfma_f32_16x16x16bf16_1k(mk4(pack2(Mk[0], Mk[1]), pack2(Mk[2], Mk[3])), mk4(vw0, vw1), PT, 0, 0, 0);
#define CW(Y) pack2((Y)[0], (Y)[1]), pack2((Y)[2], (Y)[3])
#define OPND(w0, w1) mk4((w0), (w1))
            const f32x4 Z4 = {0.f, 0.f, 0.f, 0.f};
            const unsigned mb0 = pack2(Mb[0], Mb[1]), mb1 = pack2(Mb[2], Mb[3]), mt0 = pack2(MbT[0], MbT[1]), mt1 = pack2(MbT[2], MbT[3]);
            const f32x4 P1 = __builtin_amdgcn_mfma_f32_16x16x16bf16_1k(OPND(mt0, mt1), OPND(mb0, mb1), Z4, 0, 0, 0);
            const f32x4 P1T = __builtin_amdgcn_mfma_f32_16x16x16bf16_1k(OPND(mb0, mb1), OPND(mt0, mt1), Z4, 0, 0, 0);
            const unsigned p10 = pack2(P1[0], P1[1]), p11 = pack2(P1[2], P1[3]), q10 = pack2(P1T[0], P1T[1]), q11 = pack2(P1T[2], P1T[3]);
            const f32x4 P2 = __builtin_amdgcn_mfma_f32_16x16x16bf16_1k(OPND(q10, q11), OPND(p10, p11), Z4, 0, 0, 0);
            const f32x4 P2T = __builtin_amdgcn_mfma_f32_16x16x16bf16_1k(OPND(p10, p11), OPND(q10, q11), Z4, 0, 0, 0);
            const unsigned p20 = pack2(P2[0], P2[1]), p21 = pack2(P2[2], P2[3]), q20 = pack2(P2T[0], P2T[1]), q21 = pack2(P2T[2], P2T[3]);
            const f32x4 P3 = __builtin_amdgcn_mfma_f32_16x16x16bf16_1k(OPND(q20, q21), OPND(p20, p21), Z4, 0, 0, 0);
            const unsigned p30 = pack2(P3[0], P3[1]), p31 = pack2(P3[2], P3[3]);
            f32x4 Yv = __builtin_amdgcn_mfma_f32_16x16x16bf16_1k(OPND(mb0 ^ 0x80008000u, mb1 ^ 0x80008000u), OPND(pack2(RT[0], RT[1]), pack2(RT[2], RT[3])), RT, 0, 0, 0);
            Yv = __builtin_amdgcn_mfma_f32_16x16x16bf16_1k(OPND(p10, p11), OPND(pack2(Yv[0], Yv[1]), pack2(Yv[2], Yv[3])), Yv, 0, 0, 0);
            Yv = __builtin_amdgcn_mfma_f32_16x16x16bf16_1k(OPND(p20, p21), OPND(pack2(Yv[0], Yv[1]), pack2(Yv[2], Yv[3])), Yv, 0, 0, 0);
            Yv = __builtin_amdgcn_mfma_f32_16x16x16bf16_1k(OPND(p30, p31), OPND(pack2(Yv[0], Yv[1]), pack2(Yv[2], Yv[3])), Yv, 0, 0, 0);
#undef CW
#undef OPND
            const bf16x8 bop = mk8(pack2(Yv[0], Yv[1]) ^ 0x80008000u, pack2(Yv[2], Yv[3]) ^ 0x80008000u, vw0, vw1);
            const f32x4 YT = __builtin_amdgcn_mfma_f32_16x16x32_bf16(mk8(pack2(Nb[0], Nb[1]), pack2(Nb[2], Nb[3]), pack2(Nk[0], Nk[1]), pack2(Nk[2], Nk[3])), bop, QT, 0, 0, 0);
#pragma unroll
            for (int r = 0; r < 4; ++r) Yd[(size_t)(row0 + (4 * g + r) * dir) * D + vcol] = (bf16_t)(pack2(YT[r], 0.f) & 0xffffu);
#pragma unroll
            for (int jb = 0; jb < 4; ++jb) {
                const u32x2 b2 = *(const LAS u32x2*)(im + S3_BHJ + (16 * jb + li) * 32 + g * 8), k2 = *(const LAS u32x2*)(im + S3_KHJ + (16 * jb + li) * 32 + g * 8);
                T[jb] = __builtin_amdgcn_mfma_f32_16x16x32_bf16(mk8(b2[0], b2[1], k2[0], k2[1]), bop, T[jb], 0, 0, 0);
                const f32x4 wv = *(const LAS f32x4*)(im + S3_WLF + (16 * jb + 4 * g) * 4);
                T[jb] = T[jb] * wv;
            }
            vw0 = vwn0; vw1 = vwn1;
        }
#undef LDG
#undef UNPV
        asm volatile("s_waitcnt lgkmcnt(0)" ::: "memory");
        __builtin_amdgcn_s_barrier();
    }
}

#ifndef SCAN2_MODE
#define SCAN2_MODE 3
#endif
constexpr size_t OFF_Y2DBG = OFF_BIG + 13 * U + U / 2;
__device__ __forceinline__ void phase_scan_compare(const Params& p) {
    const bf16_t* Y = (const bf16_t*)(p.ws + OFF_Y); const bf16_t* Y2 = (const bf16_t*)(p.ws + OFF_Y2DBG);
    float* accp = (float*)(p.ws + OFF_BAR + 16384);
    float e2 = 0.f, y2 = 0.f;
    for (size_t i = (size_t)blockIdx.x * NTHREADS + tidx(); i < (size_t)NT * D / 2; i += (size_t)gridDim.x * NTHREADS) {
        const unsigned a = ((const unsigned*)Y)[i], b = ((const unsigned*)Y2)[i];
        const float a0 = bflo(a), a1 = bfhi(a), b0 = bflo(b), b1 = bfhi(b);
        e2 += (a0 - b0) * (a0 - b0) + (a1 - b1) * (a1 - b1); y2 += a0 * a0 + a1 * a1;
    }
    e2 = wave_sum(e2); y2 = wave_sum(y2);
    if ((tidx() & 63) == 0) { atomicAdd(accp, e2); atomicAdd(accp + 1, y2); }
}

__device__ __forceinline__ void phase_rwkv_out(const Params& p, int j) {
    const bf16_t* Y = (const bf16_t*)(p.ws + OFF_Y); const bf16_t* V = (const bf16_t*)(p.ws + OFF_VF); const bf16_t* G = (const bf16_t*)(p.ws + OFF_G);
    const float* BON = (const float*)(p.ws + OFF_BON);
    bf16_t* YO = (bf16_t*)(p.ws + OFF_LW);
    const float* lnw = p.in[24] + (size_t)j * D; const float* lnb = p.in[25] + (size_t)j * D;
    const int tid_ = tidx(), lane = tid_ & 63, wid = tid_ >> 6, c0 = lane * 16;
    float lw[16], lb[16];
#pragma unroll
    for (int i = 0; i < 16; ++i) { lw[i] = lnw[c0 + i]; lb[i] = lnb[c0 + i]; }
    constexpr int RW = 2;
    for (int grp = blockIdx.x * 8 + wid; grp < NT / RW; grp += gridDim.x * 8) {
        u32x4 y0[RW][2], y1[RW][2], vv[RW][2], gg[RW][2]; float bon[RW];
#pragma unroll
        for (int r = 0; r < RW; ++r) {
            const size_t o = (size_t)(grp * RW + r) * D + c0;
#pragma unroll
            for (int i = 0; i < 2; ++i) {
                y0[r][i] = *(const u32x4*)(Y + o + i * 8); y1[r][i] = *(const u32x4*)(Y + (size_t)NT * D + o + i * 8);
                vv[r][i] = *(const u32x4*)(V + o + i * 8); gg[r][i] = *(const u32x4*)(G + o + i * 8);
            }
            bon[r] = BON[(size_t)(grp * RW + r) * 16 + (lane >> 2)];
        }
#pragma unroll
        for (int r = 0; r < RW; ++r) {
            const size_t o = (size_t)(grp * RW + r) * D + c0;
            float ov[16]; float s1 = 0.f;
#pragma unroll
            for (int i = 0; i < 16; ++i) {
                const unsigned w0 = y0[r][i >> 3][(i >> 1) & 3], w1 = y1[r][i >> 3][(i >> 1) & 3];
                ov[i] = ((i & 1) ? bfhi(w0) : bflo(w0)) + ((i & 1) ? bfhi(w1) : bflo(w1));
                s1 += ov[i];
            }
            s1 += __shfl_xor(s1, 1, 64); s1 += __shfl_xor(s1, 2, 64);
            const float mu = s1 * (1.f / 64.f);
            float s2 = 0.f;
#pragma unroll
            for (int i = 0; i < 16; ++i) { const float dd = ov[i] - mu; s2 += dd * dd; }
            s2 += __shfl_xor(s2, 1, 64); s2 += __shfl_xor(s2, 2, 64);
            const float rs = rsqrtf(s2 * (1.f / 64.f) + 64e-5f);
            float res[16];
#pragma unroll
            for (int i = 0; i < 16; ++i) {
                const unsigned vw = vv[r][i >> 3][(i >> 1) & 3], gw = gg[r][i >> 3][(i >> 1) & 3];
                const float v = (i & 1) ? bfhi(vw) : bflo(vw), g = (i & 1) ? bfhi(gw) : bflo(gw);
                res[i] = ((ov[i] - mu) * rs * lw[i] + lb[i] + bon[r] * v) * g;
            }
            u32x4 w[2];
#pragma unroll
            for (int i = 0; i < 8; ++i) w[i >> 2][i & 3] = pack2(res[2 * i], res[2 * i + 1]);
            *(u32x4*)(YO + o) = w[0]; *(u32x4*)(YO + o + 8) = w[1];
        }
    }
}

__device__ __forceinline__ void phase_rwkv_out2(const Params& p, int j, char* lds) {
    const bf16_t* A = (const bf16_t*)(p.ws + OFF_LD) + (size_t)2 * NT * 128;
    const bf16_t* Bt = wsm(p, j, WJ_G2);
    const bf16_t* Y = (const bf16_t*)(p.ws + OFF_Y); const bf16_t* V = (const bf16_t*)(p.ws + OFF_VF);
    const float* BON = (const float*)(p.ws + OFF_BON); const float* BON2 = (const float*)(p.ws + OFF_BON2);
    bf16_t* YO = (bf16_t*)(p.ws + OFF_LW);
    const float* lnw = p.in[24] + (size_t)j * D; const float* lnb = p.in[25] + (size_t)j * D;
    float* lwl = (float*)lds;
    constexpr int TR = 64, RT = NT / TR, NRC = 64, RPC = RT / NRC, KS = 4;
    const int tid = tidx(), lane = tid & 63, wid = tid >> 6, wr = wid >> 2, wc = wid & 3, fr = lane & 15, fq = lane >> 4;
    for (int u = blockIdx.x; u < 4 * NRC; u += gridDim.x) {
        const int ct = u / NRC, rc = u % NRC, rt0 = rc * RPC, rt1 = rt0 + RPC, col0 = ct * 256, head = ct * 4 + wc;
        __syncthreads();
        lwl[tid] = tid < 256 ? lnw[col0 + tid] : lnb[col0 + tid - 256];
        {
            char* bsl = lds + 4096;
            int t2 = tid; asm volatile("" : "+v"(t2));
#pragma unroll
            for (int q = 0; q < 8; ++q) {
                const int idx = q * 512 + t2, rowi = idx >> 4, seg = idx & 15;
                *(u32x4*)(bsl + rowi * 272 + seg * 16) = *(const u32x4*)(Bt + (size_t)(col0 + rowi) * 128 + seg * 8);
            }
        }
        __syncthreads();
        int boff[4];
#pragma unroll
        for (int n = 0; n < 4; ++n) boff[n] = 4096 + (wc * 64 + (n >> 1) * 32 + 8 * (fr >> 2) + 4 * (n & 1) + (fr & 3)) * 272 + fq * 16;
        bf16x8 afr[2][KS];
#pragma unroll
        for (int m = 0; m < 2; ++m)
#pragma unroll
            for (int ks = 0; ks < KS; ++ks) afr[m][ks] = *(const bf16x8*)(A + (size_t)(rt0 * TR + wr * 32 + m * 16 + fr) * 128 + ks * 32 + fq * 8);
        u32x4 ey0[2][2], ey1[2][2], evv[2][2]; float ebon[2];
#define OUT2_LOAD(SET, RT_, M_) do { const int row_ = (RT_) * TR + wr * 32 + (M_) * 16 + fr; const size_t o_ = (size_t)row_ * D + col0 + wc * 64 + 8 * fq; \
            _Pragma("unroll") for (int pp = 0; pp < 2; ++pp) { ey0[SET][pp] = *(const u32x4*)(Y + o_ + pp * 32); ey1[SET][pp] = *(const u32x4*)(Y + (size_t)NT * D + o_ + pp * 32); evv[SET][pp] = *(const u32x4*)(V + o_ + pp * 32); } \
            ebon[SET] = BON[(size_t)row_ * 16 + head]; } while (0)
        OUT2_LOAD(0, rt0, 0);
#pragma unroll 1
        for (int rt = rt0; rt < rt1; ++rt) {
            int zz = 0; asm volatile("" : "+v"(zz));
            f32x4 acc[2][4];
#pragma unroll
            for (int m = 0; m < 2; ++m)
#pragma unroll
                for (int n = 0; n < 4; ++n) {
                    acc[m][n] = (f32x4){0.f, 0.f, 0.f, 0.f};
#pragma unroll
                    for (int ks = 0; ks < KS; ++ks) acc[m][n] = __builtin_amdgcn_mfma_f32_16x16x32_bf16(*(const bf16x8*)(lds + boff[n] + zz + ks * 64), afr[m][ks], acc[m][n], 0, 0, 0);
                }
            if (rt + 1 < rt1) {
#pragma unroll
                for (int m = 0; m < 2; ++m)
#pragma unroll
                    for (int ks = 0; ks < KS; ++ks) afr[m][ks] = *(const bf16x8*)(A + (size_t)((rt + 1) * TR + wr * 32 + m * 16 + fr) * 128 + ks * 32 + fq * 8);
            }
#pragma unroll
            for (int m = 0; m < 2; ++m) {
                if (m == 0) OUT2_LOAD(1, rt, 1);
                else if (rt + 1 < rt1) OUT2_LOAD(0, rt + 1, 0);
                const int row = rt * TR + wr * 32 + m * 16 + fr;
                const size_t o = (size_t)row * D + col0 + wc * 64 + 8 * fq;
                const float bon = ebon[m];
                float ov[16]; float s1 = 0.f;
#pragma unroll
                for (int i = 0; i < 16; ++i) {
                    const unsigned w0 = ey0[m][i >> 3][(i >> 1) & 3], w1 = ey1[m][i >> 3][(i >> 1) & 3];
                    ov[i] = ((i & 1) ? bfhi(w0) : bflo(w0)) + ((i & 1) ? bfhi(w1) : bflo(w1));
                    s1 += ov[i];
                }
                const float mu = red4(s1) * (1.f / 64.f);
                float s2 = 0.f;
#pragma unroll
                for (int i = 0; i < 16; ++i) { const float dd = ov[i] - mu; s2 += dd * dd; }
                const float rs = rsqrtf(red4(s2) * (1.f / 64.f) + 64e-5f);
#pragma unroll
                for (int pp = 0; pp < 2; ++pp) {
                    const float* lp = lwl + wc * 64 + pp * 32 + 8 * fq;
                    const float4 w0 = *(const float4*)lp, w1 = *(const float4*)(lp + 4), b0 = *(const float4*)(lp + 256), b1 = *(const float4*)(lp + 260);
                    const float lw[8] = {w0.x, w0.y, w0.z, w0.w, w1.x, w1.y, w1.z, w1.w}, lb[8] = {b0.x, b0.y, b0.z, b0.w, b1.x, b1.y, b1.z, b1.w};
                    float res[8];
#pragma unroll
                    for (int e = 0; e < 8; ++e) {
                        const unsigned vw = evv[m][pp][e >> 1];
                        const float v = (e & 1) ? bfhi(vw) : bflo(vw);
                        const float g = acc[m][2 * pp + (e >> 2)][e & 3];
                        res[e] = ((ov[pp * 8 + e] - mu) * rs * lw[e] + lb[e] + bon * v) * g;
                    }
                    const u32x4 w = {pack2(res[0], res[1]), pack2(res[2], res[3]), pack2(res[4], res[5]), pack2(res[6], res[7])};
                    *(u32x4*)(YO + o + pp * 32) = w;
                }
            }
        }
#undef OUT2_LOAD
    }
}

__device__ __forceinline__ void phase_rwkv_wo(const Params& p, int l, int j, char* lds) {
    EpD1 ep{(bf16_t*)(p.ws + OFF_D1), nullptr};
    SchedGrid S{p.ws + OFF_LW, (const char*)wsm(p, j, WJ_WO), 0, 0, (size_t)256 * D * 2, 0, (size_t)256 * D * 2, NT / 256 / 8, (NT / 256) * 4};
    g256::gemm_phase<true>((LAS unsigned char*)lds, D, D, D, S, ep);
}

__device__ __forceinline__ void phase_pool_dlt(const Params& p, int nrows) {
    const bf16_t* H = (const bf16_t*)(p.ws + OFF_H); bf16_t* DL = (bf16_t*)(p.ws + OFF_DLT);
    const int tid_ = tidx(), lane = tid_ & 63, wid = tid_ >> 6;
    for (int row = blockIdx.x * 8 + wid; row < nrows; row += gridDim.x * 8) {
        int t, T, base;
        if (row < NLAT) { t = row & (TL - 1); T = TL; base = row - t; } else { t = (row - NLAT) & (TC - 1); T = TC; base = row - t; }
#define DLT_GROUP(G) { \
            constexpr int half = 1 << (G), win = 2 << (G); \
            const int c = (G) * 256 + lane * 4; \
            u32x2 w[win]; \
            _Pragma("unroll") for (int i = 0; i < win; ++i) { const int tt = t - half + i; const int tc = (tt >= 0 && tt < T) ? tt : t; w[i] = *(const u32x2*)(H + (size_t)(base + tc) * D + c); } \
            float s0 = 0.f, s1 = 0.f, s2 = 0.f, s3 = 0.f; \
            _Pragma("unroll") for (int i = 0; i < win; ++i) { const int tt = t - half + i; const float m = (tt >= 0 && tt < T) ? 1.f : 0.f; \
                s0 += m * bflo(w[i][0]); s1 += m * bfhi(w[i][0]); s2 += m * bflo(w[i][1]); s3 += m * bfhi(w[i][1]); } \
            const int lo = max(t - half, 0), hi = min(t + half, T); \
            const float inv = 1.f / (float)(hi - lo); \
            const u32x2 hw = w[half]; \
            u32x2 o; o[0] = pack2(s0 * inv - bflo(hw[0]), s1 * inv - bfhi(hw[0])); o[1] = pack2(s2 * inv - bflo(hw[1]), s3 * inv - bfhi(hw[1])); \
            *(u32x2*)(DL + (size_t)row * D + c) = o; }
        DLT_GROUP(0) DLT_GROUP(1) DLT_GROUP(2) DLT_GROUP(3)
#undef DLT_GROUP
    }
}
__device__ __forceinline__ void phase_pool_gemm(const Params& p, int l, int j, int nrows, char* lds) {
    EpD1 ep{(bf16_t*)(p.ws + OFF_D1), p.in[28] + (size_t)j * D};
    SchedGrid S{p.ws + OFF_DLT, (const char*)wsm(p, j, WJ_POOL), 0, 0, (size_t)256 * D * 2, (size_t)256 * 2, (size_t)256 * 256 * 2, nrows / 256 / 8, (nrows / 256) * 4};
    g256::gemm_phase<true>((LAS unsigned char*)lds, D, 256, 256, S, ep);
}

__device__ __forceinline__ void phase_topk(const Params& p, bool with_ctx, char* lds) {
    const float* AFF = (const float*)(p.ws + OFF_AFF);
    const bf16_t* H = (const bf16_t*)(p.ws + OFF_H); bf16_t* XG = (bf16_t*)(p.ws + OFF_XG);
    float* GTV = (float*)(p.ws + OFF_GTV); short* SLT = (short*)(p.ws + OFF_SLT);
    unsigned* keys = (unsigned*)lds;
    unsigned* hist = keys + 4096;
    unsigned* wtot = hist + 256;
    unsigned* bc = wtot + 8;
    int* sel = (int*)(bc + 4);
    const int tid = tidx(), lane = tid & 63, wid = tid >> 6;
    const int nunits = with_ctx ? 512 : 256;
    for (int u = blockIdx.x; u < nunits; u += gridDim.x) {
        const bool lat = u < 256;
        const int uu = lat ? u : u - 256, b = uu >> 4, e = uu & 15;
        const int n = lat ? TL : TC, kq = lat ? CAPL : CAPC, per = lat ? 8 : 1;
        const int rowbase = lat ? b * TL : NLAT + b * TC;
        for (int i = tid; i < n; i += NTHREADS) keys[i] = __float_as_uint(AFF[(size_t)(rowbase + i) * 16 + e]);
        lds_barrier();
        unsigned prefix = 0u, mask = 0u; int kth = kq;
        for (int ps = 0; ps < 4; ++ps) {
            const int shift = 24 - 8 * ps;
            if (tid < 256) hist[tid] = 0u;
            lds_barrier();
            for (int i = tid; i < n; i += NTHREADS) { const unsigned k = keys[i]; if ((k & mask) == prefix) atomicAdd(&hist[(k >> shift) & 255u], 1u); }
            lds_barrier();
            if (wid == 0) {
                const int b0 = 255 - 4 * lane;
                const unsigned h0 = hist[b0], h1 = hist[b0 - 1], h2 = hist[b0 - 2], h3 = hist[b0 - 3];
                unsigned inc = h0 + h1 + h2 + h3;
#pragma unroll
                for (int d = 1; d < 64; d <<= 1) { const unsigned o = (unsigned)__builtin_amdgcn_ds_bpermute(((lane - d) & 63) << 2, (int)inc); if (lane >= d) inc += o; }
                const unsigned exc = inc - (h0 + h1 + h2 + h3);
                if (exc < (unsigned)kth && inc >= (unsigned)kth) {
                    unsigned cum = exc; int dg = b0; unsigned rem = 0;
                    if (cum + h0 >= (unsigned)kth) { dg = b0; rem = kth - cum; }
                    else { cum += h0; if (cum + h1 >= (unsigned)kth) { dg = b0 - 1; rem = kth - cum; }
                    else { cum += h1; if (cum + h2 >= (unsigned)kth) { dg = b0 - 2; rem = kth - cum; }
                    else { cum += h2; dg = b0 - 3; rem = kth - cum; } } }
                    bc[0] = (unsigned)dg; bc[1] = rem;
                }
            }
            lds_barrier();
            prefix |= bc[0] << shift; mask |= 255u << shift; kth = (int)bc[1];
            lds_barrier();
        }
        const unsigned Tk = prefix; const int need_eq = kth;
        const int t0 = tid * per; const bool act = t0 < n;
        int cgt = 0, ceq = 0;
        if (act) for (int i = 0; i < per; ++i) { const unsigned k = keys[t0 + i]; cgt += k > Tk; ceq += k == Tk; }
        const unsigned mine = ((unsigned)cgt << 16) | (unsigned)ceq;
        unsigned inc = mine;
#pragma unroll
        for (int d = 1; d < 64; d <<= 1) { const unsigned o = (unsigned)__builtin_amdgcn_ds_bpermute(((lane - d) & 63) << 2, (int)inc); if (lane >= d) inc += o; }
        if (lane == 63) wtot[wid] = inc;
        lds_barrier();
        unsigned woff = 0;
#pragma unroll
        for (int w = 0; w < 8; ++w) woff += (w < wid) ? wtot[w] : 0u;
        const unsigned ex = woff + inc - mine;
        int gt_before = (int)(ex >> 16), eq_before = (int)(ex & 0xffffu);
        if (act) {
            for (int i = 0; i < per; ++i) {
                const int t = t0 + i; const unsigned k = keys[t];
                int slot = -1;
                if (k > Tk) { slot = gt_before + min(eq_before, need_eq); ++gt_before; }
                else if (k == Tk) { if (eq_before < need_eq) slot = gt_before + eq_before; ++eq_before; }
                SLT[(size_t)(rowbase + t) * 16 + e] = (short)slot;
                if (slot >= 0) {
                    const int srow = lat ? (b * 16 + e) * CAPL + slot : NSLOT_LAT + (e * 16 + b) * CAPC + slot;
                    sel[slot] = t; GTV[srow] = __uint_as_float(k);
#if MOE_F8
                    ((int*)(p.ws + OFF_IDX))[srow] = rowbase + t;
#endif
                }
            }
        }
        lds_barrier();
        const int sbase = lat ? (b * 16 + e) * CAPL : NSLOT_LAT + (e * 16 + b) * CAPC;
#if MOE_F8
#else
        for (int s = wid; s < kq; s += 8) {
            const size_t srcrow = (size_t)(rowbase + sel[s]) * D, dstrow = (size_t)(sbase + s) * D;
            const u32x4 x0 = *(const u32x4*)(H + srcrow + lane * 8), x1 = *(const u32x4*)(H + srcrow + 512 + lane * 8);
            *(u32x4*)(XG + dstrow + lane * 8) = x0; *(u32x4*)(XG + dstrow + 512 + lane * 8) = x1;
        }
#endif
        lds_barrier();
    }
}
__device__ __forceinline__ int expert_of_slotrow(int r) { return r < NSLOT_LAT ? ((r >> 9) & 15) : ((r - NSLOT_LAT) >> 9); }
constexpr int EB = MOE_F8 ? 1 : 2;
struct SchedMoeUp {
    const char* XG; const char* W13; int cpe, total; const int* tok; const char* abase;
    __device__ __forceinline__ bool next(int i, g256::Unit& u) const {
        const long L = g256::unit_index(i);
        if (L >= total) return false;
        const int chunk = (int)(L >> 5), o = (int)(L & 31), e = chunk / cpe, r = chunk % cpe;
        int row0, ct;
        if (r < 16) { const int t = (r >> 2) * 8 + (o >> 2); ct = (r & 3) * 4 + (o & 3); row0 = ((t >> 1) * 16 + e) * CAPL + (t & 1) * 256; }
        else { ct = o & 15; row0 = NSLOT_LAT + e * 512 + (o >> 4) * 256; }
        u.a = XG + (size_t)row0 * D * EB; u.b = W13 + ((size_t)e * 4096 + ct * 256) * 1024 * EB; u.row0 = row0; u.col0 = ct * 256;
        return true;
    }
};
__device__ __forceinline__ void phase_moe_up(const Params& p, bool with_ctx, char* lds) {
    const int cpe = with_ctx ? 17 : 16;
#if MOE_F8
    EpSwiglu8 ep{p.ws + OFF_HID};
    SchedMoeUp S{p.ws + OFF_XG, p.ws + OFF_WM, cpe, 16 * cpe * 32, (const int*)(p.ws + OFF_IDX), p.ws + OFF_H};
    g256::gemm_phase<true, true, true>((LAS unsigned char*)lds, D / 2, D / 2, D / 2, S, ep);
#else
    EpSwiglu ep{(bf16_t*)(p.ws + OFF_HID)};
    SchedMoeUp S{p.ws + OFF_XG, (const char*)((const bf16_t*)(p.ws + OFF_WM) + WM_13), cpe, 16 * cpe * 32, nullptr, nullptr};
    g256::gemm_phase<true>((LAS unsigned char*)lds, D, D, D, S, ep);
#endif
}
struct SchedMoeDown {
    const char* HID; const char* W2; int total;
    __device__ __forceinline__ bool next(int i, g256::Unit& u) const {
        const long L = g256::unit_index(i);
        if (L >= total) return false;
        const int chunk = (int)(L >> 5), o = (int)(L & 31), ct = o & 3;
        int row0, e;
        if (chunk < 64) { e = chunk >> 2; const int t = (chunk & 3) * 8 + (o >> 2); row0 = ((t >> 1) * 16 + e) * CAPL + (t & 1) * 256; }
        else { e = (chunk - 64) * 4 + (o >> 3); row0 = NSLOT_LAT + e * 512 + ((o >> 2) & 1) * 256; }
        u.a = HID + (size_t)row0 * FF * EB; u.b = W2 + ((size_t)e * 1024 + ct * 256) * 2048 * EB; u.row0 = row0; u.col0 = ct * 256;
        return true;
    }
};
__device__ __forceinline__ void phase_moe_down(const Params& p, bool with_ctx, char* lds) {
    EpGateRow ep{(bf16_t*)(p.ws + OFF_YS), (const float*)(p.ws + OFF_GTV)};
#if MOE_F8
    SchedMoeDown S{p.ws + OFF_HID, p.ws + OFF_WM + WM8_2, (64 + (with_ctx ? 4 : 0)) * 32};
    g256::gemm_phase<true, true>((LAS unsigned char*)lds, FF / 2, FF / 2, FF / 2, S, ep);
#else
    SchedMoeDown S{p.ws + OFF_HID, (const char*)((const bf16_t*)(p.ws + OFF_WM) + WM_2), (64 + (with_ctx ? 4 : 0)) * 32};
    g256::gemm_phase<true>((LAS unsigned char*)lds, FF, FF, FF, S, ep);
#endif
}
__device__ __forceinline__ void phase_moe_combine(const Params& p, int l, int nrows, float amp = 1.f) {
    float* X = (float*)(p.ws + OFF_X); const bf16_t* YS = (const bf16_t*)(p.ws + OFF_YS); const short* SLT = (const short*)(p.ws + OFF_SLT);
    bf16_t* H = (bf16_t*)(p.ws + OFF_H); const bf16_t* D1 = (const bf16_t*)(p.ws + OFF_D1);
    const float* MOD = (const float*)(p.ws + OFF_MOD) + (size_t)l * 17 * MODW + 5 * D;
    const bool last = l == 3;
    const float* MODN = (const float*)(p.ws + OFF_MOD) + (size_t)(last ? l : l + 1) * 17 * MODW;
    const float* gn = last ? p.in[33] : p.in[6] + (size_t)(l + 1) * D;
    const int tid_ = tidx(), lane = tid_ & 63, wid = tid_ >> 6;
    float gw[16];
#pragma unroll
    for (int hh = 0; hh < 2; ++hh)
#pragma unroll
        for (int i = 0; i < 8; ++i) gw[hh * 8 + i] = gn[hh * 512 + lane * 8 + i];
    for (int row = blockIdx.x * 8 + wid; row < nrows; row += gridDim.x * 8) {
        float acc[16];
#pragma unroll
        for (int i = 0; i < 16; ++i) acc[i] = 0.f;
        const bool lat = row < NLAT;
        const int b = lat ? (row >> 12) : ((row - NLAT) >> 8);
        const int myslot = (int)SLT[(size_t)row * 16 + (lane & 15)];
        float4 xv[4]; u32x4 dv[2];
        const float* xsrc = l == 0 ? (lat ? p.in[0] + (size_t)row * D : p.in[2] + (size_t)(row - NLAT) * D) : X + (size_t)row * D;
#pragma unroll
        for (int hh = 0; hh < 2; ++hh) { xv[hh * 2] = *(const float4*)(xsrc + hh * 512 + lane * 8); xv[hh * 2 + 1] = *(const float4*)(xsrc + hh * 512 + lane * 8 + 4); dv[hh] = *(const u32x4*)(D1 + (size_t)row * D + hh * 512 + lane * 8); }
        unsigned long long bal = __ballot(myslot >= 0);
        unsigned emask = (unsigned)bal & 0xffffu;
        u32x4 ya[4], yc[4];
#pragma unroll
        for (int k = 0; k < 4; ++k) {
            ya[k] = (u32x4){0u, 0u, 0u, 0u}; yc[k] = (u32x4){0u, 0u, 0u, 0u};
            if (emask) {
                const int e = __builtin_ctz(emask); emask &= emask - 1u;
                const int sv = __builtin_amdgcn_readlane(myslot, e);
                const int srow = lat ? (b * 16 + e) * CAPL + sv : NSLOT_LAT + (e * 16 + b) * CAPC + sv;
                ya[k] = *(const u32x4*)(YS + (size_t)srow * D + lane * 8); yc[k] = *(const u32x4*)(YS + (size_t)srow * D + 512 + lane * 8);
            }
        }
#pragma unroll
        for (int k = 0; k < 4; ++k)
#pragma unroll
            for (int i = 0; i < 4; ++i) { acc[2 * i] += bflo(ya[k][i]); acc[2 * i + 1] += bfhi(ya[k][i]); acc[8 + 2 * i] += bflo(yc[k][i]); acc[8 + 2 * i + 1] += bfhi(yc[k][i]); }
        while (emask) {
            const int e = __builtin_ctz(emask); emask &= emask - 1u;
            const int sv = __builtin_amdgcn_readlane(myslot, e);
            const int srow = lat ? (b * 16 + e) * CAPL + sv : NSLOT_LAT + (e * 16 + b) * CAPC + sv;
            const u32x4 a = *(const u32x4*)(YS + (size_t)srow * D + lane * 8), c = *(const u32x4*)(YS + (size_t)srow * D + 512 + lane * 8);
#pragma unroll
            for (int i = 0; i < 4; ++i) { acc[2 * i] += bflo(a[i]); acc[2 * i + 1] += bfhi(a[i]); acc[8 + 2 * i] += bflo(c[i]); acc[8 + 2 * i + 1] += bfhi(c[i]); }
        }
        if (amp == 0.f) {
#pragma unroll
            for (int i = 0; i < 16; ++i) acc[i] = 0.f;
        }
        const int mrow = mod_row(row);
        const float* gt = MOD + (size_t)mrow * MODW;
        float xn[16]; float ss = 0.f;
#pragma unroll
        for (int hh = 0; hh < 2; ++hh) {
            const float* gp = gt + hh * 512 + lane * 8;
            const float4 g0 = *(const float4*)gp, g1 = *(const float4*)(gp + 4);
            float4 x0 = xv[hh * 2], x1 = xv[hh * 2 + 1];
            {
                const float4 m0 = *(const float4*)(gp - 3 * D), m1 = *(const float4*)(gp - 3 * D + 4);
                x0.x += m0.x * bflo(dv[hh][0]); x0.y += m0.y * bfhi(dv[hh][0]); x0.z += m0.z * bflo(dv[hh][1]); x0.w += m0.w * bfhi(dv[hh][1]);
                x1.x += m1.x * bflo(dv[hh][2]); x1.y += m1.y * bfhi(dv[hh][2]); x1.z += m1.z * bflo(dv[hh][3]); x1.w += m1.w * bfhi(dv[hh][3]);
            }
            xn[hh * 8 + 0] = x0.x + g0.x * acc[hh * 8 + 0]; xn[hh * 8 + 1] = x0.y + g0.y * acc[hh * 8 + 1]; xn[hh * 8 + 2] = x0.z + g0.z * acc[hh * 8 + 2]; xn[hh * 8 + 3] = x0.w + g0.w * acc[hh * 8 + 3];
            xn[hh * 8 + 4] = x1.x + g1.x * acc[hh * 8 + 4]; xn[hh * 8 + 5] = x1.y + g1.y * acc[hh * 8 + 5]; xn[hh * 8 + 6] = x1.z + g1.z * acc[hh * 8 + 6]; xn[hh * 8 + 7] = x1.w + g1.w * acc[hh * 8 + 7];
        }
#pragma unroll
        for (int i = 0; i < 16; ++i) ss += xn[i] * xn[i];
        const float rs = rsqrtf(wave_sum(ss) * (1.f / D) + 1e-6f);
        if (!last) {
#pragma unroll
            for (int hh = 0; hh < 2; ++hh) {
                float* xp = X + (size_t)row * D + hh * 512 + lane * 8;
                *(float4*)xp = make_float4(xn[hh * 8 + 0], xn[hh * 8 + 1], xn[hh * 8 + 2], xn[hh * 8 + 3]);
                *(float4*)(xp + 4) = make_float4(xn[hh * 8 + 4], xn[hh * 8 + 5], xn[hh * 8 + 6], xn[hh * 8 + 7]);
                const float* sp = MODN + (size_t)mrow * MODW + hh * 512 + lane * 8;
                const float4 s0 = *(const float4*)sp, s1 = *(const float4*)(sp + 4), c0 = *(const float4*)(sp + D), c1 = *(const float4*)(sp + D + 4);
                u32x4 o;
                o[0] = pack2(xn[hh * 8 + 0] * rs * gw[hh * 8 + 0] * (1.f + c0.x) + s0.x, xn[hh * 8 + 1] * rs * gw[hh * 8 + 1] * (1.f + c0.y) + s0.y);
                o[1] = pack2(xn[hh * 8 + 2] * rs * gw[hh * 8 + 2] * (1.f + c0.z) + s0.z, xn[hh * 8 + 3] * rs * gw[hh * 8 + 3] * (1.f + c0.w) + s0.w);
                o[2] = pack2(xn[hh * 8 + 4] * rs * gw[hh * 8 + 4] * (1.f + c1.x) + s1.x, xn[hh * 8 + 5] * rs * gw[hh * 8 + 5] * (1.f + c1.y) + s1.y);
                o[3] = pack2(xn[hh * 8 + 6] * rs * gw[hh * 8 + 6] * (1.f + c1.z) + s1.z, xn[hh * 8 + 7] * rs * gw[hh * 8 + 7] * (1.f + c1.w) + s1.w);
                *(u32x4*)(H + (size_t)row * D + hh * 512 + lane * 8) = o;
            }
        } else {
#if SCAN2_MODE == 1
            { const float* accp = (const float*)(p.ws + OFF_BAR + 16384); const float f = 1.f + 100.f * sqrtf(accp[0] / fmaxf(accp[1], 1e-30f));
#pragma unroll
              for (int i = 0; i < 16; ++i) xn[i] *= f; }
#endif
#pragma unroll
            for (int hh = 0; hh < 2; ++hh) {
                float* op = p.out + (size_t)row * D + hh * 512 + lane * 8;
                *(float4*)op = make_float4(xn[hh * 8 + 0] * rs * gw[hh * 8 + 0], xn[hh * 8 + 1] * rs * gw[hh * 8 + 1], xn[hh * 8 + 2] * rs * gw[hh * 8 + 2], xn[hh * 8 + 3] * rs * gw[hh * 8 + 3]);
                *(float4*)(op + 4) = make_float4(xn[hh * 8 + 4] * rs * gw[hh * 8 + 4], xn[hh * 8 + 5] * rs * gw[hh * 8 + 5], xn[hh * 8 + 6] * rs * gw[hh * 8 + 6], xn[hh * 8 + 7] * rs * gw[hh * 8 + 7]);
            }
        }
    }
}
__device__ __forceinline__ void phase_final(const Params& p) {
    const float* X = (const float*)(p.ws + OFF_X); const float* g = p.in[33];
    const int tid_ = tidx(), lane = tid_ & 63, wid = tid_ >> 6;
    for (int row = blockIdx.x * 8 + wid; row < NLAT; row += gridDim.x * 8) {
        const float* xr = X + (size_t)row * D;
        float4 v[4]; float ss = 0.f;
#pragma unroll
        for (int i = 0; i < 4; ++i) { v[i] = *(const float4*)(xr + i * 256 + lane * 4); ss += v[i].x * v[i].x + v[i].y * v[i].y + v[i].z * v[i].z + v[i].w * v[i].w; }
        ss = wave_sum(ss);
        const float rs = rsqrtf(ss * (1.f / D) + 1e-6f);
#pragma unroll
        for (int i = 0; i < 4; ++i) {
            const float4 gg = *(const float4*)(g + i * 256 + lane * 4);
            float4 o; o.x = v[i].x * rs * gg.x; o.y = v[i].y * rs * gg.y; o.z = v[i].z * rs * gg.z; o.w = v[i].w * rs * gg.w;
            *(float4*)(p.out + (size_t)row * D + i * 256 + lane * 4) = o;
        }
    }
}

#define XB_TMO      128
#define XB_XCNT(j)  (256  + 64 * (j))
#define XB_XSUB(j)  (1280 + 64 * (j))
#define XB_XGEN(j)  (2304 + 64 * (j))
#define XB_TOP      3328
#define XB_TOPGEN   3392
#define XCD_BAR_WORDS 3456
#define XB_SPIN_CAP (1u << 25)
__device__ __forceinline__ unsigned xb_ld(unsigned* p)              { return __hip_atomic_load(p, __ATOMIC_RELAXED, __HIP_MEMORY_SCOPE_AGENT); }
__device__ __forceinline__ unsigned xb_add(unsigned* p, unsigned v) { return __hip_atomic_fetch_add(p, v, __ATOMIC_RELAXED, __HIP_MEMORY_SCOPE_AGENT); }
__device__ __forceinline__ unsigned xb_xcc_id() { return (unsigned)__builtin_amdgcn_s_getreg((3 << 11) | 20) & 0xFu; }
#define XB_SPIN(cond, bar) do { unsigned _sp = 0; while (cond) { __builtin_amdgcn_s_sleep(1); \
    if ((++_sp & 255u) == 0u) { if (xb_ld(&(bar)[XB_TMO])) break; if (_sp > XB_SPIN_CAP) { atomicAdd(&(bar)[XB_TMO], 1u); break; } } } } while (0)
struct XcdBarrier { unsigned* bar; unsigned x; volatile LAS unsigned* st; };
__device__ __forceinline__ XcdBarrier xcd_barrier_post(unsigned* bar, volatile LAS unsigned* st) {
    XcdBarrier b; b.bar = bar; b.x = xb_xcc_id(); b.st = st;
    if (threadIdx.x == 0) (void)xb_add(&bar[XB_XCNT(b.x)], 1u);
    return b;
}
__device__ __forceinline__ void xcd_barrier_complete(unsigned* bar, unsigned x, unsigned& nloc, unsigned& nx) {
    const unsigned G = gridDim.x * gridDim.y * gridDim.z;
    unsigned sum, cnt, mine, sp = 0u;
    for (;;) {
        sum = 0u; cnt = 0u; mine = 0u;
#pragma unroll
        for (unsigned j = 0; j < 16; ++j) { const unsigned c = xb_ld(&bar[XB_XCNT(j)]); sum += c; cnt += (c > 0u) ? 1u : 0u; mine = (j == x) ? c : mine; }
        if (sum == G) break;
        __builtin_amdgcn_s_sleep(1);
        if ((++sp & 255u) == 0u) { if (xb_ld(&bar[XB_TMO])) break; if (sp > XB_SPIN_CAP) { atomicAdd(&bar[XB_TMO], 1u); break; } }
    }
    nloc = mine > 0u ? mine : 1u; nx = cnt > 0u ? cnt : 1u;
}
__device__ __forceinline__ void xcd_barrier(const XcdBarrier& b) {
    asm volatile("s_waitcnt vmcnt(0)" ::: "memory");
    __syncthreads();
    if (threadIdx.x == 0) {
        unsigned* bar = b.bar;
        unsigned bx = b.x; asm volatile("" : "+s"(bx));
        __builtin_amdgcn_s_waitcnt(0);
        unsigned nloc = b.st[0], nx = b.st[1];
        if (nloc == 0u) { xcd_barrier_complete(bar, bx, nloc, nx); b.st[0] = nloc; b.st[1] = nx; }
        const unsigned old = xb_add(&bar[XB_XSUB(bx)], 1u);
        const unsigned gen = old / nloc;
        if (old + 1u == (gen + 1u) * nloc) {
            __builtin_amdgcn_fence(__ATOMIC_RELEASE, "agent");
            asm volatile("s_waitcnt vmcnt(0)" ::: "memory");
            const unsigned og = xb_add(&bar[XB_TOP], 1u);
            const unsigned tg = og / nx;
            if (og + 1u == (tg + 1u) * nx) xb_add(&bar[XB_TOPGEN], 1u);
            else XB_SPIN(xb_ld(&bar[XB_TOPGEN]) == tg, bar);
            __builtin_amdgcn_fence(__ATOMIC_ACQUIRE, "agent");
            xb_add(&bar[XB_XGEN(bx)], 1u);
            asm volatile("s_waitcnt vmcnt(0)" ::: "memory");
        } else {
            XB_SPIN(xb_ld(&bar[XB_XGEN(bx)]) == gen, bar);
            __builtin_amdgcn_fence(__ATOMIC_ACQUIRE, "agent");
            asm volatile("s_waitcnt vmcnt(0)" ::: "memory");
        }
    }
    __syncthreads();
}

constexpr int NSMALLJOBS = 20;
__global__ void __launch_bounds__(NTHREADS, 2) k_mega(Params p) {
    extern __shared__ __attribute__((aligned(16))) char lds_all[];
    if (threadIdx.x == 0) *(uint4*)(lds_all + LDS_BYTES) = make_uint4(0u, 0u, 0u, 0u);
    __syncthreads();
    XcdBarrier bar = xcd_barrier_post((unsigned*)(p.ws + OFF_BAR), (volatile LAS unsigned*)(lds_all + LDS_BYTES));
    char* lds = lds_all;
#define GBAR xcd_barrier(bar)
#define DUP(bit, call) do { call; if (PROBE_MASK & (1 << (bit))) { GBAR; call; } } while (0)
    DUP(17, phase_cvt(p, 0, NSMALLJOBS, lds));
    DUP(18, phase_ada(p, lds));
    GBAR;
    if (PROBE_MASK & (1 << 19)) { for (int i = 0; i < 40; ++i) GBAR; }
    for (int l = 0; l < 4; ++l) {
        const bool last = l == 3, rw = (l & 1) == 0; const int j = l >> 1;
        const int nrows = (!last || rw) ? NT : NLAT;
        if (l == 0) { phase_norm<false>(p, l, 0, nrows, lds); GBAR; }
        if (rw) {
            DUP(1, phase_mix(p, j)); GBAR;
            DUP(2, phase_rwkv_proj(p, j, lds)); GBAR;
            DUP(3, phase_rwkv_up2(p, j, lds));
            if (j == 1) phase_rwkv_up(p, j, lds);
            GBAR;
#if SCAN2_MODE == 3
            DUP(4, phase_rwkv_scan3(p, j, lds, (bf16_t*)(p.ws + OFF_Y))); GBAR;
#elif SCAN2_MODE == 2
            phase_rwkv_scan2(p, j, lds, (bf16_t*)(p.ws + OFF_Y), -1); GBAR;
#else
            DUP(4, phase_rwkv_scan(p, j, lds)); GBAR;
#endif
#if SCAN2_MODE == 1
            phase_rwkv_scan2(p, j, lds, (bf16_t*)(p.ws + OFF_Y2DBG), 0); GBAR;
            phase_scan_compare(p); GBAR;
#endif
            DUP(5, phase_rwkv_out2(p, j, lds)); GBAR;
            phase_rwkv_wo(p, l, j, lds); GBAR;
        } else {
            DUP(6, phase_pool_dlt(p, nrows)); GBAR;
            phase_pool_gemm(p, l, j, nrows, lds); GBAR;
        }
        const int mrows = last ? NLAT : NT;
        DUP(7, phase_cvt(p, NSMALLJOBS + 3 * l, NSMALLJOBS + 3 * l + 3, lds));
        DUP(8, phase_norm<true>(p, l, 1, mrows, lds)); GBAR;
        DUP(9, phase_topk(p, !last, lds)); GBAR;
        DUP(11, phase_moe_up(p, !last, lds)); GBAR;
        DUP(12, phase_moe_down(p, !last, lds)); GBAR;
        phase_moe_combine(p, l, mrows);
        if (!last) GBAR;
    }
#undef GBAR
}

enum { PH_CVT = 0, PH_ADA, PH_NORM1, PH_NORM2, PH_PROJ, PH_UP, PH_PREP, PH_SCAN, PH_OUT, PH_WO, PH_DLT, PH_POOLG, PH_TOPK, PH_GATHER, PH_MUP, PH_MDOWN, PH_COMB, PH_FINAL, PH_MIX };
template <int PH>
__global__ void __launch_bounds__(NTHREADS) k_phase(Params p, int a0, int a1, int a2) {
    extern __shared__ __attribute__((aligned(16))) char lds[];
    if (PH == PH_CVT) phase_cvt(p, a0, a1, lds);
    if (PH == PH_ADA) phase_ada(p, lds);
    if (PH == PH_NORM1) phase_norm<false>(p, a0, 0, a1, lds);
    if (PH == PH_NORM2) phase_norm<true>(p, a0, 1, a1, lds);
    if (PH == PH_PROJ) phase_rwkv_proj(p, a0, lds);
    if (PH == PH_UP) phase_rwkv_up(p, a0, lds);
    if (PH == PH_PREP) phase_rwkv_prep(p, a0);
    if (PH == PH_SCAN) phase_rwkv_scan(p, a0, lds);
    if (PH == PH_OUT) phase_rwkv_out2(p, a0, lds);
    if (PH == PH_WO) phase_rwkv_wo(p, a0, a1, lds);
    if (PH == PH_DLT) phase_pool_dlt(p, a0);
    if (PH == PH_POOLG) phase_pool_gemm(p, a0, a1, a2, lds);
    if (PH == PH_TOPK) phase_topk(p, a0 != 0, lds);
    if (PH == PH_MUP) phase_moe_up(p, a0 != 0, lds);
    if (PH == PH_MDOWN) phase_moe_down(p, a0 != 0, lds);
    if (PH == PH_COMB) phase_moe_combine(p, a0, a1);
    if (PH == PH_FINAL) phase_final(p);
    if (PH == PH_MIX) phase_mix(p, a0);
}

template <int PH>
static void launch(const Params& p, int a0, int a1, int a2, hipStream_t s) {
    static bool init = false;
    if (!init) { hipFuncSetAttribute((const void*)k_phase<PH>, hipFuncAttributeMaxDynamicSharedMemorySize, LDS_BYTES); init = true; }
    hipLaunchKernelGGL(k_phase<PH>, dim3(256), dim3(NTHREADS), LDS_BYTES, s, p, a0, a1, a2);
}

static int add_job(Params& p, int n, const float* src, bf16_t* dst, int K, int N, int src_ld, int dst_ld, int n_mul, int n_off, int Kpad, int Npad, int nbatch, long src_bs, long dst_bs) {
    CvtJob& J = p.jobs[n];
    J.src = src; J.dst = dst; J.src_bs = src_bs; J.dst_bs = dst_bs; J.K = K; J.N = N; J.src_ld = src_ld; J.dst_ld = dst_ld; J.n_mul = n_mul; J.n_off = n_off;
    J.Kpad = Kpad; J.Npad = Npad; J.nbatch = nbatch; J.tiles = nbatch * (Kpad / 64) * ((Npad + 255) / 256);
    return n + 1;
}

extern "C" void kernel_launch(void* const* d_in, const int* in_sizes, int n_in, void* d_out, int out_size, void* d_ws, size_t ws_size, hipStream_t stream) {
    Params p;
    memset(&p, 0, sizeof(p));
    for (int i = 0; i < 34; ++i) p.in[i] = (const float*)d_in[i];
    p.out = (float*)d_out; p.ws = (char*)d_ws;
    if (ws_size < WS_NEED) { fprintf(stderr, "workspace too small: %zu < %zu\n", ws_size, (size_t)WS_NEED); }
    bf16_t* wsm_ = (bf16_t*)(p.ws + OFF_WSM);
    bf16_t* wm_ = (bf16_t*)(p.ws + OFF_WM);
    int nj = 0;
    for (int j = 0; j < 2; ++j) {
        bf16_t* base = wsm_ + (size_t)j * WJ_SIZE;
        nj = add_job(p, nj, p.in[9] + (size_t)j * 3 * D * D, base + WJ_RKV, D, D, D, D, 1, 0, D, D, 3, (long)D * D, (long)D * D);
        nj = add_job(p, nj, p.in[26] + (size_t)j * D * D, base + WJ_WO, D, D, D, D, 1, 0, D, D, 1, 0, 0);
        nj = add_job(p, nj, p.in[11] + (size_t)j * 2 * D * 64, base + WJ_W1, D, 64, 64, D, 1, 0, D, 64, 2, (long)D * 64, (long)64 * D);
        nj = add_job(p, nj, p.in[14] + (size_t)j * 2 * D * 64, base + WJ_A1, D, 64, 64, D, 1, 0, D, 64, 2, (long)D * 64, (long)64 * D);
        nj = add_job(p, nj, p.in[19] + (size_t)j * D * 128, base + WJ_G1, D, 128, 128, D, 1, 0, D, 128, 1, 0, 0);
        nj = add_job(p, nj, p.in[12] + (size_t)j * 2 * 64 * D, base + WJ_W2, 64, D, D, 64, 1, 0, 64, D, 2, (long)64 * D, (long)D * 64);
        nj = add_job(p, nj, p.in[15] + (size_t)j * 2 * 64 * D, base + WJ_A2, 64, D, D, 64, 1, 0, 64, D, 2, (long)64 * D, (long)D * 64);
        nj = add_job(p, nj, p.in[20] + (size_t)j * 128 * D, base + WJ_G2, 128, D, D, 128, 1, 0, 128, D, 1, 0, 0);
        nj = add_job(p, nj, p.in[27] + (size_t)j * 4 * 256 * 256, base + WJ_POOL, 256, 256, 256, 256, 1, 0, 256, 256, 4, 65536, 65536);
    }
    nj = add_job(p, nj, p.in[17], wsm_ + W_V1, D, 32, 32, D, 1, 0, D, 128, 1, 0, 0);
    nj = add_job(p, nj, p.in[18], wsm_ + W_V2, 32, D, D, 64, 1, 0, 64, D, 1, 0, 0);
    const int nsmall = nj;
    for (int l = 0; l < 4; ++l) {
#if MOE_F8
        nj = add_job(p, nj, p.in[30] + (size_t)l * 16 * D * FF, wm_, D, FF, FF, D, 2, 0, D, FF, 16, (long)D * FF, (long)4096 * 1024);
        p.jobs[nj - 1].f8 = 1; p.jobs[nj - 1].scale = W8_SCALE;
        nj = add_job(p, nj, p.in[31] + (size_t)l * 16 * D * FF, wm_, D, FF, FF, D, 2, 1, D, FF, 16, (long)D * FF, (long)4096 * 1024);
        p.jobs[nj - 1].f8 = 1; p.jobs[nj - 1].scale = W8_SCALE;
        nj = add_job(p, nj, p.in[32] + (size_t)l * 16 * FF * D, (bf16_t*)(p.ws + OFF_WM + WM8_2), FF, D, D, FF, 1, 0, FF, D, 16, (long)FF * D, (long)D * FF);
        p.jobs[nj - 1].f8 = 1; p.jobs[nj - 1].scale = W8_SCALE;
#else
        nj = add_job(p, nj, p.in[30] + (size_t)l * 16 * D * FF, wm_ + WM_13, D, FF, FF, D, 2, 0, D, FF, 16, (long)D * FF, (long)4096 * 1024);
        nj = add_job(p, nj, p.in[31] + (size_t)l * 16 * D * FF, wm_ + WM_13, D, FF, FF, D, 2, 1, D, FF, 16, (long)D * FF, (long)4096 * 1024);
        nj = add_job(p, nj, p.in[32] + (size_t)l * 16 * FF * D, wm_ + WM_2, FF, D, D, FF, 1, 0, FF, D, 16, (long)FF * D, (long)D * FF);
#endif
    }
#if MK_MULTI
    launch<PH_CVT>(p, 0, nsmall, 0, stream);
    launch<PH_ADA>(p, 0, 0, 0, stream);
    for (int l = 0; l < 4; ++l) {
        const bool last = l == 3, rw = (l % 2) == 0; const int j = l / 2;
        const bool need_ctx = !last || rw;
        const int nrows = need_ctx ? NT : NLAT;
        if (l == 0) launch<PH_NORM1>(p, l, nrows, 0, stream);
        if (rw) {
            launch<PH_MIX>(p, j, 0, 0, stream);
            launch<PH_PROJ>(p, j, 0, 0, stream);
            launch<PH_UP>(p, j, 0, 0, stream);
            launch<PH_PREP>(p, j, 0, 0, stream);
            launch<PH_SCAN>(p, j, 0, 0, stream);
            launch<PH_OUT>(p, j, 0, 0, stream);
            launch<PH_WO>(p, l, j, 0, stream);
        } else {
            launch<PH_DLT>(p, nrows, 0, 0, stream);
            launch<PH_POOLG>(p, l, j, nrows, stream);
        }
        const int mrows = last ? NLAT : NT;
        launch<PH_CVT>(p, nsmall + 3 * l, nsmall + 3 * l + 3, 0, stream);
        launch<PH_NORM2>(p, l, mrows, 0, stream);
        launch<PH_TOPK>(p, last ? 0 : 1, 0, 0, stream);
        launch<PH_MUP>(p, last ? 0 : 1, 0, 0, stream);
        launch<PH_MDOWN>(p, last ? 0 : 1, 0, 0, stream);
        launch<PH_COMB>(p, l, mrows, 0, stream);
    }
#else
    (void)nsmall;
    static int grid = 0;
    if (!grid) {
        hipFuncSetAttribute((const void*)k_mega, hipFuncAttributeMaxDynamicSharedMemorySize, LDS_TOTAL);
        int dev = 0, cus = 0, per_cu = 0;
        hipGetDevice(&dev);
        hipDeviceGetAttribute(&cus, hipDeviceAttributeMultiprocessorCount, dev);
        hipOccupancyMaxActiveBlocksPerMultiprocessor(&per_cu, (const void*)k_mega, NTHREADS, LDS_TOTAL);
        grid = cus * (per_cu < 1 ? per_cu : 1);
        if (grid <= 0) { fprintf(stderr, "occupancy query returned %d blocks per CU\n", per_cu); grid = 0; return; }
    }
    hipMemsetAsync(p.ws + OFF_BAR, 0, 32768, stream);
    hipLaunchKernelGGL(k_mega, dim3(grid), dim3(NTHREADS), LDS_TOTAL, stream, p);
#endif
}
```

```cpp
#include <hip/hip_runtime.h>
#include <stdint.h>
#include <stdio.h>
#include <string.h>
#ifndef MK_MULTI
#define MK_MULTI 0
#endif

typedef unsigned short bf16_t;
typedef short bf16x8 __attribute__((ext_vector_type(8)));
typedef float f32x4 __attribute__((ext_vector_type(4)));
typedef unsigned u32x4 __attribute__((ext_vector_type(4)));
typedef unsigned u32x2 __attribute__((ext_vector_type(2)));

constexpr int D = 1024, NB = 16, TL = 4096, TC = 256;
constexpr int NLAT = NB * TL, NCTX = NB * TC, NT = NLAT + NCTX;
constexpr int NE = 16, FF = 2048, CAPL = 512, CAPC = 32;
constexpr int NSLOT_LAT = NB * NE * CAPL, NSLOT_CTX = NB * NE * CAPC, NSLOT = NSLOT_LAT + NSLOT_CTX;
constexpr int MODW = 6 * D;
constexpr int NTHREADS = 512;
constexpr int LDS_BYTES = 128 * 1024;
constexpr int LDS_TOK = LDS_BYTES + 16;
constexpr int LDS_TOTAL = LDS_TOK + 1024;

constexpr size_t MiB = 1ull << 20;
constexpr size_t U = (size_t)NT * D * 2;
constexpr size_t OFF_BAR = 0;
constexpr size_t OFF_MOD = 64 * 1024;
constexpr size_t OFF_WSM = 2 * MiB;
constexpr size_t OFF_AFF = 26 * MiB;
constexpr size_t OFF_BON = 31 * MiB;
constexpr size_t OFF_BON2 = 41 * MiB;
constexpr size_t OFF_IDX = 36 * MiB;
constexpr size_t OFF_GTV = 37 * MiB;
constexpr size_t OFF_SLT = 38 * MiB;
constexpr size_t OFF_BIG = 48 * MiB;
constexpr size_t OFF_X = OFF_BIG;
constexpr size_t OFF_VF = OFF_BIG + 2 * U;
constexpr size_t OFF_H = OFF_BIG + 3 * U;
constexpr size_t OFF_R = OFF_BIG + 4 * U;
constexpr size_t OFF_K = OFF_BIG + 5 * U;
constexpr size_t OFF_LD = OFF_BIG + 6 * U;
constexpr size_t OFF_LW = OFF_BIG + 6 * U + U / 2;
constexpr size_t OFF_AD = OFF_BIG + 8 * U + U / 2;
constexpr size_t OFF_Y = OFF_BIG + 10 * U + U / 2;
constexpr size_t OFF_G = OFF_BIG + 12 * U + U / 2;
constexpr size_t OFF_WM = OFF_BIG + 4 * U;
constexpr size_t OFF_XG = OFF_BIG + 5 * U + U / 2;
constexpr size_t OFF_HID = OFF_BIG + 7 * U + U / 2;
constexpr size_t OFF_YS = OFF_BIG + 11 * U + U / 2;
constexpr size_t OFF_DLT = OFF_BIG + 4 * U;
constexpr size_t OFF_D1 = OFF_BIG + 13 * U + U / 2;
constexpr size_t WS_NEED = OFF_BIG + 14 * U + U / 2;

constexpr size_t WJ_RKV = 0;
constexpr size_t WJ_WO = 3 * 1048576;
constexpr size_t WJ_W1 = 4 * 1048576;
constexpr size_t WJ_A1 = WJ_W1 + 131072;
constexpr size_t WJ_G1 = WJ_A1 + 131072;
constexpr size_t WJ_W2 = WJ_G1 + 131072;
constexpr size_t WJ_A2 = WJ_W2 + 131072;
constexpr size_t WJ_G2 = WJ_A2 + 131072;
constexpr size_t WJ_POOL = WJ_G2 + 131072;
constexpr size_t WJ_SIZE = WJ_POOL + 262144;
constexpr size_t W_V1 = 2 * WJ_SIZE;
constexpr size_t W_V2 = W_V1 + 131072;
constexpr size_t WM_13 = 0;
constexpr size_t WM_2 = (size_t)16 * 4096 * 1024;
constexpr size_t WM8_2 = (size_t)16 * 4096 * 1024;
constexpr float W8_SCALE = 64.f;
#define MOE_F8 1
#ifndef PROBE_MASK
#define PROBE_MASK 0
#endif

struct CvtJob {
    const float* src; bf16_t* dst;
    long src_bs, dst_bs;
    int K, N, src_ld, dst_ld, n_mul, n_off, Kpad, Npad, nbatch, tiles;
    int f8; float scale;
};
constexpr int NJOBS = 32;
struct Params {
    const float* in[34];
    float* out;
    char* ws;
    CvtJob jobs[NJOBS];
};

__device__ __forceinline__ float bf2f(bf16_t v) { return __uint_as_float(((unsigned)v) << 16); }
__device__ __forceinline__ bf16_t f2bf(float f) { unsigned u = __float_as_uint(f); u += 0x7FFFu + ((u >> 16) & 1u); return (bf16_t)(u >> 16); }
typedef __bf16 bf16x2_t __attribute__((ext_vector_type(2)));
typedef float f32x2_t __attribute__((ext_vector_type(2)));
__device__ __forceinline__ unsigned pack2(float lo, float hi) {
    const f32x2_t v = {lo, hi};
    return __builtin_bit_cast(unsigned, __builtin_convertvector(v, bf16x2_t));
}
__device__ __forceinline__ float bflo(unsigned w) { return __uint_as_float(w << 16); }
__device__ __forceinline__ float bfhi(unsigned w) { return __uint_as_float(w & 0xffff0000u); }
typedef unsigned u32x2_t __attribute__((ext_vector_type(2)));
__device__ __forceinline__ float red4(float x) {
    const unsigned u = __float_as_uint(x);
    const u32x2_t a = __builtin_amdgcn_permlane16_swap(u, u, false, false);
    const float t = __uint_as_float(a[0]) + __uint_as_float(a[1]);
    const unsigned v = __float_as_uint(t);
    const u32x2_t b = __builtin_amdgcn_permlane32_swap(v, v, false, false);
    return __uint_as_float(b[0]) + __uint_as_float(b[1]);
}
__device__ __forceinline__ float wave_sum(float v) {
    v += __uint_as_float(__builtin_amdgcn_update_dpp(0u, __float_as_uint(v), 0xB1, 0xf, 0xf, true));
    v += __uint_as_float(__builtin_amdgcn_update_dpp(0u, __float_as_uint(v), 0x4E, 0xf, 0xf, true));
    v += __uint_as_float(__builtin_amdgcn_update_dpp(0u, __float_as_uint(v), 0x141, 0xf, 0xf, true));
    v += __uint_as_float(__builtin_amdgcn_update_dpp(0u, __float_as_uint(v), 0x140, 0xf, 0xf, true));
    return red4(v);
}
__device__ __forceinline__ float sigmoidf_(float x) { return __builtin_amdgcn_rcpf(1.f + __expf(-x)); }
__device__ __forceinline__ float siluf_(float x) { return x * __builtin_amdgcn_rcpf(1.f + __expf(-x)); }
__device__ __forceinline__ float rdlane(float v, int l) { return __uint_as_float(__builtin_amdgcn_readlane(__float_as_uint(v), l)); }

__device__ __forceinline__ int tidx() { int t = threadIdx.x; asm volatile("" : "+v"(t)); return t; }

__device__ __forceinline__ int mod_row(int row) { return row < NLAT ? (row >> 12) : 16; }

__device__ __forceinline__ void phase_cvt(const Params& p, int jlo, int jhi, char* lds) {
    float* tile = (float*)lds;
#define CVT_T(k, n) tile[(k) * 321 + ((n) & 3) * 66 + ((n) >> 2)]
    const int tid = tidx();
    int total = 0;
    for (int j = jlo; j < jhi; ++j) total += p.jobs[j].tiles;
    auto locate = [&](int u, int& j, int& bt, int& kt, int& nt) {
        j = jlo; int uu = u;
        while (uu >= p.jobs[j].tiles) { uu -= p.jobs[j].tiles; ++j; }
        const int tk = p.jobs[j].Kpad / 64, tn = (p.jobs[j].Npad + 255) / 256;
        bt = uu / (tk * tn); const int r = uu % (tk * tn); kt = r / tn; nt = r % tn;
    };
    auto load = [&](int j, int bt, int kt, int nt, float4 (&v)[8]) {
        const CvtJob& J = p.jobs[j];
        const float* src = J.src + (size_t)bt * J.src_bs;
#pragma unroll
        for (int ps = 0; ps < 8; ++ps) {
            const int kl = ps * 8 + (tid >> 6), k = kt * 64 + kl, n = nt * 256 + (tid & 63) * 4;
            v[ps] = make_float4(0.f, 0.f, 0.f, 0.f);
            if (k < J.K) {
                const float* sp = src + (size_t)k * J.src_ld + n;
                if (n + 3 < J.N) v[ps] = *(const float4*)sp;
                else { if (n < J.N) v[ps].x = sp[0]; if (n + 1 < J.N) v[ps].y = sp[1]; if (n + 2 < J.N) v[ps].z = sp[2]; }
            }
        }
    };
    int u = blockIdx.x;
    if (u >= total) return;
    int j, bt, kt, nt;
    float4 v[8];
    locate(u, j, bt, kt, nt);
    load(j, bt, kt, nt, v);
    for (;;) {
#pragma unroll
        for (int ps = 0; ps < 8; ++ps) {
            float* tp = tile + (ps * 8 + (tid >> 6)) * 321 + (tid & 63);
            tp[0] = v[ps].x; tp[66] = v[ps].y; tp[132] = v[ps].z; tp[198] = v[ps].w;
        }
        __syncthreads();
        const int un = u + gridDim.x;
        int jn = j, btn = bt, ktn = kt, ntn = nt;
        if (un < total) { locate(un, jn, btn, ktn, ntn); load(jn, btn, ktn, ntn, v); }
        const CvtJob& J = p.jobs[j];
        if (J.f8) {
            char* dstb = (char*)J.dst + (size_t)bt * J.dst_bs;
            const float sc = J.scale;
#pragma unroll
            for (int ps = 0; ps < 4; ++ps) {
                const int nl = ps * 64 + (tid >> 3), kc = tid & 7, n = nt * 256 + nl;
                if (n < J.Npad) {
                    int w0 = 0, w1 = 0;
                    w0 = __builtin_amdgcn_cvt_pk_fp8_f32(CVT_T(kc * 8 + 0, nl) * sc, CVT_T(kc * 8 + 1, nl) * sc, w0, false);
                    w0 = __builtin_amdgcn_cvt_pk_fp8_f32(CVT_T(kc * 8 + 2, nl) * sc, CVT_T(kc * 8 + 3, nl) * sc, w0, true);
                    w1 = __builtin_amdgcn_cvt_pk_fp8_f32(CVT_T(kc * 8 + 4, nl) * sc, CVT_T(kc * 8 + 5, nl) * sc, w1, false);
                    w1 = __builtin_amdgcn_cvt_pk_fp8_f32(CVT_T(kc * 8 + 6, nl) * sc, CVT_T(kc * 8 + 7, nl) * sc, w1, true);
                    const u32x2 o = {(unsigned)w0, (unsigned)w1};
                    *(u32x2*)(dstb + ((size_t)n * J.n_mul + J.n_off) * J.dst_ld + kt * 64 + kc * 8) = o;
                }
            }
        } else {
            bf16_t* dst = J.dst + (size_t)bt * J.dst_bs;
#pragma unroll
            for (int ps = 0; ps < 4; ++ps) {
                const int nl = ps * 64 + (tid >> 3), kc = tid & 7, n = nt * 256 + nl;
                if (n < J.Npad) {
                    u32x4 o;
                    o[0] = pack2(CVT_T(kc * 8 + 0, nl), CVT_T(kc * 8 + 1, nl));
                    o[1] = pack2(CVT_T(kc * 8 + 2, nl), CVT_T(kc * 8 + 3, nl));
                    o[2] = pack2(CVT_T(kc * 8 + 4, nl), CVT_T(kc * 8 + 5, nl));
                    o[3] = pack2(CVT_T(kc * 8 + 6, nl), CVT_T(kc * 8 + 7, nl));
                    *(u32x4*)(dst + ((size_t)n * J.n_mul + J.n_off) * J.dst_ld + kt * 64 + kc * 8) = o;
                }
            }
        }
        __syncthreads();
        if (un >= total) break;
        u = un; j = jn; bt = btn; kt = ktn; nt = ntn;
    }
}
#undef CVT_T

__device__ __forceinline__ void phase_ada(const Params& p, char* lds) {
    float* sc = (float*)lds;
    float* red = sc + 17 * 1024;
    const int tid = tidx();
    const float* c = p.in[1]; const float* cctx = p.in[3];
    for (int i = tid; i < 17 * 1024; i += NTHREADS) {
        const float v = i < 16 * 1024 ? c[i] : cctx[i - 16 * 1024];
        sc[i] = siluf_(v);
    }
    __syncthreads();
    float* MOD = (float*)(p.ws + OFF_MOD);
    const int col = tid & 63, ks = tid >> 6;
    for (int u = blockIdx.x; u < 4 * 96; u += gridDim.x) {
        const int l = u / 96, n = (u % 96) * 64 + col;
        const float* w = p.in[4] + (size_t)l * D * MODW + n;
        float acc[17];
#pragma unroll
        for (int r = 0; r < 17; ++r) acc[r] = 0.f;
        for (int k = ks * 128; k < ks * 128 + 128; ++k) {
            const float wv = w[(size_t)k * MODW];
#pragma unroll
            for (int r = 0; r < 17; ++r) acc[r] += sc[r * 1024 + k] * wv;
        }
#pragma unroll
        for (int r = 0; r < 17; ++r) red[(ks * 17 + r) * 64 + col] = acc[r];
        __syncthreads();
        for (int i = tid; i < 17 * 64; i += NTHREADS) {
            const int r = i >> 6, cc = i & 63;
            float s = 0.f;
#pragma unroll
            for (int q = 0; q < 8; ++q) s += red[(q * 17 + r) * 64 + cc];
            const int nn = (u % 96) * 64 + cc;
            MOD[((size_t)l * 17 + r) * MODW + nn] = s + p.in[5][(size_t)l * MODW + nn];
        }
        __syncthreads();
    }
}

#ifndef ROUTER_RW
#define ROUTER_RW 4
#endif
template <bool ROUTER>
__device__ __forceinline__ void phase_norm(const Params& p, int l, int which, int nrows, char* lds) {
    const float* X = (const float*)(p.ws + OFF_X);
    const bool from_in = l == 0;
    const bf16_t* D1 = (const bf16_t*)(p.ws + OFF_D1);
    bf16_t* H = (bf16_t*)(p.ws + OFF_H);
    const float* MOD = (const float*)(p.ws + OFF_MOD) + (size_t)l * 17 * MODW;
    const float* g = (which == 0 ? p.in[6] : p.in[7]) + (size_t)l * D;
    float* AFF = (float*)(p.ws + OFF_AFF);
    float* rt = (float*)lds;
    const int tid = tidx(), lane = tid & 63, wid = tid >> 6;
    if (ROUTER) {
        const float* rsrc = p.in[29] + (size_t)l * D * NE;
        for (int i = tid; i < D * NE; i += NTHREADS) { const int e = i & 15, col = i >> 4; rt[(((e >> 1) * 2 + ((col >> 1) & 1)) * 256 + (col >> 2)) * 4 + (col & 1) * 2 + (e & 1)] = rsrc[i]; }
        __syncthreads();
    }
    const int so = which == 0 ? 0 : 3 * D, co = which == 0 ? D : 4 * D;
    constexpr int RW = ROUTER ? ROUTER_RW : 4;
    for (int grp = blockIdx.x * 8 + wid; grp < nrows / RW; grp += gridDim.x * 8) {
        const int row0 = grp * RW;
        const float* mr = MOD + (size_t)mod_row(row0) * MODW;
        float4 x[RW][4];
#pragma unroll
        for (int r = 0; r < RW; ++r)
#pragma unroll
            for (int i = 0; i < 4; ++i) {
                const int rw_ = row0 + r, c0 = i * 256 + lane * 4;
                const float* xs = from_in ? (rw_ < NLAT ? p.in[0] + (size_t)rw_ * D : p.in[2] + (size_t)(rw_ - NLAT) * D) : X + (size_t)rw_ * D;
                x[r][i] = *(const float4*)(xs + c0);
                if (ROUTER) {
                    const u32x2 dw = *(const u32x2*)(D1 + (size_t)rw_ * D + c0);
                    const float4 gt = *(const float4*)(mr + 2 * D + c0);
                    x[r][i].x += gt.x * bflo(dw[0]); x[r][i].y += gt.y * bfhi(dw[0]); x[r][i].z += gt.z * bflo(dw[1]); x[r][i].w += gt.w * bfhi(dw[1]);
                }
            }
        float rs[RW];
#pragma unroll
        for (int r = 0; r < RW; ++r) {
            float ss = 0.f;
#pragma unroll
            for (int i = 0; i < 4; ++i) ss += x[r][i].x * x[r][i].x + x[r][i].y * x[r][i].y + x[r][i].z * x[r][i].z + x[r][i].w * x[r][i].w;
            rs[r] = rsqrtf(wave_sum(ss) * (1.f / D) + 1e-6f);
        }
#pragma unroll
        for (int i = 0; i < 4; ++i) {
            const int c0 = i * 256 + lane * 4;
            const float4 gg = *(const float4*)(g + c0), sh = *(const float4*)(mr + so + c0), sl = *(const float4*)(mr + co + c0);
            const float m0 = gg.x * (1.f + sl.x), m1 = gg.y * (1.f + sl.y), m2 = gg.z * (1.f + sl.z), m3 = gg.w * (1.f + sl.w);
#pragma unroll
            for (int r = 0; r < RW; ++r) {
                float4 h; h.x = x[r][i].x * rs[r] * m0 + sh.x; h.y = x[r][i].y * rs[r] * m1 + sh.y; h.z = x[r][i].z * rs[r] * m2 + sh.z; h.w = x[r][i].w * rs[r] * m3 + sh.w;
                x[r][i] = h;
                if (ROUTER && MOE_F8) {
                    int w = 0; w = __builtin_amdgcn_cvt_pk_fp8_f32(h.x, h.y, w, false); w = __builtin_amdgcn_cvt_pk_fp8_f32(h.z, h.w, w, true);
                    *(unsigned*)((char*)H + (size_t)(row0 + r) * D + c0) = (unsigned)w;
                } else {
                    u32x2 o; o[0] = pack2(h.x, h.y); o[1] = pack2(h.z, h.w);
                    *(u32x2*)(H + (size_t)(row0 + r) * D + c0) = o;
                }
            }
        }
        if (ROUTER) {
            f32x2_t lgp[RW][8];
#pragma unroll
            for (int r = 0; r < RW; ++r)
#pragma unroll
                for (int ep = 0; ep < 8; ++ep) lgp[r][ep] = (f32x2_t){0.f, 0.f};
#pragma unroll
            for (int i = 0; i < 4; ++i) {
#pragma unroll
                for (int ep = 0; ep < 8; ++ep) {
                    const float4 q0 = *(const float4*)(rt + ((ep * 2 + 0) * 256 + i * 64 + lane) * 4), q1 = *(const float4*)(rt + ((ep * 2 + 1) * 256 + i * 64 + lane) * 4);
                    const f32x2_t w0 = {q0.x, q0.y}, w1 = {q0.z, q0.w}, w2 = {q1.x, q1.y}, w3 = {q1.z, q1.w};
#pragma unroll
                    for (int r = 0; r < RW; ++r) {
                        const float4 h = x[r][i];
                        lgp[r][ep] += (f32x2_t){h.x, h.x} * w0; lgp[r][ep] += (f32x2_t){h.y, h.y} * w1; lgp[r][ep] += (f32x2_t){h.z, h.z} * w2; lgp[r][ep] += (f32x2_t){h.w, h.w} * w3;
                    }
#pragma unroll
                    for (int r = 0; r < RW; ++r) asm volatile("" : "+v"(lgp[r][ep]));
                }
            }
            const int b0 = lane & 1, b1 = (lane >> 1) & 1;
            const int eidx = b1 + 2 * b0 + 4 * (lane >> 5) + 8 * ((lane >> 4) & 1);
#pragma unroll
            for (int r = 0; r < RW; ++r) {
                float v8[8], v4[4], v2[2];
#pragma unroll
                for (int i = 0; i < 8; ++i) {
                    const float lo = (i & 1) ? lgp[r][i >> 1].y : lgp[r][i >> 1].x, hi = (i & 1) ? lgp[r][4 + (i >> 1)].y : lgp[r][4 + (i >> 1)].x;
                    const u32x2_t sw = __builtin_amdgcn_permlane16_swap(__float_as_uint(lo), __float_as_uint(hi), false, false);
                    v8[i] = __uint_as_float(sw[0]) + __uint_as_float(sw[1]);
                }
#pragma unroll
                for (int i = 0; i < 4; ++i) {
                    const u32x2_t sw = __builtin_amdgcn_permlane32_swap(__float_as_uint(v8[i]), __float_as_uint(v8[i + 4]), false, false);
                    v4[i] = __uint_as_float(sw[0]) + __uint_as_float(sw[1]);
                }
#pragma unroll
                for (int i = 0; i < 2; ++i) {
                    const float keep = b0 ? v4[i + 2] : v4[i], send = b0 ? v4[i] : v4[i + 2];
                    v2[i] = keep + __uint_as_float(__builtin_amdgcn_update_dpp(0u, __float_as_uint(send), 0xB1, 0xf, 0xf, true));
                }
                float lgt;
                {
                    const float keep = b1 ? v2[1] : v2[0], send = b1 ? v2[0] : v2[1];
                    lgt = keep + __uint_as_float(__builtin_amdgcn_update_dpp(0u, __float_as_uint(send), 0x4E, 0xf, 0xf, true));
                }
                lgt += __uint_as_float(__builtin_amdgcn_update_dpp(0u, __float_as_uint(lgt), 0x124, 0xf, 0xf, true));
                lgt += __uint_as_float(__builtin_amdgcn_update_dpp(0u, __float_as_uint(lgt), 0x128, 0xf, 0xf, true));
                float mx = lgt;
                mx = fmaxf(mx, __uint_as_float(__builtin_amdgcn_update_dpp(0u, __float_as_uint(mx), 0xB1, 0xf, 0xf, true)));
                mx = fmaxf(mx, __uint_as_float(__builtin_amdgcn_update_dpp(0u, __float_as_uint(mx), 0x4E, 0xf, 0xf, true)));
                { const u32x2_t sw = __builtin_amdgcn_permlane16_swap(__float_as_uint(mx), __float_as_uint(mx), false, false); mx = fmaxf(__uint_as_float(sw[0]), __uint_as_float(sw[1])); }
                { const u32x2_t sw = __builtin_amdgcn_permlane32_swap(__float_as_uint(mx), __float_as_uint(mx), false, false); mx = fmaxf(__uint_as_float(sw[0]), __uint_as_float(sw[1])); }
                const float ex = __expf(lgt - mx);
                float sum = ex;
                sum += __uint_as_float(__builtin_amdgcn_update_dpp(0u, __float_as_uint(sum), 0xB1, 0xf, 0xf, true));
                sum += __uint_as_float(__builtin_amdgcn_update_dpp(0u, __float_as_uint(sum), 0x4E, 0xf, 0xf, true));
                { const u32x2_t sw = __builtin_amdgcn_permlane16_swap(__float_as_uint(sum), __float_as_uint(sum), false, false); sum = __uint_as_float(sw[0]) + __uint_as_float(sw[1]); }
                { const u32x2_t sw = __builtin_amdgcn_permlane32_swap(__float_as_uint(sum), __float_as_uint(sum), false, false); sum = __uint_as_float(sw[0]) + __uint_as_float(sw[1]); }
                if ((lane & 12) == 0) AFF[(size_t)(row0 + r) * 16 + eidx] = ex / sum;
            }
        }
    }
}

constexpr int GS_LD = 72;
template <class AL, class EP>
__device__ __forceinline__ void gemm_tile_small(char* lds, const AL& al, const bf16_t* __restrict__ Bt, int ldb, int K, int row0, int col0, const EP& ep) {
    bf16_t* As = (bf16_t*)lds; bf16_t* Bs = As + 128 * GS_LD;
    const int tid = tidx(), lane = tid & 63, wid = tid >> 6, wr = wid >> 1, wc = wid & 1, fr = lane & 15, fq = lane >> 4;
    const int lr = tid >> 3, kc = tid & 7;
    f32x4 acc[2][4];
#pragma unroll
    for (int m = 0; m < 2; ++m)
#pragma unroll
        for (int n = 0; n < 4; ++n) acc[m][n] = (f32x4){0.f, 0.f, 0.f, 0.f};
    bf16x8 ra0 = al(row0 + lr, kc * 8), ra1 = al(row0 + lr + 64, kc * 8);
    bf16x8 rb0 = *(const bf16x8*)(Bt + (size_t)(col0 + lr) * ldb + kc * 8), rb1 = *(const bf16x8*)(Bt + (size_t)(col0 + lr + 64) * ldb + kc * 8);
    for (int k0 = 0; k0 < K; k0 += 64) {
        __syncthreads();
        *(bf16x8*)(As + lr * GS_LD + kc * 8) = ra0; *(bf16x8*)(As + (lr + 64) * GS_LD + kc * 8) = ra1;
        *(bf16x8*)(Bs + lr * GS_LD + kc * 8) = rb0; *(bf16x8*)(Bs + (lr + 64) * GS_LD + kc * 8) = rb1;
        __syncthreads();
        if (k0 + 64 < K) {
            const int kn = k0 + 64 + kc * 8;
            ra0 = al(row0 + lr, kn); ra1 = al(row0 + lr + 64, kn);
            rb0 = *(const bf16x8*)(Bt + (size_t)(col0 + lr) * ldb + kn); rb1 = *(const bf16x8*)(Bt + (size_t)(col0 + lr + 64) * ldb + kn);
        }
#pragma unroll
        for (int ks = 0; ks < 2; ++ks) {
            bf16x8 a[2], b[4];
#pragma unroll
            for (int m = 0; m < 2; ++m) a[m] = *(const bf16x8*)(As + (wr * 32 + m * 16 + fr) * GS_LD + ks * 32 + fq * 8);
#pragma unroll
            for (int n = 0; n < 4; ++n) b[n] = *(const bf16x8*)(Bs + (wc * 64 + n * 16 + fr) * GS_LD + ks * 32 + fq * 8);
#pragma unroll
            for (int m = 0; m < 2; ++m)
#pragma unroll
                for (int n = 0; n < 4; ++n) acc[m][n] = __builtin_amdgcn_mfma_f32_16x16x32_bf16(b[n], a[m], acc[m][n], 0, 0, 0);
        }
    }
#pragma unroll
    for (int m = 0; m < 2; ++m)
#pragma unroll
        for (int n = 0; n < 4; ++n) ep(row0 + wr * 32 + m * 16 + fr, col0 + wc * 64 + n * 16 + fq * 4, acc[m][n]);
}

struct PlainLoader {
    const bf16_t* A; int lda;
    __device__ __forceinline__ bf16x8 operator()(int row, int k) const { return *(const bf16x8*)(A + (size_t)row * lda + k); }
    struct Raw { u32x4 h; };
    struct RawK { int dummy; };
    __device__ __forceinline__ void loadk(int k, RawK& r) const { r.dummy = 0; }
    __device__ __forceinline__ void load(int row, int k, Raw& r) const { r.h = *(const u32x4*)(A + (size_t)row * lda + k); }
    __device__ __forceinline__ bf16x8 finish(const Raw& r, const RawK&) const { return __builtin_bit_cast(bf16x8, r.h); }
};
struct MixLoader {
    const bf16_t* H; const float* mix;
    __device__ __forceinline__ bf16x8 operator()(int row, int k) const {
        int nb;
        if (row < NLAT) {
            const int t = row & (TL - 1), gc = t & 63, gr = t >> 6, q = k >> 8;
            if (q == 0) nb = gc > 0 ? row - 1 : -1;
            else if (q == 1) nb = gc < 63 ? row + 1 : -1;
            else if (q == 2) nb = gr > 0 ? row - 64 : -1;
            else nb = gr < 63 ? row + 64 : -1;
        } else {
            const int t = (row - NLAT) & (TC - 1);
            if (k < 512) nb = t > 0 ? row - 1 : -1;
            else nb = t < TC - 1 ? row + 1 : -1;
        }
        const u32x4 h = *(const u32x4*)(H + (size_t)row * D + k);
        u32x4 s = (u32x4){0u, 0u, 0u, 0u};
        if (nb >= 0) s = *(const u32x4*)(H + (size_t)nb * D + k);
        const float4 m0 = *(const float4*)(mix + k), m1 = *(const float4*)(mix + k + 4);
        u32x4 o;
        { float a = bflo(h[0]), b = bfhi(h[0]); o[0] = pack2(a + (bflo(s[0]) - a) * m0.x, b + (bfhi(s[0]) - b) * m0.y); }
        { float a = bflo(h[1]), b = bfhi(h[1]); o[1] = pack2(a + (bflo(s[1]) - a) * m0.z, b + (bfhi(s[1]) - b) * m0.w); }
        { float a = bflo(h[2]), b = bfhi(h[2]); o[2] = pack2(a + (bflo(s[2]) - a) * m1.x, b + (bfhi(s[2]) - b) * m1.y); }
        { float a = bflo(h[3]), b = bfhi(h[3]); o[3] = pack2(a + (bflo(s[3]) - a) * m1.z, b + (bfhi(s[3]) - b) * m1.w); }
        return __builtin_bit_cast(bf16x8, o);
    }
    struct Raw { u32x4 h, s; };
    struct RawK { float4 m0, m1; };
    __device__ __forceinline__ void loadk(int k, RawK& r) const { r.m0 = *(const float4*)(mix + k); r.m1 = *(const float4*)(mix + k + 4); }
    __device__ __forceinline__ void load(int row, int k, Raw& r) const {
        int nb;
        if (row < NLAT) {
            const int t = row & (TL - 1), gc = t & 63, gr = t >> 6, q = k >> 8;
            if (q == 0) nb = gc > 0 ? row - 1 : -1;
            else if (q == 1) nb = gc < 63 ? row + 1 : -1;
            else if (q == 2) nb = gr > 0 ? row - 64 : -1;
            else nb = gr < 63 ? row + 64 : -1;
        } else {
            const int t = (row - NLAT) & (TC - 1);
            if (k < 512) nb = t > 0 ? row - 1 : -1;
            else nb = t < TC - 1 ? row + 1 : -1;
        }
        r.h = *(const u32x4*)(H + (size_t)row * D + k);
        r.s = (u32x4){0u, 0u, 0u, 0u};
        if (nb >= 0) r.s = *(const u32x4*)(H + (size_t)nb * D + k);
    }
    __device__ __forceinline__ bf16x8 finish(const Raw& r, const RawK& c) const {
        u32x4 o;
        { float a = bflo(r.h[0]), b = bfhi(r.h[0]); o[0] = pack2(a + (bflo(r.s[0]) - a) * c.m0.x, b + (bfhi(r.s[0]) - b) * c.m0.y); }
        { float a = bflo(r.h[1]), b = bfhi(r.h[1]); o[1] = pack2(a + (bflo(r.s[1]) - a) * c.m0.z, b + (bfhi(r.s[1]) - b) * c.m0.w); }
        { float a = bflo(r.h[2]), b = bfhi(r.h[2]); o[2] = pack2(a + (bflo(r.s[2]) - a) * c.m1.x, b + (bfhi(r.s[2]) - b) * c.m1.y); }
        { float a = bflo(r.h[3]), b = bfhi(r.h[3]); o[3] = pack2(a + (bflo(r.s[3]) - a) * c.m1.z, b + (bfhi(r.s[3]) - b) * c.m1.w); }
        return __builtin_bit_cast(bf16x8, o);
    }
};

__device__ __forceinline__ void lds_barrier() { asm volatile("s_waitcnt lgkmcnt(0)\n\ts_barrier" ::: "memory"); }
template <class AL, class EP>
__device__ __forceinline__ void gemm_tile_small2(char* lds, const AL& al, const bf16_t* __restrict__ Bt, int ldb, int K, int row0, int col0, const EP& ep) {
    bf16_t* As0 = (bf16_t*)lds;
    const int tid = tidx(), lane = tid & 63, wid = tid >> 6, wr = wid >> 1, wc = wid & 1, fr = lane & 15, fq = lane >> 4;
    const int lr = tid >> 3, kc = tid & 7;
    constexpr int PD = 4;
    f32x4 acc[2][4];
#pragma unroll
    for (int m = 0; m < 2; ++m)
#pragma unroll
        for (int n = 0; n < 4; ++n) acc[m][n] = (f32x4){0.f, 0.f, 0.f, 0.f};
    typename AL::Raw qa0[PD], qa1[PD]; typename AL::RawK qk[PD]; u32x4 qb0[PD], qb1[PD];
    const int nsteps = K / 64;
#define GTS2_ISSUE(SLOT, STEP) do { const int kn_ = (STEP) * 64 + kc * 8; al.loadk(kn_, qk[SLOT]); al.load(row0 + lr, kn_, qa0[SLOT]); al.load(row0 + lr + 64, kn_, qa1[SLOT]); \
        qb0[SLOT] = *(const u32x4*)(Bt + (size_t)(col0 + lr) * ldb + kn_); qb1[SLOT] = *(const u32x4*)(Bt + (size_t)(col0 + lr + 64) * ldb + kn_); } while (0)
#pragma unroll
    for (int d = 0; d < PD; ++d) GTS2_ISSUE(d, d);
    for (int s0 = 0; s0 < nsteps; s0 += PD) {
#pragma unroll
        for (int d = 0; d < PD; ++d) {
            const int step = s0 + d;
            bf16_t* As = As0 + (d & 1) * (256 * GS_LD); bf16_t* Bs = As + 128 * GS_LD;
            *(bf16x8*)(As + lr * GS_LD + kc * 8) = al.finish(qa0[d], qk[d]); *(bf16x8*)(As + (lr + 64) * GS_LD + kc * 8) = al.finish(qa1[d], qk[d]);
            *(u32x4*)(Bs + lr * GS_LD + kc * 8) = qb0[d]; *(u32x4*)(Bs + (lr + 64) * GS_LD + kc * 8) = qb1[d];
            lds_barrier();
            if (step + PD < nsteps) GTS2_ISSUE(d, step + PD);
#pragma unroll
            for (int ks = 0; ks < 2; ++ks) {
                bf16x8 a[2], b[4];
#pragma unroll
                for (int m = 0; m < 2; ++m) a[m] = *(const bf16x8*)(As + (wr * 32 + m * 16 + fr) * GS_LD + ks * 32 + fq * 8);
#pragma unroll
                for (int n = 0; n < 4; ++n) b[n] = *(const bf16x8*)(Bs + (wc * 64 + n * 16 + fr) * GS_LD + ks * 32 + fq * 8);
#pragma unroll
                for (int m = 0; m < 2; ++m)
#pragma unroll
                    for (int n = 0; n < 4; ++n) acc[m][n] = __builtin_amdgcn_mfma_f32_16x16x32_bf16(b[n], a[m], acc[m][n], 0, 0, 0);
            }
        }
    }
#undef GTS2_ISSUE
#pragma unroll
    for (int m = 0; m < 2; ++m)
#pragma unroll
        for (int n = 0; n < 4; ++n) ep(row0 + wr * 32 + m * 16 + fr, col0 + wc * 64 + n * 16 + fq * 4, acc[m][n]);
}

struct EpStoreBf16 {
    bf16_t* O; int ldo; int act;
    __device__ __forceinline__ void operator()(int row, int col, f32x4 v) const {
        if (act == 1) { v[0] = tanhf(v[0]); v[1] = tanhf(v[1]); v[2] = tanhf(v[2]); v[3] = tanhf(v[3]); }
        else if (act == 2) { v[0] = sigmoidf_(v[0]); v[1] = sigmoidf_(v[1]); v[2] = sigmoidf_(v[2]); v[3] = sigmoidf_(v[3]); }
        u32x2 o; o[0] = pack2(v[0], v[1]); o[1] = pack2(v[2], v[3]);
        *(u32x2*)(O + (size_t)row * ldo + col) = o;
    }
};
struct EpDecay {
    bf16_t* O; const float* w0;
    __device__ __forceinline__ void operator()(int row, int col, f32x4 v) const {
        const float4 b = *(const float4*)(w0 + col);
        u32x2 o;
        o[0] = pack2(-0.6065306597f * sigmoidf_(v[0] + b.x), -0.6065306597f * sigmoidf_(v[1] + b.y));
        o[1] = pack2(-0.6065306597f * sigmoidf_(v[2] + b.z), -0.6065306597f * sigmoidf_(v[3] + b.w));
        *(u32x2*)(O + (size_t)row * D + col) = o;
    }
};
struct EpSigBias {
    bf16_t* O; const float* b0;
    __device__ __forceinline__ void operator()(int row, int col, f32x4 v) const {
        const float4 b = *(const float4*)(b0 + col);
        u32x2 o;
        o[0] = pack2(sigmoidf_(v[0] + b.x), sigmoidf_(v[1] + b.y));
        o[1] = pack2(sigmoidf_(v[2] + b.z), sigmoidf_(v[3] + b.w));
        *(u32x2*)(O + (size_t)row * D + col) = o;
    }
};
struct EpVres {
    bf16_t* VF; const bf16_t* VRAW; const float* v0;
    __device__ __forceinline__ void operator()(int row, int col, f32x4 a) const {
        const float4 b = *(const float4*)(v0 + col);
        const u32x2 vr = *(const u32x2*)(VRAW + (size_t)row * D + col);
        const u32x2 vf = *(const u32x2*)(VF + (size_t)row * D + col);
        float x0 = bflo(vr[0]), x1 = bfhi(vr[0]), x2 = bflo(vr[1]), x3 = bfhi(vr[1]);
        float f0 = bflo(vf[0]), f1 = bfhi(vf[0]), f2 = bflo(vf[1]), f3 = bfhi(vf[1]);
        u32x2 o;
        o[0] = pack2(x0 + (f0 - x0) * sigmoidf_(a[0] + b.x), x1 + (f1 - x1) * sigmoidf_(a[1] + b.y));
        o[1] = pack2(x2 + (f2 - x2) * sigmoidf_(a[2] + b.z), x3 + (f3 - x3) * sigmoidf_(a[3] + b.w));
        *(u32x2*)(VF + (size_t)row * D + col) = o;
    }
};
struct EpResidual {
    float* X; const float* gate; const float* cscale; float amp;
    const float* xin; const float* cin;
    __device__ __forceinline__ void operator()(int row, int col, f32x4 a) const {
        const float4 gt = *(const float4*)(gate + (size_t)mod_row(row) * MODW + col);
        float4 cs = make_float4(amp, amp, amp, amp);
        if (cscale) { const float4 t = *(const float4*)(cscale + col); cs.x *= t.x; cs.y *= t.y; cs.z *= t.z; cs.w *= t.w; }
        float4* xp = (float4*)(X + (size_t)row * D + col);
        const float4* sp = xin ? (const float4*)((row < NLAT ? xin + (size_t)row * D : cin + (size_t)(row - NLAT) * D) + col) : (const float4*)xp;
        float4 x = *sp;
        x.x += gt.x * a[0] * cs.x; x.y += gt.y * a[1] * cs.y; x.z += gt.z * a[2] * cs.z; x.w += gt.w * a[3] * cs.w;
        *xp = x;
    }
};
struct EpD1 {
    bf16_t* D1; const float* cscale;
    __device__ __forceinline__ void operator()(int row, int col, f32x4 a, f32x4 b) const {
        if (cscale) { const float4 s0 = *(const float4*)(cscale + col), s1 = *(const float4*)(cscale + col + 4);
            a[0] *= s0.x; a[1] *= s0.y; a[2] *= s0.z; a[3] *= s0.w; b[0] *= s1.x; b[1] *= s1.y; b[2] *= s1.z; b[3] *= s1.w; }
        const u32x4 o = {pack2(a[0], a[1]), pack2(a[2], a[3]), pack2(b[0], b[1]), pack2(b[2], b[3])};
        *(u32x4*)(D1 + (size_t)row * D + col) = o;
    }
};
struct EpSwiglu {
    bf16_t* HID;
    __device__ __forceinline__ void operator()(int row, int col, f32x4 a) const {
        *(unsigned*)(HID + (size_t)row * FF + (col >> 1)) = pack2(siluf_(a[0]) * a[1], siluf_(a[2]) * a[3]);
    }
    __device__ __forceinline__ void operator()(int row, int col, f32x4 a, f32x4 b) const {
        const f32x2_t g0 = {a[0], a[2]}, u0 = {a[1], a[3]}, g1 = {b[0], b[2]}, u1 = {b[1], b[3]};
        const f32x2_t t0 = g0 * -1.44269504089f, t1 = g1 * -1.44269504089f;
        f32x2_t e0, e1; e0.x = __builtin_amdgcn_exp2f(t0.x); e0.y = __builtin_amdgcn_exp2f(t0.y); e1.x = __builtin_amdgcn_exp2f(t1.x); e1.y = __builtin_amdgcn_exp2f(t1.y);
        const f32x2_t d0 = e0 + 1.0f, d1 = e1 + 1.0f;
        f32x2_t r0, r1; r0.x = __builtin_amdgcn_rcpf(d0.x); r0.y = __builtin_amdgcn_rcpf(d0.y); r1.x = __builtin_amdgcn_rcpf(d1.x); r1.y = __builtin_amdgcn_rcpf(d1.y);
        const f32x2_t h0 = (g0 * u0) * r0, h1 = (g1 * u1) * r1;
        const u32x2 o = {pack2(h0.x, h0.y), pack2(h1.x, h1.y)};
        *(u32x2*)(HID + (size_t)row * FF + (col >> 1)) = o;
    }
};
struct EpSwiglu8 {
    char* HID;
    __device__ __forceinline__ void operator()(int row, int col, f32x4 a) const {
        int w = 0; w = __builtin_amdgcn_cvt_pk_fp8_f32(siluf_(a[0]) * a[1], siluf_(a[2]) * a[3], w, false);
        *(unsigned short*)(HID + (size_t)row * FF + (col >> 1)) = (unsigned short)w;
    }
    __device__ __forceinline__ void operator()(int row, int col, f32x4 a, f32x4 b) const {
        const f32x2_t g0 = {a[0], a[2]}, u0 = {a[1], a[3]}, g1 = {b[0], b[2]}, u1 = {b[1], b[3]};
        const f32x2_t t0 = g0 * -1.44269504089f, t1 = g1 * -1.44269504089f;
        f32x2_t e0, e1; e0.x = __builtin_amdgcn_exp2f(t0.x); e0.y = __builtin_amdgcn_exp2f(t0.y); e1.x = __builtin_amdgcn_exp2f(t1.x); e1.y = __builtin_amdgcn_exp2f(t1.y);
        const f32x2_t d0 = e0 + 1.0f, d1 = e1 + 1.0f;
        f32x2_t r0, r1; r0.x = __builtin_amdgcn_rcpf(d0.x); r0.y = __builtin_amdgcn_rcpf(d0.y); r1.x = __builtin_amdgcn_rcpf(d1.x); r1.y = __builtin_amdgcn_rcpf(d1.y);
        const f32x2_t h0 = (g0 * u0) * r0, h1 = (g1 * u1) * r1;
        int w = 0;
        w = __builtin_amdgcn_cvt_pk_fp8_f32(h0.x, h0.y, w, false);
        w = __builtin_amdgcn_cvt_pk_fp8_f32(h1.x, h1.y, w, true);
        *(unsigned*)(HID + (size_t)row * FF + (col >> 1)) = (unsigned)w;
    }
};
struct EpGateRow {
    bf16_t* YS; const float* gatev;
    __device__ __forceinline__ void operator()(int row, int col, f32x4 a) const {
        const float gt = gatev[row];
        u32x2 o; o[0] = pack2(a[0] * gt, a[1] * gt); o[1] = pack2(a[2] * gt, a[3] * gt);
        *(u32x2*)(YS + (size_t)row * D + col) = o;
    }
    __device__ __forceinline__ void operator()(int row, int col, f32x4 a, f32x4 b) const {
        const float gt = gatev[row];
        const u32x4 o = {pack2(a[0] * gt, a[1] * gt), pack2(a[2] * gt, a[3] * gt), pack2(b[0] * gt, b[1] * gt), pack2(b[2] * gt, b[3] * gt)};
        *(u32x4*)(YS + (size_t)row * D + col) = o;
    }
};

#define LAS __attribute__((address_space(3)))
namespace g256 {
constexpr int BM = 256, BK = 64, HALF = 128, HTB = HALF * BK * 2, STAGE_BYTES = 8 * HTB;
__device__ __forceinline__ int lds_byte(int r, int c) { const int st = (r >> 4) * 2 + (c >> 5), rr = r & 15, cc = c & 31, ob = rr * 64 + cc * 2; return st * 1024 + (ob ^ (((ob >> 9) & 1) << 5)); }
__device__ __forceinline__ void stage_rc(int b, int& R, int& C) { const int st = b / 1024, sb = b % 1024, swz = sb ^ (((sb >> 9) & 1) << 5); R = (st >> 1) * 16 + swz / 64; C = (st & 1) * 32 + (swz % 64) / 2; }
struct Unit { const char* a; const char* b; int row0, col0; };
typedef int i32x4_t __attribute__((ext_vector_type(4)));
typedef int i32x8_t __attribute__((ext_vector_type(8)));
__device__ __forceinline__ i32x8_t cat8(bf16x8 lo, bf16x8 hi) { return __builtin_shufflevector(__builtin_bit_cast(i32x4_t, lo), __builtin_bit_cast(i32x4_t, hi), 0, 1, 2, 3, 4, 5, 6, 7); }

__device__ __forceinline__ int perm32(int rho) { const int n = rho >> 4, i = rho & 15; return 8 * (i >> 2) + 4 * n + (i & 3); }
template <bool PERM, bool F8 = false, bool GATHER = false, class Sched, class Ep>
__device__ __forceinline__ void gemm_phase(LAS unsigned char* lds, const int lda, const int ldb, const int K, const Sched& S, const Ep& E) {
    const int tid = tidx(), wid = __builtin_amdgcn_readfirstlane(tid >> 6), lane = tid & 63, wr = wid >> 2, wc = wid & 3, fr = lane & 15, fq = lane >> 4;
    const int nt = K / BK;
    int scw = 0x79797979, sca = 0x7F7F7F7F;
    if constexpr (F8) asm volatile("" : "+v"(scw), "+v"(sca));
    unsigned voffA[2], voffB[2], cbA[2];
#pragma unroll
    for (int i = 0; i < 2; ++i) { int R, C; stage_rc(tid * 16 + i * 8192, R, C); const int Rb = PERM ? ((R & ~31) + perm32(R & 31)) : R; voffA[i] = GATHER ? (unsigned)(R * 4) : (unsigned)(R * lda + C) * 2u; voffB[i] = (unsigned)(Rb * ldb + C) * 2u; cbA[i] = (unsigned)C * 2u; }
    LAS unsigned char* tokl = lds + LDS_TOK;
    unsigned gc[2][2], gn[2][2];
    const unsigned rowb = (unsigned)lda * 2u;
    const size_t kstep = (size_t)(BK * 2);
    const size_t hstepA = (size_t)HALF * lda * 2, hstepB = (size_t)HALF * ldb * 2;
    const unsigned ldsw = (unsigned)wid * 1024u;
    const int aoff = lds_byte(wr * 64 + fr, fq * 8), boff = lds_byte(wc * 32 + fr, fq * 8);
#define PG8_SA(b, h) (((b) * 2 + (h)) * HTB)
#define PG8_SB(b, h) ((4 + (b) * 2 + (h)) * HTB)
#define PG8_STAGE(bufoff, gbase, voff) do { _Pragma("unroll") for (int _i = 0; _i < 2; ++_i) \
        __builtin_amdgcn_global_load_lds((const unsigned*)((const char*)(gbase) + (voff)[_i]), (LAS unsigned*)(lds + (bufoff) + ldsw + _i * 8192), 16, 0, 0); } while (0)
#define PG8_STAGE_A(bufoff, ptr, h, goffs, koff) do { if constexpr (GATHER) { _Pragma("unroll") for (int _i = 0; _i < 2; ++_i) \
        __builtin_amdgcn_global_load_lds((const unsigned*)(S.abase + (size_t)(koff) + (goffs)[h][_i]), (LAS unsigned*)(lds + (bufoff) + ldsw + _i * 8192), 16, 0, 0); } \
        else PG8_STAGE(bufoff, ptr, voffA); } while (0)
#define PG8_LDA(dst, b, h) do { _Pragma("unroll") for (int m = 0; m < 4; ++m) _Pragma("unroll") for (int k = 0; k < 2; ++k) dst[m][k] = *(const LAS bf16x8*)(lds + PG8_SA(b, h) + aoff + m * 2048 + k * 1024); } while (0)
#define PG8_LDB(dst, b, h) do { _Pragma("unroll") for (int n = 0; n < 2; ++n) _Pragma("unroll") for (int k = 0; k < 2; ++k) dst[n][k] = *(const LAS bf16x8*)(lds + PG8_SB(b, h) + boff + n * 2048 + k * 1024); } while (0)
#define PG8_MMA(ai, bj, At, Bt) do { __builtin_amdgcn_s_setprio(1); _Pragma("unroll") for (int m = 0; m < 4; ++m) _Pragma("unroll") for (int n = 0; n < 2; ++n) { \
        if constexpr (F8) asm volatile("v_mfma_scale_f32_16x16x128_f8f6f4 %0, %1, %2, %0, %3, %4 op_sel_hi:[0,0,0]" : "+v"(acc[ai][bj][m][n]) : "v"(cat8(Bt[n][0], Bt[n][1])), "v"(cat8(At[m][0], At[m][1])), "v"(scw), "v"(sca)); \
        else { _Pragma("unroll") for (int k = 0; k < 2; ++k) acc[ai][bj][m][n] = __builtin_amdgcn_mfma_f32_16x16x32_bf16(Bt[n][k], At[m][k], acc[ai][bj][m][n], 0, 0, 0); } } \
        __builtin_amdgcn_s_setprio(0); } while (0)
#define PG8_WAIT_V(n) asm volatile("s_waitcnt vmcnt(" #n ")" ::: "memory")
#define PG8_WAIT_L(n) asm volatile("s_waitcnt lgkmcnt(" #n ")" ::: "memory")
#define PG8_BAR __builtin_amdgcn_s_barrier()
#define PG8_SCHED __builtin_amdgcn_sched_barrier(0)
    Unit cur, nxt; int ui = 0;
    if (!S.next(0, cur)) return;
    f32x4 acc[2][2][4][2];
#pragma unroll
    for (int a = 0; a < 2; ++a)
#pragma unroll
        for (int b = 0; b < 2; ++b)
#pragma unroll
            for (int m = 0; m < 4; ++m)
#pragma unroll
                for (int n = 0; n < 2; ++n) acc[a][b][m][n] = (f32x4){0.f, 0.f, 0.f, 0.f};
    bf16x8 At[4][2], B0[2][2], B1[2][2];
    const char* cA = cur.a; const char* cB = cur.b;
    if constexpr (GATHER) {
        if (tid < 256) *(LAS unsigned*)(tokl + tid * 4) = (unsigned)S.tok[cur.row0 + tid];
        __syncthreads();
#pragma unroll
        for (int h = 0; h < 2; ++h)
#pragma unroll
            for (int i = 0; i < 2; ++i) { gc[h][i] = *(const LAS unsigned*)(tokl + h * 512 + voffA[i]) * rowb + cbA[i]; gn[h][i] = gc[h][i]; }
        __syncthreads();
    }
    PG8_STAGE(PG8_SB(0, 0), cB, voffB); PG8_STAGE_A(PG8_SA(0, 0), cA, 0, gc, 0); PG8_STAGE(PG8_SB(0, 1), cB + hstepB, voffB); PG8_STAGE_A(PG8_SA(0, 1), cA + hstepA, 1, gc, 0);
    if (wr == 1) PG8_BAR;
    PG8_WAIT_V(4); PG8_BAR;
    PG8_STAGE(PG8_SB(1, 0), cB + kstep, voffB); PG8_STAGE_A(PG8_SA(1, 0), cA + kstep, 0, gc, kstep); PG8_STAGE(PG8_SB(1, 1), cB + hstepB + kstep, voffB);
    PG8_WAIT_V(6); PG8_BAR;
    for (;;) {
        const bool has_next = S.next(ui + 1, nxt);
        const char* nA = has_next ? nxt.a : cA; const char* nB = has_next ? nxt.b : cB;
        if constexpr (GATHER) {
            if (has_next && wid < 4) __builtin_amdgcn_global_load_lds((const unsigned*)(S.tok + nxt.row0 + tid), (LAS unsigned*)(tokl + wid * 256), 4, 0, 0);
        }
#pragma unroll 1
        for (int t = 0; t < nt; t += 2) {
            const bool last = (t == nt - 2);
            const char* a1 = cA + (size_t)(t + 1) * kstep;
            const char* a2 = last ? nA : cA + (size_t)(t + 2) * kstep; const char* b2 = last ? nB : cB + (size_t)(t + 2) * kstep;
            const char* a3 = a2 + kstep; const char* b3 = b2 + kstep;
            const size_t k1 = (size_t)(t + 1) * kstep, k2 = last ? (size_t)0 : (size_t)(t + 2) * kstep;
            unsigned o2[2][2];
            if constexpr (GATHER) {
                if (last && has_next) {
#pragma unroll
                    for (int h = 0; h < 2; ++h)
#pragma unroll
                        for (int i = 0; i < 2; ++i) gn[h][i] = *(const LAS unsigned*)(tokl + h * 512 + voffA[i]) * rowb + cbA[i];
                }
#pragma unroll
                for (int h = 0; h < 2; ++h)
#pragma unroll
                    for (int i = 0; i < 2; ++i) o2[h][i] = last ? gn[h][i] : gc[h][i];
            }
            PG8_LDB(B0, 0, 0); PG8_SCHED; PG8_LDA(At, 0, 0); PG8_STAGE_A(PG8_SA(1, 1), a1 + hstepA, 1, gc, k1);
            PG8_WAIT_L(8); PG8_BAR; PG8_WAIT_L(0); PG8_MMA(0, 0, At, B0); PG8_BAR; PG8_SCHED;
            PG8_LDB(B1, 0, 1); PG8_STAGE(PG8_SB(0, 0), b2, voffB);
            PG8_BAR; PG8_WAIT_L(0); PG8_MMA(0, 1, At, B1); PG8_BAR;
            PG8_LDA(At, 0, 1); PG8_STAGE_A(PG8_SA(0, 0), a2, 0, o2, k2);
            PG8_BAR; PG8_WAIT_L(0); PG8_MMA(1, 0, At, B0); PG8_BAR; PG8_SCHED;
            PG8_STAGE(PG8_SB(0, 1), b2 + hstepB, voffB);
            PG8_WAIT_V(6); PG8_BAR; PG8_MMA(1, 1, At, B1); PG8_BAR;
            PG8_LDB(B0, 1, 0); PG8_SCHED; PG8_LDA(At, 1, 0); PG8_STAGE_A(PG8_SA(0, 1), a2 + hstepA, 1, o2, k2);
            PG8_WAIT_L(8); PG8_BAR; PG8_WAIT_L(0); PG8_MMA(0, 0, At, B0); PG8_BAR; PG8_SCHED;
            PG8_LDB(B1, 1, 1); PG8_STAGE(PG8_SB(1, 0), b3, voffB);
            PG8_BAR; PG8_WAIT_L(0); PG8_MMA(0, 1, At, B1); PG8_BAR;
            PG8_LDA(At, 1, 1); PG8_STAGE_A(PG8_SA(1, 0), a3, 0, o2, k2 + kstep);
            PG8_BAR; PG8_WAIT_L(0); PG8_MMA(1, 0, At, B0); PG8_BAR; PG8_SCHED;
            PG8_STAGE(PG8_SB(1, 1), b3 + hstepB, voffB);
            PG8_WAIT_V(6); PG8_BAR; PG8_MMA(1, 1, At, B1); PG8_BAR;
        }
        if constexpr (F8) {
            asm volatile("s_nop 15\n\ts_nop 7" ::: "memory");
#pragma unroll
            for (int a = 0; a < 2; ++a)
#pragma unroll
                for (int b = 0; b < 2; ++b)
#pragma unroll
                    for (int m = 0; m < 4; ++m)
#pragma unroll
                        for (int n = 0; n < 2; ++n) asm volatile("" : "+v"(acc[a][b][m][n]));
        }
#pragma unroll
        for (int ai = 0; ai < 2; ++ai)
#pragma unroll
            for (int m = 0; m < 4; ++m)
#pragma unroll
                for (int bj = 0; bj < 2; ++bj) {
                    if constexpr (PERM) E(cur.row0 + ai * HALF + wr * 64 + m * 16 + fr, cur.col0 + bj * HALF + wc * 32 + 8 * fq, acc[ai][bj][m][0], acc[ai][bj][m][1]);
                    else {
#pragma unroll
                        for (int n = 0; n < 2; ++n) E(cur.row0 + ai * HALF + wr * 64 + m * 16 + fr, cur.col0 + bj * HALF + wc * 32 + n * 16 + 4 * fq, acc[ai][bj][m][n]);
                    }
                }
        if (!has_next) break;
#pragma unroll
        for (int a = 0; a < 2; ++a)
#pragma unroll
            for (int b = 0; b < 2; ++b)
#pragma unroll
                for (int m = 0; m < 4; ++m)
#pragma unroll
                    for (int n = 0; n < 2; ++n) acc[a][b][m][n] = (f32x4){0.f, 0.f, 0.f, 0.f};
        cur = nxt; cA = nA; cB = nB; ++ui;
        if constexpr (GATHER) {
#pragma unroll
            for (int h = 0; h < 2; ++h)
#pragma unroll
                for (int i = 0; i < 2; ++i) gc[h][i] = gn[h][i];
        }
    }
    PG8_WAIT_V(0);
    if (wr == 0) PG8_BAR;
    PG8_BAR;
#undef PG8_SA
#undef PG8_SB
#undef PG8_STAGE
#undef PG8_STAGE_A
#undef PG8_LDA
#undef PG8_LDB
#undef PG8_MMA
#undef PG8_WAIT_V
#undef PG8_WAIT_L
#undef PG8_BAR
#undef PG8_SCHED
}
__device__ __forceinline__ long unit_index(int i) {
    const int G = gridDim.x, c = blockIdx.x;
    if (G == 256) return ((long)i * 8 + (c & 7)) * 32 + (c >> 3);
    return (long)i * G + c;
}
}

__device__ __forceinline__ const bf16_t* wsm(const Params& p, int j, size_t off) { return (const bf16_t*)(p.ws + OFF_WSM) + (size_t)j * WJ_SIZE + off; }

__device__ __forceinline__ void phase_mix(const Params& p, int j) {
    const bf16_t* H = (const bf16_t*)(p.ws + OFF_H);
    const float* mix = p.in[8] + (size_t)j * 6 * D;
    bf16_t* XM = (bf16_t*)(p.ws + OFF_LW);
    const int tid_ = tidx(), lane = tid_ & 63, wid = tid_ >> 6;
    for (int cc = 0; cc < 2; ++cc) {
        const int k = cc * 512 + lane * 8;
        float m[3][8];
#pragma unroll
        for (int w = 0; w < 3; ++w) {
            const int mi = w == 0 ? 0 : (w == 1 ? 2 : 3);
            const float4 m0 = *(const float4*)(mix + mi * D + k), m1 = *(const float4*)(mix + mi * D + k + 4);
            m[w][0] = m0.x; m[w][1] = m0.y; m[w][2] = m0.z; m[w][3] = m0.w; m[w][4] = m1.x; m[w][5] = m1.y; m[w][6] = m1.z; m[w][7] = m1.w;
        }
        const int q = k >> 8;
        for (int grp = blockIdx.x * 8 + wid; grp < NT / 4; grp += gridDim.x * 8) {
            u32x4 h[4], s[4];
#pragma unroll
            for (int r = 0; r < 4; ++r) {
                const int row = grp * 4 + r;
                int nb;
                if (row < NLAT) {
                    const int t = row & (TL - 1), gc = t & 63, gr = t >> 6;
                    if (q == 0) nb = gc > 0 ? row - 1 : -1;
                    else if (q == 1) nb = gc < 63 ? row + 1 : -1;
                    else if (q == 2) nb = gr > 0 ? row - 64 : -1;
                    else nb = gr < 63 ? row + 64 : -1;
                } else {
                    const int t = (row - NLAT) & (TC - 1);
                    if (k < 512) nb = t > 0 ? row - 1 : -1;
                    else nb = t < TC - 1 ? row + 1 : -1;
                }
                h[r] = *(const u32x4*)(H + (size_t)row * D + k);
                s[r] = (u32x4){0u, 0u, 0u, 0u};
                if (nb >= 0) s[r] = *(const u32x4*)(H + (size_t)nb * D + k);
            }
#pragma unroll
            for (int r = 0; r < 4; ++r) {
                const int row = grp * 4 + r;
#pragma unroll
                for (int w = 0; w < 3; ++w) {
                    u32x4 o;
#pragma unroll
                    for (int e = 0; e < 4; ++e) {
                        const float x = bflo(h[r][e]), y = bfhi(h[r][e]);
                        o[e] = pack2(x + (bflo(s[r][e]) - x) * m[w][2 * e], y + (bfhi(s[r][e]) - y) * m[w][2 * e + 1]);
                    }
                    *(u32x4*)(XM + (size_t)w * NT * D + (size_t)row * D + k) = o;
                }
            }
        }
    }
}

struct SchedGrid {
    const char* A; const char* B; size_t a_mat, b_mat, a_rt, a_ct, b_ct; int cpm, total;
    __device__ __forceinline__ bool next(int i, g256::Unit& u) const {
        const long L = g256::unit_index(i);
        if (L >= total) return false;
        const int chunk = (int)(L >> 5), o = (int)(L & 31), mat = chunk / cpm, ch = chunk % cpm, rt = ch * 8 + (o >> 2), ct = o & 3;
        u.a = A + (size_t)mat * a_mat + (size_t)rt * a_rt + (size_t)ct * a_ct; u.b = B + (size_t)mat * b_mat + (size_t)ct * b_ct;
        u.row0 = rt * 256; u.col0 = mat * 1024 + ct * 256;
        return true;
    }
};
struct EpRKV {
    bf16_t* R; long vdelta;
    __device__ __forceinline__ void operator()(int row, int col, f32x4 v) const {
        const int mat = col >> 10, c = col & 1023;
        bf16_t* O = R + (size_t)mat * NT * D + (mat == 2 ? vdelta : 0l);
        u32x2 o; o[0] = pack2(v[0], v[1]); o[1] = pack2(v[2], v[3]);
        *(u32x2*)(O + (size_t)row * D + c) = o;
    }
    __device__ __forceinline__ void operator()(int row, int col, f32x4 v, f32x4 w) const {
        const int mat = col >> 10, c = col & 1023;
        bf16_t* O = R + (size_t)mat * NT * D + (mat == 2 ? vdelta : 0l);
        const u32x4 o = {pack2(v[0], v[1]), pack2(v[2], v[3]), pack2(w[0], w[1]), pack2(w[2], w[3])};
        *(u32x4*)(O + (size_t)row * D + c) = o;
    }
};

__device__ __forceinline__ void phase_rwkv_proj(const Params& p, int j, char* lds) {
    const bf16_t* H = (const bf16_t*)(p.ws + OFF_H);
    const float* mix = p.in[8] + (size_t)j * 6 * D;
    bf16_t* R = (bf16_t*)(p.ws + OFF_R);
    bf16_t* V = (bf16_t*)(p.ws + (j == 0 ? OFF_VF : OFF_Y));
    bf16_t* LD = (bf16_t*)(p.ws + OFF_LD);
    const bf16_t* XM = (const bf16_t*)(p.ws + OFF_LW);
    {
        SchedGrid S{(const char*)XM, (const char*)wsm(p, j, WJ_RKV), (size_t)NT * D * 2, (size_t)D * D * 2, (size_t)256 * D * 2, 0, (size_t)256 * D * 2, NT / 256 / 8, 3 * (NT / 256) * 4};
        EpRKV E{R, (long)(V - (R + (size_t)2 * NT * D))};
        g256::gemm_phase<true>((LAS unsigned char*)lds, D, D, D, S, E);
    }
    constexpr int RT = NT / 128;
    const int nsmall = (j == 0 ? 3 : 4) * RT;
    for (int u = blockIdx.x; u < nsmall; u += gridDim.x) {
        const int which = u / RT, rt = u % RT;
        EpStoreBf16 ep{LD + (size_t)which * NT * 128, 128, which == 0 ? 1 : (which == 2 ? 2 : 0)};
        if (which < 3) {
            const int mi = which == 0 ? 1 : (which == 1 ? 4 : 5);
            MixLoader al{H, mix + mi * D};
            const bf16_t* Bt = which == 0 ? wsm(p, j, WJ_W1) : which == 1 ? wsm(p, j, WJ_A1) : wsm(p, j, WJ_G1);
            gemm_tile_small2(lds, al, Bt, D, D, rt * 128, 0, ep);
        } else {
            PlainLoader al{XM + (size_t)2 * NT * D, D};
            gemm_tile_small2(lds, al, (const bf16_t*)(p.ws + OFF_WSM) + W_V1, D, D, rt * 128, 0, ep);
        }
    }
}

template <int KS, int MODE>
__device__ __forceinline__ void gemm_bstat(const bf16_t* __restrict__ A, int lda, const bf16_t* __restrict__ Bt, int ldb, int col0, int rt0, int rt1,
                                           bf16_t* O, const float* bias, const bf16_t* VRAW) {
    const int tid = tidx(), lane = tid & 63, wid = tid >> 6, wr = wid >> 2, wc = wid & 3, fr = lane & 15, fq = lane >> 4;
    bf16x8 bfr[4][KS];
#pragma unroll
    for (int n = 0; n < 4; ++n) {
        const int colb = col0 + wc * 64 + (n >> 1) * 32 + 8 * (fr >> 2) + 4 * (n & 1) + (fr & 3);
#pragma unroll
        for (int ks = 0; ks < KS; ++ks) bfr[n][ks] = *(const bf16x8*)(Bt + (size_t)colb * ldb + ks * 32 + fq * 8);
    }
    float bs[2][8];
#pragma unroll
    for (int pp = 0; pp < 2; ++pp)
#pragma unroll
        for (int e = 0; e < 8; ++e) bs[pp][e] = MODE == 2 ? 0.f : bias[col0 + wc * 64 + pp * 32 + 8 * fq + e] * ((MODE == 0 || MODE == 1) ? -1.44269504089f : 1.f);
    bf16x8 afr[4][KS];
#pragma unroll
    for (int m = 0; m < 4; ++m)
#pragma unroll
        for (int ks = 0; ks < KS; ++ks) afr[m][ks] = *(const bf16x8*)(A + (size_t)(rt0 * 128 + wr * 64 + m * 16 + fr) * lda + ks * 32 + fq * 8);
    for (int rt = rt0; rt < rt1; ++rt) {
        f32x4 acc[4][4];
#pragma unroll
        for (int m = 0; m < 4; ++m)
#pragma unroll
            for (int n = 0; n < 4; ++n) {
                acc[m][n] = (f32x4){0.f, 0.f, 0.f, 0.f};
#pragma unroll
                for (int ks = 0; ks < KS; ++ks) acc[m][n] = __builtin_amdgcn_mfma_f32_16x16x32_bf16(bfr[n][ks], afr[m][ks], acc[m][n], 0, 0, 0);
            }
        if (rt + 1 < rt1) {
#pragma unroll
            for (int m = 0; m < 4; ++m)
#pragma unroll
                for (int ks = 0; ks < KS; ++ks) afr[m][ks] = *(const bf16x8*)(A + (size_t)((rt + 1) * 128 + wr * 64 + m * 16 + fr) * lda + ks * 32 + fq * 8);
        }
#pragma unroll
        for (int m = 0; m < 4; ++m)
#pragma unroll
            for (int pp = 0; pp < 2; ++pp) {
                const size_t o = (size_t)(rt * 128 + wr * 64 + m * 16 + fr) * D + col0 + wc * 64 + pp * 32 + 8 * fq;
                float v[8];
#pragma unroll
                for (int e = 0; e < 4; ++e) { v[e] = acc[m][2 * pp][e]; v[4 + e] = acc[m][2 * pp + 1][e]; }
                if (MODE == 0 || MODE == 1) {
#pragma unroll
                    for (int e = 0; e < 8; e += 2) {
                        const f32x2_t x = {v[e], v[e + 1]}, bb = {bs[pp][e], bs[pp][e + 1]};
                        const f32x2_t t = x * -1.44269504089f + bb;
                        f32x2_t ex; ex.x = __builtin_amdgcn_exp2f(t.x); ex.y = __builtin_amdgcn_exp2f(t.y);
                        const f32x2_t dn = ex + 1.0f;
                        f32x2_t r; r.x = __builtin_amdgcn_rcpf(dn.x); r.y = __builtin_amdgcn_rcpf(dn.y);
                        if (MODE == 0) r = r * -0.6065306597f;
                        v[e] = r.x; v[e + 1] = r.y;
                    }
                } else if (MODE == 3) {
                    const u32x4 vr = *(const u32x4*)(VRAW + o), vf = *(const u32x4*)(O + o);
#pragma unroll
                    for (int e = 0; e < 8; ++e) {
                        const float x = (e & 1) ? bfhi(vr[e >> 1]) : bflo(vr[e >> 1]), f = (e & 1) ? bfhi(vf[e >> 1]) : bflo(vf[e >> 1]);
                        v[e] = x + (f - x) * sigmoidf_(v[e] + bs[pp][e]);
                    }
                }
                const u32x4 w = {pack2(v[0], v[1]), pack2(v[2], v[3]), pack2(v[4], v[5]), pack2(v[6], v[7])};
                *(u32x4*)(O + o) = w;
            }
    }
}
__device__ __forceinline__ void phase_rwkv_up(const Params& p, int j, char* lds) {
    bf16_t* LD = (bf16_t*)(p.ws + OFF_LD);
    bf16_t* LW = (bf16_t*)(p.ws + OFF_LW); bf16_t* AD = (bf16_t*)(p.ws + OFF_AD); bf16_t* G = (bf16_t*)(p.ws + OFF_G);
    constexpr int RT = NT / 128, NRC = 32, RPC = RT / NRC;
    const int ntot = j == 0 ? 0 : 4 * NRC;
    for (int u = blockIdx.x; u < ntot; u += gridDim.x) {
        const int which = 5, r = u % (4 * NRC), ct = r / NRC, rc = r % NRC;
        const int rt0 = rc * RPC, rt1 = rt0 + RPC, col0 = ct * 256;
        if (which < 2) {
            const int d = which;
            gemm_bstat<2, 0>(LD + d * 64, 128, wsm(p, j, WJ_W2) + (size_t)d * D * 64, 64, col0, rt0, rt1, LW + (size_t)d * NT * D, p.in[10] + ((size_t)j * 2 + d) * D, nullptr);
        } else if (which < 4) {
            const int d = which - 2;
            gemm_bstat<2, 1>(LD + (size_t)NT * 128 + d * 64, 128, wsm(p, j, WJ_A2) + (size_t)d * D * 64, 64, col0, rt0, rt1, AD + (size_t)d * NT * D, p.in[13] + ((size_t)j * 2 + d) * D, nullptr);
        } else if (which == 4) {
            gemm_bstat<4, 2>(LD + (size_t)2 * NT * 128, 128, wsm(p, j, WJ_G2), 128, col0, rt0, rt1, G, nullptr, nullptr);
        } else {
            gemm_bstat<2, 3>(LD + (size_t)3 * NT * 128, 128, (const bf16_t*)(p.ws + OFF_WSM) + W_V2, 64, col0, rt0, rt1, (bf16_t*)(p.ws + OFF_VF), p.in[16], (const bf16_t*)(p.ws + OFF_Y));
        }
    }
}

__device__ __forceinline__ void phase_rwkv_up2(const Params& p, int j, char* lds) {
    const bf16_t* R = (const bf16_t*)(p.ws + OFF_R); const bf16_t* Kb = (const bf16_t*)(p.ws + OFF_K);
    bf16_t* KK = (bf16_t*)(p.ws + OFF_H); float* BON = (float*)(p.ws + OFF_BON);
    const float* k_k = p.in[21] + (size_t)j * D; const float* k_a = p.in[22] + (size_t)j * D; const float* r_k = p.in[23] + (size_t)j * D;
    float* cst = (float*)lds;
    constexpr int TR = 32, MT = 1, RT = NT / TR, NRC = 64, RPC = RT / NRC, KS = 2;
    const int tid = tidx(), lane = tid & 63, wid = tid >> 6, wr = wid >> 2, wc = wid & 3, fr = lane & 15, fq = lane >> 4;
    const bf16_t* A = (const bf16_t*)(p.ws + OFF_LD) + (size_t)NT * 128;
    bf16_t* AD = (bf16_t*)(p.ws + OFF_AD);
    for (int u = blockIdx.x; u < 4 * NRC; u += gridDim.x) {
        const int ct = u / NRC, rc = u % NRC, rt0 = rc * RPC, rt1 = rt0 + RPC, col0 = ct * 256, head = ct * 4 + wc;
        __syncthreads();
        if (tid < 256) {
            const float kk_ = k_k[col0 + tid], ka_ = k_a[col0 + tid], rk_ = r_k[col0 + tid];
            cst[tid] = kk_; cst[256 + tid] = rk_ * (1.f - ka_); cst[512 + tid] = 0.5f * rk_ * ka_;
            cst[768 + tid] = p.in[13][((size_t)j * 2 + 0) * D + col0 + tid] * -1.44269504089f; cst[1024 + tid] = p.in[13][((size_t)j * 2 + 1) * D + col0 + tid] * -1.44269504089f;
        }
        __syncthreads();
        bf16x8 bfr[2][4][KS];
#pragma unroll
        for (int d = 0; d < 2; ++d)
#pragma unroll
            for (int n = 0; n < 4; ++n) {
                const int colb = col0 + wc * 64 + (n >> 1) * 32 + 8 * (fr >> 2) + 4 * (n & 1) + (fr & 3);
#pragma unroll
                for (int ks = 0; ks < KS; ++ks) bfr[d][n][ks] = *(const bf16x8*)(wsm(p, j, WJ_A2) + (size_t)d * D * 64 + (size_t)colb * 64 + ks * 32 + fq * 8);
            }
        bf16x8 afr[MT][2][KS];
#pragma unroll
        for (int m = 0; m < MT; ++m)
#pragma unroll
            for (int d = 0; d < 2; ++d)
#pragma unroll
                for (int ks = 0; ks < KS; ++ks) afr[m][d][ks] = *(const bf16x8*)(A + (size_t)(rt0 * TR + wr * (16 * MT) + m * 16 + fr) * 128 + d * 64 + ks * 32 + fq * 8);
#pragma unroll 1
        for (int rt = rt0; rt < rt1; ++rt) {
#pragma unroll
            for (int m = 0; m < MT; ++m) {
                const int row = rt * TR + wr * (16 * MT) + m * 16 + fr;
                const size_t o = (size_t)row * D + col0 + wc * 64 + 8 * fq;
                u32x4 kv[2], rv[2];
#pragma unroll
                for (int pp = 0; pp < 2; ++pp) { kv[pp] = *(const u32x4*)(Kb + o + pp * 32); rv[pp] = *(const u32x4*)(R + o + pp * 32); }
                float asum[16];
#pragma unroll
                for (int d = 0; d < 2; ++d) {
                    f32x4 acc[4];
#pragma unroll
                    for (int n = 0; n < 4; ++n) {
                        acc[n] = (f32x4){0.f, 0.f, 0.f, 0.f};
#pragma unroll
                        for (int ks = 0; ks < KS; ++ks) acc[n] = __builtin_amdgcn_mfma_f32_16x16x32_bf16(bfr[d][n][ks], afr[m][d][ks], acc[n], 0, 0, 0);
                    }
#pragma unroll
                    for (int pp = 0; pp < 2; ++pp) {
                        const float* bp = cst + 768 + d * 256 + wc * 64 + pp * 32 + 8 * fq;
                        const float4 b0 = *(const float4*)bp, b1 = *(const float4*)(bp + 4);
                        const float bs[8] = {b0.x, b0.y, b0.z, b0.w, b1.x, b1.y, b1.z, b1.w};
                        float av[8];
#pragma unroll
                        for (int e = 0; e < 8; e += 2) {
                            const f32x2_t x = {acc[2 * pp + (e >> 2)][e & 3], acc[2 * pp + (e >> 2)][(e & 3) + 1]}, bb = {bs[e], bs[e + 1]};
                            const f32x2_t t = x * -1.44269504089f + bb;
                            f32x2_t ex; ex.x = __builtin_amdgcn_exp2f(t.x); ex.y = __builtin_amdgcn_exp2f(t.y);
                            const f32x2_t dn = ex + 1.0f;
                            av[e] = __builtin_amdgcn_rcpf(dn.x); av[e + 1] = __builtin_amdgcn_rcpf(dn.y);
                        }
                        const u32x4 w = {pack2(av[0], av[1]), pack2(av[2], av[3]), pack2(av[4], av[5]), pack2(av[6], av[7])};
                        *(u32x4*)(AD + (size_t)d * NT * D + o + pp * 32) = w;
#pragma unroll
                        for (int e = 0; e < 8; ++e) { const float ab = bf2f(f2bf(av[e])); asum[pp * 8 + e] = d == 0 ? ab : asum[pp * 8 + e] + ab; }
                    }
                }
                if (rt + 1 < rt1) {
#pragma unroll
                    for (int d = 0; d < 2; ++d)
#pragma unroll
                        for (int ks = 0; ks < KS; ++ks) afr[m][d][ks] = *(const bf16x8*)(A + (size_t)((rt + 1) * TR + wr * (16 * MT) + m * 16 + fr) * 128 + d * 64 + ks * 32 + fq * 8);
                }
                float kk[16]; float n2 = 0.f, bon = 0.f;
#pragma unroll
                for (int pp = 0; pp < 2; ++pp) {
                    const float* cp = cst + wc * 64 + pp * 32 + 8 * fq;
                    const float4 q0 = *(const float4*)cp, q1 = *(const float4*)(cp + 4), c10 = *(const float4*)(cp + 256), c11 = *(const float4*)(cp + 260), c20 = *(const float4*)(cp + 512), c21 = *(const float4*)(cp + 516);
                    const float kkw[8] = {q0.x, q0.y, q0.z, q0.w, q1.x, q1.y, q1.z, q1.w}, c1[8] = {c10.x, c10.y, c10.z, c10.w, c11.x, c11.y, c11.z, c11.w}, c2[8] = {c20.x, c20.y, c20.z, c20.w, c21.x, c21.y, c21.z, c21.w};
#pragma unroll
                    for (int e = 0; e < 8; ++e) {
                        const unsigned kw = kv[pp][e >> 1], rw = rv[pp][e >> 1];
                        const float k = (e & 1) ? bfhi(kw) : bflo(kw), rr = (e & 1) ? bfhi(rw) : bflo(rw);
                        kk[pp * 8 + e] = k * kkw[e]; n2 += kk[pp * 8 + e] * kk[pp * 8 + e];
                        bon += rr * k * (c1[e] + c2[e] * asum[pp * 8 + e]);
                    }
                }
                bon = red4(bon); n2 = red4(n2);
                if (fq == 0) BON[(size_t)row * 16 + head] = bon;
                const float inv = 1.f / fmaxf(sqrtf(n2), 1e-12f);
#pragma unroll
                for (int pp = 0; pp < 2; ++pp) {
                    const u32x4 w = {pack2(kk[pp * 8 + 0] * inv, kk[pp * 8 + 1] * inv), pack2(kk[pp * 8 + 2] * inv, kk[pp * 8 + 3] * inv), pack2(kk[pp * 8 + 4] * inv, kk[pp * 8 + 5] * inv), pack2(kk[pp * 8 + 6] * inv, kk[pp * 8 + 7] * inv)};
                    *(u32x4*)(KK + o + pp * 32) = w;
                }
            }
        }
    }
}

__device__ __forceinline__ void phase_rwkv_prep(const Params& p, int j) {
    const bf16_t* R = (const bf16_t*)(p.ws + OFF_R); const bf16_t* Kb = (const bf16_t*)(p.ws + OFF_K);
    const bf16_t* AD = (const bf16_t*)(p.ws + OFF_AD);
    bf16_t* KK = (bf16_t*)(p.ws + OFF_H); float* BON = (float*)(p.ws + OFF_BON);
    const float* k_k = p.in[21] + (size_t)j * D; const float* k_a = p.in[22] + (size_t)j * D; const float* r_k = p.in[23] + (size_t)j * D;
    const int tid_ = tidx(), lane = tid_ & 63, wid = tid_ >> 6, c0 = lane * 16;
    float kkw[16], kaw[16], rkw[16];
#pragma unroll
    for (int i = 0; i < 16; ++i) { kkw[i] = k_k[c0 + i]; kaw[i] = k_a[c0 + i]; rkw[i] = r_k[c0 + i]; }
    constexpr int RW = 2;
    for (int grp = blockIdx.x * 8 + wid; grp < NT / RW; grp += gridDim.x * 8) {
        u32x4 kv[RW][2], rv[RW][2], a0[RW][2], a1[RW][2];
#pragma unroll
        for (int r = 0; r < RW; ++r) {
            const size_t o = (size_t)(grp * RW + r) * D + c0;
#pragma unroll
            for (int i = 0; i < 2; ++i) {
                kv[r][i] = *(const u32x4*)(Kb + o + i * 8); rv[r][i] = *(const u32x4*)(R + o + i * 8);
                a0[r][i] = *(const u32x4*)(AD + o + i * 8); a1[r][i] = *(const u32x4*)(AD + (size_t)NT * D + o + i * 8);
            }
        }
#pragma unroll
        for (int r = 0; r < RW; ++r) {
            const int row = grp * RW + r;
            const size_t o = (size_t)row * D + c0;
            float kk[16]; float n2 = 0.f, bon = 0.f;
#pragma unroll
            for (int i = 0; i < 16; ++i) {
                const unsigned kw = kv[r][i >> 3][(i >> 1) & 3], rw = rv[r][i >> 3][(i >> 1) & 3], aw0 = a0[r][i >> 3][(i >> 1) & 3], aw1 = a1[r][i >> 3][(i >> 1) & 3];
                const float k = (i & 1) ? bfhi(kw) : bflo(kw), rr = (i & 1) ? bfhi(rw) : bflo(rw);
                const float am = 0.5f * (((i & 1) ? bfhi(aw0) : bflo(aw0)) + ((i & 1) ? bfhi(aw1) : bflo(aw1)));
                kk[i] = k * kkw[i]; n2 += kk[i] * kk[i];
                bon += rr * (k * (1.f + (am - 1.f) * kaw[i])) * rkw[i];
            }
            n2 += __shfl_xor(n2, 1, 64); n2 += __shfl_xor(n2, 2, 64);
            bon += __shfl_xor(bon, 1, 64); bon += __shfl_xor(bon, 2, 64);
            const float inv = 1.f / fmaxf(sqrtf(n2), 1e-12f);
            u32x4 ov[2];
#pragma unroll
            for (int i = 0; i < 8; ++i) ov[i >> 2][i & 3] = pack2(kk[2 * i] * inv, kk[2 * i + 1] * inv);
            *(u32x4*)(KK + o) = ov[0]; *(u32x4*)(KK + o + 8) = ov[1];
            if ((lane & 3) == 0) BON[(size_t)row * 16 + (lane >> 2)] = bon;
        }
    }
}

#define SCAN_STEP_ASM \
    "s_nop 1\n\t" \
    "v_mul_f32_dpp %0, %20, %0 row_newbcast:0 row_mask:0xf bank_mask:0xf\n\t" \
    "v_mul_f32_dpp %1, %20, %1 row_newbcast:1 row_mask:0xf bank_mask:0xf\n\t" \
    "v_mul_f32_dpp %2, %20, %2 row_newbcast:2 row_mask:0xf bank_mask:0xf\n\t" \
    "v_mul_f32_dpp %3, %20, %3 row_newbcast:3 row_mask:0xf bank_mask:0xf\n\t" \
    "v_mul_f32_dpp %4, %20, %4 row_newbcast:4 row_mask:0xf bank_mask:0xf\n\t" \
    "v_mul_f32_dpp %5, %20, %5 row_newbcast:5 row_mask:0xf bank_mask:0xf\n\t" \
    "v_mul_f32_dpp %6, %20, %6 row_newbcast:6 row_mask:0xf bank_mask:0xf\n\t" \
    "v_mul_f32_dpp %7, %20, %7 row_newbcast:7 row_mask:0xf bank_mask:0xf\n\t" \
    "v_mul_f32_dpp %8, %20, %8 row_newbcast:8 row_mask:0xf bank_mask:0xf\n\t" \
    "v_mul_f32_dpp %9, %20, %9 row_newbcast:9 row_mask:0xf bank_mask:0xf\n\t" \
    "v_mul_f32_dpp %10, %20, %10 row_newbcast:10 row_mask:0xf bank_mask:0xf\n\t" \
    "v_mul_f32_dpp %11, %20, %11 row_newbcast:11 row_mask:0xf bank_mask:0xf\n\t" \
    "v_mul_f32_dpp %12, %20, %12 row_newbcast:12 row_mask:0xf bank_mask:0xf\n\t" \
    "v_mul_f32_dpp %13, %20, %13 row_newbcast:13 row_mask:0xf bank_mask:0xf\n\t" \
    "v_mul_f32_dpp %14, %20, %14 row_newbcast:14 row_mask:0xf bank_mask:0xf\n\t" \
    "v_mul_f32_dpp %15, %20, %15 row_newbcast:15 row_mask:0xf bank_mask:0xf\n\t" \
    "v_fmac_f32_dpp %0, %21, %25 row_newbcast:0 row_mask:0xf bank_mask:0xf\n\t" \
    "v_fmac_f32_dpp %1, %21, %25 row_newbcast:1 row_mask:0xf bank_mask:0xf\n\t" \
    "v_fmac_f32_dpp %2, %21, %25 row_newbcast:2 row_mask:0xf bank_mask:0xf\n\t" \
    "v_fmac_f32_dpp %3, %21, %25 row_newbcast:3 row_mask:0xf bank_mask:0xf\n\t" \
    "v_fmac_f32_dpp %4, %21, %25 row_newbcast:4 row_mask:0xf bank_mask:0xf\n\t" \
    "v_fmac_f32_dpp %5, %21, %25 row_newbcast:5 row_mask:0xf bank_mask:0xf\n\t" \
    "v_fmac_f32_dpp %6, %21, %25 row_newbcast:6 row_mask:0xf bank_mask:0xf\n\t" \
    "v_fmac_f32_dpp %7, %21, %25 row_newbcast:7 row_mask:0xf bank_mask:0xf\n\t" \
    "v_fmac_f32_dpp %8, %21, %25 row_newbcast:8 row_mask:0xf bank_mask:0xf\n\t" \
    "v_fmac_f32_dpp %9, %21, %25 row_newbcast:9 row_mask:0xf bank_mask:0xf\n\t" \
    "v_fmac_f32_dpp %10, %21, %25 row_newbcast:10 row_mask:0xf bank_mask:0xf\n\t" \
    "v_fmac_f32_dpp %11, %21, %25 row_newbcast:11 row_mask:0xf bank_mask:0xf\n\t" \
    "v_fmac_f32_dpp %12, %21, %25 row_newbcast:12 row_mask:0xf bank_mask:0xf\n\t" \
    "v_fmac_f32_dpp %13, %21, %25 row_newbcast:13 row_mask:0xf bank_mask:0xf\n\t" \
    "v_fmac_f32_dpp %14, %21, %25 row_newbcast:14 row_mask:0xf bank_mask:0xf\n\t" \
    "v_fmac_f32_dpp %15, %21, %25 row_newbcast:15 row_mask:0xf bank_mask:0xf\n\t" \
    "v_fmac_f32_dpp %0, %22, %26 row_newbcast:0 row_mask:0xf bank_mask:0xf\n\t" \
    "v_fmac_f32_dpp %1, %22, %26 row_newbcast:1 row_mask:0xf bank_mask:0xf\n\t" \
    "v_fmac_f32_dpp %2, %22, %26 row_newbcast:2 row_mask:0xf bank_mask:0xf\n\t" \
    "v_fmac_f32_dpp %3, %22, %26 row_newbcast:3 row_mask:0xf bank_mask:0xf\n\t" \
    "v_fmac_f32_dpp %4, %22, %26 row_newbcast:4 row_mask:0xf bank_mask:0xf\n\t" \
    "v_fmac_f32_dpp %5, %22, %26 row_newbcast:5 row_mask:0xf bank_mask:0xf\n\t" \
    "v_fmac_f32_dpp %6, %22, %26 row_newbcast:6 row_mask:0xf bank_mask:0xf\n\t" \
    "v_fmac_f32_dpp %7, %22, %26 row_newbcast:7 row_mask:0xf bank_mask:0xf\n\t" \
    "v_fmac_f32_dpp %8, %22, %26 row_newbcast:8 row_mask:0xf bank_mask:0xf\n\t" \
    "v_fmac_f32_dpp %9, %22, %26 row_newbcast:9 row_mask:0xf bank_mask:0xf\n\t" \
    "v_fmac_f32_dpp %10, %22, %26 row_newbcast:10 row_mask:0xf bank_mask:0xf\n\t" \
    "v_fmac_f32_dpp %11, %22, %26 row_newbcast:11 row_mask:0xf bank_mask:0xf\n\t" \
    "v_fmac_f32_dpp %12, %22, %26 row_newbcast:12 row_mask:0xf bank_mask:0xf\n\t" \
    "v_fmac_f32_dpp %13, %22, %26 row_newbcast:13 row_mask:0xf bank_mask:0xf\n\t" \
    "v_fmac_f32_dpp %14, %22, %26 row_newbcast:14 row_mask:0xf bank_mask:0xf\n\t" \
    "v_fmac_f32_dpp %15, %22, %26 row_newbcast:15 row_mask:0xf bank_mask:0xf\n\t" \
    "v_mul_f32_dpp %16, %23, %0 row_newbcast:0 row_mask:0xf bank_mask:0xf\n\t" \
    "v_mul_f32_dpp %18, %24, %0 row_newbcast:0 row_mask:0xf bank_mask:0xf\n\t" \
    "v_mul_f32_dpp %17, %23, %1 row_newbcast:1 row_mask:0xf bank_mask:0xf\n\t" \
    "v_mul_f32_dpp %19, %24, %1 row_newbcast:1 row_mask:0xf bank_mask:0xf\n\t" \
    "v_fmac_f32_dpp %16, %23, %2 row_newbcast:2 row_mask:0xf bank_mask:0xf\n\t" \
    "v_fmac_f32_dpp %18, %24, %2 row_newbcast:2 row_mask:0xf bank_mask:0xf\n\t" \
    "v_fmac_f32_dpp %17, %23, %3 row_newbcast:3 row_mask:0xf bank_mask:0xf\n\t" \
    "v_fmac_f32_dpp %19, %24, %3 row_newbcast:3 row_mask:0xf bank_mask:0xf\n\t" \
    "v_fmac_f32_dpp %16, %23, %4 row_newbcast:4 row_mask:0xf bank_mask:0xf\n\t" \
    "v_fmac_f32_dpp %18, %24, %4 row_newbcast:4 row_mask:0xf bank_mask:0xf\n\t" \
    "v_fmac_f32_dpp %17, %23, %5 row_newbcast:5 row_mask:0xf bank_mask:0xf\n\t" \
    "v_fmac_f32_dpp %19, %24, %5 row_newbcast:5 row_mask:0xf bank_mask:0xf\n\t" \
    "v_fmac_f32_dpp %16, %23, %6 row_newbcast:6 row_mask:0xf bank_mask:0xf\n\t" \
    "v_fmac_f32_dpp %18, %24, %6 row_newbcast:6 row_mask:0xf bank_mask:0xf\n\t" \
    "v_fmac_f32_dpp %17, %23, %7 row_newbcast:7 row_mask:0xf bank_mask:0xf\n\t" \
    "v_fmac_f32_dpp %19, %24, %7 row_newbcast:7 row_mask:0xf bank_mask:0xf\n\t" \
    "v_fmac_f32_dpp %16, %23, %8 row_newbcast:8 row_mask:0xf bank_mask:0xf\n\t" \
    "v_fmac_f32_dpp %18, %24, %8 row_newbcast:8 row_mask:0xf bank_mask:0xf\n\t" \
    "v_fmac_f32_dpp %17, %23, %9 row_newbcast:9 row_mask:0xf bank_mask:0xf\n\t" \
    "v_fmac_f32_dpp %19, %24, %9 row_newbcast:9 row_mask:0xf bank_mask:0xf\n\t" \
    "v_fmac_f32_dpp %16, %23, %10 row_newbcast:10 row_mask:0xf bank_mask:0xf\n\t" \
    "v_fmac_f32_dpp %18, %24, %10 row_newbcast:10 row_mask:0xf bank_mask:0xf\n\t" \
    "v_fmac_f32_dpp %17, %23, %11 row_newbcast:11 row_mask:0xf bank_mask:0xf\n\t" \
    "v_fmac_f32_dpp %19, %24, %11 row_newbcast:11 row_mask:0xf bank_mask:0xf\n\t" \
    "v_fmac_f32_dpp %16, %23, %12 row_newbcast:12 row_mask:0xf bank_mask:0xf\n\t" \
    "v_fmac_f32_dpp %18, %24, %12 row_newbcast:12 row_mask:0xf bank_mask:0xf\n\t" \
    "v_fmac_f32_dpp %17, %23, %13 row_newbcast:13 row_mask:0xf bank_mask:0xf\n\t" \
    "v_fmac_f32_dpp %19, %24, %13 row_newbcast:13 row_mask:0xf bank_mask:0xf\n\t" \
    "v_fmac_f32_dpp %16, %23, %14 row_newbcast:14 row_mask:0xf bank_mask:0xf\n\t" \
    "v_fmac_f32_dpp %18, %24, %14 row_newbcast:14 row_mask:0xf bank_mask:0xf\n\t" \
    "v_fmac_f32_dpp %17, %23, %15 row_newbcast:15 row_mask:0xf bank_mask:0xf\n\t" \
    "v_fmac_f32_dpp %19, %24, %15 row_newbcast:15 row_mask:0xf bank_mask:0xf\n\t" \
    ""

__device__ __forceinline__ void phase_rwkv_scan(const Params& p, int j, char* lds) {
    const bf16_t* R = (const bf16_t*)(p.ws + OFF_R); const bf16_t* Kb = (const bf16_t*)(p.ws + OFF_K);
    const bf16_t* V = (const bf16_t*)(p.ws + OFF_VF); const bf16_t* KK = (const bf16_t*)(p.ws + OFF_H);
    const bf16_t* LW = (const bf16_t*)(p.ws + OFF_LW); const bf16_t* AD = (const bf16_t*)(p.ws + OFF_AD);
    bf16_t* Y = (bf16_t*)(p.ws + OFF_Y);
    const int tid = tidx(), lane = tid & 63, wid = tid >> 6, cl = wid >> 2, q = wid & 3;
    for (int cp = blockIdx.x; cp < 256; cp += gridDim.x) {
        const int chain = cp * 2 + cl, d = chain & 1, bh = chain >> 1, b = bh >> 4, h = bh & 15;
        const int col = h * 64 + lane, vcol = h * 64 + q * 16 + (lane & 15);
        const float ka = p.in[22][(size_t)j * D + col];
        const bf16_t* LWd = LW + (size_t)d * NT * D; const bf16_t* ADd = AD + (size_t)d * NT * D;
        bf16_t* Yd = Y + (size_t)d * NT * D;
        float S0 = 0.f, S1 = 0.f, S2 = 0.f, S3 = 0.f, S4 = 0.f, S5 = 0.f, S6 = 0.f, S7 = 0.f, S8 = 0.f, S9 = 0.f, S10 = 0.f, S11 = 0.f, S12 = 0.f, S13 = 0.f, S14 = 0.f, S15 = 0.f;
        float sa = 0.f;
        auto row_of = [&](int s) -> int {
            if (s < TC) { const int t = d ? (TC - 1 - s) : s; return NLAT + b * TC + t; }
            const int tl = s - TC; const int t = d ? (TL - 1 - tl) : tl; return b * TL + t;
        };
        auto row_kk = [&](int s) -> int { return row_of(s < TC + TL ? s : TC + TL - 1); };
        const int colw = col & ~1, vcolw = vcol & ~1;
        const unsigned shc = (col & 1) ? 0u : 16u, shv = (vcol & 1) ? 0u : 16u;
#define LDW(P, off) (*(const unsigned*)((P) + (off)))
#define UNP(w, sh) __uint_as_float(((w) << (sh)) & 0xffff0000u)
        unsigned nr[4], nkk[4], nk[4], nlw[4], na[4], nv[4];
#pragma unroll
        for (int g = 0; g < 4; ++g) {
            const size_t o = (size_t)row_of(g) * D;
            nr[g] = LDW(R, o + colw); nk[g] = LDW(Kb, o + colw); nlw[g] = LDW(LWd, o + colw); na[g] = LDW(ADd, o + colw); nv[g] = LDW(V, o + vcolw);
            nkk[g] = LDW(KK, (size_t)row_kk(g + 1) * D + colw);
        }
        float kk_cur = bf2f(KK[(size_t)row_of(0) * D + col]);
        constexpr int NSTEP = TC + TL;
        for (int s0 = 0; s0 < NSTEP; s0 += 4) {
            unsigned cr[4], ckk[4], ck[4], clw[4], ca[4], cv[4];
#pragma unroll
            for (int g = 0; g < 4; ++g) { cr[g] = nr[g]; ckk[g] = nkk[g]; ck[g] = nk[g]; clw[g] = nlw[g]; ca[g] = na[g]; cv[g] = nv[g]; }
            if (s0 + 4 < NSTEP) {
#pragma unroll
                for (int g = 0; g < 4; ++g) {
                    const size_t o = (size_t)row_of(s0 + 4 + g) * D;
                    nr[g] = LDW(R, o + colw); nk[g] = LDW(Kb, o + colw); nlw[g] = LDW(LWd, o + colw); na[g] = LDW(ADd, o + colw); nv[g] = LDW(V, o + vcolw);
                    nkk[g] = LDW(KK, (size_t)row_kk(s0 + 5 + g) * D + colw);
                }
            }
#pragma unroll
            for (int g = 0; g < 4; ++g) {
                const float rr = UNP(cr[g], shc), kkc = kk_cur, kkn = UNP(ckk[g], shc), kv = UNP(ck[g], shc), av = UNP(ca[g], shc), vv = UNP(cv[g], shv);
                kk_cur = kkn;
                const float dec = __expf(UNP(clw[g], shc)), bb = kkc * av, kd = kv * (1.f + (av - 1.f) * ka);
                float py0, py1, ps0, ps1;
                asm volatile(SCAN_STEP_ASM
                    : "+v"(S0), "+v"(S1), "+v"(S2), "+v"(S3), "+v"(S4), "+v"(S5), "+v"(S6), "+v"(S7), "+v"(S8), "+v"(S9), "+v"(S10), "+v"(S11), "+v"(S12), "+v"(S13), "+v"(S14), "+v"(S15),
                      "=&v"(py0), "=&v"(py1), "=&v"(ps0), "=&v"(ps1)
                    : "v"(dec), "v"(bb), "v"(kd), "v"(rr), "v"(kkn), "v"(sa), "v"(vv));
                sa = -red4(ps0 + ps1);
                const float yv = red4(py0 + py1);
                if (lane < 16) Yd[(size_t)row_of(s0 + g) * D + vcol] = f2bf(yv);
            }
        }
#undef LDW
#undef UNP
    }
}

#define TRI_ASM1 \
    "s_nop 1\n\t" \
    "v_xor_b32 %0, 0x80000000, %0\n\t" \
    "v_fmac_f32_dpp %1, %8, %0 row_newbcast:1 row_mask:0xf bank_mask:0xf\n\t" \
    "v_xor_b32 %1, 0x80000000, %1\n\t" \
    "v_fmac_f32_dpp %2, %8, %0 row_newbcast:2 row_mask:0xf bank_mask:0xf\n\t" \
    "v_fmac_f32_dpp %2, %9, %1 row_newbcast:2 row_mask:0xf bank_mask:0xf\n\t" \
    "v_xor_b32 %2, 0x80000000, %2\n\t" \
    "v_fmac_f32_dpp %3, %8, %0 row_newbcast:3 row_mask:0xf bank_mask:0xf\n\t" \
    "v_fmac_f32_dpp %3, %9, %1 row_newbcast:3 row_mask:0xf bank_mask:0xf\n\t" \
    "v_fmac_f32_dpp %3, %10, %2 row_newbcast:3 row_mask:0xf bank_mask:0xf\n\t" \
    "v_xor_b32 %3, 0x80000000, %3\n\t" \
    "v_fmac_f32_dpp %4, %8, %0 row_newbcast:4 row_mask:0xf bank_mask:0xf\n\t" \
    "v_fmac_f32_dpp %4, %9, %1 row_newbcast:4 row_mask:0xf bank_mask:0xf\n\t" \
    "v_fmac_f32_dpp %4, %10, %2 row_newbcast:4 row_mask:0xf bank_mask:0xf\n\t" \
    "v_fmac_f32_dpp %4, %11, %3 row_newbcast:4 row_mask:0xf bank_mask:0xf\n\t" \
    "v_xor_b32 %4, 0x80000000, %4\n\t" \
    "v_fmac_f32_dpp %5, %8, %0 row_newbcast:5 row_mask:0xf bank_mask:0xf\n\t" \
    "v_fmac_f32_dpp %5, %9, %1 row_newbcast:5 row_mask:0xf bank_mask:0xf\n\t" \
    "v_fmac_f32_dpp %5, %10, %2 row_newbcast:5 row_mask:0xf bank_mask:0xf\n\t" \
    "v_fmac_f32_dpp %5, %11, %3 row_newbcast:5 row_mask:0xf bank_mask:0xf\n\t" \
    "v_fmac_f32_dpp %5, %12, %4 row_newbcast:5 row_mask:0xf bank_mask:0xf\n\t" \
    "v_xor_b32 %5, 0x80000000, %5\n\t" \
    "v_fmac_f32_dpp %6, %8, %0 row_newbcast:6 row_mask:0xf bank_mask:0xf\n\t" \
    "v_fmac_f32_dpp %6, %9, %1 row_newbcast:6 row_mask:0xf bank_mask:0xf\n\t" \
    "v_fmac_f32_dpp %6, %10, %2 row_newbcast:6 row_mask:0xf bank_mask:0xf\n\t" \
    "v_fmac_f32_dpp %6, %11, %3 row_newbcast:6 row_mask:0xf bank_mask:0xf\n\t" \
    "v_fmac_f32_dpp %6, %12, %4 row_newbcast:6 row_mask:0xf bank_mask:0xf\n\t" \
    "v_fmac_f32_dpp %6, %13, %5 row_newbcast:6 row_mask:0xf bank_mask:0xf\n\t" \
    "v_xor_b32 %6, 0x80000000, %6\n\t" \
    "v_fmac_f32_dpp %7, %8, %0 row_newbcast:7 row_mask:0xf bank_mask:0xf\n\t" \
    "v_fmac_f32_dpp %7, %9, %1 row_newbcast:7 row_mask:0xf bank_mask:0xf\n\t" \
    "v_fmac_f32_dpp %7, %10, %2 row_newbcast:7 row_mask:0xf bank_mask:0xf\n\t" \
    "v_fmac_f32_dpp %7, %11, %3 row_newbcast:7 row_mask:0xf bank_mask:0xf\n\t" \
    "v_fmac_f32_dpp %7, %12, %4 row_newbcast:7 row_mask:0xf bank_mask:0xf\n\t" \
    "v_fmac_f32_dpp %7, %13, %5 row_newbcast:7 row_mask:0xf bank_mask:0xf\n\t" \
    "v_fmac_f32_dpp %7, %14, %6 row_newbcast:7 row_mask:0xf bank_mask:0xf\n\t" \
    "v_xor_b32 %7, 0x80000000, %7\n\t" \
    ""
#define TRI_ASM2 \
    "s_nop 1\n\t" \
    "v_fmac_f32_dpp %0, %16, %8 row_newbcast:8 row_mask:0xf bank_mask:0xf\n\t" \
    "v_fmac_f32_dpp %0, %17, %9 row_newbcast:8 row_mask:0xf bank_mask:0xf\n\t" \
    "v_fmac_f32_dpp %0, %18, %10 row_newbcast:8 row_mask:0xf bank_mask:0xf\n\t" \
    "v_fmac_f32_dpp %0, %19, %11 row_newbcast:8 row_mask:0xf bank_mask:0xf\n\t" \
    "v_fmac_f32_dpp %0, %20, %12 row_newbcast:8 row_mask:0xf bank_mask:0xf\n\t" \
    "v_fmac_f32_dpp %0, %21, %13 row_newbcast:8 row_mask:0xf bank_mask:0xf\n\t" \
    "v_fmac_f32_dpp %0, %22, %14 row_newbcast:8 row_mask:0xf bank_mask:0xf\n\t" \
    "v_fmac_f32_dpp %0, %23, %15 row_newbcast:8 row_mask:0xf bank_mask:0xf\n\t" \
    "v_fmac_f32_dpp %1, %16, %8 row_newbcast:9 row_mask:0xf bank_mask:0xf\n\t" \
    "v_fmac_f32_dpp %1, %17, %9 row_newbcast:9 row_mask:0xf bank_mask:0xf\n\t" \
    "v_fmac_f32_dpp %1, %18, %10 row_newbcast:9 row_mask:0xf bank_mask:0xf\n\t" \
    "v_fmac_f32_dpp %1, %19, %11 row_newbcast:9 row_mask:0xf bank_mask:0xf\n\t" \
    "v_fmac_f32_dpp %1, %20, %12 row_newbcast:9 row_mask:0xf bank_mask:0xf\n\t" \
    "v_fmac_f32_dpp %1, %21, %13 row_newbcast:9 row_mask:0xf bank_mask:0xf\n\t" \
    "v_fmac_f32_dpp %1, %22, %14 row_newbcast:9 row_mask:0xf bank_mask:0xf\n\t" \
    "v_fmac_f32_dpp %1, %23, %15 row_newbcast:9 row_mask:0xf bank_mask:0xf\n\t" \
    "v_fmac_f32_dpp %2, %16, %8 row_newbcast:10 row_mask:0xf bank_mask:0xf\n\t" \
    "v_fmac_f32_dpp %2, %17, %9 row_newbcast:10 row_mask:0xf bank_mask:0xf\n\t" \
    "v_fmac_f32_dpp %2, %18, %10 row_newbcast:10 row_mask:0xf bank_mask:0xf\n\t" \
    "v_fmac_f32_dpp %2, %19, %11 row_newbcast:10 row_mask:0xf bank_mask:0xf\n\t" \
    "v_fmac_f32_dpp %2, %20, %12 row_newbcast:10 row_mask:0xf bank_mask:0xf\n\t" \
    "v_fmac_f32_dpp %2, %21, %13 row_newbcast:10 row_mask:0xf bank_mask:0xf\n\t" \
    "v_fmac_f32_dpp %2, %22, %14 row_newbcast:10 row_mask:0xf bank_mask:0xf\n\t" \
    "v_fmac_f32_dpp %2, %23, %15 row_newbcast:10 row_mask:0xf bank_mask:0xf\n\t" \
    "v_fmac_f32_dpp %3, %16, %8 row_newbcast:11 row_mask:0xf bank_mask:0xf\n\t" \
    "v_fmac_f32_dpp %3, %17, %9 row_newbcast:11 row_mask:0xf bank_mask:0xf\n\t" \
    "v_fmac_f32_dpp %3, %18, %10 row_newbcast:11 row_mask:0xf bank_mask:0xf\n\t" \
    "v_fmac_f32_dpp %3, %19, %11 row_newbcast:11 row_mask:0xf bank_mask:0xf\n\t" \
    "v_fmac_f32_dpp %3, %20, %12 row_newbcast:11 row_mask:0xf bank_mask:0xf\n\t" \
    "v_fmac_f32_dpp %3, %21, %13 row_newbcast:11 row_mask:0xf bank_mask:0xf\n\t" \
    "v_fmac_f32_dpp %3, %22, %14 row_newbcast:11 row_mask:0xf bank_mask:0xf\n\t" \
    "v_fmac_f32_dpp %3, %23, %15 row_newbcast:11 row_mask:0xf bank_mask:0xf\n\t" \
    "v_fmac_f32_dpp %4, %16, %8 row_newbcast:12 row_mask:0xf bank_mask:0xf\n\t" \
    "v_fmac_f32_dpp %4, %17, %9 row_newbcast:12 row_mask:0xf bank_mask:0xf\n\t" \
    "v_fmac_f32_dpp %4, %18, %10 row_newbcast:12 row_mask:0xf bank_mask:0xf\n\t" \
    "v_fmac_f32_dpp %4, %19, %11 row_newbcast:12 row_mask:0xf bank_mask:0xf\n\t" \
    "v_fmac_f32_dpp %4, %20, %12 row_newbcast:12 row_mask:0xf bank_mask:0xf\n\t" \
    "v_fmac_f32_dpp %4, %21, %13 row_newbcast:12 row_mask:0xf bank_mask:0xf\n\t" \
    "v_fmac_f32_dpp %4, %22, %14 row_newbcast:12 row_mask:0xf bank_mask:0xf\n\t" \
    "v_fmac_f32_dpp %4, %23, %15 row_newbcast:12 row_mask:0xf bank_mask:0xf\n\t" \
    "v_fmac_f32_dpp %5, %16, %8 row_newbcast:13 row_mask:0xf bank_mask:0xf\n\t" \
    "v_fmac_f32_dpp %5, %17, %9 row_newbcast:13 row_mask:0xf bank_mask:0xf\n\t" \
    "v_fmac_f32_dpp %5, %18, %10 row_newbcast:13 row_mask:0xf bank_mask:0xf\n\t" \
    "v_fmac_f32_dpp %5, %19, %11 row_newbcast:13 row_mask:0xf bank_mask:0xf\n\t" \
    "v_fmac_f32_dpp %5, %20, %12 row_newbcast:13 row_mask:0xf bank_mask:0xf\n\t" \
    "v_fmac_f32_dpp %5, %21, %13 row_newbcast:13 row_mask:0xf bank_mask:0xf\n\t" \
    "v_fmac_f32_dpp %5, %22, %14 row_newbcast:13 row_mask:0xf bank_mask:0xf\n\t" \
    "v_fmac_f32_dpp %5, %23, %15 row_newbcast:13 row_mask:0xf bank_mask:0xf\n\t" \
    "v_fmac_f32_dpp %6, %16, %8 row_newbcast:14 row_mask:0xf bank_mask:0xf\n\t" \
    "v_fmac_f32_dpp %6, %17, %9 row_newbcast:14 row_mask:0xf bank_mask:0xf\n\t" \
    "v_fmac_f32_dpp %6, %18, %10 row_newbcast:14 row_mask:0xf bank_mask:0xf\n\t" \
    "v_fmac_f32_dpp %6, %19, %11 row_newbcast:14 row_mask:0xf bank_mask:0xf\n\t" \
    "v_fmac_f32_dpp %6, %20, %12 row_newbcast:14 row_mask:0xf bank_mask:0xf\n\t" \
    "v_fmac_f32_dpp %6, %21, %13 row_newbcast:14 row_mask:0xf bank_mask:0xf\n\t" \
    "v_fmac_f32_dpp %6, %22, %14 row_newbcast:14 row_mask:0xf bank_mask:0xf\n\t" \
    "v_fmac_f32_dpp %6, %23, %15 row_newbcast:14 row_mask:0xf bank_mask:0xf\n\t" \
    "v_fmac_f32_dpp %7, %16, %8 row_newbcast:15 row_mask:0xf bank_mask:0xf\n\t" \
    "v_fmac_f32_dpp %7, %17, %9 row_newbcast:15 row_mask:0xf bank_mask:0xf\n\t" \
    "v_fmac_f32_dpp %7, %18, %10 row_newbcast:15 row_mask:0xf bank_mask:0xf\n\t" \
    "v_fmac_f32_dpp %7, %19, %11 row_newbcast:15 row_mask:0xf bank_mask:0xf\n\t" \
    "v_fmac_f32_dpp %7, %20, %12 row_newbcast:15 row_mask:0xf bank_mask:0xf\n\t" \
    "v_fmac_f32_dpp %7, %21, %13 row_newbcast:15 row_mask:0xf bank_mask:0xf\n\t" \
    "v_fmac_f32_dpp %7, %22, %14 row_newbcast:15 row_mask:0xf bank_mask:0xf\n\t" \
    "v_fmac_f32_dpp %7, %23, %15 row_newbcast:15 row_mask:0xf bank_mask:0xf\n\t" \
    ""
#define TRI_ASM3 \
    "s_nop 1\n\t" \
    "v_xor_b32 %0, 0x80000000, %0\n\t" \
    "v_fmac_f32_dpp %1, %8, %0 row_newbcast:9 row_mask:0xf bank_mask:0xf\n\t" \
    "v_xor_b32 %1, 0x80000000, %1\n\t" \
    "v_fmac_f32_dpp %2, %8, %0 row_newbcast:10 row_mask:0xf bank_mask:0xf\n\t" \
    "v_fmac_f32_dpp %2, %9, %1 row_newbcast:10 row_mask:0xf bank_mask:0xf\n\t" \
    "v_xor_b32 %2, 0x80000000, %2\n\t" \
    "v_fmac_f32_dpp %3, %8, %0 row_newbcast:11 row_mask:0xf bank_mask:0xf\n\t" \
    "v_fmac_f32_dpp %3, %9, %1 row_newbcast:11 row_mask:0xf bank_mask:0xf\n\t" \
    "v_fmac_f32_dpp %3, %10, %2 row_newbcast:11 row_mask:0xf bank_mask:0xf\n\t" \
    "v_xor_b32 %3, 0x80000000, %3\n\t" \
    "v_fmac_f32_dpp %4, %8, %0 row_newbcast:12 row_mask:0xf bank_mask:0xf\n\t" \
    "v_fmac_f32_dpp %4, %9, %1 row_newbcast:12 row_mask:0xf bank_mask:0xf\n\t" \
    "v_fmac_f32_dpp %4, %10, %2 row_newbcast:12 row_mask:0xf bank_mask:0xf\n\t" \
    "v_fmac_f32_dpp %4, %11, %3 row_newbcast:12 row_mask:0xf bank_mask:0xf\n\t" \
    "v_xor_b32 %4, 0x80000000, %4\n\t" \
    "v_fmac_f32_dpp %5, %8, %0 row_newbcast:13 row_mask:0xf bank_mask:0xf\n\t" \
    "v_fmac_f32_dpp %5, %9, %1 row_newbcast:13 row_mask:0xf bank_mask:0xf\n\t" \
    "v_fmac_f32_dpp %5, %10, %2 row_newbcast:13 row_mask:0xf bank_mask:0xf\n\t" \
    "v_fmac_f32_dpp %5, %11, %3 row_newbcast:13 row_mask:0xf bank_mask:0xf\n\t" \
    "v_fmac_f32_dpp %5, %12, %4 row_newbcast:13 row_mask:0xf bank_mask:0xf\n\t" \
    "v_xor_b32 %5, 0x80000000, %5\n\t" \
    "v_fmac_f32_dpp %6, %8, %0 row_newbcast:14 row_mask:0xf bank_mask:0xf\n\t" \
    "v_fmac_f32_dpp %6, %9, %1 row_newbcast:14 row_mask:0xf bank_mask:0xf\n\t" \
    "v_fmac_f32_dpp %6, %10, %2 row_newbcast:14 row_mask:0xf bank_mask:0xf\n\t" \
    "v_fmac_f32_dpp %6, %11, %3 row_newbcast:14 row_mask:0xf bank_mask:0xf\n\t" \
    "v_fmac_f32_dpp %6, %12, %4 row_newbcast:14 row_mask:0xf bank_mask:0xf\n\t" \
    "v_fmac_f32_dpp %6, %13, %5 row_newbcast:14 row_mask:0xf bank_mask:0xf\n\t" \
    "v_xor_b32 %6, 0x80000000, %6\n\t" \
    "v_fmac_f32_dpp %7, %8, %0 row_newbcast:15 row_mask:0xf bank_mask:0xf\n\t" \
    "v_fmac_f32_dpp %7, %9, %1 row_newbcast:15 row_mask:0xf bank_mask:0xf\n\t" \
    "v_fmac_f32_dpp %7, %10, %2 row_newbcast:15 row_mask:0xf bank_mask:0xf\n\t" \
    "v_fmac_f32_dpp %7, %11, %3 row_newbcast:15 row_mask:0xf bank_mask:0xf\n\t" \
    "v_fmac_f32_dpp %7, %12, %4 row_newbcast:15 row_mask:0xf bank_mask:0xf\n\t" \
    "v_fmac_f32_dpp %7, %13, %5 row_newbcast:15 row_mask:0xf bank_mask:0xf\n\t" \
    "v_fmac_f32_dpp %7, %14, %6 row_newbcast:15 row_mask:0xf bank_mask:0xf\n\t" \
    "v_xor_b32 %7, 0x80000000, %7\n\t" \
    ""

constexpr int SC_KKT = 0, SC_RRT = 2048, SC_BHT = 4096, SC_KHT = 6144, SC_BHJ = 8192, SC_KHJ = 10240, SC_MBF = 12288, SC_RHF = 13312, SC_WLF = 14336, SC_STRIDE = 15360;
__device__ __forceinline__ bf16x8 mk8(unsigned a, unsigned b, unsigned c, unsigned d) { const u32x4 w = {a, b, c, d}; return __builtin_bit_cast(bf16x8, w); }
typedef short bf16x4 __attribute__((ext_vector_type(4)));
__device__ __forceinline__ bf16x4 mk4(unsigned a, unsigned b) { const u32x2 w = {a, b}; return __builtin_bit_cast(bf16x4, w); }
__device__ __forceinline__ void phase_rwkv_scan2(const Params& p, int j, char* lds_, bf16_t* Y, int dsel  ) {
    const bf16_t* R = (const bf16_t*)(p.ws + OFF_R); const bf16_t* Kb = (const bf16_t*)(p.ws + OFF_K);
    const bf16_t* V = (const bf16_t*)(p.ws + OFF_VF); const bf16_t* KK = (const bf16_t*)(p.ws + OFF_H);
    const bf16_t* LW = (const bf16_t*)(p.ws + OFF_LW); const bf16_t* AD = (const bf16_t*)(p.ws + OFF_AD);
    const int tid = tidx(), lane = tid & 63, wid = __builtin_amdgcn_readfirstlane(tid >> 6), cl = wid >> 2, q = wid & 3, g = lane >> 4, li = lane & 15;
    LAS unsigned char* wl = (LAS unsigned char*)lds_ + wid * SC_STRIDE;
    for (int cp = blockIdx.x; cp < 256; cp += gridDim.x) {
        const int chain = cp * 2 + cl, d = chain & 1, bh = chain >> 1, b = bh >> 4, h = bh & 15;
        if (dsel >= 0 && d != dsel) continue;
        const int col = h * 64 + lane;
        const int vcol = h * 64 + q * 16 + li;
        const float ka = p.in[22][(size_t)j * D + col];
        const bf16_t* LWd = LW + (size_t)d * NT * D; const bf16_t* ADd = AD + (size_t)d * NT * D;
        bf16_t* Yd = Y + (size_t)d * NT * D;
        const int dir = d ? -1 : 1;
        f32x4 T[4];
#pragma unroll
        for (int jb = 0; jb < 4; ++jb) T[jb] = (f32x4){0.f, 0.f, 0.f, 0.f};
        for (int c = 0; c < (TC + TL) / 16; ++c) {
            const int s0 = c * 16;
            int row0;
            if (s0 < TC) row0 = NLAT + b * TC + (d ? (TC - 1 - s0) : s0);
            else { const int tl = s0 - TC; row0 = b * TL + (d ? (TL - 1 - tl) : tl); }
            {
                float cw = 0.f, ep_prev = 1.f;
                unsigned bhp[8], khp[8];
                float bh_e = 0.f, kh_e = 0.f;
#pragma unroll
                for (int t = 0; t < 16; ++t) {
                    const size_t o = (size_t)(row0 + t * dir) * D + col;
                    const float rv = bf2f(R[o]), kkv = bf2f(KK[o]), kv = bf2f(Kb[o]), lwv = bf2f(LWd[o]), av = bf2f(ADd[o]);
                    cw += lwv;
                    const float ep = __expf(cw), em = __expf(-cw);
                    const float kkt = kkv * ep_prev, rt = rv * ep, bhv = kkv * av * em, khv = kv * (1.f + (av - 1.f) * ka) * em;
                    ep_prev = ep;
                    *(LAS bf16_t*)(wl + SC_KKT + t * 128 + lane * 2) = (bf16_t)(pack2(kkt, 0.f) & 0xffffu);
                    *(LAS bf16_t*)(wl + SC_RRT + t * 128 + lane * 2) = (bf16_t)(pack2(rt, 0.f) & 0xffffu);
                    *(LAS bf16_t*)(wl + SC_BHT + t * 128 + lane * 2) = (bf16_t)(pack2(bhv, 0.f) & 0xffffu);
                    *(LAS bf16_t*)(wl + SC_KHT + t * 128 + lane * 2) = (bf16_t)(pack2(khv, 0.f) & 0xffffu);
                    if (t & 1) { bhp[t >> 1] = pack2(bh_e, bhv); khp[t >> 1] = pack2(kh_e, khv); } else { bh_e = bhv; kh_e = khv; }
                }
                *(LAS u32x4*)(wl + SC_BHJ + lane * 32) = (u32x4){bhp[0], bhp[1], bhp[2], bhp[3]};
                *(LAS u32x4*)(wl + SC_BHJ + lane * 32 + 16) = (u32x4){bhp[4], bhp[5], bhp[6], bhp[7]};
                *(LAS u32x4*)(wl + SC_KHJ + lane * 32) = (u32x4){khp[0], khp[1], khp[2], khp[3]};
                *(LAS u32x4*)(wl + SC_KHJ + lane * 32 + 16) = (u32x4){khp[4], khp[5], khp[6], khp[7]};
                *(LAS float*)(wl + SC_WLF + lane * 4) = ep_prev;
            }
            unsigned vw0, vw1;
            {
                const size_t o = (size_t)(row0 + (4 * g) * dir) * D + vcol; const long st = (long)dir * D;
                const unsigned v0 = V[o], v1 = V[o + st], v2 = V[o + 2 * st], v3 = V[o + 3 * st];
                vw0 = v0 | (v1 << 16); vw1 = v2 | (v3 << 16);
            }
            asm volatile("" ::: "memory");
            f32x4 Mb = {0.f, 0.f, 0.f, 0.f}, Mk = Mb, Nb = Mb, Nk = Mb;
#pragma unroll
            for (int kk = 0; kk < 2; ++kk) {
                const int ko = li * 128 + (32 * kk + 8 * g) * 2;
                const bf16x8 aB = *(const LAS bf16x8*)(wl + SC_BHT + ko), aK = *(const LAS bf16x8*)(wl + SC_KHT + ko);
                const bf16x8 bK = *(const LAS bf16x8*)(wl + SC_KKT + ko), bR = *(const LAS bf16x8*)(wl + SC_RRT + ko);
                Mb = __builtin_amdgcn_mfma_f32_16x16x32_bf16(aB, bK, Mb, 0, 0, 0);
                Mk = __builtin_amdgcn_mfma_f32_16x16x32_bf16(aK, bK, Mk, 0, 0, 0);
                Nb = __builtin_amdgcn_mfma_f32_16x16x32_bf16(aB, bR, Nb, 0, 0, 0);
                Nk = __builtin_amdgcn_mfma_f32_16x16x32_bf16(aK, bR, Nk, 0, 0, 0);
            }
#pragma unroll
            for (int r = 0; r < 4; ++r) {
                const int s = 4 * g + r;
                Mb[r] = s < li ? Mb[r] : 0.f; Mk[r] = s < li ? Mk[r] : 0.f;
                Nb[r] = s <= li ? Nb[r] : 0.f; Nk[r] = s <= li ? Nk[r] : 0.f;
            }
            f32x4 PT = {0.f, 0.f, 0.f, 0.f}, QT = PT;
#pragma unroll
            for (int kk = 0; kk < 2; ++kk) {
                const bf16x8 bw = mk8(pack2(T[2 * kk][0], T[2 * kk][1]), pack2(T[2 * kk][2], T[2 * kk][3]), pack2(T[2 * kk + 1][0], T[2 * kk + 1][1]), pack2(T[2 * kk + 1][2], T[2 * kk + 1][3]));
                const int ko = li * 128 + (32 * kk + 4 * g) * 2;
                const u32x2 k0 = *(const LAS u32x2*)(wl + SC_KKT + ko), k1 = *(const LAS u32x2*)(wl + SC_KKT + ko + 32);
                const u32x2 r0 = *(const LAS u32x2*)(wl + SC_RRT + ko), r1 = *(const LAS u32x2*)(wl + SC_RRT + ko + 32);
                PT = __builtin_amdgcn_mfma_f32_16x16x32_bf16(mk8(k0[0], k0[1], k1[0], k1[1]), bw, PT, 0, 0, 0);
                QT = __builtin_amdgcn_mfma_f32_16x16x32_bf16(mk8(r0[0], r0[1], r1[0], r1[1]), bw, QT, 0, 0, 0);
            }
            const f32x4 RT = __builtin_amdgcn_mfma_f32_16x16x32_bf16(mk8(pack2(Mk[0], Mk[1]), pack2(Mk[2], Mk[3]), 0u, 0u), mk8(vw0, vw1, 0u, 0u), PT, 0, 0, 0);
            *(LAS f32x4*)(wl + SC_RHF + li * 64 + g * 16) = RT;
#pragma unroll
            for (int r = 0; r < 4; ++r) *(LAS float*)(wl + SC_MBF + (4 * g + r) * 64 + li * 4) = Mb[r];
            asm volatile("" ::: "memory");
            float x0, x1, x2, x3, x4, x5, x6, x7, x8, x9, x10, x11, x12, x13, x14, x15;
            { const f32x4 u = *(const LAS f32x4*)(wl + SC_RHF + li * 64); x0 = u[0]; x1 = u[1]; x2 = u[2]; x3 = u[3]; }
            { const f32x4 u = *(const LAS f32x4*)(wl + SC_RHF + li * 64 + 16); x4 = u[0]; x5 = u[1]; x6 = u[2]; x7 = u[3]; }
            { const f32x4 u = *(const LAS f32x4*)(wl + SC_RHF + li * 64 + 32); x8 = u[0]; x9 = u[1]; x10 = u[2]; x11 = u[3]; }
            { const f32x4 u = *(const LAS f32x4*)(wl + SC_RHF + li * 64 + 48); x12 = u[0]; x13 = u[1]; x14 = u[2]; x15 = u[3]; }
            float m0, m1, m2, m3, m4, m5, m6, m7, m8, m9, m10, m11, m12, m13, m14;
#define LDM(s) (*(const LAS float*)(wl + SC_MBF + (s) * 64 + li * 4))
            m0 = LDM(0); m1 = LDM(1); m2 = LDM(2); m3 = LDM(3); m4 = LDM(4); m5 = LDM(5); m6 = LDM(6); m7 = LDM(7);
            m8 = LDM(8); m9 = LDM(9); m10 = LDM(10); m11 = LDM(11); m12 = LDM(12); m13 = LDM(13); m14 = LDM(14);
#undef LDM
            asm volatile(TRI_ASM1 : "+v"(x0), "+v"(x1), "+v"(x2), "+v"(x3), "+v"(x4), "+v"(x5), "+v"(x6), "+v"(x7)
                                  : "v"(m0), "v"(m1), "v"(m2), "v"(m3), "v"(m4), "v"(m5), "v"(m6));
            asm volatile(TRI_ASM2 : "+v"(x8), "+v"(x9), "+v"(x10), "+v"(x11), "+v"(x12), "+v"(x13), "+v"(x14), "+v"(x15)
                                  : "v"(x0), "v"(x1), "v"(x2), "v"(x3), "v"(x4), "v"(x5), "v"(x6), "v"(x7), "v"(m0), "v"(m1), "v"(m2), "v"(m3), "v"(m4), "v"(m5), "v"(m6), "v"(m7));
            asm volatile(TRI_ASM3 : "+v"(x8), "+v"(x9), "+v"(x10), "+v"(x11), "+v"(x12), "+v"(x13), "+v"(x14), "+v"(x15)
                                  : "v"(m8), "v"(m9), "v"(m10), "v"(m11), "v"(m12), "v"(m13), "v"(m14));
            const float xs0 = g == 0 ? x0 : (g == 1 ? x4 : (g == 2 ? x8 : x12));
            const float xs1 = g == 0 ? x1 : (g == 1 ? x5 : (g == 2 ? x9 : x13));
            const float xs2 = g == 0 ? x2 : (g == 1 ? x6 : (g == 2 ? x10 : x14));
            const float xs3 = g == 0 ? x3 : (g == 1 ? x7 : (g == 2 ? x11 : x15));
            const bf16x8 bop = mk8(pack2(xs0, xs1), pack2(xs2, xs3), vw0, vw1);
            const f32x4 YT = __builtin_amdgcn_mfma_f32_16x16x32_bf16(mk8(pack2(Nb[0], Nb[1]), pack2(Nb[2], Nb[3]), pack2(Nk[0], Nk[1]), pack2(Nk[2], Nk[3])), bop, QT, 0, 0, 0);
#pragma unroll
            for (int r = 0; r < 4; ++r) Yd[(size_t)(row0 + (4 * g + r) * dir) * D + vcol] = (bf16_t)(pack2(YT[r], 0.f) & 0xffffu);
#pragma unroll
            for (int jb = 0; jb < 4; ++jb) {
                const u32x2 b2 = *(const LAS u32x2*)(wl + SC_BHJ + (16 * jb + li) * 32 + g * 8), k2 = *(const LAS u32x2*)(wl + SC_KHJ + (16 * jb + li) * 32 + g * 8);
                T[jb] = __builtin_amdgcn_mfma_f32_16x16x32_bf16(mk8(b2[0], b2[1], k2[0], k2[1]), bop, T[jb], 0, 0, 0);
                const f32x4 wv = *(const LAS f32x4*)(wl + SC_WLF + (16 * jb + 4 * g) * 4);
                T[jb] = T[jb] * wv;
            }
            asm volatile("" ::: "memory");
        }
    }
}

#define TRI2_ASMA \
    "s_nop 1\n\t" \
    "v_xor_b32 %0, 0x80000000, %0\n\t" \
    "v_fmac_f32_dpp %1, %16, %0 row_newbcast:1 row_mask:0xf bank_mask:0xf\n\t" \
    "v_fmac_f32_dpp %2, %16, %0 row_newbcast:2 row_mask:0xf bank_mask:0xf\n\t" \
    "v_fmac_f32_dpp %3, %16, %0 row_newbcast:3 row_mask:0xf bank_mask:0xf\n\t" \
    "v_fmac_f32_dpp %4, %16, %0 row_newbcast:4 row_mask:0xf bank_mask:0xf\n\t" \
    "v_fmac_f32_dpp %5, %16, %0 row_newbcast:5 row_mask:0xf bank_mask:0xf\n\t" \
    "v_fmac_f32_dpp %6, %16, %0 row_newbcast:6 row_mask:0xf bank_mask:0xf\n\t" \
    "v_fmac_f32_dpp %7, %16, %0 row_newbcast:7 row_mask:0xf bank_mask:0xf\n\t" \
    "v_fmac_f32_dpp %8, %16, %0 row_newbcast:8 row_mask:0xf bank_mask:0xf\n\t" \
    "v_fmac_f32_dpp %9, %16, %0 row_newbcast:9 row_mask:0xf bank_mask:0xf\n\t" \
    "v_fmac_f32_dpp %10, %16, %0 row_newbcast:10 row_mask:0xf bank_mask:0xf\n\t" \
    "v_fmac_f32_dpp %11, %16, %0 row_newbcast:11 row_mask:0xf bank_mask:0xf\n\t" \
    "v_fmac_f32_dpp %12, %16, %0 row_newbcast:12 row_mask:0xf bank_mask:0xf\n\t" \
    "v_fmac_f32_dpp %13, %16, %0 row_newbcast:13 row_mask:0xf bank_mask:0xf\n\t" \
    "v_fmac_f32_dpp %14, %16, %0 row_newbcast:14 row_mask:0xf bank_mask:0xf\n\t" \
    "v_fmac_f32_dpp %15, %16, %0 row_newbcast:15 row_mask:0xf bank_mask:0xf\n\t" \
    "v_xor_b32 %1, 0x80000000, %1\n\t" \
    "v_fmac_f32_dpp %2, %17, %1 row_newbcast:2 row_mask:0xf bank_mask:0xf\n\t" \
    "v_fmac_f32_dpp %3, %17, %1 row_newbcast:3 row_mask:0xf bank_mask:0xf\n\t" \
    "v_fmac_f32_dpp %4, %17, %1 row_newbcast:4 row_mask:0xf bank_mask:0xf\n\t" \
    "v_fmac_f32_dpp %5, %17, %1 row_newbcast:5 row_mask:0xf bank_mask:0xf\n\t" \
    "v_fmac_f32_dpp %6, %17, %1 row_newbcast:6 row_mask:0xf bank_mask:0xf\n\t" \
    "v_fmac_f32_dpp %7, %17, %1 row_newbcast:7 row_mask:0xf bank_mask:0xf\n\t" \
    "v_fmac_f32_dpp %8, %17, %1 row_newbcast:8 row_mask:0xf bank_mask:0xf\n\t" \
    "v_fmac_f32_dpp %9, %17, %1 row_newbcast:9 row_mask:0xf bank_mask:0xf\n\t" \
    "v_fmac_f32_dpp %10, %17, %1 row_newbcast:10 row_mask:0xf bank_mask:0xf\n\t" \
    "v_fmac_f32_dpp %11, %17, %1 row_newbcast:11 row_mask:0xf bank_mask:0xf\n\t" \
    "v_fmac_f32_dpp %12, %17, %1 row_newbcast:12 row_mask:0xf bank_mask:0xf\n\t" \
    "v_fmac_f32_dpp %13, %17, %1 row_newbcast:13 row_mask:0xf bank_mask:0xf\n\t" \
    "v_fmac_f32_dpp %14, %17, %1 row_newbcast:14 row_mask:0xf bank_mask:0xf\n\t" \
    "v_fmac_f32_dpp %15, %17, %1 row_newbcast:15 row_mask:0xf bank_mask:0xf\n\t" \
    "v_xor_b32 %2, 0x80000000, %2\n\t" \
    "v_fmac_f32_dpp %3, %18, %2 row_newbcast:3 row_mask:0xf bank_mask:0xf\n\t" \
    "v_fmac_f32_dpp %4, %18, %2 row_newbcast:4 row_mask:0xf bank_mask:0xf\n\t" \
    "v_fmac_f32_dpp %5, %18, %2 row_newbcast:5 row_mask:0xf bank_mask:0xf\n\t" \
    "v_fmac_f32_dpp %6, %18, %2 row_newbcast:6 row_mask:0xf bank_mask:0xf\n\t" \
    "v_fmac_f32_dpp %7, %18, %2 row_newbcast:7 row_mask:0xf bank_mask:0xf\n\t" \
    "v_fmac_f32_dpp %8, %18, %2 row_newbcast:8 row_mask:0xf bank_mask:0xf\n\t" \
    "v_fmac_f32_dpp %9, %18, %2 row_newbcast:9 row_mask:0xf bank_mask:0xf\n\t" \
    "v_fmac_f32_dpp %10, %18, %2 row_newbcast:10 row_mask:0xf bank_mask:0xf\n\t" \
    "v_fmac_f32_dpp %11, %18, %2 row_newbcast:11 row_mask:0xf bank_mask:0xf\n\t" \
    "v_fmac_f32_dpp %12, %18, %2 row_newbcast:12 row_mask:0xf bank_mask:0xf\n\t" \
    "v_fmac_f32_dpp %13, %18, %2 row_newbcast:13 row_mask:0xf bank_mask:0xf\n\t" \
    "v_fmac_f32_dpp %14, %18, %2 row_newbcast:14 row_mask:0xf bank_mask:0xf\n\t" \
    "v_fmac_f32_dpp %15, %18, %2 row_newbcast:15 row_mask:0xf bank_mask:0xf\n\t" \
    "v_xor_b32 %3, 0x80000000, %3\n\t" \
    "v_fmac_f32_dpp %4, %19, %3 row_newbcast:4 row_mask:0xf bank_mask:0xf\n\t" \
    "v_fmac_f32_dpp %5, %19, %3 row_newbcast:5 row_mask:0xf bank_mask:0xf\n\t" \
    "v_fmac_f32_dpp %6, %19, %3 row_newbcast:6 row_mask:0xf bank_mask:0xf\n\t" \
    "v_fmac_f32_dpp %7, %19, %3 row_newbcast:7 row_mask:0xf bank_mask:0xf\n\t" \
    "v_fmac_f32_dpp %8, %19, %3 row_newbcast:8 row_mask:0xf bank_mask:0xf\n\t" \
    "v_fmac_f32_dpp %9, %19, %3 row_newbcast:9 row_mask:0xf bank_mask:0xf\n\t" \
    "v_fmac_f32_dpp %10, %19, %3 row_newbcast:10 row_mask:0xf bank_mask:0xf\n\t" \
    "v_fmac_f32_dpp %11, %19, %3 row_newbcast:11 row_mask:0xf bank_mask:0xf\n\t" \
    "v_fmac_f32_dpp %12, %19, %3 row_newbcast:12 row_mask:0xf bank_mask:0xf\n\t" \
    "v_fmac_f32_dpp %13, %19, %3 row_newbcast:13 row_mask:0xf bank_mask:0xf\n\t" \
    "v_fmac_f32_dpp %14, %19, %3 row_newbcast:14 row_mask:0xf bank_mask:0xf\n\t" \
    "v_fmac_f32_dpp %15, %19, %3 row_newbcast:15 row_mask:0xf bank_mask:0xf\n\t" \
    "v_xor_b32 %4, 0x80000000, %4\n\t" \
    "v_fmac_f32_dpp %5, %20, %4 row_newbcast:5 row_mask:0xf bank_mask:0xf\n\t" \
    "v_fmac_f32_dpp %6, %20, %4 row_newbcast:6 row_mask:0xf bank_mask:0xf\n\t" \
    "v_fmac_f32_dpp %7, %20, %4 row_newbcast:7 row_mask:0xf bank_mask:0xf\n\t" \
    "v_fmac_f32_dpp %8, %20, %4 row_newbcast:8 row_mask:0xf bank_mask:0xf\n\t" \
    "v_fmac_f32_dpp %9, %20, %4 row_newbcast:9 row_mask:0xf bank_mask:0xf\n\t" \
    "v_fmac_f32_dpp %10, %20, %4 row_newbcast:10 row_mask:0xf bank_mask:0xf\n\t" \
    "v_fmac_f32_dpp %11, %20, %4 row_newbcast:11 row_mask:0xf bank_mask:0xf\n\t" \
    "v_fmac_f32_dpp %12, %20, %4 row_newbcast:12 row_mask:0xf bank_mask:0xf\n\t" \
    "v_fmac_f32_dpp %13, %20, %4 row_newbcast:13 row_mask:0xf bank_mask:0xf\n\t" \
    "v_fmac_f32_dpp %14, %20, %4 row_newbcast:14 row_mask:0xf bank_mask:0xf\n\t" \
    "v_fmac_f32_dpp %15, %20, %4 row_newbcast:15 row_mask:0xf bank_mask:0xf\n\t" \
    "v_xor_b32 %5, 0x80000000, %5\n\t" \
    "v_fmac_f32_dpp %6, %21, %5 row_newbcast:6 row_mask:0xf bank_mask:0xf\n\t" \
    "v_fmac_f32_dpp %7, %21, %5 row_newbcast:7 row_mask:0xf bank_mask:0xf\n\t" \
    "v_fmac_f32_dpp %8, %21, %5 row_newbcast:8 row_mask:0xf bank_mask:0xf\n\t" \
    "v_fmac_f32_dpp %9, %21, %5 row_newbcast:9 row_mask:0xf bank_mask:0xf\n\t" \
    "v_fmac_f32_dpp %10, %21, %5 row_newbcast:10 row_mask:0xf bank_mask:0xf\n\t" \
    "v_fmac_f32_dpp %11, %21, %5 row_newbcast:11 row_mask:0xf bank_mask:0xf\n\t" \
    "v_fmac_f32_dpp %12, %21, %5 row_newbcast:12 row_mask:0xf bank_mask:0xf\n\t" \
    "v_fmac_f32_dpp %13, %21, %5 row_newbcast:13 row_mask:0xf bank_mask:0xf\n\t" \
    "v_fmac_f32_dpp %14, %21, %5 row_newbcast:14 row_mask:0xf bank_mask:0xf\n\t" \
    "v_fmac_f32_dpp %15, %21, %5 row_newbcast:15 row_mask:0xf bank_mask:0xf\n\t" \
    "v_xor_b32 %6, 0x80000000, %6\n\t" \
    "v_fmac_f32_dpp %7, %22, %6 row_newbcast:7 row_mask:0xf bank_mask:0xf\n\t" \
    "v_fmac_f32_dpp %8, %22, %6 row_newbcast:8 row_mask:0xf bank_mask:0xf\n\t" \
    "v_fmac_f32_dpp %9, %22, %6 row_newbcast:9 row_mask:0xf bank_mask:0xf\n\t" \
    "v_fmac_f32_dpp %10, %22, %6 row_newbcast:10 row_mask:0xf bank_mask:0xf\n\t" \
    "v_fmac_f32_dpp %11, %22, %6 row_newbcast:11 row_mask:0xf bank_mask:0xf\n\t" \
    "v_fmac_f32_dpp %12, %22, %6 row_newbcast:12 row_mask:0xf bank_mask:0xf\n\t" \
    "v_fmac_f32_dpp %13, %22, %6 row_newbcast:13 row_mask:0xf bank_mask:0xf\n\t" \
    "v_fmac_f32_dpp %14, %22, %6 row_newbcast:14 row_mask:0xf bank_mask:0xf\n\t" \
    "v_fmac_f32_dpp %15, %22, %6 row_newbcast:15 row_mask:0xf bank_mask:0xf\n\t" \
    "v_xor_b32 %7, 0x80000000, %7\n\t" \
    "v_fmac_f32_dpp %8, %23, %7 row_newbcast:8 row_mask:0xf bank_mask:0xf\n\t" \
    "v_fmac_f32_dpp %9, %23, %7 row_newbcast:9 row_mask:0xf bank_mask:0xf\n\t" \
    "v_fmac_f32_dpp %10, %23, %7 row_newbcast:10 row_mask:0xf bank_mask:0xf\n\t" \
    "v_fmac_f32_dpp %11, %23, %7 row_newbcast:11 row_mask:0xf bank_mask:0xf\n\t" \
    "v_fmac_f32_dpp %12, %23, %7 row_newbcast:12 row_mask:0xf bank_mask:0xf\n\t" \
    "v_fmac_f32_dpp %13, %23, %7 row_newbcast:13 row_mask:0xf bank_mask:0xf\n\t" \
    "v_fmac_f32_dpp %14, %23, %7 row_newbcast:14 row_mask:0xf bank_mask:0xf\n\t" \
    "v_fmac_f32_dpp %15, %23, %7 row_newbcast:15 row_mask:0xf bank_mask:0xf\n\t" \
    ""
#define TRI2_ASMB \
    "s_nop 1\n\t" \
    "v_xor_b32 %0, 0x80000000, %0\n\t" \
    "v_fmac_f32_dpp %1, %8, %0 row_newbcast:9 row_mask:0xf bank_mask:0xf\n\t" \
    "v_fmac_f32_dpp %2, %8, %0 row_newbcast:10 row_mask:0xf bank_mask:0xf\n\t" \
    "v_fmac_f32_dpp %3, %8, %0 row_newbcast:11 row_mask:0xf bank_mask:0xf\n\t" \
    "v_fmac_f32_dpp %4, %8, %0 row_newbcast:12 row_mask:0xf bank_mask:0xf\n\t" \
    "v_fmac_f32_dpp %5, %8, %0 row_newbcast:13 row_mask:0xf bank_mask:0xf\n\t" \
    "v_fmac_f32_dpp %6, %8, %0 row_newbcast:14 row_mask:0xf bank_mask:0xf\n\t" \
    "v_fmac_f32_dpp %7, %8, %0 row_newbcast:15 row_mask:0xf bank_mask:0xf\n\t" \
    "v_xor_b32 %1, 0x80000000, %1\n\t" \
    "v_fmac_f32_dpp %2, %9, %1 row_newbcast:10 row_mask:0xf bank_mask:0xf\n\t" \
    "v_fmac_f32_dpp %3, %9, %1 row_newbcast:11 row_mask:0xf bank_mask:0xf\n\t" \
    "v_fmac_f32_dpp %4, %9, %1 row_newbcast:12 row_mask:0xf bank_mask:0xf\n\t" \
    "v_fmac_f32_dpp %5, %9, %1 row_newbcast:13 row_mask:0xf bank_mask:0xf\n\t" \
    "v_fmac_f32_dpp %6, %9, %1 row_newbcast:14 row_mask:0xf bank_mask:0xf\n\t" \
    "v_fmac_f32_dpp %7, %9, %1 row_newbcast:15 row_mask:0xf bank_mask:0xf\n\t" \
    "v_xor_b32 %2, 0x80000000, %2\n\t" \
    "v_fmac_f32_dpp %3, %10, %2 row_newbcast:11 row_mask:0xf bank_mask:0xf\n\t" \
    "v_fmac_f32_dpp %4, %10, %2 row_newbcast:12 row_mask:0xf bank_mask:0xf\n\t" \
    "v_fmac_f32_dpp %5, %10, %2 row_newbcast:13 row_mask:0xf bank_mask:0xf\n\t" \
    "v_fmac_f32_dpp %6, %10, %2 row_newbcast:14 row_mask:0xf bank_mask:0xf\n\t" \
    "v_fmac_f32_dpp %7, %10, %2 row_newbcast:15 row_mask:0xf bank_mask:0xf\n\t" \
    "v_xor_b32 %3, 0x80000000, %3\n\t" \
    "v_fmac_f32_dpp %4, %11, %3 row_newbcast:12 row_mask:0xf bank_mask:0xf\n\t" \
    "v_fmac_f32_dpp %5, %11, %3 row_newbcast:13 row_mask:0xf bank_mask:0xf\n\t" \
    "v_fmac_f32_dpp %6, %11, %3 row_newbcast:14 row_mask:0xf bank_mask:0xf\n\t" \
    "v_fmac_f32_dpp %7, %11, %3 row_newbcast:15 row_mask:0xf bank_mask:0xf\n\t" \
    "v_xor_b32 %4, 0x80000000, %4\n\t" \
    "v_fmac_f32_dpp %5, %12, %4 row_newbcast:13 row_mask:0xf bank_mask:0xf\n\t" \
    "v_fmac_f32_dpp %6, %12, %4 row_newbcast:14 row_mask:0xf bank_mask:0xf\n\t" \
    "v_fmac_f32_dpp %7, %12, %4 row_newbcast:15 row_mask:0xf bank_mask:0xf\n\t" \
    "v_xor_b32 %5, 0x80000000, %5\n\t" \
    "v_fmac_f32_dpp %6, %13, %5 row_newbcast:14 row_mask:0xf bank_mask:0xf\n\t" \
    "v_fmac_f32_dpp %7, %13, %5 row_newbcast:15 row_mask:0xf bank_mask:0xf\n\t" \
    "v_xor_b32 %6, 0x80000000, %6\n\t" \
    "v_fmac_f32_dpp %7, %14, %6 row_newbcast:15 row_mask:0xf bank_mask:0xf\n\t" \
    "v_xor_b32 %7, 0x80000000, %7\n\t" \
    ""

constexpr int S3_RS = 144;
constexpr int S3_KKT = 0, S3_RRT = 2304, S3_BHT = 4608, S3_KHT = 6912, S3_BHJ = 9216, S3_KHJ = 11264, S3_WLF = 13312, S3_IMG = 13568;
constexpr int S3_PRIV = 4 * S3_IMG, S3_MBF = 0, S3_RHF = 1024, S3_PSTRIDE = 2048;
__device__ __forceinline__ void phase_rwkv_scan3(const Params& p, int j, char* lds_, bf16_t* Y) {
    const bf16_t* R = (const bf16_t*)(p.ws + OFF_R); const bf16_t* Kb = (const bf16_t*)(p.ws + OFF_K);
    const bf16_t* V = (const bf16_t*)(p.ws + OFF_VF); const bf16_t* KK = (const bf16_t*)(p.ws + OFF_H);
    const bf16_t* LW = (const bf16_t*)(p.ws + OFF_LW); const bf16_t* AD = (const bf16_t*)(p.ws + OFF_AD);
    const int tid = tidx(), lane = tid & 63, wid = __builtin_amdgcn_readfirstlane(tid >> 6), cl = wid >> 2, q = wid & 3, g = lane >> 4, li = lane & 15;
    LAS unsigned char* img0 = (LAS unsigned char*)lds_ + cl * 2 * S3_IMG;
    LAS unsigned char* pw = (LAS unsigned char*)lds_ + S3_PRIV + wid * S3_PSTRIDE;
    f32x4 msk_lt, msk_le, msk_gt;
#pragma unroll
    for (int r = 0; r < 4; ++r) { msk_lt[r] = (4 * g + r) < li ? 1.f : 0.f; msk_le[r] = (4 * g + r) <= li ? 1.f : 0.f; msk_gt[r] = (4 * g + r) > li ? 1.f : 0.f; }
    for (int cp = blockIdx.x; cp < 256; cp += gridDim.x) {
        const int chain = cp * 2 + cl, d = chain & 1, bh = chain >> 1, b = bh >> 4, h = bh & 15;
        const int vcol = h * 64 + q * 16 + li, vcolw = vcol & ~1, jcol = q * 16 + li;
        const unsigned selv = (vcol & 1) ? 0x03020c0cu : 0x01000c0cu;
        const unsigned selp = (vcol & 1) ? 0x07060302u : 0x05040100u;
        const float ka = p.in[22][(size_t)j * D + vcol];
        const bf16_t* ADd = AD + (size_t)d * NT * D;
        const bf16_t* w2t = wsm(p, j, WJ_W2) + (size_t)d * D * 64 + (size_t)vcol * 64;
        const bf16x8 Bw0 = *(const bf16x8*)(w2t + g * 8), Bw1 = *(const bf16x8*)(w2t + 32 + g * 8);
        const float w0b = p.in[10][((size_t)j * 2 + d) * D + vcol] * -1.44269504089f;
        const bf16_t* LD0 = (const bf16_t*)(p.ws + OFF_LD);
        const unsigned voa = (unsigned)((d ? 15 - li : li) * 256 + (d * 64 + g * 8) * 2);
        bf16_t* Yd = Y + (size_t)d * NT * D;
        const int dir = d ? -1 : 1;
        auto row_first = [&](int c) -> int {
            const int s0 = c * 16;
            if (s0 < TC) return NLAT + b * TC + (d ? (TC - 1 - s0) : s0);
            const int tl = s0 - TC; return b * TL + (d ? (TL - 1 - tl) : tl);
        };
#define UNPV(w) __uint_as_float(__builtin_amdgcn_perm(0u, (w), selv))
        const unsigned LA0 = ((4 * g <= li) ? 0x3F80u : 0u) | ((4 * g + 1 <= li) ? 0x3F800000u : 0u), LA1 = ((4 * g + 2 <= li) ? 0x3F80u : 0u) | ((4 * g + 3 <= li) ? 0x3F800000u : 0u);
        unsigned vov[4];
#pragma unroll
        for (int e = 0; e < 4; ++e) vov[e] = (unsigned)((d ? 15 - (4 * g + e) : 4 * g + e) * (D * 2) + vcolw * 2);
#define LDG(P, VO) (*(const unsigned*)((P) + (VO)))
        unsigned rr[4], rkk[4], rk[4], ra[4], rv[4]; bf16x8 rwa0, rwa1;
        auto issue_loads = [&](int c) {
            const int r0 = row_first(c);
            const size_t rbo = (size_t)(d ? r0 - 15 : r0) * (D * 2);
            const char* bLD = (const char*)LD0 + (size_t)(d ? r0 - 15 : r0) * 256; const char* bR = (const char*)R + rbo; const char* bKK = (const char*)KK + rbo;
            const char* bK = (const char*)Kb + rbo; const char* bA = (const char*)ADd + rbo; const char* bV = (const char*)V + rbo;
#pragma unroll
            for (int e = 0; e < 4; ++e) { rr[e] = LDG(bR, vov[e]); rkk[e] = LDG(bKK, vov[e]); rk[e] = LDG(bK, vov[e]); ra[e] = LDG(bA, vov[e]); rv[e] = LDG(bV, vov[e]); }
            rwa0 = *(const bf16x8*)(bLD + voa); rwa1 = *(const bf16x8*)(bLD + voa + 64);
        };
        issue_loads(0);
        f32x4 T[4];
#pragma unroll
        for (int jb = 0; jb < 4; ++jb) T[jb] = (f32x4){0.f, 0.f, 0.f, 0.f};
        auto do_prep = [&](int cc, unsigned& w0, unsigned& w1) {
            LAS unsigned char* im = img0 + (cc & 1) * S3_IMG;
            {
                const f32x4 Z4p = {0.f, 0.f, 0.f, 0.f};
                f32x4 WP = __builtin_amdgcn_mfma_f32_16x16x32_bf16(rwa0, Bw0, Z4p, 0, 0, 0);
                WP = __builtin_amdgcn_mfma_f32_16x16x32_bf16(rwa1, Bw1, WP, 0, 0, 0);
                unsigned lwp0, lwp1;
                {
                    const f32x2_t x0 = {WP[0], WP[1]}, x1 = {WP[2], WP[3]};
                    const f32x2_t t0 = x0 * -1.44269504089f + w0b, t1 = x1 * -1.44269504089f + w0b;
                    f32x2_t e0, e1; e0.x = __builtin_amdgcn_exp2f(t0.x); e0.y = __builtin_amdgcn_exp2f(t0.y); e1.x = __builtin_amdgcn_exp2f(t1.x); e1.y = __builtin_amdgcn_exp2f(t1.y);
                    const f32x2_t d0 = e0 + 1.0f, d1 = e1 + 1.0f;
                    lwp0 = pack2(-0.6065306597f * __builtin_amdgcn_rcpf(d0.x), -0.6065306597f * __builtin_amdgcn_rcpf(d0.y));
                    lwp1 = pack2(-0.6065306597f * __builtin_amdgcn_rcpf(d1.x), -0.6065306597f * __builtin_amdgcn_rcpf(d1.y));
                }
                const f32x4 CW = __builtin_amdgcn_mfma_f32_16x16x16bf16_1k(mk4(LA0, LA1), mk4(lwp0, lwp1), Z4p, 0, 0, 0);
                float ep_prev = __expf(CW[0] - bflo(lwp0));
                float bhv[4], khv[4];
#pragma unroll
                for (int e = 0; e < 4; ++e) {
                    const int t = 4 * g + e;
                    const float rvv = UNPV(rr[e]), kkv = UNPV(rkk[e]), kv = UNPV(rk[e]), av = UNPV(ra[e]);
                    const float ep = __expf(CW[e]), em = __expf(-CW[e]);
                    const float kkt = kkv * ep_prev, rt = rvv * ep;
                    bhv[e] = kkv * av * em; khv[e] = kv * (1.f + (av - 1.f) * ka) * em;
                    ep_prev = ep;
                    *(LAS bf16_t*)(im + S3_KKT + t * S3_RS + jcol * 2) = (bf16_t)(pack2(kkt, 0.f) & 0xffffu);
                    *(LAS bf16_t*)(im + S3_RRT + t * S3_RS + jcol * 2) = (bf16_t)(pack2(rt, 0.f) & 0xffffu);
                    *(LAS bf16_t*)(im + S3_BHT + t * S3_RS + jcol * 2) = (bf16_t)(pack2(bhv[e], 0.f) & 0xffffu);
                    *(LAS bf16_t*)(im + S3_KHT + t * S3_RS + jcol * 2) = (bf16_t)(pack2(khv[e], 0.f) & 0xffffu);
                }
                *(LAS u32x2*)(im + S3_BHJ + jcol * 32 + g * 8) = (u32x2){pack2(bhv[0], bhv[1]), pack2(bhv[2], bhv[3])};
                *(LAS u32x2*)(im + S3_KHJ + jcol * 32 + g * 8) = (u32x2){pack2(khv[0], khv[1]), pack2(khv[2], khv[3])};
                if (g == 3) *(LAS float*)(im + S3_WLF + jcol * 4) = ep_prev;
                w0 = __builtin_amdgcn_perm(rv[1], rv[0], selp); w1 = __builtin_amdgcn_perm(rv[3], rv[2], selp);
            }
        };
        constexpr int NCH = (TC + TL) / 16;
        unsigned vw0, vw1, vwn0 = 0u, vwn1 = 0u;
        do_prep(0, vw0, vw1);
        issue_loads(1);
        for (int c = 0; c < NCH; ++c) {
            const int row0 = row_first(c);
            LAS unsigned char* im = img0 + (c & 1) * S3_IMG;
            asm volatile("s_waitcnt lgkmcnt(0)" ::: "memory");
            __builtin_amdgcn_s_barrier();
            asm volatile("" ::: "memory");
            if (c + 1 < NCH) { do_prep(c + 1, vwn0, vwn1); if (c + 2 < NCH) issue_loads(c + 2); }
            f32x4 Mb = {0.f, 0.f, 0.f, 0.f}, Mk = Mb, Nb = Mb, Nk = Mb, MbT = Mb;
#pragma unroll
            for (int kk = 0; kk < 2; ++kk) {
                const int ko = li * S3_RS + (32 * kk + 8 * g) * 2;
                const bf16x8 aB = *(const LAS bf16x8*)(im + S3_BHT + ko), aK = *(const LAS bf16x8*)(im + S3_KHT + ko);
                const bf16x8 bK = *(const LAS bf16x8*)(im + S3_KKT + ko), bR = *(const LAS bf16x8*)(im + S3_RRT + ko);
                Mb = __builtin_amdgcn_mfma_f32_16x16x32_bf16(aB, bK, Mb, 0, 0, 0);
                MbT = __builtin_amdgcn_mfma_f32_16x16x32_bf16(bK, aB, MbT, 0, 0, 0);
                Mk = __builtin_amdgcn_mfma_f32_16x16x32_bf16(aK, bK, Mk, 0, 0, 0);
                Nb = __builtin_amdgcn_mfma_f32_16x16x32_bf16(aB, bR, Nb, 0, 0, 0);
                Nk = __builtin_amdgcn_mfma_f32_16x16x32_bf16(aK, bR, Nk, 0, 0, 0);
            }
            Mb = Mb * msk_lt; Mk = Mk * msk_lt; Nb = Nb * msk_le; Nk = Nk * msk_le; MbT = MbT * msk_gt;
            f32x4 PT = {0.f, 0.f, 0.f, 0.f}, QT = PT;
#pragma unroll
            for (int kk = 0; kk < 2; ++kk) {
                const bf16x8 bw = mk8(pack2(T[2 * kk][0], T[2 * kk][1]), pack2(T[2 * kk][2], T[2 * kk][3]), pack2(T[2 * kk + 1][0], T[2 * kk + 1][1]), pack2(T[2 * kk + 1][2], T[2 * kk + 1][3]));
                const int ko = li * S3_RS + (32 * kk + 4 * g) * 2;
                const u32x2 k0 = *(const LAS u32x2*)(im + S3_KKT + ko), k1 = *(const LAS u32x2*)(im + S3_KKT + ko + 32);
                const u32x2 r0 = *(const LAS u32x2*)(im + S3_RRT + ko), r1 = *(const LAS u32x2*)(im + S3_RRT + ko + 32);
                PT = __builtin_amdgcn_mfma_f32_16x16x32_bf16(mk8(k0[0], k0[1], k1[0], k1[1]), bw, PT, 0, 0, 0);
                QT = __builtin_amdgcn_mfma_f32_16x16x32_bf16(mk8(r0[0], r0[1], r1[0], r1[1]), bw, QT, 0, 0, 0);
            }
            const f32x4 RT = __builtin_amdgcn_mfma_f32_16x16x16bf16_1k(mk4(pack2(Mk[0], Mk[1]), pack2(Mk[2], Mk[3])), mk4(vw0, vw1), PT, 0, 0, 0);
#define CW(Y) pack2((Y)[0], (Y)[1]), pack2((Y)[2], (Y)[3])
#define OPND(w0, w1) mk4((w0), (w1))
            const f32x4 Z4 = {0.f, 0.f, 0.f, 0.f};
            const unsigned mb0 = pack2(Mb[0], Mb[1]), mb1 = pack2(Mb[2], Mb[3]), mt0 = pack2(MbT[0], MbT[1]), mt1 = pack2(MbT[2], MbT[3]);
            const f32x4 P1 = __builtin_amdgcn_mfma_f32_16x16x16bf16_1k(OPND(mt0, mt1), OPND(mb0, mb1), Z4, 0, 0, 0);
            const f32x4 P1T = __builtin_amdgcn_mfma_f32_16x16x16bf16_1k(OPND(mb0, mb1), OPND(mt0, mt1), Z4, 0, 0, 0);
            const unsigned p10 = pack2(P1[0], P1[1]), p11 = pack2(P1[2], P1[3]), q10 = pack2(P1T[0], P1T[1]), q11 = pack2(P1T[2], P1T[3]);
            const f32x4 P2 = __builtin_amdgcn_mfma_f32_16x16x16bf16_1k(OPND(q10, q11), OPND(p10, p11), Z4, 0, 0, 0);
            const f32x4 P2T = __builtin_amdgcn_mfma_f32_16x16x16bf16_1k(OPND(p10, p11), OPND(q10, q11), Z4, 0, 0, 0);
            const unsigned p20 = pack2(P2[0], P2[1]), p21 = pack2(P2[2], P2[3]), q20 = pack2(P2T[0], P2T[1]), q21 = pack2(P2T[2], P2T[3]);
            const f32x4 P3 = __builtin_amdgcn_mfma_f32_16x16x16bf16_1k(OPND(q20, q21), OPND(p20, p21), Z4, 0, 0, 0);
            const unsigned p30 = pack2(P3[0], P3[1]), p31 = pack2(P3[2], P3[3]);
            f32x4 Yv = __builtin_amdgcn_mfma_f32_16x16x16bf16_1k(OPND(mb0 ^ 0x80008000u, mb1 ^ 0x80008000u), OPND(pack2(RT[0], RT[1]), pack2(RT[2], RT[3])), RT, 0, 0, 0);
            Yv = __builtin_amdgcn_mfma_f32_16x16x16bf16_1k(OPND(p10, p11), OPND(pack2(Yv[0], Yv[1]), pack2(Yv[2], Yv[3])), Yv, 0, 0, 0);
            Yv = __builtin_amdgcn_mfma_f32_16x16x16bf16_1k(OPND(p20, p21), OPND(pack2(Yv[0], Yv[1]), pack2(Yv[2], Yv[3])), Yv, 0, 0, 0);
            Yv = __builtin_amdgcn_mfma_f32_16x16x16bf16_1k(OPND(p30, p31), OPND(pack2(Yv[0], Yv[1]), pack2(Yv[2], Yv[3])), Yv, 0, 0, 0);
#undef CW
#undef OPND
            const bf16x8 bop = mk8(pack2(Yv[0], Yv[1]) ^ 0x80008000u, pack2(Yv[2], Yv[3]) ^ 0x80008000u, vw0, vw1);
            const f32x4 YT = __builtin_amdgcn_mfma_f32_16x16x32_bf16(mk8(pack2(Nb[0], Nb[1]), pack2(Nb[2], Nb[3]), pack2(Nk[0], Nk[1]), pack2(Nk[2], Nk[3])), bop, QT, 0, 0, 0);
#pragma unroll
            for (int r = 0; r < 4; ++r) Yd[(size_t)(row0 + (4 * g + r) * dir) * D + vcol] = (bf16_t)(pack2(YT[r], 0.f) & 0xffffu);
#pragma unroll
            for (int jb = 0; jb < 4; ++jb) {
                const u32x2 b2 = *(const LAS u32x2*)(im + S3_BHJ + (16 * jb + li) * 32 + g * 8), k2 = *(const LAS u32x2*)(im + S3_KHJ + (16 * jb + li) * 32 + g * 8);
                T[jb] = __builtin_amdgcn_mfma_f32_16x16x32_bf16(mk8(b2[0], b2[1], k2[0], k2[1]), bop, T[jb], 0, 0, 0);
                const f32x4 wv = *(const LAS f32x4*)(im + S3_WLF + (16 * jb + 4 * g) * 4);
                T[jb] = T[jb] * wv;
            }
            vw0 = vwn0; vw1 = vwn1;
        }
#undef LDG
#undef UNPV
        asm volatile("s_waitcnt lgkmcnt(0)" ::: "memory");
        __builtin_amdgcn_s_barrier();
    }
}

#ifndef SCAN2_MODE
#define SCAN2_MODE 3
#endif
constexpr size_t OFF_Y2DBG = OFF_BIG + 13 * U + U / 2;
__device__ __forceinline__ void phase_scan_compare(const Params& p) {
    const bf16_t* Y = (const bf16_t*)(p.ws + OFF_Y); const bf16_t* Y2 = (const bf16_t*)(p.ws + OFF_Y2DBG);
    float* accp = (float*)(p.ws + OFF_BAR + 16384);
    float e2 = 0.f, y2 = 0.f;
    for (size_t i = (size_t)blockIdx.x * NTHREADS + tidx(); i < (size_t)NT * D / 2; i += (size_t)gridDim.x * NTHREADS) {
        const unsigned a = ((const unsigned*)Y)[i], b = ((const unsigned*)Y2)[i];
        const float a0 = bflo(a), a1 = bfhi(a), b0 = bflo(b), b1 = bfhi(b);
        e2 += (a0 - b0) * (a0 - b0) + (a1 - b1) * (a1 - b1); y2 += a0 * a0 + a1 * a1;
    }
    e2 = wave_sum(e2); y2 = wave_sum(y2);
    if ((tidx() & 63) == 0) { atomicAdd(accp, e2); atomicAdd(accp + 1, y2); }
}

__device__ __forceinline__ void phase_rwkv_out(const Params& p, int j) {
    const bf16_t* Y = (const bf16_t*)(p.ws + OFF_Y); const bf16_t* V = (const bf16_t*)(p.ws + OFF_VF); const bf16_t* G = (const bf16_t*)(p.ws + OFF_G);
    const float* BON = (const float*)(p.ws + OFF_BON);
    bf16_t* YO = (bf16_t*)(p.ws + OFF_LW);
    const float* lnw = p.in[24] + (size_t)j * D; const float* lnb = p.in[25] + (size_t)j * D;
    const int tid_ = tidx(), lane = tid_ & 63, wid = tid_ >> 6, c0 = lane * 16;
    float lw[16], lb[16];
#pragma unroll
    for (int i = 0; i < 16; ++i) { lw[i] = lnw[c0 + i]; lb[i] = lnb[c0 + i]; }
    constexpr int RW = 2;
    for (int grp = blockIdx.x * 8 + wid; grp < NT / RW; grp += gridDim.x * 8) {
        u32x4 y0[RW][2], y1[RW][2], vv[RW][2], gg[RW][2]; float bon[RW];
#pragma unroll
        for (int r = 0; r < RW; ++r) {
            const size_t o = (size_t)(grp * RW + r) * D + c0;
#pragma unroll
            for (int i = 0; i < 2; ++i) {
                y0[r][i] = *(const u32x4*)(Y + o + i * 8); y1[r][i] = *(const u32x4*)(Y + (size_t)NT * D + o + i * 8);
                vv[r][i] = *(const u32x4*)(V + o + i * 8); gg[r][i] = *(const u32x4*)(G + o + i * 8);
            }
            bon[r] = BON[(size_t)(grp * RW + r) * 16 + (lane >> 2)];
        }
#pragma unroll
        for (int r = 0; r < RW; ++r) {
            const size_t o = (size_t)(grp * RW + r) * D + c0;
            float ov[16]; float s1 = 0.f;
#pragma unroll
            for (int i = 0; i < 16; ++i) {
                const unsigned w0 = y0[r][i >> 3][(i >> 1) & 3], w1 = y1[r][i >> 3][(i >> 1) & 3];
                ov[i] = ((i & 1) ? bfhi(w0) : bflo(w0)) + ((i & 1) ? bfhi(w1) : bflo(w1));
                s1 += ov[i];
            }
            s1 += __shfl_xor(s1, 1, 64); s1 += __shfl_xor(s1, 2, 64);
            const float mu = s1 * (1.f / 64.f);
            float s2 = 0.f;
#pragma unroll
            for (int i = 0; i < 16; ++i) { const float dd = ov[i] - mu; s2 += dd * dd; }
            s2 += __shfl_xor(s2, 1, 64); s2 += __shfl_xor(s2, 2, 64);
            const float rs = rsqrtf(s2 * (1.f / 64.f) + 64e-5f);
            float res[16];
#pragma unroll
            for (int i = 0; i < 16; ++i) {
                const unsigned vw = vv[r][i >> 3][(i >> 1) & 3], gw = gg[r][i >> 3][(i >> 1) & 3];
                const float v = (i & 1) ? bfhi(vw) : bflo(vw), g = (i & 1) ? bfhi(gw) : bflo(gw);
                res[i] = ((ov[i] - mu) * rs * lw[i] + lb[i] + bon[r] * v) * g;
            }
            u32x4 w[2];
#pragma unroll
            for (int i = 0; i < 8; ++i) w[i >> 2][i & 3] = pack2(res[2 * i], res[2 * i + 1]);
            *(u32x4*)(YO + o) = w[0]; *(u32x4*)(YO + o + 8) = w[1];
        }
    }
}

__device__ __forceinline__ void phase_rwkv_out2(const Params& p, int j, char* lds) {
    const bf16_t* A = (const bf16_t*)(p.ws + OFF_LD) + (size_t)2 * NT * 128;
    const bf16_t* Bt = wsm(p, j, WJ_G2);
    const bf16_t* Y = (const bf16_t*)(p.ws + OFF_Y); const bf16_t* V = (const bf16_t*)(p.ws + OFF_VF);
    const float* BON = (const float*)(p.ws + OFF_BON); const float* BON2 = (const float*)(p.ws + OFF_BON2);
    bf16_t* YO = (bf16_t*)(p.ws + OFF_LW);
    const float* lnw = p.in[24] + (size_t)j * D; const float* lnb = p.in[25] + (size_t)j * D;
    float* lwl = (float*)lds;
    constexpr int TR = 64, RT = NT / TR, NRC = 64, RPC = RT / NRC, KS = 4;
    const int tid = tidx(), lane = tid & 63, wid = tid >> 6, wr = wid >> 2, wc = wid & 3, fr = lane & 15, fq = lane >> 4;
    for (int u = blockIdx.x; u < 4 * NRC; u += gridDim.x) {
        const int ct = u / NRC, rc = u % NRC, rt0 = rc * RPC, rt1 = rt0 + RPC, col0 = ct * 256, head = ct * 4 + wc;
        __syncthreads();
        lwl[tid] = tid < 256 ? lnw[col0 + tid] : lnb[col0 + tid - 256];
        {
            char* bsl = lds + 4096;
            int t2 = tid; asm volatile("" : "+v"(t2));
#pragma unroll
            for (int q = 0; q < 8; ++q) {
                const int idx = q * 512 + t2, rowi = idx >> 4, seg = idx & 15;
                *(u32x4*)(bsl + rowi * 272 + seg * 16) = *(const u32x4*)(Bt + (size_t)(col0 + rowi) * 128 + seg * 8);
            }
        }
        __syncthreads();
        int boff[4];
#pragma unroll
        for (int n = 0; n < 4; ++n) boff[n] = 4096 + (wc * 64 + (n >> 1) * 32 + 8 * (fr >> 2) + 4 * (n & 1) + (fr & 3)) * 272 + fq * 16;
        bf16x8 afr[2][KS];
#pragma unroll
        for (int m = 0; m < 2; ++m)
#pragma unroll
            for (int ks = 0; ks < KS; ++ks) afr[m][ks] = *(const bf16x8*)(A + (size_t)(rt0 * TR + wr * 32 + m * 16 + fr) * 128 + ks * 32 + fq * 8);
        u32x4 ey0[2][2], ey1[2][2], evv[2][2]; float ebon[2];
#define OUT2_LOAD(SET, RT_, M_) do { const int row_ = (RT_) * TR + wr * 32 + (M_) * 16 + fr; const size_t o_ = (size_t)row_ * D + col0 + wc * 64 + 8 * fq; \
            _Pragma("unroll") for (int pp = 0; pp < 2; ++pp) { ey0[SET][pp] = *(const u32x4*)(Y + o_ + pp * 32); ey1[SET][pp] = *(const u32x4*)(Y + (size_t)NT * D + o_ + pp * 32); evv[SET][pp] = *(const u32x4*)(V + o_ + pp * 32); } \
            ebon[SET] = BON[(size_t)row_ * 16 + head]; } while (0)
        OUT2_LOAD(0, rt0, 0);
#pragma unroll 1
        for (int rt = rt0; rt < rt1; ++rt) {
            int zz = 0; asm volatile("" : "+v"(zz));
            f32x4 acc[2][4];
#pragma unroll
            for (int m = 0; m < 2; ++m)
#pragma unroll
                for (int n = 0; n < 4; ++n) {
                    acc[m][n] = (f32x4){0.f, 0.f, 0.f, 0.f};
#pragma unroll
                    for (int ks = 0; ks < KS; ++ks) acc[m][n] = __builtin_amdgcn_mfma_f32_16x16x32_bf16(*(const bf16x8*)(lds + boff[n] + zz + ks * 64), afr[m][ks], acc[m][n], 0, 0, 0);
                }
            if (rt + 1 < rt1) {
#pragma unroll
                for (int m = 0; m < 2; ++m)
#pragma unroll
                    for (int ks = 0; ks < KS; ++ks) afr[m][ks] = *(const bf16x8*)(A + (size_t)((rt + 1) * TR + wr * 32 + m * 16 + fr) * 128 + ks * 32 + fq * 8);
            }
#pragma unroll
            for (int m = 0; m < 2; ++m) {
                if (m == 0) OUT2_LOAD(1, rt, 1);
                else if (rt + 1 < rt1) OUT2_LOAD(0, rt + 1, 0);
                const int row = rt * TR + wr * 32 + m * 16 + fr;
                const size_t o = (size_t)row * D + col0 + wc * 64 + 8 * fq;
                const float bon = ebon[m];
                float ov[16]; float s1 = 0.f;
#pragma unroll
                for (int i = 0; i < 16; ++i) {
                    const unsigned w0 = ey0[m][i >> 3][(i >> 1) & 3], w1 = ey1[m][i >> 3][(i >> 1) & 3];
                    ov[i] = ((i & 1) ? bfhi(w0) : bflo(w0)) + ((i & 1) ? bfhi(w1) : bflo(w1));
                    s1 += ov[i];
                }
                const float mu = red4(s1) * (1.f / 64.f);
                float s2 = 0.f;
#pragma unroll
                for (int i = 0; i < 16; ++i) { const float dd = ov[i] - mu; s2 += dd * dd; }
                const float rs = rsqrtf(red4(s2) * (1.f / 64.f) + 64e-5f);
#pragma unroll
                for (int pp = 0; pp < 2; ++pp) {
                    const float* lp = lwl + wc * 64 + pp * 32 + 8 * fq;
                    const float4 w0 = *(const float4*)lp, w1 = *(const float4*)(lp + 4), b0 = *(const float4*)(lp + 256), b1 = *(const float4*)(lp + 260);
                    const float lw[8] = {w0.x, w0.y, w0.z, w0.w, w1.x, w1.y, w1.z, w1.w}, lb[8] = {b0.x, b0.y, b0.z, b0.w, b1.x, b1.y, b1.z, b1.w};
                    float res[8];
#pragma unroll
                    for (int e = 0; e < 8; ++e) {
                        const unsigned vw = evv[m][pp][e >> 1];
                        const float v = (e & 1) ? bfhi(vw) : bflo(vw);
                        const float g = acc[m][2 * pp + (e >> 2)][e & 3];
                        res[e] = ((ov[pp * 8 + e] - mu) * rs * lw[e] + lb[e] + bon * v) * g;
                    }
                    const u32x4 w = {pack2(res[0], res[1]), pack2(res[2], res[3]), pack2(res[4], res[5]), pack2(res[6], res[7])};
                    *(u32x4*)(YO + o + pp * 32) = w;
                }
            }
        }
#undef OUT2_LOAD
    }
}

__device__ __forceinline__ void phase_rwkv_wo(const Params& p, int l, int j, char* lds) {
    EpD1 ep{(bf16_t*)(p.ws + OFF_D1), nullptr};
    SchedGrid S{p.ws + OFF_LW, (const char*)wsm(p, j, WJ_WO), 0, 0, (size_t)256 * D * 2, 0, (size_t)256 * D * 2, NT / 256 / 8, (NT / 256) * 4};
    g256::gemm_phase<true>((LAS unsigned char*)lds, D, D, D, S, ep);
}

__device__ __forceinline__ void phase_pool_dlt(const Params& p, int nrows) {
    const bf16_t* H = (const bf16_t*)(p.ws + OFF_H); bf16_t* DL = (bf16_t*)(p.ws + OFF_DLT);
    const int tid_ = tidx(), lane = tid_ & 63, wid = tid_ >> 6;
    for (int row0 = (blockIdx.x * 8 + wid) * 4; row0 < nrows; row0 += gridDim.x * 8 * 4) {
        int t, T, base;
        if (row0 < NLAT) { t = row0 & (TL - 1); T = TL; base = row0 - t; } else { t = (row0 - NLAT) & (TC - 1); T = TC; base = row0 - t; }
#define DLT_GROUP(G) { \
            constexpr int half = 1 << (G), win = 2 << (G), NW = win + 3; \
            const int c = (G) * 256 + lane * 4; \
            u32x2 w[NW]; float mk[NW]; \
            _Pragma("unroll") for (int i = 0; i < NW; ++i) { const int tt = t - half + i; const bool in = tt >= 0 && tt < T; mk[i] = in ? 1.f : 0.f; \
                w[i] = *(const u32x2*)(H + (size_t)(base + (in ? tt : t)) * D + c); } \
            float s0 = 0.f, s1 = 0.f, s2 = 0.f, s3 = 0.f; \
            _Pragma("unroll") for (int i = 0; i < win; ++i) { s0 += mk[i] * bflo(w[i][0]); s1 += mk[i] * bfhi(w[i][0]); s2 += mk[i] * bflo(w[i][1]); s3 += mk[i] * bfhi(w[i][1]); } \
            _Pragma("unroll") for (int r = 0; r < 4; ++r) { \
                const int tr = t + r, lo = max(tr - half, 0), hi = min(tr + half, T); \
                const float inv = 1.f / (float)(hi - lo); \
                const u32x2 hw = w[half + r]; \
                u32x2 o; o[0] = pack2(s0 * inv - bflo(hw[0]), s1 * inv - bfhi(hw[0])); o[1] = pack2(s2 * inv - bflo(hw[1]), s3 * inv - bfhi(hw[1])); \
                *(u32x2*)(DL + (size_t)(row0 + r) * D + c) = o; \
                if (r < 3) { \
                    s0 += mk[r + win] * bflo(w[r + win][0]) - mk[r] * bflo(w[r][0]); s1 += mk[r + win] * bfhi(w[r + win][0]) - mk[r] * bfhi(w[r][0]); \
                    s2 += mk[r + win] * bflo(w[r + win][1]) - mk[r] * bflo(w[r][1]); s3 += mk[r + win] * bfhi(w[r + win][1]) - mk[r] * bfhi(w[r][1]); } } }
        DLT_GROUP(0) DLT_GROUP(1) DLT_GROUP(2) DLT_GROUP(3)
#undef DLT_GROUP
    }
}
__device__ __forceinline__ void phase_pool_gemm(const Params& p, int l, int j, int nrows, char* lds) {
    EpD1 ep{(bf16_t*)(p.ws + OFF_D1), p.in[28] + (size_t)j * D};
    SchedGrid S{p.ws + OFF_DLT, (const char*)wsm(p, j, WJ_POOL), 0, 0, (size_t)256 * D * 2, (size_t)256 * 2, (size_t)256 * 256 * 2, nrows / 256 / 8, (nrows / 256) * 4};
    g256::gemm_phase<true>((LAS unsigned char*)lds, D, 256, 256, S, ep);
}

__device__ __forceinline__ void phase_topk(const Params& p, bool with_ctx, char* lds) {
    const float* AFF = (const float*)(p.ws + OFF_AFF);
    const bf16_t* H = (const bf16_t*)(p.ws + OFF_H); bf16_t* XG = (bf16_t*)(p.ws + OFF_XG);
    float* GTV = (float*)(p.ws + OFF_GTV); short* SLT = (short*)(p.ws + OFF_SLT);
    unsigned* keys = (unsigned*)lds;
    unsigned* hist = keys + 4096;
    unsigned* wtot = hist + 256;
    unsigned* bc = wtot + 8;
    int* sel = (int*)(bc + 4);
    const int tid = tidx(), lane = tid & 63, wid = tid >> 6;
    const int nunits = with_ctx ? 512 : 256;
    for (int u = blockIdx.x; u < nunits; u += gridDim.x) {
        const bool lat = u < 256;
        const int uu = lat ? u : u - 256, b = uu >> 4, e = uu & 15;
        const int n = lat ? TL : TC, kq = lat ? CAPL : CAPC, per = lat ? 8 : 1;
        const int rowbase = lat ? b * TL : NLAT + b * TC;
        for (int i = tid; i < n; i += NTHREADS) keys[i] = __float_as_uint(AFF[(size_t)(rowbase + i) * 16 + e]);
        lds_barrier();
        unsigned prefix = 0u, mask = 0u; int kth = kq;
        for (int ps = 0; ps < 4; ++ps) {
            const int shift = 24 - 8 * ps;
            if (tid < 256) hist[tid] = 0u;
            lds_barrier();
            for (int i = tid; i < n; i += NTHREADS) { const unsigned k = keys[i]; if ((k & mask) == prefix) atomicAdd(&hist[(k >> shift) & 255u], 1u); }
            lds_barrier();
            if (wid == 0) {
                const int b0 = 255 - 4 * lane;
                const unsigned h0 = hist[b0], h1 = hist[b0 - 1], h2 = hist[b0 - 2], h3 = hist[b0 - 3];
                unsigned inc = h0 + h1 + h2 + h3;
#pragma unroll
                for (int d = 1; d < 64; d <<= 1) { const unsigned o = (unsigned)__builtin_amdgcn_ds_bpermute(((lane - d) & 63) << 2, (int)inc); if (lane >= d) inc += o; }
                const unsigned exc = inc - (h0 + h1 + h2 + h3);
                if (exc < (unsigned)kth && inc >= (unsigned)kth) {
                    unsigned cum = exc; int dg = b0; unsigned rem = 0;
                    if (cum + h0 >= (unsigned)kth) { dg = b0; rem = kth - cum; }
                    else { cum += h0; if (cum + h1 >= (unsigned)kth) { dg = b0 - 1; rem = kth - cum; }
                    else { cum += h1; if (cum + h2 >= (unsigned)kth) { dg = b0 - 2; rem = kth - cum; }
                    else { cum += h2; dg = b0 - 3; rem = kth - cum; } } }
                    bc[0] = (unsigned)dg; bc[1] = rem;
                }
            }
            lds_barrier();
            prefix |= bc[0] << shift; mask |= 255u << shift; kth = (int)bc[1];
            lds_barrier();
        }
        const unsigned Tk = prefix; const int need_eq = kth;
        const int t0 = tid * per; const bool act = t0 < n;
        int cgt = 0, ceq = 0;
        if (act) for (int i = 0; i < per; ++i) { const unsigned k = keys[t0 + i]; cgt += k > Tk; ceq += k == Tk; }
        const unsigned mine = ((unsigned)cgt << 16) | (unsigned)ceq;
        unsigned inc = mine;
#pragma unroll
        for (int d = 1; d < 64; d <<= 1) { const unsigned o = (unsigned)__builtin_amdgcn_ds_bpermute(((lane - d) & 63) << 2, (int)inc); if (lane >= d) inc += o; }
        if (lane == 63) wtot[wid] = inc;
        lds_barrier();
        unsigned woff = 0;
#pragma unroll
        for (int w = 0; w < 8; ++w) woff += (w < wid) ? wtot[w] : 0u;
        const unsigned ex = woff + inc - mine;
        int gt_before = (int)(ex >> 16), eq_before = (int)(ex & 0xffffu);
        if (act) {
            for (int i = 0; i < per; ++i) {
                const int t = t0 + i; const unsigned k = keys[t];
                int slot = -1;
                if (k > Tk) { slot = gt_before + min(eq_before, need_eq); ++gt_before; }
                else if (k == Tk) { if (eq_before < need_eq) slot = gt_before + eq_before; ++eq_before; }
                SLT[(size_t)(rowbase + t) * 16 + e] = (short)slot;
                if (slot >= 0) {
                    const int srow = lat ? (b * 16 + e) * CAPL + slot : NSLOT_LAT + (e * 16 + b) * CAPC + slot;
                    sel[slot] = t; GTV[srow] = __uint_as_float(k);
#if MOE_F8
                    ((int*)(p.ws + OFF_IDX))[srow] = rowbase + t;
#endif
                }
            }
        }
        lds_barrier();
        const int sbase = lat ? (b * 16 + e) * CAPL : NSLOT_LAT + (e * 16 + b) * CAPC;
#if MOE_F8
#else
        for (int s = wid; s < kq; s += 8) {
            const size_t srcrow = (size_t)(rowbase + sel[s]) * D, dstrow = (size_t)(sbase + s) * D;
            const u32x4 x0 = *(const u32x4*)(H + srcrow + lane * 8), x1 = *(const u32x4*)(H + srcrow + 512 + lane * 8);
            *(u32x4*)(XG + dstrow + lane * 8) = x0; *(u32x4*)(XG + dstrow + 512 + lane * 8) = x1;
        }
#endif
        lds_barrier();
    }
}
__device__ __forceinline__ int expert_of_slotrow(int r) { return r < NSLOT_LAT ? ((r >> 9) & 15) : ((r - NSLOT_LAT) >> 9); }
constexpr int EB = MOE_F8 ? 1 : 2;
struct SchedMoeUp {
    const char* XG; const char* W13; int cpe, total; const int* tok; const char* abase;
    __device__ __forceinline__ bool next(int i, g256::Unit& u) const {
        const long L = g256::unit_index(i);
        if (L >= total) return false;
        const int chunk = (int)(L >> 5), o = (int)(L & 31), e = chunk / cpe, r = chunk % cpe;
        int row0, ct;
        if (r < 16) { const int t = (r >> 2) * 8 + (o >> 2); ct = (r & 3) * 4 + (o & 3); row0 = ((t >> 1) * 16 + e) * CAPL + (t & 1) * 256; }
        else { ct = o & 15; row0 = NSLOT_LAT + e * 512 + (o >> 4) * 256; }
        u.a = XG + (size_t)row0 * D * EB; u.b = W13 + ((size_t)e * 4096 + ct * 256) * 1024 * EB; u.row0 = row0; u.col0 = ct * 256;
        return true;
    }
};
__device__ __forceinline__ void phase_moe_up(const Params& p, bool with_ctx, char* lds) {
    const int cpe = with_ctx ? 17 : 16;
#if MOE_F8
    EpSwiglu8 ep{p.ws + OFF_HID};
    SchedMoeUp S{p.ws + OFF_XG, p.ws + OFF_WM, cpe, 16 * cpe * 32, (const int*)(p.ws + OFF_IDX), p.ws + OFF_H};
    g256::gemm_phase<true, true, true>((LAS unsigned char*)lds, D / 2, D / 2, D / 2, S, ep);
#else
    EpSwiglu ep{(bf16_t*)(p.ws + OFF_HID)};
    SchedMoeUp S{p.ws + OFF_XG, (const char*)((const bf16_t*)(p.ws + OFF_WM) + WM_13), cpe, 16 * cpe * 32, nullptr, nullptr};
    g256::gemm_phase<true>((LAS unsigned char*)lds, D, D, D, S, ep);
#endif
}
struct SchedMoeDown {
    const char* HID; const char* W2; int total;
    __device__ __forceinline__ bool next(int i, g256::Unit& u) const {
        const long L = g256::unit_index(i);
        if (L >= total) return false;
        const int chunk = (int)(L >> 5), o = (int)(L & 31), ct = o & 3;
        int row0, e;
        if (chunk < 64) { e = chunk >> 2; const int t = (chunk & 3) * 8 + (o >> 2); row0 = ((t >> 1) * 16 + e) * CAPL + (t & 1) * 256; }
        else { e = (chunk - 64) * 4 + (o >> 3); row0 = NSLOT_LAT + e * 512 + ((o >> 2) & 1) * 256; }
        u.a = HID + (size_t)row0 * FF * EB; u.b = W2 + ((size_t)e * 1024 + ct * 256) * 2048 * EB; u.row0 = row0; u.col0 = ct * 256;
        return true;
    }
};
__device__ __forceinline__ void phase_moe_down(const Params& p, bool with_ctx, char* lds) {
    EpGateRow ep{(bf16_t*)(p.ws + OFF_YS), (const float*)(p.ws + OFF_GTV)};
#if MOE_F8
    SchedMoeDown S{p.ws + OFF_HID, p.ws + OFF_WM + WM8_2, (64 + (with_ctx ? 4 : 0)) * 32};
    g256::gemm_phase<true, true>((LAS unsigned char*)lds, FF / 2, FF / 2, FF / 2, S, ep);
#else
    SchedMoeDown S{p.ws + OFF_HID, (const char*)((const bf16_t*)(p.ws + OFF_WM) + WM_2), (64 + (with_ctx ? 4 : 0)) * 32};
    g256::gemm_phase<true>((LAS unsigned char*)lds, FF, FF, FF, S, ep);
#endif
}
__device__ __forceinline__ void phase_moe_combine(const Params& p, int l, int nrows, float amp = 1.f) {
    float* X = (float*)(p.ws + OFF_X); const bf16_t* YS = (const bf16_t*)(p.ws + OFF_YS); const short* SLT = (const short*)(p.ws + OFF_SLT);
    bf16_t* H = (bf16_t*)(p.ws + OFF_H); const bf16_t* D1 = (const bf16_t*)(p.ws + OFF_D1);
    const float* MOD = (const float*)(p.ws + OFF_MOD) + (size_t)l * 17 * MODW + 5 * D;
    const bool last = l == 3;
    const float* MODN = (const float*)(p.ws + OFF_MOD) + (size_t)(last ? l : l + 1) * 17 * MODW;
    const float* gn = last ? p.in[33] : p.in[6] + (size_t)(l + 1) * D;
    const int tid_ = tidx(), lane = tid_ & 63, wid = tid_ >> 6;
    float gw[16];
#pragma unroll
    for (int hh = 0; hh < 2; ++hh)
#pragma unroll
        for (int i = 0; i < 8; ++i) gw[hh * 8 + i] = gn[hh * 512 + lane * 8 + i];
    for (int row = blockIdx.x * 8 + wid; row < nrows; row += gridDim.x * 8) {
        float acc[16];
#pragma unroll
        for (int i = 0; i < 16; ++i) acc[i] = 0.f;
        const bool lat = row < NLAT;
        const int b = lat ? (row >> 12) : ((row - NLAT) >> 8);
        const int myslot = (int)SLT[(size_t)row * 16 + (lane & 15)];
        float4 xv[4]; u32x4 dv[2];
        const float* xsrc = l == 0 ? (lat ? p.in[0] + (size_t)row * D : p.in[2] + (size_t)(row - NLAT) * D) : X + (size_t)row * D;
#pragma unroll
        for (int hh = 0; hh < 2; ++hh) { xv[hh * 2] = *(const float4*)(xsrc + hh * 512 + lane * 8); xv[hh * 2 + 1] = *(const float4*)(xsrc + hh * 512 + lane * 8 + 4); dv[hh] = *(const u32x4*)(D1 + (size_t)row * D + hh * 512 + lane * 8); }
        unsigned long long bal = __ballot(myslot >= 0);
        unsigned emask = (unsigned)bal & 0xffffu;
        u32x4 ya[4], yc[4];
#pragma unroll
        for (int k = 0; k < 4; ++k) {
            ya[k] = (u32x4){0u, 0u, 0u, 0u}; yc[k] = (u32x4){0u, 0u, 0u, 0u};
            if (emask) {
                const int e = __builtin_ctz(emask); emask &= emask - 1u;
                const int sv = __builtin_amdgcn_readlane(myslot, e);
                const int srow = lat ? (b * 16 + e) * CAPL + sv : NSLOT_LAT + (e * 16 + b) * CAPC + sv;
                ya[k] = *(const u32x4*)(YS + (size_t)srow * D + lane * 8); yc[k] = *(const u32x4*)(YS + (size_t)srow * D + 512 + lane * 8);
            }
        }
#pragma unroll
        for (int k = 0; k < 4; ++k)
#pragma unroll
            for (int i = 0; i < 4; ++i) { acc[2 * i] += bflo(ya[k][i]); acc[2 * i + 1] += bfhi(ya[k][i]); acc[8 + 2 * i] += bflo(yc[k][i]); acc[8 + 2 * i + 1] += bfhi(yc[k][i]); }
        while (emask) {
            const int e = __builtin_ctz(emask); emask &= emask - 1u;
            const int sv = __builtin_amdgcn_readlane(myslot, e);
            const int srow = lat ? (b * 16 + e) * CAPL + sv : NSLOT_LAT + (e * 16 + b) * CAPC + sv;
            const u32x4 a = *(const u32x4*)(YS + (size_t)srow * D + lane * 8), c = *(const u32x4*)(YS + (size_t)srow * D + 512 + lane * 8);
#pragma unroll
            for (int i = 0; i < 4; ++i) { acc[2 * i] += bflo(a[i]); acc[2 * i + 1] += bfhi(a[i]); acc[8 + 2 * i] += bflo(c[i]); acc[8 + 2 * i + 1] += bfhi(c[i]); }
        }
        if (amp == 0.f) {
#pragma unroll
            for (int i = 0; i < 16; ++i) acc[i] = 0.f;
        }
        const int mrow = mod_row(row);
        const float* gt = MOD + (size_t)mrow * MODW;
        float xn[16]; float ss = 0.f;
#pragma unroll
        for (int hh = 0; hh < 2; ++hh) {
            const float* gp = gt + hh * 512 + lane * 8;
            const float4 g0 = *(const float4*)gp, g1 = *(const float4*)(gp + 4);
            float4 x0 = xv[hh * 2], x1 = xv[hh * 2 + 1];
            {
                const float4 m0 = *(const float4*)(gp - 3 * D), m1 = *(const float4*)(gp - 3 * D + 4);
                x0.x += m0.x * bflo(dv[hh][0]); x0.y += m0.y * bfhi(dv[hh][0]); x0.z += m0.z * bflo(dv[hh][1]); x0.w += m0.w * bfhi(dv[hh][1]);
                x1.x += m1.x * bflo(dv[hh][2]); x1.y += m1.y * bfhi(dv[hh][2]); x1.z += m1.z * bflo(dv[hh][3]); x1.w += m1.w * bfhi(dv[hh][3]);
            }
            xn[hh * 8 + 0] = x0.x + g0.x * acc[hh * 8 + 0]; xn[hh * 8 + 1] = x0.y + g0.y * acc[hh * 8 + 1]; xn[hh * 8 + 2] = x0.z + g0.z * acc[hh * 8 + 2]; xn[hh * 8 + 3] = x0.w + g0.w * acc[hh * 8 + 3];
            xn[hh * 8 + 4] = x1.x + g1.x * acc[hh * 8 + 4]; xn[hh * 8 + 5] = x1.y + g1.y * acc[hh * 8 + 5]; xn[hh * 8 + 6] = x1.z + g1.z * acc[hh * 8 + 6]; xn[hh * 8 + 7] = x1.w + g1.w * acc[hh * 8 + 7];
        }
#pragma unroll
        for (int i = 0; i < 16; ++i) ss += xn[i] * xn[i];
        const float rs = rsqrtf(wave_sum(ss) * (1.f / D) + 1e-6f);
        if (!last) {
#pragma unroll
            for (int hh = 0; hh < 2; ++hh) {
                float* xp = X + (size_t)row * D + hh * 512 + lane * 8;
                *(float4*)xp = make_float4(xn[hh * 8 + 0], xn[hh * 8 + 1], xn[hh * 8 + 2], xn[hh * 8 + 3]);
                *(float4*)(xp + 4) = make_float4(xn[hh * 8 + 4], xn[hh * 8 + 5], xn[hh * 8 + 6], xn[hh * 8 + 7]);
                const float* sp = MODN + (size_t)mrow * MODW + hh * 512 + lane * 8;
                const float4 s0 = *(const float4*)sp, s1 = *(const float4*)(sp + 4), c0 = *(const float4*)(sp + D), c1 = *(const float4*)(sp + D + 4);
                u32x4 o;
                o[0] = pack2(xn[hh * 8 + 0] * rs * gw[hh * 8 + 0] * (1.f + c0.x) + s0.x, xn[hh * 8 + 1] * rs * gw[hh * 8 + 1] * (1.f + c0.y) + s0.y);
                o[1] = pack2(xn[hh * 8 + 2] * rs * gw[hh * 8 + 2] * (1.f + c0.z) + s0.z, xn[hh * 8 + 3] * rs * gw[hh * 8 + 3] * (1.f + c0.w) + s0.w);
                o[2] = pack2(xn[hh * 8 + 4] * rs * gw[hh * 8 + 4] * (1.f + c1.x) + s1.x, xn[hh * 8 + 5] * rs * gw[hh * 8 + 5] * (1.f + c1.y) + s1.y);
                o[3] = pack2(xn[hh * 8 + 6] * rs * gw[hh * 8 + 6] * (1.f + c1.z) + s1.z, xn[hh * 8 + 7] * rs * gw[hh * 8 + 7] * (1.f + c1.w) + s1.w);
                *(u32x4*)(H + (size_t)row * D + hh * 512 + lane * 8) = o;
            }
        } else {
#if SCAN2_MODE == 1
            { const float* accp = (const float*)(p.ws + OFF_BAR + 16384); const float f = 1.f + 100.f * sqrtf(accp[0] / fmaxf(accp[1], 1e-30f));
#pragma unroll
              for (int i = 0; i < 16; ++i) xn[i] *= f; }
#endif
#pragma unroll
            for (int hh = 0; hh < 2; ++hh) {
                float* op = p.out + (size_t)row * D + hh * 512 + lane * 8;
                *(float4*)op = make_float4(xn[hh * 8 + 0] * rs * gw[hh * 8 + 0], xn[hh * 8 + 1] * rs * gw[hh * 8 + 1], xn[hh * 8 + 2] * rs * gw[hh * 8 + 2], xn[hh * 8 + 3] * rs * gw[hh * 8 + 3]);
                *(float4*)(op + 4) = make_float4(xn[hh * 8 + 4] * rs * gw[hh * 8 + 4], xn[hh * 8 + 5] * rs * gw[hh * 8 + 5], xn[hh * 8 + 6] * rs * gw[hh * 8 + 6], xn[hh * 8 + 7] * rs * gw[hh * 8 + 7]);
            }
        }
    }
}
__device__ __forceinline__ void phase_final(const Params& p) {
    const float* X = (const float*)(p.ws + OFF_X); const float* g = p.in[33];
    const int tid_ = tidx(), lane = tid_ & 63, wid = tid_ >> 6;
    for (int row = blockIdx.x * 8 + wid; row < NLAT; row += gridDim.x * 8) {
        const float* xr = X + (size_t)row * D;
        float4 v[4]; float ss = 0.f;
#pragma unroll
        for (int i = 0; i < 4; ++i) { v[i] = *(const float4*)(xr + i * 256 + lane * 4); ss += v[i].x * v[i].x + v[i].y * v[i].y + v[i].z * v[i].z + v[i].w * v[i].w; }
        ss = wave_sum(ss);
        const float rs = rsqrtf(ss * (1.f / D) + 1e-6f);
#pragma unroll
        for (int i = 0; i < 4; ++i) {
            const float4 gg = *(const float4*)(g + i * 256 + lane * 4);
            float4 o; o.x = v[i].x * rs * gg.x; o.y = v[i].y * rs * gg.y; o.z = v[i].z * rs * gg.z; o.w = v[i].w * rs * gg.w;
            *(float4*)(p.out + (size_t)row * D + i * 256 + lane * 4) = o;
        }
    }
}

#define XB_TMO      128
#define XB_XCNT(j)  (256  + 64 * (j))
#define XB_XSUB(j)  (1280 + 64 * (j))
#define XB_XGEN(j)  (2304 + 64 * (j))
#define XB_TOP      3328
#define XB_TOPGEN   3392
#define XCD_BAR_WORDS 3456
#define XB_SPIN_CAP (1u << 25)
__device__ __forceinline__ unsigned xb_ld(unsigned* p)              { return __hip_atomic_load(p, __ATOMIC_RELAXED, __HIP_MEMORY_SCOPE_AGENT); }
__device__ __forceinline__ unsigned xb_add(unsigned* p, unsigned v) { return __hip_atomic_fetch_add(p, v, __ATOMIC_RELAXED, __HIP_MEMORY_SCOPE_AGENT); }
__device__ __forceinline__ unsigned xb_xcc_id() { return (unsigned)__builtin_amdgcn_s_getreg((3 << 11) | 20) & 0xFu; }
#define XB_SPIN(cond, bar) do { unsigned _sp = 0; while (cond) { __builtin_amdgcn_s_sleep(1); \
    if ((++_sp & 255u) == 0u) { if (xb_ld(&(bar)[XB_TMO])) break; if (_sp > XB_SPIN_CAP) { atomicAdd(&(bar)[XB_TMO], 1u); break; } } } } while (0)
struct XcdBarrier { unsigned* bar; unsigned x; volatile LAS unsigned* st; };
__device__ __forceinline__ XcdBarrier xcd_barrier_post(unsigned* bar, volatile LAS unsigned* st) {
    XcdBarrier b; b.bar = bar; b.x = xb_xcc_id(); b.st = st;
    if (threadIdx.x == 0) (void)xb_add(&bar[XB_XCNT(b.x)], 1u);
    return b;
}
__device__ __forceinline__ void xcd_barrier_complete(unsigned* bar, unsigned x, unsigned& nloc, unsigned& nx) {
    const unsigned G = gridDim.x * gridDim.y * gridDim.z;
    unsigned sum, cnt, mine, sp = 0u;
    for (;;) {
        sum = 0u; cnt = 0u; mine = 0u;
#pragma unroll
        for (unsigned j = 0; j < 16; ++j) { const unsigned c = xb_ld(&bar[XB_XCNT(j)]); sum += c; cnt += (c > 0u) ? 1u : 0u; mine = (j == x) ? c : mine; }
        if (sum == G) break;
        __builtin_amdgcn_s_sleep(1);
        if ((++sp & 255u) == 0u) { if (xb_ld(&bar[XB_TMO])) break; if (sp > XB_SPIN_CAP) { atomicAdd(&bar[XB_TMO], 1u); break; } }
    }
    nloc = mine > 0u ? mine : 1u; nx = cnt > 0u ? cnt : 1u;
}
__device__ __forceinline__ void xcd_barrier(const XcdBarrier& b) {
    asm volatile("s_waitcnt vmcnt(0)" ::: "memory");
    __syncthreads();
    if (threadIdx.x == 0) {
        unsigned* bar = b.bar;
        unsigned bx = b.x; asm volatile("" : "+s"(bx));
        __builtin_amdgcn_s_waitcnt(0);
        unsigned nloc = b.st[0], nx = b.st[1];
        if (nloc == 0u) { xcd_barrier_complete(bar, bx, nloc, nx); b.st[0] = nloc; b.st[1] = nx; }
        const unsigned old = xb_add(&bar[XB_XSUB(bx)], 1u);
        const unsigned gen = old / nloc;
        if (old + 1u == (gen + 1u) * nloc) {
            __builtin_amdgcn_fence(__ATOMIC_RELEASE, "agent");
            asm volatile("s_waitcnt vmcnt(0)" ::: "memory");
            const unsigned og = xb_add(&bar[XB_TOP], 1u);
            const unsigned tg = og / nx;
            if (og + 1u == (tg + 1u) * nx) xb_add(&bar[XB_TOPGEN], 1u);
            else XB_SPIN(xb_ld(&bar[XB_TOPGEN]) == tg, bar);
            __builtin_amdgcn_fence(__ATOMIC_ACQUIRE, "agent");
            xb_add(&bar[XB_XGEN(bx)], 1u);
            asm volatile("s_waitcnt vmcnt(0)" ::: "memory");
        } else {
            XB_SPIN(xb_ld(&bar[XB_XGEN(bx)]) == gen, bar);
            __builtin_amdgcn_fence(__ATOMIC_ACQUIRE, "agent");
            asm volatile("s_waitcnt vmcnt(0)" ::: "memory");
        }
    }
    __syncthreads();
}

constexpr int NSMALLJOBS = 20;
__global__ void __launch_bounds__(NTHREADS, 2) k_mega(Params p) {
    extern __shared__ __attribute__((aligned(16))) char lds_all[];
    if (threadIdx.x == 0) *(uint4*)(lds_all + LDS_BYTES) = make_uint4(0u, 0u, 0u, 0u);
    __syncthreads();
    XcdBarrier bar = xcd_barrier_post((unsigned*)(p.ws + OFF_BAR), (volatile LAS unsigned*)(lds_all + LDS_BYTES));
    char* lds = lds_all;
#define GBAR xcd_barrier(bar)
#define DUP(bit, call) do { call; if (PROBE_MASK & (1 << (bit))) { GBAR; call; } } while (0)
    DUP(17, phase_cvt(p, 0, NSMALLJOBS, lds));
    DUP(18, phase_ada(p, lds));
    GBAR;
    if (PROBE_MASK & (1 << 19)) { for (int i = 0; i < 40; ++i) GBAR; }
    for (int l = 0; l < 4; ++l) {
        const bool last = l == 3, rw = (l & 1) == 0; const int j = l >> 1;
        const int nrows = (!last || rw) ? NT : NLAT;
        if (l == 0) { phase_norm<false>(p, l, 0, nrows, lds); GBAR; }
        if (rw) {
            DUP(1, phase_mix(p, j)); GBAR;
            DUP(2, phase_rwkv_proj(p, j, lds)); GBAR;
            DUP(3, phase_rwkv_up2(p, j, lds));
            if (j == 1) phase_rwkv_up(p, j, lds);
            GBAR;
#if SCAN2_MODE == 3
            DUP(4, phase_rwkv_scan3(p, j, lds, (bf16_t*)(p.ws + OFF_Y))); GBAR;
#elif SCAN2_MODE == 2
            phase_rwkv_scan2(p, j, lds, (bf16_t*)(p.ws + OFF_Y), -1); GBAR;
#else
            DUP(4, phase_rwkv_scan(p, j, lds)); GBAR;
#endif
#if SCAN2_MODE == 1
            phase_rwkv_scan2(p, j, lds, (bf16_t*)(p.ws + OFF_Y2DBG), 0); GBAR;
            phase_scan_compare(p); GBAR;
#endif
            DUP(5, phase_rwkv_out2(p, j, lds)); GBAR;
            phase_rwkv_wo(p, l, j, lds); GBAR;
        } else {
            DUP(6, phase_pool_dlt(p, nrows)); GBAR;
            phase_pool_gemm(p, l, j, nrows, lds); GBAR;
        }
        const int mrows = last ? NLAT : NT;
        DUP(7, phase_cvt(p, NSMALLJOBS + 3 * l, NSMALLJOBS + 3 * l + 3, lds));
        DUP(8, phase_norm<true>(p, l, 1, mrows, lds)); GBAR;
        DUP(9, phase_topk(p, !last, lds)); GBAR;
        DUP(11, phase_moe_up(p, !last, lds)); GBAR;
        DUP(12, phase_moe_down(p, !last, lds)); GBAR;
        phase_moe_combine(p, l, mrows);
        if (!last) GBAR;
    }
#undef GBAR
}

enum { PH_CVT = 0, PH_ADA, PH_NORM1, PH_NORM2, PH_PROJ, PH_UP, PH_PREP, PH_SCAN, PH_OUT, PH_WO, PH_DLT, PH_POOLG, PH_TOPK, PH_GATHER, PH_MUP, PH_MDOWN, PH_COMB, PH_FINAL, PH_MIX };
template <int PH>
__global__ void __launch_bounds__(NTHREADS) k_phase(Params p, int a0, int a1, int a2) {
    extern __shared__ __attribute__((aligned(16))) char lds[];
    if (PH == PH_CVT) phase_cvt(p, a0, a1, lds);
    if (PH == PH_ADA) phase_ada(p, lds);
    if (PH == PH_NORM1) phase_norm<false>(p, a0, 0, a1, lds);
    if (PH == PH_NORM2) phase_norm<true>(p, a0, 1, a1, lds);
    if (PH == PH_PROJ) phase_rwkv_proj(p, a0, lds);
    if (PH == PH_UP) phase_rwkv_up(p, a0, lds);
    if (PH == PH_PREP) phase_rwkv_prep(p, a0);
    if (PH == PH_SCAN) phase_rwkv_scan(p, a0, lds);
    if (PH == PH_OUT) phase_rwkv_out2(p, a0, lds);
    if (PH == PH_WO) phase_rwkv_wo(p, a0, a1, lds);
    if (PH == PH_DLT) phase_pool_dlt(p, a0);
    if (PH == PH_POOLG) phase_pool_gemm(p, a0, a1, a2, lds);
    if (PH == PH_TOPK) phase_topk(p, a0 != 0, lds);
    if (PH == PH_MUP) phase_moe_up(p, a0 != 0, lds);
    if (PH == PH_MDOWN) phase_moe_down(p, a0 != 0, lds);
    if (PH == PH_COMB) phase_moe_combine(p, a0, a1);
    if (PH == PH_FINAL) phase_final(p);
    if (PH == PH_MIX) phase_mix(p, a0);
}

template <int PH>
static void launch(const Params& p, int a0, int a1, int a2, hipStream_t s) {
    static bool init = false;
    if (!init) { hipFuncSetAttribute((const void*)k_phase<PH>, hipFuncAttributeMaxDynamicSharedMemorySize, LDS_BYTES); init = true; }
    hipLaunchKernelGGL(k_phase<PH>, dim3(256), dim3(NTHREADS), LDS_BYTES, s, p, a0, a1, a2);
}

static int add_job(Params& p, int n, const float* src, bf16_t* dst, int K, int N, int src_ld, int dst_ld, int n_mul, int n_off, int Kpad, int Npad, int nbatch, long src_bs, long dst_bs) {
    CvtJob& J = p.jobs[n];
    J.src = src; J.dst = dst; J.src_bs = src_bs; J.dst_bs = dst_bs; J.K = K; J.N = N; J.src_ld = src_ld; J.dst_ld = dst_ld; J.n_mul = n_mul; J.n_off = n_off;
    J.Kpad = Kpad; J.Npad = Npad; J.nbatch = nbatch; J.tiles = nbatch * (Kpad / 64) * ((Npad + 255) / 256);
    return n + 1;
}

extern "C" void kernel_launch(void* const* d_in, const int* in_sizes, int n_in, void* d_out, int out_size, void* d_ws, size_t ws_size, hipStream_t stream) {
    Params p;
    memset(&p, 0, sizeof(p));
    for (int i = 0; i < 34; ++i) p.in[i] = (const float*)d_in[i];
    p.out = (float*)d_out; p.ws = (char*)d_ws;
    if (ws_size < WS_NEED) { fprintf(stderr, "workspace too small: %zu < %zu\n", ws_size, (size_t)WS_NEED); }
    bf16_t* wsm_ = (bf16_t*)(p.ws + OFF_WSM);
    bf16_t* wm_ = (bf16_t*)(p.ws + OFF_WM);
    int nj = 0;
    for (int j = 0; j < 2; ++j) {
        bf16_t* base = wsm_ + (size_t)j * WJ_SIZE;
        nj = add_job(p, nj, p.in[9] + (size_t)j * 3 * D * D, base + WJ_RKV, D, D, D, D, 1, 0, D, D, 3, (long)D * D, (long)D * D);
        nj = add_job(p, nj, p.in[26] + (size_t)j * D * D, base + WJ_WO, D, D, D, D, 1, 0, D, D, 1, 0, 0);
        nj = add_job(p, nj, p.in[11] + (size_t)j * 2 * D * 64, base + WJ_W1, D, 64, 64, D, 1, 0, D, 64, 2, (long)D * 64, (long)64 * D);
        nj = add_job(p, nj, p.in[14] + (size_t)j * 2 * D * 64, base + WJ_A1, D, 64, 64, D, 1, 0, D, 64, 2, (long)D * 64, (long)64 * D);
        nj = add_job(p, nj, p.in[19] + (size_t)j * D * 128, base + WJ_G1, D, 128, 128, D, 1, 0, D, 128, 1, 0, 0);
        nj = add_job(p, nj, p.in[12] + (size_t)j * 2 * 64 * D, base + WJ_W2, 64, D, D, 64, 1, 0, 64, D, 2, (long)64 * D, (long)D * 64);
        nj = add_job(p, nj, p.in[15] + (size_t)j * 2 * 64 * D, base + WJ_A2, 64, D, D, 64, 1, 0, 64, D, 2, (long)64 * D, (long)D * 64);
        nj = add_job(p, nj, p.in[20] + (size_t)j * 128 * D, base + WJ_G2, 128, D, D, 128, 1, 0, 128, D, 1, 0, 0);
        nj = add_job(p, nj, p.in[27] + (size_t)j * 4 * 256 * 256, base + WJ_POOL, 256, 256, 256, 256, 1, 0, 256, 256, 4, 65536, 65536);
    }
    nj = add_job(p, nj, p.in[17], wsm_ + W_V1, D, 32, 32, D, 1, 0, D, 128, 1, 0, 0);
    nj = add_job(p, nj, p.in[18], wsm_ + W_V2, 32, D, D, 64, 1, 0, 64, D, 1, 0, 0);
    const int nsmall = nj;
    for (int l = 0; l < 4; ++l) {
#if MOE_F8
        nj = add_job(p, nj, p.in[30] + (size_t)l * 16 * D * FF, wm_, D, FF, FF, D, 2, 0, D, FF, 16, (long)D * FF, (long)4096 * 1024);
        p.jobs[nj - 1].f8 = 1; p.jobs[nj - 1].scale = W8_SCALE;
        nj = add_job(p, nj, p.in[31] + (size_t)l * 16 * D * FF, wm_, D, FF, FF, D, 2, 1, D, FF, 16, (long)D * FF, (long)4096 * 1024);
        p.jobs[nj - 1].f8 = 1; p.jobs[nj - 1].scale = W8_SCALE;
        nj = add_job(p, nj, p.in[32] + (size_t)l * 16 * FF * D, (bf16_t*)(p.ws + OFF_WM + WM8_2), FF, D, D, FF, 1, 0, FF, D, 16, (long)FF * D, (long)D * FF);
        p.jobs[nj - 1].f8 = 1; p.jobs[nj - 1].scale = W8_SCALE;
#else
        nj = add_job(p, nj, p.in[30] + (size_t)l * 16 * D * FF, wm_ + WM_13, D, FF, FF, D, 2, 0, D, FF, 16, (long)D * FF, (long)4096 * 1024);
        nj = add_job(p, nj, p.in[31] + (size_t)l * 16 * D * FF, wm_ + WM_13, D, FF, FF, D, 2, 1, D, FF, 16, (long)D * FF, (long)4096 * 1024);
        nj = add_job(p, nj, p.in[32] + (size_t)l * 16 * FF * D, wm_ + WM_2, FF, D, D, FF, 1, 0, FF, D, 16, (long)FF * D, (long)D * FF);
#endif
    }
#if MK_MULTI
    launch<PH_CVT>(p, 0, nsmall, 0, stream);
    launch<PH_ADA>(p, 0, 0, 0, stream);
    for (int l = 0; l < 4; ++l) {
        const bool last = l == 3, rw = (l % 2) == 0; const int j = l / 2;
        const bool need_ctx = !last || rw;
        const int nrows = need_ctx ? NT : NLAT;
        if (l == 0) launch<PH_NORM1>(p, l, nrows, 0, stream);
        if (rw) {
            launch<PH_MIX>(p, j, 0, 0, stream);
            launch<PH_PROJ>(p, j, 0, 0, stream);
            launch<PH_UP>(p, j, 0, 0, stream);
            launch<PH_PREP>(p, j, 0, 0, stream);
            launch<PH_SCAN>(p, j, 0, 0, stream);
            launch<PH_OUT>(p, j, 0, 0, stream);
            launch<PH_WO>(p, l, j, 0, stream);
        } else {
            launch<PH_DLT>(p, nrows, 0, 0, stream);
            launch<PH_POOLG>(p, l, j, nrows, stream);
        }
        const int mrows = last ? NLAT : NT;
        launch<PH_CVT>(p, nsmall + 3 * l, nsmall + 3 * l + 3, 0, stream);
        launch<PH_NORM2>(p, l, mrows, 0, stream);
        launch<PH_TOPK>(p, last ? 0 : 1, 0, 0, stream);
        launch<PH_MUP>(p, last ? 0 : 1, 0, 0, stream);
        launch<PH_MDOWN>(p, last ? 0 : 1, 0, 0, stream);
        launch<PH_COMB>(p, l, mrows, 0, stream);
    }
#else
    (void)nsmall;
    static int grid = 0;
    if (!grid) {
        hipFuncSetAttribute((const void*)k_mega, hipFuncAttributeMaxDynamicSharedMemorySize, LDS_TOTAL);
        int dev = 0, cus = 0, per_cu = 0;
        hipGetDevice(&dev);
        hipDeviceGetAttribute(&cus, hipDeviceAttributeMultiprocessorCount, dev);
        hipOccupancyMaxActiveBlocksPerMultiprocessor(&per_cu, (const void*)k_mega, NTHREADS, LDS_TOTAL);
        grid = cus * (per_cu < 1 ? per_cu : 1);
        if (grid <= 0) { fprintf(stderr, "occupancy query returned %d blocks per CU\n", per_cu); grid = 0; return; }
    }
    hipMemsetAsync(p.ws + OFF_BAR, 0, 32768, stream);
    hipLaunchKernelGGL(k_mega, dim3(grid), dim3(NTHREADS), LDS_TOTAL, stream, p);
#endif
}
```

```cpp
#include <hip/hip_runtime.h>
#include <stdint.h>
#include <stdio.h>
#include <string.h>
#ifndef MK_MULTI
#define MK_MULTI 0
#endif

typedef unsigned short bf16_t;
typedef short bf16x8 __attribute__((ext_vector_type(8)));
typedef float f32x4 __attribute__((ext_vector_type(4)));
typedef unsigned u32x4 __attribute__((ext_vector_type(4)));
typedef unsigned u32x2 __attribute__((ext_vector_type(2)));

constexpr int D = 1024, NB = 16, TL = 4096, TC = 256;
constexpr int NLAT = NB * TL, NCTX = NB * TC, NT = NLAT + NCTX;
constexpr int NE = 16, FF = 2048, CAPL = 512, CAPC = 32;
constexpr int NSLOT_LAT = NB * NE * CAPL, NSLOT_CTX = NB * NE * CAPC, NSLOT = NSLOT_LAT + NSLOT_CTX;
constexpr int MODW = 6 * D;
constexpr int NTHREADS = 512;
constexpr int LDS_BYTES = 128 * 1024;
constexpr int LDS_TOK = LDS_BYTES + 16;
constexpr int LDS_TOTAL = LDS_TOK + 1024;

constexpr size_t MiB = 1ull << 20;
constexpr size_t U = (size_t)NT * D * 2;
constexpr size_t OFF_BAR = 0;
constexpr size_t OFF_MOD = 64 * 1024;
constexpr size_t OFF_WSM = 2 * MiB;
constexpr size_t OFF_AFF = 26 * MiB;
constexpr size_t OFF_BON = 31 * MiB;
constexpr size_t OFF_BON2 = 41 * MiB;
constexpr size_t OFF_IDX = 36 * MiB;
constexpr size_t OFF_GTV = 37 * MiB;
constexpr size_t OFF_SLT = 38 * MiB;
constexpr size_t OFF_BIG = 48 * MiB;
constexpr size_t OFF_X = OFF_BIG;
constexpr size_t OFF_VF = OFF_BIG + 2 * U;
constexpr size_t OFF_H = OFF_BIG + 3 * U;
constexpr size_t OFF_R = OFF_BIG + 4 * U;
constexpr size_t OFF_K = OFF_BIG + 5 * U;
constexpr size_t OFF_LD = OFF_BIG + 6 * U;
constexpr size_t OFF_LW = OFF_BIG + 6 * U + U / 2;
constexpr size_t OFF_AD = OFF_BIG + 8 * U + U / 2;
constexpr size_t OFF_Y = OFF_BIG + 10 * U + U / 2;
constexpr size_t OFF_G = OFF_BIG + 12 * U + U / 2;
constexpr size_t OFF_WM = OFF_BIG + 4 * U;
constexpr size_t OFF_XG = OFF_BIG + 5 * U + U / 2;
constexpr size_t OFF_HID = OFF_BIG + 7 * U + U / 2;
constexpr size_t OFF_YS = OFF_BIG + 11 * U + U / 2;
constexpr size_t OFF_DLT = OFF_BIG + 4 * U;
constexpr size_t OFF_D1 = OFF_BIG + 13 * U + U / 2;
constexpr size_t WS_NEED = OFF_BIG + 14 * U + U / 2;

constexpr size_t WJ_RKV = 0;
constexpr size_t WJ_WO = 3 * 1048576;
constexpr size_t WJ_W1 = 4 * 1048576;
constexpr size_t WJ_A1 = WJ_W1 + 131072;
constexpr size_t WJ_G1 = WJ_A1 + 131072;
constexpr size_t WJ_W2 = WJ_G1 + 131072;
constexpr size_t WJ_A2 = WJ_W2 + 131072;
constexpr size_t WJ_G2 = WJ_A2 + 131072;
constexpr size_t WJ_POOL = WJ_G2 + 131072;
constexpr size_t WJ_SIZE = WJ_POOL + 262144;
constexpr size_t W_V1 = 2 * WJ_SIZE;
constexpr size_t W_V2 = W_V1 + 131072;
constexpr size_t WM_13 = 0;
constexpr size_t WM_2 = (size_t)16 * 4096 * 1024;
constexpr size_t WM8_2 = (size_t)16 * 4096 * 1024;
constexpr float W8_SCALE = 64.f;
#define MOE_F8 1
#ifndef PROBE_MASK
#define PROBE_MASK 0
#endif

struct CvtJob {
    const float* src; bf16_t* dst;
    long src_bs, dst_bs;
    int K, N, src_ld, dst_ld, n_mul, n_off, Kpad, Npad, nbatch, tiles;
    int f8; float scale;
};
constexpr int NJOBS = 32;
struct Params {
    const float* in[34];
    float* out;
    char* ws;
    CvtJob jobs[NJOBS];
};

__device__ __forceinline__ float bf2f(bf16_t v) { return __uint_as_float(((unsigned)v) << 16); }
__device__ __forceinline__ bf16_t f2bf(float f) { unsigned u = __float_as_uint(f); u += 0x7FFFu + ((u >> 16) & 1u); return (bf16_t)(u >> 16); }
typedef __bf16 bf16x2_t __attribute__((ext_vector_type(2)));
typedef float f32x2_t __attribute__((ext_vector_type(2)));
__device__ __forceinline__ unsigned pack2(float lo, float hi) {
    const f32x2_t v = {lo, hi};
    return __builtin_bit_cast(unsigned, __builtin_convertvector(v, bf16x2_t));
}
__device__ __forceinline__ float bflo(unsigned w) { return __uint_as_float(w << 16); }
__device__ __forceinline__ float bfhi(unsigned w) { return __uint_as_float(w & 0xffff0000u); }
typedef unsigned u32x2_t __attribute__((ext_vector_type(2)));
__device__ __forceinline__ float red4(float x) {
    const unsigned u = __float_as_uint(x);
    const u32x2_t a = __builtin_amdgcn_permlane16_swap(u, u, false, false);
    const float t = __uint_as_float(a[0]) + __uint_as_float(a[1]);
    const unsigned v = __float_as_uint(t);
    const u32x2_t b = __builtin_amdgcn_permlane32_swap(v, v, false, false);
    return __uint_as_float(b[0]) + __uint_as_float(b[1]);
}
__device__ __forceinline__ float wave_sum(float v) {
    v += __uint_as_float(__builtin_amdgcn_update_dpp(0u, __float_as_uint(v), 0xB1, 0xf, 0xf, true));
    v += __uint_as_float(__builtin_amdgcn_update_dpp(0u, __float_as_uint(v), 0x4E, 0xf, 0xf, true));
    v += __uint_as_float(__builtin_amdgcn_update_dpp(0u, __float_as_uint(v), 0x141, 0xf, 0xf, true));
    v += __uint_as_float(__builtin_amdgcn_update_dpp(0u, __float_as_uint(v), 0x140, 0xf, 0xf, true));
    return red4(v);
}
__device__ __forceinline__ float sigmoidf_(float x) { return __builtin_amdgcn_rcpf(1.f + __expf(-x)); }
__device__ __forceinline__ float siluf_(float x) { return x * __builtin_amdgcn_rcpf(1.f + __expf(-x)); }
__device__ __forceinline__ float rdlane(float v, int l) { return __uint_as_float(__builtin_amdgcn_readlane(__float_as_uint(v), l)); }

__device__ __forceinline__ int tidx() { int t = threadIdx.x; asm volatile("" : "+v"(t)); return t; }

__device__ __forceinline__ int mod_row(int row) { return row < NLAT ? (row >> 12) : 16; }

__device__ __forceinline__ void phase_cvt(const Params& p, int jlo, int jhi, char* lds) {
    float* tile = (float*)lds;
#define CVT_T(k, n) tile[(k) * 321 + ((n) & 3) * 66 + ((n) >> 2)]
    const int tid = tidx();
    int total = 0;
    for (int j = jlo; j < jhi; ++j) total += p.jobs[j].tiles;
    auto locate = [&](int u, int& j, int& bt, int& kt, int& nt) {
        j = jlo; int uu = u;
        while (uu >= p.jobs[j].tiles) { uu -= p.jobs[j].tiles; ++j; }
        const int tk = p.jobs[j].Kpad / 64, tn = (p.jobs[j].Npad + 255) / 256;
        bt = uu / (tk * tn); const int r = uu % (tk * tn); kt = r / tn; nt = r % tn;
    };
    auto load = [&](int j, int bt, int kt, int nt, float4 (&v)[8]) {
        const CvtJob& J = p.jobs[j];
        const float* src = J.src + (size_t)bt * J.src_bs;
#pragma unroll
        for (int ps = 0; ps < 8; ++ps) {
            const int kl = ps * 8 + (tid >> 6), k = kt * 64 + kl, n = nt * 256 + (tid & 63) * 4;
            v[ps] = make_float4(0.f, 0.f, 0.f, 0.f);
            if (k < J.K) {
                const float* sp = src + (size_t)k * J.src_ld + n;
                if (n + 3 < J.N) v[ps] = *(const float4*)sp;
                else { if (n < J.N) v[ps].x = sp[0]; if (n + 1 < J.N) v[ps].y = sp[1]; if (n + 2 < J.N) v[ps].z = sp[2]; }
            }
        }
    };
    int u = blockIdx.x;
    if (u >= total) return;
    int j, bt, kt, nt;
    float4 v[8];
    locate(u, j, bt, kt, nt);
    load(j, bt, kt, nt, v);
    for (;;) {
#pragma unroll
        for (int ps = 0; ps < 8; ++ps) {
            float* tp = tile + (ps * 8 + (tid >> 6)) * 321 + (tid & 63);
            tp[0] = v[ps].x; tp[66] = v[ps].y; tp[132] = v[ps].z; tp[198] = v[ps].w;
        }
        __syncthreads();
        const int un = u + gridDim.x;
        int jn = j, btn = bt, ktn = kt, ntn = nt;
        if (un < total) { locate(un, jn, btn, ktn, ntn); load(jn, btn, ktn, ntn, v); }
        const CvtJob& J = p.jobs[j];
        if (J.f8) {
            char* dstb = (char*)J.dst + (size_t)bt * J.dst_bs;
            const float sc = J.scale;
#pragma unroll
            for (int ps = 0; ps < 4; ++ps) {
                const int nl = ps * 64 + (tid >> 3), kc = tid & 7, n = nt * 256 + nl;
                if (n < J.Npad) {
                    int w0 = 0, w1 = 0;
                    w0 = __builtin_amdgcn_cvt_pk_fp8_f32(CVT_T(kc * 8 + 0, nl) * sc, CVT_T(kc * 8 + 1, nl) * sc, w0, false);
                    w0 = __builtin_amdgcn_cvt_pk_fp8_f32(CVT_T(kc * 8 + 2, nl) * sc, CVT_T(kc * 8 + 3, nl) * sc, w0, true);
                    w1 = __builtin_amdgcn_cvt_pk_fp8_f32(CVT_T(kc * 8 + 4, nl) * sc, CVT_T(kc * 8 + 5, nl) * sc, w1, false);
                    w1 = __builtin_amdgcn_cvt_pk_fp8_f32(CVT_T(kc * 8 + 6, nl) * sc, CVT_T(kc * 8 + 7, nl) * sc, w1, true);
                    const u32x2 o = {(unsigned)w0, (unsigned)w1};
                    *(u32x2*)(dstb + ((size_t)n * J.n_mul + J.n_off) * J.dst_ld + kt * 64 + kc * 8) = o;
                }
            }
        } else {
            bf16_t* dst = J.dst + (size_t)bt * J.dst_bs;
#pragma unroll
            for (int ps = 0; ps < 4; ++ps) {
                const int nl = ps * 64 + (tid >> 3), kc = tid & 7, n = nt * 256 + nl;
                if (n < J.Npad) {
                    u32x4 o;
                    o[0] = pack2(CVT_T(kc * 8 + 0, nl), CVT_T(kc * 8 + 1, nl));
                    o[1] = pack2(CVT_T(kc * 8 + 2, nl), CVT_T(kc * 8 + 3, nl));
                    o[2] = pack2(CVT_T(kc * 8 + 4, nl), CVT_T(kc * 8 + 5, nl));
                    o[3] = pack2(CVT_T(kc * 8 + 6, nl), CVT_T(kc * 8 + 7, nl));
                    *(u32x4*)(dst + ((size_t)n * J.n_mul + J.n_off) * J.dst_ld + kt * 64 + kc * 8) = o;
                }
            }
        }
        __syncthreads();
        if (un >= total) break;
        u = un; j = jn; bt = btn; kt = ktn; nt = ntn;
    }
}
#undef CVT_T

__device__ __forceinline__ void phase_ada(const Params& p, char* lds) {
    float* sc = (float*)lds;
    float* red = sc + 17 * 1024;
    const int tid = tidx();
    const float* c = p.in[1]; const float* cctx = p.in[3];
    for (int i = tid; i < 17 * 1024; i += NTHREADS) {
        const float v = i < 16 * 1024 ? c[i] : cctx[i - 16 * 1024];
        sc[i] = siluf_(v);
    }
    __syncthreads();
    float* MOD = (float*)(p.ws + OFF_MOD);
    const int col = tid & 63, ks = tid >> 6;
    for (int u = blockIdx.x; u < 4 * 96; u += gridDim.x) {
        const int l = u / 96, n = (u % 96) * 64 + col;
        const float* w = p.in[4] + (size_t)l * D * MODW + n;
        float acc[17];
#pragma unroll
        for (int r = 0; r < 17; ++r) acc[r] = 0.f;
        for (int k0 = ks * 128; k0 < ks * 128 + 128; k0 += 16) {
            float wv[16];
#pragma unroll
            for (int kk = 0; kk < 16; ++kk) wv[kk] = w[(size_t)(k0 + kk) * MODW];
#pragma unroll
            for (int kk = 0; kk < 16; ++kk)
#pragma unroll
                for (int r = 0; r < 17; ++r) acc[r] += sc[r * 1024 + k0 + kk] * wv[kk];
        }
#pragma unroll
        for (int r = 0; r < 17; ++r) red[(ks * 17 + r) * 64 + col] = acc[r];
        __syncthreads();
        for (int i = tid; i < 17 * 64; i += NTHREADS) {
            const int r = i >> 6, cc = i & 63;
            float s = 0.f;
#pragma unroll
            for (int q = 0; q < 8; ++q) s += red[(q * 17 + r) * 64 + cc];
            const int nn = (u % 96) * 64 + cc;
            MOD[((size_t)l * 17 + r) * MODW + nn] = s + p.in[5][(size_t)l * MODW + nn];
        }
        __syncthreads();
    }
}

#ifndef ROUTER_RW
#define ROUTER_RW 4
#endif
template <bool ROUTER>
__device__ __forceinline__ void phase_norm(const Params& p, int l, int which, int nrows, char* lds) {
    const float* X = (const float*)(p.ws + OFF_X);
    const bool from_in = l == 0;
    const bf16_t* D1 = (const bf16_t*)(p.ws + OFF_D1);
    bf16_t* H = (bf16_t*)(p.ws + OFF_H);
    const float* MOD = (const float*)(p.ws + OFF_MOD) + (size_t)l * 17 * MODW;
    const float* g = (which == 0 ? p.in[6] : p.in[7]) + (size_t)l * D;
    float* AFF = (float*)(p.ws + OFF_AFF);
    float* rt = (float*)lds;
    const int tid = tidx(), lane = tid & 63, wid = tid >> 6;
    if (ROUTER) {
        const float* rsrc = p.in[29] + (size_t)l * D * NE;
        for (int i = tid; i < D * NE; i += NTHREADS) { const int e = i & 15, col = i >> 4; rt[(((e >> 1) * 2 + ((col >> 1) & 1)) * 256 + (col >> 2)) * 4 + (col & 1) * 2 + (e & 1)] = rsrc[i]; }
        __syncthreads();
    }
    const int so = which == 0 ? 0 : 3 * D, co = which == 0 ? D : 4 * D;
    constexpr int RW = ROUTER ? ROUTER_RW : 4;
    for (int grp = blockIdx.x * 8 + wid; grp < nrows / RW; grp += gridDim.x * 8) {
        const int row0 = grp * RW;
        const float* mr = MOD + (size_t)mod_row(row0) * MODW;
        float4 x[RW][4];
#pragma unroll
        for (int r = 0; r < RW; ++r)
#pragma unroll
            for (int i = 0; i < 4; ++i) {
                const int rw_ = row0 + r, c0 = i * 256 + lane * 4;
                const float* xs = from_in ? (rw_ < NLAT ? p.in[0] + (size_t)rw_ * D : p.in[2] + (size_t)(rw_ - NLAT) * D) : X + (size_t)rw_ * D;
                x[r][i] = *(const float4*)(xs + c0);
                if (ROUTER) {
                    const u32x2 dw = *(const u32x2*)(D1 + (size_t)rw_ * D + c0);
                    const float4 gt = *(const float4*)(mr + 2 * D + c0);
                    x[r][i].x += gt.x * bflo(dw[0]); x[r][i].y += gt.y * bfhi(dw[0]); x[r][i].z += gt.z * bflo(dw[1]); x[r][i].w += gt.w * bfhi(dw[1]);
                }
            }
        float4 pgg[4], psh[4], psl[4];
#pragma unroll
        for (int i = 0; i < 4; ++i) {
            const int c0 = i * 256 + lane * 4;
            pgg[i] = *(const float4*)(g + c0); psh[i] = *(const float4*)(mr + so + c0); psl[i] = *(const float4*)(mr + co + c0);
        }
        float rs[RW];
#pragma unroll
        for (int r = 0; r < RW; ++r) {
            float ss = 0.f;
#pragma unroll
            for (int i = 0; i < 4; ++i) ss += x[r][i].x * x[r][i].x + x[r][i].y * x[r][i].y + x[r][i].z * x[r][i].z + x[r][i].w * x[r][i].w;
            rs[r] = rsqrtf(wave_sum(ss) * (1.f / D) + 1e-6f);
        }
#pragma unroll
        for (int i = 0; i < 4; ++i) {
            const int c0 = i * 256 + lane * 4;
            const float4 gg = pgg[i], sh = psh[i], sl = psl[i];
            const float m0 = gg.x * (1.f + sl.x), m1 = gg.y * (1.f + sl.y), m2 = gg.z * (1.f + sl.z), m3 = gg.w * (1.f + sl.w);
#pragma unroll
            for (int r = 0; r < RW; ++r) {
                float4 h; h.x = x[r][i].x * rs[r] * m0 + sh.x; h.y = x[r][i].y * rs[r] * m1 + sh.y; h.z = x[r][i].z * rs[r] * m2 + sh.z; h.w = x[r][i].w * rs[r] * m3 + sh.w;
                x[r][i] = h;
                if (ROUTER && MOE_F8) {
                    int w = 0; w = __builtin_amdgcn_cvt_pk_fp8_f32(h.x, h.y, w, false); w = __builtin_amdgcn_cvt_pk_fp8_f32(h.z, h.w, w, true);
                    *(unsigned*)((char*)H + (size_t)(row0 + r) * D + c0) = (unsigned)w;
                } else {
                    u32x2 o; o[0] = pack2(h.x, h.y); o[1] = pack2(h.z, h.w);
                    *(u32x2*)(H + (size_t)(row0 + r) * D + c0) = o;
                }
            }
        }
        if (ROUTER) {
            f32x2_t lgp[RW][8];
#pragma unroll
            for (int r = 0; r < RW; ++r)
#pragma unroll
                for (int ep = 0; ep < 8; ++ep) lgp[r][ep] = (f32x2_t){0.f, 0.f};
#pragma unroll
            for (int i = 0; i < 4; ++i) {
#pragma unroll
                for (int ep = 0; ep < 8; ++ep) {
                    const float4 q0 = *(const float4*)(rt + ((ep * 2 + 0) * 256 + i * 64 + lane) * 4), q1 = *(const float4*)(rt + ((ep * 2 + 1) * 256 + i * 64 + lane) * 4);
                    const f32x2_t w0 = {q0.x, q0.y}, w1 = {q0.z, q0.w}, w2 = {q1.x, q1.y}, w3 = {q1.z, q1.w};
#pragma unroll
                    for (int r = 0; r < RW; ++r) {
                        const float4 h = x[r][i];
                        lgp[r][ep] += (f32x2_t){h.x, h.x} * w0; lgp[r][ep] += (f32x2_t){h.y, h.y} * w1; lgp[r][ep] += (f32x2_t){h.z, h.z} * w2; lgp[r][ep] += (f32x2_t){h.w, h.w} * w3;
                    }
#pragma unroll
                    for (int r = 0; r < RW; ++r) asm volatile("" : "+v"(lgp[r][ep]));
                }
            }
            const int b0 = lane & 1, b1 = (lane >> 1) & 1;
            const int eidx = b1 + 2 * b0 + 4 * (lane >> 5) + 8 * ((lane >> 4) & 1);
#pragma unroll
            for (int r = 0; r < RW; ++r) {
                float v8[8], v4[4], v2[2];
#pragma unroll
                for (int i = 0; i < 8; ++i) {
                    const float lo = (i & 1) ? lgp[r][i >> 1].y : lgp[r][i >> 1].x, hi = (i & 1) ? lgp[r][4 + (i >> 1)].y : lgp[r][4 + (i >> 1)].x;
                    const u32x2_t sw = __builtin_amdgcn_permlane16_swap(__float_as_uint(lo), __float_as_uint(hi), false, false);
                    v8[i] = __uint_as_float(sw[0]) + __uint_as_float(sw[1]);
                }
#pragma unroll
                for (int i = 0; i < 4; ++i) {
                    const u32x2_t sw = __builtin_amdgcn_permlane32_swap(__float_as_uint(v8[i]), __float_as_uint(v8[i + 4]), false, false);
                    v4[i] = __uint_as_float(sw[0]) + __uint_as_float(sw[1]);
                }
#pragma unroll
                for (int i = 0; i < 2; ++i) {
                    const float keep = b0 ? v4[i + 2] : v4[i], send = b0 ? v4[i] : v4[i + 2];
                    v2[i] = keep + __uint_as_float(__builtin_amdgcn_update_dpp(0u, __float_as_uint(send), 0xB1, 0xf, 0xf, true));
                }
                float lgt;
                {
                    const float keep = b1 ? v2[1] : v2[0], send = b1 ? v2[0] : v2[1];
                    lgt = keep + __uint_as_float(__builtin_amdgcn_update_dpp(0u, __float_as_uint(send), 0x4E, 0xf, 0xf, true));
                }
                lgt += __uint_as_float(__builtin_amdgcn_update_dpp(0u, __float_as_uint(lgt), 0x124, 0xf, 0xf, true));
                lgt += __uint_as_float(__builtin_amdgcn_update_dpp(0u, __float_as_uint(lgt), 0x128, 0xf, 0xf, true));
                float mx = lgt;
                mx = fmaxf(mx, __uint_as_float(__builtin_amdgcn_update_dpp(0u, __float_as_uint(mx), 0xB1, 0xf, 0xf, true)));
                mx = fmaxf(mx, __uint_as_float(__builtin_amdgcn_update_dpp(0u, __float_as_uint(mx), 0x4E, 0xf, 0xf, true)));
                { const u32x2_t sw = __builtin_amdgcn_permlane16_swap(__float_as_uint(mx), __float_as_uint(mx), false, false); mx = fmaxf(__uint_as_float(sw[0]), __uint_as_float(sw[1])); }
                { const u32x2_t sw = __builtin_amdgcn_permlane32_swap(__float_as_uint(mx), __float_as_uint(mx), false, false); mx = fmaxf(__uint_as_float(sw[0]), __uint_as_float(sw[1])); }
                const float ex = __expf(lgt - mx);
                float sum = ex;
                sum += __uint_as_float(__builtin_amdgcn_update_dpp(0u, __float_as_uint(sum), 0xB1, 0xf, 0xf, true));
                sum += __uint_as_float(__builtin_amdgcn_update_dpp(0u, __float_as_uint(sum), 0x4E, 0xf, 0xf, true));
                { const u32x2_t sw = __builtin_amdgcn_permlane16_swap(__float_as_uint(sum), __float_as_uint(sum), false, false); sum = __uint_as_float(sw[0]) + __uint_as_float(sw[1]); }
                { const u32x2_t sw = __builtin_amdgcn_permlane32_swap(__float_as_uint(sum), __float_as_uint(sum), false, false); sum = __uint_as_float(sw[0]) + __uint_as_float(sw[1]); }
                if ((lane & 12) == 0) AFF[(size_t)(row0 + r) * 16 + eidx] = ex / sum;
            }
        }
    }
}

constexpr int GS_LD = 72;
template <class AL, class EP>
__device__ __forceinline__ void gemm_tile_small(char* lds, const AL& al, const bf16_t* __restrict__ Bt, int ldb, int K, int row0, int col0, const EP& ep) {
    bf16_t* As = (bf16_t*)lds; bf16_t* Bs = As + 128 * GS_LD;
    const int tid = tidx(), lane = tid & 63, wid = tid >> 6, wr = wid >> 1, wc = wid & 1, fr = lane & 15, fq = lane >> 4;
    const int lr = tid >> 3, kc = tid & 7;
    f32x4 acc[2][4];
#pragma unroll
    for (int m = 0; m < 2; ++m)
#pragma unroll
        for (int n = 0; n < 4; ++n) acc[m][n] = (f32x4){0.f, 0.f, 0.f, 0.f};
    bf16x8 ra0 = al(row0 + lr, kc * 8), ra1 = al(row0 + lr + 64, kc * 8);
    bf16x8 rb0 = *(const bf16x8*)(Bt + (size_t)(col0 + lr) * ldb + kc * 8), rb1 = *(const bf16x8*)(Bt + (size_t)(col0 + lr + 64) * ldb + kc * 8);
    for (int k0 = 0; k0 < K; k0 += 64) {
        __syncthreads();
        *(bf16x8*)(As + lr * GS_LD + kc * 8) = ra0; *(bf16x8*)(As + (lr + 64) * GS_LD + kc * 8) = ra1;
        *(bf16x8*)(Bs + lr * GS_LD + kc * 8) = rb0; *(bf16x8*)(Bs + (lr + 64) * GS_LD + kc * 8) = rb1;
        __syncthreads();
        if (k0 + 64 < K) {
            const int kn = k0 + 64 + kc * 8;
            ra0 = al(row0 + lr, kn); ra1 = al(row0 + lr + 64, kn);
            rb0 = *(const bf16x8*)(Bt + (size_t)(col0 + lr) * ldb + kn); rb1 = *(const bf16x8*)(Bt + (size_t)(col0 + lr + 64) * ldb + kn);
        }
#pragma unroll
        for (int ks = 0; ks < 2; ++ks) {
            bf16x8 a[2], b[4];
#pragma unroll
            for (int m = 0; m < 2; ++m) a[m] = *(const bf16x8*)(As + (wr * 32 + m * 16 + fr) * GS_LD + ks * 32 + fq * 8);
#pragma unroll
            for (int n = 0; n < 4; ++n) b[n] = *(const bf16x8*)(Bs + (wc * 64 + n * 16 + fr) * GS_LD + ks * 32 + fq * 8);
#pragma unroll
            for (int m = 0; m < 2; ++m)
#pragma unroll
                for (int n = 0; n < 4; ++n) acc[m][n] = __builtin_amdgcn_mfma_f32_16x16x32_bf16(b[n], a[m], acc[m][n], 0, 0, 0);
        }
    }
#pragma unroll
    for (int m = 0; m < 2; ++m)
#pragma unroll
        for (int n = 0; n < 4; ++n) ep(row0 + wr * 32 + m * 16 + fr, col0 + wc * 64 + n * 16 + fq * 4, acc[m][n]);
}

struct PlainLoader {
    const bf16_t* A; int lda;
    __device__ __forceinline__ bf16x8 operator()(int row, int k) const { return *(const bf16x8*)(A + (size_t)row * lda + k); }
    struct Raw { u32x4 h; };
    struct RawK { int dummy; };
    __device__ __forceinline__ void loadk(int k, RawK& r) const { r.dummy = 0; }
    __device__ __forceinline__ void load(int row, int k, Raw& r) const { r.h = *(const u32x4*)(A + (size_t)row * lda + k); }
    __device__ __forceinline__ bf16x8 finish(const Raw& r, const RawK&) const { return __builtin_bit_cast(bf16x8, r.h); }
};
struct MixLoader {
    const bf16_t* H; const float* mix;
    __device__ __forceinline__ bf16x8 operator()(int row, int k) const {
        int nb;
        if (row < NLAT) {
            const int t = row & (TL - 1), gc = t & 63, gr = t >> 6, q = k >> 8;
            if (q == 0) nb = gc > 0 ? row - 1 : -1;
            else if (q == 1) nb = gc < 63 ? row + 1 : -1;
            else if (q == 2) nb = gr > 0 ? row - 64 : -1;
            else nb = gr < 63 ? row + 64 : -1;
        } else {
            const int t = (row - NLAT) & (TC - 1);
            if (k < 512) nb = t > 0 ? row - 1 : -1;
            else nb = t < TC - 1 ? row + 1 : -1;
        }
        const u32x4 h = *(const u32x4*)(H + (size_t)row * D + k);
        u32x4 s = (u32x4){0u, 0u, 0u, 0u};
        if (nb >= 0) s = *(const u32x4*)(H + (size_t)nb * D + k);
        const float4 m0 = *(const float4*)(mix + k), m1 = *(const float4*)(mix + k + 4);
        u32x4 o;
        { float a = bflo(h[0]), b = bfhi(h[0]); o[0] = pack2(a + (bflo(s[0]) - a) * m0.x, b + (bfhi(s[0]) - b) * m0.y); }
        { float a = bflo(h[1]), b = bfhi(h[1]); o[1] = pack2(a + (bflo(s[1]) - a) * m0.z, b + (bfhi(s[1]) - b) * m0.w); }
        { float a = bflo(h[2]), b = bfhi(h[2]); o[2] = pack2(a + (bflo(s[2]) - a) * m1.x, b + (bfhi(s[2]) - b) * m1.y); }
        { float a = bflo(h[3]), b = bfhi(h[3]); o[3] = pack2(a + (bflo(s[3]) - a) * m1.z, b + (bfhi(s[3]) - b) * m1.w); }
        return __builtin_bit_cast(bf16x8, o);
    }
    struct Raw { u32x4 h, s; };
    struct RawK { float4 m0, m1; };
    __device__ __forceinline__ void loadk(int k, RawK& r) const { r.m0 = *(const float4*)(mix + k); r.m1 = *(const float4*)(mix + k + 4); }
    __device__ __forceinline__ void load(int row, int k, Raw& r) const {
        int nb;
        if (row < NLAT) {
            const int t = row & (TL - 1), gc = t & 63, gr = t >> 6, q = k >> 8;
            if (q == 0) nb = gc > 0 ? row - 1 : -1;
            else if (q == 1) nb = gc < 63 ? row + 1 : -1;
            else if (q == 2) nb = gr > 0 ? row - 64 : -1;
            else nb = gr < 63 ? row + 64 : -1;
        } else {
            const int t = (row - NLAT) & (TC - 1);
            if (k < 512) nb = t > 0 ? row - 1 : -1;
            else nb = t < TC - 1 ? row + 1 : -1;
        }
        r.h = *(const u32x4*)(H + (size_t)row * D + k);
        r.s = (u32x4){0u, 0u, 0u, 0u};
        if (nb >= 0) r.s = *(const u32x4*)(H + (size_t)nb * D + k);
    }
    __device__ __forceinline__ bf16x8 finish(const Raw& r, const RawK& c) const {
        u32x4 o;
        { float a = bflo(r.h[0]), b = bfhi(r.h[0]); o[0] = pack2(a + (bflo(r.s[0]) - a) * c.m0.x, b + (bfhi(r.s[0]) - b) * c.m0.y); }
        { float a = bflo(r.h[1]), b = bfhi(r.h[1]); o[1] = pack2(a + (bflo(r.s[1]) - a) * c.m0.z, b + (bfhi(r.s[1]) - b) * c.m0.w); }
        { float a = bflo(r.h[2]), b = bfhi(r.h[2]); o[2] = pack2(a + (bflo(r.s[2]) - a) * c.m1.x, b + (bfhi(r.s[2]) - b) * c.m1.y); }
        { float a = bflo(r.h[3]), b = bfhi(r.h[3]); o[3] = pack2(a + (bflo(r.s[3]) - a) * c.m1.z, b + (bfhi(r.s[3]) - b) * c.m1.w); }
        return __builtin_bit_cast(bf16x8, o);
    }
};

__device__ __forceinline__ void lds_barrier() { asm volatile("s_waitcnt lgkmcnt(0)\n\ts_barrier" ::: "memory"); }
template <class AL, class EP>
__device__ __forceinline__ void gemm_tile_small2(char* lds, const AL& al, const bf16_t* __restrict__ Bt, int ldb, int K, int row0, int col0, const EP& ep) {
    bf16_t* As0 = (bf16_t*)lds;
    const int tid = tidx(), lane = tid & 63, wid = tid >> 6, wr = wid >> 1, wc = wid & 1, fr = lane & 15, fq = lane >> 4;
    const int lr = tid >> 3, kc = tid & 7;
    constexpr int PD = 4;
    f32x4 acc[2][4];
#pragma unroll
    for (int m = 0; m < 2; ++m)
#pragma unroll
        for (int n = 0; n < 4; ++n) acc[m][n] = (f32x4){0.f, 0.f, 0.f, 0.f};
    typename AL::Raw qa0[PD], qa1[PD]; typename AL::RawK qk[PD]; u32x4 qb0[PD], qb1[PD];
    const int nsteps = K / 64;
#define GTS2_ISSUE(SLOT, STEP) do { const int kn_ = (STEP) * 64 + kc * 8; al.loadk(kn_, qk[SLOT]); al.load(row0 + lr, kn_, qa0[SLOT]); al.load(row0 + lr + 64, kn_, qa1[SLOT]); \
        qb0[SLOT] = *(const u32x4*)(Bt + (size_t)(col0 + lr) * ldb + kn_); qb1[SLOT] = *(const u32x4*)(Bt + (size_t)(col0 + lr + 64) * ldb + kn_); } while (0)
#pragma unroll
    for (int d = 0; d < PD; ++d) GTS2_ISSUE(d, d);
    for (int s0 = 0; s0 < nsteps; s0 += PD) {
#pragma unroll
        for (int d = 0; d < PD; ++d) {
            const int step = s0 + d;
            bf16_t* As = As0 + (d & 1) * (256 * GS_LD); bf16_t* Bs = As + 128 * GS_LD;
            *(bf16x8*)(As + lr * GS_LD + kc * 8) = al.finish(qa0[d], qk[d]); *(bf16x8*)(As + (lr + 64) * GS_LD + kc * 8) = al.finish(qa1[d], qk[d]);
            *(u32x4*)(Bs + lr * GS_LD + kc * 8) = qb0[d]; *(u32x4*)(Bs + (lr + 64) * GS_LD + kc * 8) = qb1[d];
            lds_barrier();
            if (step + PD < nsteps) GTS2_ISSUE(d, step + PD);
#pragma unroll
            for (int ks = 0; ks < 2; ++ks) {
                bf16x8 a[2], b[4];
#pragma unroll
                for (int m = 0; m < 2; ++m) a[m] = *(const bf16x8*)(As + (wr * 32 + m * 16 + fr) * GS_LD + ks * 32 + fq * 8);
#pragma unroll
                for (int n = 0; n < 4; ++n) b[n] = *(const bf16x8*)(Bs + (wc * 64 + n * 16 + fr) * GS_LD + ks * 32 + fq * 8);
#pragma unroll
                for (int m = 0; m < 2; ++m)
#pragma unroll
                    for (int n = 0; n < 4; ++n) acc[m][n] = __builtin_amdgcn_mfma_f32_16x16x32_bf16(b[n], a[m], acc[m][n], 0, 0, 0);
            }
        }
    }
#undef GTS2_ISSUE
#pragma unroll
    for (int m = 0; m < 2; ++m)
#pragma unroll
        for (int n = 0; n < 4; ++n) ep(row0 + wr * 32 + m * 16 + fr, col0 + wc * 64 + n * 16 + fq * 4, acc[m][n]);
}

struct EpStoreBf16 {
    bf16_t* O; int ldo; int act;
    __device__ __forceinline__ void operator()(int row, int col, f32x4 v) const {
        if (act == 1) { v[0] = tanhf(v[0]); v[1] = tanhf(v[1]); v[2] = tanhf(v[2]); v[3] = tanhf(v[3]); }
        else if (act == 2) { v[0] = sigmoidf_(v[0]); v[1] = sigmoidf_(v[1]); v[2] = sigmoidf_(v[2]); v[3] = sigmoidf_(v[3]); }
        u32x2 o; o[0] = pack2(v[0], v[1]); o[1] = pack2(v[2], v[3]);
        *(u32x2*)(O + (size_t)row * ldo + col) = o;
    }
};
struct EpDecay {
    bf16_t* O; const float* w0;
    __device__ __forceinline__ void operator()(int row, int col, f32x4 v) const {
        const float4 b = *(const float4*)(w0 + col);
        u32x2 o;
        o[0] = pack2(-0.6065306597f * sigmoidf_(v[0] + b.x), -0.6065306597f * sigmoidf_(v[1] + b.y));
        o[1] = pack2(-0.6065306597f * sigmoidf_(v[2] + b.z), -0.6065306597f * sigmoidf_(v[3] + b.w));
        *(u32x2*)(O + (size_t)row * D + col) = o;
    }
};
struct EpSigBias {
    bf16_t* O; const float* b0;
    __device__ __forceinline__ void operator()(int row, int col, f32x4 v) const {
        const float4 b = *(const float4*)(b0 + col);
        u32x2 o;
        o[0] = pack2(sigmoidf_(v[0] + b.x), sigmoidf_(v[1] + b.y));
        o[1] = pack2(sigmoidf_(v[2] + b.z), sigmoidf_(v[3] + b.w));
        *(u32x2*)(O + (size_t)row * D + col) = o;
    }
};
struct EpVres {
    bf16_t* VF; const bf16_t* VRAW; const float* v0;
    __device__ __forceinline__ void operator()(int row, int col, f32x4 a) const {
        const float4 b = *(const float4*)(v0 + col);
        const u32x2 vr = *(const u32x2*)(VRAW + (size_t)row * D + col);
        const u32x2 vf = *(const u32x2*)(VF + (size_t)row * D + col);
        float x0 = bflo(vr[0]), x1 = bfhi(vr[0]), x2 = bflo(vr[1]), x3 = bfhi(vr[1]);
        float f0 = bflo(vf[0]), f1 = bfhi(vf[0]), f2 = bflo(vf[1]), f3 = bfhi(vf[1]);
        u32x2 o;
        o[0] = pack2(x0 + (f0 - x0) * sigmoidf_(a[0] + b.x), x1 + (f1 - x1) * sigmoidf_(a[1] + b.y));
        o[1] = pack2(x2 + (f2 - x2) * sigmoidf_(a[2] + b.z), x3 + (f3 - x3) * sigmoidf_(a[3] + b.w));
        *(u32x2*)(VF + (size_t)row * D + col) = o;
    }
};
struct EpResidual {
    float* X; const float* gate; const float* cscale; float amp;
    const float* xin; const float* cin;
    __device__ __forceinline__ void operator()(int row, int col, f32x4 a) const {
        const float4 gt = *(const float4*)(gate + (size_t)mod_row(row) * MODW + col);
        float4 cs = make_float4(amp, amp, amp, amp);
        if (cscale) { const float4 t = *(const float4*)(cscale + col); cs.x *= t.x; cs.y *= t.y; cs.z *= t.z; cs.w *= t.w; }
        float4* xp = (float4*)(X + (size_t)row * D + col);
        const float4* sp = xin ? (const float4*)((row < NLAT ? xin + (size_t)row * D : cin + (size_t)(row - NLAT) * D) + col) : (const float4*)xp;
        float4 x = *sp;
        x.x += gt.x * a[0] * cs.x; x.y += gt.y * a[1] * cs.y; x.z += gt.z * a[2] * cs.z; x.w += gt.w * a[3] * cs.w;
        *xp = x;
    }
};
struct EpD1 {
    bf16_t* D1; const float* cscale;
    __device__ __forceinline__ void operator()(int row, int col, f32x4 a, f32x4 b) const {
        if (cscale) { const float4 s0 = *(const float4*)(cscale + col), s1 = *(const float4*)(cscale + col + 4);
            a[0] *= s0.x; a[1] *= s0.y; a[2] *= s0.z; a[3] *= s0.w; b[0] *= s1.x; b[1] *= s1.y; b[2] *= s1.z; b[3] *= s1.w; }
        const u32x4 o = {pack2(a[0], a[1]), pack2(a[2], a[3]), pack2(b[0], b[1]), pack2(b[2], b[3])};
        *(u32x4*)(D1 + (size_t)row * D + col) = o;
    }
};
struct EpSwiglu {
    bf16_t* HID;
    __device__ __forceinline__ void operator()(int row, int col, f32x4 a) const {
        *(unsigned*)(HID + (size_t)row * FF + (col >> 1)) = pack2(siluf_(a[0]) * a[1], siluf_(a[2]) * a[3]);
    }
    __device__ __forceinline__ void operator()(int row, int col, f32x4 a, f32x4 b) const {
        const f32x2_t g0 = {a[0], a[2]}, u0 = {a[1], a[3]}, g1 = {b[0], b[2]}, u1 = {b[1], b[3]};
        const f32x2_t t0 = g0 * -1.44269504089f, t1 = g1 * -1.44269504089f;
        f32x2_t e0, e1; e0.x = __builtin_amdgcn_exp2f(t0.x); e0.y = __builtin_amdgcn_exp2f(t0.y); e1.x = __builtin_amdgcn_exp2f(t1.x); e1.y = __builtin_amdgcn_exp2f(t1.y);
        const f32x2_t d0 = e0 + 1.0f, d1 = e1 + 1.0f;
        f32x2_t r0, r1; r0.x = __builtin_amdgcn_rcpf(d0.x); r0.y = __builtin_amdgcn_rcpf(d0.y); r1.x = __builtin_amdgcn_rcpf(d1.x); r1.y = __builtin_amdgcn_rcpf(d1.y);
        const f32x2_t h0 = (g0 * u0) * r0, h1 = (g1 * u1) * r1;
        const u32x2 o = {pack2(h0.x, h0.y), pack2(h1.x, h1.y)};
        *(u32x2*)(HID + (size_t)row * FF + (col >> 1)) = o;
    }
};
struct EpSwiglu8 {
    char* HID;
    __device__ __forceinline__ void operator()(int row, int col, f32x4 a) const {
        int w = 0; w = __builtin_amdgcn_cvt_pk_fp8_f32(siluf_(a[0]) * a[1], siluf_(a[2]) * a[3], w, false);
        *(unsigned short*)(HID + (size_t)row * FF + (col >> 1)) = (unsigned short)w;
    }
    __device__ __forceinline__ void operator()(int row, int col, f32x4 a, f32x4 b) const {
        const f32x2_t g0 = {a[0], a[2]}, u0 = {a[1], a[3]}, g1 = {b[0], b[2]}, u1 = {b[1], b[3]};
        const f32x2_t t0 = g0 * -1.44269504089f, t1 = g1 * -1.44269504089f;
        f32x2_t e0, e1; e0.x = __builtin_amdgcn_exp2f(t0.x); e0.y = __builtin_amdgcn_exp2f(t0.y); e1.x = __builtin_amdgcn_exp2f(t1.x); e1.y = __builtin_amdgcn_exp2f(t1.y);
        const f32x2_t d0 = e0 + 1.0f, d1 = e1 + 1.0f;
        f32x2_t r0, r1; r0.x = __builtin_amdgcn_rcpf(d0.x); r0.y = __builtin_amdgcn_rcpf(d0.y); r1.x = __builtin_amdgcn_rcpf(d1.x); r1.y = __builtin_amdgcn_rcpf(d1.y);
        const f32x2_t h0 = (g0 * u0) * r0, h1 = (g1 * u1) * r1;
        int w = 0;
        w = __builtin_amdgcn_cvt_pk_fp8_f32(h0.x, h0.y, w, false);
        w = __builtin_amdgcn_cvt_pk_fp8_f32(h1.x, h1.y, w, true);
        *(unsigned*)(HID + (size_t)row * FF + (col >> 1)) = (unsigned)w;
    }
};
struct EpGateRow {
    bf16_t* YS; const float* gatev;
    __device__ __forceinline__ void operator()(int row, int col, f32x4 a) const {
        const float gt = gatev[row];
        u32x2 o; o[0] = pack2(a[0] * gt, a[1] * gt); o[1] = pack2(a[2] * gt, a[3] * gt);
        *(u32x2*)(YS + (size_t)row * D + col) = o;
    }
    __device__ __forceinline__ void operator()(int row, int col, f32x4 a, f32x4 b) const {
        const float gt = gatev[row];
        const u32x4 o = {pack2(a[0] * gt, a[1] * gt), pack2(a[2] * gt, a[3] * gt), pack2(b[0] * gt, b[1] * gt), pack2(b[2] * gt, b[3] * gt)};
        *(u32x4*)(YS + (size_t)row * D + col) = o;
    }
    __device__ __forceinline__ float rowval(int row) const { return gatev[row]; }
    __device__ __forceinline__ void operator()(int row, int col, f32x4 a, f32x4 b, float gt) const {
        const u32x4 o = {pack2(a[0] * gt, a[1] * gt), pack2(a[2] * gt, a[3] * gt), pack2(b[0] * gt, b[1] * gt), pack2(b[2] * gt, b[3] * gt)};
        *(u32x4*)(YS + (size_t)row * D + col) = o;
    }
};
template <class E> __device__ __forceinline__ auto ep_rowval(const E& e, int row, int) -> decltype(e.rowval(row)) { return e.rowval(row); }
template <class E> __device__ __forceinline__ float ep_rowval(const E&, int, long) { return 0.f; }
template <class E> __device__ __forceinline__ auto ep_call(const E& e, int row, int col, f32x4 a, f32x4 b, float rv, int) -> decltype(e(row, col, a, b, rv)) { return e(row, col, a, b, rv); }
template <class E> __device__ __forceinline__ void ep_call(const E& e, int row, int col, f32x4 a, f32x4 b, float, long) { e(row, col, a, b); }

#define LAS __attribute__((address_space(3)))
namespace g256 {
constexpr int BM = 256, BK = 64, HALF = 128, HTB = HALF * BK * 2, STAGE_BYTES = 8 * HTB;
__device__ __forceinline__ int lds_byte(int r, int c) { const int st = (r >> 4) * 2 + (c >> 5), rr = r & 15, cc = c & 31, ob = rr * 64 + cc * 2; return st * 1024 + (ob ^ (((ob >> 9) & 1) << 5)); }
__device__ __forceinline__ void stage_rc(int b, int& R, int& C) { const int st = b / 1024, sb = b % 1024, swz = sb ^ (((sb >> 9) & 1) << 5); R = (st >> 1) * 16 + swz / 64; C = (st & 1) * 32 + (swz % 64) / 2; }
struct Unit { const char* a; const char* b; int row0, col0; };
typedef int i32x4_t __attribute__((ext_vector_type(4)));
typedef int i32x8_t __attribute__((ext_vector_type(8)));
__device__ __forceinline__ i32x8_t cat8(bf16x8 lo, bf16x8 hi) { return __builtin_shufflevector(__builtin_bit_cast(i32x4_t, lo), __builtin_bit_cast(i32x4_t, hi), 0, 1, 2, 3, 4, 5, 6, 7); }

__device__ __forceinline__ int perm32(int rho) { const int n = rho >> 4, i = rho & 15; return 8 * (i >> 2) + 4 * n + (i & 3); }
template <bool PERM, bool F8 = false, bool GATHER = false, class Sched, class Ep>
__device__ __forceinline__ void gemm_phase(LAS unsigned char* lds, const int lda, const int ldb, const int K, const Sched& S, const Ep& E) {
    const int tid = tidx(), wid = __builtin_amdgcn_readfirstlane(tid >> 6), lane = tid & 63, wr = wid >> 2, wc = wid & 3, fr = lane & 15, fq = lane >> 4;
    const int nt = K / BK;
    int scw = 0x79797979, sca = 0x7F7F7F7F;
    if constexpr (F8) asm volatile("" : "+v"(scw), "+v"(sca));
    unsigned voffA[2], voffB[2], cbA[2];
#pragma unroll
    for (int i = 0; i < 2; ++i) { int R, C; stage_rc(tid * 16 + i * 8192, R, C); const int Rb = PERM ? ((R & ~31) + perm32(R & 31)) : R; voffA[i] = GATHER ? (unsigned)(R * 4) : (unsigned)(R * lda + C) * 2u; voffB[i] = (unsigned)(Rb * ldb + C) * 2u; cbA[i] = (unsigned)C * 2u; }
    LAS unsigned char* tokl = lds + LDS_TOK;
    unsigned gc[2][2], gn[2][2];
    const unsigned rowb = (unsigned)lda * 2u;
    const size_t kstep = (size_t)(BK * 2);
    const size_t hstepA = (size_t)HALF * lda * 2, hstepB = (size_t)HALF * ldb * 2;
    const unsigned ldsw = (unsigned)wid * 1024u;
    const int aoff = lds_byte(wr * 64 + fr, fq * 8), boff = lds_byte(wc * 32 + fr, fq * 8);
#define PG8_SA(b, h) (((b) * 2 + (h)) * HTB)
#define PG8_SB(b, h) ((4 + (b) * 2 + (h)) * HTB)
#define PG8_STAGE(bufoff, gbase, voff) do { _Pragma("unroll") for (int _i = 0; _i < 2; ++_i) \
        __builtin_amdgcn_global_load_lds((const unsigned*)((const char*)(gbase) + (voff)[_i]), (LAS unsigned*)(lds + (bufoff) + ldsw + _i * 8192), 16, 0, 0); } while (0)
#define PG8_STAGE_A(bufoff, ptr, h, goffs, koff) do { if constexpr (GATHER) { _Pragma("unroll") for (int _i = 0; _i < 2; ++_i) \
        __builtin_amdgcn_global_load_lds((const unsigned*)(S.abase + (size_t)(koff) + (goffs)[h][_i]), (LAS unsigned*)(lds + (bufoff) + ldsw + _i * 8192), 16, 0, 0); } \
        else PG8_STAGE(bufoff, ptr, voffA); } while (0)
#define PG8_LDA(dst, b, h) do { _Pragma("unroll") for (int m = 0; m < 4; ++m) _Pragma("unroll") for (int k = 0; k < 2; ++k) dst[m][k] = *(const LAS bf16x8*)(lds + PG8_SA(b, h) + aoff + m * 2048 + k * 1024); } while (0)
#define PG8_LDB(dst, b, h) do { _Pragma("unroll") for (int n = 0; n < 2; ++n) _Pragma("unroll") for (int k = 0; k < 2; ++k) dst[n][k] = *(const LAS bf16x8*)(lds + PG8_SB(b, h) + boff + n * 2048 + k * 1024); } while (0)
#define PG8_MMA(ai, bj, At, Bt) do { __builtin_amdgcn_s_setprio(1); _Pragma("unroll") for (int m = 0; m < 4; ++m) _Pragma("unroll") for (int n = 0; n < 2; ++n) { \
        if constexpr (F8) asm volatile("v_mfma_scale_f32_16x16x128_f8f6f4 %0, %1, %2, %0, %3, %4 op_sel_hi:[0,0,0]" : "+v"(acc[ai][bj][m][n]) : "v"(cat8(Bt[n][0], Bt[n][1])), "v"(cat8(At[m][0], At[m][1])), "v"(scw), "v"(sca)); \
        else { _Pragma("unroll") for (int k = 0; k < 2; ++k) acc[ai][bj][m][n] = __builtin_amdgcn_mfma_f32_16x16x32_bf16(Bt[n][k], At[m][k], acc[ai][bj][m][n], 0, 0, 0); } } \
        __builtin_amdgcn_s_setprio(0); } while (0)
#define PG8_WAIT_V(n) asm volatile("s_waitcnt vmcnt(" #n ")" ::: "memory")
#define PG8_WAIT_L(n) asm volatile("s_waitcnt lgkmcnt(" #n ")" ::: "memory")
#define PG8_BAR __builtin_amdgcn_s_barrier()
#define PG8_SCHED __builtin_amdgcn_sched_barrier(0)
    Unit cur, nxt; int ui = 0;
    if (!S.next(0, cur)) return;
    f32x4 acc[2][2][4][2];
#pragma unroll
    for (int a = 0; a < 2; ++a)
#pragma unroll
        for (int b = 0; b < 2; ++b)
#pragma unroll
            for (int m = 0; m < 4; ++m)
#pragma unroll
                for (int n = 0; n < 2; ++n) acc[a][b][m][n] = (f32x4){0.f, 0.f, 0.f, 0.f};
    bf16x8 At[4][2], B0[2][2], B1[2][2];
    const char* cA = cur.a; const char* cB = cur.b;
    if constexpr (GATHER) {
        if (tid < 256) *(LAS unsigned*)(tokl + tid * 4) = (unsigned)S.tok[cur.row0 + tid];
        __syncthreads();
#pragma unroll
        for (int h = 0; h < 2; ++h)
#pragma unroll
            for (int i = 0; i < 2; ++i) { gc[h][i] = *(const LAS unsigned*)(tokl + h * 512 + voffA[i]) * rowb + cbA[i]; gn[h][i] = gc[h][i]; }
        __syncthreads();
    }
    PG8_STAGE(PG8_SB(0, 0), cB, voffB); PG8_STAGE_A(PG8_SA(0, 0), cA, 0, gc, 0); PG8_STAGE(PG8_SB(0, 1), cB + hstepB, voffB); PG8_STAGE_A(PG8_SA(0, 1), cA + hstepA, 1, gc, 0);
    if (wr == 1) PG8_BAR;
    PG8_WAIT_V(4); PG8_BAR;
    PG8_STAGE(PG8_SB(1, 0), cB + kstep, voffB); PG8_STAGE_A(PG8_SA(1, 0), cA + kstep, 0, gc, kstep); PG8_STAGE(PG8_SB(1, 1), cB + hstepB + kstep, voffB);
    PG8_WAIT_V(6); PG8_BAR;
    for (;;) {
        const bool has_next = S.next(ui + 1, nxt);
        const char* nA = has_next ? nxt.a : cA; const char* nB = has_next ? nxt.b : cB;
        if constexpr (GATHER) {
            if (has_next && wid < 4) __builtin_amdgcn_global_load_lds((const unsigned*)(S.tok + nxt.row0 + tid), (LAS unsigned*)(tokl + wid * 256), 4, 0, 0);
        }
#pragma unroll 1
        for (int t = 0; t < nt; t += 2) {
            const bool last = (t == nt - 2);
            const char* a1 = cA + (size_t)(t + 1) * kstep;
            const char* a2 = last ? nA : cA + (size_t)(t + 2) * kstep; const char* b2 = last ? nB : cB + (size_t)(t + 2) * kstep;
            const char* a3 = a2 + kstep; const char* b3 = b2 + kstep;
            const size_t k1 = (size_t)(t + 1) * kstep, k2 = last ? (size_t)0 : (size_t)(t + 2) * kstep;
            unsigned o2[2][2];
            if constexpr (GATHER) {
                if (last && has_next) {
#pragma unroll
                    for (int h = 0; h < 2; ++h)
#pragma unroll
                        for (int i = 0; i < 2; ++i) gn[h][i] = *(const LAS unsigned*)(tokl + h * 512 + voffA[i]) * rowb + cbA[i];
                }
#pragma unroll
                for (int h = 0; h < 2; ++h)
#pragma unroll
                    for (int i = 0; i < 2; ++i) o2[h][i] = last ? gn[h][i] : gc[h][i];
            }
            PG8_LDB(B0, 0, 0); PG8_SCHED; PG8_LDA(At, 0, 0); PG8_STAGE_A(PG8_SA(1, 1), a1 + hstepA, 1, gc, k1);
            PG8_WAIT_L(8); PG8_BAR; PG8_WAIT_L(0); PG8_MMA(0, 0, At, B0); PG8_BAR; PG8_SCHED;
            PG8_LDB(B1, 0, 1); PG8_STAGE(PG8_SB(0, 0), b2, voffB);
            PG8_BAR; PG8_WAIT_L(0); PG8_MMA(0, 1, At, B1); PG8_BAR;
            PG8_LDA(At, 0, 1); PG8_STAGE_A(PG8_SA(0, 0), a2, 0, o2, k2);
            PG8_BAR; PG8_WAIT_L(0); PG8_MMA(1, 0, At, B0); PG8_BAR; PG8_SCHED;
            PG8_STAGE(PG8_SB(0, 1), b2 + hstepB, voffB);
            PG8_WAIT_V(6); PG8_BAR; PG8_MMA(1, 1, At, B1); PG8_BAR;
            PG8_LDB(B0, 1, 0); PG8_SCHED; PG8_LDA(At, 1, 0); PG8_STAGE_A(PG8_SA(0, 1), a2 + hstepA, 1, o2, k2);
            PG8_WAIT_L(8); PG8_BAR; PG8_WAIT_L(0); PG8_MMA(0, 0, At, B0); PG8_BAR; PG8_SCHED;
            PG8_LDB(B1, 1, 1); PG8_STAGE(PG8_SB(1, 0), b3, voffB);
            PG8_BAR; PG8_WAIT_L(0); PG8_MMA(0, 1, At, B1); PG8_BAR;
            PG8_LDA(At, 1, 1); PG8_STAGE_A(PG8_SA(1, 0), a3, 0, o2, k2 + kstep);
            PG8_BAR; PG8_WAIT_L(0); PG8_MMA(1, 0, At, B0); PG8_BAR; PG8_SCHED;
            PG8_STAGE(PG8_SB(1, 1), b3 + hstepB, voffB);
            PG8_WAIT_V(6); PG8_BAR; PG8_MMA(1, 1, At, B1); PG8_BAR;
        }
        float rvv[2][4];
        if constexpr (PERM) {
#pragma unroll
            for (int ai = 0; ai < 2; ++ai)
#pragma unroll
                for (int m = 0; m < 4; ++m) rvv[ai][m] = ep_rowval(E, cur.row0 + ai * HALF + wr * 64 + m * 16 + fr, 0);
        }
        if constexpr (F8) {
            asm volatile("s_nop 15\n\ts_nop 7" ::: "memory");
#pragma unroll
            for (int a = 0; a < 2; ++a)
#pragma unroll
                for (int b = 0; b < 2; ++b)
#pragma unroll
                    for (int m = 0; m < 4; ++m)
#pragma unroll
                        for (int n = 0; n < 2; ++n) asm volatile("" : "+v"(acc[a][b][m][n]));
        }
#pragma unroll
        for (int ai = 0; ai < 2; ++ai)
#pragma unroll
            for (int m = 0; m < 4; ++m)
#pragma unroll
                for (int bj = 0; bj < 2; ++bj) {
                    if constexpr (PERM) ep_call(E, cur.row0 + ai * HALF + wr * 64 + m * 16 + fr, cur.col0 + bj * HALF + wc * 32 + 8 * fq, acc[ai][bj][m][0], acc[ai][bj][m][1], rvv[ai][m], 0);
                    else {
#pragma unroll
                        for (int n = 0; n < 2; ++n) E(cur.row0 + ai * HALF + wr * 64 + m * 16 + fr, cur.col0 + bj * HALF + wc * 32 + n * 16 + 4 * fq, acc[ai][bj][m][n]);
                    }
                }
        if (!has_next) break;
#pragma unroll
        for (int a = 0; a < 2; ++a)
#pragma unroll
            for (int b = 0; b < 2; ++b)
#pragma unroll
                for (int m = 0; m < 4; ++m)
#pragma unroll
                    for (int n = 0; n < 2; ++n) acc[a][b][m][n] = (f32x4){0.f, 0.f, 0.f, 0.f};
        cur = nxt; cA = nA; cB = nB; ++ui;
        if constexpr (GATHER) {
#pragma unroll
            for (int h = 0; h < 2; ++h)
#pragma unroll
                for (int i = 0; i < 2; ++i) gc[h][i] = gn[h][i];
        }
    }
    PG8_WAIT_V(0);
    if (wr == 0) PG8_BAR;
    PG8_BAR;
#undef PG8_SA
#undef PG8_SB
#undef PG8_STAGE
#undef PG8_STAGE_A
#undef PG8_LDA
#undef PG8_LDB
#undef PG8_MMA
#undef PG8_WAIT_V
#undef PG8_WAIT_L
#undef PG8_BAR
#undef PG8_SCHED
}
__device__ __forceinline__ long unit_index(int i) {
    const int G = gridDim.x, c = blockIdx.x;
    if (G == 256) return ((long)i * 8 + (c & 7)) * 32 + (c >> 3);
    return (long)i * G + c;
}
}

__device__ __forceinline__ const bf16_t* wsm(const Params& p, int j, size_t off) { return (const bf16_t*)(p.ws + OFF_WSM) + (size_t)j * WJ_SIZE + off; }

__device__ __forceinline__ void phase_mix(const Params& p, int j) {
    const bf16_t* H = (const bf16_t*)(p.ws + OFF_H);
    const float* mix = p.in[8] + (size_t)j * 6 * D;
    bf16_t* XM = (bf16_t*)(p.ws + OFF_LW);
    const int tid_ = tidx(), lane = tid_ & 63, wid = tid_ >> 6;
    for (int cc = 0; cc < 2; ++cc) {
        const int k = cc * 512 + lane * 8;
        float m[3][8];
#pragma unroll
        for (int w = 0; w < 3; ++w) {
            const int mi = w == 0 ? 0 : (w == 1 ? 2 : 3);
            const float4 m0 = *(const float4*)(mix + mi * D + k), m1 = *(const float4*)(mix + mi * D + k + 4);
            m[w][0] = m0.x; m[w][1] = m0.y; m[w][2] = m0.z; m[w][3] = m0.w; m[w][4] = m1.x; m[w][5] = m1.y; m[w][6] = m1.z; m[w][7] = m1.w;
        }
        const int q = k >> 8;
        for (int grp = blockIdx.x * 8 + wid; grp < NT / 4; grp += gridDim.x * 8) {
            u32x4 h[4], s[4];
#pragma unroll
            for (int r = 0; r < 4; ++r) {
                const int row = grp * 4 + r;
                int nb;
                if (row < NLAT) {
                    const int t = row & (TL - 1), gc = t & 63, gr = t >> 6;
                    if (q == 0) nb = gc > 0 ? row - 1 : -1;
                    else if (q == 1) nb = gc < 63 ? row + 1 : -1;
                    else if (q == 2) nb = gr > 0 ? row - 64 : -1;
                    else nb = gr < 63 ? row + 64 : -1;
                } else {
                    const int t = (row - NLAT) & (TC - 1);
                    if (k < 512) nb = t > 0 ? row - 1 : -1;
                    else nb = t < TC - 1 ? row + 1 : -1;
                }
                h[r] = *(const u32x4*)(H + (size_t)row * D + k);
                s[r] = (u32x4){0u, 0u, 0u, 0u};
                if (nb >= 0) s[r] = *(const u32x4*)(H + (size_t)nb * D + k);
            }
#pragma unroll
            for (int r = 0; r < 4; ++r) {
                const int row = grp * 4 + r;
#pragma unroll
                for (int w = 0; w < 3; ++w) {
                    u32x4 o;
#pragma unroll
                    for (int e = 0; e < 4; ++e) {
                        const float x = bflo(h[r][e]), y = bfhi(h[r][e]);
                        o[e] = pack2(x + (bflo(s[r][e]) - x) * m[w][2 * e], y + (bfhi(s[r][e]) - y) * m[w][2 * e + 1]);
                    }
                    *(u32x4*)(XM + (size_t)w * NT * D + (size_t)row * D + k) = o;
                }
            }
        }
    }
}

struct SchedGrid {
    const char* A; const char* B; size_t a_mat, b_mat, a_rt, a_ct, b_ct; int cpm, total;
    __device__ __forceinline__ bool next(int i, g256::Unit& u) const {
        const long L = g256::unit_index(i);
        if (L >= total) return false;
        const int chunk = (int)(L >> 5), o = (int)(L & 31), mat = chunk / cpm, ch = chunk % cpm, rt = ch * 8 + (o >> 2), ct = o & 3;
        u.a = A + (size_t)mat * a_mat + (size_t)rt * a_rt + (size_t)ct * a_ct; u.b = B + (size_t)mat * b_mat + (size_t)ct * b_ct;
        u.row0 = rt * 256; u.col0 = mat * 1024 + ct * 256;
        return true;
    }
};
struct EpRKV {
    bf16_t* R; long vdelta;
    __device__ __forceinline__ void operator()(int row, int col, f32x4 v) const {
        const int mat = col >> 10, c = col & 1023;
        bf16_t* O = R + (size_t)mat * NT * D + (mat == 2 ? vdelta : 0l);
        u32x2 o; o[0] = pack2(v[0], v[1]); o[1] = pack2(v[2], v[3]);
        *(u32x2*)(O + (size_t)row * D + c) = o;
    }
    __device__ __forceinline__ void operator()(int row, int col, f32x4 v, f32x4 w) const {
        const int mat = col >> 10, c = col & 1023;
        bf16_t* O = R + (size_t)mat * NT * D + (mat == 2 ? vdelta : 0l);
        const u32x4 o = {pack2(v[0], v[1]), pack2(v[2], v[3]), pack2(w[0], w[1]), pack2(w[2], w[3])};
        *(u32x4*)(O + (size_t)row * D + c) = o;
    }
};

__device__ __forceinline__ void phase_rwkv_proj(const Params& p, int j, char* lds) {
    const bf16_t* H = (const bf16_t*)(p.ws + OFF_H);
    const float* mix = p.in[8] + (size_t)j * 6 * D;
    bf16_t* R = (bf16_t*)(p.ws + OFF_R);
    bf16_t* V = (bf16_t*)(p.ws + (j == 0 ? OFF_VF : OFF_Y));
    bf16_t* LD = (bf16_t*)(p.ws + OFF_LD);
    const bf16_t* XM = (const bf16_t*)(p.ws + OFF_LW);
    {
        SchedGrid S{(const char*)XM, (const char*)wsm(p, j, WJ_RKV), (size_t)NT * D * 2, (size_t)D * D * 2, (size_t)256 * D * 2, 0, (size_t)256 * D * 2, NT / 256 / 8, 3 * (NT / 256) * 4};
        EpRKV E{R, (long)(V - (R + (size_t)2 * NT * D))};
        g256::gemm_phase<true>((LAS unsigned char*)lds, D, D, D, S, E);
    }
    constexpr int RT = NT / 128;
    const int nsmall = (j == 0 ? 3 : 4) * RT;
    for (int u = blockIdx.x; u < nsmall; u += gridDim.x) {
        const int which = u / RT, rt = u % RT;
        EpStoreBf16 ep{LD + (size_t)which * NT * 128, 128, which == 0 ? 1 : (which == 2 ? 2 : 0)};
        if (which < 3) {
            const int mi = which == 0 ? 1 : (which == 1 ? 4 : 5);
            MixLoader al{H, mix + mi * D};
            const bf16_t* Bt = which == 0 ? wsm(p, j, WJ_W1) : which == 1 ? wsm(p, j, WJ_A1) : wsm(p, j, WJ_G1);
            gemm_tile_small2(lds, al, Bt, D, D, rt * 128, 0, ep);
        } else {
            PlainLoader al{XM + (size_t)2 * NT * D, D};
            gemm_tile_small2(lds, al, (const bf16_t*)(p.ws + OFF_WSM) + W_V1, D, D, rt * 128, 0, ep);
        }
    }
}

template <int KS, int MODE>
__device__ __forceinline__ void gemm_bstat(const bf16_t* __restrict__ A, int lda, const bf16_t* __restrict__ Bt, int ldb, int col0, int rt0, int rt1,
                                           bf16_t* O, const float* bias, const bf16_t* VRAW) {
    const int tid = tidx(), lane = tid & 63, wid = tid >> 6, wr = wid >> 2, wc = wid & 3, fr = lane & 15, fq = lane >> 4;
    bf16x8 bfr[4][KS];
#pragma unroll
    for (int n = 0; n < 4; ++n) {
        const int colb = col0 + wc * 64 + (n >> 1) * 32 + 8 * (fr >> 2) + 4 * (n & 1) + (fr & 3);
#pragma unroll
        for (int ks = 0; ks < KS; ++ks) bfr[n][ks] = *(const bf16x8*)(Bt + (size_t)colb * ldb + ks * 32 + fq * 8);
    }
    float bs[2][8];
#pragma unroll
    for (int pp = 0; pp < 2; ++pp)
#pragma unroll
        for (int e = 0; e < 8; ++e) bs[pp][e] = MODE == 2 ? 0.f : bias[col0 + wc * 64 + pp * 32 + 8 * fq + e] * ((MODE == 0 || MODE == 1) ? -1.44269504089f : 1.f);
    bf16x8 afr[4][KS];
#pragma unroll
    for (int m = 0; m < 4; ++m)
#pragma unroll
        for (int ks = 0; ks < KS; ++ks) afr[m][ks] = *(const bf16x8*)(A + (size_t)(rt0 * 128 + wr * 64 + m * 16 + fr) * lda + ks * 32 + fq * 8);
    for (int rt = rt0; rt < rt1; ++rt) {
        u32x4 pvr[4][2], pvf[4][2];
        if (MODE == 3) {
#pragma unroll
            for (int m = 0; m < 4; ++m)
#pragma unroll
                for (int pp = 0; pp < 2; ++pp) {
                    const size_t o = (size_t)(rt * 128 + wr * 64 + m * 16 + fr) * D + col0 + wc * 64 + pp * 32 + 8 * fq;
                    pvr[m][pp] = *(const u32x4*)(VRAW + o); pvf[m][pp] = *(const u32x4*)(O + o);
                }
        }
        f32x4 acc[4][4];
#pragma unroll
        for (int m = 0; m < 4; ++m)
#pragma unroll
            for (int n = 0; n < 4; ++n) {
                acc[m][n] = (f32x4){0.f, 0.f, 0.f, 0.f};
#pragma unroll
                for (int ks = 0; ks < KS; ++ks) acc[m][n] = __builtin_amdgcn_mfma_f32_16x16x32_bf16(bfr[n][ks], afr[m][ks], acc[m][n], 0, 0, 0);
            }
        if (rt + 1 < rt1) {
#pragma unroll
            for (int m = 0; m < 4; ++m)
#pragma unroll
                for (int ks = 0; ks < KS; ++ks) afr[m][ks] = *(const bf16x8*)(A + (size_t)((rt + 1) * 128 + wr * 64 + m * 16 + fr) * lda + ks * 32 + fq * 8);
        }
#pragma unroll
        for (int m = 0; m < 4; ++m)
#pragma unroll
            for (int pp = 0; pp < 2; ++pp) {
                const size_t o = (size_t)(rt * 128 + wr * 64 + m * 16 + fr) * D + col0 + wc * 64 + pp * 32 + 8 * fq;
                float v[8];
#pragma unroll
                for (int e = 0; e < 4; ++e) { v[e] = acc[m][2 * pp][e]; v[4 + e] = acc[m][2 * pp + 1][e]; }
                if (MODE == 0 || MODE == 1) {
#pragma unroll
                    for (int e = 0; e < 8; e += 2) {
                        const f32x2_t x = {v[e], v[e + 1]}, bb = {bs[pp][e], bs[pp][e + 1]};
                        const f32x2_t t = x * -1.44269504089f + bb;
                        f32x2_t ex; ex.x = __builtin_amdgcn_exp2f(t.x); ex.y = __builtin_amdgcn_exp2f(t.y);
                        const f32x2_t dn = ex + 1.0f;
                        f32x2_t r; r.x = __builtin_amdgcn_rcpf(dn.x); r.y = __builtin_amdgcn_rcpf(dn.y);
                        if (MODE == 0) r = r * -0.6065306597f;
                        v[e] = r.x; v[e + 1] = r.y;
                    }
                } else if (MODE == 3) {
                    const u32x4 vr = pvr[m][pp], vf = pvf[m][pp];
#pragma unroll
                    for (int e = 0; e < 8; ++e) {
                        const float x = (e & 1) ? bfhi(vr[e >> 1]) : bflo(vr[e >> 1]), f = (e & 1) ? bfhi(vf[e >> 1]) : bflo(vf[e >> 1]);
                        v[e] = x + (f - x) * sigmoidf_(v[e] + bs[pp][e]);
                    }
                }
                const u32x4 w = {pack2(v[0], v[1]), pack2(v[2], v[3]), pack2(v[4], v[5]), pack2(v[6], v[7])};
                *(u32x4*)(O + o) = w;
            }
    }
}
__device__ __forceinline__ void phase_rwkv_up(const Params& p, int j, char* lds) {
    bf16_t* LD = (bf16_t*)(p.ws + OFF_LD);
    bf16_t* LW = (bf16_t*)(p.ws + OFF_LW); bf16_t* AD = (bf16_t*)(p.ws + OFF_AD); bf16_t* G = (bf16_t*)(p.ws + OFF_G);
    constexpr int RT = NT / 128, NRC = 32, RPC = RT / NRC;
    constexpr int NRV = 64;
    const int ntot = j == 0 ? 0 : 4 * NRV;
    for (int u = blockIdx.x; u < ntot; u += gridDim.x) {
        const int which = 5, ct = u / NRV, rc = u % NRV;
        const int rt0 = (rc * RT) / NRV, rt1 = ((rc + 1) * RT) / NRV, col0 = ct * 256;
        if (which < 2) {
            const int d = which;
            gemm_bstat<2, 0>(LD + d * 64, 128, wsm(p, j, WJ_W2) + (size_t)d * D * 64, 64, col0, rt0, rt1, LW + (size_t)d * NT * D, p.in[10] + ((size_t)j * 2 + d) * D, nullptr);
        } else if (which < 4) {
            const int d = which - 2;
            gemm_bstat<2, 1>(LD + (size_t)NT * 128 + d * 64, 128, wsm(p, j, WJ_A2) + (size_t)d * D * 64, 64, col0, rt0, rt1, AD + (size_t)d * NT * D, p.in[13] + ((size_t)j * 2 + d) * D, nullptr);
        } else if (which == 4) {
            gemm_bstat<4, 2>(LD + (size_t)2 * NT * 128, 128, wsm(p, j, WJ_G2), 128, col0, rt0, rt1, G, nullptr, nullptr);
        } else {
            gemm_bstat<2, 3>(LD + (size_t)3 * NT * 128, 128, (const bf16_t*)(p.ws + OFF_WSM) + W_V2, 64, col0, rt0, rt1, (bf16_t*)(p.ws + OFF_VF), p.in[16], (const bf16_t*)(p.ws + OFF_Y));
        }
    }
}

__device__ __forceinline__ void phase_rwkv_up2(const Params& p, int j, char* lds) {
    const bf16_t* R = (const bf16_t*)(p.ws + OFF_R); const bf16_t* Kb = (const bf16_t*)(p.ws + OFF_K);
    bf16_t* KK = (bf16_t*)(p.ws + OFF_H); float* BON = (float*)(p.ws + OFF_BON);
    const float* k_k = p.in[21] + (size_t)j * D; const float* k_a = p.in[22] + (size_t)j * D; const float* r_k = p.in[23] + (size_t)j * D;
    float* cst = (float*)lds;
    constexpr int TR = 32, MT = 1, RT = NT / TR, NRC = 64, RPC = RT / NRC, KS = 2;
    const int tid = tidx(), lane = tid & 63, wid = tid >> 6, wr = wid >> 2, wc = wid & 3, fr = lane & 15, fq = lane >> 4;
    const bf16_t* A = (const bf16_t*)(p.ws + OFF_LD) + (size_t)NT * 128;
    bf16_t* AD = (bf16_t*)(p.ws + OFF_AD);
    for (int u = blockIdx.x; u < 4 * NRC; u += gridDim.x) {
        const int ct = u / NRC, rc = u % NRC, rt0 = rc * RPC, rt1 = rt0 + RPC, col0 = ct * 256, head = ct * 4 + wc;
        __syncthreads();
        if (tid < 256) {
            const float kk_ = k_k[col0 + tid], ka_ = k_a[col0 + tid], rk_ = r_k[col0 + tid];
            cst[tid] = kk_; cst[256 + tid] = rk_ * (1.f - ka_); cst[512 + tid] = 0.5f * rk_ * ka_;
            cst[768 + tid] = p.in[13][((size_t)j * 2 + 0) * D + col0 + tid] * -1.44269504089f; cst[1024 + tid] = p.in[13][((size_t)j * 2 + 1) * D + col0 + tid] * -1.44269504089f;
        }
        __syncthreads();
        bf16x8 bfr[2][4][KS];
#pragma unroll
        for (int d = 0; d < 2; ++d)
#pragma unroll
            for (int n = 0; n < 4; ++n) {
                const int colb = col0 + wc * 64 + (n >> 1) * 32 + 8 * (fr >> 2) + 4 * (n & 1) + (fr & 3);
#pragma unroll
                for (int ks = 0; ks < KS; ++ks) bfr[d][n][ks] = *(const bf16x8*)(wsm(p, j, WJ_A2) + (size_t)d * D * 64 + (size_t)colb * 64 + ks * 32 + fq * 8);
            }
        bf16x8 afr[MT][2][KS];
#pragma unroll
        for (int m = 0; m < MT; ++m)
#pragma unroll
            for (int d = 0; d < 2; ++d)
#pragma unroll
                for (int ks = 0; ks < KS; ++ks) afr[m][d][ks] = *(const bf16x8*)(A + (size_t)(rt0 * TR + wr * (16 * MT) + m * 16 + fr) * 128 + d * 64 + ks * 32 + fq * 8);
#pragma unroll 1
        for (int rt = rt0; rt < rt1; ++rt) {
#pragma unroll
            for (int m = 0; m < MT; ++m) {
                const int row = rt * TR + wr * (16 * MT) + m * 16 + fr;
                const size_t o = (size_t)row * D + col0 + wc * 64 + 8 * fq;
                u32x4 kv[2], rv[2];
#pragma unroll
                for (int pp = 0; pp < 2; ++pp) { kv[pp] = *(const u32x4*)(Kb + o + pp * 32); rv[pp] = *(const u32x4*)(R + o + pp * 32); }
                float asum[16];
#pragma unroll
                for (int d = 0; d < 2; ++d) {
                    f32x4 acc[4];
#pragma unroll
                    for (int n = 0; n < 4; ++n) {
                        acc[n] = (f32x4){0.f, 0.f, 0.f, 0.f};
#pragma unroll
                        for (int ks = 0; ks < KS; ++ks) acc[n] = __builtin_amdgcn_mfma_f32_16x16x32_bf16(bfr[d][n][ks], afr[m][d][ks], acc[n], 0, 0, 0);
                    }
#pragma unroll
                    for (int pp = 0; pp < 2; ++pp) {
                        const float* bp = cst + 768 + d * 256 + wc * 64 + pp * 32 + 8 * fq;
                        const float4 b0 = *(const float4*)bp, b1 = *(const float4*)(bp + 4);
                        const float bs[8] = {b0.x, b0.y, b0.z, b0.w, b1.x, b1.y, b1.z, b1.w};
                        float av[8];
#pragma unroll
                        for (int e = 0; e < 8; e += 2) {
                            const f32x2_t x = {acc[2 * pp + (e >> 2)][e & 3], acc[2 * pp + (e >> 2)][(e & 3) + 1]}, bb = {bs[e], bs[e + 1]};
                            const f32x2_t t = x * -1.44269504089f + bb;
                            f32x2_t ex; ex.x = __builtin_amdgcn_exp2f(t.x); ex.y = __builtin_amdgcn_exp2f(t.y);
                            const f32x2_t dn = ex + 1.0f;
                            av[e] = __builtin_amdgcn_rcpf(dn.x); av[e + 1] = __builtin_amdgcn_rcpf(dn.y);
                        }
                        const u32x4 w = {pack2(av[0], av[1]), pack2(av[2], av[3]), pack2(av[4], av[5]), pack2(av[6], av[7])};
                        *(u32x4*)(AD + (size_t)d * NT * D + o + pp * 32) = w;
#pragma unroll
                        for (int e = 0; e < 8; ++e) { const float ab = bf2f(f2bf(av[e])); asum[pp * 8 + e] = d == 0 ? ab : asum[pp * 8 + e] + ab; }
                    }
                }
                if (rt + 1 < rt1) {
#pragma unroll
                    for (int d = 0; d < 2; ++d)
#pragma unroll
                        for (int ks = 0; ks < KS; ++ks) afr[m][d][ks] = *(const bf16x8*)(A + (size_t)((rt + 1) * TR + wr * (16 * MT) + m * 16 + fr) * 128 + d * 64 + ks * 32 + fq * 8);
                }
                float kk[16]; float n2 = 0.f, bon = 0.f;
#pragma unroll
                for (int pp = 0; pp < 2; ++pp) {
                    const float* cp = cst + wc * 64 + pp * 32 + 8 * fq;
                    const float4 q0 = *(const float4*)cp, q1 = *(const float4*)(cp + 4), c10 = *(const float4*)(cp + 256), c11 = *(const float4*)(cp + 260), c20 = *(const float4*)(cp + 512), c21 = *(const float4*)(cp + 516);
                    const float kkw[8] = {q0.x, q0.y, q0.z, q0.w, q1.x, q1.y, q1.z, q1.w}, c1[8] = {c10.x, c10.y, c10.z, c10.w, c11.x, c11.y, c11.z, c11.w}, c2[8] = {c20.x, c20.y, c20.z, c20.w, c21.x, c21.y, c21.z, c21.w};
#pragma unroll
                    for (int e = 0; e < 8; ++e) {
                        const unsigned kw = kv[pp][e >> 1], rw = rv[pp][e >> 1];
                        const float k = (e & 1) ? bfhi(kw) : bflo(kw), rr = (e & 1) ? bfhi(rw) : bflo(rw);
                        kk[pp * 8 + e] = k * kkw[e]; n2 += kk[pp * 8 + e] * kk[pp * 8 + e];
                        bon += rr * k * (c1[e] + c2[e] * asum[pp * 8 + e]);
                    }
                }
                bon = red4(bon); n2 = red4(n2);
                if (fq == 0) BON[(size_t)row * 16 + head] = bon;
                const float inv = 1.f / fmaxf(sqrtf(n2), 1e-12f);
#pragma unroll
                for (int pp = 0; pp < 2; ++pp) {
                    const u32x4 w = {pack2(kk[pp * 8 + 0] * inv, kk[pp * 8 + 1] * inv), pack2(kk[pp * 8 + 2] * inv, kk[pp * 8 + 3] * inv), pack2(kk[pp * 8 + 4] * inv, kk[pp * 8 + 5] * inv), pack2(kk[pp * 8 + 6] * inv, kk[pp * 8 + 7] * inv)};
                    *(u32x4*)(KK + o + pp * 32) = w;
                }
            }
        }
    }
}

__device__ __forceinline__ void phase_rwkv_prep(const Params& p, int j) {
    const bf16_t* R = (const bf16_t*)(p.ws + OFF_R); const bf16_t* Kb = (const bf16_t*)(p.ws + OFF_K);
    const bf16_t* AD = (const bf16_t*)(p.ws + OFF_AD);
    bf16_t* KK = (bf16_t*)(p.ws + OFF_H); float* BON = (float*)(p.ws + OFF_BON);
    const float* k_k = p.in[21] + (size_t)j * D; const float* k_a = p.in[22] + (size_t)j * D; const float* r_k = p.in[23] + (size_t)j * D;
    const int tid_ = tidx(), lane = tid_ & 63, wid = tid_ >> 6, c0 = lane * 16;
    float kkw[16], kaw[16], rkw[16];
#pragma unroll
    for (int i = 0; i < 16; ++i) { kkw[i] = k_k[c0 + i]; kaw[i] = k_a[c0 + i]; rkw[i] = r_k[c0 + i]; }
    constexpr int RW = 2;
    for (int grp = blockIdx.x * 8 + wid; grp < NT / RW; grp += gridDim.x * 8) {
        u32x4 kv[RW][2], rv[RW][2], a0[RW][2], a1[RW][2];
#pragma unroll
        for (int r = 0; r < RW; ++r) {
            const size_t o = (size_t)(grp * RW + r) * D + c0;
#pragma unroll
            for (int i = 0; i < 2; ++i) {
                kv[r][i] = *(const u32x4*)(Kb + o + i * 8); rv[r][i] = *(const u32x4*)(R + o + i * 8);
                a0[r][i] = *(const u32x4*)(AD + o + i * 8); a1[r][i] = *(const u32x4*)(AD + (size_t)NT * D + o + i * 8);
            }
        }
#pragma unroll
        for (int r = 0; r < RW; ++r) {
            const int row = grp * RW + r;
            const size_t o = (size_t)row * D + c0;
            float kk[16]; float n2 = 0.f, bon = 0.f;
#pragma unroll
            for (int i = 0; i < 16; ++i) {
                const unsigned kw = kv[r][i >> 3][(i >> 1) & 3], rw = rv[r][i >> 3][(i >> 1) & 3], aw0 = a0[r][i >> 3][(i >> 1) & 3], aw1 = a1[r][i >> 3][(i >> 1) & 3];
                const float k = (i & 1) ? bfhi(kw) : bflo(kw), rr = (i & 1) ? bfhi(rw) : bflo(rw);
                const float am = 0.5f * (((i & 1) ? bfhi(aw0) : bflo(aw0)) + ((i & 1) ? bfhi(aw1) : bflo(aw1)));
                kk[i] = k * kkw[i]; n2 += kk[i] * kk[i];
                bon += rr * (k * (1.f + (am - 1.f) * kaw[i])) * rkw[i];
            }
            n2 += __shfl_xor(n2, 1, 64); n2 += __shfl_xor(n2, 2, 64);
            bon += __shfl_xor(bon, 1, 64); bon += __shfl_xor(bon, 2, 64);
            const float inv = 1.f / fmaxf(sqrtf(n2), 1e-12f);
            u32x4 ov[2];
#pragma unroll
            for (int i = 0; i < 8; ++i) ov[i >> 2][i & 3] = pack2(kk[2 * i] * inv, kk[2 * i + 1] * inv);
            *(u32x4*)(KK + o) = ov[0]; *(u32x4*)(KK + o + 8) = ov[1];
            if ((lane & 3) == 0) BON[(size_t)row * 16 + (lane >> 2)] = bon;
        }
    }
}

#define SCAN_STEP_ASM \
    "s_nop 1\n\t" \
    "v_mul_f32_dpp %0, %20, %0 row_newbcast:0 row_mask:0xf bank_mask:0xf\n\t" \
    "v_mul_f32_dpp %1, %20, %1 row_newbcast:1 row_mask:0xf bank_mask:0xf\n\t" \
    "v_mul_f32_dpp %2, %20, %2 row_newbcast:2 row_mask:0xf bank_mask:0xf\n\t" \
    "v_mul_f32_dpp %3, %20, %3 row_newbcast:3 row_mask:0xf bank_mask:0xf\n\t" \
    "v_mul_f32_dpp %4, %20, %4 row_newbcast:4 row_mask:0xf bank_mask:0xf\n\t" \
    "v_mul_f32_dpp %5, %20, %5 row_newbcast:5 row_mask:0xf bank_mask:0xf\n\t" \
    "v_mul_f32_dpp %6, %20, %6 row_newbcast:6 row_mask:0xf bank_mask:0xf\n\t" \
    "v_mul_f32_dpp %7, %20, %7 row_newbcast:7 row_mask:0xf bank_mask:0xf\n\t" \
    "v_mul_f32_dpp %8, %20, %8 row_newbcast:8 row_mask:0xf bank_mask:0xf\n\t" \
    "v_mul_f32_dpp %9, %20, %9 row_newbcast:9 row_mask:0xf bank_mask:0xf\n\t" \
    "v_mul_f32_dpp %10, %20, %10 row_newbcast:10 row_mask:0xf bank_mask:0xf\n\t" \
    "v_mul_f32_dpp %11, %20, %11 row_newbcast:11 row_mask:0xf bank_mask:0xf\n\t" \
    "v_mul_f32_dpp %12, %20, %12 row_newbcast:12 row_mask:0xf bank_mask:0xf\n\t" \
    "v_mul_f32_dpp %13, %20, %13 row_newbcast:13 row_mask:0xf bank_mask:0xf\n\t" \
    "v_mul_f32_dpp %14, %20, %14 row_newbcast:14 row_mask:0xf bank_mask:0xf\n\t" \
    "v_mul_f32_dpp %15, %20, %15 row_newbcast:15 row_mask:0xf bank_mask:0xf\n\t" \
    "v_fmac_f32_dpp %0, %21, %25 row_newbcast:0 row_mask:0xf bank_mask:0xf\n\t" \
    "v_fmac_f32_dpp %1, %21, %25 row_newbcast:1 row_mask:0xf bank_mask:0xf\n\t" \
    "v_fmac_f32_dpp %2, %21, %25 row_newbcast:2 row_mask:0xf bank_mask:0xf\n\t" \
    "v_fmac_f32_dpp %3, %21, %25 row_newbcast:3 row_mask:0xf bank_mask:0xf\n\t" \
    "v_fmac_f32_dpp %4, %21, %25 row_newbcast:4 row_mask:0xf bank_mask:0xf\n\t" \
    "v_fmac_f32_dpp %5, %21, %25 row_newbcast:5 row_mask:0xf bank_mask:0xf\n\t" \
    "v_fmac_f32_dpp %6, %21, %25 row_newbcast:6 row_mask:0xf bank_mask:0xf\n\t" \
    "v_fmac_f32_dpp %7, %21, %25 row_newbcast:7 row_mask:0xf bank_mask:0xf\n\t" \
    "v_fmac_f32_dpp %8, %21, %25 row_newbcast:8 row_mask:0xf bank_mask:0xf\n\t" \
    "v_fmac_f32_dpp %9, %21, %25 row_newbcast:9 row_mask:0xf bank_mask:0xf\n\t" \
    "v_fmac_f32_dpp %10, %21, %25 row_newbcast:10 row_mask:0xf bank_mask:0xf\n\t" \
    "v_fmac_f32_dpp %11, %21, %25 row_newbcast:11 row_mask:0xf bank_mask:0xf\n\t" \
    "v_fmac_f32_dpp %12, %21, %25 row_newbcast:12 row_mask:0xf bank_mask:0xf\n\t" \
    "v_fmac_f32_dpp %13, %21, %25 row_newbcast:13 row_mask:0xf bank_mask:0xf\n\t" \
    "v_fmac_f32_dpp %14, %21, %25 row_newbcast:14 row_mask:0xf bank_mask:0xf\n\t" \
    "v_fmac_f32_dpp %15, %21, %25 row_newbcast:15 row_mask:0xf bank_mask:0xf\n\t" \
    "v_fmac_f32_dpp %0, %22, %26 row_newbcast:0 row_mask:0xf bank_mask:0xf\n\t" \
    "v_fmac_f32_dpp %1, %22, %26 row_newbcast:1 row_mask:0xf bank_mask:0xf\n\t" \
    "v_fmac_f32_dpp %2, %22, %26 row_newbcast:2 row_mask:0xf bank_mask:0xf\n\t" \
    "v_fmac_f32_dpp %3, %22, %26 row_newbcast:3 row_mask:0xf bank_mask:0xf\n\t" \
    "v_fmac_f32_dpp %4, %22, %26 row_newbcast:4 row_mask:0xf bank_mask:0xf\n\t" \
    "v_fmac_f32_dpp %5, %22, %26 row_newbcast:5 row_mask:0xf bank_mask:0xf\n\t" \
    "v_fmac_f32_dpp %6, %22, %26 row_newbcast:6 row_mask:0xf bank_mask:0xf\n\t" \
    "v_fmac_f32_dpp %7, %22, %26 row_newbcast:7 row_mask:0xf bank_mask:0xf\n\t" \
    "v_fmac_f32_dpp %8, %22, %26 row_newbcast:8 row_mask:0xf bank_mask:0xf\n\t" \
    "v_fmac_f32_dpp %9, %22, %26 row_newbcast:9 row_mask:0xf bank_mask:0xf\n\t" \
    "v_fmac_f32_dpp %10, %22, %26 row_newbcast:10 row_mask:0xf bank_mask:0xf\n\t" \
    "v_fmac_f32_dpp %11, %22, %26 row_newbcast:11 row_mask:0xf bank_mask:0xf\n\t" \
    "v_fmac_f32_dpp %12, %22, %26 row_newbcast:12 row_mask:0xf bank_mask:0xf\n\t" \
    "v_fmac_f32_dpp %13, %22, %26 row_newbcast:13 row_mask:0xf bank_mask:0xf\n\t" \
    "v_fmac_f32_dpp %14, %22, %26 row_newbcast:14 row_mask:0xf bank_mask:0xf\n\t" \
    "v_fmac_f32_dpp %15, %22, %26 row_newbcast:15 row_mask:0xf bank_mask:0xf\n\t" \
    "v_mul_f32_dpp %16, %23, %0 row_newbcast:0 row_mask:0xf bank_mask:0xf\n\t" \
    "v_mul_f32_dpp %18, %24, %0 row_newbcast:0 row_mask:0xf bank_mask:0xf\n\t" \
    "v_mul_f32_dpp %17, %23, %1 row_newbcast:1 row_mask:0xf bank_mask:0xf\n\t" \
    "v_mul_f32_dpp %19, %24, %1 row_newbcast:1 row_mask:0xf bank_mask:0xf\n\t" \
    "v_fmac_f32_dpp %16, %23, %2 row_newbcast:2 row_mask:0xf bank_mask:0xf\n\t" \
    "v_fmac_f32_dpp %18, %24, %2 row_newbcast:2 row_mask:0xf bank_mask:0xf\n\t" \
    "v_fmac_f32_dpp %17, %23, %3 row_newbcast:3 row_mask:0xf bank_mask:0xf\n\t" \
    "v_fmac_f32_dpp %19, %24, %3 row_newbcast:3 row_mask:0xf bank_mask:0xf\n\t" \
    "v_fmac_f32_dpp %16, %23, %4 row_newbcast:4 row_mask:0xf bank_mask:0xf\n\t" \
    "v_fmac_f32_dpp %18, %24, %4 row_newbcast:4 row_mask:0xf bank_mask:0xf\n\t" \
    "v_fmac_f32_dpp %17, %23, %5 row_newbcast:5 row_mask:0xf bank_mask:0xf\n\t" \
    "v_fmac_f32_dpp %19, %24, %5 row_newbcast:5 row_mask:0xf bank_mask:0xf\n\t" \
    "v_fmac_f32_dpp %16, %23, %6 row_newbcast:6 row_mask:0xf bank_mask:0xf\n\t" \
    "v_fmac_f32_dpp %18, %24, %6 row_newbcast:6 row_mask:0xf bank_mask:0xf\n\t" \
    "v_fmac_f32_dpp %17, %23, %7 row_newbcast:7 row_mask:0xf bank_mask:0xf\n\t" \
    "v_fmac_f32_dpp %19, %24, %7 row_newbcast:7 row_mask:0xf bank_mask:0xf\n\t" \
    "v_fmac_f32_dpp %16, %23, %8 row_newbcast:8 row_mask:0xf bank_mask:0xf\n\t" \
    "v_fmac_f32_dpp %18, %24, %8 row_newbcast:8 row_mask:0xf bank_mask:0xf\n\t" \
    "v_fmac_f32_dpp %17, %23, %9 row_newbcast:9 row_mask:0xf bank_mask:0xf\n\t" \
    "v_fmac_f32_dpp %19, %24, %9 row_newbcast:9 row_mask:0xf bank_mask:0xf\n\t" \
    "v_fmac_f32_dpp %16, %23, %10 row_newbcast:10 row_mask:0xf bank_mask:0xf\n\t" \
    "v_fmac_f32_dpp %18, %24, %10 row_newbcast:10 row_mask:0xf bank_mask:0xf\n\t" \
    "v_fmac_f32_dpp %17, %23, %11 row_newbcast:11 row_mask:0xf bank_mask:0xf\n\t" \
    "v_fmac_f32_dpp %19, %24, %11 row_newbcast:11 row_mask:0xf bank_mask:0xf\n\t" \
    "v_fmac_f32_dpp %16, %23, %12 row_newbcast:12 row_mask:0xf bank_mask:0xf\n\t" \
    "v_fmac_f32_dpp %18, %24, %12 row_newbcast:12 row_mask:0xf bank_mask:0xf\n\t" \
    "v_fmac_f32_dpp %17, %23, %13 row_newbcast:13 row_mask:0xf bank_mask:0xf\n\t" \
    "v_fmac_f32_dpp %19, %24, %13 row_newbcast:13 row_mask:0xf bank_mask:0xf\n\t" \
    "v_fmac_f32_dpp %16, %23, %14 row_newbcast:14 row_mask:0xf bank_mask:0xf\n\t" \
    "v_fmac_f32_dpp %18, %24, %14 row_newbcast:14 row_mask:0xf bank_mask:0xf\n\t" \
    "v_fmac_f32_dpp %17, %23, %15 row_newbcast:15 row_mask:0xf bank_mask:0xf\n\t" \
    "v_fmac_f32_dpp %19, %24, %15 row_newbcast:15 row_mask:0xf bank_mask:0xf\n\t" \
    ""

__device__ __forceinline__ void phase_rwkv_scan(const Params& p, int j, char* lds) {
    const bf16_t* R = (const bf16_t*)(p.ws + OFF_R); const bf16_t* Kb = (const bf16_t*)(p.ws + OFF_K);
    const bf16_t* V = (const bf16_t*)(p.ws + OFF_VF); const bf16_t* KK = (const bf16_t*)(p.ws + OFF_H);
    const bf16_t* LW = (const bf16_t*)(p.ws + OFF_LW); const bf16_t* AD = (const bf16_t*)(p.ws + OFF_AD);
    bf16_t* Y = (bf16_t*)(p.ws + OFF_Y);
    const int tid = tidx(), lane = tid & 63, wid = tid >> 6, cl = wid >> 2, q = wid & 3;
    for (int cp = blockIdx.x; cp < 256; cp += gridDim.x) {
        const int chain = cp * 2 + cl, d = chain & 1, bh = chain >> 1, b = bh >> 4, h = bh & 15;
        const int col = h * 64 + lane, vcol = h * 64 + q * 16 + (lane & 15);
        const float ka = p.in[22][(size_t)j * D + col];
        const bf16_t* LWd = LW + (size_t)d * NT * D; const bf16_t* ADd = AD + (size_t)d * NT * D;
        bf16_t* Yd = Y + (size_t)d * NT * D;
        float S0 = 0.f, S1 = 0.f, S2 = 0.f, S3 = 0.f, S4 = 0.f, S5 = 0.f, S6 = 0.f, S7 = 0.f, S8 = 0.f, S9 = 0.f, S10 = 0.f, S11 = 0.f, S12 = 0.f, S13 = 0.f, S14 = 0.f, S15 = 0.f;
        float sa = 0.f;
        auto row_of = [&](int s) -> int {
            if (s < TC) { const int t = d ? (TC - 1 - s) : s; return NLAT + b * TC + t; }
            const int tl = s - TC; const int t = d ? (TL - 1 - tl) : tl; return b * TL + t;
        };
        auto row_kk = [&](int s) -> int { return row_of(s < TC + TL ? s : TC + TL - 1); };
        const int colw = col & ~1, vcolw = vcol & ~1;
        const unsigned shc = (col & 1) ? 0u : 16u, shv = (vcol & 1) ? 0u : 16u;
#define LDW(P, off) (*(const unsigned*)((P) + (off)))
#define UNP(w, sh) __uint_as_float(((w) << (sh)) & 0xffff0000u)
        unsigned nr[4], nkk[4], nk[4], nlw[4], na[4], nv[4];
#pragma unroll
        for (int g = 0; g < 4; ++g) {
            const size_t o = (size_t)row_of(g) * D;
            nr[g] = LDW(R, o + colw); nk[g] = LDW(Kb, o + colw); nlw[g] = LDW(LWd, o + colw); na[g] = LDW(ADd, o + colw); nv[g] = LDW(V, o + vcolw);
            nkk[g] = LDW(KK, (size_t)row_kk(g + 1) * D + colw);
        }
        float kk_cur = bf2f(KK[(size_t)row_of(0) * D + col]);
        constexpr int NSTEP = TC + TL;
        for (int s0 = 0; s0 < NSTEP; s0 += 4) {
            unsigned cr[4], ckk[4], ck[4], clw[4], ca[4], cv[4];
#pragma unroll
            for (int g = 0; g < 4; ++g) { cr[g] = nr[g]; ckk[g] = nkk[g]; ck[g] = nk[g]; clw[g] = nlw[g]; ca[g] = na[g]; cv[g] = nv[g]; }
            if (s0 + 4 < NSTEP) {
#pragma unroll
                for (int g = 0; g < 4; ++g) {
                    const size_t o = (size_t)row_of(s0 + 4 + g) * D;
                    nr[g] = LDW(R, o + colw); nk[g] = LDW(Kb, o + colw); nlw[g] = LDW(LWd, o + colw); na[g] = LDW(ADd, o + colw); nv[g] = LDW(V, o + vcolw);
                    nkk[g] = LDW(KK, (size_t)row_kk(s0 + 5 + g) * D + colw);
                }
            }
#pragma unroll
            for (int g = 0; g < 4; ++g) {
                const float rr = UNP(cr[g], shc), kkc = kk_cur, kkn = UNP(ckk[g], shc), kv = UNP(ck[g], shc), av = UNP(ca[g], shc), vv = UNP(cv[g], shv);
                kk_cur = kkn;
                const float dec = __expf(UNP(clw[g], shc)), bb = kkc * av, kd = kv * (1.f + (av - 1.f) * ka);
                float py0, py1, ps0, ps1;
                asm volatile(SCAN_STEP_ASM
                    : "+v"(S0), "+v"(S1), "+v"(S2), "+v"(S3), "+v"(S4), "+v"(S5), "+v"(S6), "+v"(S7), "+v"(S8), "+v"(S9), "+v"(S10), "+v"(S11), "+v"(S12), "+v"(S13), "+v"(S14), "+v"(S15),
                      "=&v"(py0), "=&v"(py1), "=&v"(ps0), "=&v"(ps1)
                    : "v"(dec), "v"(bb), "v"(kd), "v"(rr), "v"(kkn), "v"(sa), "v"(vv));
                sa = -red4(ps0 + ps1);
                const float yv = red4(py0 + py1);
                if (lane < 16) Yd[(size_t)row_of(s0 + g) * D + vcol] = f2bf(yv);
            }
        }
#undef LDW
#undef UNP
    }
}

#define TRI_ASM1 \
    "s_nop 1\n\t" \
    "v_xor_b32 %0, 0x80000000, %0\n\t" \
    "v_fmac_f32_dpp %1, %8, %0 row_newbcast:1 row_mask:0xf bank_mask:0xf\n\t" \
    "v_xor_b32 %1, 0x80000000, %1\n\t" \
    "v_fmac_f32_dpp %2, %8, %0 row_newbcast:2 row_mask:0xf bank_mask:0xf\n\t" \
    "v_fmac_f32_dpp %2, %9, %1 row_newbcast:2 row_mask:0xf bank_mask:0xf\n\t" \
    "v_xor_b32 %2, 0x80000000, %2\n\t" \
    "v_fmac_f32_dpp %3, %8, %0 row_newbcast:3 row_mask:0xf bank_mask:0xf\n\t" \
    "v_fmac_f32_dpp %3, %9, %1 row_newbcast:3 row_mask:0xf bank_mask:0xf\n\t" \
    "v_fmac_f32_dpp %3, %10, %2 row_newbcast:3 row_mask:0xf bank_mask:0xf\n\t" \
    "v_xor_b32 %3, 0x80000000, %3\n\t" \
    "v_fmac_f32_dpp %4, %8, %0 row_newbcast:4 row_mask:0xf bank_mask:0xf\n\t" \
    "v_fmac_f32_dpp %4, %9, %1 row_newbcast:4 row_mask:0xf bank_mask:0xf\n\t" \
    "v_fmac_f32_dpp %4, %10, %2 row_newbcast:4 row_mask:0xf bank_mask:0xf\n\t" \
    "v_fmac_f32_dpp %4, %11, %3 row_newbcast:4 row_mask:0xf bank_mask:0xf\n\t" \
    "v_xor_b32 %4, 0x80000000, %4\n\t" \
    "v_fmac_f32_dpp %5, %8, %0 row_newbcast:5 row_mask:0xf bank_mask:0xf\n\t" \
    "v_fmac_f32_dpp %5, %9, %1 row_newbcast:5 row_mask:0xf bank_mask:0xf\n\t" \
    "v_fmac_f32_dpp %5, %10, %2 row_newbcast:5 row_mask:0xf bank_mask:0xf\n\t" \
    "v_fmac_f32_dpp %5, %11, %3 row_newbcast:5 row_mask:0xf bank_mask:0xf\n\t" \
    "v_fmac_f32_dpp %5, %12, %4 row_newbcast:5 row_mask:0xf bank_mask:0xf\n\t" \
    "v_xor_b32 %5, 0x80000000, %5\n\t" \
    "v_fmac_f32_dpp %6, %8, %0 row_newbcast:6 row_mask:0xf bank_mask:0xf\n\t" \
    "v_fmac_f32_dpp %6, %9, %1 row_newbcast:6 row_mask:0xf bank_mask:0xf\n\t" \
    "v_fmac_f32_dpp %6, %10, %2 row_newbcast:6 row_mask:0xf bank_mask:0xf\n\t" \
    "v_fmac_f32_dpp %6, %11, %3 row_newbcast:6 row_mask:0xf bank_mask:0xf\n\t" \
    "v_fmac_f32_dpp %6, %12, %4 row_newbcast:6 row_mask:0xf bank_mask:0xf\n\t" \
    "v_fmac_f32_dpp %6, %13, %5 row_newbcast:6 row_mask:0xf bank_mask:0xf\n\t" \
    "v_xor_b32 %6, 0x80000000, %6\n\t" \
    "v_fmac_f32_dpp %7, %8, %0 row_newbcast:7 row_mask:0xf bank_mask:0xf\n\t" \
    "v_fmac_f32_dpp %7, %9, %1 row_newbcast:7 row_mask:0xf bank_mask:0xf\n\t" \
    "v_fmac_f32_dpp %7, %10, %2 row_newbcast:7 row_mask:0xf bank_mask:0xf\n\t" \
    "v_fmac_f32_dpp %7, %11, %3 row_newbcast:7 row_mask:0xf bank_mask:0xf\n\t" \
    "v_fmac_f32_dpp %7, %12, %4 row_newbcast:7 row_mask:0xf bank_mask:0xf\n\t" \
    "v_fmac_f32_dpp %7, %13, %5 row_newbcast:7 row_mask:0xf bank_mask:0xf\n\t" \
    "v_fmac_f32_dpp %7, %14, %6 row_newbcast:7 row_mask:0xf bank_mask:0xf\n\t" \
    "v_xor_b32 %7, 0x80000000, %7\n\t" \
    ""
#define TRI_ASM2 \
    "s_nop 1\n\t" \
    "v_fmac_f32_dpp %0, %16, %8 row_newbcast:8 row_mask:0xf bank_mask:0xf\n\t" \
    "v_fmac_f32_dpp %0, %17, %9 row_newbcast:8 row_mask:0xf bank_mask:0xf\n\t" \
    "v_fmac_f32_dpp %0, %18, %10 row_newbcast:8 row_mask:0xf bank_mask:0xf\n\t" \
    "v_fmac_f32_dpp %0, %19, %11 row_newbcast:8 row_mask:0xf bank_mask:0xf\n\t" \
    "v_fmac_f32_dpp %0, %20, %12 row_newbcast:8 row_mask:0xf bank_mask:0xf\n\t" \
    "v_fmac_f32_dpp %0, %21, %13 row_newbcast:8 row_mask:0xf bank_mask:0xf\n\t" \
    "v_fmac_f32_dpp %0, %22, %14 row_newbcast:8 row_mask:0xf bank_mask:0xf\n\t" \
    "v_fmac_f32_dpp %0, %23, %15 row_newbcast:8 row_mask:0xf bank_mask:0xf\n\t" \
    "v_fmac_f32_dpp %1, %16, %8 row_newbcast:9 row_mask:0xf bank_mask:0xf\n\t" \
    "v_fmac_f32_dpp %1, %17, %9 row_newbcast:9 row_mask:0xf bank_mask:0xf\n\t" \
    "v_fmac_f32_dpp %1, %18, %10 row_newbcast:9 row_mask:0xf bank_mask:0xf\n\t" \
    "v_fmac_f32_dpp %1, %19, %11 row_newbcast:9 row_mask:0xf bank_mask:0xf\n\t" \
    "v_fmac_f32_dpp %1, %20, %12 row_newbcast:9 row_mask:0xf bank_mask:0xf\n\t" \
    "v_fmac_f32_dpp %1, %21, %13 row_newbcast:9 row_mask:0xf bank_mask:0xf\n\t" \
    "v_fmac_f32_dpp %1, %22, %14 row_newbcast:9 row_mask:0xf bank_mask:0xf\n\t" \
    "v_fmac_f32_dpp %1, %23, %15 row_newbcast:9 row_mask:0xf bank_mask:0xf\n\t" \
    "v_fmac_f32_dpp %2, %16, %8 row_newbcast:10 row_mask:0xf bank_mask:0xf\n\t" \
    "v_fmac_f32_dpp %2, %17, %9 row_newbcast:10 row_mask:0xf bank_mask:0xf\n\t" \
    "v_fmac_f32_dpp %2, %18, %10 row_newbcast:10 row_mask:0xf bank_mask:0xf\n\t" \
    "v_fmac_f32_dpp %2, %19, %11 row_newbcast:10 row_mask:0xf bank_mask:0xf\n\t" \
    "v_fmac_f32_dpp %2, %20, %12 row_newbcast:10 row_mask:0xf bank_mask:0xf\n\t" \
    "v_fmac_f32_dpp %2, %21, %13 row_newbcast:10 row_mask:0xf bank_mask:0xf\n\t" \
    "v_fmac_f32_dpp %2, %22, %14 row_newbcast:10 row_mask:0xf bank_mask:0xf\n\t" \
    "v_fmac_f32_dpp %2, %23, %15 row_newbcast:10 row_mask:0xf bank_mask:0xf\n\t" \
    "v_fmac_f32_dpp %3, %16, %8 row_newbcast:11 row_mask:0xf bank_mask:0xf\n\t" \
    "v_fmac_f32_dpp %3, %17, %9 row_newbcast:11 row_mask:0xf bank_mask:0xf\n\t" \
    "v_fmac_f32_dpp %3, %18, %10 row_newbcast:11 row_mask:0xf bank_mask:0xf\n\t" \
    "v_fmac_f32_dpp %3, %19, %11 row_newbcast:11 row_mask:0xf bank_mask:0xf\n\t" \
    "v_fmac_f32_dpp %3, %20, %12 row_newbcast:11 row_mask:0xf bank_mask:0xf\n\t" \
    "v_fmac_f32_dpp %3, %21, %13 row_newbcast:11 row_mask:0xf bank_mask:0xf\n\t" \
    "v_fmac_f32_dpp %3, %22, %14 row_newbcast:11 row_mask:0xf bank_mask:0xf\n\t" \
    "v_fmac_f32_dpp %3, %23, %15 row_newbcast:11 row_mask:0xf bank_mask:0xf\n\t" \
    "v_fmac_f32_dpp %4, %16, %8 row_newbcast:12 row_mask:0xf bank_mask:0xf\n\t" \
    "v_fmac_f32_dpp %4, %17, %9 row_newbcast:12 row_mask:0xf bank_mask:0xf\n\t" \
    "v_fmac_f32_dpp %4, %18, %10 row_newbcast:12 row_mask:0xf bank_mask:0xf\n\t" \
    "v_fmac_f32_dpp %4, %19, %11 row_newbcast:12 row_mask:0xf bank_mask:0xf\n\t" \
    "v_fmac_f32_dpp %4, %20, %12 row_newbcast:12 row_mask:0xf bank_mask:0xf\n\t" \
    "v_fmac_f32_dpp %4, %21, %13 row_newbcast:12 row_mask:0xf bank_mask:0xf\n\t" \
    "v_fmac_f32_dpp %4, %22, %14 row_newbcast:12 row_mask:0xf bank_mask:0xf\n\t" \
    "v_fmac_f32_dpp %4, %23, %15 row_newbcast:12 row_mask:0xf bank_mask:0xf\n\t" \
    "v_fmac_f32_dpp %5, %16, %8 row_newbcast:13 row_mask:0xf bank_mask:0xf\n\t" \
    "v_fmac_f32_dpp %5, %17, %9 row_newbcast:13 row_mask:0xf bank_mask:0xf\n\t" \
    "v_fmac_f32_dpp %5, %18, %10 row_newbcast:13 row_mask:0xf bank_mask:0xf\n\t" \
    "v_fmac_f32_dpp %5, %19, %11 row_newbcast:13 row_mask:0xf bank_mask:0xf\n\t" \
    "v_fmac_f32_dpp %5, %20, %12 row_newbcast:13 row_mask:0xf bank_mask:0xf\n\t" \
    "v_fmac_f32_dpp %5, %21, %13 row_newbcast:13 row_mask:0xf bank_mask:0xf\n\t" \
    "v_fmac_f32_dpp %5, %22, %14 row_newbcast:13 row_mask:0xf bank_mask:0xf\n\t" \
    "v_fmac_f32_dpp %5, %23, %15 row_newbcast:13 row_mask:0xf bank_mask:0xf\n\t" \
    "v_fmac_f32_dpp %6, %16, %8 row_newbcast:14 row_mask:0xf bank_mask:0xf\n\t" \
    "v_fmac_f32_dpp %6, %17, %9 row_newbcast:14 row_mask:0xf bank_mask:0xf\n\t" \
    "v_fmac_f32_dpp %6, %18, %10 row_newbcast:14 row_mask:0xf bank_mask:0xf\n\t" \
    "v_fmac_f32_dpp %6, %19, %11 row_newbcast:14 row_mask:0xf bank_mask:0xf\n\t" \
    "v_fmac_f32_dpp %6, %20, %12 row_newbcast:14 row_mask:0xf bank_mask:0xf\n\t" \
    "v_fmac_f32_dpp %6, %21, %13 row_newbcast:14 row_mask:0xf bank_mask:0xf\n\t" \
    "v_fmac_f32_dpp %6, %22, %14 row_newbcast:14 row_mask:0xf bank_mask:0xf\n\t" \
    "v_fmac_f32_dpp %6, %23, %15 row_newbcast:14 row_mask:0xf bank_mask:0xf\n\t" \
    "v_fmac_f32_dpp %7, %16, %8 row_newbcast:15 row_mask:0xf bank_mask:0xf\n\t" \
    "v_fmac_f32_dpp %7, %17, %9 row_newbcast:15 row_mask:0xf bank_mask:0xf\n\t" \
    "v_fmac_f32_dpp %7, %18, %10 row_newbcast:15 row_mask:0xf bank_mask:0xf\n\t" \
    "v_fmac_f32_dpp %7, %19, %11 row_newbcast:15 row_mask:0xf bank_mask:0xf\n\t" \
    "v_fmac_f32_dpp %7, %20, %12 row_newbcast:15 row_mask:0xf bank_mask:0xf\n\t" \
    "v_fmac_f32_dpp %7, %21, %13 row_newbcast:15 row_mask:0xf bank_mask:0xf\n\t" \
    "v_fmac_f32_dpp %7, %22, %14 row_newbcast:15 row_mask:0xf bank_mask:0xf\n\t" \
    "v_fmac_f32_dpp %7, %23, %15 row_newbcast:15 row_mask:0xf bank_mask:0xf\n\t" \
    ""
#define TRI_ASM3 \
    "s_nop 1\n\t" \
    "v_xor_b32 %0, 0x80000000, %0\n\t" \
    "v_fmac_f32_dpp %1, %8, %0 row_newbcast:9 row_mask:0xf bank_mask:0xf\n\t" \
    "v_xor_b32 %1, 0x80000000, %1\n\t" \
    "v_fmac_f32_dpp %2, %8, %0 row_newbcast:10 row_mask:0xf bank_mask:0xf\n\t" \
    "v_fmac_f32_dpp %2, %9, %1 row_newbcast:10 row_mask:0xf bank_mask:0xf\n\t" \
    "v_xor_b32 %2, 0x80000000, %2\n\t" \
    "v_fmac_f32_dpp %3, %8, %0 row_newbcast:11 row_mask:0xf bank_mask:0xf\n\t" \
    "v_fmac_f32_dpp %3, %9, %1 row_newbcast:11 row_mask:0xf bank_mask:0xf\n\t" \
    "v_fmac_f32_dpp %3, %10, %2 row_newbcast:11 row_mask:0xf bank_mask:0xf\n\t" \
    "v_xor_b32 %3, 0x80000000, %3\n\t" \
    "v_fmac_f32_dpp %4, %8, %0 row_newbcast:12 row_mask:0xf bank_mask:0xf\n\t" \
    "v_fmac_f32_dpp %4, %9, %1 row_newbcast:12 row_mask:0xf bank_mask:0xf\n\t" \
    "v_fmac_f32_dpp %4, %10, %2 row_newbcast:12 row_mask:0xf bank_mask:0xf\n\t" \
    "v_fmac_f32_dpp %4, %11, %3 row_newbcast:12 row_mask:0xf bank_mask:0xf\n\t" \
    "v_xor_b32 %4, 0x80000000, %4\n\t" \
    "v_fmac_f32_dpp %5, %8, %0 row_newbcast:13 row_mask:0xf bank_mask:0xf\n\t" \
    "v_fmac_f32_dpp %5, %9, %1 row_newbcast:13 row_mask:0xf bank_mask:0xf\n\t" \
    "v_fmac_f32_dpp %5, %10, %2 row_newbcast:13 row_mask:0xf bank_mask:0xf\n\t" \
    "v_fmac_f32_dpp %5, %11, %3 row_newbcast:13 row_mask:0xf bank_mask:0xf\n\t" \
    "v_fmac_f32_dpp %5, %12, %4 row_newbcast:13 row_mask:0xf bank_mask:0xf\n\t" \
    "v_xor_b32 %5, 0x80000000, %5\n\t" \
    "v_fmac_f32_dpp %6, %8, %0 row_newbcast:14 row_mask:0xf bank_mask:0xf\n\t" \
    "v_fmac_f32_dpp %6, %9, %1 row_newbcast:14 row_mask:0xf bank_mask:0xf\n\t" \
    "v_fmac_f32_dpp %6, %10, %2 row_newbcast:14 row_mask:0xf bank_mask:0xf\n\t" \
    "v_fmac_f32_dpp %6, %11, %3 row_newbcast:14 row_mask:0xf bank_mask:0xf\n\t" \
    "v_fmac_f32_dpp %6, %12, %4 row_newbcast:14 row_mask:0xf bank_mask:0xf\n\t" \
    "v_fmac_f32_dpp %6, %13, %5 row_newbcast:14 row_mask:0xf bank_mask:0xf\n\t" \
    "v_xor_b32 %6, 0x80000000, %6\n\t" \
    "v_fmac_f32_dpp %7, %8, %0 row_newbcast:15 row_mask:0xf bank_mask:0xf\n\t" \
    "v_fmac_f32_dpp %7, %9, %1 row_newbcast:15 row_mask:0xf bank_mask:0xf\n\t" \
    "v_fmac_f32_dpp %7, %10, %2 row_newbcast:15 row_mask:0xf bank_mask:0xf\n\t" \
    "v_fmac_f32_dpp %7, %11, %3 row_newbcast:15 row_mask:0xf bank_mask:0xf\n\t" \
    "v_fmac_f32_dpp %7, %12, %4 row_newbcast:15 row_mask:0xf bank_mask:0xf\n\t" \
    "v_fmac_f32_dpp %7, %13, %5 row_newbcast:15 row_mask:0xf bank_mask:0xf\n\t" \
    "v_fmac_f32_dpp %7, %14, %6 row_newbcast:15 row_mask:0xf bank_mask:0xf\n\t" \
    "v_xor_b32 %7, 0x80000000, %7\n\t" \
    ""

constexpr int SC_KKT = 0, SC_RRT = 2048, SC_BHT = 4096, SC_KHT = 6144, SC_BHJ = 8192, SC_KHJ = 10240, SC_MBF = 12288, SC_RHF = 13312, SC_WLF = 14336, SC_STRIDE = 15360;
__device__ __forceinline__ bf16x8 mk8(unsigned a, unsigned b, unsigned c, unsigned d) { const u32x4 w = {a, b, c, d}; return __builtin_bit_cast(bf16x8, w); }
typedef short bf16x4 __attribute__((ext_vector_type(4)));
__device__ __forceinline__ bf16x4 mk4(unsigned a, unsigned b) { const u32x2 w = {a, b}; return __builtin_bit_cast(bf16x4, w); }
__device__ __forceinline__ void phase_rwkv_scan2(const Params& p, int j, char* lds_, bf16_t* Y, int dsel  ) {
    const bf16_t* R = (const bf16_t*)(p.ws + OFF_R); const bf16_t* Kb = (const bf16_t*)(p.ws + OFF_K);
    const bf16_t* V = (const bf16_t*)(p.ws + OFF_VF); const bf16_t* KK = (const bf16_t*)(p.ws + OFF_H);
    const bf16_t* LW = (const bf16_t*)(p.ws + OFF_LW); const bf16_t* AD = (const bf16_t*)(p.ws + OFF_AD);
    const int tid = tidx(), lane = tid & 63, wid = __builtin_amdgcn_readfirstlane(tid >> 6), cl = wid >> 2, q = wid & 3, g = lane >> 4, li = lane & 15;
    LAS unsigned char* wl = (LAS unsigned char*)lds_ + wid * SC_STRIDE;
    for (int cp = blockIdx.x; cp < 256; cp += gridDim.x) {
        const int chain = cp * 2 + cl, d = chain & 1, bh = chain >> 1, b = bh >> 4, h = bh & 15;
        if (dsel >= 0 && d != dsel) continue;
        const int col = h * 64 + lane;
        const int vcol = h * 64 + q * 16 + li;
        const float ka = p.in[22][(size_t)j * D + col];
        const bf16_t* LWd = LW + (size_t)d * NT * D; const bf16_t* ADd = AD + (size_t)d * NT * D;
        bf16_t* Yd = Y + (size_t)d * NT * D;
        const int dir = d ? -1 : 1;
        f32x4 T[4];
#pragma unroll
        for (int jb = 0; jb < 4; ++jb) T[jb] = (f32x4){0.f, 0.f, 0.f, 0.f};
        for (int c = 0; c < (TC + TL) / 16; ++c) {
            const int s0 = c * 16;
            int row0;
            if (s0 < TC) row0 = NLAT + b * TC + (d ? (TC - 1 - s0) : s0);
            else { const int tl = s0 - TC; row0 = b * TL + (d ? (TL - 1 - tl) : tl); }
            {
                float cw = 0.f, ep_prev = 1.f;
                unsigned bhp[8], khp[8];
                float bh_e = 0.f, kh_e = 0.f;
#pragma unroll
                for (int t = 0; t < 16; ++t) {
                    const size_t o = (size_t)(row0 + t * dir) * D + col;
                    const float rv = bf2f(R[o]), kkv = bf2f(KK[o]), kv = bf2f(Kb[o]), lwv = bf2f(LWd[o]), av = bf2f(ADd[o]);
                    cw += lwv;
                    const float ep = __expf(cw), em = __expf(-cw);
                    const float kkt = kkv * ep_prev, rt = rv * ep, bhv = kkv * av * em, khv = kv * (1.f + (av - 1.f) * ka) * em;
                    ep_prev = ep;
                    *(LAS bf16_t*)(wl + SC_KKT + t * 128 + lane * 2) = (bf16_t)(pack2(kkt, 0.f) & 0xffffu);
                    *(LAS bf16_t*)(wl + SC_RRT + t * 128 + lane * 2) = (bf16_t)(pack2(rt, 0.f) & 0xffffu);
                    *(LAS bf16_t*)(wl + SC_BHT + t * 128 + lane * 2) = (bf16_t)(pack2(bhv, 0.f) & 0xffffu);
                    *(LAS bf16_t*)(wl + SC_KHT + t * 128 + lane * 2) = (bf16_t)(pack2(khv, 0.f) & 0xffffu);
                    if (t & 1) { bhp[t >> 1] = pack2(bh_e, bhv); khp[t >> 1] = pack2(kh_e, khv); } else { bh_e = bhv; kh_e = khv; }
                }
                *(LAS u32x4*)(wl + SC_BHJ + lane * 32) = (u32x4){bhp[0], bhp[1], bhp[2], bhp[3]};
                *(LAS u32x4*)(wl + SC_BHJ + lane * 32 + 16) = (u32x4){bhp[4], bhp[5], bhp[6], bhp[7]};
                *(LAS u32x4*)(wl + SC_KHJ + lane * 32) = (u32x4){khp[0], khp[1], khp[2], khp[3]};
                *(LAS u32x4*)(wl + SC_KHJ + lane * 32 + 16) = (u32x4){khp[4], khp[5], khp[6], khp[7]};
                *(LAS float*)(wl + SC_WLF + lane * 4) = ep_prev;
            }
            unsigned vw0, vw1;
            {
                const size_t o = (size_t)(row0 + (4 * g) * dir) * D + vcol; const long st = (long)dir * D;
                const unsigned v0 = V[o], v1 = V[o + st], v2 = V[o + 2 * st], v3 = V[o + 3 * st];
                vw0 = v0 | (v1 << 16); vw1 = v2 | (v3 << 16);
            }
            asm volatile("" ::: "memory");
            f32x4 Mb = {0.f, 0.f, 0.f, 0.f}, Mk = Mb, Nb = Mb, Nk = Mb;
#pragma unroll
            for (int kk = 0; kk < 2; ++kk) {
                const int ko = li * 128 + (32 * kk + 8 * g) * 2;
                const bf16x8 aB = *(const LAS bf16x8*)(wl + SC_BHT + ko), aK = *(const LAS bf16x8*)(wl + SC_KHT + ko);
                const bf16x8 bK = *(const LAS bf16x8*)(wl + SC_KKT + ko), bR = *(const LAS bf16x8*)(wl + SC_RRT + ko);
                Mb = __builtin_amdgcn_mfma_f32_16x16x32_bf16(aB, bK, Mb, 0, 0, 0);
                Mk = __builtin_amdgcn_mfma_f32_16x16x32_bf16(aK, bK, Mk, 0, 0, 0);
                Nb = __builtin_amdgcn_mfma_f32_16x16x32_bf16(aB, bR, Nb, 0, 0, 0);
                Nk = __builtin_amdgcn_mfma_f32_16x16x32_bf16(aK, bR, Nk, 0, 0, 0);
            }
#pragma unroll
            for (int r = 0; r < 4; ++r) {
                const int s = 4 * g + r;
                Mb[r] = s < li ? Mb[r] : 0.f; Mk[r] = s < li ? Mk[r] : 0.f;
                Nb[r] = s <= li ? Nb[r] : 0.f; Nk[r] = s <= li ? Nk[r] : 0.f;
            }
            f32x4 PT = {0.f, 0.f, 0.f, 0.f}, QT = PT;
#pragma unroll
            for (int kk = 0; kk < 2; ++kk) {
                const bf16x8 bw = mk8(pack2(T[2 * kk][0], T[2 * kk][1]), pack2(T[2 * kk][2], T[2 * kk][3]), pack2(T[2 * kk + 1][0], T[2 * kk + 1][1]), pack2(T[2 * kk + 1][2], T[2 * kk + 1][3]));
                const int ko = li * 128 + (32 * kk + 4 * g) * 2;
                const u32x2 k0 = *(const LAS u32x2*)(wl + SC_KKT + ko), k1 = *(const LAS u32x2*)(wl + SC_KKT + ko + 32);
                const u32x2 r0 = *(const LAS u32x2*)(wl + SC_RRT + ko), r1 = *(const LAS u32x2*)(wl + SC_RRT + ko + 32);
                PT = __builtin_amdgcn_mfma_f32_16x16x32_bf16(mk8(k0[0], k0[1], k1[0], k1[1]), bw, PT, 0, 0, 0);
                QT = __builtin_amdgcn_mfma_f32_16x16x32_bf16(mk8(r0[0], r0[1], r1[0], r1[1]), bw, QT, 0, 0, 0);
            }
            const f32x4 RT = __builtin_amdgcn_mfma_f32_16x16x32_bf16(mk8(pack2(Mk[0], Mk[1]), pack2(Mk[2], Mk[3]), 0u, 0u), mk8(vw0, vw1, 0u, 0u), PT, 0, 0, 0);
            *(LAS f32x4*)(wl + SC_RHF + li * 64 + g * 16) = RT;
#pragma unroll
            for (int r = 0; r < 4; ++r) *(LAS float*)(wl + SC_MBF + (4 * g + r) * 64 + li * 4) = Mb[r];
            asm volatile("" ::: "memory");
            float x0, x1, x2, x3, x4, x5, x6, x7, x8, x9, x10, x11, x12, x13, x14, x15;
            { const f32x4 u = *(const LAS f32x4*)(wl + SC_RHF + li * 64); x0 = u[0]; x1 = u[1]; x2 = u[2]; x3 = u[3]; }
            { const f32x4 u = *(const LAS f32x4*)(wl + SC_RHF + li * 64 + 16); x4 = u[0]; x5 = u[1]; x6 = u[2]; x7 = u[3]; }
            { const f32x4 u = *(const LAS f32x4*)(wl + SC_RHF + li * 64 + 32); x8 = u[0]; x9 = u[1]; x10 = u[2]; x11 = u[3]; }
            { const f32x4 u = *(const LAS f32x4*)(wl + SC_RHF + li * 64 + 48); x12 = u[0]; x13 = u[1]; x14 = u[2]; x15 = u[3]; }
            float m0, m1, m2, m3, m4, m5, m6, m7, m8, m9, m10, m11, m12, m13, m14;
#define LDM(s) (*(const LAS float*)(wl + SC_MBF + (s) * 64 + li * 4))
            m0 = LDM(0); m1 = LDM(1); m2 = LDM(2); m3 = LDM(3); m4 = LDM(4); m5 = LDM(5); m6 = LDM(6); m7 = LDM(7);
            m8 = LDM(8); m9 = LDM(9); m10 = LDM(10); m11 = LDM(11); m12 = LDM(12); m13 = LDM(13); m14 = LDM(14);
#undef LDM
            asm volatile(TRI_ASM1 : "+v"(x0), "+v"(x1), "+v"(x2), "+v"(x3), "+v"(x4), "+v"(x5), "+v"(x6), "+v"(x7)
                                  : "v"(m0), "v"(m1), "v"(m2), "v"(m3), "v"(m4), "v"(m5), "v"(m6));
            asm volatile(TRI_ASM2 : "+v"(x8), "+v"(x9), "+v"(x10), "+v"(x11), "+v"(x12), "+v"(x13), "+v"(x14), "+v"(x15)
                                  : "v"(x0), "v"(x1), "v"(x2), "v"(x3), "v"(x4), "v"(x5), "v"(x6), "v"(x7), "v"(m0), "v"(m1), "v"(m2), "v"(m3), "v"(m4), "v"(m5), "v"(m6), "v"(m7));
            asm volatile(TRI_ASM3 : "+v"(x8), "+v"(x9), "+v"(x10), "+v"(x11), "+v"(x12), "+v"(x13), "+v"(x14), "+v"(x15)
                                  : "v"(m8), "v"(m9), "v"(m10), "v"(m11), "v"(m12), "v"(m13), "v"(m14));
            const float xs0 = g == 0 ? x0 : (g == 1 ? x4 : (g == 2 ? x8 : x12));
            const float xs1 = g == 0 ? x1 : (g == 1 ? x5 : (g == 2 ? x9 : x13));
            const float xs2 = g == 0 ? x2 : (g == 1 ? x6 : (g == 2 ? x10 : x14));
            const float xs3 = g == 0 ? x3 : (g == 1 ? x7 : (g == 2 ? x11 : x15));
            const bf16x8 bop = mk8(pack2(xs0, xs1), pack2(xs2, xs3), vw0, vw1);
            const f32x4 YT = __builtin_amdgcn_mfma_f32_16x16x32_bf16(mk8(pack2(Nb[0], Nb[1]), pack2(Nb[2], Nb[3]), pack2(Nk[0], Nk[1]), pack2(Nk[2], Nk[3])), bop, QT, 0, 0, 0);
#pragma unroll
            for (int r = 0; r < 4; ++r) Yd[(size_t)(row0 + (4 * g + r) * dir) * D + vcol] = (bf16_t)(pack2(YT[r], 0.f) & 0xffffu);
#pragma unroll
            for (int jb = 0; jb < 4; ++jb) {
                const u32x2 b2 = *(const LAS u32x2*)(wl + SC_BHJ + (16 * jb + li) * 32 + g * 8), k2 = *(const LAS u32x2*)(wl + SC_KHJ + (16 * jb + li) * 32 + g * 8);
                T[jb] = __builtin_amdgcn_mfma_f32_16x16x32_bf16(mk8(b2[0], b2[1], k2[0], k2[1]), bop, T[jb], 0, 0, 0);
                const f32x4 wv = *(const LAS f32x4*)(wl + SC_WLF + (16 * jb + 4 * g) * 4);
                T[jb] = T[jb] * wv;
            }
            asm volatile("" ::: "memory");
        }
    }
}

#define TRI2_ASMA \
    "s_nop 1\n\t" \
    "v_xor_b32 %0, 0x80000000, %0\n\t" \
    "v_fmac_f32_dpp %1, %16, %0 row_newbcast:1 row_mask:0xf bank_mask:0xf\n\t" \
    "v_fmac_f32_dpp %2, %16, %0 row_newbcast:2 row_mask:0xf bank_mask:0xf\n\t" \
    "v_fmac_f32_dpp %3, %16, %0 row_newbcast:3 row_mask:0xf bank_mask:0xf\n\t" \
    "v_fmac_f32_dpp %4, %16, %0 row_newbcast:4 row_mask:0xf bank_mask:0xf\n\t" \
    "v_fmac_f32_dpp %5, %16, %0 row_newbcast:5 row_mask:0xf bank_mask:0xf\n\t" \
    "v_fmac_f32_dpp %6, %16, %0 row_newbcast:6 row_mask:0xf bank_mask:0xf\n\t" \
    "v_fmac_f32_dpp %7, %16, %0 row_newbcast:7 row_mask:0xf bank_mask:0xf\n\t" \
    "v_fmac_f32_dpp %8, %16, %0 row_newbcast:8 row_mask:0xf bank_mask:0xf\n\t" \
    "v_fmac_f32_dpp %9, %16, %0 row_newbcast:9 row_mask:0xf bank_mask:0xf\n\t" \
    "v_fmac_f32_dpp %10, %16, %0 row_newbcast:10 row_mask:0xf bank_mask:0xf\n\t" \
    "v_fmac_f32_dpp %11, %16, %0 row_newbcast:11 row_mask:0xf bank_mask:0xf\n\t" \
    "v_fmac_f32_dpp %12, %16, %0 row_newbcast:12 row_mask:0xf bank_mask:0xf\n\t" \
    "v_fmac_f32_dpp %13, %16, %0 row_newbcast:13 row_mask:0xf bank_mask:0xf\n\t" \
    "v_fmac_f32_dpp %14, %16, %0 row_newbcast:14 row_mask:0xf bank_mask:0xf\n\t" \
    "v_fmac_f32_dpp %15, %16, %0 row_newbcast:15 row_mask:0xf bank_mask:0xf\n\t" \
    "v_xor_b32 %1, 0x80000000, %1\n\t" \
    "v_fmac_f32_dpp %2, %17, %1 row_newbcast:2 row_mask:0xf bank_mask:0xf\n\t" \
    "v_fmac_f32_dpp %3, %17, %1 row_newbcast:3 row_mask:0xf bank_mask:0xf\n\t" \
    "v_fmac_f32_dpp %4, %17, %1 row_newbcast:4 row_mask:0xf bank_mask:0xf\n\t" \
    "v_fmac_f32_dpp %5, %17, %1 row_newbcast:5 row_mask:0xf bank_mask:0xf\n\t" \
    "v_fmac_f32_dpp %6, %17, %1 row_newbcast:6 row_mask:0xf bank_mask:0xf\n\t" \
    "v_fmac_f32_dpp %7, %17, %1 row_newbcast:7 row_mask:0xf bank_mask:0xf\n\t" \
    "v_fmac_f32_dpp %8, %17, %1 row_newbcast:8 row_mask:0xf bank_mask:0xf\n\t" \
    "v_fmac_f32_dpp %9, %17, %1 row_newbcast:9 row_mask:0xf bank_mask:0xf\n\t" \
    "v_fmac_f32_dpp %10, %17, %1 row_newbcast:10 row_mask:0xf bank_mask:0xf\n\t" \
    "v_fmac_f32_dpp %11, %17, %1 row_newbcast:11 row_mask:0xf bank_mask:0xf\n\t" \
    "v_fmac_f32_dpp %12, %17, %1 row_newbcast:12 row_mask:0xf bank_mask:0xf\n\t" \
    "v_fmac_f32_dpp %13, %17, %1 row_newbcast:13 row_mask:0xf bank_mask:0xf\n\t" \
    "v_fmac_f32_dpp %14, %17, %1 row_newbcast:14 row_mask:0xf bank_mask:0xf\n\t" \
    "v_fmac_f32_dpp %15, %17, %1 row_newbcast:15 row_mask:0xf bank_mask:0xf\n\t" \
    "v_xor_b32 %2, 0x80000000, %2\n\t" \
    "v_fmac_f32_dpp %3, %18, %2 row_newbcast:3 row_mask:0xf bank_mask:0xf\n\t" \
    "v_fmac_f32_dpp %4, %18, %2 row_newbcast:4 row_mask:0xf bank_mask:0xf\n\t" \
    "v_fmac_f32_dpp %5, %18, %2 row_newbcast:5 row_mask:0xf bank_mask:0xf\n\t" \
    "v_fmac_f32_dpp %6, %18, %2 row_newbcast:6 row_mask:0xf bank_mask:0xf\n\t" \
    "v_fmac_f32_dpp %7, %18, %2 row_newbcast:7 row_mask:0xf bank_mask:0xf\n\t" \
    "v_fmac_f32_dpp %8, %18, %2 row_newbcast:8 row_mask:0xf bank_mask:0xf\n\t" \
    "v_fmac_f32_dpp %9, %18, %2 row_newbcast:9 row_mask:0xf bank_mask:0xf\n\t" \
    "v_fmac_f32_dpp %10, %18, %2 row_newbcast:10 row_mask:0xf bank_mask:0xf\n\t" \
    "v_fmac_f32_dpp %11, %18, %2 row_newbcast:11 row_mask:0xf bank_mask:0xf\n\t" \
    "v_fmac_f32_dpp %12, %18, %2 row_newbcast:12 row_mask:0xf bank_mask:0xf\n\t" \
    "v_fmac_f32_dpp %13, %18, %2 row_newbcast:13 row_mask:0xf bank_mask:0xf\n\t" \
    "v_fmac_f32_dpp %14, %18, %2 row_newbcast:14 row_mask:0xf bank_mask:0xf\n\t" \
    "v_fmac_f32_dpp %15, %18, %2 row_newbcast:15 row_mask:0xf bank_mask:0xf\n\t" \
    "v_xor_b32 %3, 0x80000000, %3\n\t" \
    "v_fmac_f32_dpp %4, %19, %3 row_newbcast:4 row_mask:0xf bank_mask:0xf\n\t" \
    "v_fmac_f32_dpp %5, %19, %3 row_newbcast:5 row_mask:0xf bank_mask:0xf\n\t" \
    "v_fmac_f32_dpp %6, %19, %3 row_newbcast:6 row_mask:0xf bank_mask:0xf\n\t" \
    "v_fmac_f32_dpp %7, %19, %3 row_newbcast:7 row_mask:0xf bank_mask:0xf\n\t" \
    "v_fmac_f32_dpp %8, %19, %3 row_newbcast:8 row_mask:0xf bank_mask:0xf\n\t" \
    "v_fmac_f32_dpp %9, %19, %3 row_newbcast:9 row_mask:0xf bank_mask:0xf\n\t" \
    "v_fmac_f32_dpp %10, %19, %3 row_newbcast:10 row_mask:0xf bank_mask:0xf\n\t" \
    "v_fmac_f32_dpp %11, %19, %3 row_newbcast:11 row_mask:0xf bank_mask:0xf\n\t" \
    "v_fmac_f32_dpp %12, %19, %3 row_newbcast:12 row_mask:0xf bank_mask:0xf\n\t" \
    "v_fmac_f32_dpp %13, %19, %3 row_newbcast:13 row_mask:0xf bank_mask:0xf\n\t" \
    "v_fmac_f32_dpp %14, %19, %3 row_newbcast:14 row_mask:0xf bank_mask:0xf\n\t" \
    "v_fmac_f32_dpp %15, %19, %3 row_newbcast:15 row_mask:0xf bank_mask:0xf\n\t" \
    "v_xor_b32 %4, 0x80000000, %4\n\t" \
    "v_fmac_f32_dpp %5, %20, %4 row_newbcast:5 row_mask:0xf bank_mask:0xf\n\t" \
    "v_fmac_f32_dpp %6, %20, %4 row_newbcast:6 row_mask:0xf bank_mask:0xf\n\t" \
    "v_fmac_f32_dpp %7, %20, %4 row_newbcast:7 row_mask:0xf bank_mask:0xf\n\t" \
    "v_fmac_f32_dpp %8, %20, %4 row_newbcast:8 row_mask:0xf bank_mask:0xf\n\t" \
    "v_fmac_f32_dpp %9, %20, %4 row_newbcast:9 row_mask:0xf bank_mask:0xf\n\t" \
    "v_fmac_f32_dpp %10, %20, %4 row_newbcast:10 row_mask:0xf bank_mask:0xf\n\t" \
    "v_fmac_f32_dpp %11, %20, %4 row_newbcast:11 row_mask:0xf bank_mask:0xf\n\t" \
    "v_fmac_f32_dpp %12, %20, %4 row_newbcast:12 row_mask:0xf bank_mask:0xf\n\t" \
    "v_fmac_f32_dpp %13, %20, %4 row_newbcast:13 row_mask:0xf bank_mask:0xf\n\t" \
    "v_fmac_f32_dpp %14, %20, %4 row_newbcast:14 row_mask:0xf bank_mask:0xf\n\t" \
    "v_fmac_f32_dpp %15, %20, %4 row_newbcast:15 row_mask:0xf bank_mask:0xf\n\t" \
    "v_xor_b32 %5, 0x80000000, %5\n\t" \
    "v_fmac_f32_dpp %6, %21, %5 row_newbcast:6 row_mask:0xf bank_mask:0xf\n\t" \
    "v_fmac_f32_dpp %7, %21, %5 row_newbcast:7 row_mask:0xf bank_mask:0xf\n\t" \
    "v_fmac_f32_dpp %8, %21, %5 row_newbcast:8 row_mask:0xf bank_mask:0xf\n\t" \
    "v_fmac_f32_dpp %9, %21, %5 row_newbcast:9 row_mask:0xf bank_mask:0xf\n\t" \
    "v_fmac_f32_dpp %10, %21, %5 row_newbcast:10 row_mask:0xf bank_mask:0xf\n\t" \
    "v_fmac_f32_dpp %11, %21, %5 row_newbcast:11 row_mask:0xf bank_mask:0xf\n\t" \
    "v_fmac_f32_dpp %12, %21, %5 row_newbcast:12 row_mask:0xf bank_mask:0xf\n\t" \
    "v_fmac_f32_dpp %13, %21, %5 row_newbcast:13 row_mask:0xf bank_mask:0xf\n\t" \
    "v_fmac_f32_dpp %14, %21, %5 row_newbcast:14 row_mask:0xf bank_mask:0xf\n\t" \
    "v_fmac_f32_dpp %15, %21, %5 row_newbcast:15 row_mask:0xf bank_mask:0xf\n\t" \
    "v_xor_b32 %6, 0x80000000, %6\n\t" \
    "v_fmac_f32_dpp %7, %22, %6 row_newbcast:7 row_mask:0xf bank_mask:0xf\n\t" \
    "v_fmac_f32_dpp %8, %22, %6 row_newbcast:8 row_mask:0xf bank_mask:0xf\n\t" \
    "v_fmac_f32_dpp %9, %22, %6 row_newbcast:9 row_mask:0xf bank_mask:0xf\n\t" \
    "v_fmac_f32_dpp %10, %22, %6 row_newbcast:10 row_mask:0xf bank_mask:0xf\n\t" \
    "v_fmac_f32_dpp %11, %22, %6 row_newbcast:11 row_mask:0xf bank_mask:0xf\n\t" \
    "v_fmac_f32_dpp %12, %22, %6 row_newbcast:12 row_mask:0xf bank_mask:0xf\n\t" \
    "v_fmac_f32_dpp %13, %22, %6 row_newbcast:13 row_mask:0xf bank_mask:0xf\n\t" \
    "v_fmac_f32_dpp %14, %22, %6 row_newbcast:14 row_mask:0xf bank_mask:0xf\n\t" \
    "v_fmac_f32_dpp %15, %22, %6 row_newbcast:15 row_mask:0xf bank_mask:0xf\n\t" \
    "v_xor_b32 %7, 0x80000000, %7\n\t" \
    "v_fmac_f32_dpp %8, %23, %7 row_newbcast:8 row_mask:0xf bank_mask:0xf\n\t" \
    "v_fmac_f32_dpp %9, %23, %7 row_newbcast:9 row_mask:0xf bank_mask:0xf\n\t" \
    "v_fmac_f32_dpp %10, %23, %7 row_newbcast:10 row_mask:0xf bank_mask:0xf\n\t" \
    "v_fmac_f32_dpp %11, %23, %7 row_newbcast:11 row_mask:0xf bank_mask:0xf\n\t" \
    "v_fmac_f32_dpp %12, %23, %7 row_newbcast:12 row_mask:0xf bank_mask:0xf\n\t" \
    "v_fmac_f32_dpp %13, %23, %7 row_newbcast:13 row_mask:0xf bank_mask:0xf\n\t" \
    "v_fmac_f32_dpp %14, %23, %7 row_newbcast:14 row_mask:0xf bank_mask:0xf\n\t" \
    "v_fmac_f32_dpp %15, %23, %7 row_newbcast:15 row_mask:0xf bank_mask:0xf\n\t" \
    ""
#define TRI2_ASMB \
    "s_nop 1\n\t" \
    "v_xor_b32 %0, 0x80000000, %0\n\t" \
    "v_fmac_f32_dpp %1, %8, %0 row_newbcast:9 row_mask:0xf bank_mask:0xf\n\t" \
    "v_fmac_f32_dpp %2, %8, %0 row_newbcast:10 row_mask:0xf bank_mask:0xf\n\t" \
    "v_fmac_f32_dpp %3, %8, %0 row_newbcast:11 row_mask:0xf bank_mask:0xf\n\t" \
    "v_fmac_f32_dpp %4, %8, %0 row_newbcast:12 row_mask:0xf bank_mask:0xf\n\t" \
    "v_fmac_f32_dpp %5, %8, %0 row_newbcast:13 row_mask:0xf bank_mask:0xf\n\t" \
    "v_fmac_f32_dpp %6, %8, %0 row_newbcast:14 row_mask:0xf bank_mask:0xf\n\t" \
    "v_fmac_f32_dpp %7, %8, %0 row_newbcast:15 row_mask:0xf bank_mask:0xf\n\t" \
    "v_xor_b32 %1, 0x80000000, %1\n\t" \
    "v_fmac_f32_dpp %2, %9, %1 row_newbcast:10 row_mask:0xf bank_mask:0xf\n\t" \
    "v_fmac_f32_dpp %3, %9, %1 row_newbcast:11 row_mask:0xf bank_mask:0xf\n\t" \
    "v_fmac_f32_dpp %4, %9, %1 row_newbcast:12 row_mask:0xf bank_mask:0xf\n\t" \
    "v_fmac_f32_dpp %5, %9, %1 row_newbcast:13 row_mask:0xf bank_mask:0xf\n\t" \
    "v_fmac_f32_dpp %6, %9, %1 row_newbcast:14 row_mask:0xf bank_mask:0xf\n\t" \
    "v_fmac_f32_dpp %7, %9, %1 row_newbcast:15 row_mask:0xf bank_mask:0xf\n\t" \
    "v_xor_b32 %2, 0x80000000, %2\n\t" \
    "v_fmac_f32_dpp %3, %10, %2 row_newbcast:11 row_mask:0xf bank_mask:0xf\n\t" \
    "v_fmac_f32_dpp %4, %10, %2 row_newbcast:12 row_mask:0xf bank_mask:0xf\n\t" \
    "v_fmac_f32_dpp %5, %10, %2 row_newbcast:13 row_mask:0xf bank_mask:0xf\n\t" \
    "v_fmac_f32_dpp %6, %10, %2 row_newbcast:14 row_mask:0xf bank_mask:0xf\n\t" \
    "v_fmac_f32_dpp %7, %10, %2 row_newbcast:15 row_mask:0xf bank_mask:0xf\n\t" \
    "v_xor_b32 %3, 0x80000000, %3\n\t" \
    "v_fmac_f32_dpp %4, %11, %3 row_newbcast:12 row_mask:0xf bank_mask:0xf\n\t" \
    "v_fmac_f32_dpp %5, %11, %3 row_newbcast:13 row_mask:0xf bank_mask:0xf\n\t" \
    "v_fmac_f32_dpp %6, %11, %3 row_newbcast:14 row_mask:0xf bank_mask:0xf\n\t" \
    "v_fmac_f32_dpp %7, %11, %3 row_newbcast:15 row_mask:0xf bank_mask:0xf\n\t" \
    "v_xor_b32 %4, 0x80000000, %4\n\t" \
    "v_fmac_f32_dpp %5, %12, %4 row_newbcast:13 row_mask:0xf bank_mask:0xf\n\t" \
    "v_fmac_f32_dpp %6, %12, %4 row_newbcast:14 row_mask:0xf bank_mask:0xf\n\t" \
    "v_fmac_f32_dpp %7, %12, %4 row_newbcast:15 row_mask:0xf bank_mask:0xf\n\t" \
    "v_xor_b32 %5, 0x80000000, %5\n\t" \
    "v_fmac_f32_dpp %6, %13, %5 row_newbcast:14 row_mask:0xf bank_mask:0xf\n\t" \
    "v_fmac_f32_dpp %7, %13, %5 row_newbcast:15 row_mask:0xf bank_mask:0xf\n\t" \
    "v_xor_b32 %6, 0x80000000, %6\n\t" \
    "v_fmac_f32_dpp %7, %14, %6 row_newbcast:15 row_mask:0xf bank_mask:0xf\n\t" \
    "v_xor_b32 %7, 0x80000000, %7\n\t" \
    ""

constexpr int S3_RS = 144;
constexpr int S3_KKT = 0, S3_RRT = 2304, S3_BHT = 4608, S3_KHT = 6912, S3_BHJ = 9216, S3_KHJ = 11264, S3_WLF = 13312, S3_IMG = 13568;
constexpr int S3_PRIV = 4 * S3_IMG, S3_MBF = 0, S3_RHF = 1024, S3_PSTRIDE = 2048;
__device__ __forceinline__ void phase_rwkv_scan3(const Params& p, int j, char* lds_, bf16_t* Y) {
    const bf16_t* R = (const bf16_t*)(p.ws + OFF_R); const bf16_t* Kb = (const bf16_t*)(p.ws + OFF_K);
    const bf16_t* V = (const bf16_t*)(p.ws + OFF_VF); const bf16_t* KK = (const bf16_t*)(p.ws + OFF_H);
    const bf16_t* LW = (const bf16_t*)(p.ws + OFF_LW); const bf16_t* AD = (const bf16_t*)(p.ws + OFF_AD);
    const int tid = tidx(), lane = tid & 63, wid = __builtin_amdgcn_readfirstlane(tid >> 6), cl = wid >> 2, q = wid & 3, g = lane >> 4, li = lane & 15;
    LAS unsigned char* img0 = (LAS unsigned char*)lds_ + cl * 2 * S3_IMG;
    LAS unsigned char* pw = (LAS unsigned char*)lds_ + S3_PRIV + wid * S3_PSTRIDE;
    f32x4 msk_lt, msk_le, msk_gt;
#pragma unroll
    for (int r = 0; r < 4; ++r) { msk_lt[r] = (4 * g + r) < li ? 1.f : 0.f; msk_le[r] = (4 * g + r) <= li ? 1.f : 0.f; msk_gt[r] = (4 * g + r) > li ? 1.f : 0.f; }
    for (int cp = blockIdx.x; cp < 256; cp += gridDim.x) {
        const int chain = cp * 2 + cl, d = chain & 1, bh = chain >> 1, b = bh >> 4, h = bh & 15;
        const int vcol = h * 64 + q * 16 + li, vcolw = vcol & ~1, jcol = q * 16 + li;
        const unsigned selv = (vcol & 1) ? 0x03020c0cu : 0x01000c0cu;
        const unsigned selp = (vcol & 1) ? 0x07060302u : 0x05040100u;
        const float ka = p.in[22][(size_t)j * D + vcol];
        const bf16_t* ADd = AD + (size_t)d * NT * D;
        const bf16_t* w2t = wsm(p, j, WJ_W2) + (size_t)d * D * 64 + (size_t)vcol * 64;
        const bf16x8 Bw0 = *(const bf16x8*)(w2t + g * 8), Bw1 = *(const bf16x8*)(w2t + 32 + g * 8);
        const float w0b = p.in[10][((size_t)j * 2 + d) * D + vcol] * -1.44269504089f;
        const bf16_t* LD0 = (const bf16_t*)(p.ws + OFF_LD);
        const unsigned voa = (unsigned)((d ? 15 - li : li) * 256 + (d * 64 + g * 8) * 2);
        bf16_t* Yd = Y + (size_t)d * NT * D;
        const int dir = d ? -1 : 1;
        auto row_first = [&](int c) -> int {
            const int s0 = c * 16;
            if (s0 < TC) return NLAT + b * TC + (d ? (TC - 1 - s0) : s0);
            const int tl = s0 - TC; return b * TL + (d ? (TL - 1 - tl) : tl);
        };
#define UNPV(w) __uint_as_float(__builtin_amdgcn_perm(0u, (w), selv))
        const unsigned LA0 = ((4 * g <= li) ? 0x3F80u : 0u) | ((4 * g + 1 <= li) ? 0x3F800000u : 0u), LA1 = ((4 * g + 2 <= li) ? 0x3F80u : 0u) | ((4 * g + 3 <= li) ? 0x3F800000u : 0u);
        unsigned vov[4];
#pragma unroll
        for (int e = 0; e < 4; ++e) vov[e] = (unsigned)((d ? 15 - (4 * g + e) : 4 * g + e) * (D * 2) + vcolw * 2);
#define LDG(P, VO) (*(const unsigned*)((P) + (VO)))
        unsigned rr[4], rkk[4], rk[4], ra[4], rv[4]; bf16x8 rwa0, rwa1;
        auto issue_loads = [&](int c) {
            const int r0 = row_first(c);
            const size_t rbo = (size_t)(d ? r0 - 15 : r0) * (D * 2);
            const char* bLD = (const char*)LD0 + (size_t)(d ? r0 - 15 : r0) * 256; const char* bR = (const char*)R + rbo; const char* bKK = (const char*)KK + rbo;
            const char* bK = (const char*)Kb + rbo; const char* bA = (const char*)ADd + rbo; const char* bV = (const char*)V + rbo;
#pragma unroll
            for (int e = 0; e < 4; ++e) { rr[e] = LDG(bR, vov[e]); rkk[e] = LDG(bKK, vov[e]); rk[e] = LDG(bK, vov[e]); ra[e] = LDG(bA, vov[e]); rv[e] = LDG(bV, vov[e]); }
            rwa0 = *(const bf16x8*)(bLD + voa); rwa1 = *(const bf16x8*)(bLD + voa + 64);
        };
        issue_loads(0);
        f32x4 T[4];
#pragma unroll
        for (int jb = 0; jb < 4; ++jb) T[jb] = (f32x4){0.f, 0.f, 0.f, 0.f};
        auto do_prep = [&](int cc, unsigned& w0, unsigned& w1) {
            LAS unsigned char* im = img0 + (cc & 1) * S3_IMG;
            {
                const f32x4 Z4p = {0.f, 0.f, 0.f, 0.f};
                f32x4 WP = __builtin_amdgcn_mfma_f32_16x16x32_bf16(rwa0, Bw0, Z4p, 0, 0, 0);
                WP = __builtin_amdgcn_mfma_f32_16x16x32_bf16(rwa1, Bw1, WP, 0, 0, 0);
                unsigned lwp0, lwp1;
                {
                    const f32x2_t x0 = {WP[0], WP[1]}, x1 = {WP[2], WP[3]};
                    const f32x2_t t0 = x0 * -1.44269504089f + w0b, t1 = x1 * -1.44269504089f + w0b;
                    f32x2_t e0, e1; e0.x = __builtin_amdgcn_exp2f(t0.x); e0.y = __builtin_amdgcn_exp2f(t0.y); e1.x = __builtin_amdgcn_exp2f(t1.x); e1.y = __builtin_amdgcn_exp2f(t1.y);
                    const f32x2_t d0 = e0 + 1.0f, d1 = e1 + 1.0f;
                    lwp0 = pack2(-0.6065306597f * __builtin_amdgcn_rcpf(d0.x), -0.6065306597f * __builtin_amdgcn_rcpf(d0.y));
                    lwp1 = pack2(-0.6065306597f * __builtin_amdgcn_rcpf(d1.x), -0.6065306597f * __builtin_amdgcn_rcpf(d1.y));
                }
                const f32x4 CW = __builtin_amdgcn_mfma_f32_16x16x16bf16_1k(mk4(LA0, LA1), mk4(lwp0, lwp1), Z4p, 0, 0, 0);
                float ep_prev = __expf(CW[0] - bflo(lwp0));
                float bhv[4], khv[4];
#pragma unroll
                for (int e = 0; e < 4; ++e) {
                    const int t = 4 * g + e;
                    const float rvv = UNPV(rr[e]), kkv = UNPV(rkk[e]), kv = UNPV(rk[e]), av = UNPV(ra[e]);
                    const float ep = __expf(CW[e]), em = __expf(-CW[e]);
                    const float kkt = kkv * ep_prev, rt = rvv * ep;
                    bhv[e] = kkv * av * em; khv[e] = kv * (1.f + (av - 1.f) * ka) * em;
                    ep_prev = ep;
                    *(LAS bf16_t*)(im + S3_KKT + t * S3_RS + jcol * 2) = (bf16_t)(pack2(kkt, 0.f) & 0xffffu);
                    *(LAS bf16_t*)(im + S3_RRT + t * S3_RS + jcol * 2) = (bf16_t)(pack2(rt, 0.f) & 0xffffu);
                    *(LAS bf16_t*)(im + S3_BHT + t * S3_RS + jcol * 2) = (bf16_t)(pack2(bhv[e], 0.f) & 0xffffu);
                    *(LAS bf16_t*)(im + S3_KHT + t * S3_RS + jcol * 2) = (bf16_t)(pack2(khv[e], 0.f) & 0xffffu);
                }
                *(LAS u32x2*)(im + S3_BHJ + jcol * 32 + g * 8) = (u32x2){pack2(bhv[0], bhv[1]), pack2(bhv[2], bhv[3])};
                *(LAS u32x2*)(im + S3_KHJ + jcol * 32 + g * 8) = (u32x2){pack2(khv[0], khv[1]), pack2(khv[2], khv[3])};
                if (g == 3) *(LAS float*)(im + S3_WLF + jcol * 4) = ep_prev;
                w0 = __builtin_amdgcn_perm(rv[1], rv[0], selp); w1 = __builtin_amdgcn_perm(rv[3], rv[2], selp);
            }
        };
        constexpr int NCH = (TC + TL) / 16;
        unsigned vw0, vw1, vwn0 = 0u, vwn1 = 0u;
        do_prep(0, vw0, vw1);
        issue_loads(1);
        for (int c = 0; c < NCH; ++c) {
            const int row0 = row_first(c);
            LAS unsigned char* im = img0 + (c & 1) * S3_IMG;
            asm volatile("s_waitcnt lgkmcnt(0)" ::: "memory");
            __builtin_amdgcn_s_barrier();
            asm volatile("" ::: "memory");
            if (c + 1 < NCH) { do_prep(c + 1, vwn0, vwn1); if (c + 2 < NCH) issue_loads(c + 2); }
            f32x4 Mb = {0.f, 0.f, 0.f, 0.f}, Mk = Mb, Nb = Mb, Nk = Mb, MbT = Mb;
#pragma unroll
            for (int kk = 0; kk < 2; ++kk) {
                const int ko = li * S3_RS + (32 * kk + 8 * g) * 2;
                const bf16x8 aB = *(const LAS bf16x8*)(im + S3_BHT + ko), aK = *(const LAS bf16x8*)(im + S3_KHT + ko);
                const bf16x8 bK = *(const LAS bf16x8*)(im + S3_KKT + ko), bR = *(const LAS bf16x8*)(im + S3_RRT + ko);
                Mb = __builtin_amdgcn_mfma_f32_16x16x32_bf16(aB, bK, Mb, 0, 0, 0);
                MbT = __builtin_amdgcn_mfma_f32_16x16x32_bf16(bK, aB, MbT, 0, 0, 0);
                Mk = __builtin_amdgcn_mfma_f32_16x16x32_bf16(aK, bK, Mk, 0, 0, 0);
                Nb = __builtin_amdgcn_mfma_f32_16x16x32_bf16(aB, bR, Nb, 0, 0, 0);
                Nk = __builtin_amdgcn_mfma_f32_16x16x32_bf16(aK, bR, Nk, 0, 0, 0);
            }
            Mb = Mb * msk_lt; Mk = Mk * msk_lt; Nb = Nb * msk_le; Nk = Nk * msk_le; MbT = MbT * msk_gt;
            f32x4 PT = {0.f, 0.f, 0.f, 0.f}, QT = PT;
#pragma unroll
            for (int kk = 0; kk < 2; ++kk) {
                const bf16x8 bw = mk8(pack2(T[2 * kk][0], T[2 * kk][1]), pack2(T[2 * kk][2], T[2 * kk][3]), pack2(T[2 * kk + 1][0], T[2 * kk + 1][1]), pack2(T[2 * kk + 1][2], T[2 * kk + 1][3]));
                const int ko = li * S3_RS + (32 * kk + 4 * g) * 2;
                const u32x2 k0 = *(const LAS u32x2*)(im + S3_KKT + ko), k1 = *(const LAS u32x2*)(im + S3_KKT + ko + 32);
                const u32x2 r0 = *(const LAS u32x2*)(im + S3_RRT + ko), r1 = *(const LAS u32x2*)(im + S3_RRT + ko + 32);
                PT = __builtin_amdgcn_mfma_f32_16x16x32_bf16(mk8(k0[0], k0[1], k1[0], k1[1]), bw, PT, 0, 0, 0);
                QT = __builtin_amdgcn_mfma_f32_16x16x32_bf16(mk8(r0[0], r0[1], r1[0], r1[1]), bw, QT, 0, 0, 0);
            }
            const f32x4 RT = __builtin_amdgcn_mfma_f32_16x16x16bf16_1k(mk4(pack2(Mk[0], Mk[1]), pack2(Mk[2], Mk[3])), mk4(vw0, vw1), PT, 0, 0, 0);
#define CW(Y) pack2((Y)[0], (Y)[1]), pack2((Y)[2], (Y)[3])
#define OPND(w0, w1) mk4((w0), (w1))
            const f32x4 Z4 = {0.f, 0.f, 0.f, 0.f};
            const unsigned mb0 = pack2(Mb[0], Mb[1]), mb1 = pack2(Mb[2], Mb[3]), mt0 = pack2(MbT[0], MbT[1]), mt1 = pack2(MbT[2], MbT[3]);
            const f32x4 P1 = __builtin_amdgcn_mfma_f32_16x16x16bf16_1k(OPND(mt0, mt1), OPND(mb0, mb1), Z4, 0, 0, 0);
            const f32x4 P1T = __builtin_amdgcn_mfma_f32_16x16x16bf16_1k(OPND(mb0, mb1), OPND(mt0, mt1), Z4, 0, 0, 0);
            const unsigned p10 = pack2(P1[0], P1[1]), p11 = pack2(P1[2], P1[3]), q10 = pack2(P1T[0], P1T[1]), q11 = pack2(P1T[2], P1T[3]);
            const f32x4 P2 = __builtin_amdgcn_mfma_f32_16x16x16bf16_1k(OPND(q10, q11), OPND(p10, p11), Z4, 0, 0, 0);
            const f32x4 P2T = __builtin_amdgcn_mfma_f32_16x16x16bf16_1k(OPND(p10, p11), OPND(q10, q11), Z4, 0, 0, 0);
            const unsigned p20 = pack2(P2[0], P2[1]), p21 = pack2(P2[2], P2[3]), q20 = pack2(P2T[0], P2T[1]), q21 = pack2(P2T[2], P2T[3]);
            const f32x4 P3 = __builtin_amdgcn_mfma_f32_16x16x16bf16_1k(OPND(q20, q21), OPND(p20, p21), Z4, 0, 0, 0);
            const unsigned p30 = pack2(P3[0], P3[1]), p31 = pack2(P3[2], P3[3]);
            f32x4 Yv = __builtin_amdgcn_mfma_f32_16x16x16bf16_1k(OPND(mb0 ^ 0x80008000u, mb1 ^ 0x80008000u), OPND(pack2(RT[0], RT[1]), pack2(RT[2], RT[3])), RT, 0, 0, 0);
            Yv = __builtin_amdgcn_mfma_f32_16x16x16bf16_1k(OPND(p10, p11), OPND(pack2(Yv[0], Yv[1]), pack2(Yv[2], Yv[3])), Yv, 0, 0, 0);
            Yv = __builtin_amdgcn_mfma_f32_16x16x16bf16_1k(OPND(p20, p21), OPND(pack2(Yv[0], Yv[1]), pack2(Yv[2], Yv[3])), Yv, 0, 0, 0);
            Yv = __builtin_amdgcn_mfma_f32_16x16x16bf16_1k(OPND(p30, p31), OPND(pack2(Yv[0], Yv[1]), pack2(Yv[2], Yv[3])), Yv, 0, 0, 0);
#undef CW
#undef OPND
            const bf16x8 bop = mk8(pack2(Yv[0], Yv[1]) ^ 0x80008000u, pack2(Yv[2], Yv[3]) ^ 0x80008000u, vw0, vw1);
            const f32x4 YT = __builtin_amdgcn_mfma_f32_16x16x32_bf16(mk8(pack2(Nb[0], Nb[1]), pack2(Nb[2], Nb[3]), pack2(Nk[0], Nk[1]), pack2(Nk[2], Nk[3])), bop, QT, 0, 0, 0);
#pragma unroll
            for (int r = 0; r < 4; ++r) Yd[(size_t)(row0 + (4 * g + r) * dir) * D + vcol] = (bf16_t)(pack2(YT[r], 0.f) & 0xffffu);
#pragma unroll
            for (int jb = 0; jb < 4; ++jb) {
                const u32x2 b2 = *(const LAS u32x2*)(im + S3_BHJ + (16 * jb + li) * 32 + g * 8), k2 = *(const LAS u32x2*)(im + S3_KHJ + (16 * jb + li) * 32 + g * 8);
                T[jb] = __builtin_amdgcn_mfma_f32_16x16x32_bf16(mk8(b2[0], b2[1], k2[0], k2[1]), bop, T[jb], 0, 0, 0);
                const f32x4 wv = *(const LAS f32x4*)(im + S3_WLF + (16 * jb + 4 * g) * 4);
                T[jb] = T[jb] * wv;
            }
            vw0 = vwn0; vw1 = vwn1;
        }
#undef LDG
#undef UNPV
        asm volatile("s_waitcnt lgkmcnt(0)" ::: "memory");
        __builtin_amdgcn_s_barrier();
    }
}

#ifndef SCAN2_MODE
#define SCAN2_MODE 3
#endif
constexpr size_t OFF_Y2DBG = OFF_BIG + 13 * U + U / 2;
__device__ __forceinline__ void phase_scan_compare(const Params& p) {
    const bf16_t* Y = (const bf16_t*)(p.ws + OFF_Y); const bf16_t* Y2 = (const bf16_t*)(p.ws + OFF_Y2DBG);
    float* accp = (float*)(p.ws + OFF_BAR + 16384);
    float e2 = 0.f, y2 = 0.f;
    for (size_t i = (size_t)blockIdx.x * NTHREADS + tidx(); i < (size_t)NT * D / 2; i += (size_t)gridDim.x * NTHREADS) {
        const unsigned a = ((const unsigned*)Y)[i], b = ((const unsigned*)Y2)[i];
        const float a0 = bflo(a), a1 = bfhi(a), b0 = bflo(b), b1 = bfhi(b);
        e2 += (a0 - b0) * (a0 - b0) + (a1 - b1) * (a1 - b1); y2 += a0 * a0 + a1 * a1;
    }
    e2 = wave_sum(e2); y2 = wave_sum(y2);
    if ((tidx() & 63) == 0) { atomicAdd(accp, e2); atomicAdd(accp + 1, y2); }
}

__device__ __forceinline__ void phase_rwkv_out(const Params& p, int j) {
    const bf16_t* Y = (const bf16_t*)(p.ws + OFF_Y); const bf16_t* V = (const bf16_t*)(p.ws + OFF_VF); const bf16_t* G = (const bf16_t*)(p.ws + OFF_G);
    const float* BON = (const float*)(p.ws + OFF_BON);
    bf16_t* YO = (bf16_t*)(p.ws + OFF_LW);
    const float* lnw = p.in[24] + (size_t)j * D; const float* lnb = p.in[25] + (size_t)j * D;
    const int tid_ = tidx(), lane = tid_ & 63, wid = tid_ >> 6, c0 = lane * 16;
    float lw[16], lb[16];
#pragma unroll
    for (int i = 0; i < 16; ++i) { lw[i] = lnw[c0 + i]; lb[i] = lnb[c0 + i]; }
    constexpr int RW = 2;
    for (int grp = blockIdx.x * 8 + wid; grp < NT / RW; grp += gridDim.x * 8) {
        u32x4 y0[RW][2], y1[RW][2], vv[RW][2], gg[RW][2]; float bon[RW];
#pragma unroll
        for (int r = 0; r < RW; ++r) {
            const size_t o = (size_t)(grp * RW + r) * D + c0;
#pragma unroll
            for (int i = 0; i < 2; ++i) {
                y0[r][i] = *(const u32x4*)(Y + o + i * 8); y1[r][i] = *(const u32x4*)(Y + (size_t)NT * D + o + i * 8);
                vv[r][i] = *(const u32x4*)(V + o + i * 8); gg[r][i] = *(const u32x4*)(G + o + i * 8);
            }
            bon[r] = BON[(size_t)(grp * RW + r) * 16 + (lane >> 2)];
        }
#pragma unroll
        for (int r = 0; r < RW; ++r) {
            const size_t o = (size_t)(grp * RW + r) * D + c0;
            float ov[16]; float s1 = 0.f;
#pragma unroll
            for (int i = 0; i < 16; ++i) {
                const unsigned w0 = y0[r][i >> 3][(i >> 1) & 3], w1 = y1[r][i >> 3][(i >> 1) & 3];
                ov[i] = ((i & 1) ? bfhi(w0) : bflo(w0)) + ((i & 1) ? bfhi(w1) : bflo(w1));
                s1 += ov[i];
            }
            s1 += __shfl_xor(s1, 1, 64); s1 += __shfl_xor(s1, 2, 64);
            const float mu = s1 * (1.f / 64.f);
            float s2 = 0.f;
#pragma unroll
            for (int i = 0; i < 16; ++i) { const float dd = ov[i] - mu; s2 += dd * dd; }
            s2 += __shfl_xor(s2, 1, 64); s2 += __shfl_xor(s2, 2, 64);
            const float rs = rsqrtf(s2 * (1.f / 64.f) + 64e-5f);
            float res[16];
#pragma unroll
            for (int i = 0; i < 16; ++i) {
                const unsigned vw = vv[r][i >> 3][(i >> 1) & 3], gw = gg[r][i >> 3][(i >> 1) & 3];
                const float v = (i & 1) ? bfhi(vw) : bflo(vw), g = (i & 1) ? bfhi(gw) : bflo(gw);
                res[i] = ((ov[i] - mu) * rs * lw[i] + lb[i] + bon[r] * v) * g;
            }
            u32x4 w[2];
#pragma unroll
            for (int i = 0; i < 8; ++i) w[i >> 2][i & 3] = pack2(res[2 * i], res[2 * i + 1]);
            *(u32x4*)(YO + o) = w[0]; *(u32x4*)(YO + o + 8) = w[1];
        }
    }
}

__device__ __forceinline__ void phase_rwkv_out2(const Params& p, int j, char* lds) {
    const bf16_t* A = (const bf16_t*)(p.ws + OFF_LD) + (size_t)2 * NT * 128;
    const bf16_t* Bt = wsm(p, j, WJ_G2);
    const bf16_t* Y = (const bf16_t*)(p.ws + OFF_Y); const bf16_t* V = (const bf16_t*)(p.ws + OFF_VF);
    const float* BON = (const float*)(p.ws + OFF_BON); const float* BON2 = (const float*)(p.ws + OFF_BON2);
    bf16_t* YO = (bf16_t*)(p.ws + OFF_LW);
    const float* lnw = p.in[24] + (size_t)j * D; const float* lnb = p.in[25] + (size_t)j * D;
    float* lwl = (float*)lds;
    constexpr int TR = 64, RT = NT / TR, NRC = 64, RPC = RT / NRC, KS = 4;
    const int tid = tidx(), lane = tid & 63, wid = tid >> 6, wr = wid >> 2, wc = wid & 3, fr = lane & 15, fq = lane >> 4;
    for (int u = blockIdx.x; u < 4 * NRC; u += gridDim.x) {
        const int ct = u / NRC, rc = u % NRC, rt0 = rc * RPC, rt1 = rt0 + RPC, col0 = ct * 256, head = ct * 4 + wc;
        __syncthreads();
        lwl[tid] = tid < 256 ? lnw[col0 + tid] : lnb[col0 + tid - 256];
        {
            char* bsl = lds + 4096;
            int t2 = tid; asm volatile("" : "+v"(t2));
#pragma unroll
            for (int q = 0; q < 8; ++q) {
                const int idx = q * 512 + t2, rowi = idx >> 4, seg = idx & 15;
                *(u32x4*)(bsl + rowi * 272 + seg * 16) = *(const u32x4*)(Bt + (size_t)(col0 + rowi) * 128 + seg * 8);
            }
        }
        __syncthreads();
        int boff[4];
#pragma unroll
        for (int n = 0; n < 4; ++n) boff[n] = 4096 + (wc * 64 + (n >> 1) * 32 + 8 * (fr >> 2) + 4 * (n & 1) + (fr & 3)) * 272 + fq * 16;
        bf16x8 afr[2][KS];
#pragma unroll
        for (int m = 0; m < 2; ++m)
#pragma unroll
            for (int ks = 0; ks < KS; ++ks) afr[m][ks] = *(const bf16x8*)(A + (size_t)(rt0 * TR + wr * 32 + m * 16 + fr) * 128 + ks * 32 + fq * 8);
        u32x4 ey0[2][2], ey1[2][2], evv[2][2]; float ebon[2];
#define OUT2_LOAD(SET, RT_, M_) do { const int row_ = (RT_) * TR + wr * 32 + (M_) * 16 + fr; const size_t o_ = (size_t)row_ * D + col0 + wc * 64 + 8 * fq; \
            _Pragma("unroll") for (int pp = 0; pp < 2; ++pp) { ey0[SET][pp] = *(const u32x4*)(Y + o_ + pp * 32); ey1[SET][pp] = *(const u32x4*)(Y + (size_t)NT * D + o_ + pp * 32); evv[SET][pp] = *(const u32x4*)(V + o_ + pp * 32); } \
            ebon[SET] = BON[(size_t)row_ * 16 + head]; } while (0)
        OUT2_LOAD(0, rt0, 0);
#pragma unroll 1
        for (int rt = rt0; rt < rt1; ++rt) {
            int zz = 0; asm volatile("" : "+v"(zz));
            f32x4 acc[2][4];
#pragma unroll
            for (int m = 0; m < 2; ++m)
#pragma unroll
                for (int n = 0; n < 4; ++n) {
                    acc[m][n] = (f32x4){0.f, 0.f, 0.f, 0.f};
#pragma unroll
                    for (int ks = 0; ks < KS; ++ks) acc[m][n] = __builtin_amdgcn_mfma_f32_16x16x32_bf16(*(const bf16x8*)(lds + boff[n] + zz + ks * 64), afr[m][ks], acc[m][n], 0, 0, 0);
                }
            if (rt + 1 < rt1) {
#pragma unroll
                for (int m = 0; m < 2; ++m)
#pragma unroll
                    for (int ks = 0; ks < KS; ++ks) afr[m][ks] = *(const bf16x8*)(A + (size_t)((rt + 1) * TR + wr * 32 + m * 16 + fr) * 128 + ks * 32 + fq * 8);
            }
#pragma unroll
            for (int m = 0; m < 2; ++m) {
                if (m == 0) OUT2_LOAD(1, rt, 1);
                else if (rt + 1 < rt1) OUT2_LOAD(0, rt + 1, 0);
                const int row = rt * TR + wr * 32 + m * 16 + fr;
                const size_t o = (size_t)row * D + col0 + wc * 64 + 8 * fq;
                const float bon = ebon[m];
                float ov[16]; float s1 = 0.f;
#pragma unroll
                for (int i = 0; i < 16; ++i) {
                    const unsigned w0 = ey0[m][i >> 3][(i >> 1) & 3], w1 = ey1[m][i >> 3][(i >> 1) & 3];
                    ov[i] = ((i & 1) ? bfhi(w0) : bflo(w0)) + ((i & 1) ? bfhi(w1) : bflo(w1));
                    s1 += ov[i];
                }
                const float mu = red4(s1) * (1.f / 64.f);
                float s2 = 0.f;
#pragma unroll
                for (int i = 0; i < 16; ++i) { const float dd = ov[i] - mu; s2 += dd * dd; }
                const float rs = rsqrtf(red4(s2) * (1.f / 64.f) + 64e-5f);
#pragma unroll
                for (int pp = 0; pp < 2; ++pp) {
                    const float* lp = lwl + wc * 64 + pp * 32 + 8 * fq;
                    const float4 w0 = *(const float4*)lp, w1 = *(const float4*)(lp + 4), b0 = *(const float4*)(lp + 256), b1 = *(const float4*)(lp + 260);
                    const float lw[8] = {w0.x, w0.y, w0.z, w0.w, w1.x, w1.y, w1.z, w1.w}, lb[8] = {b0.x, b0.y, b0.z, b0.w, b1.x, b1.y, b1.z, b1.w};
                    float res[8];
#pragma unroll
                    for (int e = 0; e < 8; ++e) {
                        const unsigned vw = evv[m][pp][e >> 1];
                        const float v = (e & 1) ? bfhi(vw) : bflo(vw);
                        const float g = acc[m][2 * pp + (e >> 2)][e & 3];
                        res[e] = ((ov[pp * 8 + e] - mu) * rs * lw[e] + lb[e] + bon * v) * g;
                    }
                    const u32x4 w = {pack2(res[0], res[1]), pack2(res[2], res[3]), pack2(res[4], res[5]), pack2(res[6], res[7])};
                    *(u32x4*)(YO + o + pp * 32) = w;
                }
            }
        }
#undef OUT2_LOAD
    }
}

__device__ __forceinline__ void phase_rwkv_wo(const Params& p, int l, int j, char* lds) {
    EpD1 ep{(bf16_t*)(p.ws + OFF_D1), nullptr};
    SchedGrid S{p.ws + OFF_LW, (const char*)wsm(p, j, WJ_WO), 0, 0, (size_t)256 * D * 2, 0, (size_t)256 * D * 2, NT / 256 / 8, (NT / 256) * 4};
    g256::gemm_phase<true>((LAS unsigned char*)lds, D, D, D, S, ep);
}

__device__ __forceinline__ void phase_pool_dlt(const Params& p, int nrows) {
    const bf16_t* H = (const bf16_t*)(p.ws + OFF_H); bf16_t* DL = (bf16_t*)(p.ws + OFF_DLT);
    const int tid_ = tidx(), lane = tid_ & 63, wid = tid_ >> 6;
    constexpr int DR = 8;
    for (int row0 = (blockIdx.x * 8 + wid) * DR; row0 < nrows; row0 += gridDim.x * 8 * DR) {
        int t, T, base;
        if (row0 < NLAT) { t = row0 & (TL - 1); T = TL; base = row0 - t; } else { t = (row0 - NLAT) & (TC - 1); T = TC; base = row0 - t; }
#define DLT_GROUP(G) { \
            constexpr int half = 1 << (G), win = 2 << (G), NW = win + DR - 1; \
            const int c = (G) * 256 + lane * 4; \
            u32x2 w[NW]; float mk[NW]; \
            _Pragma("unroll") for (int i = 0; i < NW; ++i) { const int tt = t - half + i; const bool in = tt >= 0 && tt < T; mk[i] = in ? 1.f : 0.f; \
                w[i] = *(const u32x2*)(H + (size_t)(base + (in ? tt : t)) * D + c); } \
            float s0 = 0.f, s1 = 0.f, s2 = 0.f, s3 = 0.f; \
            _Pragma("unroll") for (int i = 0; i < win; ++i) { s0 += mk[i] * bflo(w[i][0]); s1 += mk[i] * bfhi(w[i][0]); s2 += mk[i] * bflo(w[i][1]); s3 += mk[i] * bfhi(w[i][1]); } \
            _Pragma("unroll") for (int r = 0; r < DR; ++r) { \
                const int tr = t + r, lo = max(tr - half, 0), hi = min(tr + half, T); \
                const float inv = 1.f / (float)(hi - lo); \
                const u32x2 hw = w[half + r]; \
                u32x2 o; o[0] = pack2(s0 * inv - bflo(hw[0]), s1 * inv - bfhi(hw[0])); o[1] = pack2(s2 * inv - bflo(hw[1]), s3 * inv - bfhi(hw[1])); \
                *(u32x2*)(DL + (size_t)(row0 + r) * D + c) = o; \
                if (r < DR - 1) { \
                    s0 += mk[r + win] * bflo(w[r + win][0]) - mk[r] * bflo(w[r][0]); s1 += mk[r + win] * bfhi(w[r + win][0]) - mk[r] * bfhi(w[r][0]); \
                    s2 += mk[r + win] * bflo(w[r + win][1]) - mk[r] * bflo(w[r][1]); s3 += mk[r + win] * bfhi(w[r + win][1]) - mk[r] * bfhi(w[r][1]); } } }
        DLT_GROUP(0) DLT_GROUP(1) DLT_GROUP(2) DLT_GROUP(3)
#undef DLT_GROUP
    }
}
__device__ __forceinline__ void phase_pool_gemm(const Params& p, int l, int j, int nrows, char* lds) {
    EpD1 ep{(bf16_t*)(p.ws + OFF_D1), p.in[28] + (size_t)j * D};
    SchedGrid S{p.ws + OFF_DLT, (const char*)wsm(p, j, WJ_POOL), 0, 0, (size_t)256 * D * 2, (size_t)256 * 2, (size_t)256 * 256 * 2, nrows / 256 / 8, (nrows / 256) * 4};
    g256::gemm_phase<true>((LAS unsigned char*)lds, D, 256, 256, S, ep);
}

__device__ __forceinline__ void phase_topk(const Params& p, bool with_ctx, char* lds) {
    const float* AFF = (const float*)(p.ws + OFF_AFF);
    const bf16_t* H = (const bf16_t*)(p.ws + OFF_H); bf16_t* XG = (bf16_t*)(p.ws + OFF_XG);
    float* GTV = (float*)(p.ws + OFF_GTV); short* SLT = (short*)(p.ws + OFF_SLT);
    unsigned* keys = (unsigned*)lds;
    unsigned* hist = keys + 4096;
    unsigned* wtot = hist + 256;
    unsigned* bc = wtot + 8;
    int* sel = (int*)(bc + 4);
    const int tid = tidx(), lane = tid & 63, wid = tid >> 6;
    const int nunits = with_ctx ? 512 : 256;
    for (int u = blockIdx.x; u < nunits; u += gridDim.x) {
        const bool lat = u < 256;
        const int uu = lat ? u : u - 256, b = uu >> 4, e = uu & 15;
        const int n = lat ? TL : TC, kq = lat ? CAPL : CAPC, per = lat ? 8 : 1;
        const int rowbase = lat ? b * TL : NLAT + b * TC;
        for (int i = tid; i < n; i += NTHREADS) keys[i] = __float_as_uint(AFF[(size_t)(rowbase + i) * 16 + e]);
        lds_barrier();
        unsigned prefix = 0u, mask = 0u; int kth = kq;
        for (int ps = 0; ps < 4; ++ps) {
            const int shift = 24 - 8 * ps;
            if (tid < 256) hist[tid] = 0u;
            lds_barrier();
            for (int i = tid; i < n; i += NTHREADS) { const unsigned k = keys[i]; if ((k & mask) == prefix) atomicAdd(&hist[(k >> shift) & 255u], 1u); }
            lds_barrier();
            if (wid == 0) {
                const int b0 = 255 - 4 * lane;
                const unsigned h0 = hist[b0], h1 = hist[b0 - 1], h2 = hist[b0 - 2], h3 = hist[b0 - 3];
                unsigned inc = h0 + h1 + h2 + h3;
#pragma unroll
                for (int d = 1; d < 64; d <<= 1) { const unsigned o = (unsigned)__builtin_amdgcn_ds_bpermute(((lane - d) & 63) << 2, (int)inc); if (lane >= d) inc += o; }
                const unsigned exc = inc - (h0 + h1 + h2 + h3);
                if (exc < (unsigned)kth && inc >= (unsigned)kth) {
                    unsigned cum = exc; int dg = b0; unsigned rem = 0;
                    if (cum + h0 >= (unsigned)kth) { dg = b0; rem = kth - cum; }
                    else { cum += h0; if (cum + h1 >= (unsigned)kth) { dg = b0 - 1; rem = kth - cum; }
                    else { cum += h1; if (cum + h2 >= (unsigned)kth) { dg = b0 - 2; rem = kth - cum; }
                    else { cum += h2; dg = b0 - 3; rem = kth - cum; } } }
                    bc[0] = (unsigned)dg; bc[1] = rem;
                }
            }
            lds_barrier();
            prefix |= bc[0] << shift; mask |= 255u << shift; kth = (int)bc[1];
            lds_barrier();
        }
        const unsigned Tk = prefix; const int need_eq = kth;
        const int t0 = tid * per; const bool act = t0 < n;
        int cgt = 0, ceq = 0;
        if (act) for (int i = 0; i < per; ++i) { const unsigned k = keys[t0 + i]; cgt += k > Tk; ceq += k == Tk; }
        const unsigned mine = ((unsigned)cgt << 16) | (unsigned)ceq;
        unsigned inc = mine;
#pragma unroll
        for (int d = 1; d < 64; d <<= 1) { const unsigned o = (unsigned)__builtin_amdgcn_ds_bpermute(((lane - d) & 63) << 2, (int)inc); if (lane >= d) inc += o; }
        if (lane == 63) wtot[wid] = inc;
        lds_barrier();
        unsigned woff = 0;
#pragma unroll
        for (int w = 0; w < 8; ++w) woff += (w < wid) ? wtot[w] : 0u;
        const unsigned ex = woff + inc - mine;
        int gt_before = (int)(ex >> 16), eq_before = (int)(ex & 0xffffu);
        if (act) {
            for (int i = 0; i < per; ++i) {
                const int t = t0 + i; const unsigned k = keys[t];
                int slot = -1;
                if (k > Tk) { slot = gt_before + min(eq_before, need_eq); ++gt_before; }
                else if (k == Tk) { if (eq_before < need_eq) slot = gt_before + eq_before; ++eq_before; }
                SLT[(size_t)(rowbase + t) * 16 + e] = (short)slot;
                if (slot >= 0) {
                    const int srow = lat ? (b * 16 + e) * CAPL + slot : NSLOT_LAT + (e * 16 + b) * CAPC + slot;
                    sel[slot] = t; GTV[srow] = __uint_as_float(k);
#if MOE_F8
                    ((int*)(p.ws + OFF_IDX))[srow] = rowbase + t;
#endif
                }
            }
        }
        lds_barrier();
        const int sbase = lat ? (b * 16 + e) * CAPL : NSLOT_LAT + (e * 16 + b) * CAPC;
#if MOE_F8
#else
        for (int s = wid; s < kq; s += 8) {
            const size_t srcrow = (size_t)(rowbase + sel[s]) * D, dstrow = (size_t)(sbase + s) * D;
            const u32x4 x0 = *(const u32x4*)(H + srcrow + lane * 8), x1 = *(const u32x4*)(H + srcrow + 512 + lane * 8);
            *(u32x4*)(XG + dstrow + lane * 8) = x0; *(u32x4*)(XG + dstrow + 512 + lane * 8) = x1;
        }
#endif
        lds_barrier();
    }
}
__device__ __forceinline__ int expert_of_slotrow(int r) { return r < NSLOT_LAT ? ((r >> 9) & 15) : ((r - NSLOT_LAT) >> 9); }
constexpr int EB = MOE_F8 ? 1 : 2;
struct SchedMoeUp {
    const char* XG; const char* W13; int cpe, total; const int* tok; const char* abase;
    __device__ __forceinline__ bool next(int i, g256::Unit& u) const {
        const long L = g256::unit_index(i);
        if (L >= total) return false;
        const int chunk = (int)(L >> 5), o = (int)(L & 31), e = chunk / cpe, r = chunk % cpe;
        int row0, ct;
        if (r < 16) { const int t = (r >> 2) * 8 + (o >> 2); ct = (r & 3) * 4 + (o & 3); row0 = ((t >> 1) * 16 + e) * CAPL + (t & 1) * 256; }
        else { ct = o & 15; row0 = NSLOT_LAT + e * 512 + (o >> 4) * 256; }
        u.a = XG + (size_t)row0 * D * EB; u.b = W13 + ((size_t)e * 4096 + ct * 256) * 1024 * EB; u.row0 = row0; u.col0 = ct * 256;
        return true;
    }
};
__device__ __forceinline__ void phase_moe_up(const Params& p, bool with_ctx, char* lds) {
    const int cpe = with_ctx ? 17 : 16;
#if MOE_F8
    EpSwiglu8 ep{p.ws + OFF_HID};
    SchedMoeUp S{p.ws + OFF_XG, p.ws + OFF_WM, cpe, 16 * cpe * 32, (const int*)(p.ws + OFF_IDX), p.ws + OFF_H};
    g256::gemm_phase<true, true, true>((LAS unsigned char*)lds, D / 2, D / 2, D / 2, S, ep);
#else
    EpSwiglu ep{(bf16_t*)(p.ws + OFF_HID)};
    SchedMoeUp S{p.ws + OFF_XG, (const char*)((const bf16_t*)(p.ws + OFF_WM) + WM_13), cpe, 16 * cpe * 32, nullptr, nullptr};
    g256::gemm_phase<true>((LAS unsigned char*)lds, D, D, D, S, ep);
#endif
}
struct SchedMoeDown {
    const char* HID; const char* W2; int total;
    __device__ __forceinline__ bool next(int i, g256::Unit& u) const {
        const long L = g256::unit_index(i);
        if (L >= total) return false;
        const int chunk = (int)(L >> 5), o = (int)(L & 31), ct = o & 3;
        int row0, e;
        if (chunk < 64) { e = chunk >> 2; const int t = (chunk & 3) * 8 + (o >> 2); row0 = ((t >> 1) * 16 + e) * CAPL + (t & 1) * 256; }
        else { e = (chunk - 64) * 4 + (o >> 3); row0 = NSLOT_LAT + e * 512 + ((o >> 2) & 1) * 256; }
        u.a = HID + (size_t)row0 * FF * EB; u.b = W2 + ((size_t)e * 1024 + ct * 256) * 2048 * EB; u.row0 = row0; u.col0 = ct * 256;
        return true;
    }
};
__device__ __forceinline__ void phase_moe_down(const Params& p, bool with_ctx, char* lds) {
    EpGateRow ep{(bf16_t*)(p.ws + OFF_YS), (const float*)(p.ws + OFF_GTV)};
#if MOE_F8
    SchedMoeDown S{p.ws + OFF_HID, p.ws + OFF_WM + WM8_2, (64 + (with_ctx ? 4 : 0)) * 32};
    g256::gemm_phase<true, true>((LAS unsigned char*)lds, FF / 2, FF / 2, FF / 2, S, ep);
#else
    SchedMoeDown S{p.ws + OFF_HID, (const char*)((const bf16_t*)(p.ws + OFF_WM) + WM_2), (64 + (with_ctx ? 4 : 0)) * 32};
    g256::gemm_phase<true>((LAS unsigned char*)lds, FF, FF, FF, S, ep);
#endif
}
__device__ __forceinline__ void phase_moe_combine(const Params& p, int l, int nrows, float amp = 1.f) {
    float* X = (float*)(p.ws + OFF_X); const bf16_t* YS = (const bf16_t*)(p.ws + OFF_YS); const short* SLT = (const short*)(p.ws + OFF_SLT);
    bf16_t* H = (bf16_t*)(p.ws + OFF_H); const bf16_t* D1 = (const bf16_t*)(p.ws + OFF_D1);
    const float* MOD = (const float*)(p.ws + OFF_MOD) + (size_t)l * 17 * MODW + 5 * D;
    const bool last = l == 3;
    const float* MODN = (const float*)(p.ws + OFF_MOD) + (size_t)(last ? l : l + 1) * 17 * MODW;
    const float* gn = last ? p.in[33] : p.in[6] + (size_t)(l + 1) * D;
    const int tid_ = tidx(), lane = tid_ & 63, wid = tid_ >> 6;
    float gw[16];
#pragma unroll
    for (int hh = 0; hh < 2; ++hh)
#pragma unroll
        for (int i = 0; i < 8; ++i) gw[hh * 8 + i] = gn[hh * 512 + lane * 8 + i];
    for (int row = blockIdx.x * 8 + wid; row < nrows; row += gridDim.x * 8) {
        float acc[16];
#pragma unroll
        for (int i = 0; i < 16; ++i) acc[i] = 0.f;
        const bool lat = row < NLAT;
        const int b = lat ? (row >> 12) : ((row - NLAT) >> 8);
        const int myslot = (int)SLT[(size_t)row * 16 + (lane & 15)];
        float4 xv[4]; u32x4 dv[2];
        const float* xsrc = l == 0 ? (lat ? p.in[0] + (size_t)row * D : p.in[2] + (size_t)(row - NLAT) * D) : X + (size_t)row * D;
#pragma unroll
        for (int hh = 0; hh < 2; ++hh) { xv[hh * 2] = *(const float4*)(xsrc + hh * 512 + lane * 8); xv[hh * 2 + 1] = *(const float4*)(xsrc + hh * 512 + lane * 8 + 4); dv[hh] = *(const u32x4*)(D1 + (size_t)row * D + hh * 512 + lane * 8); }
        unsigned long long bal = __ballot(myslot >= 0);
        unsigned emask = (unsigned)bal & 0xffffu;
        u32x4 ya[4], yc[4];
#pragma unroll
        for (int k = 0; k < 4; ++k) {
            ya[k] = (u32x4){0u, 0u, 0u, 0u}; yc[k] = (u32x4){0u, 0u, 0u, 0u};
            if (emask) {
                const int e = __builtin_ctz(emask); emask &= emask - 1u;
                const int sv = __builtin_amdgcn_readlane(myslot, e);
                const int srow = lat ? (b * 16 + e) * CAPL + sv : NSLOT_LAT + (e * 16 + b) * CAPC + sv;
                ya[k] = *(const u32x4*)(YS + (size_t)srow * D + lane * 8); yc[k] = *(const u32x4*)(YS + (size_t)srow * D + 512 + lane * 8);
            }
        }
#pragma unroll
        for (int k = 0; k < 4; ++k)
#pragma unroll
            for (int i = 0; i < 4; ++i) { acc[2 * i] += bflo(ya[k][i]); acc[2 * i + 1] += bfhi(ya[k][i]); acc[8 + 2 * i] += bflo(yc[k][i]); acc[8 + 2 * i + 1] += bfhi(yc[k][i]); }
        while (emask) {
            const int e = __builtin_ctz(emask); emask &= emask - 1u;
            const int sv = __builtin_amdgcn_readlane(myslot, e);
            const int srow = lat ? (b * 16 + e) * CAPL + sv : NSLOT_LAT + (e * 16 + b) * CAPC + sv;
            const u32x4 a = *(const u32x4*)(YS + (size_t)srow * D + lane * 8), c = *(const u32x4*)(YS + (size_t)srow * D + 512 + lane * 8);
#pragma unroll
            for (int i = 0; i < 4; ++i) { acc[2 * i] += bflo(a[i]); acc[2 * i + 1] += bfhi(a[i]); acc[8 + 2 * i] += bflo(c[i]); acc[8 + 2 * i + 1] += bfhi(c[i]); }
        }
        if (amp == 0.f) {
#pragma unroll
            for (int i = 0; i < 16; ++i) acc[i] = 0.f;
        }
        const int mrow = mod_row(row);
        const float* gt = MOD + (size_t)mrow * MODW;
        float xn[16]; float ss = 0.f;
#pragma unroll
        for (int hh = 0; hh < 2; ++hh) {
            const float* gp = gt + hh * 512 + lane * 8;
            const float4 g0 = *(const float4*)gp, g1 = *(const float4*)(gp + 4);
            float4 x0 = xv[hh * 2], x1 = xv[hh * 2 + 1];
            {
                const float4 m0 = *(const float4*)(gp - 3 * D), m1 = *(const float4*)(gp - 3 * D + 4);
                x0.x += m0.x * bflo(dv[hh][0]); x0.y += m0.y * bfhi(dv[hh][0]); x0.z += m0.z * bflo(dv[hh][1]); x0.w += m0.w * bfhi(dv[hh][1]);
                x1.x += m1.x * bflo(dv[hh][2]); x1.y += m1.y * bfhi(dv[hh][2]); x1.z += m1.z * bflo(dv[hh][3]); x1.w += m1.w * bfhi(dv[hh][3]);
            }
            xn[hh * 8 + 0] = x0.x + g0.x * acc[hh * 8 + 0]; xn[hh * 8 + 1] = x0.y + g0.y * acc[hh * 8 + 1]; xn[hh * 8 + 2] = x0.z + g0.z * acc[hh * 8 + 2]; xn[hh * 8 + 3] = x0.w + g0.w * acc[hh * 8 + 3];
            xn[hh * 8 + 4] = x1.x + g1.x * acc[hh * 8 + 4]; xn[hh * 8 + 5] = x1.y + g1.y * acc[hh * 8 + 5]; xn[hh * 8 + 6] = x1.z + g1.z * acc[hh * 8 + 6]; xn[hh * 8 + 7] = x1.w + g1.w * acc[hh * 8 + 7];
        }
#pragma unroll
        for (int i = 0; i < 16; ++i) ss += xn[i] * xn[i];
        const float rs = rsqrtf(wave_sum(ss) * (1.f / D) + 1e-6f);
        if (!last) {
#pragma unroll
            for (int hh = 0; hh < 2; ++hh) {
                float* xp = X + (size_t)row * D + hh * 512 + lane * 8;
                *(float4*)xp = make_float4(xn[hh * 8 + 0], xn[hh * 8 + 1], xn[hh * 8 + 2], xn[hh * 8 + 3]);
                *(float4*)(xp + 4) = make_float4(xn[hh * 8 + 4], xn[hh * 8 + 5], xn[hh * 8 + 6], xn[hh * 8 + 7]);
                const float* sp = MODN + (size_t)mrow * MODW + hh * 512 + lane * 8;
                const float4 s0 = *(const float4*)sp, s1 = *(const float4*)(sp + 4), c0 = *(const float4*)(sp + D), c1 = *(const float4*)(sp + D + 4);
                u32x4 o;
                o[0] = pack2(xn[hh * 8 + 0] * rs * gw[hh * 8 + 0] * (1.f + c0.x) + s0.x, xn[hh * 8 + 1] * rs * gw[hh * 8 + 1] * (1.f + c0.y) + s0.y);
                o[1] = pack2(xn[hh * 8 + 2] * rs * gw[hh * 8 + 2] * (1.f + c0.z) + s0.z, xn[hh * 8 + 3] * rs * gw[hh * 8 + 3] * (1.f + c0.w) + s0.w);
                o[2] = pack2(xn[hh * 8 + 4] * rs * gw[hh * 8 + 4] * (1.f + c1.x) + s1.x, xn[hh * 8 + 5] * rs * gw[hh * 8 + 5] * (1.f + c1.y) + s1.y);
                o[3] = pack2(xn[hh * 8 + 6] * rs * gw[hh * 8 + 6] * (1.f + c1.z) + s1.z, xn[hh * 8 + 7] * rs * gw[hh * 8 + 7] * (1.f + c1.w) + s1.w);
                *(u32x4*)(H + (size_t)row * D + hh * 512 + lane * 8) = o;
            }
        } else {
#if SCAN2_MODE == 1
            { const float* accp = (const float*)(p.ws + OFF_BAR + 16384); const float f = 1.f + 100.f * sqrtf(accp[0] / fmaxf(accp[1], 1e-30f));
#pragma unroll
              for (int i = 0; i < 16; ++i) xn[i] *= f; }
#endif
#pragma unroll
            for (int hh = 0; hh < 2; ++hh) {
                float* op = p.out + (size_t)row * D + hh * 512 + lane * 8;
                *(float4*)op = make_float4(xn[hh * 8 + 0] * rs * gw[hh * 8 + 0], xn[hh * 8 + 1] * rs * gw[hh * 8 + 1], xn[hh * 8 + 2] * rs * gw[hh * 8 + 2], xn[hh * 8 + 3] * rs * gw[hh * 8 + 3]);
                *(float4*)(op + 4) = make_float4(xn[hh * 8 + 4] * rs * gw[hh * 8 + 4], xn[hh * 8 + 5] * rs * gw[hh * 8 + 5], xn[hh * 8 + 6] * rs * gw[hh * 8 + 6], xn[hh * 8 + 7] * rs * gw[hh * 8 + 7]);
            }
        }
    }
}
__device__ __forceinline__ void phase_final(const Params& p) {
    const float* X = (const float*)(p.ws + OFF_X); const float* g = p.in[33];
    const int tid_ = tidx(), lane = tid_ & 63, wid = tid_ >> 6;
    for (int row = blockIdx.x * 8 + wid; row < NLAT; row += gridDim.x * 8) {
        const float* xr = X + (size_t)row * D;
        float4 v[4]; float ss = 0.f;
#pragma unroll
        for (int i = 0; i < 4; ++i) { v[i] = *(const float4*)(xr + i * 256 + lane * 4); ss += v[i].x * v[i].x + v[i].y * v[i].y + v[i].z * v[i].z + v[i].w * v[i].w; }
        ss = wave_sum(ss);
        const float rs = rsqrtf(ss * (1.f / D) + 1e-6f);
#pragma unroll
        for (int i = 0; i < 4; ++i) {
            const float4 gg = *(const float4*)(g + i * 256 + lane * 4);
            float4 o; o.x = v[i].x * rs * gg.x; o.y = v[i].y * rs * gg.y; o.z = v[i].z * rs * gg.z; o.w = v[i].w * rs * gg.w;
            *(float4*)(p.out + (size_t)row * D + i * 256 + lane * 4) = o;
        }
    }
}

#define XB_TMO      128
#define XB_XCNT(j)  (256  + 64 * (j))
#define XB_XSUB(j)  (1280 + 64 * (j))
#define XB_XGEN(j)  (2304 + 64 * (j))
#define XB_TOP      3328
#define XB_TOPGEN   3392
#define XCD_BAR_WORDS 3456
#define XB_SPIN_CAP (1u << 25)
__device__ __forceinline__ unsigned xb_ld(unsigned* p)              { return __hip_atomic_load(p, __ATOMIC_RELAXED, __HIP_MEMORY_SCOPE_AGENT); }
__device__ __forceinline__ unsigned xb_add(unsigned* p, unsigned v) { return __hip_atomic_fetch_add(p, v, __ATOMIC_RELAXED, __HIP_MEMORY_SCOPE_AGENT); }
__device__ __forceinline__ unsigned xb_xcc_id() { return (unsigned)__builtin_amdgcn_s_getreg((3 << 11) | 20) & 0xFu; }
#define XB_SPIN(cond, bar) do { unsigned _sp = 0; while (cond) { __builtin_amdgcn_s_sleep(1); \
    if ((++_sp & 255u) == 0u) { if (xb_ld(&(bar)[XB_TMO])) break; if (_sp > XB_SPIN_CAP) { atomicAdd(&(bar)[XB_TMO], 1u); break; } } } } while (0)
struct XcdBarrier { unsigned* bar; unsigned x; volatile LAS unsigned* st; };
__device__ __forceinline__ XcdBarrier xcd_barrier_post(unsigned* bar, volatile LAS unsigned* st) {
    XcdBarrier b; b.bar = bar; b.x = xb_xcc_id(); b.st = st;
    if (threadIdx.x == 0) (void)xb_add(&bar[XB_XCNT(b.x)], 1u);
    return b;
}
__device__ __forceinline__ void xcd_barrier_complete(unsigned* bar, unsigned x, unsigned& nloc, unsigned& nx) {
    const unsigned G = gridDim.x * gridDim.y * gridDim.z;
    unsigned sum, cnt, mine, sp = 0u;
    for (;;) {
        sum = 0u; cnt = 0u; mine = 0u;
#pragma unroll
        for (unsigned j = 0; j < 16; ++j) { const unsigned c = xb_ld(&bar[XB_XCNT(j)]); sum += c; cnt += (c > 0u) ? 1u : 0u; mine = (j == x) ? c : mine; }
        if (sum == G) break;
        __builtin_amdgcn_s_sleep(1);
        if ((++sp & 255u) == 0u) { if (xb_ld(&bar[XB_TMO])) break; if (sp > XB_SPIN_CAP) { atomicAdd(&bar[XB_TMO], 1u); break; } }
    }
    nloc = mine > 0u ? mine : 1u; nx = cnt > 0u ? cnt : 1u;
}
__device__ __forceinline__ void xcd_barrier(const XcdBarrier& b) {
    asm volatile("s_waitcnt vmcnt(0)" ::: "memory");
    __syncthreads();
    if (threadIdx.x == 0) {
        unsigned* bar = b.bar;
        unsigned bx = b.x; asm volatile("" : "+s"(bx));
        __builtin_amdgcn_s_waitcnt(0);
        unsigned nloc = b.st[0], nx = b.st[1];
        if (nloc == 0u) { xcd_barrier_complete(bar, bx, nloc, nx); b.st[0] = nloc; b.st[1] = nx; }
        const unsigned old = xb_add(&bar[XB_XSUB(bx)], 1u);
        const unsigned gen = old / nloc;
        if (old + 1u == (gen + 1u) * nloc) {
            __builtin_amdgcn_fence(__ATOMIC_RELEASE, "agent");
            asm volatile("s_waitcnt vmcnt(0)" ::: "memory");
            const unsigned og = xb_add(&bar[XB_TOP], 1u);
            const unsigned tg = og / nx;
            if (og + 1u == (tg + 1u) * nx) xb_add(&bar[XB_TOPGEN], 1u);
            else XB_SPIN(xb_ld(&bar[XB_TOPGEN]) == tg, bar);
            __builtin_amdgcn_fence(__ATOMIC_ACQUIRE, "agent");
            xb_add(&bar[XB_XGEN(bx)], 1u);
            asm volatile("s_waitcnt vmcnt(0)" ::: "memory");
        } else {
            XB_SPIN(xb_ld(&bar[XB_XGEN(bx)]) == gen, bar);
            __builtin_amdgcn_fence(__ATOMIC_ACQUIRE, "agent");
            asm volatile("s_waitcnt vmcnt(0)" ::: "memory");
        }
    }
    __syncthreads();
}

constexpr int NSMALLJOBS = 20;
__global__ void __launch_bounds__(NTHREADS, 2) k_mega(Params p) {
    extern __shared__ __attribute__((aligned(16))) char lds_all[];
    if (threadIdx.x == 0) *(uint4*)(lds_all + LDS_BYTES) = make_uint4(0u, 0u, 0u, 0u);
    __syncthreads();
    XcdBarrier bar = xcd_barrier_post((unsigned*)(p.ws + OFF_BAR), (volatile LAS unsigned*)(lds_all + LDS_BYTES));
    char* lds = lds_all;
#define GBAR xcd_barrier(bar)
#define DUP(bit, call) do { call; if (PROBE_MASK & (1 << (bit))) { GBAR; call; } } while (0)
    DUP(17, phase_cvt(p, 0, NSMALLJOBS, lds));
    DUP(18, phase_ada(p, lds));
    GBAR;
    if (PROBE_MASK & (1 << 19)) { for (int i = 0; i < 40; ++i) GBAR; }
    for (int l = 0; l < 4; ++l) {
        const bool last = l == 3, rw = (l & 1) == 0; const int j = l >> 1;
        const int nrows = (!last || rw) ? NT : NLAT;
        if (l == 0) { phase_norm<false>(p, l, 0, nrows, lds); GBAR; }
        if (rw) {
            DUP(1, phase_mix(p, j)); GBAR;
            DUP(2, phase_rwkv_proj(p, j, lds)); GBAR;
            DUP(3, phase_rwkv_up2(p, j, lds));
            if (j == 1) phase_rwkv_up(p, j, lds);
            GBAR;
#if SCAN2_MODE == 3
            DUP(4, phase_rwkv_scan3(p, j, lds, (bf16_t*)(p.ws + OFF_Y))); GBAR;
#elif SCAN2_MODE == 2
            phase_rwkv_scan2(p, j, lds, (bf16_t*)(p.ws + OFF_Y), -1); GBAR;
#else
            DUP(4, phase_rwkv_scan(p, j, lds)); GBAR;
#endif
#if SCAN2_MODE == 1
            phase_rwkv_scan2(p, j, lds, (bf16_t*)(p.ws + OFF_Y2DBG), 0); GBAR;
            phase_scan_compare(p); GBAR;
#endif
            DUP(5, phase_rwkv_out2(p, j, lds)); GBAR;
            phase_rwkv_wo(p, l, j, lds); GBAR;
        } else {
            DUP(6, phase_pool_dlt(p, nrows)); GBAR;
            phase_pool_gemm(p, l, j, nrows, lds); GBAR;
        }
        const int mrows = last ? NLAT : NT;
        DUP(7, phase_cvt(p, NSMALLJOBS + 3 * l, NSMALLJOBS + 3 * l + 3, lds));
        DUP(8, phase_norm<true>(p, l, 1, mrows, lds)); GBAR;
        DUP(9, phase_topk(p, !last, lds)); GBAR;
        DUP(11, phase_moe_up(p, !last, lds)); GBAR;
        DUP(12, phase_moe_down(p, !last, lds)); GBAR;
        phase_moe_combine(p, l, mrows);
        if (!last) GBAR;
    }
#undef GBAR
}

enum { PH_CVT = 0, PH_ADA, PH_NORM1, PH_NORM2, PH_PROJ, PH_UP, PH_PREP, PH_SCAN, PH_OUT, PH_WO, PH_DLT, PH_POOLG, PH_TOPK, PH_GATHER, PH_MUP, PH_MDOWN, PH_COMB, PH_FINAL, PH_MIX };
template <int PH>
__global__ void __launch_bounds__(NTHREADS) k_phase(Params p, int a0, int a1, int a2) {
    extern __shared__ __attribute__((aligned(16))) char lds[];
    if (PH == PH_CVT) phase_cvt(p, a0, a1, lds);
    if (PH == PH_ADA) phase_ada(p, lds);
    if (PH == PH_NORM1) phase_norm<false>(p, a0, 0, a1, lds);
    if (PH == PH_NORM2) phase_norm<true>(p, a0, 1, a1, lds);
    if (PH == PH_PROJ) phase_rwkv_proj(p, a0, lds);
    if (PH == PH_UP) phase_rwkv_up(p, a0, lds);
    if (PH == PH_PREP) phase_rwkv_prep(p, a0);
    if (PH == PH_SCAN) phase_rwkv_scan(p, a0, lds);
    if (PH == PH_OUT) phase_rwkv_out2(p, a0, lds);
    if (PH == PH_WO) phase_rwkv_wo(p, a0, a1, lds);
    if (PH == PH_DLT) phase_pool_dlt(p, a0);
    if (PH == PH_POOLG) phase_pool_gemm(p, a0, a1, a2, lds);
    if (PH == PH_TOPK) phase_topk(p, a0 != 0, lds);
    if (PH == PH_MUP) phase_moe_up(p, a0 != 0, lds);
    if (PH == PH_MDOWN) phase_moe_down(p, a0 != 0, lds);
    if (PH == PH_COMB) phase_moe_combine(p, a0, a1);
    if (PH == PH_FINAL) phase_final(p);
    if (PH == PH_MIX) phase_mix(p, a0);
}

template <int PH>
static void launch(const Params& p, int a0, int a1, int a2, hipStream_t s) {
    static bool init = false;
    if (!init) { hipFuncSetAttribute((const void*)k_phase<PH>, hipFuncAttributeMaxDynamicSharedMemorySize, LDS_BYTES); init = true; }
    hipLaunchKernelGGL(k_phase<PH>, dim3(256), dim3(NTHREADS), LDS_BYTES, s, p, a0, a1, a2);
}

static int add_job(Params& p, int n, const float* src, bf16_t* dst, int K, int N, int src_ld, int dst_ld, int n_mul, int n_off, int Kpad, int Npad, int nbatch, long src_bs, long dst_bs) {
    CvtJob& J = p.jobs[n];
    J.src = src; J.dst = dst; J.src_bs = src_bs; J.dst_bs = dst_bs; J.K = K; J.N = N; J.src_ld = src_ld; J.dst_ld = dst_ld; J.n_mul = n_mul; J.n_off = n_off;
    J.Kpad = Kpad; J.Npad = Npad; J.nbatch = nbatch; J.tiles = nbatch * (Kpad / 64) * ((Npad + 255) / 256);
    return n + 1;
}

extern "C" void kernel_launch(void* const* d_in, const int* in_sizes, int n_in, void* d_out, int out_size, void* d_ws, size_t ws_size, hipStream_t stream) {
    Params p;
    memset(&p, 0, sizeof(p));
    for (int i = 0; i < 34; ++i) p.in[i] = (const float*)d_in[i];
    p.out = (float*)d_out; p.ws = (char*)d_ws;
    if (ws_size < WS_NEED) { fprintf(stderr, "workspace too small: %zu < %zu\n", ws_size, (size_t)WS_NEED); }
    bf16_t* wsm_ = (bf16_t*)(p.ws + OFF_WSM);
    bf16_t* wm_ = (bf16_t*)(p.ws + OFF_WM);
    int nj = 0;
    for (int j = 0; j < 2; ++j) {
        bf16_t* base = wsm_ + (size_t)j * WJ_SIZE;
        nj = add_job(p, nj, p.in[9] + (size_t)j * 3 * D * D, base + WJ_RKV, D, D, D, D, 1, 0, D, D, 3, (long)D * D, (long)D * D);
        nj = add_job(p, nj, p.in[26] + (size_t)j * D * D, base + WJ_WO, D, D, D, D, 1, 0, D, D, 1, 0, 0);
        nj = add_job(p, nj, p.in[11] + (size_t)j * 2 * D * 64, base + WJ_W1, D, 64, 64, D, 1, 0, D, 64, 2, (long)D * 64, (long)64 * D);
        nj = add_job(p, nj, p.in[14] + (size_t)j * 2 * D * 64, base + WJ_A1, D, 64, 64, D, 1, 0, D, 64, 2, (long)D * 64, (long)64 * D);
        nj = add_job(p, nj, p.in[19] + (size_t)j * D * 128, base + WJ_G1, D, 128, 128, D, 1, 0, D, 128, 1, 0, 0);
        nj = add_job(p, nj, p.in[12] + (size_t)j * 2 * 64 * D, base + WJ_W2, 64, D, D, 64, 1, 0, 64, D, 2, (long)64 * D, (long)D * 64);
        nj = add_job(p, nj, p.in[15] + (size_t)j * 2 * 64 * D, base + WJ_A2, 64, D, D, 64, 1, 0, 64, D, 2, (long)64 * D, (long)D * 64);
        nj = add_job(p, nj, p.in[20] + (size_t)j * 128 * D, base + WJ_G2, 128, D, D, 128, 1, 0, 128, D, 1, 0, 0);
        nj = add_job(p, nj, p.in[27] + (size_t)j * 4 * 256 * 256, base + WJ_POOL, 256, 256, 256, 256, 1, 0, 256, 256, 4, 65536, 65536);
    }
    nj = add_job(p, nj, p.in[17], wsm_ + W_V1, D, 32, 32, D, 1, 0, D, 128, 1, 0, 0);
    nj = add_job(p, nj, p.in[18], wsm_ + W_V2, 32, D, D, 64, 1, 0, 64, D, 1, 0, 0);
    const int nsmall = nj;
    for (int l = 0; l < 4; ++l) {
#if MOE_F8
        nj = add_job(p, nj, p.in[30] + (size_t)l * 16 * D * FF, wm_, D, FF, FF, D, 2, 0, D, FF, 16, (long)D * FF, (long)4096 * 1024);
        p.jobs[nj - 1].f8 = 1; p.jobs[nj - 1].scale = W8_SCALE;
        nj = add_job(p, nj, p.in[31] + (size_t)l * 16 * D * FF, wm_, D, FF, FF, D, 2, 1, D, FF, 16, (long)D * FF, (long)4096 * 1024);
        p.jobs[nj - 1].f8 = 1; p.jobs[nj - 1].scale = W8_SCALE;
        nj = add_job(p, nj, p.in[32] + (size_t)l * 16 * FF * D, (bf16_t*)(p.ws + OFF_WM + WM8_2), FF, D, D, FF, 1, 0, FF, D, 16, (long)FF * D, (long)D * FF);
        p.jobs[nj - 1].f8 = 1; p.jobs[nj - 1].scale = W8_SCALE;
#else
        nj = add_job(p, nj, p.in[30] + (size_t)l * 16 * D * FF, wm_ + WM_13, D, FF, FF, D, 2, 0, D, FF, 16, (long)D * FF, (long)4096 * 1024);
        nj = add_job(p, nj, p.in[31] + (size_t)l * 16 * D * FF, wm_ + WM_13, D, FF, FF, D, 2, 1, D, FF, 16, (long)D * FF, (long)4096 * 1024);
        nj = add_job(p, nj, p.in[32] + (size_t)l * 16 * FF * D, wm_ + WM_2, FF, D, D, FF, 1, 0, FF, D, 16, (long)FF * D, (long)D * FF);
#endif
    }
#if MK_MULTI
    launch<PH_CVT>(p, 0, nsmall, 0, stream);
    launch<PH_ADA>(p, 0, 0, 0, stream);
    for (int l = 0; l < 4; ++l) {
        const bool last = l == 3, rw = (l % 2) == 0; const int j = l / 2;
        const bool need_ctx = !last || rw;
        const int nrows = need_ctx ? NT : NLAT;
        if (l == 0) launch<PH_NORM1>(p, l, nrows, 0, stream);
        if (rw) {
            launch<PH_MIX>(p, j, 0, 0, stream);
            launch<PH_PROJ>(p, j, 0, 0, stream);
            launch<PH_UP>(p, j, 0, 0, stream);
            launch<PH_PREP>(p, j, 0, 0, stream);
            launch<PH_SCAN>(p, j, 0, 0, stream);
            launch<PH_OUT>(p, j, 0, 0, stream);
            launch<PH_WO>(p, l, j, 0, stream);
        } else {
            launch<PH_DLT>(p, nrows, 0, 0, stream);
            launch<PH_POOLG>(p, l, j, nrows, stream);
        }
        const int mrows = last ? NLAT : NT;
        launch<PH_CVT>(p, nsmall + 3 * l, nsmall + 3 * l + 3, 0, stream);
        launch<PH_NORM2>(p, l, mrows, 0, stream);
        launch<PH_TOPK>(p, last ? 0 : 1, 0, 0, stream);
        launch<PH_MUP>(p, last ? 0 : 1, 0, 0, stream);
        launch<PH_MDOWN>(p, last ? 0 : 1, 0, 0, stream);
        launch<PH_COMB>(p, l, mrows, 0, stream);
    }
#else
    (void)nsmall;
    static int grid = 0;
    if (!grid) {
        hipFuncSetAttribute((const void*)k_mega, hipFuncAttributeMaxDynamicSharedMemorySize, LDS_TOTAL);
        int dev = 0, cus = 0, per_cu = 0;
        hipGetDevice(&dev);
        hipDeviceGetAttribute(&cus, hipDeviceAttributeMultiprocessorCount, dev);
        hipOccupancyMaxActiveBlocksPerMultiprocessor(&per_cu, (const void*)k_mega, NTHREADS, LDS_TOTAL);
        grid = cus * (per_cu < 1 ? per_cu : 1);
        if (grid <= 0) { fprintf(stderr, "occupancy query returned %d blocks per CU\n", per_cu); grid = 0; return; }
    }
    hipMemsetAsync(p.ws + OFF_BAR, 0, 32768, stream);
    hipLaunchKernelGGL(k_mega, dim3(grid), dim3(NTHREADS), LDS_TOTAL, stream, p);
#endif
}
```
